# Optimizing an MI355X kernel written in HIP

```python
import math
import jax, jax.numpy as jnp
from jax import lax
import numpy as np

D_MODEL = 1024
BATCH = 8
SEQ = 2048
DEPTH = 2

HEAD_DIM = 64
BLOCK_Q = 128
N_SB_HEADS = 4
DIL_PATTERNS = ((128, 1), (512, 4), (2048, 16))
N_DIL_GROUPS = len(DIL_PATTERNS)
N_DIL_HEADS = 4
N_FOX_HEADS = 4
N_DIFF_HEADS = 4
DIFF_QK_DIM = HEAD_DIM // 2
N_BRANCH = 4
BRANCH_WIDTH = 4 * HEAD_DIM
D_FF = 4 * D_MODEL
RMS_EPS = 1e-6
N_ALIBI = N_DIL_GROUPS * N_DIL_HEADS + N_DIFF_HEADS

SB_W = N_SB_HEADS * HEAD_DIM
DIL_W = N_DIL_GROUPS * N_DIL_HEADS * HEAD_DIM
FOX_W = N_FOX_HEADS * HEAD_DIM
DIFF_QK_W = N_DIFF_HEADS * 2 * DIFF_QK_DIM
DIFF_V_W = N_DIFF_HEADS * HEAD_DIM
GATE_W = N_BRANCH * D_MODEL
SPLIT_SIZES = (SB_W,) * 3 + (DIL_W,) * 3 + (FOX_W,) * 3 + (N_FOX_HEADS,) + (DIFF_QK_W, DIFF_QK_W, DIFF_V_W) + (GATE_W,)
D_IN = sum(SPLIT_SIZES)
SPLIT_OFFSETS = tuple(sum(SPLIT_SIZES[:i + 1]) for i in range(len(SPLIT_SIZES) - 1))

kernel_name = 'hybrid_gated_four_mixer_decoder'


def rms_norm(x, g):
    xf = x.astype(jnp.float32)
    y = xf * lax.rsqrt(jnp.mean(xf * xf, axis=-1, keepdims=True) + RMS_EPS)
    return (y * g.astype(jnp.float32)).astype(x.dtype)


def alibi_slopes():
    return jnp.asarray(2.0 ** (-8.0 * np.arange(1, N_ALIBI + 1) / N_ALIBI), dtype=jnp.float32)


def _stick_breaking(q_blk, k, v, dist):
    z = jnp.einsum('bqhd,bshd->bhqs', q_blk, k).astype(jnp.float32) * (HEAD_DIM ** -0.5)
    strict = dist > 0
    log_keep = jnp.where(strict, jax.nn.log_sigmoid(-z), 0.0)
    log_between = lax.cumsum(log_keep, axis=3, reverse=True) - log_keep
    a = jnp.where(strict, jnp.exp(jax.nn.log_sigmoid(z) + log_between), 0.0)
    return jnp.einsum('bhqs,bshd->bqhd', a.astype(v.dtype), v)


def _dilated(q_blk, k, v, t_idx, slopes):
    outs, lses = [], []
    for g, (window, dil) in enumerate(DIL_PATTERNS):
        dists = dil * jnp.arange(window // dil + 1)
        idx = t_idx[:, None] - dists[None, :]
        valid = idx >= 0
        idx = jnp.maximum(idx, 0)
        kg = jnp.take(k[:, :, g], idx, axis=1)
        vg = jnp.take(v[:, :, g], idx, axis=1)
        s = jnp.einsum('bqhd,bqnhd->bhqn', q_blk[:, :, g], kg).astype(jnp.float32) * (HEAD_DIM ** -0.5)
        s = s - slopes[g][:, None, None] * dists.astype(jnp.float32)
        s = jnp.where(valid, s, -jnp.inf)
        lse = jax.nn.logsumexp(s, axis=-1)
        p = jnp.exp(s - lse[..., None])
        outs.append(jnp.einsum('bhqn,bqnhd->bqhd', p.astype(v.dtype), vg))
        lses.append(lse)
    alpha = jax.nn.softmax(jnp.stack(lses, axis=0), axis=0)
    alpha = jnp.transpose(alpha, (0, 1, 3, 2))[..., None]
    return jnp.sum(alpha.astype(v.dtype) * jnp.stack(outs, axis=0), axis=0)


def _forgetting(q_blk, k, v, cum_blk, cum, dist):
    s = jnp.einsum('bqhd,bshd->bhqs', q_blk, k).astype(jnp.float32) * (HEAD_DIM ** -0.5)
    s = s + jnp.transpose(cum_blk, (0, 2, 1))[..., None] - jnp.transpose(cum, (0, 2, 1))[:, :, None, :]
    p = jax.nn.softmax(jnp.where(dist >= 0, s, -jnp.inf), axis=-1)
    return jnp.einsum('bhqs,bshd->bqhd', p.astype(v.dtype), v)


def _differential(q_blk, k, v, dist, slopes, lam):
    s = jnp.einsum('bqhcd,bshcd->bchqs', q_blk, k).astype(jnp.float32) * (DIFF_QK_DIM ** -0.5)
    s = s - slopes[:, None, None] * dist.astype(jnp.float32)
    p = jax.nn.softmax(jnp.where(dist >= 0, s, -jnp.inf), axis=-1)
    w = p[:, 0] - lam * p[:, 1]
    return jnp.einsum('bhqs,bshd->bqhd', w.astype(v.dtype), v)


def _token_mixers(h, w_in, b_forget, lam, diff_g, diff_out_scale, slopes_dil, slopes_diff):
    bsz, seq, _ = h.shape
    proj = h @ w_in
    (qa, ka, va, qb, kb, vb, qc, kc, vc, f_logit, qd, kd, vd, gate_logit) = jnp.split(proj, SPLIT_OFFSETS, axis=-1)
    qa, ka, va = (a.reshape(bsz, seq, N_SB_HEADS, HEAD_DIM) for a in (qa, ka, va))
    qb, kb, vb = (a.reshape(bsz, seq, N_DIL_GROUPS, N_DIL_HEADS, HEAD_DIM) for a in (qb, kb, vb))
    qc, kc, vc = (a.reshape(bsz, seq, N_FOX_HEADS, HEAD_DIM) for a in (qc, kc, vc))
    qd, kd = (a.reshape(bsz, seq, N_DIFF_HEADS, 2, DIFF_QK_DIM) for a in (qd, kd))
    vd = vd.reshape(bsz, seq, N_DIFF_HEADS, HEAD_DIM)
    log_f = jax.nn.log_sigmoid(f_logit.astype(jnp.float32) + b_forget.astype(jnp.float32))
    cum = jnp.cumsum(log_f, axis=1)
    s_idx = jnp.arange(seq)

    def block(q0):
        t_idx = q0 + jnp.arange(BLOCK_Q)
        dist = t_idx[:, None] - s_idx[None, :]
        sl = lambda a: lax.dynamic_slice_in_dim(a, q0, BLOCK_Q, axis=1)
        return (_stick_breaking(sl(qa), ka, va, dist),
                _dilated(sl(qb), kb, vb, t_idx, slopes_dil),
                _forgetting(sl(qc), kc, vc, sl(cum), cum, dist),
                _differential(sl(qd), kd, vd, dist, slopes_diff, lam))

    o_a, o_b, o_c, o_d = lax.map(block, jnp.arange(seq // BLOCK_Q) * BLOCK_Q)
    unblock = lambda o: jnp.moveaxis(o, 0, 1).reshape(bsz, seq, o.shape[3], o.shape[4])
    o_d = rms_norm(unblock(o_d), diff_g) * diff_out_scale
    ys = jnp.stack([unblock(o_a), unblock(o_b), unblock(o_c), o_d], axis=2)
    return ys.reshape(bsz, seq, N_BRANCH, BRANCH_WIDTH), gate_logit


def setup_inputs(seed: int = 0) -> dict:
    key = jax.random.key(seed)
    ks = jax.random.split(key, 16)
    nrm = lambda k, shape, scale: jax.random.normal(k, shape, jnp.float32) * scale
    return {
        'x': nrm(ks[0], (BATCH, SEQ, D_MODEL), 1.0),
        'mix_norm_g': 1.0 + nrm(ks[1], (DEPTH, D_MODEL), 0.05),
        'w_in': nrm(ks[2], (DEPTH, D_MODEL, D_IN), D_MODEL ** -0.5),
        'b_forget': jax.random.uniform(ks[3], (DEPTH, N_FOX_HEADS), jnp.float32, 1.0, 4.0),
        'lambda_q1': nrm(ks[4], (DEPTH, DIFF_QK_DIM), 0.1),
        'lambda_k1': nrm(ks[5], (DEPTH, DIFF_QK_DIM), 0.1),
        'lambda_q2': nrm(ks[6], (DEPTH, DIFF_QK_DIM), 0.1),
        'lambda_k2': nrm(ks[7], (DEPTH, DIFF_QK_DIM), 0.1),
        'diff_norm_g': 1.0 + nrm(ks[8], (DEPTH, HEAD_DIM), 0.05),
        'w_branch': nrm(ks[9], (DEPTH, N_BRANCH, BRANCH_WIDTH, D_MODEL), BRANCH_WIDTH ** -0.5),
        'w_out': nrm(ks[10], (DEPTH, D_MODEL, D_MODEL), D_MODEL ** -0.5),
        'mlp_norm_g': 1.0 + nrm(ks[11], (DEPTH, D_MODEL), 0.05),
        'w_up': nrm(ks[12], (DEPTH, D_MODEL, D_FF), D_MODEL ** -0.5),
        'w_down': nrm(ks[13], (DEPTH, D_FF, D_MODEL), D_FF ** -0.5),
        'final_norm_g': 1.0 + nrm(ks[14], (D_MODEL,), 0.05),
    }


def reference(x, mix_norm_g, w_in, b_forget, lambda_q1, lambda_k1, lambda_q2, lambda_k2, diff_norm_g, w_branch, w_out, mlp_norm_g, w_up, w_down, final_norm_g):
    bsz, seq, _ = x.shape
    slopes = alibi_slopes()
    n0, n1 = N_DIL_HEADS, N_DIL_HEADS + N_DIFF_HEADS
    slopes_dil = jnp.stack([slopes[:n0], slopes[n1:n1 + N_DIL_HEADS], slopes[n1 + N_DIL_HEADS:]], axis=0)
    slopes_diff = slopes[n0:n1]
    for l in range(DEPTH):
        lambda_init = 0.8 - 0.6 * math.exp(-0.3 * l)
        lam = (jnp.exp(jnp.sum(lambda_q1[l].astype(jnp.float32) * lambda_k1[l].astype(jnp.float32)))
               - jnp.exp(jnp.sum(lambda_q2[l].astype(jnp.float32) * lambda_k2[l].astype(jnp.float32))) + lambda_init)
        h = rms_norm(x, mix_norm_g[l])
        ys, gate_logit = _token_mixers(h, w_in[l], b_forget[l], lam, diff_norm_g[l], 1.0 - lambda_init, slopes_dil, slopes_diff)
        branch = jnp.einsum('bsnc,ncd->bsnd', ys, w_branch[l])
        gates = jax.nn.sigmoid(gate_logit.reshape(bsz, seq, N_BRANCH, D_MODEL))
        x = x + jnp.sum(gates * branch, axis=2) @ w_out[l]
        h = rms_norm(x, mlp_norm_g[l])
        x = x + jnp.square(jax.nn.relu(h @ w_up[l])) @ w_down[l]
    return rms_norm(x, final_norm_g)
```

```cpp
#include <hip/hip_runtime.h>
#include <hip/hip_cooperative_groups.h>
#include <cstdio>
#include <cstdint>
namespace cg = cooperative_groups;

#define LAS __attribute__((address_space(3)))
typedef unsigned short bf16_t;
typedef short bf16x8 __attribute__((ext_vector_type(8)));
typedef float f32x4 __attribute__((ext_vector_type(4)));
typedef float f32x16 __attribute__((ext_vector_type(16)));
typedef unsigned u32x4 __attribute__((ext_vector_type(4)));
typedef unsigned u32x2 __attribute__((ext_vector_type(2)));
typedef float f32x2_t __attribute__((ext_vector_type(2)));
typedef __bf16 bf16x2_t __attribute__((ext_vector_type(2)));

constexpr int DM = 1024, BATCH = 8, SEQ = 2048, DEPTH = 2, TOK = BATCH * SEQ, DFF = 4096, DIN = 8708;
constexpr int HT = TOK / 2;
constexpr int NPROJ = 35 * 256;
constexpr int LDQK = 12 * 256;
constexpr float LOG2E = 1.4426950408889634f, LN2 = 0.6931471805599453f;
constexpr float RMS_EPS = 1e-6f;

constexpr size_t MiB = 1u << 20;
constexpr size_t WS_CTL = 0, CTL_BYTES = 4096;
constexpr size_t WS_SSQ = 1 * MiB;
constexpr size_t WS_WIN = 2 * MiB;
constexpr size_t WS_WUP = WS_WIN, WS_WDN = WS_WIN + 8 * MiB;
constexpr size_t WS_WB = 20 * MiB;
constexpr size_t WS_WOUT = 22 * MiB;
constexpr size_t WS_XB = 24 * MiB;
constexpr size_t WS_MERGED = 56 * MiB;
constexpr size_t WS_YS = 88 * MiB;
constexpr size_t WS_DILO = 104 * MiB;
constexpr size_t WS_LSE = 116 * MiB;
constexpr size_t WS_FL = 117 * MiB;
constexpr size_t WS_QK = 118 * MiB;
constexpr size_t WS_VT = 166 * MiB;
constexpr size_t WS_GATE = 190 * MiB;
constexpr size_t WS_HMLP = 118 * MiB;
constexpr size_t WS_END = 254 * MiB;

constexpr int LDS_BYTES = 147456;
constexpr int NWAVES = 8;

__device__ __forceinline__ unsigned cvtpk(float lo, float hi) { f32x2_t v = {lo, hi}; bf16x2_t b = __builtin_convertvector(v, bf16x2_t); return __builtin_bit_cast(unsigned, b); }
__device__ __forceinline__ float bflo(unsigned w) { return __uint_as_float(w << 16); }
__device__ __forceinline__ float bfhi(unsigned w) { return __uint_as_float(w & 0xffff0000u); }
__device__ __forceinline__ float ex2(float x) { return __builtin_amdgcn_exp2f(x); }
__device__ __forceinline__ float lg2(float x) { return __builtin_amdgcn_logf(x); }
__device__ __forceinline__ float x32_sum(float v) { auto r = __builtin_amdgcn_permlane32_swap(__float_as_uint(v), __float_as_uint(v), false, false); return __uint_as_float(r[0]) + __uint_as_float(r[1]); }
__device__ __forceinline__ float x32_max(float v) { auto r = __builtin_amdgcn_permlane32_swap(__float_as_uint(v), __float_as_uint(v), false, false); return fmaxf(__uint_as_float(r[0]), __uint_as_float(r[1])); }
__device__ __forceinline__ float x32_partner(float v, int hi) { auto r = __builtin_amdgcn_permlane32_swap(__float_as_uint(v), __float_as_uint(v), false, false); return hi ? __uint_as_float(r[0]) : __uint_as_float(r[1]); }
template <int X> __device__ __forceinline__ float swz_xor(float v) { return __uint_as_float((unsigned)__builtin_amdgcn_ds_swizzle((int)__float_as_uint(v), (X << 10) | 0x1f)); }
__device__ __forceinline__ float x16_sum(float v) { return v + swz_xor<16>(v); }
__device__ __forceinline__ float wave_sum(float v) { v += swz_xor<1>(v); v += swz_xor<2>(v); v += swz_xor<4>(v); v += swz_xor<8>(v); v += swz_xor<16>(v); return x32_sum(v); }

namespace pg8 {
constexpr int BM = 256, BK = 64, HALF = 128, HTB = HALF * BK * 2, STAGE_BYTES = 8 * HTB, NXCD = 8, WGM = 8;
__host__ __device__ __forceinline__ int lds_byte(int r, int c) { const int st = (r >> 4) * 2 + (c >> 5), rr = r & 15, cc = c & 31, ob = rr * 64 + cc * 2; return st * 1024 + (ob ^ (((ob >> 9) & 1) << 5)); }
__host__ __device__ __forceinline__ void stage_rc(int b, int& R, int& C) { const int st = b / 1024, sb = b % 1024, swz = sb ^ (((sb >> 9) & 1) << 5); R = (st >> 1) * 16 + swz / 64; C = (st & 1) * 32 + (swz % 64) / 2; }
__host__ __device__ __forceinline__ int perm32(int rho) { const int n = rho >> 4, i = rho & 15; return 8 * (i >> 2) + 4 * n + (i & 3); }

struct Unit { int pm, pn, aux; };
struct Gemm { const bf16_t* A; const bf16_t* Bt; int lda, ldb, K; long a_aux, b_aux; };

struct StaticOrder {
    int nM, nN, nwg, G, c;
    __device__ void init(int M, int N, int G_, int c_) { nM = M / BM; nN = N / BM; nwg = nM * nN; G = G_; c = c_; }
    __device__ bool next(int i, Unit& u) const {
        const long L = (long)i * G + c; if (L >= nwg) return false;
        int wgid = (int)L; { const int q = nwg / NXCD, r = nwg % NXCD, xcd = wgid % NXCD, off = wgid / NXCD; wgid = (xcd < r ? xcd * (q + 1) : r * (q + 1) + (xcd - r) * q) + off; }
        const int nig = WGM * nN, gid = wgid / nig, fm = gid * WGM, gsz = (nM - fm) < WGM ? (nM - fm) : WGM;
        u.pm = fm + ((wgid % nig) % gsz); u.pn = (wgid % nig) / gsz; u.aux = 0; return true;
    }
};
struct BranchOrder {
    int c;
    __device__ bool next(int i, Unit& u) const { if (c >= 128 || i >= 4) return false; u.pm = c >> 2; u.pn = c & 3; u.aux = i; return true; }
};

template <class Epi, class Sched, bool ALIGN_EPI>
__device__ __forceinline__ void gemm_phase(LAS unsigned char* lds, const Gemm g, const Sched& S, const Epi& E) {
    int tid_ = threadIdx.x; asm volatile("" : "+v"(tid_));
    const int tid = tid_, wid = __builtin_amdgcn_readfirstlane(tid >> 6), lane = tid & 63, wr = wid >> 2, wc = wid & 3, fr = lane & 15, fq = lane >> 4;
    int nt_ = g.K / BK; asm volatile("" : "+s"(nt_)); const int nt = nt_;
    unsigned voffA[2], voffB[2];
#pragma unroll
    for (int i = 0; i < 2; ++i) { int R, C; stage_rc(tid * 16 + i * 8192, R, C); const int Rb = Epi::PERM ? ((R & ~31) + perm32(R & 31)) : R;
        voffA[i] = (unsigned)(R * g.lda + C) * 2u; voffB[i] = (unsigned)(Rb * g.ldb + C) * 2u; }
    const size_t kstep = (size_t)(BK * 2);
    const size_t hstepA = (size_t)HALF * g.lda * 2, hstepB = (size_t)HALF * g.ldb * 2;
    const size_t tstepA = 2 * hstepA, tstepB = 2 * hstepB;
    const unsigned ldsw = (unsigned)wid * 1024u;
    const int aoff = lds_byte(wr * 64 + fr, fq * 8), boff = lds_byte(wc * 32 + fr, fq * 8);
#define PG8_SA(b, h) (((b) * 2 + (h)) * HTB)
#define PG8_SB(b, h) ((4 + (b) * 2 + (h)) * HTB)
#define PG8_STAGE(bufoff, gbase, voff) do { _Pragma("unroll") for (int _i = 0; _i < 2; ++_i) \
        __builtin_amdgcn_global_load_lds((const unsigned*)((const char*)(gbase) + (voff)[_i]), (LAS unsigned*)(lds + (bufoff) + ldsw + _i * 8192), 16, 0, 0); } while (0)
#define PG8_LDA(dst, b, h) do { _Pragma("unroll") for (int m = 0; m < 4; ++m) _Pragma("unroll") for (int k = 0; k < 2; ++k) dst[m][k] = *(const LAS bf16x8*)(lds + PG8_SA(b, h) + aoff + m * 2048 + k * 1024); } while (0)
#define PG8_LDB(dst, b, h) do { _Pragma("unroll") for (int n = 0; n < 2; ++n) _Pragma("unroll") for (int k = 0; k < 2; ++k) dst[n][k] = *(const LAS bf16x8*)(lds + PG8_SB(b, h) + boff + n * 2048 + k * 1024); } while (0)
#define PG8_MMA(ai, bj, At, Bt) do { __builtin_amdgcn_s_setprio(1); _Pragma("unroll") for (int m = 0; m < 4; ++m) _Pragma("unroll") for (int n = 0; n < 2; ++n) _Pragma("unroll") for (int k = 0; k < 2; ++k) \
        acc[ai][bj][m][n] = __builtin_amdgcn_mfma_f32_16x16x32_bf16(Bt[n][k], At[m][k], acc[ai][bj][m][n], 0, 0, 0); __builtin_amdgcn_s_setprio(0); } while (0)
#define PG8_WAIT_V(n) asm volatile("s_waitcnt vmcnt(" #n ")" ::: "memory")
#define PG8_WAIT_L(n) asm volatile("s_waitcnt lgkmcnt(" #n ")" ::: "memory")
#define PG8_BAR __builtin_amdgcn_s_barrier()
#define PG8_SCHED __builtin_amdgcn_sched_barrier(0)
#define PG8_UA(u) ((const char*)g.A + (size_t)(u).pm * tstepA + (size_t)(u).aux * (size_t)g.a_aux)
#define PG8_UB(u) ((const char*)g.Bt + (size_t)(u).pn * tstepB + (size_t)(u).aux * (size_t)g.b_aux)
    Unit cur, nxt; int ui = 0;
    if (!S.next(0, cur)) return;
    f32x4 acc[2][2][4][2];
#pragma unroll
    for (int a = 0; a < 2; ++a)
#pragma unroll
        for (int b = 0; b < 2; ++b)
#pragma unroll
            for (int m = 0; m < 4; ++m)
#pragma unroll
                for (int n = 0; n < 2; ++n) acc[a][b][m][n] = (f32x4){0.f, 0.f, 0.f, 0.f};
    bf16x8 At[4][2], B0[2][2], B1[2][2];
    const char* cA = PG8_UA(cur); const char* cB = PG8_UB(cur);
    PG8_STAGE(PG8_SB(0, 0), cB, voffB); PG8_STAGE(PG8_SB(0, 1), cB + hstepB, voffB); PG8_STAGE(PG8_SA(0, 0), cA, voffA); PG8_STAGE(PG8_SA(0, 1), cA + hstepA, voffA);
    if (wr == 1) PG8_BAR;
    PG8_WAIT_V(2); PG8_BAR;
    PG8_STAGE(PG8_SB(1, 0), cB + kstep, voffB); PG8_STAGE(PG8_SA(1, 0), cA + kstep, voffA); PG8_STAGE(PG8_SB(1, 1), cB + hstepB + kstep, voffB);
    PG8_WAIT_V(6); PG8_BAR;
    for (;;) {
        const bool has_next = S.next(ui + 1, nxt);
        const char* nA = has_next ? PG8_UA(nxt) : cA; const char* nB = has_next ? PG8_UB(nxt) : cB;
        for (int t = 0; t < nt; t += 2) {
            const bool last = (t == nt - 2);
            const char* a1 = cA + (size_t)(t + 1) * kstep;
            const char* a2 = last ? nA : cA + (size_t)(t + 2) * kstep; const char* b2 = last ? nB : cB + (size_t)(t + 2) * kstep;
            const char* a3 = a2 + kstep; const char* b3 = b2 + kstep;
            PG8_LDB(B0, 0, 0); PG8_LDB(B1, 0, 1); PG8_SCHED; PG8_LDA(At, 0, 0); PG8_STAGE(PG8_SA(1, 1), a1 + hstepA, voffA);
            PG8_WAIT_V(8); PG8_WAIT_L(0); PG8_BAR; PG8_MMA(0, 0, At, B0); PG8_MMA(0, 1, At, B1); PG8_BAR; PG8_SCHED;
            PG8_LDA(At, 0, 1); PG8_STAGE(PG8_SB(0, 0), b2, voffB); PG8_STAGE(PG8_SB(0, 1), b2 + hstepB, voffB); PG8_STAGE(PG8_SA(0, 0), a2, voffA);
            PG8_WAIT_V(8); PG8_WAIT_L(0); PG8_BAR; PG8_MMA(1, 0, At, B0); PG8_MMA(1, 1, At, B1); PG8_BAR; PG8_SCHED;
            PG8_LDB(B0, 1, 0); PG8_LDB(B1, 1, 1); PG8_SCHED; PG8_LDA(At, 1, 0); PG8_STAGE(PG8_SA(0, 1), a2 + hstepA, voffA);
            PG8_WAIT_V(8); PG8_WAIT_L(0); PG8_BAR; PG8_MMA(0, 0, At, B0); PG8_MMA(0, 1, At, B1); PG8_BAR; PG8_SCHED;
            PG8_LDA(At, 1, 1); PG8_STAGE(PG8_SB(1, 0), b3, voffB); PG8_STAGE(PG8_SB(1, 1), b3 + hstepB, voffB); PG8_STAGE(PG8_SA(1, 0), a3, voffA);
            PG8_WAIT_V(8); PG8_WAIT_L(0); PG8_BAR; PG8_MMA(1, 0, At, B0); PG8_MMA(1, 1, At, B1); PG8_BAR; PG8_SCHED;
        }
        if constexpr (ALIGN_EPI) { if (wr == 0) PG8_BAR; }
        { Unit eu = cur; asm volatile("" : "+s"(eu.pm), "+s"(eu.pn), "+s"(eu.aux)); E(acc, eu, wr, wc, fr, fq); }
        if (!has_next) break;
#pragma unroll
        for (int a = 0; a < 2; ++a)
#pragma unroll
            for (int b = 0; b < 2; ++b)
#pragma unroll
                for (int m = 0; m < 4; ++m)
#pragma unroll
                    for (int n = 0; n < 2; ++n) acc[a][b][m][n] = (f32x4){0.f, 0.f, 0.f, 0.f};
        cur = nxt; cA = nA; cB = nB; ++ui;
        if constexpr (ALIGN_EPI) { if (wr == 1) PG8_BAR; }
    }
    PG8_WAIT_V(0);
    if constexpr (!ALIGN_EPI) { if (wr == 0) PG8_BAR; }
    PG8_BAR;
#undef PG8_SA
#undef PG8_SB
#undef PG8_STAGE
#undef PG8_LDA
#undef PG8_LDB
#undef PG8_MMA
#undef PG8_WAIT_V
#undef PG8_WAIT_L
#undef PG8_BAR
#undef PG8_SCHED
#undef PG8_UA
#undef PG8_UB
}

__device__ __forceinline__ float row_rstd(const float* ssq, int row) {
    const f32x4* p = (const f32x4*)(ssq + (size_t)row * 16);
    const f32x4 a = p[0], b = p[1], c = p[2], d = p[3];
    const float s = ((a[0] + a[1]) + (a[2] + a[3])) + ((b[0] + b[1]) + (b[2] + b[3])) + ((c[0] + c[1]) + (c[2] + c[3])) + ((d[0] + d[1]) + (d[2] + d[3]));
    return __builtin_amdgcn_rsqf(s * (1.0f / DM) + RMS_EPS);
}
__device__ __forceinline__ int pos16(int o) { return 8 * ((o >> 2) & 1) + 4 * (o >> 3) + (o & 3); }

struct EpiProj {
    static constexpr bool PERM = true;
    const float* ssq; int row_base; bf16_t* QK; bf16_t* VT; float* FL; bf16_t* GATE;
    __device__ __forceinline__ void operator()(const f32x4 (&acc)[2][2][4][2], const Unit& u, int wr, int wc, int fr, int fq) const {
        const int pn = u.pn;
        const int lrow0 = u.pm * BM + wr * 64 + fr;
        const int cin = wc * 32 + 8 * fq;
        if (pn >= 19) {
#pragma unroll
            for (int ai = 0; ai < 2; ++ai)
#pragma unroll
                for (int m = 0; m < 4; ++m) { const int lrow = lrow0 + ai * HALF + m * 16; const float s = row_rstd(ssq, row_base + lrow); asm volatile("" ::: "memory");
#pragma unroll
                    for (int bj = 0; bj < 2; ++bj) { const f32x4 v0 = acc[ai][bj][m][0] * s, v1 = acc[ai][bj][m][1] * s;
                        u32x4 w; w.x = cvtpk(v0[0], v0[1]); w.y = cvtpk(v0[2], v0[3]); w.z = cvtpk(v1[0], v1[1]); w.w = cvtpk(v1[2], v1[3]);
                        *(u32x4*)(GATE + (size_t)lrow * 4096 + (pn - 19) * 256 + bj * HALF + cin) = w; } asm volatile("" ::: "memory"); }
        } else if (pn == 18) {
            if (wc == 0 && fq == 0) {
#pragma unroll
                for (int ai = 0; ai < 2; ++ai)
#pragma unroll
                    for (int m = 0; m < 4; ++m) { const int lrow = lrow0 + ai * HALF + m * 16; *(f32x4*)(FL + (size_t)lrow * 4) = acc[ai][0][m][0] * row_rstd(ssq, row_base + lrow); asm volatile("" ::: "memory"); }
            }
        } else if (pn == 2 || (pn >= 9 && pn <= 11) || pn == 14 || pn == 17) {
            int vhb, rsh;
            if (pn == 2) { vhb = 0; rsh = 0; } else if (pn == 14) { vhb = 16; rsh = 0; } else if (pn == 17) { vhb = 20; rsh = 0; } else { const int gI = pn - 9; vhb = 4 + 4 * gI; rsh = 2 * gI; }
            const int slsh = 11 - rsh, rmask = (1 << rsh) - 1;
#pragma unroll
            for (int ai = 0; ai < 2; ++ai)
#pragma unroll
                for (int m = 0; m < 4; ++m) { const int lrow = lrow0 + ai * HALF + m * 16; const float s = row_rstd(ssq, row_base + lrow); asm volatile("" ::: "memory");
                    const int bl = lrow >> 11, t = lrow & (SEQ - 1); int p = ((t & rmask) << slsh) + (t >> rsh); p = (p & ~15) | pos16(p & 15);
                    bf16_t* base = VT + (size_t)bl * 24 * 64 * SEQ + p;
#pragma unroll
                    for (int bj = 0; bj < 2; ++bj) { const int c0 = bj * HALF + cin; bf16_t* bp = base + (size_t)(vhb * 64 + c0) * SEQ;
                        const f32x4 v0 = acc[ai][bj][m][0] * s, v1 = acc[ai][bj][m][1] * s;
                        const unsigned w0 = cvtpk(v0[0], v0[1]), w1 = cvtpk(v0[2], v0[3]), w2 = cvtpk(v1[0], v1[1]), w3 = cvtpk(v1[2], v1[3]);
                        bp[0 * SEQ] = (bf16_t)(w0 & 0xffff); bp[1 * SEQ] = (bf16_t)(w0 >> 16); bp[2 * SEQ] = (bf16_t)(w1 & 0xffff); bp[3 * SEQ] = (bf16_t)(w1 >> 16);
                        bp[4 * SEQ] = (bf16_t)(w2 & 0xffff); bp[5 * SEQ] = (bf16_t)(w2 >> 16); bp[6 * SEQ] = (bf16_t)(w3 & 0xffff); bp[7 * SEQ] = (bf16_t)(w3 >> 16); } asm volatile("" ::: "memory"); }
        } else {
            int slot, rsh = 0;
            if (pn <= 1) slot = pn; else if (pn <= 8) { slot = pn - 1; const int gI = (pn - 3) % 3; rsh = 2 * gI; } else if (pn <= 13) slot = pn - 4; else slot = pn - 5;
            const int slsh = 11 - rsh, rmask = (1 << rsh) - 1;
#pragma unroll
            for (int ai = 0; ai < 2; ++ai)
#pragma unroll
                for (int m = 0; m < 4; ++m) { const int lrow = lrow0 + ai * HALF + m * 16; const float s = row_rstd(ssq, row_base + lrow); asm volatile("" ::: "memory");
                    const int bl = lrow >> 11, t = lrow & (SEQ - 1); const int prow = bl * SEQ + ((t & rmask) << slsh) + (t >> rsh);
#pragma unroll
                    for (int bj = 0; bj < 2; ++bj) { const f32x4 v0 = acc[ai][bj][m][0] * s, v1 = acc[ai][bj][m][1] * s;
                        u32x4 w; w.x = cvtpk(v0[0], v0[1]); w.y = cvtpk(v0[2], v0[3]); w.z = cvtpk(v1[0], v1[1]); w.w = cvtpk(v1[2], v1[3]);
                        *(u32x4*)(QK + (size_t)prow * LDQK + slot * 256 + bj * HALF + cin) = w; } asm volatile("" ::: "memory"); }
        }
    }
};

struct EpiBranch {
    static constexpr bool PERM = true;
    const bf16_t* GATE; bf16_t* MERGED; int row_base;
    __device__ __forceinline__ static float sg(float g) { return __builtin_amdgcn_rcpf(1.0f + ex2(-g * LOG2E)); }
    __device__ __forceinline__ void operator()(const f32x4 (&acc)[2][2][4][2], const Unit& u, int wr, int wc, int fr, int fq) const {
        const int n = u.aux; const int lrow0 = u.pm * BM + wr * 64 + fr; const int col0 = u.pn * BM + wc * 32 + 8 * fq;
        const bf16_t* gbase = GATE + (size_t)lrow0 * 4096 + n * 1024 + col0; bf16_t* mbase = MERGED + (size_t)(row_base + lrow0) * DM + col0;
#pragma unroll
        for (int ai = 0; ai < 2; ++ai)
#pragma unroll
            for (int m = 0; m < 4; ++m)
#pragma unroll
                for (int bj = 0; bj < 2; ++bj) {
                    const size_t ro = (size_t)(ai * HALF + m * 16);
                    const u32x4 gw = *(const u32x4*)(gbase + ro * 4096 + bj * HALF);
                    bf16_t* mp = mbase + ro * DM + bj * HALF;
                    const f32x4 v0 = acc[ai][bj][m][0], v1 = acc[ai][bj][m][1];
                    float o0 = sg(bflo(gw.x)) * v0[0], o1 = sg(bfhi(gw.x)) * v0[1], o2 = sg(bflo(gw.y)) * v0[2], o3 = sg(bfhi(gw.y)) * v0[3];
                    float o4 = sg(bflo(gw.z)) * v1[0], o5 = sg(bfhi(gw.z)) * v1[1], o6 = sg(bflo(gw.w)) * v1[2], o7 = sg(bfhi(gw.w)) * v1[3];
                    if (n > 0) { const u32x4 ow = *(const u32x4*)mp; o0 += bflo(ow.x); o1 += bfhi(ow.x); o2 += bflo(ow.y); o3 += bfhi(ow.y); o4 += bflo(ow.z); o5 += bfhi(ow.z); o6 += bflo(ow.w); o7 += bfhi(ow.w); }
                    u32x4 w; w.x = cvtpk(o0, o1); w.y = cvtpk(o2, o3); w.z = cvtpk(o4, o5); w.w = cvtpk(o6, o7);
                    *(u32x4*)mp = w; asm volatile("" ::: "memory");
                }
    }
};

struct EpiResid {
    static constexpr bool PERM = true;
    float* X; bf16_t* XB; float* ssq;
    __device__ __forceinline__ void operator()(const f32x4 (&acc)[2][2][4][2], const Unit& u, int wr, int wc, int fr, int fq) const {
        const int row0 = u.pm * BM + wr * 64 + fr; const int col0 = u.pn * BM + wc * 32 + 8 * fq;
#pragma unroll
        for (int ai = 0; ai < 2; ++ai)
#pragma unroll
            for (int m = 0; m < 4; ++m) { const int row = row0 + ai * HALF + m * 16; float sq = 0.f;
#pragma unroll
                for (int bj = 0; bj < 2; ++bj) { const int col = col0 + bj * HALF; f32x4* xp = (f32x4*)(X + (size_t)row * DM + col);
                    const f32x4 x0 = xp[0] + acc[ai][bj][m][0], x1 = xp[1] + acc[ai][bj][m][1];
                    xp[0] = x0; xp[1] = x1;
                    u32x4 w; w.x = cvtpk(x0[0], x0[1]); w.y = cvtpk(x0[2], x0[3]); w.z = cvtpk(x1[0], x1[1]); w.w = cvtpk(x1[2], x1[3]);
                    *(u32x4*)(XB + (size_t)row * DM + col) = w;
                    sq += (x0[0] * x0[0] + x0[1] * x0[1]) + (x0[2] * x0[2] + x0[3] * x0[3]) + (x1[0] * x1[0] + x1[1] * x1[1]) + (x1[2] * x1[2] + x1[3] * x1[3]); }
                sq = x16_sum(sq); sq = x32_sum(sq);
                if (fq == 0) ssq[(size_t)row * 16 + u.pn * 4 + wc] = sq; asm volatile("" ::: "memory"); }
    }
};

struct EpiUp {
    static constexpr bool PERM = true;
    const float* ssq; bf16_t* H;
    __device__ __forceinline__ void operator()(const f32x4 (&acc)[2][2][4][2], const Unit& u, int wr, int wc, int fr, int fq) const {
        const int row0 = u.pm * BM + wr * 64 + fr; const int col0 = u.pn * BM + wc * 32 + 8 * fq;
#pragma unroll
        for (int ai = 0; ai < 2; ++ai)
#pragma unroll
            for (int m = 0; m < 4; ++m) { const int row = row0 + ai * HALF + m * 16; const float s = row_rstd(ssq, row); asm volatile("" ::: "memory");
#pragma unroll
                for (int bj = 0; bj < 2; ++bj) { f32x4 v0 = acc[ai][bj][m][0] * s, v1 = acc[ai][bj][m][1] * s;
#pragma unroll
                    for (int i = 0; i < 4; ++i) { const float a = fmaxf(v0[i], 0.f), b = fmaxf(v1[i], 0.f); v0[i] = a * a; v1[i] = b * b; }
                    u32x4 w; w.x = cvtpk(v0[0], v0[1]); w.y = cvtpk(v0[2], v0[3]); w.z = cvtpk(v1[0], v1[1]); w.w = cvtpk(v1[2], v1[3]);
                    *(u32x4*)(H + (size_t)row * DFF + col0 + bj * HALF) = w; } asm volatile("" ::: "memory"); }
    }
};
}

__device__ __forceinline__ int win_src(int n) {
    if (n < 3840) return n;
    if (n < 4608) return n + 4;
    if (n < 4864) return (n - 4608 < 4) ? 3840 + (n - 4608) : -1;
    return n - 4864 + 4612;
}
template <int CMAP>
__device__ __forceinline__ void transpose_item(const float* W, int K, int N, int Nsrc, const float* gain, bf16_t* WT, LAS float* scr, int item, int lane) {
    const int nblk = N / 32, kb = item / nblk, nb = item % nblk, k0 = 64 * kb, n0 = 32 * nb;
    const int n = n0 + (lane & 31); const int src = CMAP ? win_src(n) : n;
#pragma unroll 8
    for (int i = 0; i < 32; ++i) { const int kk = 2 * i + (lane >> 5); float v = 0.f; if (src >= 0) { v = W[(size_t)(k0 + kk) * Nsrc + src]; if (gain) v *= gain[k0 + kk]; } scr[kk * 33 + (lane & 31)] = v; }
    asm volatile("s_waitcnt lgkmcnt(0)" ::: "memory");
    const int c = lane & 7;
#pragma unroll
    for (int j = 0; j < 4; ++j) { const int nn = (lane >> 3) + 8 * j; const LAS float* s = scr + (8 * c) * 33 + nn;
        u32x4 o; o.x = cvtpk(s[0 * 33], s[1 * 33]); o.y = cvtpk(s[2 * 33], s[3 * 33]); o.z = cvtpk(s[4 * 33], s[5 * 33]); o.w = cvtpk(s[6 * 33], s[7 * 33]);
        *(u32x4*)(WT + (size_t)(n0 + nn) * K + k0 + 8 * c) = o; }
    asm volatile("s_waitcnt lgkmcnt(0)" ::: "memory");
}

#define MFMA32(a, b, c) __builtin_amdgcn_mfma_f32_32x32x16_bf16((a), (b), (c), 0, 0, 0)
__device__ __forceinline__ bf16x8 ld16(const bf16_t* p) { return *(const bf16x8*)p; }
__device__ __forceinline__ bf16x8 pack8(const f32x16& s, int b) { u32x4 w; w.x = cvtpk(s[b], s[b + 1]); w.y = cvtpk(s[b + 2], s[b + 3]); w.z = cvtpk(s[b + 4], s[b + 5]); w.w = cvtpk(s[b + 6], s[b + 7]); return __builtin_bit_cast(bf16x8, w); }
__device__ __forceinline__ int crow(int r, int hi) { return (r & 3) + 8 * (r >> 2) + 4 * hi; }
__device__ __forceinline__ void store_o(bf16_t* orow, const f32x16& o0, const f32x16& o1, int hi) {
#pragma unroll
    for (int g = 0; g < 4; ++g) {
        u32x2 a; a.x = cvtpk(o0[4 * g], o0[4 * g + 1]); a.y = cvtpk(o0[4 * g + 2], o0[4 * g + 3]); *(u32x2*)(orow + 8 * g + 4 * hi) = a;
        u32x2 b; b.x = cvtpk(o1[4 * g], o1[4 * g + 1]); b.y = cvtpk(o1[4 * g + 2], o1[4 * g + 3]); *(u32x2*)(orow + 32 + 8 * g + 4 * hi) = b; }
}

template <int MODE>
__device__ __forceinline__ void sm_unit(const bf16_t* Qs, const bf16_t* Ks, const bf16_t* VTs, int qb, int kb_lo, float slope2, const LAS float* cl,
                                        f32x16& o0, f32x16& o1, float& m_out, float& l_out, int lane) {
    const int r32 = lane & 31, hi = lane >> 5;
    constexpr float SC2 = 0.125f * LOG2E;
    bf16x8 qf[4];
    { const bf16_t* qp = Qs + (size_t)(qb * 32 + r32) * LDQK + hi * 8;
#pragma unroll
      for (int ds = 0; ds < 4; ++ds) qf[ds] = ld16(qp + ds * 16); }
    float m = -INFINITY, l = 0.f;
#pragma unroll
    for (int i = 0; i < 16; ++i) { o0[i] = 0.f; o1[i] = 0.f; }
    for (int kb = qb; kb >= kb_lo; --kb) {
        f32x16 s;
#pragma unroll
        for (int i = 0; i < 16; ++i) s[i] = 0.f;
        const bf16_t* kp = Ks + (size_t)(kb * 32 + r32) * LDQK + hi * 8;
#pragma unroll
        for (int ds = 0; ds < 4; ++ds) { const bf16x8 kf = ld16(kp + ds * 16); s = MFMA32(kf, qf[ds], s); }
        const bf16_t* vp = VTs + (size_t)r32 * SEQ + kb * 32 + hi * 8;
        const bf16x8 v00 = ld16(vp), v01 = ld16(vp + 16), v10 = ld16(vp + 32 * SEQ), v11 = ld16(vp + 32 * SEQ + 16);
        float mt = -INFINITY;
#pragma unroll
        for (int r = 0; r < 16; ++r) { const int kk = crow(r, hi); float v; bool valid;
            if (MODE == 0) { v = s[r] * SC2 + cl[33 * kb + kk]; valid = (kb < qb) || (kk <= r32); }
            else { const int dist = (qb - kb) * 32 + r32 - kk; v = s[r] * SC2 - slope2 * (float)dist; valid = (dist >= 0) && (dist <= 128); }
            v = valid ? v : -INFINITY; s[r] = v; mt = fmaxf(mt, v); }
        mt = x32_max(mt);
        const float mn = fmaxf(m, mt), alpha = ex2(m - mn);
        float ps = 0.f;
#pragma unroll
        for (int r = 0; r < 16; ++r) { const float p = ex2(s[r] - mn); s[r] = p; ps += p; }
        l = l * alpha + ps; m = mn;
#pragma unroll
        for (int i = 0; i < 16; ++i) { o0[i] *= alpha; o1[i] *= alpha; }
        const bf16x8 pf0 = pack8(s, 0), pf1 = pack8(s, 8);
        o0 = MFMA32(v00, pf0, o0); o0 = MFMA32(v01, pf1, o0); o1 = MFMA32(v10, pf0, o1); o1 = MFMA32(v11, pf1, o1);
    }
    l = x32_sum(l);
    m_out = m; l_out = l;
}

__device__ __forceinline__ void diff_unit(const bf16_t* Qs, const bf16_t* Ks, const bf16_t* VTs, int qb, float slope2, float lam, f32x16& r0, f32x16& r1, int lane) {
    const int r32 = lane & 31, hi = lane >> 5;
    constexpr float SC2 = 0.17677669529663687f * LOG2E;
    bf16x8 qf[4];
    { const bf16_t* qp = Qs + (size_t)(qb * 32 + r32) * LDQK + hi * 8;
#pragma unroll
      for (int ds = 0; ds < 4; ++ds) qf[ds] = ld16(qp + ds * 16); }
    float m[2] = {-INFINITY, -INFINITY}, l[2] = {0.f, 0.f};
    f32x16 o[2][2];
#pragma unroll
    for (int i = 0; i < 16; ++i) { o[0][0][i] = 0.f; o[0][1][i] = 0.f; o[1][0][i] = 0.f; o[1][1][i] = 0.f; }
    for (int kb = qb; kb >= 0; --kb) {
        const bf16_t* kp = Ks + (size_t)(kb * 32 + r32) * LDQK + hi * 8;
        bf16x8 kf[4];
#pragma unroll
        for (int ds = 0; ds < 4; ++ds) kf[ds] = ld16(kp + ds * 16);
        const bf16_t* vp = VTs + (size_t)r32 * SEQ + kb * 32 + hi * 8;
        const bf16x8 v00 = ld16(vp), v01 = ld16(vp + 16), v10 = ld16(vp + 32 * SEQ), v11 = ld16(vp + 32 * SEQ + 16);
#pragma unroll
        for (int c = 0; c < 2; ++c) {
            f32x16 s;
#pragma unroll
            for (int i = 0; i < 16; ++i) s[i] = 0.f;
            s = MFMA32(kf[2 * c], qf[2 * c], s); s = MFMA32(kf[2 * c + 1], qf[2 * c + 1], s);
            float mt = -INFINITY;
#pragma unroll
            for (int r = 0; r < 16; ++r) { const int dist = (qb - kb) * 32 + r32 - crow(r, hi); float v = s[r] * SC2 - slope2 * (float)dist; v = (dist >= 0) ? v : -INFINITY; s[r] = v; mt = fmaxf(mt, v); }
            mt = x32_max(mt);
            const float mn = fmaxf(m[c], mt), alpha = ex2(m[c] - mn);
            float ps = 0.f;
#pragma unroll
            for (int r = 0; r < 16; ++r) { const float p = ex2(s[r] - mn); s[r] = p; ps += p; }
            l[c] = l[c] * alpha + ps; m[c] = mn;
#pragma unroll
            for (int i = 0; i < 16; ++i) { o[c][0][i] *= alpha; o[c][1][i] *= alpha; }
            const bf16x8 pf0 = pack8(s, 0), pf1 = pack8(s, 8);
            o[c][0] = MFMA32(v00, pf0, o[c][0]); o[c][0] = MFMA32(v01, pf1, o[c][0]); o[c][1] = MFMA32(v10, pf0, o[c][1]); o[c][1] = MFMA32(v11, pf1, o[c][1]);
        }
    }
    l[0] = x32_sum(l[0]); l[1] = x32_sum(l[1]);
    const float i0 = 1.0f / l[0], i1 = lam / l[1];
#pragma unroll
    for (int i = 0; i < 16; ++i) { r0[i] = o[0][0][i] * i0 - o[1][0][i] * i1; r1[i] = o[0][1][i] * i0 - o[1][1][i] * i1; }
}

__device__ __forceinline__ void sb_unit(const bf16_t* Qs, const bf16_t* Ks, const bf16_t* VTs, int qb, f32x16& o0, f32x16& o1, int lane) {
    const int r32 = lane & 31, hi = lane >> 5;
    constexpr float SC2 = 0.125f * LOG2E;
    bf16x8 qf[4];
    { const bf16_t* qp = Qs + (size_t)(qb * 32 + r32) * LDQK + hi * 8;
#pragma unroll
      for (int ds = 0; ds < 4; ++ds) qf[ds] = ld16(qp + ds * 16); }
    float R = 0.f;
#pragma unroll
    for (int i = 0; i < 16; ++i) { o0[i] = 0.f; o1[i] = 0.f; }
    for (int kb = qb; kb >= 0; --kb) {
        f32x16 s;
#pragma unroll
        for (int i = 0; i < 16; ++i) s[i] = 0.f;
        const bf16_t* kp = Ks + (size_t)(kb * 32 + r32) * LDQK + hi * 8;
#pragma unroll
        for (int ds = 0; ds < 4; ++ds) { const bf16x8 kf = ld16(kp + ds * 16); s = MFMA32(kf, qf[ds], s); }
        const bf16_t* vp = VTs + (size_t)r32 * SEQ + kb * 32 + hi * 8;
        const bf16x8 v00 = ld16(vp), v01 = ld16(vp + 16), v10 = ld16(vp + 32 * SEQ), v11 = ld16(vp + 32 * SEQ + 16);
        float lk[16], ls[16];
#pragma unroll
        for (int r = 0; r < 16; ++r) { const float z2 = s[r] * SC2; const float sp = fmaxf(z2, 0.f) + lg2(1.0f + ex2(-fabsf(z2)));
            const bool valid = (kb < qb) || (crow(r, hi) < r32);
            lk[r] = valid ? -sp : 0.f; ls[r] = valid ? (z2 - sp) : -INFINITY; }
        float e[16], tq[4], pq[4];
#pragma unroll
        for (int g = 0; g < 4; ++g) { e[4 * g + 3] = 0.f; e[4 * g + 2] = lk[4 * g + 3]; e[4 * g + 1] = e[4 * g + 2] + lk[4 * g + 2]; e[4 * g] = e[4 * g + 1] + lk[4 * g + 1]; tq[g] = e[4 * g] + lk[4 * g]; }
#pragma unroll
        for (int g = 0; g < 4; ++g) pq[g] = x32_partner(tq[g], hi);
        float cs[4]; cs[3] = 0.f; cs[2] = tq[3] + pq[3]; cs[1] = cs[2] + (tq[2] + pq[2]); cs[0] = cs[1] + (tq[1] + pq[1]);
        const float total = cs[0] + (tq[0] + pq[0]);
#pragma unroll
        for (int g = 0; g < 4; ++g) { const float later = R + cs[g] + (hi == 0 ? pq[g] : 0.f);
#pragma unroll
            for (int i = 0; i < 4; ++i) s[4 * g + i] = ex2(ls[4 * g + i] + e[4 * g + i] + later); }
        R += total;
        const bf16x8 pf0 = pack8(s, 0), pf1 = pack8(s, 8);
        o0 = MFMA32(v00, pf0, o0); o0 = MFMA32(v01, pf1, o0); o1 = MFMA32(v10, pf0, o1); o1 = MFMA32(v11, pf1, o1);
    }
}

struct Params {
    const float* x; const float* mix_g; const float* w_in; const float* b_forget; const float* lq1; const float* lk1; const float* lq2; const float* lk2;
    const float* diff_g; const float* w_branch; const float* w_out; const float* mlp_g; const float* w_up; const float* w_down; const float* final_g;
    float* out; unsigned char* ws;
};

#define OPQ_TID() ({ int t_ = threadIdx.x; asm volatile("" : "+v"(t_)); t_; })
typedef const __attribute__((address_space(4))) Params* KParamsPtr;
#define OPQ_PP() ({ KParamsPtr p_ = (KParamsPtr)__builtin_amdgcn_kernarg_segment_ptr(); asm volatile("" : "+s"(p_)); p_; })
#define PHASE_VARS() const int tid = OPQ_TID(); const int lane = tid & 63, wave = __builtin_amdgcn_readfirstlane(tid >> 6); const int G = gridDim.x, bx = blockIdx.x; \
    const int gw = bx * NWAVES + wave, NGW = G * NWAVES; KParamsPtr PP = OPQ_PP(); unsigned char* ws = PP->ws; LAS float* scr = (LAS float*)(lds + wave * 16384); (void)lane; (void)gw; (void)NGW; (void)ws; (void)scr; (void)G; (void)bx; (void)PP

__global__ void __launch_bounds__(NWAVES * 64, 2) fwd_mega(Params P) {
    extern __shared__ __attribute__((aligned(16))) unsigned char lds_raw[];
    LAS unsigned char* lds = (LAS unsigned char*)lds_raw;
    cg::grid_group grid = cg::this_grid();

    {
        PHASE_VARS();
        float* X = PP->out; bf16_t* XB = (bf16_t*)(ws + WS_XB); float* SSQ = (float*)(ws + WS_SSQ);
        for (int row = gw; row < TOK; row += NGW) {
            const f32x4* xr = (const f32x4*)(PP->x + (size_t)row * DM) + lane; f32x4* xo = (f32x4*)(X + (size_t)row * DM) + lane;
            unsigned long long* o8 = (unsigned long long*)(XB + (size_t)row * DM) + lane;
            float s = 0.f;
#pragma unroll
            for (int j = 0; j < 4; ++j) { const f32x4 v = xr[64 * j]; xo[64 * j] = v; s += (v[0] * v[0] + v[1] * v[1]) + (v[2] * v[2] + v[3] * v[3]);
                o8[64 * j] = (unsigned long long)cvtpk(v[0], v[1]) | ((unsigned long long)cvtpk(v[2], v[3]) << 32); }
            s = wave_sum(s);
            if (lane < 16) SSQ[(size_t)row * 16 + lane] = (lane == 0) ? s : 0.f;
        }
    }

    for (int layer = 0; layer < DEPTH; ++layer) {
        {
            PHASE_VARS();
            bf16_t* WIN = (bf16_t*)(ws + WS_WIN); bf16_t* WB = (bf16_t*)(ws + WS_WB); bf16_t* WOUT = (bf16_t*)(ws + WS_WOUT);
            const float* w_in = PP->w_in + (size_t)layer * DM * DIN; const float* mg = PP->mix_g + (size_t)layer * DM;
            const float* wb = PP->w_branch + (size_t)layer * 4 * 256 * DM; const float* wo = PP->w_out + (size_t)layer * DM * DM;
            constexpr int I_IN = (DM / 64) * (NPROJ / 32), I_B = (256 / 64) * (DM / 32), I_O = (DM / 64) * (DM / 32);
            for (int it = gw; it < I_IN + 4 * I_B + I_O; it += NGW) {
                int r = it;
                if (r < I_IN) { transpose_item<1>(w_in, DM, NPROJ, DIN, mg, WIN, scr, r, lane); continue; } r -= I_IN;
                if (r < 4 * I_B) { const int n = r / I_B; transpose_item<0>(wb + (size_t)n * 256 * DM, 256, DM, DM, nullptr, WB + (size_t)n * DM * 256, scr, r % I_B, lane); continue; } r -= 4 * I_B;
                transpose_item<0>(wo, DM, DM, DM, nullptr, WOUT, scr, r, lane);
            }
        }
        grid.sync();

        for (int half = 0; half < 2; ++half) {
#ifndef NO_P1
            {
                PHASE_VARS();
                const int rb = half * HT;
                pg8::Gemm g{(const bf16_t*)(ws + WS_XB) + (size_t)rb * DM, (const bf16_t*)(ws + WS_WIN), DM, DM, DM, 0, 0};
                pg8::StaticOrder S; S.init(HT, NPROJ, G, bx);
                pg8::EpiProj E{(const float*)(ws + WS_SSQ), rb, (bf16_t*)(ws + WS_QK), (bf16_t*)(ws + WS_VT), (float*)(ws + WS_FL), (bf16_t*)(ws + WS_GATE)};
                pg8::gemm_phase<pg8::EpiProj, pg8::StaticOrder, true>(lds, g, S, E);
            }
#endif
            grid.sync();
#ifndef NO_P2
            {
                PHASE_VARS();
                const float lam_init = (layer == 0) ? 0.2f : 0.35550906759093115f;
                unsigned* ctr = (unsigned*)(ws + WS_CTL) + 64 * (1 + layer * 2 + half);
                const int r32 = lane & 31, hi = lane >> 5;
                float lam;
                { const float a = (lane < 32) ? PP->lq1[layer * 32 + lane] * PP->lk1[layer * 32 + lane] : 0.f, b = (lane < 32) ? PP->lq2[layer * 32 + lane] * PP->lk2[layer * 32 + lane] : 0.f;
                  lam = __expf(wave_sum(a)) - __expf(wave_sum(b)) + lam_init; }
                for (;;) {
                    int idx = 0; if (lane == 0) idx = (int)atomicAdd(ctr, 1u); idx = __builtin_amdgcn_readfirstlane(idx);
                    if (idx >= 6144) break;
                    KParamsPtr PU = OPQ_PP(); unsigned char* wsu = PU->ws;
                    bf16_t* YS = (bf16_t*)(wsu + WS_YS); bf16_t* DILO = (bf16_t*)(wsu + WS_DILO); float* LSE = (float*)(wsu + WS_LSE); const float* FL = (const float*)(wsu + WS_FL);
                    const bf16_t* QK = (const bf16_t*)(wsu + WS_QK); const bf16_t* VT = (const bf16_t*)(wsu + WS_VT);
                    if (idx < 3072) {
                        const int qb = 63 - idx / 48, rem = idx % 48, type = rem / 16, bh = rem % 16, b = bh >> 2, h = bh & 3;
                        const size_t rowb = (size_t)b * SEQ;
                        const int t = qb * 32 + r32;
                        if (type == 0) {
                            f32x16 o0, o1;
                            sb_unit(QK + rowb * LDQK + 0 * 256 + h * 64, QK + rowb * LDQK + 1 * 256 + h * 64, VT + ((size_t)(b * 24 + h) * 64) * SEQ, qb, o0, o1, lane);
                            store_o(YS + (rowb + t) * DM + 0 * 256 + h * 64, o0, o1, hi);
                        } else if (type == 1) {
                            const float slope = exp2f(-8.0f * (float)(5 + h) / 16.0f);
                            f32x16 r0, r1;
                            diff_unit(QK + rowb * LDQK + 10 * 256 + h * 64, QK + rowb * LDQK + 11 * 256 + h * 64, VT + ((size_t)(b * 24 + 20 + h) * 64) * SEQ, qb, slope * LOG2E, lam, r0, r1, lane);
                            float ss = 0.f;
#pragma unroll
                            for (int i = 0; i < 16; ++i) ss += r0[i] * r0[i] + r1[i] * r1[i];
                            ss = x32_sum(ss);
                            const float rn = __builtin_amdgcn_rsqf(ss * (1.0f / 64.0f) + RMS_EPS) * (1.0f - lam_init);
                            const float* dg = PP->diff_g + layer * 64;
#pragma unroll
                            for (int i = 0; i < 16; ++i) { const int d = crow(i, hi); r0[i] *= rn * dg[d]; r1[i] *= rn * dg[32 + d]; }
                            store_o(YS + (rowb + t) * DM + 3 * 256 + h * 64, r0, r1, hi);
                        } else {
                            LAS float* cl = scr;
                            const float bf = PP->b_forget[layer * 4 + h];
                            float run = 0.f;
                            if (lane <= qb) {
                                const float* fp = FL + (rowb + 32 * lane) * 4 + h;
#pragma unroll 8
                                for (int i = 0; i < 32; ++i) { const float y = fp[4 * i] + bf; const float lf = fminf(y, 0.f) - __logf(1.0f + __expf(-fabsf(y))); run += lf; cl[33 * lane + i] = run; }
                            }
                            float incl = run;
#pragma unroll
                            for (int o = 1; o < 64; o <<= 1) { const float tt = __uint_as_float((unsigned)__builtin_amdgcn_ds_bpermute((lane - o) << 2, (int)__float_as_uint(incl))); if (lane >= o) incl += tt; }
                            const float excl = incl - run;
                            if (lane <= qb) {
#pragma unroll 8
                                for (int i = 0; i < 32; ++i) cl[33 * lane + i] = -(cl[33 * lane + i] + excl) * LOG2E;
                            }
                            asm volatile("s_waitcnt lgkmcnt(0)" ::: "memory");
                            f32x16 o0, o1; float m, l;
                            sm_unit<0>(QK + rowb * LDQK + 8 * 256 + h * 64, QK + rowb * LDQK + 9 * 256 + h * 64, VT + ((size_t)(b * 24 + 16 + h) * 64) * SEQ, qb, 0, 0.f, cl, o0, o1, m, l, lane);
                            const float inv = 1.0f / l;
#pragma unroll
                            for (int i = 0; i < 16; ++i) { o0[i] *= inv; o1[i] *= inv; }
                            store_o(YS + (rowb + t) * DM + 2 * 256 + h * 64, o0, o1, hi);
                            asm volatile("s_waitcnt lgkmcnt(0)" ::: "memory");
                        }
                    } else {
                        const int i2 = idx - 3072, j = i2 & 63, gh = (i2 >> 6) % 12, b = i2 / 768, gI = gh >> 2, h = gh & 3;
                        const int rsh = 2 * gI, r = 1 << rsh, sl = SEQ >> rsh, nubsh = 6 - rsh, rho = j >> nubsh, ub = j & ((1 << nubsh) - 1);
                        const int sidx = (gI == 0) ? h : (gI == 1 ? 8 + h : 12 + h);
                        const float slope = exp2f(-8.0f * (float)(sidx + 1) / 16.0f);
                        const size_t rowb = (size_t)b * SEQ + (size_t)rho * sl;
                        f32x16 o0, o1; float m, l;
                        const int kb_lo = (ub - 4 > 0) ? ub - 4 : 0;
                        sm_unit<1>(QK + rowb * LDQK + (2 + gI) * 256 + h * 64, QK + rowb * LDQK + (5 + gI) * 256 + h * 64,
                                   VT + ((size_t)(b * 24 + 4 + 4 * gI + h) * 64) * SEQ + (size_t)rho * sl, ub, kb_lo, slope * (float)r * LOG2E, nullptr, o0, o1, m, l, lane);
                        const float inv = 1.0f / l;
#pragma unroll
                        for (int i = 0; i < 16; ++i) { o0[i] *= inv; o1[i] *= inv; }
                        const int u = ub * 32 + r32; const size_t tok = (size_t)b * SEQ + (size_t)u * r + rho;
                        store_o(DILO + tok * 768 + gI * 256 + h * 64, o0, o1, hi);
                        if (hi == 0) LSE[tok * 12 + gI * 4 + h] = (m + lg2(l)) * LN2;
                    }
                }
            }
#endif
            grid.sync();
            {
                PHASE_VARS();
                bf16_t* YS = (bf16_t*)(ws + WS_YS); const bf16_t* DILO = (const bf16_t*)(ws + WS_DILO); const float* LSE = (const float*)(ws + WS_LSE);
                for (int row = gw; row < HT; row += NGW) {
                    const int h = lane >> 4;
                    const float l0 = LSE[(size_t)row * 12 + h], l1 = LSE[(size_t)row * 12 + 4 + h], l2 = LSE[(size_t)row * 12 + 8 + h];
                    const float mx = fmaxf(l0, fmaxf(l1, l2)); const float e0 = __expf(l0 - mx), e1 = __expf(l1 - mx), e2 = __expf(l2 - mx); const float inv = 1.0f / (e0 + e1 + e2);
                    const u32x2 a = *(const u32x2*)(DILO + (size_t)row * 768 + 4 * lane), b = *(const u32x2*)(DILO + (size_t)row * 768 + 256 + 4 * lane), c = *(const u32x2*)(DILO + (size_t)row * 768 + 512 + 4 * lane);
                    const float w0 = e0 * inv, w1 = e1 * inv, w2 = e2 * inv;
                    u32x2 o; o.x = cvtpk(w0 * bflo(a.x) + w1 * bflo(b.x) + w2 * bflo(c.x), w0 * bfhi(a.x) + w1 * bfhi(b.x) + w2 * bfhi(c.x));
                    o.y = cvtpk(w0 * bflo(a.y) + w1 * bflo(b.y) + w2 * bflo(c.y), w0 * bfhi(a.y) + w1 * bfhi(b.y) + w2 * bfhi(c.y));
                    *(u32x2*)(YS + (size_t)row * DM + 256 + 4 * lane) = o;
                }
            }
            grid.sync();
#ifndef NO_P3
            {
                PHASE_VARS();
                pg8::Gemm g{(const bf16_t*)(ws + WS_YS), (const bf16_t*)(ws + WS_WB), DM, 256, 256, 256 * 2, (long)DM * 256 * 2};
                pg8::BranchOrder S{bx};
                pg8::EpiBranch E{(const bf16_t*)(ws + WS_GATE), (bf16_t*)(ws + WS_MERGED), half * HT};
                pg8::gemm_phase<pg8::EpiBranch, pg8::BranchOrder, false>(lds, g, S, E);
            }
#endif
            grid.sync();
        }
#ifndef NO_P4
        {
            PHASE_VARS();
            bf16_t* WUP = (bf16_t*)(ws + WS_WUP); bf16_t* WDN = (bf16_t*)(ws + WS_WDN);
            const float* wu = PP->w_up + (size_t)layer * DM * DFF; const float* wd = PP->w_down + (size_t)layer * DFF * DM; const float* mg = PP->mlp_g + (size_t)layer * DM;
            constexpr int I_U = (DM / 64) * (DFF / 32), I_D = (DFF / 64) * (DM / 32);
            for (int it = gw; it < I_U + I_D; it += NGW) {
                if (it < I_U) transpose_item<0>(wu, DM, DFF, DFF, mg, WUP, scr, it, lane);
                else transpose_item<0>(wd, DFF, DM, DM, nullptr, WDN, scr, it - I_U, lane);
            }
            __syncthreads();
        }
        {
            PHASE_VARS();
            pg8::Gemm g{(const bf16_t*)(ws + WS_MERGED), (const bf16_t*)(ws + WS_WOUT), DM, DM, DM, 0, 0};
            pg8::StaticOrder S; S.init(TOK, DM, G, bx);
            pg8::EpiResid E{PP->out, (bf16_t*)(ws + WS_XB), (float*)(ws + WS_SSQ)};
            pg8::gemm_phase<pg8::EpiResid, pg8::StaticOrder, false>(lds, g, S, E);
        }
#endif
        grid.sync();
#ifndef NO_P5
        {
            PHASE_VARS();
            pg8::Gemm g{(const bf16_t*)(ws + WS_XB), (const bf16_t*)(ws + WS_WUP), DM, DM, DM, 0, 0};
            pg8::StaticOrder S; S.init(TOK, DFF, G, bx);
            pg8::EpiUp E{(const float*)(ws + WS_SSQ), (bf16_t*)(ws + WS_HMLP)};
            pg8::gemm_phase<pg8::EpiUp, pg8::StaticOrder, true>(lds, g, S, E);
        }
#endif
        grid.sync();
#ifndef NO_P6
        {
            PHASE_VARS();
            pg8::Gemm g{(const bf16_t*)(ws + WS_HMLP), (const bf16_t*)(ws + WS_WDN), DFF, DFF, DFF, 0, 0};
            pg8::StaticOrder S; S.init(TOK, DM, G, bx);
            pg8::EpiResid E{PP->out, (bf16_t*)(ws + WS_XB), (float*)(ws + WS_SSQ)};
            pg8::gemm_phase<pg8::EpiResid, pg8::StaticOrder, false>(lds, g, S, E);
        }
#endif
        grid.sync();
    }
    {
        PHASE_VARS();
        float* X = PP->out;
        for (int row = gw; row < TOK; row += NGW) {
            f32x4* xo = (f32x4*)(X + (size_t)row * DM) + lane; const f32x4* gp = (const f32x4*)PP->final_g + lane;
            f32x4 v[4]; float s = 0.f;
#pragma unroll
            for (int j = 0; j < 4; ++j) { v[j] = xo[64 * j]; s += (v[j][0] * v[j][0] + v[j][1] * v[j][1]) + (v[j][2] * v[j][2] + v[j][3] * v[j][3]); }
            const float rstd = __builtin_amdgcn_rsqf(wave_sum(s) * (1.0f / DM) + RMS_EPS);
#pragma unroll
            for (int j = 0; j < 4; ++j) xo[64 * j] = v[j] * rstd * gp[64 * j];
        }
    }
}

extern "C" void kernel_launch(void* const* d_in, const int* in_sizes, int n_in, void* d_out, int out_size, void* d_ws, size_t ws_size, hipStream_t stream) {
    static int grid = 0;
    if (grid == 0) {
        if (n_in != 15 || in_sizes[0] != TOK * DM || out_size != TOK * DM || ws_size < WS_END) { fprintf(stderr, "kernel_launch: unexpected shapes / workspace (n_in %d, ws %zu)\n", n_in, ws_size); grid = -1; return; }
        int dev = 0, cus = 0, per_cu = 0;
        hipGetDevice(&dev); hipDeviceGetAttribute(&cus, hipDeviceAttributeMultiprocessorCount, dev);
        hipFuncSetAttribute((const void*)fwd_mega, hipFuncAttributeMaxDynamicSharedMemorySize, LDS_BYTES);
        hipOccupancyMaxActiveBlocksPerMultiprocessor(&per_cu, (const void*)fwd_mega, NWAVES * 64, LDS_BYTES);
        (void)hipGetLastError();
        if (per_cu < 1) per_cu = 1;
        grid = cus;
        if (grid > 256) grid = 256;
    }
    if (grid < 0) return;
    hipMemsetAsync((char*)d_ws + WS_CTL, 0, CTL_BYTES, stream);
    Params p{};
    p.x = (const float*)d_in[0]; p.mix_g = (const float*)d_in[1]; p.w_in = (const float*)d_in[2]; p.b_forget = (const float*)d_in[3];
    p.lq1 = (const float*)d_in[4]; p.lk1 = (const float*)d_in[5]; p.lq2 = (const float*)d_in[6]; p.lk2 = (const float*)d_in[7];
    p.diff_g = (const float*)d_in[8]; p.w_branch = (const float*)d_in[9]; p.w_out = (const float*)d_in[10]; p.mlp_g = (const float*)d_in[11];
    p.w_up = (const float*)d_in[12]; p.w_down = (const float*)d_in[13]; p.final_g = (const float*)d_in[14];
    p.out = (float*)d_out; p.ws = (unsigned char*)d_ws;
    void* args[] = {&p};
    hipError_t e = hipLaunchCooperativeKernel((const void*)fwd_mega, dim3(grid), dim3(NWAVES * 64), args, LDS_BYTES, stream);
    if (e != hipSuccess) fprintf(stderr, "cooperative launch failed: %s (grid %d)\n", hipGetErrorString(e), grid);
}
```

```cpp
#include <hip/hip_runtime.h>
#include <hip/hip_cooperative_groups.h>
#include <cstdio>
#include <cstdint>
namespace cg = cooperative_groups;

#define LAS __attribute__((address_space(3)))
typedef unsigned short bf16_t;
typedef short bf16x8 __attribute__((ext_vector_type(8)));
typedef float f32x4 __attribute__((ext_vector_type(4)));
typedef float f32x16 __attribute__((ext_vector_type(16)));
typedef unsigned u32x4 __attribute__((ext_vector_type(4)));
typedef unsigned u32x2 __attribute__((ext_vector_type(2)));
typedef float f32x2_t __attribute__((ext_vector_type(2)));
typedef __bf16 bf16x2_t __attribute__((ext_vector_type(2)));

constexpr int DM = 1024, BATCH = 8, SEQ = 2048, DEPTH = 2, TOK = BATCH * SEQ, DFF = 4096, DIN = 8708;
constexpr int HT = TOK / 2;
constexpr int NPROJ = 35 * 256;
constexpr int LDQK = 12 * 256;
constexpr float LOG2E = 1.4426950408889634f, LN2 = 0.6931471805599453f;
constexpr float RMS_EPS = 1e-6f;

constexpr size_t MiB = 1u << 20;
constexpr size_t WS_CTL = 0, CTL_BYTES = 65536;
constexpr int CW_BAR = 4096;
constexpr size_t WS_SSQ = 1 * MiB;
constexpr size_t WS_WIN = 2 * MiB;
constexpr size_t WS_WUP = WS_WIN, WS_WDN = WS_WIN + 8 * MiB;
constexpr size_t WS_WB = 20 * MiB;
constexpr size_t WS_WOUT = 22 * MiB;
constexpr size_t WS_XB = 24 * MiB;
constexpr size_t WS_MERGED = 56 * MiB;
constexpr size_t WS_YS = 88 * MiB;
constexpr size_t WS_DILO = 104 * MiB;
constexpr size_t WS_LSE = 116 * MiB;
constexpr size_t WS_FL = 117 * MiB;
constexpr size_t WS_QK = 118 * MiB;
constexpr size_t WS_VT = 166 * MiB;
constexpr size_t WS_GATE = 190 * MiB;
constexpr size_t WS_HMLP = 118 * MiB;
constexpr size_t WS_END = 254 * MiB;

constexpr int LDS_BYTES = 147456;
constexpr int NWAVES = 8;

__device__ __forceinline__ unsigned cvtpk(float lo, float hi) { f32x2_t v = {lo, hi}; bf16x2_t b = __builtin_convertvector(v, bf16x2_t); return __builtin_bit_cast(unsigned, b); }
__device__ __forceinline__ float bflo(unsigned w) { return __uint_as_float(w << 16); }
__device__ __forceinline__ float bfhi(unsigned w) { return __uint_as_float(w & 0xffff0000u); }
__device__ __forceinline__ float ex2(float x) { return __builtin_amdgcn_exp2f(x); }
__device__ __forceinline__ float lg2(float x) { return __builtin_amdgcn_logf(x); }
__device__ __forceinline__ float x32_sum(float v) { auto r = __builtin_amdgcn_permlane32_swap(__float_as_uint(v), __float_as_uint(v), false, false); return __uint_as_float(r[0]) + __uint_as_float(r[1]); }
__device__ __forceinline__ float x32_max(float v) { auto r = __builtin_amdgcn_permlane32_swap(__float_as_uint(v), __float_as_uint(v), false, false); return fmaxf(__uint_as_float(r[0]), __uint_as_float(r[1])); }
__device__ __forceinline__ float x32_partner(float v, int hi) { auto r = __builtin_amdgcn_permlane32_swap(__float_as_uint(v), __float_as_uint(v), false, false); return hi ? __uint_as_float(r[0]) : __uint_as_float(r[1]); }
template <int X> __device__ __forceinline__ float swz_xor(float v) { return __uint_as_float((unsigned)__builtin_amdgcn_ds_swizzle((int)__float_as_uint(v), (X << 10) | 0x1f)); }
__device__ __forceinline__ float x16_sum(float v) { return v + swz_xor<16>(v); }
__device__ __forceinline__ float wave_sum(float v) { v += swz_xor<1>(v); v += swz_xor<2>(v); v += swz_xor<4>(v); v += swz_xor<8>(v); v += swz_xor<16>(v); return x32_sum(v); }

namespace pg8 {
constexpr int BM = 256, BK = 64, HALF = 128, HTB = HALF * BK * 2, STAGE_BYTES = 8 * HTB, NXCD = 8, WGM = 8;
__host__ __device__ __forceinline__ int lds_byte(int r, int c) { const int st = (r >> 4) * 2 + (c >> 5), rr = r & 15, cc = c & 31, ob = rr * 64 + cc * 2; return st * 1024 + (ob ^ (((ob >> 9) & 1) << 5)); }
__host__ __device__ __forceinline__ void stage_rc(int b, int& R, int& C) { const int st = b / 1024, sb = b % 1024, swz = sb ^ (((sb >> 9) & 1) << 5); R = (st >> 1) * 16 + swz / 64; C = (st & 1) * 32 + (swz % 64) / 2; }
__host__ __device__ __forceinline__ int perm32(int rho) { const int n = rho >> 4, i = rho & 15; return 8 * (i >> 2) + 4 * n + (i & 3); }

struct Unit { int pm, pn, aux; };
struct Gemm { const bf16_t* A; const bf16_t* Bt; int lda, ldb, K; long a_aux, b_aux; };

struct StaticOrder {
    int nM, nN, nwg, G, c;
    __device__ void init(int M, int N, int G_, int c_) { nM = M / BM; nN = N / BM; nwg = nM * nN; G = G_; c = c_; }
    __device__ bool next(int i, Unit& u) const {
        const long L = (long)i * G + c; if (L >= nwg) return false;
        int wgid = (int)L; { const int q = nwg / NXCD, r = nwg % NXCD, xcd = wgid % NXCD, off = wgid / NXCD; wgid = (xcd < r ? xcd * (q + 1) : r * (q + 1) + (xcd - r) * q) + off; }
        const int nig = WGM * nN, gid = wgid / nig, fm = gid * WGM, gsz = (nM - fm) < WGM ? (nM - fm) : WGM;
        u.pm = fm + ((wgid % nig) % gsz); u.pn = (wgid % nig) / gsz; u.aux = 0; return true;
    }
};
struct BranchOrder {
    int c;
    __device__ bool next(int i, Unit& u) const { if (c >= 128 || i >= 4) return false; u.pm = c >> 2; u.pn = c & 3; u.aux = i; return true; }
};

template <class Epi, class Sched, bool ALIGN_EPI>
__device__ __forceinline__ void gemm_phase(LAS unsigned char* lds, const Gemm g, const Sched& S, const Epi& E) {
    int tid_ = threadIdx.x; asm volatile("" : "+v"(tid_));
    const int tid = tid_, wid = __builtin_amdgcn_readfirstlane(tid >> 6), lane = tid & 63, wr = wid >> 2, wc = wid & 3, fr = lane & 15, fq = lane >> 4;
    int nt_ = g.K / BK; asm volatile("" : "+s"(nt_)); const int nt = nt_;
    unsigned voffA[2], voffB[2];
#pragma unroll
    for (int i = 0; i < 2; ++i) { int R, C; stage_rc(tid * 16 + i * 8192, R, C); const int Rb = Epi::PERM ? ((R & ~31) + perm32(R & 31)) : R;
        voffA[i] = (unsigned)(R * g.lda + C) * 2u; voffB[i] = (unsigned)(Rb * g.ldb + C) * 2u; }
    const size_t kstep = (size_t)(BK * 2);
    const size_t hstepA = (size_t)HALF * g.lda * 2, hstepB = (size_t)HALF * g.ldb * 2;
    const size_t tstepA = 2 * hstepA, tstepB = 2 * hstepB;
    const unsigned ldsw = (unsigned)wid * 1024u;
    const int aoff = lds_byte(wr * 64 + fr, fq * 8), boff = lds_byte(wc * 32 + fr, fq * 8);
#define PG8_SA(b, h) (((b) * 2 + (h)) * HTB)
#define PG8_SB(b, h) ((4 + (b) * 2 + (h)) * HTB)
#define PG8_STAGE(bufoff, gbase, voff) do { _Pragma("unroll") for (int _i = 0; _i < 2; ++_i) \
        __builtin_amdgcn_global_load_lds((const unsigned*)((const char*)(gbase) + (voff)[_i]), (LAS unsigned*)(lds + (bufoff) + ldsw + _i * 8192), 16, 0, 0); } while (0)
#define PG8_LDA(dst, b, h) do { _Pragma("unroll") for (int m = 0; m < 4; ++m) _Pragma("unroll") for (int k = 0; k < 2; ++k) dst[m][k] = *(const LAS bf16x8*)(lds + PG8_SA(b, h) + aoff + m * 2048 + k * 1024); } while (0)
#define PG8_LDB(dst, b, h) do { _Pragma("unroll") for (int n = 0; n < 2; ++n) _Pragma("unroll") for (int k = 0; k < 2; ++k) dst[n][k] = *(const LAS bf16x8*)(lds + PG8_SB(b, h) + boff + n * 2048 + k * 1024); } while (0)
#define PG8_MMA(ai, bj, At, Bt) do { __builtin_amdgcn_s_setprio(1); _Pragma("unroll") for (int m = 0; m < 4; ++m) _Pragma("unroll") for (int n = 0; n < 2; ++n) _Pragma("unroll") for (int k = 0; k < 2; ++k) \
        acc[ai][bj][m][n] = __builtin_amdgcn_mfma_f32_16x16x32_bf16(Bt[n][k], At[m][k], acc[ai][bj][m][n], 0, 0, 0); __builtin_amdgcn_s_setprio(0); } while (0)
#define PG8_WAIT_V(n) asm volatile("s_waitcnt vmcnt(" #n ")" ::: "memory")
#define PG8_WAIT_L(n) asm volatile("s_waitcnt lgkmcnt(" #n ")" ::: "memory")
#define PG8_BAR __builtin_amdgcn_s_barrier()
#define PG8_SCHED __builtin_amdgcn_sched_barrier(0)
#define PG8_UA(u) ((const char*)g.A + (size_t)(u).pm * tstepA + (size_t)(u).aux * (size_t)g.a_aux)
#define PG8_UB(u) ((const char*)g.Bt + (size_t)(u).pn * tstepB + (size_t)(u).aux * (size_t)g.b_aux)
    Unit cur, nxt; int ui = 0;
    if (!S.next(0, cur)) return;
    f32x4 acc[2][2][4][2];
#pragma unroll
    for (int a = 0; a < 2; ++a)
#pragma unroll
        for (int b = 0; b < 2; ++b)
#pragma unroll
            for (int m = 0; m < 4; ++m)
#pragma unroll
                for (int n = 0; n < 2; ++n) acc[a][b][m][n] = (f32x4){0.f, 0.f, 0.f, 0.f};
    bf16x8 At[4][2], B0[2][2], B1[2][2];
    const char* cA = PG8_UA(cur); const char* cB = PG8_UB(cur);
    PG8_STAGE(PG8_SB(0, 0), cB, voffB); PG8_STAGE(PG8_SB(0, 1), cB + hstepB, voffB); PG8_STAGE(PG8_SA(0, 0), cA, voffA); PG8_STAGE(PG8_SA(0, 1), cA + hstepA, voffA);
    if (wr == 1) PG8_BAR;
    PG8_WAIT_V(2); PG8_BAR;
    PG8_STAGE(PG8_SB(1, 0), cB + kstep, voffB); PG8_STAGE(PG8_SA(1, 0), cA + kstep, voffA); PG8_STAGE(PG8_SB(1, 1), cB + hstepB + kstep, voffB);
    PG8_WAIT_V(6); PG8_BAR;
    for (;;) {
        const bool has_next = S.next(ui + 1, nxt);
        const char* nA = has_next ? PG8_UA(nxt) : cA; const char* nB = has_next ? PG8_UB(nxt) : cB;
        for (int t = 0; t < nt; t += 2) {
            const bool last = (t == nt - 2);
            const char* a1 = cA + (size_t)(t + 1) * kstep;
            const char* a2 = last ? nA : cA + (size_t)(t + 2) * kstep; const char* b2 = last ? nB : cB + (size_t)(t + 2) * kstep;
            const char* a3 = a2 + kstep; const char* b3 = b2 + kstep;
            PG8_LDB(B0, 0, 0); PG8_LDB(B1, 0, 1); PG8_SCHED; PG8_LDA(At, 0, 0); PG8_STAGE(PG8_SA(1, 1), a1 + hstepA, voffA);
            PG8_WAIT_V(8); PG8_WAIT_L(0); PG8_BAR; PG8_MMA(0, 0, At, B0); PG8_MMA(0, 1, At, B1); PG8_BAR; PG8_SCHED;
            PG8_LDA(At, 0, 1); PG8_STAGE(PG8_SB(0, 0), b2, voffB); PG8_STAGE(PG8_SB(0, 1), b2 + hstepB, voffB); PG8_STAGE(PG8_SA(0, 0), a2, voffA);
            PG8_WAIT_V(8); PG8_WAIT_L(0); PG8_BAR; PG8_MMA(1, 0, At, B0); PG8_MMA(1, 1, At, B1); PG8_BAR; PG8_SCHED;
            PG8_LDB(B0, 1, 0); PG8_LDB(B1, 1, 1); PG8_SCHED; PG8_LDA(At, 1, 0); PG8_STAGE(PG8_SA(0, 1), a2 + hstepA, voffA);
            PG8_WAIT_V(8); PG8_WAIT_L(0); PG8_BAR; PG8_MMA(0, 0, At, B0); PG8_MMA(0, 1, At, B1); PG8_BAR; PG8_SCHED;
            PG8_LDA(At, 1, 1); PG8_STAGE(PG8_SB(1, 0), b3, voffB); PG8_STAGE(PG8_SB(1, 1), b3 + hstepB, voffB); PG8_STAGE(PG8_SA(1, 0), a3, voffA);
            PG8_WAIT_V(8); PG8_WAIT_L(0); PG8_BAR; PG8_MMA(1, 0, At, B0); PG8_MMA(1, 1, At, B1); PG8_BAR; PG8_SCHED;
        }
        if constexpr (ALIGN_EPI) { if (wr == 0) PG8_BAR; }
        { Unit eu = cur; asm volatile("" : "+s"(eu.pm), "+s"(eu.pn), "+s"(eu.aux)); E(acc, eu, wr, wc, fr, fq); }
        if (!has_next) break;
#pragma unroll
        for (int a = 0; a < 2; ++a)
#pragma unroll
            for (int b = 0; b < 2; ++b)
#pragma unroll
                for (int m = 0; m < 4; ++m)
#pragma unroll
                    for (int n = 0; n < 2; ++n) acc[a][b][m][n] = (f32x4){0.f, 0.f, 0.f, 0.f};
        cur = nxt; cA = nA; cB = nB; ++ui;
        if constexpr (ALIGN_EPI) { if (wr == 1) PG8_BAR; }
    }
    PG8_WAIT_V(0);
    if constexpr (!ALIGN_EPI) { if (wr == 0) PG8_BAR; }
    PG8_BAR;
#undef PG8_SA
#undef PG8_SB
#undef PG8_STAGE
#undef PG8_LDA
#undef PG8_LDB
#undef PG8_MMA
#undef PG8_WAIT_V
#undef PG8_WAIT_L
#undef PG8_BAR
#undef PG8_SCHED
#undef PG8_UA
#undef PG8_UB
}

__device__ __forceinline__ float row_rstd(const float* ssq, int row, int fq) {
    const f32x4 a = *(const f32x4*)(ssq + (size_t)row * 16 + 4 * fq);
    float s = (a[0] + a[1]) + (a[2] + a[3]);
    s = x16_sum(s); s = x32_sum(s);
    return __builtin_amdgcn_rsqf(s * (1.0f / DM) + RMS_EPS);
}
__device__ __forceinline__ int pos16(int o) { return 8 * ((o >> 2) & 1) + 4 * (o >> 3) + (o & 3); }

struct EpiProj {
    static constexpr bool PERM = true;
    const float* ssq; int row_base; bf16_t* QK; bf16_t* VT; float* FL; bf16_t* GATE;
    __device__ __forceinline__ void operator()(const f32x4 (&acc)[2][2][4][2], const Unit& u, int wr, int wc, int fr, int fq) const {
        const int pn = u.pn;
        const int lrow0 = u.pm * BM + wr * 64 + fr;
        float rs[2][4];
#pragma unroll
        for (int ai = 0; ai < 2; ++ai)
#pragma unroll
            for (int m = 0; m < 4; ++m) rs[ai][m] = row_rstd(ssq, row_base + lrow0 + ai * HALF + m * 16, fq);
        const int cin = wc * 32 + 8 * fq;
        if (pn >= 19) {
#pragma unroll
            for (int ai = 0; ai < 2; ++ai)
#pragma unroll
                for (int m = 0; m < 4; ++m) { const int lrow = lrow0 + ai * HALF + m * 16; const float s = rs[ai][m];
#pragma unroll
                    for (int bj = 0; bj < 2; ++bj) { const f32x4 v0 = acc[ai][bj][m][0] * s, v1 = acc[ai][bj][m][1] * s;
                        u32x4 w; w.x = cvtpk(v0[0], v0[1]); w.y = cvtpk(v0[2], v0[3]); w.z = cvtpk(v1[0], v1[1]); w.w = cvtpk(v1[2], v1[3]);
                        *(u32x4*)(GATE + (size_t)lrow * 4096 + (pn - 19) * 256 + bj * HALF + cin) = w; } }
        } else if (pn == 18) {
            if (wc == 0 && fq == 0) {
#pragma unroll
                for (int ai = 0; ai < 2; ++ai)
#pragma unroll
                    for (int m = 0; m < 4; ++m) { const int lrow = lrow0 + ai * HALF + m * 16; *(f32x4*)(FL + (size_t)lrow * 4) = acc[ai][0][m][0] * rs[ai][m]; }
            }
        } else if (pn == 2 || (pn >= 9 && pn <= 11) || pn == 14 || pn == 17) {
            int vhb, rsh;
            if (pn == 2) { vhb = 0; rsh = 0; } else if (pn == 14) { vhb = 16; rsh = 0; } else if (pn == 17) { vhb = 20; rsh = 0; } else { const int gI = pn - 9; vhb = 4 + 4 * gI; rsh = 2 * gI; }
            const int slsh = 11 - rsh, rmask = (1 << rsh) - 1;
#pragma unroll
            for (int ai = 0; ai < 2; ++ai)
#pragma unroll
                for (int m = 0; m < 4; ++m) { const int lrow = lrow0 + ai * HALF + m * 16; const float s = rs[ai][m];
                    const int bl = lrow >> 11, t = lrow & (SEQ - 1); int p = ((t & rmask) << slsh) + (t >> rsh); p = (p & ~15) | pos16(p & 15);
                    bf16_t* base = VT + (size_t)bl * 24 * 64 * SEQ + p;
#pragma unroll
                    for (int bj = 0; bj < 2; ++bj) { const int c0 = bj * HALF + cin; bf16_t* bp = base + (size_t)(vhb * 64 + c0) * SEQ;
                        const f32x4 v0 = acc[ai][bj][m][0] * s, v1 = acc[ai][bj][m][1] * s;
                        const unsigned w0 = cvtpk(v0[0], v0[1]), w1 = cvtpk(v0[2], v0[3]), w2 = cvtpk(v1[0], v1[1]), w3 = cvtpk(v1[2], v1[3]);
                        bp[0 * SEQ] = (bf16_t)(w0 & 0xffff); bp[1 * SEQ] = (bf16_t)(w0 >> 16); bp[2 * SEQ] = (bf16_t)(w1 & 0xffff); bp[3 * SEQ] = (bf16_t)(w1 >> 16);
                        bp[4 * SEQ] = (bf16_t)(w2 & 0xffff); bp[5 * SEQ] = (bf16_t)(w2 >> 16); bp[6 * SEQ] = (bf16_t)(w3 & 0xffff); bp[7 * SEQ] = (bf16_t)(w3 >> 16); } }
        } else {
            int slot, rsh = 0;
            if (pn <= 1) slot = pn; else if (pn <= 8) { slot = pn - 1; const int gI = (pn - 3) % 3; rsh = 2 * gI; } else if (pn <= 13) slot = pn - 4; else slot = pn - 5;
            const int slsh = 11 - rsh, rmask = (1 << rsh) - 1;
#pragma unroll
            for (int ai = 0; ai < 2; ++ai)
#pragma unroll
                for (int m = 0; m < 4; ++m) { const int lrow = lrow0 + ai * HALF + m * 16; const float s = rs[ai][m];
                    const int bl = lrow >> 11, t = lrow & (SEQ - 1); const int prow = bl * SEQ + ((t & rmask) << slsh) + (t >> rsh);
#pragma unroll
                    for (int bj = 0; bj < 2; ++bj) { const f32x4 v0 = acc[ai][bj][m][0] * s, v1 = acc[ai][bj][m][1] * s;
                        u32x4 w; w.x = cvtpk(v0[0], v0[1]); w.y = cvtpk(v0[2], v0[3]); w.z = cvtpk(v1[0], v1[1]); w.w = cvtpk(v1[2], v1[3]);
                        *(u32x4*)(QK + (size_t)prow * LDQK + slot * 256 + bj * HALF + cin) = w; } }
        }
    }
};

struct EpiBranch {
    static constexpr bool PERM = true;
    const bf16_t* GATE; bf16_t* MERGED; int row_base;
    __device__ __forceinline__ static float sg(float g) { return __builtin_amdgcn_rcpf(1.0f + ex2(-g * LOG2E)); }
    __device__ __forceinline__ static u32x4 mix(const u32x4 gw, const u32x4 ow, const f32x4 v0, const f32x4 v1) {
        const float o0 = sg(bflo(gw.x)) * v0[0] + bflo(ow.x), o1 = sg(bfhi(gw.x)) * v0[1] + bfhi(ow.x), o2 = sg(bflo(gw.y)) * v0[2] + bflo(ow.y), o3 = sg(bfhi(gw.y)) * v0[3] + bfhi(ow.y);
        const float o4 = sg(bflo(gw.z)) * v1[0] + bflo(ow.z), o5 = sg(bfhi(gw.z)) * v1[1] + bfhi(ow.z), o6 = sg(bflo(gw.w)) * v1[2] + bflo(ow.w), o7 = sg(bfhi(gw.w)) * v1[3] + bfhi(ow.w);
        u32x4 w; w.x = cvtpk(o0, o1); w.y = cvtpk(o2, o3); w.z = cvtpk(o4, o5); w.w = cvtpk(o6, o7); return w;
    }
    __device__ __forceinline__ void operator()(const f32x4 (&acc)[2][2][4][2], const Unit& u, int wr, int wc, int fr, int fq) const {
        const int n = u.aux; const int lrow0 = u.pm * BM + wr * 64 + fr; const int col0 = u.pn * BM + wc * 32 + 8 * fq;
        const bf16_t* gbase = GATE + (size_t)lrow0 * 4096 + n * 1024 + col0; bf16_t* mbase = MERGED + (size_t)(row_base + lrow0) * DM + col0;
        const u32x4 zero = {0u, 0u, 0u, 0u};
#pragma unroll
        for (int ai = 0; ai < 2; ++ai)
#pragma unroll
            for (int mp = 0; mp < 2; ++mp) {
                u32x4 gw[2][2], ow[2][2];
#pragma unroll
                for (int mm = 0; mm < 2; ++mm)
#pragma unroll
                    for (int bj = 0; bj < 2; ++bj) { const size_t ro = (size_t)(ai * HALF + (2 * mp + mm) * 16);
                        gw[mm][bj] = *(const u32x4*)(gbase + ro * 4096 + bj * HALF);
                        ow[mm][bj] = zero; if (n > 0) ow[mm][bj] = *(const u32x4*)(mbase + ro * DM + bj * HALF); }
#pragma unroll
                for (int mm = 0; mm < 2; ++mm)
#pragma unroll
                    for (int bj = 0; bj < 2; ++bj) { const int m = 2 * mp + mm; const size_t ro = (size_t)(ai * HALF + m * 16);
                        *(u32x4*)(mbase + ro * DM + bj * HALF) = mix(gw[mm][bj], ow[mm][bj], acc[ai][bj][m][0], acc[ai][bj][m][1]); }
                asm volatile("" ::: "memory");
            }
    }
};

struct EpiResid {
    static constexpr bool PERM = true;
    float* X; bf16_t* XB; float* ssq;
    __device__ __forceinline__ void operator()(const f32x4 (&acc)[2][2][4][2], const Unit& u, int wr, int wc, int fr, int fq) const {
        const int row0 = u.pm * BM + wr * 64 + fr; const int col0 = u.pn * BM + wc * 32 + 8 * fq;
#pragma unroll
        for (int ai = 0; ai < 2; ++ai)
#pragma unroll
            for (int m = 0; m < 4; ++m) { const int row = row0 + ai * HALF + m * 16; float sq = 0.f;
#pragma unroll
                for (int bj = 0; bj < 2; ++bj) { const int col = col0 + bj * HALF; f32x4* xp = (f32x4*)(X + (size_t)row * DM + col);
                    const f32x4 x0 = xp[0] + acc[ai][bj][m][0], x1 = xp[1] + acc[ai][bj][m][1];
                    xp[0] = x0; xp[1] = x1;
                    u32x4 w; w.x = cvtpk(x0[0], x0[1]); w.y = cvtpk(x0[2], x0[3]); w.z = cvtpk(x1[0], x1[1]); w.w = cvtpk(x1[2], x1[3]);
                    *(u32x4*)(XB + (size_t)row * DM + col) = w;
                    sq += (x0[0] * x0[0] + x0[1] * x0[1]) + (x0[2] * x0[2] + x0[3] * x0[3]) + (x1[0] * x1[0] + x1[1] * x1[1]) + (x1[2] * x1[2] + x1[3] * x1[3]); }
                sq = x16_sum(sq); sq = x32_sum(sq);
                if (fq == 0) ssq[(size_t)row * 16 + u.pn * 4 + wc] = sq; if (m & 1) asm volatile("" ::: "memory"); }
    }
};

struct EpiUp {
    static constexpr bool PERM = true;
    const float* ssq; bf16_t* H;
    __device__ __forceinline__ void operator()(const f32x4 (&acc)[2][2][4][2], const Unit& u, int wr, int wc, int fr, int fq) const {
        const int row0 = u.pm * BM + wr * 64 + fr; const int col0 = u.pn * BM + wc * 32 + 8 * fq;
        float rs[2][4];
#pragma unroll
        for (int ai = 0; ai < 2; ++ai)
#pragma unroll
            for (int m = 0; m < 4; ++m) rs[ai][m] = row_rstd(ssq, row0 + ai * HALF + m * 16, fq);
#pragma unroll
        for (int ai = 0; ai < 2; ++ai)
#pragma unroll
            for (int m = 0; m < 4; ++m) { const int row = row0 + ai * HALF + m * 16; const float s = rs[ai][m];
#pragma unroll
                for (int bj = 0; bj < 2; ++bj) { f32x4 v0 = acc[ai][bj][m][0] * s, v1 = acc[ai][bj][m][1] * s;
#pragma unroll
                    for (int i = 0; i < 4; ++i) { const float a = fmaxf(v0[i], 0.f), b = fmaxf(v1[i], 0.f); v0[i] = a * a; v1[i] = b * b; }
                    u32x4 w; w.x = cvtpk(v0[0], v0[1]); w.y = cvtpk(v0[2], v0[3]); w.z = cvtpk(v1[0], v1[1]); w.w = cvtpk(v1[2], v1[3]);
                    *(u32x4*)(H + (size_t)row * DFF + col0 + bj * HALF) = w; } }
    }
};
}

__device__ __forceinline__ int win_src(int n) {
    if (n < 3840) return n;
    if (n < 4608) return n + 4;
    if (n < 4864) return (n - 4608 < 4) ? 3840 + (n - 4608) : -1;
    return n - 4864 + 4612;
}
template <int CMAP>
__device__ __forceinline__ void transpose_item(const float* W, int K, int N, int Nsrc, const float* gain, bf16_t* WT, LAS float* scr, int item, int lane) {
    const int nblk = N / 32, kb = item / nblk, nb = item % nblk, k0 = 64 * kb, n0 = 32 * nb;
    const int n = n0 + (lane & 31); const int src = CMAP ? win_src(n) : n;
#pragma unroll 8
    for (int i = 0; i < 32; ++i) { const int kk = 2 * i + (lane >> 5); float v = 0.f; if (src >= 0) { v = W[(size_t)(k0 + kk) * Nsrc + src]; if (gain) v *= gain[k0 + kk]; } scr[kk * 33 + (lane & 31)] = v; }
    asm volatile("s_waitcnt lgkmcnt(0)" ::: "memory");
    const int c = lane & 7;
#pragma unroll
    for (int j = 0; j < 4; ++j) { const int nn = (lane >> 3) + 8 * j; const LAS float* s = scr + (8 * c) * 33 + nn;
        u32x4 o; o.x = cvtpk(s[0 * 33], s[1 * 33]); o.y = cvtpk(s[2 * 33], s[3 * 33]); o.z = cvtpk(s[4 * 33], s[5 * 33]); o.w = cvtpk(s[6 * 33], s[7 * 33]);
        *(u32x4*)(WT + (size_t)(n0 + nn) * K + k0 + 8 * c) = o; }
    asm volatile("s_waitcnt lgkmcnt(0)" ::: "memory");
}

#define MFMA32(a, b, c) __builtin_amdgcn_mfma_f32_32x32x16_bf16((a), (b), (c), 0, 0, 0)
__device__ __forceinline__ bf16x8 ld16(const bf16_t* p) { return *(const bf16x8*)p; }
__device__ __forceinline__ bf16x8 pack8(const f32x16& s, int b) { u32x4 w; w.x = cvtpk(s[b], s[b + 1]); w.y = cvtpk(s[b + 2], s[b + 3]); w.z = cvtpk(s[b + 4], s[b + 5]); w.w = cvtpk(s[b + 6], s[b + 7]); return __builtin_bit_cast(bf16x8, w); }
__device__ __forceinline__ int crow(int r, int hi) { return (r & 3) + 8 * (r >> 2) + 4 * hi; }
__device__ __forceinline__ void store_o(bf16_t* orow, const f32x16& o0, const f32x16& o1, int hi) {
#pragma unroll
    for (int g = 0; g < 4; ++g) {
        u32x2 a; a.x = cvtpk(o0[4 * g], o0[4 * g + 1]); a.y = cvtpk(o0[4 * g + 2], o0[4 * g + 3]); *(u32x2*)(orow + 8 * g + 4 * hi) = a;
        u32x2 b; b.x = cvtpk(o1[4 * g], o1[4 * g + 1]); b.y = cvtpk(o1[4 * g + 2], o1[4 * g + 3]); *(u32x2*)(orow + 32 + 8 * g + 4 * hi) = b; }
}

template <int MODE>
__device__ __forceinline__ void sm_unit(const bf16_t* Qs, const bf16_t* Ks, const bf16_t* VTs, int qb, int kb_lo, float slope2, const LAS float* cl,
                                        f32x16& o0, f32x16& o1, float& m_out, float& l_out, int lane) {
    const int r32 = lane & 31, hi = lane >> 5;
    constexpr float SC2 = 0.125f * LOG2E;
    bf16x8 qf[4];
    { const bf16_t* qp = Qs + (size_t)(qb * 32 + r32) * LDQK + hi * 8;
#pragma unroll
      for (int ds = 0; ds < 4; ++ds) qf[ds] = ld16(qp + ds * 16); }
    float m = -INFINITY, l = 0.f;
#pragma unroll
    for (int i = 0; i < 16; ++i) { o0[i] = 0.f; o1[i] = 0.f; }
    for (int kb = qb; kb >= kb_lo; --kb) {
        f32x16 s;
#pragma unroll
        for (int i = 0; i < 16; ++i) s[i] = 0.f;
        const bf16_t* kp = Ks + (size_t)(kb * 32 + r32) * LDQK + hi * 8;
#pragma unroll
        for (int ds = 0; ds < 4; ++ds) { const bf16x8 kf = ld16(kp + ds * 16); s = MFMA32(kf, qf[ds], s); }
        const bf16_t* vp = VTs + (size_t)r32 * SEQ + kb * 32 + hi * 8;
        const bf16x8 v00 = ld16(vp), v01 = ld16(vp + 16), v10 = ld16(vp + 32 * SEQ), v11 = ld16(vp + 32 * SEQ + 16);
        float mt = -INFINITY;
#pragma unroll
        for (int r = 0; r < 16; ++r) { const int kk = crow(r, hi); float v; bool valid;
            if (MODE == 0) { v = s[r] * SC2 + cl[33 * kb + kk]; valid = (kb < qb) || (kk <= r32); }
            else { const int dist = (qb - kb) * 32 + r32 - kk; v = s[r] * SC2 - slope2 * (float)dist; valid = (dist >= 0) && (dist <= 128); }
            v = valid ? v : -INFINITY; s[r] = v; mt = fmaxf(mt, v); }
        mt = x32_max(mt);
        const float mn = fmaxf(m, mt), alpha = ex2(m - mn);
        float ps = 0.f;
#pragma unroll
        for (int r = 0; r < 16; ++r) { const float p = ex2(s[r] - mn); s[r] = p; ps += p; }
        l = l * alpha + ps; m = mn;
#pragma unroll
        for (int i = 0; i < 16; ++i) { o0[i] *= alpha; o1[i] *= alpha; }
        const bf16x8 pf0 = pack8(s, 0), pf1 = pack8(s, 8);
        o0 = MFMA32(v00, pf0, o0); o0 = MFMA32(v01, pf1, o0); o1 = MFMA32(v10, pf0, o1); o1 = MFMA32(v11, pf1, o1);
    }
    l = x32_sum(l);
    m_out = m; l_out = l;
}

__device__ __forceinline__ void diff_unit(const bf16_t* Qs, const bf16_t* Ks, const bf16_t* VTs, int qb, float slope2, float lam, f32x16& r0, f32x16& r1, int lane) {
    const int r32 = lane & 31, hi = lane >> 5;
    constexpr float SC2 = 0.17677669529663687f * LOG2E;
    bf16x8 qf[4];
    { const bf16_t* qp = Qs + (size_t)(qb * 32 + r32) * LDQK + hi * 8;
#pragma unroll
      for (int ds = 0; ds < 4; ++ds) qf[ds] = ld16(qp + ds * 16); }
    float m[2] = {-INFINITY, -INFINITY}, l[2] = {0.f, 0.f};
    f32x16 o[2][2];
#pragma unroll
    for (int i = 0; i < 16; ++i) { o[0][0][i] = 0.f; o[0][1][i] = 0.f; o[1][0][i] = 0.f; o[1][1][i] = 0.f; }
    for (int kb = qb; kb >= 0; --kb) {
        const bf16_t* kp = Ks + (size_t)(kb * 32 + r32) * LDQK + hi * 8;
        bf16x8 kf[4];
#pragma unroll
        for (int ds = 0; ds < 4; ++ds) kf[ds] = ld16(kp + ds * 16);
        const bf16_t* vp = VTs + (size_t)r32 * SEQ + kb * 32 + hi * 8;
        const bf16x8 v00 = ld16(vp), v01 = ld16(vp + 16), v10 = ld16(vp + 32 * SEQ), v11 = ld16(vp + 32 * SEQ + 16);
#pragma unroll
        for (int c = 0; c < 2; ++c) {
            f32x16 s;
#pragma unroll
            for (int i = 0; i < 16; ++i) s[i] = 0.f;
            s = MFMA32(kf[2 * c], qf[2 * c], s); s = MFMA32(kf[2 * c + 1], qf[2 * c + 1], s);
            float mt = -INFINITY;
#pragma unroll
            for (int r = 0; r < 16; ++r) { const int dist = (qb - kb) * 32 + r32 - crow(r, hi); float v = s[r] * SC2 - slope2 * (float)dist; v = (dist >= 0) ? v : -INFINITY; s[r] = v; mt = fmaxf(mt, v); }
            mt = x32_max(mt);
            const float mn = fmaxf(m[c], mt), alpha = ex2(m[c] - mn);
            float ps = 0.f;
#pragma unroll
            for (int r = 0; r < 16; ++r) { const float p = ex2(s[r] - mn); s[r] = p; ps += p; }
            l[c] = l[c] * alpha + ps; m[c] = mn;
#pragma unroll
            for (int i = 0; i < 16; ++i) { o[c][0][i] *= alpha; o[c][1][i] *= alpha; }
            const bf16x8 pf0 = pack8(s, 0), pf1 = pack8(s, 8);
            o[c][0] = MFMA32(v00, pf0, o[c][0]); o[c][0] = MFMA32(v01, pf1, o[c][0]); o[c][1] = MFMA32(v10, pf0, o[c][1]); o[c][1] = MFMA32(v11, pf1, o[c][1]);
        }
    }
    l[0] = x32_sum(l[0]); l[1] = x32_sum(l[1]);
    const float i0 = 1.0f / l[0], i1 = lam / l[1];
#pragma unroll
    for (int i = 0; i < 16; ++i) { r0[i] = o[0][0][i] * i0 - o[1][0][i] * i1; r1[i] = o[0][1][i] * i0 - o[1][1][i] * i1; }
}

__device__ __forceinline__ void sb_unit(const bf16_t* Qs, const bf16_t* Ks, const bf16_t* VTs, int qb, f32x16& o0, f32x16& o1, int lane) {
    const int r32 = lane & 31, hi = lane >> 5;
    constexpr float SC2 = 0.125f * LOG2E;
    bf16x8 qf[4];
    { const bf16_t* qp = Qs + (size_t)(qb * 32 + r32) * LDQK + hi * 8;
#pragma unroll
      for (int ds = 0; ds < 4; ++ds) qf[ds] = ld16(qp + ds * 16); }
    float R = 0.f;
#pragma unroll
    for (int i = 0; i < 16; ++i) { o0[i] = 0.f; o1[i] = 0.f; }
    for (int kb = qb; kb >= 0; --kb) {
        f32x16 s;
#pragma unroll
        for (int i = 0; i < 16; ++i) s[i] = 0.f;
        const bf16_t* kp = Ks + (size_t)(kb * 32 + r32) * LDQK + hi * 8;
#pragma unroll
        for (int ds = 0; ds < 4; ++ds) { const bf16x8 kf = ld16(kp + ds * 16); s = MFMA32(kf, qf[ds], s); }
        const bf16_t* vp = VTs + (size_t)r32 * SEQ + kb * 32 + hi * 8;
        const bf16x8 v00 = ld16(vp), v01 = ld16(vp + 16), v10 = ld16(vp + 32 * SEQ), v11 = ld16(vp + 32 * SEQ + 16);
        float lk[16], ls[16];
#pragma unroll
        for (int r = 0; r < 16; ++r) { const float z2 = s[r] * SC2; const float sp = fmaxf(z2, 0.f) + lg2(1.0f + ex2(-fabsf(z2)));
            const bool valid = (kb < qb) || (crow(r, hi) < r32);
            lk[r] = valid ? -sp : 0.f; ls[r] = valid ? (z2 - sp) : -INFINITY; }
        float e[16], tq[4], pq[4];
#pragma unroll
        for (int g = 0; g < 4; ++g) { e[4 * g + 3] = 0.f; e[4 * g + 2] = lk[4 * g + 3]; e[4 * g + 1] = e[4 * g + 2] + lk[4 * g + 2]; e[4 * g] = e[4 * g + 1] + lk[4 * g + 1]; tq[g] = e[4 * g] + lk[4 * g]; }
#pragma unroll
        for (int g = 0; g < 4; ++g) pq[g] = x32_partner(tq[g], hi);
        float cs[4]; cs[3] = 0.f; cs[2] = tq[3] + pq[3]; cs[1] = cs[2] + (tq[2] + pq[2]); cs[0] = cs[1] + (tq[1] + pq[1]);
        const float total = cs[0] + (tq[0] + pq[0]);
#pragma unroll
        for (int g = 0; g < 4; ++g) { const float later = R + cs[g] + (hi == 0 ? pq[g] : 0.f);
#pragma unroll
            for (int i = 0; i < 4; ++i) s[4 * g + i] = ex2(ls[4 * g + i] + e[4 * g + i] + later); }
        R += total;
        const bf16x8 pf0 = pack8(s, 0), pf1 = pack8(s, 8);
        o0 = MFMA32(v00, pf0, o0); o0 = MFMA32(v01, pf1, o0); o1 = MFMA32(v10, pf0, o1); o1 = MFMA32(v11, pf1, o1);
    }
}


#define XB_TMO      128
#define XB_XCNT(j)  (256  + 64 * (j))
#define XB_XSUB(j)  (1280 + 64 * (j))
#define XB_XGEN(j)  (2304 + 64 * (j))
#define XB_TOP      3328
#define XB_TOPGEN   3392
#define XCD_BAR_WORDS 3456
#define XB_SPIN_CAP (1u << 18)
__device__ __forceinline__ unsigned xb_ld(unsigned* p)              { return __hip_atomic_load(p, __ATOMIC_RELAXED, __HIP_MEMORY_SCOPE_AGENT); }
__device__ __forceinline__ unsigned xb_add(unsigned* p, unsigned v) { return __hip_atomic_fetch_add(p, v, __ATOMIC_RELAXED, __HIP_MEMORY_SCOPE_AGENT); }
__device__ __forceinline__ unsigned xb_xcc_id() { return (unsigned)__builtin_amdgcn_s_getreg((3 << 11) | 20) & 0xFu; }
#define XB_SPIN(cond, bar) do { unsigned _sp = 0; while (cond) { __builtin_amdgcn_s_sleep(1); \
    if ((++_sp & 255u) == 0u) { if (xb_ld(&(bar)[XB_TMO])) break; if (_sp > XB_SPIN_CAP) { atomicAdd(&(bar)[XB_TMO], 1u); break; } } } } while (0)
__device__ __forceinline__ void xcd_barrier_complete(unsigned* bar, unsigned x, unsigned& nloc, unsigned& nx) {
    const unsigned G = gridDim.x * gridDim.y * gridDim.z;
    unsigned sum, cnt, mine, sp = 0u;
    for (;;) {
        sum = 0u; cnt = 0u; mine = 0u;
#pragma unroll
        for (unsigned j = 0; j < 16; ++j) { const unsigned c = xb_ld(&bar[XB_XCNT(j)]); sum += c; cnt += (c > 0u) ? 1u : 0u; mine = (j == x) ? c : mine; }
        if (sum == G) break;
        __builtin_amdgcn_s_sleep(1);
        if ((++sp & 255u) == 0u) { if (xb_ld(&bar[XB_TMO])) break; if (sp > XB_SPIN_CAP) { atomicAdd(&bar[XB_TMO], 1u); break; } }
    }
    nloc = mine > 0u ? mine : 1u; nx = cnt > 0u ? cnt : 1u;
}
__device__ __forceinline__ void xcd_barrier(unsigned* bar, volatile LAS unsigned* st) {
    asm volatile("s_waitcnt vmcnt(0)" ::: "memory");
    __syncthreads();
    if (threadIdx.x == 0) {
        const unsigned x = xb_xcc_id();
        __builtin_amdgcn_s_waitcnt(0);
        unsigned nloc = st[0], nx = st[1];
        if (nloc == 0u) { xcd_barrier_complete(bar, x, nloc, nx); st[0] = nloc; st[1] = nx; }
        const unsigned old = xb_add(&bar[XB_XSUB(x)], 1u);
        const unsigned gen = old / nloc;
        if (old + 1u == (gen + 1u) * nloc) {
            __builtin_amdgcn_fence(__ATOMIC_RELEASE, "agent");
            asm volatile("s_waitcnt vmcnt(0)" ::: "memory");
            const unsigned og = xb_add(&bar[XB_TOP], 1u);
            const unsigned tg = og / nx;
            if (og + 1u == (tg + 1u) * nx) xb_add(&bar[XB_TOPGEN], 1u);
            else XB_SPIN(xb_ld(&bar[XB_TOPGEN]) == tg, bar);
            __builtin_amdgcn_fence(__ATOMIC_ACQUIRE, "agent");
            xb_add(&bar[XB_XGEN(x)], 1u);
            asm volatile("s_waitcnt vmcnt(0)" ::: "memory");
        } else {
            XB_SPIN(xb_ld(&bar[XB_XGEN(x)]) == gen, bar);
            __builtin_amdgcn_fence(__ATOMIC_ACQUIRE, "agent");
            asm volatile("s_waitcnt vmcnt(0)" ::: "memory");
        }
    }
    __syncthreads();
}
constexpr int MISC_OFF = 131072 + 320;

struct Params {
    const float* x; const float* mix_g; const float* w_in; const float* b_forget; const float* lq1; const float* lk1; const float* lq2; const float* lk2;
    const float* diff_g; const float* w_branch; const float* w_out; const float* mlp_g; const float* w_up; const float* w_down; const float* final_g;
    float* out; unsigned char* ws;
};

#ifndef REP_P1
#define REP_P1 1
#endif
#ifndef REP_P2
#define REP_P2 1
#endif
#ifndef REP_P3
#define REP_P3 1
#endif
#ifndef REP_P5
#define REP_P5 1
#endif
#ifndef REP_SYNC
#define REP_SYNC 1
#endif
#ifndef REP_CONV
#define REP_CONV 1
#endif
#define GSYNC() do { for (int rs_ = 0; rs_ < REP_SYNC; ++rs_) { KParamsPtr pb_ = OPQ_PP(); xcd_barrier((unsigned*)(pb_->ws + WS_CTL) + CW_BAR, (volatile LAS unsigned*)(lds + MISC_OFF)); } } while (0)
#define OPQ_TID() ({ int t_ = threadIdx.x; asm volatile("" : "+v"(t_)); t_; })
typedef const __attribute__((address_space(4))) Params* KParamsPtr;
#define OPQ_PP() ({ KParamsPtr p_ = (KParamsPtr)__builtin_amdgcn_kernarg_segment_ptr(); asm volatile("" : "+s"(p_)); p_; })
#define PHASE_VARS() const int tid = OPQ_TID(); const int lane = tid & 63, wave = __builtin_amdgcn_readfirstlane(tid >> 6); const int G = gridDim.x, bx = blockIdx.x; \
    const int gw = bx * NWAVES + wave, NGW = G * NWAVES; KParamsPtr PP = OPQ_PP(); unsigned char* ws = PP->ws; LAS float* scr = (LAS float*)(lds + wave * 16384); (void)lane; (void)gw; (void)NGW; (void)ws; (void)scr; (void)G; (void)bx; (void)PP

__global__ void __launch_bounds__(NWAVES * 64, 2) fwd_mega(Params P) {
    extern __shared__ __attribute__((aligned(16))) unsigned char lds_raw[];
    LAS unsigned char* lds = (LAS unsigned char*)lds_raw;
    cg::grid_group grid = cg::this_grid();
    { const int t0 = OPQ_TID(); if (t0 < 64) ((LAS unsigned*)(lds + 131072))[t0 + 64] = 0u; __syncthreads();
      if (t0 == 0) { KParamsPtr p0 = OPQ_PP(); (void)xb_add((unsigned*)(p0->ws + WS_CTL) + CW_BAR + XB_XCNT(xb_xcc_id()), 1u); } }

    {
        PHASE_VARS();
        float* X = PP->out; bf16_t* XB = (bf16_t*)(ws + WS_XB); float* SSQ = (float*)(ws + WS_SSQ);
        for (int row = gw; row < TOK; row += NGW) {
            const f32x4* xr = (const f32x4*)(PP->x + (size_t)row * DM) + lane; f32x4* xo = (f32x4*)(X + (size_t)row * DM) + lane;
            unsigned long long* o8 = (unsigned long long*)(XB + (size_t)row * DM) + lane;
            float s = 0.f;
#pragma unroll
            for (int j = 0; j < 4; ++j) { const f32x4 v = xr[64 * j]; xo[64 * j] = v; s += (v[0] * v[0] + v[1] * v[1]) + (v[2] * v[2] + v[3] * v[3]);
                o8[64 * j] = (unsigned long long)cvtpk(v[0], v[1]) | ((unsigned long long)cvtpk(v[2], v[3]) << 32); }
            s = wave_sum(s);
            if (lane < 16) SSQ[(size_t)row * 16 + lane] = (lane == 0) ? s : 0.f;
        }
    }

    for (int layer = 0; layer < DEPTH; ++layer) {
        for (int rep = 0; rep < REP_CONV; ++rep) {
            PHASE_VARS();
            bf16_t* WIN = (bf16_t*)(ws + WS_WIN); bf16_t* WB = (bf16_t*)(ws + WS_WB); bf16_t* WOUT = (bf16_t*)(ws + WS_WOUT);
            const float* w_in = PP->w_in + (size_t)layer * DM * DIN; const float* mg = PP->mix_g + (size_t)layer * DM;
            const float* wb = PP->w_branch + (size_t)layer * 4 * 256 * DM; const float* wo = PP->w_out + (size_t)layer * DM * DM;
            constexpr int I_IN = (DM / 64) * (NPROJ / 32), I_B = (256 / 64) * (DM / 32), I_O = (DM / 64) * (DM / 32);
            for (int it = gw; it < I_IN + 4 * I_B + I_O; it += NGW) {
                int r = it;
                if (r < I_IN) { transpose_item<1>(w_in, DM, NPROJ, DIN, mg, WIN, scr, r, lane); continue; } r -= I_IN;
                if (r < 4 * I_B) { const int n = r / I_B; transpose_item<0>(wb + (size_t)n * 256 * DM, 256, DM, DM, nullptr, WB + (size_t)n * DM * 256, scr, r % I_B, lane); continue; } r -= 4 * I_B;
                transpose_item<0>(wo, DM, DM, DM, nullptr, WOUT, scr, r, lane);
            }
        }
        if (layer == 0) grid.sync(); else GSYNC();

        for (int half = 0; half < 2; ++half) {
#ifndef NO_P1
            for (int rep = 0; rep < REP_P1; ++rep) {
                PHASE_VARS();
                const int rb = half * HT;
                pg8::Gemm g{(const bf16_t*)(ws + WS_XB) + (size_t)rb * DM, (const bf16_t*)(ws + WS_WIN), DM, DM, DM, 0, 0};
                pg8::StaticOrder S; S.init(HT, NPROJ, G, bx);
                pg8::EpiProj E{(const float*)(ws + WS_SSQ), rb, (bf16_t*)(ws + WS_QK), (bf16_t*)(ws + WS_VT), (float*)(ws + WS_FL), (bf16_t*)(ws + WS_GATE)};
                pg8::gemm_phase<pg8::EpiProj, pg8::StaticOrder, true>(lds, g, S, E);
            }
#endif
            GSYNC();
#ifndef NO_P2
            for (int rep = 0; rep < REP_P2; ++rep) {
                PHASE_VARS();
                const float lam_init = (layer == 0) ? 0.2f : 0.35550906759093115f;
                unsigned* ctr = (unsigned*)(ws + WS_CTL) + 64 * (1 + layer * 2 + half + 4 * rep);
                const int r32 = lane & 31, hi = lane >> 5;
                float lam;
                { const float a = (lane < 32) ? PP->lq1[layer * 32 + lane] * PP->lk1[layer * 32 + lane] : 0.f, b = (lane < 32) ? PP->lq2[layer * 32 + lane] * PP->lk2[layer * 32 + lane] : 0.f;
                  lam = __expf(wave_sum(a)) - __expf(wave_sum(b)) + lam_init; }
                for (;;) {
                    int idx = 0; if (lane == 0) idx = (int)atomicAdd(ctr, 1u); idx = __builtin_amdgcn_readfirstlane(idx);
                    if (idx >= 6144) break;
                    KParamsPtr PU = OPQ_PP(); unsigned char* wsu = PU->ws;
                    bf16_t* YS = (bf16_t*)(wsu + WS_YS); bf16_t* DILO = (bf16_t*)(wsu + WS_DILO); float* LSE = (float*)(wsu + WS_LSE); const float* FL = (const float*)(wsu + WS_FL);
                    const bf16_t* QK = (const bf16_t*)(wsu + WS_QK); const bf16_t* VT = (const bf16_t*)(wsu + WS_VT);
                    if (idx < 3072) {
                        const int qb = 63 - idx / 48, rem = idx % 48, type = rem / 16, bh = rem % 16, b = bh >> 2, h = bh & 3;
                        const size_t rowb = (size_t)b * SEQ;
                        const int t = qb * 32 + r32;
                        if (type == 0) {
                            f32x16 o0, o1;
                            sb_unit(QK + rowb * LDQK + 0 * 256 + h * 64, QK + rowb * LDQK + 1 * 256 + h * 64, VT + ((size_t)(b * 24 + h) * 64) * SEQ, qb, o0, o1, lane);
                            store_o(YS + (rowb + t) * DM + 0 * 256 + h * 64, o0, o1, hi);
                        } else if (type == 1) {
                            const float slope = exp2f(-8.0f * (float)(5 + h) / 16.0f);
                            f32x16 r0, r1;
                            diff_unit(QK + rowb * LDQK + 10 * 256 + h * 64, QK + rowb * LDQK + 11 * 256 + h * 64, VT + ((size_t)(b * 24 + 20 + h) * 64) * SEQ, qb, slope * LOG2E, lam, r0, r1, lane);
                            float ss = 0.f;
#pragma unroll
                            for (int i = 0; i < 16; ++i) ss += r0[i] * r0[i] + r1[i] * r1[i];
                            ss = x32_sum(ss);
                            const float rn = __builtin_amdgcn_rsqf(ss * (1.0f / 64.0f) + RMS_EPS) * (1.0f - lam_init);
                            const float* dg = PP->diff_g + layer * 64;
#pragma unroll
                            for (int i = 0; i < 16; ++i) { const int d = crow(i, hi); r0[i] *= rn * dg[d]; r1[i] *= rn * dg[32 + d]; }
                            store_o(YS + (rowb + t) * DM + 3 * 256 + h * 64, r0, r1, hi);
                        } else {
                            LAS float* cl = scr;
                            const float bf = PP->b_forget[layer * 4 + h];
                            float run = 0.f;
                            if (lane <= qb) {
                                const float* fp = FL + (rowb + 32 * lane) * 4 + h;
#pragma unroll 8
                                for (int i = 0; i < 32; ++i) { const float y = fp[4 * i] + bf; const float lf = fminf(y, 0.f) - __logf(1.0f + __expf(-fabsf(y))); run += lf; cl[33 * lane + i] = run; }
                            }
                            float incl = run;
#pragma unroll
                            for (int o = 1; o < 64; o <<= 1) { const float tt = __uint_as_float((unsigned)__builtin_amdgcn_ds_bpermute((lane - o) << 2, (int)__float_as_uint(incl))); if (lane >= o) incl += tt; }
                            const float excl = incl - run;
                            if (lane <= qb) {
#pragma unroll 8
                                for (int i = 0; i < 32; ++i) cl[33 * lane + i] = -(cl[33 * lane + i] + excl) * LOG2E;
                            }
                            asm volatile("s_waitcnt lgkmcnt(0)" ::: "memory");
                            f32x16 o0, o1; float m, l;
                            sm_unit<0>(QK + rowb * LDQK + 8 * 256 + h * 64, QK + rowb * LDQK + 9 * 256 + h * 64, VT + ((size_t)(b * 24 + 16 + h) * 64) * SEQ, qb, 0, 0.f, cl, o0, o1, m, l, lane);
                            const float inv = 1.0f / l;
#pragma unroll
                            for (int i = 0; i < 16; ++i) { o0[i] *= inv; o1[i] *= inv; }
                            store_o(YS + (rowb + t) * DM + 2 * 256 + h * 64, o0, o1, hi);
                            asm volatile("s_waitcnt lgkmcnt(0)" ::: "memory");
                        }
                    } else {
                        const int i2 = idx - 3072, j = i2 & 63, gh = (i2 >> 6) % 12, b = i2 / 768, gI = gh >> 2, h = gh & 3;
                        const int rsh = 2 * gI, r = 1 << rsh, sl = SEQ >> rsh, nubsh = 6 - rsh, rho = j >> nubsh, ub = j & ((1 << nubsh) - 1);
                        const int sidx = (gI == 0) ? h : (gI == 1 ? 8 + h : 12 + h);
                        const float slope = exp2f(-8.0f * (float)(sidx + 1) / 16.0f);
                        const size_t rowb = (size_t)b * SEQ + (size_t)rho * sl;
                        f32x16 o0, o1; float m, l;
                        const int kb_lo = (ub - 4 > 0) ? ub - 4 : 0;
                        sm_unit<1>(QK + rowb * LDQK + (2 + gI) * 256 + h * 64, QK + rowb * LDQK + (5 + gI) * 256 + h * 64,
                                   VT + ((size_t)(b * 24 + 4 + 4 * gI + h) * 64) * SEQ + (size_t)rho * sl, ub, kb_lo, slope * (float)r * LOG2E, nullptr, o0, o1, m, l, lane);
                        const float inv = 1.0f / l;
#pragma unroll
                        for (int i = 0; i < 16; ++i) { o0[i] *= inv; o1[i] *= inv; }
                        const int u = ub * 32 + r32; const size_t tok = (size_t)b * SEQ + (size_t)u * r + rho;
                        store_o(DILO + tok * 768 + gI * 256 + h * 64, o0, o1, hi);
                        if (hi == 0) LSE[tok * 12 + gI * 4 + h] = (m + lg2(l)) * LN2;
                    }
                }
            }
#endif
            GSYNC();
            {
                PHASE_VARS();
                bf16_t* YS = (bf16_t*)(ws + WS_YS); const bf16_t* DILO = (const bf16_t*)(ws + WS_DILO); const float* LSE = (const float*)(ws + WS_LSE);
                for (int row = gw; row < HT; row += NGW) {
                    const int h = lane >> 4;
                    const float l0 = LSE[(size_t)row * 12 + h], l1 = LSE[(size_t)row * 12 + 4 + h], l2 = LSE[(size_t)row * 12 + 8 + h];
                    const float mx = fmaxf(l0, fmaxf(l1, l2)); const float e0 = __expf(l0 - mx), e1 = __expf(l1 - mx), e2 = __expf(l2 - mx); const float inv = 1.0f / (e0 + e1 + e2);
                    const u32x2 a = *(const u32x2*)(DILO + (size_t)row * 768 + 4 * lane), b = *(const u32x2*)(DILO + (size_t)row * 768 + 256 + 4 * lane), c = *(const u32x2*)(DILO + (size_t)row * 768 + 512 + 4 * lane);
                    const float w0 = e0 * inv, w1 = e1 * inv, w2 = e2 * inv;
                    u32x2 o; o.x = cvtpk(w0 * bflo(a.x) + w1 * bflo(b.x) + w2 * bflo(c.x), w0 * bfhi(a.x) + w1 * bfhi(b.x) + w2 * bfhi(c.x));
                    o.y = cvtpk(w0 * bflo(a.y) + w1 * bflo(b.y) + w2 * bflo(c.y), w0 * bfhi(a.y) + w1 * bfhi(b.y) + w2 * bfhi(c.y));
                    *(u32x2*)(YS + (size_t)row * DM + 256 + 4 * lane) = o;
                }
            }
            GSYNC();
#ifndef NO_P3
            for (int rep = 0; rep < REP_P3; ++rep) {
                PHASE_VARS();
                pg8::Gemm g{(const bf16_t*)(ws + WS_YS), (const bf16_t*)(ws + WS_WB), DM, 256, 256, 256 * 2, (long)DM * 256 * 2};
                pg8::BranchOrder S{bx};
                pg8::EpiBranch E{(const bf16_t*)(ws + WS_GATE), (bf16_t*)(ws + WS_MERGED), half * HT};
                pg8::gemm_phase<pg8::EpiBranch, pg8::BranchOrder, false>(lds, g, S, E);
            }
#endif
            GSYNC();
        }
#ifndef NO_P4
        for (int rep = 0; rep < REP_CONV; ++rep) {
            PHASE_VARS();
            bf16_t* WUP = (bf16_t*)(ws + WS_WUP); bf16_t* WDN = (bf16_t*)(ws + WS_WDN);
            const float* wu = PP->w_up + (size_t)layer * DM * DFF; const float* wd = PP->w_down + (size_t)layer * DFF * DM; const float* mg = PP->mlp_g + (size_t)layer * DM;
            constexpr int I_U = (DM / 64) * (DFF / 32), I_D = (DFF / 64) * (DM / 32);
            for (int it = gw; it < I_U + I_D; it += NGW) {
                if (it < I_U) transpose_item<0>(wu, DM, DFF, DFF, mg, WUP, scr, it, lane);
                else transpose_item<0>(wd, DFF, DM, DM, nullptr, WDN, scr, it - I_U, lane);
            }
            __syncthreads();
        }
        {
            PHASE_VARS();
            pg8::Gemm g{(const bf16_t*)(ws + WS_MERGED), (const bf16_t*)(ws + WS_WOUT), DM, DM, DM, 0, 0};
            pg8::StaticOrder S; S.init(TOK, DM, G, bx);
            pg8::EpiResid E{PP->out, (bf16_t*)(ws + WS_XB), (float*)(ws + WS_SSQ)};
            pg8::gemm_phase<pg8::EpiResid, pg8::StaticOrder, false>(lds, g, S, E);
        }
#endif
        GSYNC();
#ifndef NO_P5
        for (int rep = 0; rep < REP_P5; ++rep) {
            PHASE_VARS();
            pg8::Gemm g{(const bf16_t*)(ws + WS_XB), (const bf16_t*)(ws + WS_WUP), DM, DM, DM, 0, 0};
            pg8::StaticOrder S; S.init(TOK, DFF, G, bx);
            pg8::EpiUp E{(const float*)(ws + WS_SSQ), (bf16_t*)(ws + WS_HMLP)};
            pg8::gemm_phase<pg8::EpiUp, pg8::StaticOrder, true>(lds, g, S, E);
        }
#endif
        GSYNC();
#ifndef NO_P6
        {
            PHASE_VARS();
            pg8::Gemm g{(const bf16_t*)(ws + WS_HMLP), (const bf16_t*)(ws + WS_WDN), DFF, DFF, DFF, 0, 0};
            pg8::StaticOrder S; S.init(TOK, DM, G, bx);
            pg8::EpiResid E{PP->out, (bf16_t*)(ws + WS_XB), (float*)(ws + WS_SSQ)};
            pg8::gemm_phase<pg8::EpiResid, pg8::StaticOrder, false>(lds, g, S, E);
        }
#endif
        GSYNC();
    }
    {
        PHASE_VARS();
        float* X = PP->out;
        for (int row = gw; row < TOK; row += NGW) {
            f32x4* xo = (f32x4*)(X + (size_t)row * DM) + lane; const f32x4* gp = (const f32x4*)PP->final_g + lane;
            f32x4 v[4]; float s = 0.f;
#pragma unroll
            for (int j = 0; j < 4; ++j) { v[j] = xo[64 * j]; s += (v[j][0] * v[j][0] + v[j][1] * v[j][1]) + (v[j][2] * v[j][2] + v[j][3] * v[j][3]); }
            const float rstd = __builtin_amdgcn_rsqf(wave_sum(s) * (1.0f / DM) + RMS_EPS);
#pragma unroll
            for (int j = 0; j < 4; ++j) xo[64 * j] = v[j] * rstd * gp[64 * j];
        }
    }
}

extern "C" void kernel_launch(void* const* d_in, const int* in_sizes, int n_in, void* d_out, int out_size, void* d_ws, size_t ws_size, hipStream_t stream) {
    static int grid = 0;
    if (grid == 0) {
        if (n_in != 15 || in_sizes[0] != TOK * DM || out_size != TOK * DM || ws_size < WS_END) { fprintf(stderr, "kernel_launch: unexpected shapes / workspace (n_in %d, ws %zu)\n", n_in, ws_size); grid = -1; return; }
        int dev = 0, cus = 0, per_cu = 0;
        hipGetDevice(&dev); hipDeviceGetAttribute(&cus, hipDeviceAttributeMultiprocessorCount, dev);
        hipFuncSetAttribute((const void*)fwd_mega, hipFuncAttributeMaxDynamicSharedMemorySize, LDS_BYTES);
        hipOccupancyMaxActiveBlocksPerMultiprocessor(&per_cu, (const void*)fwd_mega, NWAVES * 64, LDS_BYTES);
        (void)hipGetLastError();
        if (per_cu < 1) per_cu = 1;
        grid = cus;
        if (grid > 256) grid = 256;
    }
    if (grid < 0) return;
    hipMemsetAsync((char*)d_ws + WS_CTL, 0, CTL_BYTES, stream);
    Params p{};
    p.x = (const float*)d_in[0]; p.mix_g = (const float*)d_in[1]; p.w_in = (const float*)d_in[2]; p.b_forget = (const float*)d_in[3];
    p.lq1 = (const float*)d_in[4]; p.lk1 = (const float*)d_in[5]; p.lq2 = (const float*)d_in[6]; p.lk2 = (const float*)d_in[7];
    p.diff_g = (const float*)d_in[8]; p.w_branch = (const float*)d_in[9]; p.w_out = (const float*)d_in[10]; p.mlp_g = (const float*)d_in[11];
    p.w_up = (const float*)d_in[12]; p.w_down = (const float*)d_in[13]; p.final_g = (const float*)d_in[14];
    p.out = (float*)d_out; p.ws = (unsigned char*)d_ws;
    void* args[] = {&p};
    hipError_t e = hipLaunchCooperativeKernel((const void*)fwd_mega, dim3(grid), dim3(NWAVES * 64), args, LDS_BYTES, stream);
    if (e != hipSuccess) fprintf(stderr, "cooperative launch failed: %s (grid %d)\n", hipGetErrorString(e), grid);
}
```

```cpp
#include <hip/hip_runtime.h>
#include <hip/hip_cooperative_groups.h>
#include <cstdio>
#include <cstdint>
namespace cg = cooperative_groups;

#define LAS __attribute__((address_space(3)))
typedef unsigned short bf16_t;
typedef short bf16x8 __attribute__((ext_vector_type(8)));
typedef float f32x4 __attribute__((ext_vector_type(4)));
typedef float f32x16 __attribute__((ext_vector_type(16)));
typedef unsigned u32x4 __attribute__((ext_vector_type(4)));
typedef unsigned u32x2 __attribute__((ext_vector_type(2)));
typedef float f32x2_t __attribute__((ext_vector_type(2)));
typedef __bf16 bf16x2_t __attribute__((ext_vector_type(2)));

constexpr int DM = 1024, BATCH = 8, SEQ = 2048, DEPTH = 2, TOK = BATCH * SEQ, DFF = 4096, DIN = 8708;
constexpr int HT = TOK / 2;
constexpr int NPROJ = 35 * 256;
constexpr int LDQK = 12 * 256;
constexpr float LOG2E = 1.4426950408889634f, LN2 = 0.6931471805599453f;
constexpr float RMS_EPS = 1e-6f;

constexpr size_t MiB = 1u << 20;
constexpr size_t WS_CTL = 0, CTL_BYTES = 65536;
constexpr int CW_BAR = 4096;
constexpr size_t WS_SSQ = 1 * MiB;
constexpr size_t WS_WIN = 2 * MiB;
constexpr size_t WS_WUP = WS_WIN, WS_WDN = WS_WIN + 8 * MiB;
constexpr size_t WS_WB = 20 * MiB;
constexpr size_t WS_WOUT = 22 * MiB;
constexpr size_t WS_XB = 24 * MiB;
constexpr size_t WS_MERGED = 56 * MiB;
constexpr size_t WS_YS = 88 * MiB;
constexpr size_t WS_DILO = 104 * MiB;
constexpr size_t WS_LSE = 116 * MiB;
constexpr size_t WS_FL = 117 * MiB;
constexpr size_t WS_QK = 118 * MiB;
constexpr size_t WS_VT = 166 * MiB;
constexpr size_t WS_GATE = 190 * MiB;
constexpr size_t WS_HMLP = 118 * MiB;
constexpr size_t WS_END = 254 * MiB;

constexpr int LDS_BYTES = 147456;
constexpr int NWAVES = 8;

__device__ __forceinline__ unsigned cvtpk(float lo, float hi) { f32x2_t v = {lo, hi}; bf16x2_t b = __builtin_convertvector(v, bf16x2_t); return __builtin_bit_cast(unsigned, b); }
__device__ __forceinline__ float bflo(unsigned w) { return __uint_as_float(w << 16); }
__device__ __forceinline__ float bfhi(unsigned w) { return __uint_as_float(w & 0xffff0000u); }
__device__ __forceinline__ float ex2(float x) { return __builtin_amdgcn_exp2f(x); }
__device__ __forceinline__ float lg2(float x) { return __builtin_amdgcn_logf(x); }
__device__ __forceinline__ float x32_sum(float v) { auto r = __builtin_amdgcn_permlane32_swap(__float_as_uint(v), __float_as_uint(v), false, false); return __uint_as_float(r[0]) + __uint_as_float(r[1]); }
__device__ __forceinline__ float x32_max(float v) { auto r = __builtin_amdgcn_permlane32_swap(__float_as_uint(v), __float_as_uint(v), false, false); return fmaxf(__uint_as_float(r[0]), __uint_as_float(r[1])); }
__device__ __forceinline__ float x32_partner(float v, int hi) { auto r = __builtin_amdgcn_permlane32_swap(__float_as_uint(v), __float_as_uint(v), false, false); return hi ? __uint_as_float(r[0]) : __uint_as_float(r[1]); }
template <int X> __device__ __forceinline__ float swz_xor(float v) { return __uint_as_float((unsigned)__builtin_amdgcn_ds_swizzle((int)__float_as_uint(v), (X << 10) | 0x1f)); }
__device__ __forceinline__ float x16_sum(float v) { return v + swz_xor<16>(v); }
__device__ __forceinline__ float wave_sum(float v) { v += swz_xor<1>(v); v += swz_xor<2>(v); v += swz_xor<4>(v); v += swz_xor<8>(v); v += swz_xor<16>(v); return x32_sum(v); }

namespace pg8 {
constexpr int BM = 256, BK = 64, HALF = 128, HTB = HALF * BK * 2, STAGE_BYTES = 8 * HTB, NXCD = 8, WGM = 8;
__host__ __device__ __forceinline__ int lds_byte(int r, int c) { const int st = (r >> 4) * 2 + (c >> 5), rr = r & 15, cc = c & 31, ob = rr * 64 + cc * 2; return st * 1024 + (ob ^ (((ob >> 9) & 1) << 5)); }
__host__ __device__ __forceinline__ void stage_rc(int b, int& R, int& C) { const int st = b / 1024, sb = b % 1024, swz = sb ^ (((sb >> 9) & 1) << 5); R = (st >> 1) * 16 + swz / 64; C = (st & 1) * 32 + (swz % 64) / 2; }
__host__ __device__ __forceinline__ int perm32(int rho) { const int n = rho >> 4, i = rho & 15; return 8 * (i >> 2) + 4 * n + (i & 3); }

struct Unit { int pm, pn, aux; };
struct Gemm { const bf16_t* A; const bf16_t* Bt; int lda, ldb, K; long a_aux, b_aux; };

struct StaticOrder {
    int nM, nN, nwg, G, c;
    __device__ void init(int M, int N, int G_, int c_) { nM = M / BM; nN = N / BM; nwg = nM * nN; G = G_; c = c_; }
    __device__ bool next(int i, Unit& u) const {
        const long L = (long)i * G + c; if (L >= nwg) return false;
        int wgid = (int)L; { const int q = nwg / NXCD, r = nwg % NXCD, xcd = wgid % NXCD, off = wgid / NXCD; wgid = (xcd < r ? xcd * (q + 1) : r * (q + 1) + (xcd - r) * q) + off; }
        const int nig = WGM * nN, gid = wgid / nig, fm = gid * WGM, gsz = (nM - fm) < WGM ? (nM - fm) : WGM;
        u.pm = fm + ((wgid % nig) % gsz); u.pn = (wgid % nig) / gsz; u.aux = 0; return true;
    }
};
struct BranchOrder {
    int c;
    __device__ bool next(int i, Unit& u) const { if (c >= 128 || i >= 4) return false; u.pm = c >> 2; u.pn = c & 3; u.aux = i; return true; }
};

template <class Epi, class Sched, bool ALIGN_EPI>
__device__ __forceinline__ void gemm_phase(LAS unsigned char* lds, const Gemm g, const Sched& S, const Epi& E) {
    int tid_ = threadIdx.x; asm volatile("" : "+v"(tid_));
    const int tid = tid_, wid = __builtin_amdgcn_readfirstlane(tid >> 6), lane = tid & 63, wr = wid >> 2, wc = wid & 3, fr = lane & 15, fq = lane >> 4;
    int nt_ = g.K / BK; asm volatile("" : "+s"(nt_)); const int nt = nt_;
    unsigned voffA[2], voffB[2];
#pragma unroll
    for (int i = 0; i < 2; ++i) { int R, C; stage_rc(tid * 16 + i * 8192, R, C); const int Rb = Epi::PERM ? ((R & ~31) + perm32(R & 31)) : R;
        voffA[i] = (unsigned)(R * g.lda + C) * 2u; voffB[i] = (unsigned)(Rb * g.ldb + C) * 2u; }
    const size_t kstep = (size_t)(BK * 2);
    const size_t hstepA = (size_t)HALF * g.lda * 2, hstepB = (size_t)HALF * g.ldb * 2;
    const size_t tstepA = 2 * hstepA, tstepB = 2 * hstepB;
    const unsigned ldsw = (unsigned)wid * 1024u;
    const int aoff = lds_byte(wr * 64 + fr, fq * 8), boff = lds_byte(wc * 32 + fr, fq * 8);
#define PG8_SA(b, h) (((b) * 2 + (h)) * HTB)
#define PG8_SB(b, h) ((4 + (b) * 2 + (h)) * HTB)
#define PG8_STAGE(bufoff, gbase, voff) do { _Pragma("unroll") for (int _i = 0; _i < 2; ++_i) \
        __builtin_amdgcn_global_load_lds((const unsigned*)((const char*)(gbase) + (voff)[_i]), (LAS unsigned*)(lds + (bufoff) + ldsw + _i * 8192), 16, 0, 0); } while (0)
#define PG8_LDA(dst, b, h) do { _Pragma("unroll") for (int m = 0; m < 4; ++m) _Pragma("unroll") for (int k = 0; k < 2; ++k) dst[m][k] = *(const LAS bf16x8*)(lds + PG8_SA(b, h) + aoff + m * 2048 + k * 1024); } while (0)
#define PG8_LDB(dst, b, h) do { _Pragma("unroll") for (int n = 0; n < 2; ++n) _Pragma("unroll") for (int k = 0; k < 2; ++k) dst[n][k] = *(const LAS bf16x8*)(lds + PG8_SB(b, h) + boff + n * 2048 + k * 1024); } while (0)
#define PG8_MMA(ai, bj, At, Bt) do { __builtin_amdgcn_s_setprio(1); _Pragma("unroll") for (int m = 0; m < 4; ++m) _Pragma("unroll") for (int n = 0; n < 2; ++n) _Pragma("unroll") for (int k = 0; k < 2; ++k) \
        acc[ai][bj][m][n] = __builtin_amdgcn_mfma_f32_16x16x32_bf16(Bt[n][k], At[m][k], acc[ai][bj][m][n], 0, 0, 0); __builtin_amdgcn_s_setprio(0); } while (0)
#define PG8_WAIT_V(n) asm volatile("s_waitcnt vmcnt(" #n ")" ::: "memory")
#define PG8_WAIT_L(n) asm volatile("s_waitcnt lgkmcnt(" #n ")" ::: "memory")
#define PG8_BAR __builtin_amdgcn_s_barrier()
#define PG8_SCHED __builtin_amdgcn_sched_barrier(0)
#define PG8_UA(u) ((const char*)g.A + (size_t)(u).pm * tstepA + (size_t)(u).aux * (size_t)g.a_aux)
#define PG8_UB(u) ((const char*)g.Bt + (size_t)(u).pn * tstepB + (size_t)(u).aux * (size_t)g.b_aux)
    Unit cur, nxt; int ui = 0;
    if (!S.next(0, cur)) return;
    f32x4 acc[2][2][4][2];
#pragma unroll
    for (int a = 0; a < 2; ++a)
#pragma unroll
        for (int b = 0; b < 2; ++b)
#pragma unroll
            for (int m = 0; m < 4; ++m)
#pragma unroll
                for (int n = 0; n < 2; ++n) acc[a][b][m][n] = (f32x4){0.f, 0.f, 0.f, 0.f};
    bf16x8 At[4][2], B0[2][2], B1[2][2];
    const char* cA = PG8_UA(cur); const char* cB = PG8_UB(cur);
    PG8_STAGE(PG8_SB(0, 0), cB, voffB); PG8_STAGE(PG8_SB(0, 1), cB + hstepB, voffB); PG8_STAGE(PG8_SA(0, 0), cA, voffA); PG8_STAGE(PG8_SA(0, 1), cA + hstepA, voffA);
    if (wr == 1) PG8_BAR;
    PG8_WAIT_V(2); PG8_BAR;
    PG8_STAGE(PG8_SB(1, 0), cB + kstep, voffB); PG8_STAGE(PG8_SA(1, 0), cA + kstep, voffA); PG8_STAGE(PG8_SB(1, 1), cB + hstepB + kstep, voffB);
    PG8_WAIT_V(6); PG8_BAR;
    for (;;) {
        const bool has_next = S.next(ui + 1, nxt);
        const char* nA = has_next ? PG8_UA(nxt) : cA; const char* nB = has_next ? PG8_UB(nxt) : cB;
        for (int t = 0; t < nt; t += 2) {
            const bool last = (t == nt - 2);
            const char* a1 = cA + (size_t)(t + 1) * kstep;
            const char* a2 = last ? nA : cA + (size_t)(t + 2) * kstep; const char* b2 = last ? nB : cB + (size_t)(t + 2) * kstep;
            const char* a3 = a2 + kstep; const char* b3 = b2 + kstep;
            PG8_LDB(B0, 0, 0); PG8_LDB(B1, 0, 1); PG8_SCHED; PG8_LDA(At, 0, 0); PG8_STAGE(PG8_SA(1, 1), a1 + hstepA, voffA);
            PG8_WAIT_V(8); PG8_WAIT_L(0); PG8_BAR; PG8_MMA(0, 0, At, B0); PG8_MMA(0, 1, At, B1); PG8_BAR; PG8_SCHED;
            PG8_LDA(At, 0, 1); PG8_STAGE(PG8_SB(0, 0), b2, voffB); PG8_STAGE(PG8_SB(0, 1), b2 + hstepB, voffB); PG8_STAGE(PG8_SA(0, 0), a2, voffA);
            PG8_WAIT_V(8); PG8_WAIT_L(0); PG8_BAR; PG8_MMA(1, 0, At, B0); PG8_MMA(1, 1, At, B1); PG8_BAR; PG8_SCHED;
            PG8_LDB(B0, 1, 0); PG8_LDB(B1, 1, 1); PG8_SCHED; PG8_LDA(At, 1, 0); PG8_STAGE(PG8_SA(0, 1), a2 + hstepA, voffA);
            PG8_WAIT_V(8); PG8_WAIT_L(0); PG8_BAR; PG8_MMA(0, 0, At, B0); PG8_MMA(0, 1, At, B1); PG8_BAR; PG8_SCHED;
            PG8_LDA(At, 1, 1); PG8_STAGE(PG8_SB(1, 0), b3, voffB); PG8_STAGE(PG8_SB(1, 1), b3 + hstepB, voffB); PG8_STAGE(PG8_SA(1, 0), a3, voffA);
            PG8_WAIT_V(8); PG8_WAIT_L(0); PG8_BAR; PG8_MMA(1, 0, At, B0); PG8_MMA(1, 1, At, B1); PG8_BAR; PG8_SCHED;
        }
        if constexpr (ALIGN_EPI) { if (wr == 0) PG8_BAR; }
        { Unit eu = cur; asm volatile("" : "+s"(eu.pm), "+s"(eu.pn), "+s"(eu.aux)); E(acc, eu, wr, wc, fr, fq); }
        if (!has_next) break;
#pragma unroll
        for (int a = 0; a < 2; ++a)
#pragma unroll
            for (int b = 0; b < 2; ++b)
#pragma unroll
                for (int m = 0; m < 4; ++m)
#pragma unroll
                    for (int n = 0; n < 2; ++n) acc[a][b][m][n] = (f32x4){0.f, 0.f, 0.f, 0.f};
        cur = nxt; cA = nA; cB = nB; ++ui;
        if constexpr (ALIGN_EPI) { if (wr == 1) PG8_BAR; }
    }
    PG8_WAIT_V(0);
    if constexpr (!ALIGN_EPI) { if (wr == 0) PG8_BAR; }
    PG8_BAR;
#undef PG8_SA
#undef PG8_SB
#undef PG8_STAGE
#undef PG8_LDA
#undef PG8_LDB
#undef PG8_MMA
#undef PG8_WAIT_V
#undef PG8_WAIT_L
#undef PG8_BAR
#undef PG8_SCHED
#undef PG8_UA
#undef PG8_UB
}

__device__ __forceinline__ float row_rstd(const float* ssq, int row, int fq) {
    const f32x4 a = *(const f32x4*)(ssq + (size_t)row * 16 + 4 * fq);
    float s = (a[0] + a[1]) + (a[2] + a[3]);
    s = x16_sum(s); s = x32_sum(s);
    return __builtin_amdgcn_rsqf(s * (1.0f / DM) + RMS_EPS);
}
__device__ __forceinline__ int pos16(int o) { return 8 * ((o >> 2) & 1) + 4 * (o >> 3) + (o & 3); }

struct EpiProj {
    static constexpr bool PERM = true;
    const float* ssq; int row_base; bf16_t* QK; bf16_t* VT; float* FL; bf16_t* GATE;
    __device__ __forceinline__ void operator()(const f32x4 (&acc)[2][2][4][2], const Unit& u, int wr, int wc, int fr, int fq) const {
        const int pn = u.pn;
        const int lrow0 = u.pm * BM + wr * 64 + fr;
        float rs[2][4];
#pragma unroll
        for (int ai = 0; ai < 2; ++ai)
#pragma unroll
            for (int m = 0; m < 4; ++m) rs[ai][m] = row_rstd(ssq, row_base + lrow0 + ai * HALF + m * 16, fq);
        const int cin = wc * 32 + 8 * fq;
        if (pn >= 19) {
#pragma unroll
            for (int ai = 0; ai < 2; ++ai)
#pragma unroll
                for (int m = 0; m < 4; ++m) { const int lrow = lrow0 + ai * HALF + m * 16; const float s = rs[ai][m];
#pragma unroll
                    for (int bj = 0; bj < 2; ++bj) { const f32x4 v0 = acc[ai][bj][m][0] * s, v1 = acc[ai][bj][m][1] * s;
                        u32x4 w; w.x = cvtpk(v0[0], v0[1]); w.y = cvtpk(v0[2], v0[3]); w.z = cvtpk(v1[0], v1[1]); w.w = cvtpk(v1[2], v1[3]);
                        *(u32x4*)(GATE + (size_t)lrow * 4096 + (pn - 19) * 256 + bj * HALF + cin) = w; } }
        } else if (pn == 18) {
            if (wc == 0 && fq == 0) {
#pragma unroll
                for (int ai = 0; ai < 2; ++ai)
#pragma unroll
                    for (int m = 0; m < 4; ++m) { const int lrow = lrow0 + ai * HALF + m * 16; *(f32x4*)(FL + (size_t)lrow * 4) = acc[ai][0][m][0] * rs[ai][m]; }
            }
        } else if (pn == 2 || (pn >= 9 && pn <= 11) || pn == 14 || pn == 17) {
            int vhb, rsh;
            if (pn == 2) { vhb = 0; rsh = 0; } else if (pn == 14) { vhb = 16; rsh = 0; } else if (pn == 17) { vhb = 20; rsh = 0; } else { const int gI = pn - 9; vhb = 4 + 4 * gI; rsh = 2 * gI; }
            const int slsh = 11 - rsh, rmask = (1 << rsh) - 1;
#pragma unroll
            for (int ai = 0; ai < 2; ++ai)
#pragma unroll
                for (int m = 0; m < 4; ++m) { const int lrow = lrow0 + ai * HALF + m * 16; const float s = rs[ai][m];
                    const int bl = lrow >> 11, t = lrow & (SEQ - 1); int p = ((t & rmask) << slsh) + (t >> rsh); p = (p & ~15) | pos16(p & 15);
                    bf16_t* base = VT + (size_t)bl * 24 * 64 * SEQ + p;
#pragma unroll
                    for (int bj = 0; bj < 2; ++bj) { const int c0 = bj * HALF + cin; bf16_t* bp = base + (size_t)(vhb * 64 + c0) * SEQ;
                        const f32x4 v0 = acc[ai][bj][m][0] * s, v1 = acc[ai][bj][m][1] * s;
                        const unsigned w0 = cvtpk(v0[0], v0[1]), w1 = cvtpk(v0[2], v0[3]), w2 = cvtpk(v1[0], v1[1]), w3 = cvtpk(v1[2], v1[3]);
                        bp[0 * SEQ] = (bf16_t)(w0 & 0xffff); bp[1 * SEQ] = (bf16_t)(w0 >> 16); bp[2 * SEQ] = (bf16_t)(w1 & 0xffff); bp[3 * SEQ] = (bf16_t)(w1 >> 16);
                        bp[4 * SEQ] = (bf16_t)(w2 & 0xffff); bp[5 * SEQ] = (bf16_t)(w2 >> 16); bp[6 * SEQ] = (bf16_t)(w3 & 0xffff); bp[7 * SEQ] = (bf16_t)(w3 >> 16); } }
        } else {
            int slot, rsh = 0;
            if (pn <= 1) slot = pn; else if (pn <= 8) { slot = pn - 1; const int gI = (pn - 3) % 3; rsh = 2 * gI; } else if (pn <= 13) slot = pn - 4; else slot = pn - 5;
            const int slsh = 11 - rsh, rmask = (1 << rsh) - 1;
#pragma unroll
            for (int ai = 0; ai < 2; ++ai)
#pragma unroll
                for (int m = 0; m < 4; ++m) { const int lrow = lrow0 + ai * HALF + m * 16; const float s = rs[ai][m];
                    const int bl = lrow >> 11, t = lrow & (SEQ - 1); const int prow = bl * SEQ + ((t & rmask) << slsh) + (t >> rsh);
#pragma unroll
                    for (int bj = 0; bj < 2; ++bj) { const f32x4 v0 = acc[ai][bj][m][0] * s, v1 = acc[ai][bj][m][1] * s;
                        u32x4 w; w.x = cvtpk(v0[0], v0[1]); w.y = cvtpk(v0[2], v0[3]); w.z = cvtpk(v1[0], v1[1]); w.w = cvtpk(v1[2], v1[3]);
                        *(u32x4*)(QK + (size_t)prow * LDQK + slot * 256 + bj * HALF + cin) = w; } }
        }
    }
};

struct EpiBranch {
    static constexpr bool PERM = true;
    const bf16_t* GATE; bf16_t* MERGED; int row_base;
    __device__ __forceinline__ static float sg(float g) { return __builtin_amdgcn_rcpf(1.0f + ex2(-g * LOG2E)); }
    __device__ __forceinline__ static u32x4 mix(const u32x4 gw, const u32x4 ow, const f32x4 v0, const f32x4 v1) {
        const float o0 = sg(bflo(gw.x)) * v0[0] + bflo(ow.x), o1 = sg(bfhi(gw.x)) * v0[1] + bfhi(ow.x), o2 = sg(bflo(gw.y)) * v0[2] + bflo(ow.y), o3 = sg(bfhi(gw.y)) * v0[3] + bfhi(ow.y);
        const float o4 = sg(bflo(gw.z)) * v1[0] + bflo(ow.z), o5 = sg(bfhi(gw.z)) * v1[1] + bfhi(ow.z), o6 = sg(bflo(gw.w)) * v1[2] + bflo(ow.w), o7 = sg(bfhi(gw.w)) * v1[3] + bfhi(ow.w);
        u32x4 w; w.x = cvtpk(o0, o1); w.y = cvtpk(o2, o3); w.z = cvtpk(o4, o5); w.w = cvtpk(o6, o7); return w;
    }
    __device__ __forceinline__ void operator()(const f32x4 (&acc)[2][2][4][2], const Unit& u, int wr, int wc, int fr, int fq) const {
        const int n = u.aux; const int lrow0 = u.pm * BM + wr * 64 + fr; const int col0 = u.pn * BM + wc * 32 + 8 * fq;
        const bf16_t* gbase = GATE + (size_t)lrow0 * 4096 + n * 1024 + col0; bf16_t* mbase = MERGED + (size_t)(row_base + lrow0) * DM + col0;
        const u32x4 zero = {0u, 0u, 0u, 0u};
#pragma unroll
        for (int ai = 0; ai < 2; ++ai)
#pragma unroll
            for (int mp = 0; mp < 2; ++mp) {
                u32x4 gw[2][2], ow[2][2];
#pragma unroll
                for (int mm = 0; mm < 2; ++mm)
#pragma unroll
                    for (int bj = 0; bj < 2; ++bj) { const size_t ro = (size_t)(ai * HALF + (2 * mp + mm) * 16);
                        gw[mm][bj] = *(const u32x4*)(gbase + ro * 4096 + bj * HALF);
                        ow[mm][bj] = zero; if (n > 0) ow[mm][bj] = *(const u32x4*)(mbase + ro * DM + bj * HALF); }
#pragma unroll
                for (int mm = 0; mm < 2; ++mm)
#pragma unroll
                    for (int bj = 0; bj < 2; ++bj) { const int m = 2 * mp + mm; const size_t ro = (size_t)(ai * HALF + m * 16);
                        *(u32x4*)(mbase + ro * DM + bj * HALF) = mix(gw[mm][bj], ow[mm][bj], acc[ai][bj][m][0], acc[ai][bj][m][1]); }
                asm volatile("" ::: "memory");
            }
    }
};

struct EpiResid {
    static constexpr bool PERM = true;
    float* X; bf16_t* XB; float* ssq;
    __device__ __forceinline__ void operator()(const f32x4 (&acc)[2][2][4][2], const Unit& u, int wr, int wc, int fr, int fq) const {
        const int row0 = u.pm * BM + wr * 64 + fr; const int col0 = u.pn * BM + wc * 32 + 8 * fq;
#pragma unroll
        for (int ai = 0; ai < 2; ++ai)
#pragma unroll
            for (int m = 0; m < 4; ++m) { const int row = row0 + ai * HALF + m * 16; float sq = 0.f;
#pragma unroll
                for (int bj = 0; bj < 2; ++bj) { const int col = col0 + bj * HALF; f32x4* xp = (f32x4*)(X + (size_t)row * DM + col);
                    const f32x4 x0 = xp[0] + acc[ai][bj][m][0], x1 = xp[1] + acc[ai][bj][m][1];
                    xp[0] = x0; xp[1] = x1;
                    u32x4 w; w.x = cvtpk(x0[0], x0[1]); w.y = cvtpk(x0[2], x0[3]); w.z = cvtpk(x1[0], x1[1]); w.w = cvtpk(x1[2], x1[3]);
                    *(u32x4*)(XB + (size_t)row * DM + col) = w;
                    sq += (x0[0] * x0[0] + x0[1] * x0[1]) + (x0[2] * x0[2] + x0[3] * x0[3]) + (x1[0] * x1[0] + x1[1] * x1[1]) + (x1[2] * x1[2] + x1[3] * x1[3]); }
                sq = x16_sum(sq); sq = x32_sum(sq);
                if (fq == 0) ssq[(size_t)row * 16 + u.pn * 4 + wc] = sq; if (m & 1) asm volatile("" ::: "memory"); }
    }
};

struct EpiUp {
    static constexpr bool PERM = true;
    const float* ssq; bf16_t* H;
    __device__ __forceinline__ void operator()(const f32x4 (&acc)[2][2][4][2], const Unit& u, int wr, int wc, int fr, int fq) const {
        const int row0 = u.pm * BM + wr * 64 + fr; const int col0 = u.pn * BM + wc * 32 + 8 * fq;
        float rs[2][4];
#pragma unroll
        for (int ai = 0; ai < 2; ++ai)
#pragma unroll
            for (int m = 0; m < 4; ++m) rs[ai][m] = row_rstd(ssq, row0 + ai * HALF + m * 16, fq);
#pragma unroll
        for (int ai = 0; ai < 2; ++ai)
#pragma unroll
            for (int m = 0; m < 4; ++m) { const int row = row0 + ai * HALF + m * 16; const float s = rs[ai][m];
#pragma unroll
                for (int bj = 0; bj < 2; ++bj) { f32x4 v0 = acc[ai][bj][m][0] * s, v1 = acc[ai][bj][m][1] * s;
#pragma unroll
                    for (int i = 0; i < 4; ++i) { const float a = fmaxf(v0[i], 0.f), b = fmaxf(v1[i], 0.f); v0[i] = a * a; v1[i] = b * b; }
                    u32x4 w; w.x = cvtpk(v0[0], v0[1]); w.y = cvtpk(v0[2], v0[3]); w.z = cvtpk(v1[0], v1[1]); w.w = cvtpk(v1[2], v1[3]);
                    *(u32x4*)(H + (size_t)row * DFF + col0 + bj * HALF) = w; } }
    }
};
}

__device__ __forceinline__ int win_src(int n) {
    if (n < 3840) return n;
    if (n < 4608) return n + 4;
    if (n < 4864) return (n - 4608 < 4) ? 3840 + (n - 4608) : -1;
    return n - 4864 + 4612;
}
template <int CMAP>
__device__ __forceinline__ void transpose_item(const float* W, int K, int N, int Nsrc, const float* gain, bf16_t* WT, LAS float* scr, int item, int lane) {
    const int nblk = N / 32, kb = item / nblk, nb = item % nblk, k0 = 64 * kb, n0 = 32 * nb;
    const int n = n0 + (lane & 31); const int src = CMAP ? win_src(n) : n;
#pragma unroll 8
    for (int i = 0; i < 32; ++i) { const int kk = 2 * i + (lane >> 5); float v = 0.f; if (src >= 0) { v = W[(size_t)(k0 + kk) * Nsrc + src]; if (gain) v *= gain[k0 + kk]; } scr[kk * 33 + (lane & 31)] = v; }
    asm volatile("s_waitcnt lgkmcnt(0)" ::: "memory");
    const int c = lane & 7;
#pragma unroll
    for (int j = 0; j < 4; ++j) { const int nn = (lane >> 3) + 8 * j; const LAS float* s = scr + (8 * c) * 33 + nn;
        u32x4 o; o.x = cvtpk(s[0 * 33], s[1 * 33]); o.y = cvtpk(s[2 * 33], s[3 * 33]); o.z = cvtpk(s[4 * 33], s[5 * 33]); o.w = cvtpk(s[6 * 33], s[7 * 33]);
        *(u32x4*)(WT + (size_t)(n0 + nn) * K + k0 + 8 * c) = o; }
    asm volatile("s_waitcnt lgkmcnt(0)" ::: "memory");
}

#define MFMA32(a, b, c) __builtin_amdgcn_mfma_f32_32x32x16_bf16((a), (b), (c), 0, 0, 0)
__device__ __forceinline__ bf16x8 ld16(const bf16_t* p) { return *(const bf16x8*)p; }
__device__ __forceinline__ bf16x8 pack8(const f32x16& s, int b) { u32x4 w; w.x = cvtpk(s[b], s[b + 1]); w.y = cvtpk(s[b + 2], s[b + 3]); w.z = cvtpk(s[b + 4], s[b + 5]); w.w = cvtpk(s[b + 6], s[b + 7]); return __builtin_bit_cast(bf16x8, w); }
__device__ __forceinline__ int crow(int r, int hi) { return (r & 3) + 8 * (r >> 2) + 4 * hi; }
__device__ __forceinline__ void store_o(bf16_t* orow, const f32x16& o0, const f32x16& o1, int hi) {
#pragma unroll
    for (int g = 0; g < 4; ++g) {
        u32x2 a; a.x = cvtpk(o0[4 * g], o0[4 * g + 1]); a.y = cvtpk(o0[4 * g + 2], o0[4 * g + 3]); *(u32x2*)(orow + 8 * g + 4 * hi) = a;
        u32x2 b; b.x = cvtpk(o1[4 * g], o1[4 * g + 1]); b.y = cvtpk(o1[4 * g + 2], o1[4 * g + 3]); *(u32x2*)(orow + 32 + 8 * g + 4 * hi) = b; }
}

struct KFrag { bf16x8 k[4]; };
struct VFrag { bf16x8 v[4]; };
__device__ __forceinline__ void k_load(KFrag& f, const bf16_t* Ks, int kb, int r32, int hi) {
    const bf16_t* kp = Ks + (size_t)(kb * 32 + r32) * LDQK + hi * 8;
#pragma unroll
    for (int ds = 0; ds < 4; ++ds) f.k[ds] = ld16(kp + ds * 16);
}
__device__ __forceinline__ void v_load(VFrag& f, const bf16_t* VTs, int kb, int r32, int hi) {
    const bf16_t* vp = VTs + (size_t)r32 * SEQ + kb * 32 + hi * 8;
    f.v[0] = ld16(vp); f.v[1] = ld16(vp + 16); f.v[2] = ld16(vp + 32 * SEQ); f.v[3] = ld16(vp + 32 * SEQ + 16);
}
__device__ __forceinline__ void q_load(bf16x8 (&qf)[4], const bf16_t* Qs, int qb, int r32, int hi) {
    const bf16_t* qp = Qs + (size_t)(qb * 32 + r32) * LDQK + hi * 8;
#pragma unroll
    for (int ds = 0; ds < 4; ++ds) qf[ds] = ld16(qp + ds * 16);
}

template <int MODE>
__device__ __forceinline__ void sm_unit(const bf16_t* Qs, const bf16_t* Ks, const bf16_t* VTs, int qb, int kb_lo, float slope2, const LAS float* cl,
                                        f32x16& o0, f32x16& o1, float& m_out, float& l_out, int lane) {
    const int r32 = lane & 31, hi = lane >> 5;
    constexpr float SC2 = 0.125f * LOG2E;
    bf16x8 qf[4]; q_load(qf, Qs, qb, r32, hi);
    KFrag nx; k_load(nx, Ks, qb, r32, hi);
    float m = -INFINITY, l = 0.f;
#pragma unroll
    for (int i = 0; i < 16; ++i) { o0[i] = 0.f; o1[i] = 0.f; }
    for (int kb = qb; kb >= kb_lo; --kb) {
        const KFrag cu = nx; VFrag cv; v_load(cv, VTs, kb, r32, hi);
        if (kb > kb_lo) k_load(nx, Ks, kb - 1, r32, hi);
        f32x16 s;
#pragma unroll
        for (int i = 0; i < 16; ++i) s[i] = 0.f;
#pragma unroll
        for (int ds = 0; ds < 4; ++ds) s = MFMA32(cu.k[ds], qf[ds], s);
        const int d0 = (qb - kb) * 32 + r32;
        if (MODE == 0) {
#pragma unroll
            for (int r = 0; r < 16; ++r) { const float v = s[r] * SC2 + cl[33 * kb + crow(r, hi)]; s[r] = (crow(r, hi) <= d0) ? v : -INFINITY; }
        } else {
#pragma unroll
            for (int r = 0; r < 16; ++r) { const int dist = d0 - crow(r, hi); const float v = s[r] * SC2 - slope2 * (float)dist; s[r] = ((unsigned)dist <= 128u) ? v : -INFINITY; }
        }
        float mt = fmaxf(fmaxf(s[0], s[1]), fmaxf(s[2], s[3]));
#pragma unroll
        for (int r = 4; r < 16; r += 4) mt = fmaxf(mt, fmaxf(fmaxf(s[r], s[r + 1]), fmaxf(s[r + 2], s[r + 3])));
        mt = x32_max(mt);
        const float mn = fmaxf(m, mt), alpha = ex2(m - mn);
        float ps = 0.f;
#pragma unroll
        for (int r = 0; r < 16; ++r) { const float p = ex2(s[r] - mn); s[r] = p; ps += p; }
        l = l * alpha + ps; m = mn;
#pragma unroll
        for (int i = 0; i < 16; ++i) { o0[i] *= alpha; o1[i] *= alpha; }
        const bf16x8 pf0 = pack8(s, 0), pf1 = pack8(s, 8);
        o0 = MFMA32(cv.v[0], pf0, o0); o0 = MFMA32(cv.v[1], pf1, o0); o1 = MFMA32(cv.v[2], pf0, o1); o1 = MFMA32(cv.v[3], pf1, o1);
    }
    l = x32_sum(l);
    m_out = m; l_out = l;
}

__device__ __forceinline__ void diff_unit(const bf16_t* Qs, const bf16_t* Ks, const bf16_t* VTs, int qb, float slope2, float lam, f32x16& r0, f32x16& r1, int lane) {
    const int r32 = lane & 31, hi = lane >> 5;
    constexpr float SC2 = 0.17677669529663687f * LOG2E;
    bf16x8 qf[4]; q_load(qf, Qs, qb, r32, hi);
    KFrag nx; k_load(nx, Ks, qb, r32, hi);
    float m[2] = {-INFINITY, -INFINITY}, l[2] = {0.f, 0.f};
    f32x16 o[2][2];
#pragma unroll
    for (int i = 0; i < 16; ++i) { o[0][0][i] = 0.f; o[0][1][i] = 0.f; o[1][0][i] = 0.f; o[1][1][i] = 0.f; }
    for (int kb = qb; kb >= 0; --kb) {
        const KFrag cu = nx; VFrag cv; v_load(cv, VTs, kb, r32, hi);
        if (kb > 0) k_load(nx, Ks, kb - 1, r32, hi);
        const int d0 = (qb - kb) * 32 + r32;
#pragma unroll
        for (int c = 0; c < 2; ++c) {
            f32x16 s;
#pragma unroll
            for (int i = 0; i < 16; ++i) s[i] = 0.f;
            s = MFMA32(cu.k[2 * c], qf[2 * c], s); s = MFMA32(cu.k[2 * c + 1], qf[2 * c + 1], s);
#pragma unroll
            for (int r = 0; r < 16; ++r) { const int dist = d0 - crow(r, hi); const float v = s[r] * SC2 - slope2 * (float)dist; s[r] = (dist >= 0) ? v : -INFINITY; }
            float mt = fmaxf(fmaxf(s[0], s[1]), fmaxf(s[2], s[3]));
#pragma unroll
            for (int r = 4; r < 16; r += 4) mt = fmaxf(mt, fmaxf(fmaxf(s[r], s[r + 1]), fmaxf(s[r + 2], s[r + 3])));
            mt = x32_max(mt);
            const float mn = fmaxf(m[c], mt), alpha = ex2(m[c] - mn);
            float ps = 0.f;
#pragma unroll
            for (int r = 0; r < 16; ++r) { const float p = ex2(s[r] - mn); s[r] = p; ps += p; }
            l[c] = l[c] * alpha + ps; m[c] = mn;
#pragma unroll
            for (int i = 0; i < 16; ++i) { o[c][0][i] *= alpha; o[c][1][i] *= alpha; }
            const bf16x8 pf0 = pack8(s, 0), pf1 = pack8(s, 8);
            o[c][0] = MFMA32(cv.v[0], pf0, o[c][0]); o[c][0] = MFMA32(cv.v[1], pf1, o[c][0]); o[c][1] = MFMA32(cv.v[2], pf0, o[c][1]); o[c][1] = MFMA32(cv.v[3], pf1, o[c][1]);
        }
    }
    l[0] = x32_sum(l[0]); l[1] = x32_sum(l[1]);
    const float i0 = 1.0f / l[0], i1 = lam / l[1];
#pragma unroll
    for (int i = 0; i < 16; ++i) { r0[i] = o[0][0][i] * i0 - o[1][0][i] * i1; r1[i] = o[0][1][i] * i0 - o[1][1][i] * i1; }
}

__device__ __forceinline__ void sb_unit(const bf16_t* Qs, const bf16_t* Ks, const bf16_t* VTs, int qb, f32x16& o0, f32x16& o1, int lane) {
    const int r32 = lane & 31, hi = lane >> 5;
    constexpr float SC2 = 0.125f * LOG2E;
    bf16x8 qf[4]; q_load(qf, Qs, qb, r32, hi);
    KFrag nx; k_load(nx, Ks, qb, r32, hi);
    float R = 0.f;
#pragma unroll
    for (int i = 0; i < 16; ++i) { o0[i] = 0.f; o1[i] = 0.f; }
    for (int kb = qb; kb >= 0; --kb) {
        const KFrag cu = nx; VFrag cv; v_load(cv, VTs, kb, r32, hi);
        if (kb > 0) k_load(nx, Ks, kb - 1, r32, hi);
        f32x16 s;
#pragma unroll
        for (int i = 0; i < 16; ++i) s[i] = 0.f;
#pragma unroll
        for (int ds = 0; ds < 4; ++ds) s = MFMA32(cu.k[ds], qf[ds], s);
        float lk[16], ls[16];
        const int d0 = (qb - kb) * 32 + r32;
#pragma unroll
        for (int r = 0; r < 16; ++r) { const float z2 = s[r] * SC2; const float sp = fmaxf(z2, 0.f) + lg2(1.0f + ex2(-fabsf(z2))); const bool valid = crow(r, hi) < d0; lk[r] = valid ? -sp : 0.f; ls[r] = valid ? (z2 - sp) : -INFINITY; }
        float e[16], tq[4], pq[4];
#pragma unroll
        for (int g = 0; g < 4; ++g) { e[4 * g + 3] = 0.f; e[4 * g + 2] = lk[4 * g + 3]; e[4 * g + 1] = e[4 * g + 2] + lk[4 * g + 2]; e[4 * g] = e[4 * g + 1] + lk[4 * g + 1]; tq[g] = e[4 * g] + lk[4 * g]; }
#pragma unroll
        for (int g = 0; g < 4; ++g) pq[g] = x32_partner(tq[g], hi);
        float cs[4]; cs[3] = 0.f; cs[2] = tq[3] + pq[3]; cs[1] = cs[2] + (tq[2] + pq[2]); cs[0] = cs[1] + (tq[1] + pq[1]);
        const float total = cs[0] + (tq[0] + pq[0]);
#pragma unroll
        for (int g = 0; g < 4; ++g) { const float later = R + cs[g] + (hi == 0 ? pq[g] : 0.f);
#pragma unroll
            for (int i = 0; i < 4; ++i) s[4 * g + i] = ex2(ls[4 * g + i] + e[4 * g + i] + later); }
        R += total;
        const bf16x8 pf0 = pack8(s, 0), pf1 = pack8(s, 8);
        o0 = MFMA32(cv.v[0], pf0, o0); o0 = MFMA32(cv.v[1], pf1, o0); o1 = MFMA32(cv.v[2], pf0, o1); o1 = MFMA32(cv.v[3], pf1, o1);
        if (__all(R < -150.0f)) break;
    }
}

#define XB_TMO      128
#define XB_XCNT(j)  (256  + 64 * (j))
#define XB_XSUB(j)  (1280 + 64 * (j))
#define XB_XGEN(j)  (2304 + 64 * (j))
#define XB_TOP      3328
#define XB_TOPGEN   3392
#define XCD_BAR_WORDS 3456
#define XB_SPIN_CAP (1u << 18)
__device__ __forceinline__ unsigned xb_ld(unsigned* p)              { return __hip_atomic_load(p, __ATOMIC_RELAXED, __HIP_MEMORY_SCOPE_AGENT); }
__device__ __forceinline__ unsigned xb_add(unsigned* p, unsigned v) { return __hip_atomic_fetch_add(p, v, __ATOMIC_RELAXED, __HIP_MEMORY_SCOPE_AGENT); }
__device__ __forceinline__ unsigned xb_xcc_id() { return (unsigned)__builtin_amdgcn_s_getreg((3 << 11) | 20) & 0xFu; }
#define XB_SPIN(cond, bar) do { unsigned _sp = 0; while (cond) { __builtin_amdgcn_s_sleep(1); \
    if ((++_sp & 255u) == 0u) { if (xb_ld(&(bar)[XB_TMO])) break; if (_sp > XB_SPIN_CAP) { atomicAdd(&(bar)[XB_TMO], 1u); break; } } } } while (0)
__device__ __forceinline__ void xcd_barrier_complete(unsigned* bar, unsigned x, unsigned& nloc, unsigned& nx) {
    const unsigned G = gridDim.x * gridDim.y * gridDim.z;
    unsigned sum, cnt, mine, sp = 0u;
    for (;;) {
        sum = 0u; cnt = 0u; mine = 0u;
#pragma unroll
        for (unsigned j = 0; j < 16; ++j) { const unsigned c = xb_ld(&bar[XB_XCNT(j)]); sum += c; cnt += (c > 0u) ? 1u : 0u; mine = (j == x) ? c : mine; }
        if (sum == G) break;
        __builtin_amdgcn_s_sleep(1);
        if ((++sp & 255u) == 0u) { if (xb_ld(&bar[XB_TMO])) break; if (sp > XB_SPIN_CAP) { atomicAdd(&bar[XB_TMO], 1u); break; } }
    }
    nloc = mine > 0u ? mine : 1u; nx = cnt > 0u ? cnt : 1u;
}
__device__ __forceinline__ void xcd_barrier(unsigned* bar, volatile LAS unsigned* st) {
    asm volatile("s_waitcnt vmcnt(0)" ::: "memory");
    __syncthreads();
    if (threadIdx.x == 0) {
        const unsigned x = xb_xcc_id();
        __builtin_amdgcn_s_waitcnt(0);
        unsigned nloc = st[0], nx = st[1];
        if (nloc == 0u) { xcd_barrier_complete(bar, x, nloc, nx); st[0] = nloc; st[1] = nx; }
        const unsigned old = xb_add(&bar[XB_XSUB(x)], 1u);
        const unsigned gen = old / nloc;
        if (old + 1u == (gen + 1u) * nloc) {
            __builtin_amdgcn_fence(__ATOMIC_RELEASE, "agent");
            asm volatile("s_waitcnt vmcnt(0)" ::: "memory");
            const unsigned og = xb_add(&bar[XB_TOP], 1u);
            const unsigned tg = og / nx;
            if (og + 1u == (tg + 1u) * nx) xb_add(&bar[XB_TOPGEN], 1u);
            else XB_SPIN(xb_ld(&bar[XB_TOPGEN]) == tg, bar);
            __builtin_amdgcn_fence(__ATOMIC_ACQUIRE, "agent");
            xb_add(&bar[XB_XGEN(x)], 1u);
            asm volatile("s_waitcnt vmcnt(0)" ::: "memory");
        } else {
            XB_SPIN(xb_ld(&bar[XB_XGEN(x)]) == gen, bar);
            __builtin_amdgcn_fence(__ATOMIC_ACQUIRE, "agent");
            asm volatile("s_waitcnt vmcnt(0)" ::: "memory");
        }
    }
    __syncthreads();
}
constexpr int MISC_OFF = 131072 + 320;

struct Params {
    const float* x; const float* mix_g; const float* w_in; const float* b_forget; const float* lq1; const float* lk1; const float* lq2; const float* lk2;
    const float* diff_g; const float* w_branch; const float* w_out; const float* mlp_g; const float* w_up; const float* w_down; const float* final_g;
    float* out; unsigned char* ws;
};

#ifndef REP_P1
#define REP_P1 1
#endif
#ifndef REP_P2
#define REP_P2 1
#endif
#ifndef REP_P3
#define REP_P3 1
#endif
#ifndef REP_P5
#define REP_P5 1
#endif
#ifndef REP_SYNC
#define REP_SYNC 1
#endif
#ifndef REP_CONV
#define REP_CONV 1
#endif
#define GSYNC() do { for (int rs_ = 0; rs_ < REP_SYNC; ++rs_) { KParamsPtr pb_ = OPQ_PP(); xcd_barrier((unsigned*)(pb_->ws + WS_CTL) + CW_BAR, (volatile LAS unsigned*)(lds + MISC_OFF)); } } while (0)
#define OPQ_TID() ({ int t_ = threadIdx.x; asm volatile("" : "+v"(t_)); t_; })
typedef const __attribute__((address_space(4))) Params* KParamsPtr;
#define OPQ_PP() ({ KParamsPtr p_ = (KParamsPtr)__builtin_amdgcn_kernarg_segment_ptr(); asm volatile("" : "+s"(p_)); p_; })
#define PHASE_VARS() const int tid = OPQ_TID(); const int lane = tid & 63, wave = __builtin_amdgcn_readfirstlane(tid >> 6); const int G = gridDim.x, bx = blockIdx.x; \
    const int gw = bx * NWAVES + wave, NGW = G * NWAVES; KParamsPtr PP = OPQ_PP(); unsigned char* ws = PP->ws; LAS float* scr = (LAS float*)(lds + wave * 16384); (void)lane; (void)gw; (void)NGW; (void)ws; (void)scr; (void)G; (void)bx; (void)PP

__global__ void __launch_bounds__(NWAVES * 64, 2) fwd_mega(Params P) {
    extern __shared__ __attribute__((aligned(16))) unsigned char lds_raw[];
    LAS unsigned char* lds = (LAS unsigned char*)lds_raw;
    cg::grid_group grid = cg::this_grid();
    { const int t0 = OPQ_TID(); if (t0 < 64) ((LAS unsigned*)(lds + 131072))[t0 + 64] = 0u; __syncthreads();
      if (t0 == 0) { KParamsPtr p0 = OPQ_PP(); (void)xb_add((unsigned*)(p0->ws + WS_CTL) + CW_BAR + XB_XCNT(xb_xcc_id()), 1u); } }

    {
        PHASE_VARS();
        float* X = PP->out; bf16_t* XB = (bf16_t*)(ws + WS_XB); float* SSQ = (float*)(ws + WS_SSQ);
        for (int row = gw; row < TOK; row += NGW) {
            const f32x4* xr = (const f32x4*)(PP->x + (size_t)row * DM) + lane; f32x4* xo = (f32x4*)(X + (size_t)row * DM) + lane;
            unsigned long long* o8 = (unsigned long long*)(XB + (size_t)row * DM) + lane;
            float s = 0.f;
#pragma unroll
            for (int j = 0; j < 4; ++j) { const f32x4 v = xr[64 * j]; xo[64 * j] = v; s += (v[0] * v[0] + v[1] * v[1]) + (v[2] * v[2] + v[3] * v[3]);
                o8[64 * j] = (unsigned long long)cvtpk(v[0], v[1]) | ((unsigned long long)cvtpk(v[2], v[3]) << 32); }
            s = wave_sum(s);
            if (lane < 16) SSQ[(size_t)row * 16 + lane] = (lane == 0) ? s : 0.f;
        }
    }

    for (int layer = 0; layer < DEPTH; ++layer) {
        for (int rep = 0; rep < REP_CONV; ++rep) {
            PHASE_VARS();
            bf16_t* WIN = (bf16_t*)(ws + WS_WIN); bf16_t* WB = (bf16_t*)(ws + WS_WB); bf16_t* WOUT = (bf16_t*)(ws + WS_WOUT);
            const float* w_in = PP->w_in + (size_t)layer * DM * DIN; const float* mg = PP->mix_g + (size_t)layer * DM;
            const float* wb = PP->w_branch + (size_t)layer * 4 * 256 * DM; const float* wo = PP->w_out + (size_t)layer * DM * DM;
            constexpr int I_IN = (DM / 64) * (NPROJ / 32), I_B = (256 / 64) * (DM / 32), I_O = (DM / 64) * (DM / 32);
            for (int it = gw; it < I_IN + 4 * I_B + I_O; it += NGW) {
                int r = it;
                if (r < I_IN) { transpose_item<1>(w_in, DM, NPROJ, DIN, mg, WIN, scr, r, lane); continue; } r -= I_IN;
                if (r < 4 * I_B) { const int n = r / I_B; transpose_item<0>(wb + (size_t)n * 256 * DM, 256, DM, DM, nullptr, WB + (size_t)n * DM * 256, scr, r % I_B, lane); continue; } r -= 4 * I_B;
                transpose_item<0>(wo, DM, DM, DM, nullptr, WOUT, scr, r, lane);
            }
        }
        if (layer == 0) grid.sync(); else GSYNC();

        for (int half = 0; half < 2; ++half) {
#ifndef NO_P1
            for (int rep = 0; rep < REP_P1; ++rep) {
                PHASE_VARS();
                const int rb = half * HT;
                pg8::Gemm g{(const bf16_t*)(ws + WS_XB) + (size_t)rb * DM, (const bf16_t*)(ws + WS_WIN), DM, DM, DM, 0, 0};
                pg8::StaticOrder S; S.init(HT, NPROJ, G, bx);
                pg8::EpiProj E{(const float*)(ws + WS_SSQ), rb, (bf16_t*)(ws + WS_QK), (bf16_t*)(ws + WS_VT), (float*)(ws + WS_FL), (bf16_t*)(ws + WS_GATE)};
                pg8::gemm_phase<pg8::EpiProj, pg8::StaticOrder, true>(lds, g, S, E);
            }
#endif
            GSYNC();
#ifndef NO_P2
            for (int rep = 0; rep < REP_P2; ++rep) {
                PHASE_VARS();
                const float lam_init = (layer == 0) ? 0.2f : 0.35550906759093115f;
                unsigned* ctr = (unsigned*)(ws + WS_CTL) + 64 * (1 + layer * 2 + half + 4 * rep);
                const int r32 = lane & 31, hi = lane >> 5;
                float lam;
                { const float a = (lane < 32) ? PP->lq1[layer * 32 + lane] * PP->lk1[layer * 32 + lane] : 0.f, b = (lane < 32) ? PP->lq2[layer * 32 + lane] * PP->lk2[layer * 32 + lane] : 0.f;
                  lam = __expf(wave_sum(a)) - __expf(wave_sum(b)) + lam_init; }
                for (;;) {
                    int idx = 0; if (lane == 0) idx = (int)atomicAdd(ctr, 1u); idx = __builtin_amdgcn_readfirstlane(idx);
                    if (idx >= 6144) break;
                    KParamsPtr PU = OPQ_PP(); unsigned char* wsu = PU->ws;
                    bf16_t* YS = (bf16_t*)(wsu + WS_YS); bf16_t* DILO = (bf16_t*)(wsu + WS_DILO); float* LSE = (float*)(wsu + WS_LSE); const float* FL = (const float*)(wsu + WS_FL);
                    const bf16_t* QK = (const bf16_t*)(wsu + WS_QK); const bf16_t* VT = (const bf16_t*)(wsu + WS_VT);
                    if (idx < 3072) {
                        int qb, type, bh;
                        if (idx < 2048) { qb = 63 - (idx >> 5); type = 1 + ((idx >> 4) & 1); bh = idx & 15; } else { const int i1 = idx - 2048; qb = 63 - (i1 >> 4); type = 0; bh = i1 & 15; }
                        const int b = bh >> 2, h = bh & 3;
                        const size_t rowb = (size_t)b * SEQ;
                        const int t = qb * 32 + r32;
                        if (type == 0) {
                            f32x16 o0, o1;
                            sb_unit(QK + rowb * LDQK + 0 * 256 + h * 64, QK + rowb * LDQK + 1 * 256 + h * 64, VT + ((size_t)(b * 24 + h) * 64) * SEQ, qb, o0, o1, lane);
                            store_o(YS + (rowb + t) * DM + 0 * 256 + h * 64, o0, o1, hi);
                        } else if (type == 1) {
                            const float slope = exp2f(-8.0f * (float)(5 + h) / 16.0f);
                            f32x16 r0, r1;
                            diff_unit(QK + rowb * LDQK + 10 * 256 + h * 64, QK + rowb * LDQK + 11 * 256 + h * 64, VT + ((size_t)(b * 24 + 20 + h) * 64) * SEQ, qb, slope * LOG2E, lam, r0, r1, lane);
                            float ss = 0.f;
#pragma unroll
                            for (int i = 0; i < 16; ++i) ss += r0[i] * r0[i] + r1[i] * r1[i];
                            ss = x32_sum(ss);
                            const float rn = __builtin_amdgcn_rsqf(ss * (1.0f / 64.0f) + RMS_EPS) * (1.0f - lam_init);
                            const float* dg = PP->diff_g + layer * 64;
#pragma unroll
                            for (int i = 0; i < 16; ++i) { const int d = crow(i, hi); r0[i] *= rn * dg[d]; r1[i] *= rn * dg[32 + d]; }
                            store_o(YS + (rowb + t) * DM + 3 * 256 + h * 64, r0, r1, hi);
                        } else {
                            LAS float* cl = scr;
                            const float bf = PP->b_forget[layer * 4 + h];
                            float run = 0.f;
                            if (lane <= qb) {
                                const float* fp = FL + (rowb + 32 * lane) * 4 + h;
#pragma unroll 8
                                for (int i = 0; i < 32; ++i) { const float y = fp[4 * i] + bf; const float lf = fminf(y, 0.f) - __logf(1.0f + __expf(-fabsf(y))); run += lf; cl[33 * lane + i] = run; }
                            }
                            float incl = run;
#pragma unroll
                            for (int o = 1; o < 64; o <<= 1) { const float tt = __uint_as_float((unsigned)__builtin_amdgcn_ds_bpermute((lane - o) << 2, (int)__float_as_uint(incl))); if (lane >= o) incl += tt; }
                            const float excl = incl - run;
                            if (lane <= qb) {
#pragma unroll 8
                                for (int i = 0; i < 32; ++i) cl[33 * lane + i] = -(cl[33 * lane + i] + excl) * LOG2E;
                            }
                            asm volatile("s_waitcnt lgkmcnt(0)" ::: "memory");
                            f32x16 o0, o1; float m, l;
                            sm_unit<0>(QK + rowb * LDQK + 8 * 256 + h * 64, QK + rowb * LDQK + 9 * 256 + h * 64, VT + ((size_t)(b * 24 + 16 + h) * 64) * SEQ, qb, 0, 0.f, cl, o0, o1, m, l, lane);
                            const float inv = 1.0f / l;
#pragma unroll
                            for (int i = 0; i < 16; ++i) { o0[i] *= inv; o1[i] *= inv; }
                            store_o(YS + (rowb + t) * DM + 2 * 256 + h * 64, o0, o1, hi);
                            asm volatile("s_waitcnt lgkmcnt(0)" ::: "memory");
                        }
                    } else {
                        const int i2 = idx - 3072, j = i2 & 63, gh = (i2 >> 6) % 12, b = i2 / 768, gI = gh >> 2, h = gh & 3;
                        const int rsh = 2 * gI, r = 1 << rsh, sl = SEQ >> rsh, nubsh = 6 - rsh, rho = j >> nubsh, ub = j & ((1 << nubsh) - 1);
                        const int sidx = (gI == 0) ? h : (gI == 1 ? 8 + h : 12 + h);
                        const float slope = exp2f(-8.0f * (float)(sidx + 1) / 16.0f);
                        const size_t rowb = (size_t)b * SEQ + (size_t)rho * sl;
                        f32x16 o0, o1; float m, l;
                        const int kb_lo = (ub - 4 > 0) ? ub - 4 : 0;
                        sm_unit<1>(QK + rowb * LDQK + (2 + gI) * 256 + h * 64, QK + rowb * LDQK + (5 + gI) * 256 + h * 64,
                                   VT + ((size_t)(b * 24 + 4 + 4 * gI + h) * 64) * SEQ + (size_t)rho * sl, ub, kb_lo, slope * (float)r * LOG2E, nullptr, o0, o1, m, l, lane);
                        const float inv = 1.0f / l;
#pragma unroll
                        for (int i = 0; i < 16; ++i) { o0[i] *= inv; o1[i] *= inv; }
                        const int u = ub * 32 + r32; const size_t tok = (size_t)b * SEQ + (size_t)u * r + rho;
                        store_o(DILO + tok * 768 + gI * 256 + h * 64, o0, o1, hi);
                        if (hi == 0) LSE[tok * 12 + gI * 4 + h] = (m + lg2(l)) * LN2;
                    }
                }
            }
#endif
            GSYNC();
            {
                PHASE_VARS();
                bf16_t* YS = (bf16_t*)(ws + WS_YS); const bf16_t* DILO = (const bf16_t*)(ws + WS_DILO); const float* LSE = (const float*)(ws + WS_LSE);
                for (int row = gw; row < HT; row += NGW) {
                    const int h = lane >> 4;
                    const float l0 = LSE[(size_t)row * 12 + h], l1 = LSE[(size_t)row * 12 + 4 + h], l2 = LSE[(size_t)row * 12 + 8 + h];
                    const float mx = fmaxf(l0, fmaxf(l1, l2)); const float e0 = __expf(l0 - mx), e1 = __expf(l1 - mx), e2 = __expf(l2 - mx); const float inv = 1.0f / (e0 + e1 + e2);
                    const u32x2 a = *(const u32x2*)(DILO + (size_t)row * 768 + 4 * lane), b = *(const u32x2*)(DILO + (size_t)row * 768 + 256 + 4 * lane), c = *(const u32x2*)(DILO + (size_t)row * 768 + 512 + 4 * lane);
                    const float w0 = e0 * inv, w1 = e1 * inv, w2 = e2 * inv;
                    u32x2 o; o.x = cvtpk(w0 * bflo(a.x) + w1 * bflo(b.x) + w2 * bflo(c.x), w0 * bfhi(a.x) + w1 * bfhi(b.x) + w2 * bfhi(c.x));
                    o.y = cvtpk(w0 * bflo(a.y) + w1 * bflo(b.y) + w2 * bflo(c.y), w0 * bfhi(a.y) + w1 * bfhi(b.y) + w2 * bfhi(c.y));
                    *(u32x2*)(YS + (size_t)row * DM + 256 + 4 * lane) = o;
                }
            }
            GSYNC();
#ifndef NO_P3
            for (int rep = 0; rep < REP_P3; ++rep) {
                PHASE_VARS();
                pg8::Gemm g{(const bf16_t*)(ws + WS_YS), (const bf16_t*)(ws + WS_WB), DM, 256, 256, 256 * 2, (long)DM * 256 * 2};
                pg8::BranchOrder S{bx};
                pg8::EpiBranch E{(const bf16_t*)(ws + WS_GATE), (bf16_t*)(ws + WS_MERGED), half * HT};
                pg8::gemm_phase<pg8::EpiBranch, pg8::BranchOrder, false>(lds, g, S, E);
            }
#endif
            GSYNC();
        }
#ifndef NO_P4
        for (int rep = 0; rep < REP_CONV; ++rep) {
            PHASE_VARS();
            bf16_t* WUP = (bf16_t*)(ws + WS_WUP); bf16_t* WDN = (bf16_t*)(ws + WS_WDN);
            const float* wu = PP->w_up + (size_t)layer * DM * DFF; const float* wd = PP->w_down + (size_t)layer * DFF * DM; const float* mg = PP->mlp_g + (size_t)layer * DM;
            constexpr int I_U = (DM / 64) * (DFF / 32), I_D = (DFF / 64) * (DM / 32);
            for (int it = gw; it < I_U + I_D; it += NGW) {
                if (it < I_U) transpose_item<0>(wu, DM, DFF, DFF, mg, WUP, scr, it, lane);
                else transpose_item<0>(wd, DFF, DM, DM, nullptr, WDN, scr, it - I_U, lane);
            }
            __syncthreads();
        }
        {
            PHASE_VARS();
            pg8::Gemm g{(const bf16_t*)(ws + WS_MERGED), (const bf16_t*)(ws + WS_WOUT), DM, DM, DM, 0, 0};
            pg8::StaticOrder S; S.init(TOK, DM, G, bx);
            pg8::EpiResid E{PP->out, (bf16_t*)(ws + WS_XB), (float*)(ws + WS_SSQ)};
            pg8::gemm_phase<pg8::EpiResid, pg8::StaticOrder, false>(lds, g, S, E);
        }
#endif
        GSYNC();
#ifndef NO_P5
        for (int rep = 0; rep < REP_P5; ++rep) {
            PHASE_VARS();
            pg8::Gemm g{(const bf16_t*)(ws + WS_XB), (const bf16_t*)(ws + WS_WUP), DM, DM, DM, 0, 0};
            pg8::StaticOrder S; S.init(TOK, DFF, G, bx);
            pg8::EpiUp E{(const float*)(ws + WS_SSQ), (bf16_t*)(ws + WS_HMLP)};
            pg8::gemm_phase<pg8::EpiUp, pg8::StaticOrder, true>(lds, g, S, E);
        }
#endif
        GSYNC();
#ifndef NO_P6
        {
            PHASE_VARS();
            pg8::Gemm g{(const bf16_t*)(ws + WS_HMLP), (const bf16_t*)(ws + WS_WDN), DFF, DFF, DFF, 0, 0};
            pg8::StaticOrder S; S.init(TOK, DM, G, bx);
            pg8::EpiResid E{PP->out, (bf16_t*)(ws + WS_XB), (float*)(ws + WS_SSQ)};
            pg8::gemm_phase<pg8::EpiResid, pg8::StaticOrder, false>(lds, g, S, E);
        }
#endif
        GSYNC();
    }
    {
        PHASE_VARS();
        float* X = PP->out;
        for (int row = gw; row < TOK; row += NGW) {
            f32x4* xo = (f32x4*)(X + (size_t)row * DM) + lane; const f32x4* gp = (const f32x4*)PP->final_g + lane;
            f32x4 v[4]; float s = 0.f;
#pragma unroll
            for (int j = 0; j < 4; ++j) { v[j] = xo[64 * j]; s += (v[j][0] * v[j][0] + v[j][1] * v[j][1]) + (v[j][2] * v[j][2] + v[j][3] * v[j][3]); }
            const float rstd = __builtin_amdgcn_rsqf(wave_sum(s) * (1.0f / DM) + RMS_EPS);
#pragma unroll
            for (int j = 0; j < 4; ++j) xo[64 * j] = v[j] * rstd * gp[64 * j];
        }
    }
}

extern "C" void kernel_launch(void* const* d_in, const int* in_sizes, int n_in, void* d_out, int out_size, void* d_ws, size_t ws_size, hipStream_t stream) {
    static int grid = 0;
    if (grid == 0) {
        if (n_in != 15 || in_sizes[0] != TOK * DM || out_size != TOK * DM || ws_size < WS_END) { fprintf(stderr, "kernel_launch: unexpected shapes / workspace (n_in %d, ws %zu)\n", n_in, ws_size); grid = -1; return; }
        int dev = 0, cus = 0, per_cu = 0;
        hipGetDevice(&dev); hipDeviceGetAttribute(&cus, hipDeviceAttributeMultiprocessorCount, dev);
        hipFuncSetAttribute((const void*)fwd_mega, hipFuncAttributeMaxDynamicSharedMemorySize, LDS_BYTES);
        hipOccupancyMaxActiveBlocksPerMultiprocessor(&per_cu, (const void*)fwd_mega, NWAVES * 64, LDS_BYTES);
        (void)hipGetLastError();
        if (per_cu < 1) per_cu = 1;
        grid = cus;
        if (grid > 256) grid = 256;
    }
    if (grid < 0) return;
    hipMemsetAsync((char*)d_ws + WS_CTL, 0, CTL_BYTES, stream);
    Params p{};
    p.x = (const float*)d_in[0]; p.mix_g = (const float*)d_in[1]; p.w_in = (const float*)d_in[2]; p.b_forget = (const float*)d_in[3];
    p.lq1 = (const float*)d_in[4]; p.lk1 = (const float*)d_in[5]; p.lq2 = (const float*)d_in[6]; p.lk2 = (const float*)d_in[7];
    p.diff_g = (const float*)d_in[8]; p.w_branch = (const float*)d_in[9]; p.w_out = (const float*)d_in[10]; p.mlp_g = (const float*)d_in[11];
    p.w_up = (const float*)d_in[12]; p.w_down = (const float*)d_in[13]; p.final_g = (const float*)d_in[14];
    p.out = (float*)d_out; p.ws = (unsigned char*)d_ws;
    void* args[] = {&p};
    hipError_t e = hipLaunchCooperativeKernel((const void*)fwd_mega, dim3(grid), dim3(NWAVES * 64), args, LDS_BYTES, stream);
    if (e != hipSuccess) fprintf(stderr, "cooperative launch failed: %s (grid %d)\n", hipGetErrorString(e), grid);
}
```

```cpp
#include <hip/hip_runtime.h>
#include <hip/hip_cooperative_groups.h>
#include <cstdio>
#include <cstdint>
namespace cg = cooperative_groups;

#define LAS __attribute__((address_space(3)))
typedef unsigned short bf16_t;
typedef short bf16x8 __attribute__((ext_vector_type(8)));
typedef float f32x4 __attribute__((ext_vector_type(4)));
typedef float f32x16 __attribute__((ext_vector_type(16)));
typedef unsigned u32x4 __attribute__((ext_vector_type(4)));
typedef unsigned u32x2 __attribute__((ext_vector_type(2)));
typedef float f32x2_t __attribute__((ext_vector_type(2)));
typedef __bf16 bf16x2_t __attribute__((ext_vector_type(2)));

constexpr int DM = 1024, BATCH = 8, SEQ = 2048, DEPTH = 2, TOK = BATCH * SEQ, DFF = 4096, DIN = 8708;
constexpr int HT = TOK / 2;
constexpr int NPROJ = 35 * 256;
constexpr int LDQK = 12 * 256;
constexpr float LOG2E = 1.4426950408889634f, LN2 = 0.6931471805599453f;
constexpr float RMS_EPS = 1e-6f;

constexpr size_t MiB = 1u << 20;
constexpr size_t WS_CTL = 0, CTL_BYTES = 65536;
constexpr int CW_BAR = 4096;
constexpr size_t WS_SSQ = 1 * MiB;
constexpr size_t WS_WIN = 2 * MiB;
constexpr size_t WS_WUP = WS_WIN, WS_WDN = WS_WIN + 8 * MiB;
constexpr size_t WS_WB = 20 * MiB;
constexpr size_t WS_WOUT = 24 * MiB;
constexpr size_t WS_XB = 26 * MiB;
constexpr size_t WS_MERGED = 58 * MiB;
constexpr size_t WS_YS = 90 * MiB;
constexpr size_t WS_DILO = 106 * MiB;
constexpr size_t WS_LSE = 118 * MiB;
constexpr size_t WS_FL = 119 * MiB;
constexpr size_t WS_QK = 120 * MiB;
constexpr size_t WS_VT = 168 * MiB;
constexpr size_t WS_GATE = 192 * MiB;
constexpr size_t WS_HMLP = 120 * MiB;
constexpr size_t WS_END = 256 * MiB;

constexpr int LDS_BYTES = 147456;
constexpr int NWAVES = 8;

__device__ __forceinline__ unsigned cvtpk(float lo, float hi) { f32x2_t v = {lo, hi}; bf16x2_t b = __builtin_convertvector(v, bf16x2_t); return __builtin_bit_cast(unsigned, b); }
__device__ __forceinline__ float bflo(unsigned w) { return __uint_as_float(w << 16); }
__device__ __forceinline__ float bfhi(unsigned w) { return __uint_as_float(w & 0xffff0000u); }
__device__ __forceinline__ float ex2(float x) { return __builtin_amdgcn_exp2f(x); }
__device__ __forceinline__ float lg2(float x) { return __builtin_amdgcn_logf(x); }
__device__ __forceinline__ float x32_sum(float v) { auto r = __builtin_amdgcn_permlane32_swap(__float_as_uint(v), __float_as_uint(v), false, false); return __uint_as_float(r[0]) + __uint_as_float(r[1]); }
__device__ __forceinline__ float x32_max(float v) { auto r = __builtin_amdgcn_permlane32_swap(__float_as_uint(v), __float_as_uint(v), false, false); return fmaxf(__uint_as_float(r[0]), __uint_as_float(r[1])); }
__device__ __forceinline__ float x32_partner(float v, int hi) { auto r = __builtin_amdgcn_permlane32_swap(__float_as_uint(v), __float_as_uint(v), false, false); return hi ? __uint_as_float(r[0]) : __uint_as_float(r[1]); }
template <int X> __device__ __forceinline__ float swz_xor(float v) { return __uint_as_float((unsigned)__builtin_amdgcn_ds_swizzle((int)__float_as_uint(v), (X << 10) | 0x1f)); }
__device__ __forceinline__ float x16_sum(float v) { return v + swz_xor<16>(v); }
__device__ __forceinline__ float wave_sum(float v) { v += swz_xor<1>(v); v += swz_xor<2>(v); v += swz_xor<4>(v); v += swz_xor<8>(v); v += swz_xor<16>(v); return x32_sum(v); }

namespace pg8 {
constexpr int BM = 256, BK = 64, HALF = 128, HTB = HALF * BK * 2, STAGE_BYTES = 8 * HTB, NXCD = 8, WGM = 8;
__host__ __device__ __forceinline__ int lds_byte(int r, int c) { const int st = (r >> 4) * 2 + (c >> 5), rr = r & 15, cc = c & 31, ob = rr * 64 + cc * 2; return st * 1024 + (ob ^ (((ob >> 9) & 1) << 5)); }
__host__ __device__ __forceinline__ void stage_rc(int b, int& R, int& C) { const int st = b / 1024, sb = b % 1024, swz = sb ^ (((sb >> 9) & 1) << 5); R = (st >> 1) * 16 + swz / 64; C = (st & 1) * 32 + (swz % 64) / 2; }
__host__ __device__ __forceinline__ int perm32(int rho) { const int n = rho >> 4, i = rho & 15; return 8 * (i >> 2) + 4 * n + (i & 3); }

struct Unit { int pm, pn, aux; };
struct Gemm { const bf16_t* A; const bf16_t* Bt; int lda, ldb, K; long a_aux, b_aux; };

struct StaticOrder {
    int nM, nN, nwg, G, c;
    __device__ void init(int M, int N, int G_, int c_) { nM = M / BM; nN = N / BM; nwg = nM * nN; G = G_; c = c_; }
    __device__ bool next(int i, Unit& u) const {
        const long L = (long)i * G + c; if (L >= nwg) return false;
        int wgid = (int)L; { const int q = nwg / NXCD, r = nwg % NXCD, xcd = wgid % NXCD, off = wgid / NXCD; wgid = (xcd < r ? xcd * (q + 1) : r * (q + 1) + (xcd - r) * q) + off; }
        const int nig = WGM * nN, gid = wgid / nig, fm = gid * WGM, gsz = (nM - fm) < WGM ? (nM - fm) : WGM;
        u.pm = fm + ((wgid % nig) % gsz); u.pn = (wgid % nig) / gsz; u.aux = 0; return true;
    }
};
struct BranchOrder {
    int c, G;
    __device__ bool next(int i, Unit& u) const { const int t = c + (i >> 1) * G; if (t >= 256) return false; u.pm = t >> 3; u.pn = t & 7; u.aux = i & 1; return true; }
};

template <class Epi, class Sched, bool ALIGN_EPI>
__device__ __forceinline__ void gemm_phase(LAS unsigned char* lds, const Gemm g, const Sched& S, const Epi& E) {
    int tid_ = threadIdx.x; asm volatile("" : "+v"(tid_));
    const int tid = tid_, wid = __builtin_amdgcn_readfirstlane(tid >> 6), lane = tid & 63, wr = wid >> 2, wc = wid & 3, fr = lane & 15, fq = lane >> 4;
    int nt_ = g.K / BK; asm volatile("" : "+s"(nt_)); const int nt = nt_;
    unsigned voffA[2], voffB[2];
#pragma unroll
    for (int i = 0; i < 2; ++i) { int R, C; stage_rc(tid * 16 + i * 8192, R, C); const int Rb = Epi::PERM ? ((R & ~31) + perm32(R & 31)) : R;
        voffA[i] = (unsigned)(R * g.lda + C) * 2u; voffB[i] = (unsigned)(Rb * g.ldb + C) * 2u; }
    const size_t kstep = (size_t)(BK * 2);
    const size_t hstepA = (size_t)HALF * g.lda * 2, hstepB = (size_t)HALF * g.ldb * 2;
    const size_t tstepA = 2 * hstepA, tstepB = 2 * hstepB;
    const unsigned ldsw = (unsigned)wid * 1024u;
    const int aoff = lds_byte(wr * 64 + fr, fq * 8), boff = lds_byte(wc * 32 + fr, fq * 8);
#define PG8_SA(b, h) (((b) * 2 + (h)) * HTB)
#define PG8_SB(b, h) ((4 + (b) * 2 + (h)) * HTB)
#define PG8_STAGE(bufoff, gbase, voff) do { _Pragma("unroll") for (int _i = 0; _i < 2; ++_i) \
        __builtin_amdgcn_global_load_lds((const unsigned*)((const char*)(gbase) + (voff)[_i]), (LAS unsigned*)(lds + (bufoff) + ldsw + _i * 8192), 16, 0, 0); } while (0)
#define PG8_LDA(dst, b, h) do { _Pragma("unroll") for (int m = 0; m < 4; ++m) _Pragma("unroll") for (int k = 0; k < 2; ++k) dst[m][k] = *(const LAS bf16x8*)(lds + PG8_SA(b, h) + aoff + m * 2048 + k * 1024); } while (0)
#define PG8_LDB(dst, b, h) do { _Pragma("unroll") for (int n = 0; n < 2; ++n) _Pragma("unroll") for (int k = 0; k < 2; ++k) dst[n][k] = *(const LAS bf16x8*)(lds + PG8_SB(b, h) + boff + n * 2048 + k * 1024); } while (0)
#define PG8_MMA(ai, bj, At, Bt) do { __builtin_amdgcn_s_setprio(1); _Pragma("unroll") for (int m = 0; m < 4; ++m) _Pragma("unroll") for (int n = 0; n < 2; ++n) _Pragma("unroll") for (int k = 0; k < 2; ++k) \
        acc[ai][bj][m][n] = __builtin_amdgcn_mfma_f32_16x16x32_bf16(Bt[n][k], At[m][k], acc[ai][bj][m][n], 0, 0, 0); __builtin_amdgcn_s_setprio(0); } while (0)
#define PG8_WAIT_V(n) asm volatile("s_waitcnt vmcnt(" #n ")" ::: "memory")
#define PG8_WAIT_L(n) asm volatile("s_waitcnt lgkmcnt(" #n ")" ::: "memory")
#define PG8_BAR __builtin_amdgcn_s_barrier()
#define PG8_SCHED __builtin_amdgcn_sched_barrier(0)
#define PG8_UA(u) ((const char*)g.A + (size_t)(u).pm * tstepA + (size_t)(u).aux * (size_t)g.a_aux)
#define PG8_UB(u) ((const char*)g.Bt + (size_t)(u).pn * tstepB + (size_t)(u).aux * (size_t)g.b_aux)
    Unit cur, nxt; int ui = 0;
    if (!S.next(0, cur)) return;
    f32x4 acc[2][2][4][2];
#pragma unroll
    for (int a = 0; a < 2; ++a)
#pragma unroll
        for (int b = 0; b < 2; ++b)
#pragma unroll
            for (int m = 0; m < 4; ++m)
#pragma unroll
                for (int n = 0; n < 2; ++n) acc[a][b][m][n] = (f32x4){0.f, 0.f, 0.f, 0.f};
    bf16x8 At[4][2], B0[2][2], B1[2][2];
    const char* cA = PG8_UA(cur); const char* cB = PG8_UB(cur);
    PG8_STAGE(PG8_SB(0, 0), cB, voffB); PG8_STAGE(PG8_SB(0, 1), cB + hstepB, voffB); PG8_STAGE(PG8_SA(0, 0), cA, voffA); PG8_STAGE(PG8_SA(0, 1), cA + hstepA, voffA);
    if (wr == 1) PG8_BAR;
    PG8_WAIT_V(2); PG8_BAR;
    PG8_STAGE(PG8_SB(1, 0), cB + kstep, voffB); PG8_STAGE(PG8_SA(1, 0), cA + kstep, voffA); PG8_STAGE(PG8_SB(1, 1), cB + hstepB + kstep, voffB);
    PG8_WAIT_V(6); PG8_BAR;
    for (;;) {
        const bool has_next = S.next(ui + 1, nxt);
        const char* nA = has_next ? PG8_UA(nxt) : cA; const char* nB = has_next ? PG8_UB(nxt) : cB;
        for (int t = 0; t < nt; t += 2) {
            const bool last = (t == nt - 2);
            const char* a1 = cA + (size_t)(t + 1) * kstep;
            const char* a2 = last ? nA : cA + (size_t)(t + 2) * kstep; const char* b2 = last ? nB : cB + (size_t)(t + 2) * kstep;
            const char* a3 = a2 + kstep; const char* b3 = b2 + kstep;
            PG8_LDB(B0, 0, 0); PG8_LDB(B1, 0, 1); PG8_SCHED; PG8_LDA(At, 0, 0); PG8_STAGE(PG8_SA(1, 1), a1 + hstepA, voffA);
            PG8_WAIT_V(8); PG8_WAIT_L(0); PG8_BAR; PG8_MMA(0, 0, At, B0); PG8_MMA(0, 1, At, B1); PG8_BAR; PG8_SCHED;
            PG8_LDA(At, 0, 1); PG8_STAGE(PG8_SB(0, 0), b2, voffB); PG8_STAGE(PG8_SB(0, 1), b2 + hstepB, voffB); PG8_STAGE(PG8_SA(0, 0), a2, voffA);
            PG8_WAIT_V(8); PG8_WAIT_L(0); PG8_BAR; PG8_MMA(1, 0, At, B0); PG8_MMA(1, 1, At, B1); PG8_BAR; PG8_SCHED;
            PG8_LDB(B0, 1, 0); PG8_LDB(B1, 1, 1); PG8_SCHED; PG8_LDA(At, 1, 0); PG8_STAGE(PG8_SA(0, 1), a2 + hstepA, voffA);
            PG8_WAIT_V(8); PG8_WAIT_L(0); PG8_BAR; PG8_MMA(0, 0, At, B0); PG8_MMA(0, 1, At, B1); PG8_BAR; PG8_SCHED;
            PG8_LDA(At, 1, 1); PG8_STAGE(PG8_SB(1, 0), b3, voffB); PG8_STAGE(PG8_SB(1, 1), b3 + hstepB, voffB); PG8_STAGE(PG8_SA(1, 0), a3, voffA);
            PG8_WAIT_V(8); PG8_WAIT_L(0); PG8_BAR; PG8_MMA(1, 0, At, B0); PG8_MMA(1, 1, At, B1); PG8_BAR; PG8_SCHED;
        }
        if constexpr (ALIGN_EPI) { if (wr == 0) PG8_BAR; }
        { Unit eu = cur; asm volatile("" : "+s"(eu.pm), "+s"(eu.pn), "+s"(eu.aux)); E(acc, eu, wr, wc, fr, fq); }
        if (!has_next) break;
#pragma unroll
        for (int a = 0; a < 2; ++a)
#pragma unroll
            for (int b = 0; b < 2; ++b)
#pragma unroll
                for (int m = 0; m < 4; ++m)
#pragma unroll
                    for (int n = 0; n < 2; ++n) acc[a][b][m][n] = (f32x4){0.f, 0.f, 0.f, 0.f};
        cur = nxt; cA = nA; cB = nB; ++ui;
        if constexpr (ALIGN_EPI) { if (wr == 1) PG8_BAR; }
    }
    PG8_WAIT_V(0);
    if constexpr (!ALIGN_EPI) { if (wr == 0) PG8_BAR; }
    PG8_BAR;
#undef PG8_SA
#undef PG8_SB
#undef PG8_STAGE
#undef PG8_LDA
#undef PG8_LDB
#undef PG8_MMA
#undef PG8_WAIT_V
#undef PG8_WAIT_L
#undef PG8_BAR
#undef PG8_SCHED
#undef PG8_UA
#undef PG8_UB
}

__device__ __forceinline__ float row_rstd(const float* ssq, int row, int fq) {
    const f32x4 a = *(const f32x4*)(ssq + (size_t)row * 16 + 4 * fq);
    float s = (a[0] + a[1]) + (a[2] + a[3]);
    s = x16_sum(s); s = x32_sum(s);
    return __builtin_amdgcn_rsqf(s * (1.0f / DM) + RMS_EPS);
}
__device__ __forceinline__ int pos16(int o) { return 8 * ((o >> 2) & 1) + 4 * (o >> 3) + (o & 3); }

struct EpiProj {
    static constexpr bool PERM = true;
    const float* ssq; int row_base; bf16_t* QK; bf16_t* VT; float* FL; bf16_t* GATE;
    __device__ __forceinline__ void operator()(const f32x4 (&acc)[2][2][4][2], const Unit& u, int wr, int wc, int fr, int fq) const {
        const int pn = u.pn;
        const int lrow0 = u.pm * BM + wr * 64 + fr;
        float rs[2][4];
#pragma unroll
        for (int ai = 0; ai < 2; ++ai)
#pragma unroll
            for (int m = 0; m < 4; ++m) rs[ai][m] = row_rstd(ssq, row_base + lrow0 + ai * HALF + m * 16, fq);
        const int cin = wc * 32 + 8 * fq;
        if (pn >= 19) {
#pragma unroll
            for (int ai = 0; ai < 2; ++ai)
#pragma unroll
                for (int m = 0; m < 4; ++m) { const int lrow = lrow0 + ai * HALF + m * 16; const float s = rs[ai][m];
#pragma unroll
                    for (int bj = 0; bj < 2; ++bj) { const f32x4 v0 = acc[ai][bj][m][0] * s, v1 = acc[ai][bj][m][1] * s;
                        u32x4 w; w.x = cvtpk(v0[0], v0[1]); w.y = cvtpk(v0[2], v0[3]); w.z = cvtpk(v1[0], v1[1]); w.w = cvtpk(v1[2], v1[3]);
                        *(u32x4*)(GATE + (size_t)lrow * 4096 + (pn - 19) * 256 + bj * HALF + cin) = w; } }
        } else if (pn == 18) {
            if (wc == 0 && fq == 0) {
#pragma unroll
                for (int ai = 0; ai < 2; ++ai)
#pragma unroll
                    for (int m = 0; m < 4; ++m) { const int lrow = lrow0 + ai * HALF + m * 16; *(f32x4*)(FL + (size_t)lrow * 4) = acc[ai][0][m][0] * rs[ai][m]; }
            }
        } else if (pn == 2 || (pn >= 9 && pn <= 11) || pn == 14 || pn == 17) {
            int vhb, rsh;
            if (pn == 2) { vhb = 0; rsh = 0; } else if (pn == 14) { vhb = 16; rsh = 0; } else if (pn == 17) { vhb = 20; rsh = 0; } else { const int gI = pn - 9; vhb = 4 + 4 * gI; rsh = 2 * gI; }
            const int slsh = 11 - rsh, rmask = (1 << rsh) - 1;
#pragma unroll
            for (int ai = 0; ai < 2; ++ai)
#pragma unroll
                for (int m = 0; m < 4; ++m) { const int lrow = lrow0 + ai * HALF + m * 16; const float s = rs[ai][m];
                    const int bl = lrow >> 11, t = lrow & (SEQ - 1); int p = ((t & rmask) << slsh) + (t >> rsh); p = (p & ~15) | pos16(p & 15);
                    bf16_t* base = VT + (size_t)bl * 24 * 64 * SEQ + p;
#pragma unroll
                    for (int bj = 0; bj < 2; ++bj) { const int c0 = bj * HALF + cin; bf16_t* bp = base + (size_t)(vhb * 64 + c0) * SEQ;
                        const f32x4 v0 = acc[ai][bj][m][0] * s, v1 = acc[ai][bj][m][1] * s;
                        const unsigned w0 = cvtpk(v0[0], v0[1]), w1 = cvtpk(v0[2], v0[3]), w2 = cvtpk(v1[0], v1[1]), w3 = cvtpk(v1[2], v1[3]);
                        bp[0 * SEQ] = (bf16_t)(w0 & 0xffff); bp[1 * SEQ] = (bf16_t)(w0 >> 16); bp[2 * SEQ] = (bf16_t)(w1 & 0xffff); bp[3 * SEQ] = (bf16_t)(w1 >> 16);
                        bp[4 * SEQ] = (bf16_t)(w2 & 0xffff); bp[5 * SEQ] = (bf16_t)(w2 >> 16); bp[6 * SEQ] = (bf16_t)(w3 & 0xffff); bp[7 * SEQ] = (bf16_t)(w3 >> 16); } }
        } else {
            int slot, rsh = 0;
            if (pn <= 1) slot = pn; else if (pn <= 8) { slot = pn - 1; const int gI = (pn - 3) % 3; rsh = 2 * gI; } else if (pn <= 13) slot = pn - 4; else slot = pn - 5;
            const int slsh = 11 - rsh, rmask = (1 << rsh) - 1;
#pragma unroll
            for (int ai = 0; ai < 2; ++ai)
#pragma unroll
                for (int m = 0; m < 4; ++m) { const int lrow = lrow0 + ai * HALF + m * 16; const float s = rs[ai][m];
                    const int bl = lrow >> 11, t = lrow & (SEQ - 1); const int prow = bl * SEQ + ((t & rmask) << slsh) + (t >> rsh);
#pragma unroll
                    for (int bj = 0; bj < 2; ++bj) { const f32x4 v0 = acc[ai][bj][m][0] * s, v1 = acc[ai][bj][m][1] * s;
                        u32x4 w; w.x = cvtpk(v0[0], v0[1]); w.y = cvtpk(v0[2], v0[3]); w.z = cvtpk(v1[0], v1[1]); w.w = cvtpk(v1[2], v1[3]);
                        *(u32x4*)(QK + (size_t)prow * LDQK + slot * 256 + bj * HALF + cin) = w; } }
        }
    }
};

struct EpiBranch {
    static constexpr bool PERM = true;
    const bf16_t* GATE; bf16_t* MERGED; int row_base;
    __device__ __forceinline__ static float sg(float g) { return __builtin_amdgcn_rcpf(1.0f + ex2(-g * LOG2E)); }
    __device__ __forceinline__ static u32x4 mix(const u32x4 ga, const u32x4 gb, const u32x4 ow, const f32x4 a0, const f32x4 a1, const f32x4 b0, const f32x4 b1) {
        const float o0 = sg(bflo(ga.x)) * a0[0] + sg(bflo(gb.x)) * b0[0] + bflo(ow.x), o1 = sg(bfhi(ga.x)) * a0[1] + sg(bfhi(gb.x)) * b0[1] + bfhi(ow.x);
        const float o2 = sg(bflo(ga.y)) * a0[2] + sg(bflo(gb.y)) * b0[2] + bflo(ow.y), o3 = sg(bfhi(ga.y)) * a0[3] + sg(bfhi(gb.y)) * b0[3] + bfhi(ow.y);
        const float o4 = sg(bflo(ga.z)) * a1[0] + sg(bflo(gb.z)) * b1[0] + bflo(ow.z), o5 = sg(bfhi(ga.z)) * a1[1] + sg(bfhi(gb.z)) * b1[1] + bfhi(ow.z);
        const float o6 = sg(bflo(ga.w)) * a1[2] + sg(bflo(gb.w)) * b1[2] + bflo(ow.w), o7 = sg(bfhi(ga.w)) * a1[3] + sg(bfhi(gb.w)) * b1[3] + bfhi(ow.w);
        u32x4 w; w.x = cvtpk(o0, o1); w.y = cvtpk(o2, o3); w.z = cvtpk(o4, o5); w.w = cvtpk(o6, o7); return w;
    }
    __device__ __forceinline__ void operator()(const f32x4 (&acc)[2][2][4][2], const Unit& u, int wr, int wc, int fr, int fq) const {
        const int p = u.aux; const int lrow0 = u.pm * BM + wr * 64 + fr; const int d0 = u.pn * 128 + wc * 32 + 8 * fq;
        const bf16_t* gbase = GATE + (size_t)lrow0 * 4096 + (2 * p) * 1024 + d0; bf16_t* mbase = MERGED + (size_t)(row_base + lrow0) * DM + d0;
        const u32x4 zero = {0u, 0u, 0u, 0u};
#pragma unroll
        for (int ai = 0; ai < 2; ++ai)
#pragma unroll
            for (int mp = 0; mp < 2; ++mp) {
                u32x4 ga[2], gb[2], ow[2];
#pragma unroll
                for (int mm = 0; mm < 2; ++mm) { const size_t ro = (size_t)(ai * HALF + (2 * mp + mm) * 16);
                    ga[mm] = *(const u32x4*)(gbase + ro * 4096); gb[mm] = *(const u32x4*)(gbase + ro * 4096 + 1024);
                    ow[mm] = zero; if (p > 0) ow[mm] = *(const u32x4*)(mbase + ro * DM); }
#pragma unroll
                for (int mm = 0; mm < 2; ++mm) { const int m = 2 * mp + mm; const size_t ro = (size_t)(ai * HALF + m * 16);
                    *(u32x4*)(mbase + ro * DM) = mix(ga[mm], gb[mm], ow[mm], acc[ai][0][m][0], acc[ai][0][m][1], acc[ai][1][m][0], acc[ai][1][m][1]); }
                asm volatile("" ::: "memory");
            }
    }
};

struct EpiResid {
    static constexpr bool PERM = true;
    float* X; bf16_t* XB; float* ssq;
    __device__ __forceinline__ void operator()(const f32x4 (&acc)[2][2][4][2], const Unit& u, int wr, int wc, int fr, int fq) const {
        const int row0 = u.pm * BM + wr * 64 + fr; const int col0 = u.pn * BM + wc * 32 + 8 * fq;
#pragma unroll
        for (int ai = 0; ai < 2; ++ai)
#pragma unroll
            for (int m = 0; m < 4; ++m) { const int row = row0 + ai * HALF + m * 16; float sq = 0.f;
#pragma unroll
                for (int bj = 0; bj < 2; ++bj) { const int col = col0 + bj * HALF; f32x4* xp = (f32x4*)(X + (size_t)row * DM + col);
                    const f32x4 x0 = xp[0] + acc[ai][bj][m][0], x1 = xp[1] + acc[ai][bj][m][1];
                    xp[0] = x0; xp[1] = x1;
                    u32x4 w; w.x = cvtpk(x0[0], x0[1]); w.y = cvtpk(x0[2], x0[3]); w.z = cvtpk(x1[0], x1[1]); w.w = cvtpk(x1[2], x1[3]);
                    *(u32x4*)(XB + (size_t)row * DM + col) = w;
                    sq += (x0[0] * x0[0] + x0[1] * x0[1]) + (x0[2] * x0[2] + x0[3] * x0[3]) + (x1[0] * x1[0] + x1[1] * x1[1]) + (x1[2] * x1[2] + x1[3] * x1[3]); }
                sq = x16_sum(sq); sq = x32_sum(sq);
                if (fq == 0) ssq[(size_t)row * 16 + u.pn * 4 + wc] = sq; if (m & 1) asm volatile("" ::: "memory"); }
    }
};

struct EpiUp {
    static constexpr bool PERM = true;
    const float* ssq; bf16_t* H;
    __device__ __forceinline__ void operator()(const f32x4 (&acc)[2][2][4][2], const Unit& u, int wr, int wc, int fr, int fq) const {
        const int row0 = u.pm * BM + wr * 64 + fr; const int col0 = u.pn * BM + wc * 32 + 8 * fq;
        float rs[2][4];
#pragma unroll
        for (int ai = 0; ai < 2; ++ai)
#pragma unroll
            for (int m = 0; m < 4; ++m) rs[ai][m] = row_rstd(ssq, row0 + ai * HALF + m * 16, fq);
#pragma unroll
        for (int ai = 0; ai < 2; ++ai)
#pragma unroll
            for (int m = 0; m < 4; ++m) { const int row = row0 + ai * HALF + m * 16; const float s = rs[ai][m];
#pragma unroll
                for (int bj = 0; bj < 2; ++bj) { f32x4 v0 = acc[ai][bj][m][0] * s, v1 = acc[ai][bj][m][1] * s;
#pragma unroll
                    for (int i = 0; i < 4; ++i) { const float a = fmaxf(v0[i], 0.f), b = fmaxf(v1[i], 0.f); v0[i] = a * a; v1[i] = b * b; }
                    u32x4 w; w.x = cvtpk(v0[0], v0[1]); w.y = cvtpk(v0[2], v0[3]); w.z = cvtpk(v1[0], v1[1]); w.w = cvtpk(v1[2], v1[3]);
                    *(u32x4*)(H + (size_t)row * DFF + col0 + bj * HALF) = w; } }
    }
};
}

__device__ __forceinline__ int win_src(int n) {
    if (n < 3840) return n;
    if (n < 4608) return n + 4;
    if (n < 4864) return (n - 4608 < 4) ? 3840 + (n - 4608) : -1;
    return n - 4864 + 4612;
}
template <int CMAP>
__device__ __forceinline__ void transpose_item(const float* W, int K, int N, int Nsrc, const float* gain, bf16_t* WT, LAS float* scr, int item, int lane) {
    const int nblk = N / 32, kb = item / nblk, nb = item % nblk, k0 = 64 * kb, n0 = 32 * nb;
    const int n = n0 + (lane & 31); const int src = CMAP ? win_src(n) : n;
    const bool live = (src >= 0); const float* wp = W + (size_t)(k0 + (lane >> 5)) * Nsrc + (live ? src : 0); const float* gp = gain ? gain + k0 + (lane >> 5) : nullptr;
    float wv[32];
#pragma unroll
    for (int i = 0; i < 32; ++i) wv[i] = wp[(size_t)(2 * i) * Nsrc];
#pragma unroll
    for (int i = 0; i < 32; ++i) { float v = live ? wv[i] : 0.f; if (gp) v *= gp[2 * i]; scr[(2 * i + (lane >> 5)) * 33 + (lane & 31)] = v; }
    asm volatile("s_waitcnt lgkmcnt(0)" ::: "memory");
    const int c = lane & 7;
#pragma unroll
    for (int j = 0; j < 4; ++j) { const int nn = (lane >> 3) + 8 * j; const LAS float* s = scr + (8 * c) * 33 + nn;
        u32x4 o; o.x = cvtpk(s[0 * 33], s[1 * 33]); o.y = cvtpk(s[2 * 33], s[3 * 33]); o.z = cvtpk(s[4 * 33], s[5 * 33]); o.w = cvtpk(s[6 * 33], s[7 * 33]);
        *(u32x4*)(WT + (size_t)(n0 + nn) * K + k0 + 8 * c) = o; }
    asm volatile("s_waitcnt lgkmcnt(0)" ::: "memory");
}

__device__ __forceinline__ void branch_item(const float* Wn, int n, bf16_t* WBP, LAS float* scr, int item, int lane) {
    const int kb = item >> 5, nb = item & 31, k0 = 64 * kb, n0 = 32 * nb;
    const float* wp = Wn + (size_t)(k0 + (lane >> 5)) * DM + n0 + (lane & 31);
    float wv[32];
#pragma unroll
    for (int i = 0; i < 32; ++i) wv[i] = wp[(size_t)(2 * i) * DM];
#pragma unroll
    for (int i = 0; i < 32; ++i) scr[(2 * i + (lane >> 5)) * 33 + (lane & 31)] = wv[i];
    asm volatile("s_waitcnt lgkmcnt(0)" ::: "memory");
    const int c = lane & 7, bj = n & 1, pair = n >> 1;
    const u32x4 zero = {0u, 0u, 0u, 0u};
#pragma unroll
    for (int j = 0; j < 4; ++j) { const int nn = (lane >> 3) + 8 * j; const LAS float* sp = scr + (8 * c) * 33 + nn; const int d = n0 + nn;
        u32x4 o; o.x = cvtpk(sp[0 * 33], sp[1 * 33]); o.y = cvtpk(sp[2 * 33], sp[3 * 33]); o.z = cvtpk(sp[4 * 33], sp[5 * 33]); o.w = cvtpk(sp[6 * 33], sp[7 * 33]);
        bf16_t* row = WBP + ((size_t)((pair * 8 + (d >> 7)) * 256 + bj * 128 + (d & 127))) * 512 + k0 + 8 * c;
        *(u32x4*)(row + 256 * bj) = o; *(u32x4*)(row + 256 * (1 - bj)) = zero; }
    asm volatile("s_waitcnt lgkmcnt(0)" ::: "memory");
}

#define MFMA32(a, b, c) __builtin_amdgcn_mfma_f32_32x32x16_bf16((a), (b), (c), 0, 0, 0)
__device__ __forceinline__ bf16x8 ld16(const bf16_t* p) { return *(const bf16x8*)p; }
__device__ __forceinline__ bf16x8 pack8(const f32x16& s, int b) { u32x4 w; w.x = cvtpk(s[b], s[b + 1]); w.y = cvtpk(s[b + 2], s[b + 3]); w.z = cvtpk(s[b + 4], s[b + 5]); w.w = cvtpk(s[b + 6], s[b + 7]); return __builtin_bit_cast(bf16x8, w); }
__device__ __forceinline__ int crow(int r, int hi) { return (r & 3) + 8 * (r >> 2) + 4 * hi; }
__device__ __forceinline__ void store_o(bf16_t* orow, const f32x16& o0, const f32x16& o1, int hi) {
#pragma unroll
    for (int g = 0; g < 4; ++g) {
        u32x2 a; a.x = cvtpk(o0[4 * g], o0[4 * g + 1]); a.y = cvtpk(o0[4 * g + 2], o0[4 * g + 3]); *(u32x2*)(orow + 8 * g + 4 * hi) = a;
        u32x2 b; b.x = cvtpk(o1[4 * g], o1[4 * g + 1]); b.y = cvtpk(o1[4 * g + 2], o1[4 * g + 3]); *(u32x2*)(orow + 32 + 8 * g + 4 * hi) = b; }
}

struct KFrag { bf16x8 k[4]; };
struct VFrag { bf16x8 v[4]; };
__device__ __forceinline__ void k_load(KFrag& f, const bf16_t* Ks, int kb, int r32, int hi) {
    const bf16_t* kp = Ks + (size_t)(kb * 32 + r32) * LDQK + hi * 8;
#pragma unroll
    for (int ds = 0; ds < 4; ++ds) f.k[ds] = ld16(kp + ds * 16);
}
__device__ __forceinline__ void v_load(VFrag& f, const bf16_t* VTs, int kb, int r32, int hi) {
    const bf16_t* vp = VTs + (size_t)r32 * SEQ + kb * 32 + hi * 8;
    f.v[0] = ld16(vp); f.v[1] = ld16(vp + 16); f.v[2] = ld16(vp + 32 * SEQ); f.v[3] = ld16(vp + 32 * SEQ + 16);
}
__device__ __forceinline__ void q_load(bf16x8 (&qf)[4], const bf16_t* Qs, int qb, int r32, int hi) {
    const bf16_t* qp = Qs + (size_t)(qb * 32 + r32) * LDQK + hi * 8;
#pragma unroll
    for (int ds = 0; ds < 4; ++ds) qf[ds] = ld16(qp + ds * 16);
}

template <int MODE>
__device__ __forceinline__ void sm_unit(const bf16_t* Qs, const bf16_t* Ks, const bf16_t* VTs, int qb, int kb_lo, float slope2, const LAS float* cl,
                                        f32x16& o0, f32x16& o1, float& m_out, float& l_out, int lane) {
    const int r32 = lane & 31, hi = lane >> 5;
    constexpr float SC2 = 0.125f * LOG2E;
    bf16x8 qf[4]; q_load(qf, Qs, qb, r32, hi);
    KFrag nx; k_load(nx, Ks, qb, r32, hi);
    float m = -INFINITY, l = 0.f;
#pragma unroll
    for (int i = 0; i < 16; ++i) { o0[i] = 0.f; o1[i] = 0.f; }
    for (int kb = qb; kb >= kb_lo; --kb) {
        const KFrag cu = nx; VFrag cv; v_load(cv, VTs, kb, r32, hi);
        if (kb > kb_lo) k_load(nx, Ks, kb - 1, r32, hi);
        f32x16 s;
#pragma unroll
        for (int i = 0; i < 16; ++i) s[i] = 0.f;
#pragma unroll
        for (int ds = 0; ds < 4; ++ds) s = MFMA32(cu.k[ds], qf[ds], s);
        const int d0 = (qb - kb) * 32 + r32;
        if (MODE == 0) {
#pragma unroll
            for (int r = 0; r < 16; ++r) { const float v = s[r] * SC2 + cl[33 * kb + crow(r, hi)]; s[r] = (crow(r, hi) <= d0) ? v : -INFINITY; }
        } else {
#pragma unroll
            for (int r = 0; r < 16; ++r) { const int dist = d0 - crow(r, hi); const float v = s[r] * SC2 - slope2 * (float)dist; s[r] = ((unsigned)dist <= 128u) ? v : -INFINITY; }
        }
        float mt = fmaxf(fmaxf(s[0], s[1]), fmaxf(s[2], s[3]));
#pragma unroll
        for (int r = 4; r < 16; r += 4) mt = fmaxf(mt, fmaxf(fmaxf(s[r], s[r + 1]), fmaxf(s[r + 2], s[r + 3])));
        mt = x32_max(mt);
        const float mn = fmaxf(m, mt), alpha = ex2(m - mn);
        float ps = 0.f;
#pragma unroll
        for (int r = 0; r < 16; ++r) { const float p = ex2(s[r] - mn); s[r] = p; ps += p; }
        l = l * alpha + ps; m = mn;
#pragma unroll
        for (int i = 0; i < 16; ++i) { o0[i] *= alpha; o1[i] *= alpha; }
        const bf16x8 pf0 = pack8(s, 0), pf1 = pack8(s, 8);
        o0 = MFMA32(cv.v[0], pf0, o0); o0 = MFMA32(cv.v[1], pf1, o0); o1 = MFMA32(cv.v[2], pf0, o1); o1 = MFMA32(cv.v[3], pf1, o1);
    }
    l = x32_sum(l);
    m_out = m; l_out = l;
}

__device__ __forceinline__ void diff_unit(const bf16_t* Qs, const bf16_t* Ks, const bf16_t* VTs, int qb, float slope2, float lam, f32x16& r0, f32x16& r1, int lane) {
    const int r32 = lane & 31, hi = lane >> 5;
    constexpr float SC2 = 0.17677669529663687f * LOG2E;
    bf16x8 qf[4]; q_load(qf, Qs, qb, r32, hi);
    KFrag nx; k_load(nx, Ks, qb, r32, hi);
    float m[2] = {-INFINITY, -INFINITY}, l[2] = {0.f, 0.f};
    f32x16 o[2][2];
#pragma unroll
    for (int i = 0; i < 16; ++i) { o[0][0][i] = 0.f; o[0][1][i] = 0.f; o[1][0][i] = 0.f; o[1][1][i] = 0.f; }
    for (int kb = qb; kb >= 0; --kb) {
        const KFrag cu = nx; VFrag cv; v_load(cv, VTs, kb, r32, hi);
        if (kb > 0) k_load(nx, Ks, kb - 1, r32, hi);
        const int d0 = (qb - kb) * 32 + r32;
#pragma unroll
        for (int c = 0; c < 2; ++c) {
            f32x16 s;
#pragma unroll
            for (int i = 0; i < 16; ++i) s[i] = 0.f;
            s = MFMA32(cu.k[2 * c], qf[2 * c], s); s = MFMA32(cu.k[2 * c + 1], qf[2 * c + 1], s);
#pragma unroll
            for (int r = 0; r < 16; ++r) { const int dist = d0 - crow(r, hi); const float v = s[r] * SC2 - slope2 * (float)dist; s[r] = (dist >= 0) ? v : -INFINITY; }
            float mt = fmaxf(fmaxf(s[0], s[1]), fmaxf(s[2], s[3]));
#pragma unroll
            for (int r = 4; r < 16; r += 4) mt = fmaxf(mt, fmaxf(fmaxf(s[r], s[r + 1]), fmaxf(s[r + 2], s[r + 3])));
            mt = x32_max(mt);
            const float mn = fmaxf(m[c], mt), alpha = ex2(m[c] - mn);
            float ps = 0.f;
#pragma unroll
            for (int r = 0; r < 16; ++r) { const float p = ex2(s[r] - mn); s[r] = p; ps += p; }
            l[c] = l[c] * alpha + ps; m[c] = mn;
#pragma unroll
            for (int i = 0; i < 16; ++i) { o[c][0][i] *= alpha; o[c][1][i] *= alpha; }
            const bf16x8 pf0 = pack8(s, 0), pf1 = pack8(s, 8);
            o[c][0] = MFMA32(cv.v[0], pf0, o[c][0]); o[c][0] = MFMA32(cv.v[1], pf1, o[c][0]); o[c][1] = MFMA32(cv.v[2], pf0, o[c][1]); o[c][1] = MFMA32(cv.v[3], pf1, o[c][1]);
        }
    }
    l[0] = x32_sum(l[0]); l[1] = x32_sum(l[1]);
    const float i0 = 1.0f / l[0], i1 = lam / l[1];
#pragma unroll
    for (int i = 0; i < 16; ++i) { r0[i] = o[0][0][i] * i0 - o[1][0][i] * i1; r1[i] = o[0][1][i] * i0 - o[1][1][i] * i1; }
}

__device__ __forceinline__ void sb_unit(const bf16_t* Qs, const bf16_t* Ks, const bf16_t* VTs, int qb, f32x16& o0, f32x16& o1, int lane) {
    const int r32 = lane & 31, hi = lane >> 5;
    constexpr float SC2 = 0.125f * LOG2E;
    bf16x8 qf[4]; q_load(qf, Qs, qb, r32, hi);
    KFrag nx; k_load(nx, Ks, qb, r32, hi);
    float R = 0.f;
#pragma unroll
    for (int i = 0; i < 16; ++i) { o0[i] = 0.f; o1[i] = 0.f; }
    for (int kb = qb; kb >= 0; --kb) {
        const KFrag cu = nx; VFrag cv; v_load(cv, VTs, kb, r32, hi);
        if (kb > 0) k_load(nx, Ks, kb - 1, r32, hi);
        f32x16 s;
#pragma unroll
        for (int i = 0; i < 16; ++i) s[i] = 0.f;
#pragma unroll
        for (int ds = 0; ds < 4; ++ds) s = MFMA32(cu.k[ds], qf[ds], s);
        float lk[16], ls[16];
        const int d0 = (qb - kb) * 32 + r32;
#pragma unroll
        for (int r = 0; r < 16; ++r) { const float z2 = s[r] * SC2; const float sp = fmaxf(z2, 0.f) + lg2(1.0f + ex2(-fabsf(z2))); const bool valid = crow(r, hi) < d0; lk[r] = valid ? -sp : 0.f; ls[r] = valid ? (z2 - sp) : -INFINITY; }
        float e[16], tq[4], pq[4];
#pragma unroll
        for (int g = 0; g < 4; ++g) { e[4 * g + 3] = 0.f; e[4 * g + 2] = lk[4 * g + 3]; e[4 * g + 1] = e[4 * g + 2] + lk[4 * g + 2]; e[4 * g] = e[4 * g + 1] + lk[4 * g + 1]; tq[g] = e[4 * g] + lk[4 * g]; }
#pragma unroll
        for (int g = 0; g < 4; ++g) pq[g] = x32_partner(tq[g], hi);
        float cs[4]; cs[3] = 0.f; cs[2] = tq[3] + pq[3]; cs[1] = cs[2] + (tq[2] + pq[2]); cs[0] = cs[1] + (tq[1] + pq[1]);
        const float total = cs[0] + (tq[0] + pq[0]);
#pragma unroll
        for (int g = 0; g < 4; ++g) { const float later = R + cs[g] + (hi == 0 ? pq[g] : 0.f);
#pragma unroll
            for (int i = 0; i < 4; ++i) s[4 * g + i] = ex2(ls[4 * g + i] + e[4 * g + i] + later); }
        R += total;
        const bf16x8 pf0 = pack8(s, 0), pf1 = pack8(s, 8);
        o0 = MFMA32(cv.v[0], pf0, o0); o0 = MFMA32(cv.v[1], pf1, o0); o1 = MFMA32(cv.v[2], pf0, o1); o1 = MFMA32(cv.v[3], pf1, o1);
        if (__all(R < -150.0f)) break;
    }
}

#define XB_TMO      128
#define XB_XCNT(j)  (256  + 64 * (j))
#define XB_XSUB(j)  (1280 + 64 * (j))
#define XB_XGEN(j)  (2304 + 64 * (j))
#define XB_TOP      3328
#define XB_TOPGEN   3392
#define XCD_BAR_WORDS 3456
#define XB_SPIN_CAP (1u << 18)
__device__ __forceinline__ unsigned xb_ld(unsigned* p)              { return __hip_atomic_load(p, __ATOMIC_RELAXED, __HIP_MEMORY_SCOPE_AGENT); }
__device__ __forceinline__ unsigned xb_add(unsigned* p, unsigned v) { return __hip_atomic_fetch_add(p, v, __ATOMIC_RELAXED, __HIP_MEMORY_SCOPE_AGENT); }
__device__ __forceinline__ unsigned xb_xcc_id() { return (unsigned)__builtin_amdgcn_s_getreg((3 << 11) | 20) & 0xFu; }
#define XB_SPIN(cond, bar) do { unsigned _sp = 0; while (cond) { __builtin_amdgcn_s_sleep(1); \
    if ((++_sp & 255u) == 0u) { if (xb_ld(&(bar)[XB_TMO])) break; if (_sp > XB_SPIN_CAP) { atomicAdd(&(bar)[XB_TMO], 1u); break; } } } } while (0)
__device__ __forceinline__ void xcd_barrier_complete(unsigned* bar, unsigned x, unsigned& nloc, unsigned& nx) {
    const unsigned G = gridDim.x * gridDim.y * gridDim.z;
    unsigned sum, cnt, mine, sp = 0u;
    for (;;) {
        sum = 0u; cnt = 0u; mine = 0u;
#pragma unroll
        for (unsigned j = 0; j < 16; ++j) { const unsigned c = xb_ld(&bar[XB_XCNT(j)]); sum += c; cnt += (c > 0u) ? 1u : 0u; mine = (j == x) ? c : mine; }
        if (sum == G) break;
        __builtin_amdgcn_s_sleep(1);
        if ((++sp & 255u) == 0u) { if (xb_ld(&bar[XB_TMO])) break; if (sp > XB_SPIN_CAP) { atomicAdd(&bar[XB_TMO], 1u); break; } }
    }
    nloc = mine > 0u ? mine : 1u; nx = cnt > 0u ? cnt : 1u;
}
__device__ __forceinline__ void xcd_barrier(unsigned* bar, volatile LAS unsigned* st) {
    asm volatile("s_waitcnt vmcnt(0)" ::: "memory");
    __syncthreads();
    if (threadIdx.x == 0) {
        const unsigned x = xb_xcc_id();
        __builtin_amdgcn_s_waitcnt(0);
        unsigned nloc = st[0], nx = st[1];
        if (nloc == 0u) { xcd_barrier_complete(bar, x, nloc, nx); st[0] = nloc; st[1] = nx; }
        const unsigned old = xb_add(&bar[XB_XSUB(x)], 1u);
        const unsigned gen = old / nloc;
        if (old + 1u == (gen + 1u) * nloc) {
            __builtin_amdgcn_fence(__ATOMIC_RELEASE, "agent");
            asm volatile("s_waitcnt vmcnt(0)" ::: "memory");
            const unsigned og = xb_add(&bar[XB_TOP], 1u);
            const unsigned tg = og / nx;
            if (og + 1u == (tg + 1u) * nx) xb_add(&bar[XB_TOPGEN], 1u);
            else XB_SPIN(xb_ld(&bar[XB_TOPGEN]) == tg, bar);
            __builtin_amdgcn_fence(__ATOMIC_ACQUIRE, "agent");
            xb_add(&bar[XB_XGEN(x)], 1u);
            asm volatile("s_waitcnt vmcnt(0)" ::: "memory");
        } else {
            XB_SPIN(xb_ld(&bar[XB_XGEN(x)]) == gen, bar);
            __builtin_amdgcn_fence(__ATOMIC_ACQUIRE, "agent");
            asm volatile("s_waitcnt vmcnt(0)" ::: "memory");
        }
    }
    __syncthreads();
}
constexpr int MISC_OFF = 131072 + 320;

struct Params {
    const float* x; const float* mix_g; const float* w_in; const float* b_forget; const float* lq1; const float* lk1; const float* lq2; const float* lk2;
    const float* diff_g; const float* w_branch; const float* w_out; const float* mlp_g; const float* w_up; const float* w_down; const float* final_g;
    float* out; unsigned char* ws;
};

#ifndef REP_P1
#define REP_P1 1
#endif
#ifndef REP_P2
#define REP_P2 1
#endif
#ifndef REP_P3
#define REP_P3 1
#endif
#ifndef REP_P5
#define REP_P5 1
#endif
#ifndef REP_SYNC
#define REP_SYNC 1
#endif
#ifndef REP_CONV
#define REP_CONV 1
#endif
#define GSYNC() do { for (int rs_ = 0; rs_ < REP_SYNC; ++rs_) { KParamsPtr pb_ = OPQ_PP(); xcd_barrier((unsigned*)(pb_->ws + WS_CTL) + CW_BAR, (volatile LAS unsigned*)(lds + MISC_OFF)); } } while (0)
#define OPQ_TID() ({ int t_ = threadIdx.x; asm volatile("" : "+v"(t_)); t_; })
typedef const __attribute__((address_space(4))) Params* KParamsPtr;
#define OPQ_PP() ({ KParamsPtr p_ = (KParamsPtr)__builtin_amdgcn_kernarg_segment_ptr(); asm volatile("" : "+s"(p_)); p_; })
#define PHASE_VARS() const int tid = OPQ_TID(); const int lane = tid & 63, wave = __builtin_amdgcn_readfirstlane(tid >> 6); const int G = gridDim.x, bx = blockIdx.x; \
    const int gw = bx * NWAVES + wave, NGW = G * NWAVES; KParamsPtr PP = OPQ_PP(); unsigned char* ws = PP->ws; LAS float* scr = (LAS float*)(lds + wave * 16384); (void)lane; (void)gw; (void)NGW; (void)ws; (void)scr; (void)G; (void)bx; (void)PP

__global__ void __launch_bounds__(NWAVES * 64, 2) fwd_mega(Params P) {
    extern __shared__ __attribute__((aligned(16))) unsigned char lds_raw[];
    LAS unsigned char* lds = (LAS unsigned char*)lds_raw;
    cg::grid_group grid = cg::this_grid();
    { const int t0 = OPQ_TID(); if (t0 < 64) ((LAS unsigned*)(lds + 131072))[t0 + 64] = 0u; __syncthreads();
      if (t0 == 0) { KParamsPtr p0 = OPQ_PP(); (void)xb_add((unsigned*)(p0->ws + WS_CTL) + CW_BAR + XB_XCNT(xb_xcc_id()), 1u); } }

    {
        PHASE_VARS();
        float* X = PP->out; bf16_t* XB = (bf16_t*)(ws + WS_XB); float* SSQ = (float*)(ws + WS_SSQ);
        for (int row = gw; row < TOK; row += NGW) {
            const f32x4* xr = (const f32x4*)(PP->x + (size_t)row * DM) + lane; f32x4* xo = (f32x4*)(X + (size_t)row * DM) + lane;
            unsigned long long* o8 = (unsigned long long*)(XB + (size_t)row * DM) + lane;
            float s = 0.f;
#pragma unroll
            for (int j = 0; j < 4; ++j) { const f32x4 v = xr[64 * j]; xo[64 * j] = v; s += (v[0] * v[0] + v[1] * v[1]) + (v[2] * v[2] + v[3] * v[3]);
                o8[64 * j] = (unsigned long long)cvtpk(v[0], v[1]) | ((unsigned long long)cvtpk(v[2], v[3]) << 32); }
            s = wave_sum(s);
            if (lane < 16) SSQ[(size_t)row * 16 + lane] = (lane == 0) ? s : 0.f;
        }
    }

    for (int layer = 0; layer < DEPTH; ++layer) {
        for (int rep = 0; rep < REP_CONV; ++rep) {
            PHASE_VARS();
            bf16_t* WIN = (bf16_t*)(ws + WS_WIN); bf16_t* WB = (bf16_t*)(ws + WS_WB); bf16_t* WOUT = (bf16_t*)(ws + WS_WOUT);
            const float* w_in = PP->w_in + (size_t)layer * DM * DIN; const float* mg = PP->mix_g + (size_t)layer * DM;
            const float* wb = PP->w_branch + (size_t)layer * 4 * 256 * DM; const float* wo = PP->w_out + (size_t)layer * DM * DM;
            constexpr int I_IN = (DM / 64) * (NPROJ / 32), I_B = (256 / 64) * (DM / 32), I_O = (DM / 64) * (DM / 32);
            for (int it = gw; it < I_IN + 4 * I_B + I_O; it += NGW) {
                int r = it;
                if (r < I_IN) { transpose_item<1>(w_in, DM, NPROJ, DIN, mg, WIN, scr, r, lane); continue; } r -= I_IN;
                if (r < 4 * I_B) { const int n = r / I_B; branch_item(wb + (size_t)n * 256 * DM, n, WB, scr, r % I_B, lane); continue; } r -= 4 * I_B;
                transpose_item<0>(wo, DM, DM, DM, nullptr, WOUT, scr, r, lane);
            }
        }
        if (layer == 0) grid.sync(); else GSYNC();

        for (int half = 0; half < 2; ++half) {
#ifndef NO_P1
            for (int rep = 0; rep < REP_P1; ++rep) {
                PHASE_VARS();
                const int rb = half * HT;
                pg8::Gemm g{(const bf16_t*)(ws + WS_XB) + (size_t)rb * DM, (const bf16_t*)(ws + WS_WIN), DM, DM, DM, 0, 0};
                pg8::StaticOrder S; S.init(HT, NPROJ, G, bx);
                pg8::EpiProj E{(const float*)(ws + WS_SSQ), rb, (bf16_t*)(ws + WS_QK), (bf16_t*)(ws + WS_VT), (float*)(ws + WS_FL), (bf16_t*)(ws + WS_GATE)};
                pg8::gemm_phase<pg8::EpiProj, pg8::StaticOrder, true>(lds, g, S, E);
            }
#endif
            GSYNC();
#ifndef NO_P2
            for (int rep = 0; rep < REP_P2; ++rep) {
                PHASE_VARS();
                const float lam_init = (layer == 0) ? 0.2f : 0.35550906759093115f;
                unsigned* ctr = (unsigned*)(ws + WS_CTL) + 64 * (1 + layer * 2 + half + 4 * rep);
                const int r32 = lane & 31, hi = lane >> 5;
                float lam;
                { const float a = (lane < 32) ? PP->lq1[layer * 32 + lane] * PP->lk1[layer * 32 + lane] : 0.f, b = (lane < 32) ? PP->lq2[layer * 32 + lane] * PP->lk2[layer * 32 + lane] : 0.f;
                  lam = __expf(wave_sum(a)) - __expf(wave_sum(b)) + lam_init; }
                for (;;) {
                    int idx = 0; if (lane == 0) idx = (int)atomicAdd(ctr, 1u); idx = __builtin_amdgcn_readfirstlane(idx);
                    if (idx >= 6144) break;
                    KParamsPtr PU = OPQ_PP(); unsigned char* wsu = PU->ws;
                    bf16_t* YS = (bf16_t*)(wsu + WS_YS); bf16_t* DILO = (bf16_t*)(wsu + WS_DILO); float* LSE = (float*)(wsu + WS_LSE); const float* FL = (const float*)(wsu + WS_FL);
                    const bf16_t* QK = (const bf16_t*)(wsu + WS_QK); const bf16_t* VT = (const bf16_t*)(wsu + WS_VT);
                    if (idx < 3072) {
                        int qb, type, bh;
                        if (idx < 2048) { qb = 63 - (idx >> 5); type = 1 + ((idx >> 4) & 1); bh = idx & 15; } else { const int i1 = idx - 2048; qb = 63 - (i1 >> 4); type = 0; bh = i1 & 15; }
                        const int b = bh >> 2, h = bh & 3;
                        const size_t rowb = (size_t)b * SEQ;
                        const int t = qb * 32 + r32;
                        if (type == 0) {
                            f32x16 o0, o1;
                            sb_unit(QK + rowb * LDQK + 0 * 256 + h * 64, QK + rowb * LDQK + 1 * 256 + h * 64, VT + ((size_t)(b * 24 + h) * 64) * SEQ, qb, o0, o1, lane);
                            store_o(YS + (rowb + t) * DM + 0 * 256 + h * 64, o0, o1, hi);
                        } else if (type == 1) {
                            const float slope = exp2f(-8.0f * (float)(5 + h) / 16.0f);
                            f32x16 r0, r1;
                            diff_unit(QK + rowb * LDQK + 10 * 256 + h * 64, QK + rowb * LDQK + 11 * 256 + h * 64, VT + ((size_t)(b * 24 + 20 + h) * 64) * SEQ, qb, slope * LOG2E, lam, r0, r1, lane);
                            float ss = 0.f;
#pragma unroll
                            for (int i = 0; i < 16; ++i) ss += r0[i] * r0[i] + r1[i] * r1[i];
                            ss = x32_sum(ss);
                            const float rn = __builtin_amdgcn_rsqf(ss * (1.0f / 64.0f) + RMS_EPS) * (1.0f - lam_init);
                            const float* dg = PP->diff_g + layer * 64;
#pragma unroll
                            for (int i = 0; i < 16; ++i) { const int d = crow(i, hi); r0[i] *= rn * dg[d]; r1[i] *= rn * dg[32 + d]; }
                            store_o(YS + (rowb + t) * DM + 3 * 256 + h * 64, r0, r1, hi);
                        } else {
                            LAS float* cl = scr;
                            const float bf = PP->b_forget[layer * 4 + h];
                            float run = 0.f;
                            if (lane <= qb) {
                                const float* fp = FL + (rowb + 32 * lane) * 4 + h;
#pragma unroll 8
                                for (int i = 0; i < 32; ++i) { const float y = fp[4 * i] + bf; const float lf = fminf(y, 0.f) - __logf(1.0f + __expf(-fabsf(y))); run += lf; cl[33 * lane + i] = run; }
                            }
                            float incl = run;
#pragma unroll
                            for (int o = 1; o < 64; o <<= 1) { const float tt = __uint_as_float((unsigned)__builtin_amdgcn_ds_bpermute((lane - o) << 2, (int)__float_as_uint(incl))); if (lane >= o) incl += tt; }
                            const float excl = incl - run;
                            if (lane <= qb) {
#pragma unroll 8
                                for (int i = 0; i < 32; ++i) cl[33 * lane + i] = -(cl[33 * lane + i] + excl) * LOG2E;
                            }
                            asm volatile("s_waitcnt lgkmcnt(0)" ::: "memory");
                            f32x16 o0, o1; float m, l;
                            sm_unit<0>(QK + rowb * LDQK + 8 * 256 + h * 64, QK + rowb * LDQK + 9 * 256 + h * 64, VT + ((size_t)(b * 24 + 16 + h) * 64) * SEQ, qb, 0, 0.f, cl, o0, o1, m, l, lane);
                            const float inv = 1.0f / l;
#pragma unroll
                            for (int i = 0; i < 16; ++i) { o0[i] *= inv; o1[i] *= inv; }
                            store_o(YS + (rowb + t) * DM + 2 * 256 + h * 64, o0, o1, hi);
                            asm volatile("s_waitcnt lgkmcnt(0)" ::: "memory");
                        }
                    } else {
                        const int i2 = idx - 3072, j = i2 & 63, gh = (i2 >> 6) % 12, b = i2 / 768, gI = gh >> 2, h = gh & 3;
                        const int rsh = 2 * gI, r = 1 << rsh, sl = SEQ >> rsh, nubsh = 6 - rsh, rho = j >> nubsh, ub = j & ((1 << nubsh) - 1);
                        const int sidx = (gI == 0) ? h : (gI == 1 ? 8 + h : 12 + h);
                        const float slope = exp2f(-8.0f * (float)(sidx + 1) / 16.0f);
                        const size_t rowb = (size_t)b * SEQ + (size_t)rho * sl;
                        f32x16 o0, o1; float m, l;
                        const int kb_lo = (ub - 4 > 0) ? ub - 4 : 0;
                        sm_unit<1>(QK + rowb * LDQK + (2 + gI) * 256 + h * 64, QK + rowb * LDQK + (5 + gI) * 256 + h * 64,
                                   VT + ((size_t)(b * 24 + 4 + 4 * gI + h) * 64) * SEQ + (size_t)rho * sl, ub, kb_lo, slope * (float)r * LOG2E, nullptr, o0, o1, m, l, lane);
                        const float inv = 1.0f / l;
#pragma unroll
                        for (int i = 0; i < 16; ++i) { o0[i] *= inv; o1[i] *= inv; }
                        const int u = ub * 32 + r32; const size_t tok = (size_t)b * SEQ + (size_t)u * r + rho;
                        store_o(DILO + tok * 768 + gI * 256 + h * 64, o0, o1, hi);
                        if (hi == 0) LSE[tok * 12 + gI * 4 + h] = (m + lg2(l)) * LN2;
                    }
                }
            }
#endif
            GSYNC();
            {
                PHASE_VARS();
                bf16_t* YS = (bf16_t*)(ws + WS_YS); const bf16_t* DILO = (const bf16_t*)(ws + WS_DILO); const float* LSE = (const float*)(ws + WS_LSE);
                for (int row = gw; row < HT; row += NGW) {
                    const int h = lane >> 4;
                    const float l0 = LSE[(size_t)row * 12 + h], l1 = LSE[(size_t)row * 12 + 4 + h], l2 = LSE[(size_t)row * 12 + 8 + h];
                    const float mx = fmaxf(l0, fmaxf(l1, l2)); const float e0 = __expf(l0 - mx), e1 = __expf(l1 - mx), e2 = __expf(l2 - mx); const float inv = 1.0f / (e0 + e1 + e2);
                    const u32x2 a = *(const u32x2*)(DILO + (size_t)row * 768 + 4 * lane), b = *(const u32x2*)(DILO + (size_t)row * 768 + 256 + 4 * lane), c = *(const u32x2*)(DILO + (size_t)row * 768 + 512 + 4 * lane);
                    const float w0 = e0 * inv, w1 = e1 * inv, w2 = e2 * inv;
                    u32x2 o; o.x = cvtpk(w0 * bflo(a.x) + w1 * bflo(b.x) + w2 * bflo(c.x), w0 * bfhi(a.x) + w1 * bfhi(b.x) + w2 * bfhi(c.x));
                    o.y = cvtpk(w0 * bflo(a.y) + w1 * bflo(b.y) + w2 * bflo(c.y), w0 * bfhi(a.y) + w1 * bfhi(b.y) + w2 * bfhi(c.y));
                    *(u32x2*)(YS + (size_t)row * DM + 256 + 4 * lane) = o;
                }
            }
            GSYNC();
#ifndef NO_P3
            for (int rep = 0; rep < REP_P3; ++rep) {
                PHASE_VARS();
                pg8::Gemm g{(const bf16_t*)(ws + WS_YS), (const bf16_t*)(ws + WS_WB), DM, 512, 512, 512 * 2, (long)8 * 256 * 512 * 2};
                pg8::BranchOrder S{bx, G};
                pg8::EpiBranch E{(const bf16_t*)(ws + WS_GATE), (bf16_t*)(ws + WS_MERGED), half * HT};
                pg8::gemm_phase<pg8::EpiBranch, pg8::BranchOrder, false>(lds, g, S, E);
            }
#endif
            GSYNC();
        }
#ifndef NO_P4
        for (int rep = 0; rep < REP_CONV; ++rep) {
            PHASE_VARS();
            bf16_t* WUP = (bf16_t*)(ws + WS_WUP); bf16_t* WDN = (bf16_t*)(ws + WS_WDN);
            const float* wu = PP->w_up + (size_t)layer * DM * DFF; const float* wd = PP->w_down + (size_t)layer * DFF * DM; const float* mg = PP->mlp_g + (size_t)layer * DM;
            constexpr int I_U = (DM / 64) * (DFF / 32), I_D = (DFF / 64) * (DM / 32);
            for (int it = gw; it < I_U + I_D; it += NGW) {
                if (it < I_U) transpose_item<0>(wu, DM, DFF, DFF, mg, WUP, scr, it, lane);
                else transpose_item<0>(wd, DFF, DM, DM, nullptr, WDN, scr, it - I_U, lane);
            }
            __syncthreads();
        }
        {
            PHASE_VARS();
            pg8::Gemm g{(const bf16_t*)(ws + WS_MERGED), (const bf16_t*)(ws + WS_WOUT), DM, DM, DM, 0, 0};
            pg8::StaticOrder S; S.init(TOK, DM, G, bx);
            pg8::EpiResid E{PP->out, (bf16_t*)(ws + WS_XB), (float*)(ws + WS_SSQ)};
            pg8::gemm_phase<pg8::EpiResid, pg8::StaticOrder, false>(lds, g, S, E);
        }
#endif
        GSYNC();
#ifndef NO_P5
        for (int rep = 0; rep < REP_P5; ++rep) {
            PHASE_VARS();
            pg8::Gemm g{(const bf16_t*)(ws + WS_XB), (const bf16_t*)(ws + WS_WUP), DM, DM, DM, 0, 0};
            pg8::StaticOrder S; S.init(TOK, DFF, G, bx);
            pg8::EpiUp E{(const float*)(ws + WS_SSQ), (bf16_t*)(ws + WS_HMLP)};
            pg8::gemm_phase<pg8::EpiUp, pg8::StaticOrder, true>(lds, g, S, E);
        }
#endif
        GSYNC();
#ifndef NO_P6
        {
            PHASE_VARS();
            pg8::Gemm g{(const bf16_t*)(ws + WS_HMLP), (const bf16_t*)(ws + WS_WDN), DFF, DFF, DFF, 0, 0};
            pg8::StaticOrder S; S.init(TOK, DM, G, bx);
            pg8::EpiResid E{PP->out, (bf16_t*)(ws + WS_XB), (float*)(ws + WS_SSQ)};
            pg8::gemm_phase<pg8::EpiResid, pg8::StaticOrder, false>(lds, g, S, E);
        }
#endif
        GSYNC();
    }
    {
        PHASE_VARS();
        float* X = PP->out;
        for (int row = gw; row < TOK; row += NGW) {
            f32x4* xo = (f32x4*)(X + (size_t)row * DM) + lane; const f32x4* gp = (const f32x4*)PP->final_g + lane;
            f32x4 v[4]; float s = 0.f;
#pragma unroll
            for (int j = 0; j < 4; ++j) { v[j] = xo[64 * j]; s += (v[j][0] * v[j][0] + v[j][1] * v[j][1]) + (v[j][2] * v[j][2] + v[j][3] * v[j][3]); }
            const float rstd = __builtin_amdgcn_rsqf(wave_sum(s) * (1.0f / DM) + RMS_EPS);
#pragma unroll
            for (int j = 0; j < 4; ++j) xo[64 * j] = v[j] * rstd * gp[64 * j];
        }
    }
}

extern "C" void kernel_launch(void* const* d_in, const int* in_sizes, int n_in, void* d_out, int out_size, void* d_ws, size_t ws_size, hipStream_t stream) {
    static int grid = 0;
    if (grid == 0) {
        if (n_in != 15 || in_sizes[0] != TOK * DM || out_size != TOK * DM || ws_size < WS_END) { fprintf(stderr, "kernel_launch: unexpected shapes / workspace (n_in %d, ws %zu)\n", n_in, ws_size); grid = -1; return; }
        int dev = 0, cus = 0, per_cu = 0;
        hipGetDevice(&dev); hipDeviceGetAttribute(&cus, hipDeviceAttributeMultiprocessorCount, dev);
        hipFuncSetAttribute((const void*)fwd_mega, hipFuncAttributeMaxDynamicSharedMemorySize, LDS_BYTES);
        hipOccupancyMaxActiveBlocksPerMultiprocessor(&per_cu, (const void*)fwd_mega, NWAVES * 64, LDS_BYTES);
        (void)hipGetLastError();
        if (per_cu < 1) per_cu = 1;
        grid = cus;
        if (grid > 256) grid = 256;
    }
    if (grid < 0) return;
    hipMemsetAsync((char*)d_ws + WS_CTL, 0, CTL_BYTES, stream);
    Params p{};
    p.x = (const float*)d_in[0]; p.mix_g = (const float*)d_in[1]; p.w_in = (const float*)d_in[2]; p.b_forget = (const float*)d_in[3];
    p.lq1 = (const float*)d_in[4]; p.lk1 = (const float*)d_in[5]; p.lq2 = (const float*)d_in[6]; p.lk2 = (const float*)d_in[7];
    p.diff_g = (const float*)d_in[8]; p.w_branch = (const float*)d_in[9]; p.w_out = (const float*)d_in[10]; p.mlp_g = (const float*)d_in[11];
    p.w_up = (const float*)d_in[12]; p.w_down = (const float*)d_in[13]; p.final_g = (const float*)d_in[14];
    p.out = (float*)d_out; p.ws = (unsigned char*)d_ws;
    void* args[] = {&p};
    hipError_t e = hipLaunchCooperativeKernel((const void*)fwd_mega, dim3(grid), dim3(NWAVES * 64), args, LDS_BYTES, stream);
    if (e != hipSuccess) fprintf(stderr, "cooperative launch failed: %s (grid %d)\n", hipGetErrorString(e), grid);
}
```

```cpp
#include <hip/hip_runtime.h>
#include <hip/hip_cooperative_groups.h>
#include <cstdio>
#include <cstdint>
namespace cg = cooperative_groups;

#define LAS __attribute__((address_space(3)))
typedef unsigned short bf16_t;
typedef short bf16x8 __attribute__((ext_vector_type(8)));
typedef float f32x4 __attribute__((ext_vector_type(4)));
typedef float f32x16 __attribute__((ext_vector_type(16)));
typedef unsigned u32x4 __attribute__((ext_vector_type(4)));
typedef unsigned u32x2 __attribute__((ext_vector_type(2)));
typedef float f32x2_t __attribute__((ext_vector_type(2)));
typedef __bf16 bf16x2_t __attribute__((ext_vector_type(2)));

constexpr int DM = 1024, BATCH = 8, SEQ = 2048, DEPTH = 2, TOK = BATCH * SEQ, DFF = 4096, DIN = 8708;
constexpr int HT = TOK / 2;
constexpr int NPROJ = 35 * 256;
constexpr int LDQK = 12 * 256;
constexpr float LOG2E = 1.4426950408889634f, LN2 = 0.6931471805599453f;
constexpr float RMS_EPS = 1e-6f;

constexpr size_t MiB = 1u << 20;
constexpr size_t WS_CTL = 0, CTL_BYTES = 65536;
constexpr int CW_BAR = 4096;
constexpr size_t WS_SSQ = 1 * MiB;
constexpr size_t WS_WIN = 2 * MiB;
constexpr size_t WS_WUP = WS_WIN, WS_WDN = WS_WIN + 8 * MiB;
constexpr size_t WS_WB = 20 * MiB;
constexpr size_t WS_WOUT = 24 * MiB;
constexpr size_t WS_XB = 26 * MiB;
constexpr size_t WS_MERGED = 58 * MiB;
constexpr size_t WS_YS = 90 * MiB;
constexpr size_t WS_DILO = 106 * MiB;
constexpr size_t WS_LSE = 118 * MiB;
constexpr size_t WS_LSE2 = 118 * MiB + 512 * 1024;
constexpr size_t WS_FL = 119 * MiB + 512 * 1024;
constexpr size_t WS_QK = 120 * MiB;
constexpr size_t WS_VT = 168 * MiB;
constexpr size_t WS_GATE = 192 * MiB;
constexpr size_t WS_HMLP = 120 * MiB;
constexpr size_t WS_END = 256 * MiB;

constexpr int LDS_BYTES = 147456;
constexpr int NWAVES = 8;

__device__ __forceinline__ unsigned cvtpk(float lo, float hi) { f32x2_t v = {lo, hi}; bf16x2_t b = __builtin_convertvector(v, bf16x2_t); return __builtin_bit_cast(unsigned, b); }
__device__ __forceinline__ float bflo(unsigned w) { return __uint_as_float(w << 16); }
__device__ __forceinline__ float bfhi(unsigned w) { return __uint_as_float(w & 0xffff0000u); }
__device__ __forceinline__ float ex2(float x) { return __builtin_amdgcn_exp2f(x); }
__device__ __forceinline__ float lg2(float x) { return __builtin_amdgcn_logf(x); }
__device__ __forceinline__ float x32_sum(float v) { auto r = __builtin_amdgcn_permlane32_swap(__float_as_uint(v), __float_as_uint(v), false, false); return __uint_as_float(r[0]) + __uint_as_float(r[1]); }
__device__ __forceinline__ float x32_max(float v) { auto r = __builtin_amdgcn_permlane32_swap(__float_as_uint(v), __float_as_uint(v), false, false); return fmaxf(__uint_as_float(r[0]), __uint_as_float(r[1])); }
__device__ __forceinline__ float x32_partner(float v, int hi) { auto r = __builtin_amdgcn_permlane32_swap(__float_as_uint(v), __float_as_uint(v), false, false); return hi ? __uint_as_float(r[0]) : __uint_as_float(r[1]); }
template <int X> __device__ __forceinline__ float swz_xor(float v) { return __uint_as_float((unsigned)__builtin_amdgcn_ds_swizzle((int)__float_as_uint(v), (X << 10) | 0x1f)); }
__device__ __forceinline__ float x16_sum(float v) { return v + swz_xor<16>(v); }
__device__ __forceinline__ float wave_sum(float v) { v += swz_xor<1>(v); v += swz_xor<2>(v); v += swz_xor<4>(v); v += swz_xor<8>(v); v += swz_xor<16>(v); return x32_sum(v); }

namespace pg8 {
constexpr int BM = 256, BK = 64, HALF = 128, HTB = HALF * BK * 2, STAGE_BYTES = 8 * HTB, NXCD = 8, WGM = 8;
__host__ __device__ __forceinline__ int lds_byte(int r, int c) { const int st = (r >> 4) * 2 + (c >> 5), rr = r & 15, cc = c & 31, ob = rr * 64 + cc * 2; return st * 1024 + (ob ^ (((ob >> 9) & 1) << 5)); }
__host__ __device__ __forceinline__ void stage_rc(int b, int& R, int& C) { const int st = b / 1024, sb = b % 1024, swz = sb ^ (((sb >> 9) & 1) << 5); R = (st >> 1) * 16 + swz / 64; C = (st & 1) * 32 + (swz % 64) / 2; }
__host__ __device__ __forceinline__ int perm32(int rho) { const int n = rho >> 4, i = rho & 15; return 8 * (i >> 2) + 4 * n + (i & 3); }

struct Unit { int pm, pn, aux; };
struct Gemm { const bf16_t* A; const bf16_t* Bt; int lda, ldb, K; long a_aux, b_aux; };

struct StaticOrder {
    int nM, nN, nwg, G, c;
    __device__ void init(int M, int N, int G_, int c_) { nM = M / BM; nN = N / BM; nwg = nM * nN; G = G_; c = c_; }
    __device__ bool next(int i, Unit& u) const {
        const long L = (long)i * G + c; if (L >= nwg) return false;
        int wgid = (int)L; { const int q = nwg / NXCD, r = nwg % NXCD, xcd = wgid % NXCD, off = wgid / NXCD; wgid = (xcd < r ? xcd * (q + 1) : r * (q + 1) + (xcd - r) * q) + off; }
        const int nig = WGM * nN, gid = wgid / nig, fm = gid * WGM, gsz = (nM - fm) < WGM ? (nM - fm) : WGM;
        u.pm = fm + ((wgid % nig) % gsz); u.pn = (wgid % nig) / gsz; u.aux = 0; return true;
    }
};
struct BranchOrder {
    int c, G;
    __device__ bool next(int i, Unit& u) const { const int t = c + (i >> 1) * G; if (t >= 256) return false; u.pm = t >> 3; u.pn = t & 7; u.aux = i & 1; return true; }
};

template <class Epi, class Sched, bool ALIGN_EPI>
__device__ __forceinline__ void gemm_phase(LAS unsigned char* lds, const Gemm g, const Sched& S, const Epi& E) {
    int tid_ = threadIdx.x; asm volatile("" : "+v"(tid_));
    const int tid = tid_, wid = __builtin_amdgcn_readfirstlane(tid >> 6), lane = tid & 63, wr = wid >> 2, wc = wid & 3, fr = lane & 15, fq = lane >> 4;
    int nt_ = g.K / BK; asm volatile("" : "+s"(nt_)); const int nt = nt_;
    unsigned voffA[2], voffB[2];
#pragma unroll
    for (int i = 0; i < 2; ++i) { int R, C; stage_rc(tid * 16 + i * 8192, R, C); const int Rb = Epi::PERM ? ((R & ~31) + perm32(R & 31)) : R;
        voffA[i] = (unsigned)(R * g.lda + C) * 2u; voffB[i] = (unsigned)(Rb * g.ldb + C) * 2u; }
    const size_t kstep = (size_t)(BK * 2);
    const size_t hstepA = (size_t)HALF * g.lda * 2, hstepB = (size_t)HALF * g.ldb * 2;
    const size_t tstepA = 2 * hstepA, tstepB = 2 * hstepB;
    const unsigned ldsw = (unsigned)wid * 1024u;
    const int aoff = lds_byte(wr * 64 + fr, fq * 8), boff = lds_byte(wc * 32 + fr, fq * 8);
#define PG8_SA(b, h) (((b) * 2 + (h)) * HTB)
#define PG8_SB(b, h) ((4 + (b) * 2 + (h)) * HTB)
#define PG8_STAGE(bufoff, gbase, voff) do { _Pragma("unroll") for (int _i = 0; _i < 2; ++_i) \
        __builtin_amdgcn_global_load_lds((const unsigned*)((const char*)(gbase) + (voff)[_i]), (LAS unsigned*)(lds + (bufoff) + ldsw + _i * 8192), 16, 0, 0); } while (0)
#define PG8_LDA(dst, b, h) do { _Pragma("unroll") for (int m = 0; m < 4; ++m) _Pragma("unroll") for (int k = 0; k < 2; ++k) dst[m][k] = *(const LAS bf16x8*)(lds + PG8_SA(b, h) + aoff + m * 2048 + k * 1024); } while (0)
#define PG8_LDB(dst, b, h) do { _Pragma("unroll") for (int n = 0; n < 2; ++n) _Pragma("unroll") for (int k = 0; k < 2; ++k) dst[n][k] = *(const LAS bf16x8*)(lds + PG8_SB(b, h) + boff + n * 2048 + k * 1024); } while (0)
#define PG8_MMA(ai, bj, At, Bt) do { __builtin_amdgcn_s_setprio(1); _Pragma("unroll") for (int m = 0; m < 4; ++m) _Pragma("unroll") for (int n = 0; n < 2; ++n) _Pragma("unroll") for (int k = 0; k < 2; ++k) \
        acc[ai][bj][m][n] = __builtin_amdgcn_mfma_f32_16x16x32_bf16(Bt[n][k], At[m][k], acc[ai][bj][m][n], 0, 0, 0); __builtin_amdgcn_s_setprio(0); } while (0)
#define PG8_WAIT_V(n) asm volatile("s_waitcnt vmcnt(" #n ")" ::: "memory")
#define PG8_WAIT_L(n) asm volatile("s_waitcnt lgkmcnt(" #n ")" ::: "memory")
#define PG8_BAR __builtin_amdgcn_s_barrier()
#define PG8_SCHED __builtin_amdgcn_sched_barrier(0)
#define PG8_UA(u) ((const char*)g.A + (size_t)(u).pm * tstepA + (size_t)(u).aux * (size_t)g.a_aux)
#define PG8_UB(u) ((const char*)g.Bt + (size_t)(u).pn * tstepB + (size_t)(u).aux * (size_t)g.b_aux)
    Unit cur, nxt; int ui = 0;
    if (!S.next(0, cur)) return;
    f32x4 acc[2][2][4][2];
#pragma unroll
    for (int a = 0; a < 2; ++a)
#pragma unroll
        for (int b = 0; b < 2; ++b)
#pragma unroll
            for (int m = 0; m < 4; ++m)
#pragma unroll
                for (int n = 0; n < 2; ++n) acc[a][b][m][n] = (f32x4){0.f, 0.f, 0.f, 0.f};
    bf16x8 At[4][2], B0[2][2], B1[2][2];
    const char* cA = PG8_UA(cur); const char* cB = PG8_UB(cur);
    PG8_STAGE(PG8_SB(0, 0), cB, voffB); PG8_STAGE(PG8_SB(0, 1), cB + hstepB, voffB); PG8_STAGE(PG8_SA(0, 0), cA, voffA); PG8_STAGE(PG8_SA(0, 1), cA + hstepA, voffA);
    if (wr == 1) PG8_BAR;
    PG8_WAIT_V(2); PG8_BAR;
    PG8_STAGE(PG8_SB(1, 0), cB + kstep, voffB); PG8_STAGE(PG8_SA(1, 0), cA + kstep, voffA); PG8_STAGE(PG8_SB(1, 1), cB + hstepB + kstep, voffB);
    PG8_WAIT_V(6); PG8_BAR;
    for (;;) {
        const bool has_next = S.next(ui + 1, nxt);
        const char* nA = has_next ? PG8_UA(nxt) : cA; const char* nB = has_next ? PG8_UB(nxt) : cB;
        for (int t = 0; t < nt; t += 2) {
            const bool last = (t == nt - 2);
            const char* a1 = cA + (size_t)(t + 1) * kstep;
            const char* a2 = last ? nA : cA + (size_t)(t + 2) * kstep; const char* b2 = last ? nB : cB + (size_t)(t + 2) * kstep;
            const char* a3 = a2 + kstep; const char* b3 = b2 + kstep;
            PG8_LDB(B0, 0, 0); PG8_LDB(B1, 0, 1); PG8_SCHED; PG8_LDA(At, 0, 0); PG8_STAGE(PG8_SA(1, 1), a1 + hstepA, voffA);
            PG8_WAIT_V(8); PG8_WAIT_L(0); PG8_BAR; PG8_MMA(0, 0, At, B0); PG8_MMA(0, 1, At, B1); PG8_BAR; PG8_SCHED;
            PG8_LDA(At, 0, 1); PG8_STAGE(PG8_SB(0, 0), b2, voffB); PG8_STAGE(PG8_SB(0, 1), b2 + hstepB, voffB); PG8_STAGE(PG8_SA(0, 0), a2, voffA);
            PG8_WAIT_V(8); PG8_WAIT_L(0); PG8_BAR; PG8_MMA(1, 0, At, B0); PG8_MMA(1, 1, At, B1); PG8_BAR; PG8_SCHED;
            PG8_LDB(B0, 1, 0); PG8_LDB(B1, 1, 1); PG8_SCHED; PG8_LDA(At, 1, 0); PG8_STAGE(PG8_SA(0, 1), a2 + hstepA, voffA);
            PG8_WAIT_V(8); PG8_WAIT_L(0); PG8_BAR; PG8_MMA(0, 0, At, B0); PG8_MMA(0, 1, At, B1); PG8_BAR; PG8_SCHED;
            PG8_LDA(At, 1, 1); PG8_STAGE(PG8_SB(1, 0), b3, voffB); PG8_STAGE(PG8_SB(1, 1), b3 + hstepB, voffB); PG8_STAGE(PG8_SA(1, 0), a3, voffA);
            PG8_WAIT_V(8); PG8_WAIT_L(0); PG8_BAR; PG8_MMA(1, 0, At, B0); PG8_MMA(1, 1, At, B1); PG8_BAR; PG8_SCHED;
        }
        if constexpr (ALIGN_EPI) { if (wr == 0) PG8_BAR; }
        { Unit eu = cur; asm volatile("" : "+s"(eu.pm), "+s"(eu.pn), "+s"(eu.aux)); E(acc, eu, wr, wc, fr, fq); }
        if (!has_next) break;
#pragma unroll
        for (int a = 0; a < 2; ++a)
#pragma unroll
            for (int b = 0; b < 2; ++b)
#pragma unroll
                for (int m = 0; m < 4; ++m)
#pragma unroll
                    for (int n = 0; n < 2; ++n) acc[a][b][m][n] = (f32x4){0.f, 0.f, 0.f, 0.f};
        cur = nxt; cA = nA; cB = nB; ++ui;
        if constexpr (ALIGN_EPI) { if (wr == 1) PG8_BAR; }
    }
    PG8_WAIT_V(0);
    if constexpr (!ALIGN_EPI) { if (wr == 0) PG8_BAR; }
    PG8_BAR;
#undef PG8_SA
#undef PG8_SB
#undef PG8_STAGE
#undef PG8_LDA
#undef PG8_LDB
#undef PG8_MMA
#undef PG8_WAIT_V
#undef PG8_WAIT_L
#undef PG8_BAR
#undef PG8_SCHED
#undef PG8_UA
#undef PG8_UB
}

__device__ __forceinline__ float row_rstd(const float* ssq, int row, int fq) {
    const f32x4 a = *(const f32x4*)(ssq + (size_t)row * 16 + 4 * fq);
    float s = (a[0] + a[1]) + (a[2] + a[3]);
    s = x16_sum(s); s = x32_sum(s);
    return __builtin_amdgcn_rsqf(s * (1.0f / DM) + RMS_EPS);
}
__device__ __forceinline__ int pos16(int o) { return 8 * ((o >> 2) & 1) + 4 * (o >> 3) + (o & 3); }

struct EpiProj {
    static constexpr bool PERM = true;
    const float* ssq; int row_base; bf16_t* QK; bf16_t* VT; float* FL; bf16_t* GATE;
    __device__ __forceinline__ void operator()(const f32x4 (&acc)[2][2][4][2], const Unit& u, int wr, int wc, int fr, int fq) const {
        const int pn = u.pn;
        const int lrow0 = u.pm * BM + wr * 64 + fr;
        float rs[2][4];
#pragma unroll
        for (int ai = 0; ai < 2; ++ai)
#pragma unroll
            for (int m = 0; m < 4; ++m) rs[ai][m] = row_rstd(ssq, row_base + lrow0 + ai * HALF + m * 16, fq);
        const int cin = wc * 32 + 8 * fq;
        if (pn >= 19) {
#pragma unroll
            for (int ai = 0; ai < 2; ++ai)
#pragma unroll
                for (int m = 0; m < 4; ++m) { const int lrow = lrow0 + ai * HALF + m * 16; const float s = rs[ai][m];
#pragma unroll
                    for (int bj = 0; bj < 2; ++bj) { const f32x4 v0 = acc[ai][bj][m][0] * s, v1 = acc[ai][bj][m][1] * s;
                        u32x4 w; w.x = cvtpk(v0[0], v0[1]); w.y = cvtpk(v0[2], v0[3]); w.z = cvtpk(v1[0], v1[1]); w.w = cvtpk(v1[2], v1[3]);
                        *(u32x4*)(GATE + (size_t)lrow * 4096 + (pn - 19) * 256 + bj * HALF + cin) = w; } }
        } else if (pn == 18) {
            if (wc == 0 && fq == 0) {
#pragma unroll
                for (int ai = 0; ai < 2; ++ai)
#pragma unroll
                    for (int m = 0; m < 4; ++m) { const int lrow = lrow0 + ai * HALF + m * 16; *(f32x4*)(FL + (size_t)lrow * 4) = acc[ai][0][m][0] * rs[ai][m]; }
            }
        } else if (pn == 2 || (pn >= 9 && pn <= 11) || pn == 14 || pn == 17) {
            int vhb, rsh;
            if (pn == 2) { vhb = 0; rsh = 0; } else if (pn == 14) { vhb = 16; rsh = 0; } else if (pn == 17) { vhb = 20; rsh = 0; } else { const int gI = pn - 9; vhb = 4 + 4 * gI; rsh = 2 * gI; }
            const int slsh = 11 - rsh, rmask = (1 << rsh) - 1;
#pragma unroll
            for (int ai = 0; ai < 2; ++ai)
#pragma unroll
                for (int m = 0; m < 4; ++m) { const int lrow = lrow0 + ai * HALF + m * 16; const float s = rs[ai][m];
                    const int bl = lrow >> 11, t = lrow & (SEQ - 1); int p = ((t & rmask) << slsh) + (t >> rsh); p = (p & ~15) | pos16(p & 15);
                    bf16_t* base = VT + (size_t)bl * 24 * 64 * SEQ + p;
#pragma unroll
                    for (int bj = 0; bj < 2; ++bj) { const int c0 = bj * HALF + cin; bf16_t* bp = base + (size_t)(vhb * 64 + c0) * SEQ;
                        const f32x4 v0 = acc[ai][bj][m][0] * s, v1 = acc[ai][bj][m][1] * s;
                        const unsigned w0 = cvtpk(v0[0], v0[1]), w1 = cvtpk(v0[2], v0[3]), w2 = cvtpk(v1[0], v1[1]), w3 = cvtpk(v1[2], v1[3]);
                        bp[0 * SEQ] = (bf16_t)(w0 & 0xffff); bp[1 * SEQ] = (bf16_t)(w0 >> 16); bp[2 * SEQ] = (bf16_t)(w1 & 0xffff); bp[3 * SEQ] = (bf16_t)(w1 >> 16);
                        bp[4 * SEQ] = (bf16_t)(w2 & 0xffff); bp[5 * SEQ] = (bf16_t)(w2 >> 16); bp[6 * SEQ] = (bf16_t)(w3 & 0xffff); bp[7 * SEQ] = (bf16_t)(w3 >> 16); } }
        } else {
            int slot, rsh = 0;
            if (pn <= 1) slot = pn; else if (pn <= 8) { slot = pn - 1; const int gI = (pn - 3) % 3; rsh = 2 * gI; } else if (pn <= 13) slot = pn - 4; else slot = pn - 5;
            const int slsh = 11 - rsh, rmask = (1 << rsh) - 1;
#pragma unroll
            for (int ai = 0; ai < 2; ++ai)
#pragma unroll
                for (int m = 0; m < 4; ++m) { const int lrow = lrow0 + ai * HALF + m * 16; const float s = rs[ai][m];
                    const int bl = lrow >> 11, t = lrow & (SEQ - 1); const int prow = bl * SEQ + ((t & rmask) << slsh) + (t >> rsh);
#pragma unroll
                    for (int bj = 0; bj < 2; ++bj) { const f32x4 v0 = acc[ai][bj][m][0] * s, v1 = acc[ai][bj][m][1] * s;
                        u32x4 w; w.x = cvtpk(v0[0], v0[1]); w.y = cvtpk(v0[2], v0[3]); w.z = cvtpk(v1[0], v1[1]); w.w = cvtpk(v1[2], v1[3]);
                        *(u32x4*)(QK + (size_t)prow * LDQK + slot * 256 + bj * HALF + cin) = w; } }
        }
    }
};

struct EpiBranch {
    static constexpr bool PERM = true;
    const bf16_t* GATE; bf16_t* MERGED; int row_base;
    __device__ __forceinline__ static float sg(float g) { return __builtin_amdgcn_rcpf(1.0f + ex2(-g * LOG2E)); }
    __device__ __forceinline__ static u32x4 mix(const u32x4 ga, const u32x4 gb, const u32x4 ow, const f32x4 a0, const f32x4 a1, const f32x4 b0, const f32x4 b1) {
        const float o0 = sg(bflo(ga.x)) * a0[0] + sg(bflo(gb.x)) * b0[0] + bflo(ow.x), o1 = sg(bfhi(ga.x)) * a0[1] + sg(bfhi(gb.x)) * b0[1] + bfhi(ow.x);
        const float o2 = sg(bflo(ga.y)) * a0[2] + sg(bflo(gb.y)) * b0[2] + bflo(ow.y), o3 = sg(bfhi(ga.y)) * a0[3] + sg(bfhi(gb.y)) * b0[3] + bfhi(ow.y);
        const float o4 = sg(bflo(ga.z)) * a1[0] + sg(bflo(gb.z)) * b1[0] + bflo(ow.z), o5 = sg(bfhi(ga.z)) * a1[1] + sg(bfhi(gb.z)) * b1[1] + bfhi(ow.z);
        const float o6 = sg(bflo(ga.w)) * a1[2] + sg(bflo(gb.w)) * b1[2] + bflo(ow.w), o7 = sg(bfhi(ga.w)) * a1[3] + sg(bfhi(gb.w)) * b1[3] + bfhi(ow.w);
        u32x4 w; w.x = cvtpk(o0, o1); w.y = cvtpk(o2, o3); w.z = cvtpk(o4, o5); w.w = cvtpk(o6, o7); return w;
    }
    __device__ __forceinline__ void operator()(const f32x4 (&acc)[2][2][4][2], const Unit& u, int wr, int wc, int fr, int fq) const {
        const int p = u.aux; const int lrow0 = u.pm * BM + wr * 64 + fr; const int d0 = u.pn * 128 + wc * 32 + 8 * fq;
        const bf16_t* gbase = GATE + (size_t)lrow0 * 4096 + (2 * p) * 1024 + d0; bf16_t* mbase = MERGED + (size_t)(row_base + lrow0) * DM + d0;
        const u32x4 zero = {0u, 0u, 0u, 0u};
#pragma unroll
        for (int ai = 0; ai < 2; ++ai)
#pragma unroll
            for (int mp = 0; mp < 2; ++mp) {
                u32x4 ga[2], gb[2], ow[2];
#pragma unroll
                for (int mm = 0; mm < 2; ++mm) { const size_t ro = (size_t)(ai * HALF + (2 * mp + mm) * 16);
                    ga[mm] = *(const u32x4*)(gbase + ro * 4096); gb[mm] = *(const u32x4*)(gbase + ro * 4096 + 1024);
                    ow[mm] = zero; if (p > 0) ow[mm] = *(const u32x4*)(mbase + ro * DM); }
#pragma unroll
                for (int mm = 0; mm < 2; ++mm) { const int m = 2 * mp + mm; const size_t ro = (size_t)(ai * HALF + m * 16);
                    *(u32x4*)(mbase + ro * DM) = mix(ga[mm], gb[mm], ow[mm], acc[ai][0][m][0], acc[ai][0][m][1], acc[ai][1][m][0], acc[ai][1][m][1]); }
                asm volatile("" ::: "memory");
            }
    }
};

struct EpiResid {
    static constexpr bool PERM = true;
    float* X; bf16_t* XB; float* ssq;
    __device__ __forceinline__ void operator()(const f32x4 (&acc)[2][2][4][2], const Unit& u, int wr, int wc, int fr, int fq) const {
        const int row0 = u.pm * BM + wr * 64 + fr; const int col0 = u.pn * BM + wc * 32 + 8 * fq;
#pragma unroll
        for (int ai = 0; ai < 2; ++ai)
#pragma unroll
            for (int m = 0; m < 4; ++m) { const int row = row0 + ai * HALF + m * 16; float sq = 0.f;
#pragma unroll
                for (int bj = 0; bj < 2; ++bj) { const int col = col0 + bj * HALF; f32x4* xp = (f32x4*)(X + (size_t)row * DM + col);
                    const f32x4 x0 = xp[0] + acc[ai][bj][m][0], x1 = xp[1] + acc[ai][bj][m][1];
                    xp[0] = x0; xp[1] = x1;
                    u32x4 w; w.x = cvtpk(x0[0], x0[1]); w.y = cvtpk(x0[2], x0[3]); w.z = cvtpk(x1[0], x1[1]); w.w = cvtpk(x1[2], x1[3]);
                    *(u32x4*)(XB + (size_t)row * DM + col) = w;
                    sq += (x0[0] * x0[0] + x0[1] * x0[1]) + (x0[2] * x0[2] + x0[3] * x0[3]) + (x1[0] * x1[0] + x1[1] * x1[1]) + (x1[2] * x1[2] + x1[3] * x1[3]); }
                sq = x16_sum(sq); sq = x32_sum(sq);
                if (fq == 0) ssq[(size_t)row * 16 + u.pn * 4 + wc] = sq; if (m & 1) asm volatile("" ::: "memory"); }
    }
};

struct EpiUp {
    static constexpr bool PERM = true;
    const float* ssq; bf16_t* H;
    __device__ __forceinline__ void operator()(const f32x4 (&acc)[2][2][4][2], const Unit& u, int wr, int wc, int fr, int fq) const {
        const int row0 = u.pm * BM + wr * 64 + fr; const int col0 = u.pn * BM + wc * 32 + 8 * fq;
        float rs[2][4];
#pragma unroll
        for (int ai = 0; ai < 2; ++ai)
#pragma unroll
            for (int m = 0; m < 4; ++m) rs[ai][m] = row_rstd(ssq, row0 + ai * HALF + m * 16, fq);
#pragma unroll
        for (int ai = 0; ai < 2; ++ai)
#pragma unroll
            for (int m = 0; m < 4; ++m) { const int row = row0 + ai * HALF + m * 16; const float s = rs[ai][m];
#pragma unroll
                for (int bj = 0; bj < 2; ++bj) { f32x4 v0 = acc[ai][bj][m][0] * s, v1 = acc[ai][bj][m][1] * s;
#pragma unroll
                    for (int i = 0; i < 4; ++i) { const float a = fmaxf(v0[i], 0.f), b = fmaxf(v1[i], 0.f); v0[i] = a * a; v1[i] = b * b; }
                    u32x4 w; w.x = cvtpk(v0[0], v0[1]); w.y = cvtpk(v0[2], v0[3]); w.z = cvtpk(v1[0], v1[1]); w.w = cvtpk(v1[2], v1[3]);
                    *(u32x4*)(H + (size_t)row * DFF + col0 + bj * HALF) = w; } }
    }
};
}

__device__ __forceinline__ int win_src(int n) {
    if (n < 3840) return n;
    if (n < 4608) return n + 4;
    if (n < 4864) return (n - 4608 < 4) ? 3840 + (n - 4608) : -1;
    return n - 4864 + 4612;
}
template <int CMAP>
__device__ __forceinline__ void transpose_item(const float* W, int K, int N, int Nsrc, const float* gain, bf16_t* WT, LAS float* scr, int item, int lane) {
    const int nblk = N / 32, kb = item / nblk, nb = item % nblk, k0 = 64 * kb, n0 = 32 * nb;
    const int n = n0 + (lane & 31); const int src = CMAP ? win_src(n) : n;
    const bool live = (src >= 0); const float* wp = W + (size_t)(k0 + (lane >> 5)) * Nsrc + (live ? src : 0); const float* gp = gain ? gain + k0 + (lane >> 5) : nullptr;
    float wv[32];
#pragma unroll
    for (int i = 0; i < 32; ++i) wv[i] = wp[(size_t)(2 * i) * Nsrc];
#pragma unroll
    for (int i = 0; i < 32; ++i) { float v = live ? wv[i] : 0.f; if (gp) v *= gp[2 * i]; scr[(2 * i + (lane >> 5)) * 33 + (lane & 31)] = v; }
    asm volatile("s_waitcnt lgkmcnt(0)" ::: "memory");
    const int c = lane & 7;
#pragma unroll
    for (int j = 0; j < 4; ++j) { const int nn = (lane >> 3) + 8 * j; const LAS float* s = scr + (8 * c) * 33 + nn;
        u32x4 o; o.x = cvtpk(s[0 * 33], s[1 * 33]); o.y = cvtpk(s[2 * 33], s[3 * 33]); o.z = cvtpk(s[4 * 33], s[5 * 33]); o.w = cvtpk(s[6 * 33], s[7 * 33]);
        *(u32x4*)(WT + (size_t)(n0 + nn) * K + k0 + 8 * c) = o; }
    asm volatile("s_waitcnt lgkmcnt(0)" ::: "memory");
}

__device__ __forceinline__ void branch_item(const float* Wn, int n, bf16_t* WBP, LAS float* scr, int item, int lane) {
    const int kb = item >> 5, nb = item & 31, k0 = 64 * kb, n0 = 32 * nb;
    const float* wp = Wn + (size_t)(k0 + (lane >> 5)) * DM + n0 + (lane & 31);
    float wv[32];
#pragma unroll
    for (int i = 0; i < 32; ++i) wv[i] = wp[(size_t)(2 * i) * DM];
#pragma unroll
    for (int i = 0; i < 32; ++i) scr[(2 * i + (lane >> 5)) * 33 + (lane & 31)] = wv[i];
    asm volatile("s_waitcnt lgkmcnt(0)" ::: "memory");
    const int c = lane & 7, bj = n & 1, pair = n >> 1;
    const u32x4 zero = {0u, 0u, 0u, 0u};
#pragma unroll
    for (int j = 0; j < 4; ++j) { const int nn = (lane >> 3) + 8 * j; const LAS float* sp = scr + (8 * c) * 33 + nn; const int d = n0 + nn;
        u32x4 o; o.x = cvtpk(sp[0 * 33], sp[1 * 33]); o.y = cvtpk(sp[2 * 33], sp[3 * 33]); o.z = cvtpk(sp[4 * 33], sp[5 * 33]); o.w = cvtpk(sp[6 * 33], sp[7 * 33]);
        bf16_t* row = WBP + ((size_t)((pair * 8 + (d >> 7)) * 256 + bj * 128 + (d & 127))) * 512 + k0 + 8 * c;
        *(u32x4*)(row + 256 * bj) = o; *(u32x4*)(row + 256 * (1 - bj)) = zero; }
    asm volatile("s_waitcnt lgkmcnt(0)" ::: "memory");
}

#define MFMA32(a, b, c) __builtin_amdgcn_mfma_f32_32x32x16_bf16((a), (b), (c), 0, 0, 0)
__device__ __forceinline__ bf16x8 ld16(const bf16_t* p) { return *(const bf16x8*)p; }
__device__ __forceinline__ bf16x8 pack8(const f32x16& s, int b) { u32x4 w; w.x = cvtpk(s[b], s[b + 1]); w.y = cvtpk(s[b + 2], s[b + 3]); w.z = cvtpk(s[b + 4], s[b + 5]); w.w = cvtpk(s[b + 6], s[b + 7]); return __builtin_bit_cast(bf16x8, w); }
__device__ __forceinline__ int crow(int r, int hi) { return (r & 3) + 8 * (r >> 2) + 4 * hi; }
__device__ __forceinline__ void store_o(bf16_t* orow, const f32x16& o0, const f32x16& o1, int hi) {
#pragma unroll
    for (int g = 0; g < 4; ++g) {
        u32x2 a; a.x = cvtpk(o0[4 * g], o0[4 * g + 1]); a.y = cvtpk(o0[4 * g + 2], o0[4 * g + 3]); *(u32x2*)(orow + 8 * g + 4 * hi) = a;
        u32x2 b; b.x = cvtpk(o1[4 * g], o1[4 * g + 1]); b.y = cvtpk(o1[4 * g + 2], o1[4 * g + 3]); *(u32x2*)(orow + 32 + 8 * g + 4 * hi) = b; }
}

struct KFrag { bf16x8 k[4]; };
struct VFrag { bf16x8 v[4]; };
__device__ __forceinline__ void k_load(KFrag& f, const bf16_t* Ks, int kb, int r32, int hi) {
    const bf16_t* kp = Ks + (size_t)(kb * 32 + r32) * LDQK + hi * 8;
#pragma unroll
    for (int ds = 0; ds < 4; ++ds) f.k[ds] = ld16(kp + ds * 16);
}
__device__ __forceinline__ void v_load(VFrag& f, const bf16_t* VTs, int kb, int r32, int hi) {
    const bf16_t* vp = VTs + (size_t)r32 * SEQ + kb * 32 + hi * 8;
    f.v[0] = ld16(vp); f.v[1] = ld16(vp + 16); f.v[2] = ld16(vp + 32 * SEQ); f.v[3] = ld16(vp + 32 * SEQ + 16);
}
__device__ __forceinline__ void q_load(bf16x8 (&qf)[4], const bf16_t* Qs, int qb, int r32, int hi) {
    const bf16_t* qp = Qs + (size_t)(qb * 32 + r32) * LDQK + hi * 8;
#pragma unroll
    for (int ds = 0; ds < 4; ++ds) qf[ds] = ld16(qp + ds * 16);
}

template <int MODE>
__device__ __forceinline__ void sm_unit(const bf16_t* Qs, const bf16_t* Ks, const bf16_t* VTs, int qb, int kb_hi, int kb_lo, float slope2, const LAS float* cl,
                                        f32x16& o0, f32x16& o1, float& m_out, float& l_out, int lane) {
    const int r32 = lane & 31, hi = lane >> 5;
    constexpr int NDS = (MODE == 2) ? 2 : 4;
    constexpr float SC2 = ((MODE == 2) ? 0.17677669529663687f : 0.125f) * LOG2E;
    bf16x8 qf[NDS];
    { const bf16_t* qp = Qs + (size_t)(qb * 32 + r32) * LDQK + hi * 8;
#pragma unroll
      for (int ds = 0; ds < NDS; ++ds) qf[ds] = ld16(qp + ds * 16); }
    bf16x8 nk[NDS];
    { const bf16_t* kp = Ks + (size_t)(kb_hi * 32 + r32) * LDQK + hi * 8;
#pragma unroll
      for (int ds = 0; ds < NDS; ++ds) nk[ds] = ld16(kp + ds * 16); }
    float m = -INFINITY, l = 0.f;
#pragma unroll
    for (int i = 0; i < 16; ++i) { o0[i] = 0.f; o1[i] = 0.f; }
    for (int kb = kb_hi; kb >= kb_lo; --kb) {
        bf16x8 ck[NDS];
#pragma unroll
        for (int ds = 0; ds < NDS; ++ds) ck[ds] = nk[ds];
        VFrag cv; v_load(cv, VTs, kb, r32, hi);
        if (kb > kb_lo) { const bf16_t* kp = Ks + (size_t)((kb - 1) * 32 + r32) * LDQK + hi * 8;
#pragma unroll
            for (int ds = 0; ds < NDS; ++ds) nk[ds] = ld16(kp + ds * 16); }
        f32x16 s;
#pragma unroll
        for (int i = 0; i < 16; ++i) s[i] = 0.f;
#pragma unroll
        for (int ds = 0; ds < NDS; ++ds) s = MFMA32(ck[ds], qf[ds], s);
        const int d0 = (qb - kb) * 32 + r32;
        if (MODE == 0) {
#pragma unroll
            for (int r = 0; r < 16; ++r) { const float v = s[r] * SC2 + cl[33 * kb + crow(r, hi)]; s[r] = (crow(r, hi) <= d0) ? v : -INFINITY; }
        } else if (MODE == 1) {
#pragma unroll
            for (int r = 0; r < 16; ++r) { const int dist = d0 - crow(r, hi); const float v = s[r] * SC2 - slope2 * (float)dist; s[r] = ((unsigned)dist <= 128u) ? v : -INFINITY; }
        } else {
#pragma unroll
            for (int r = 0; r < 16; ++r) { const int dist = d0 - crow(r, hi); const float v = s[r] * SC2 - slope2 * (float)dist; s[r] = (dist >= 0) ? v : -INFINITY; }
        }
        float mt = fmaxf(fmaxf(s[0], s[1]), fmaxf(s[2], s[3]));
#pragma unroll
        for (int r = 4; r < 16; r += 4) mt = fmaxf(mt, fmaxf(fmaxf(s[r], s[r + 1]), fmaxf(s[r + 2], s[r + 3])));
        mt = x32_max(mt);
        const float mn = fmaxf(m, mt), alpha = ex2(m - mn);
        float ps = 0.f;
#pragma unroll
        for (int r = 0; r < 16; ++r) { const float p = ex2(s[r] - mn); s[r] = p; ps += p; }
        l = l * alpha + ps; m = mn;
#pragma unroll
        for (int i = 0; i < 16; ++i) { o0[i] *= alpha; o1[i] *= alpha; }
        const bf16x8 pf0 = pack8(s, 0), pf1 = pack8(s, 8);
        o0 = MFMA32(cv.v[0], pf0, o0); o0 = MFMA32(cv.v[1], pf1, o0); o1 = MFMA32(cv.v[2], pf0, o1); o1 = MFMA32(cv.v[3], pf1, o1);
    }
    l = x32_sum(l);
    m_out = m; l_out = l;
}

__device__ __forceinline__ void sb_unit(const bf16_t* Qs, const bf16_t* Ks, const bf16_t* VTs, int qb, f32x16& o0, f32x16& o1, int lane) {
    const int r32 = lane & 31, hi = lane >> 5;
    constexpr float SC2 = 0.125f * LOG2E;
    bf16x8 qf[4]; q_load(qf, Qs, qb, r32, hi);
    KFrag nx; k_load(nx, Ks, qb, r32, hi);
    float R = 0.f;
#pragma unroll
    for (int i = 0; i < 16; ++i) { o0[i] = 0.f; o1[i] = 0.f; }
    for (int kb = qb; kb >= 0; --kb) {
        const KFrag cu = nx; VFrag cv; v_load(cv, VTs, kb, r32, hi);
        if (kb > 0) k_load(nx, Ks, kb - 1, r32, hi);
        f32x16 s;
#pragma unroll
        for (int i = 0; i < 16; ++i) s[i] = 0.f;
#pragma unroll
        for (int ds = 0; ds < 4; ++ds) s = MFMA32(cu.k[ds], qf[ds], s);
        float lk[16], ls[16];
        const int d0 = (qb - kb) * 32 + r32;
#pragma unroll
        for (int r = 0; r < 16; ++r) { const float z2 = s[r] * SC2; const float sp = fmaxf(z2, 0.f) + lg2(1.0f + ex2(-fabsf(z2))); const bool valid = crow(r, hi) < d0; lk[r] = valid ? -sp : 0.f; ls[r] = valid ? (z2 - sp) : -INFINITY; }
        float e[16], tq[4], pq[4];
#pragma unroll
        for (int g = 0; g < 4; ++g) { e[4 * g + 3] = 0.f; e[4 * g + 2] = lk[4 * g + 3]; e[4 * g + 1] = e[4 * g + 2] + lk[4 * g + 2]; e[4 * g] = e[4 * g + 1] + lk[4 * g + 1]; tq[g] = e[4 * g] + lk[4 * g]; }
#pragma unroll
        for (int g = 0; g < 4; ++g) pq[g] = x32_partner(tq[g], hi);
        float cs[4]; cs[3] = 0.f; cs[2] = tq[3] + pq[3]; cs[1] = cs[2] + (tq[2] + pq[2]); cs[0] = cs[1] + (tq[1] + pq[1]);
        const float total = cs[0] + (tq[0] + pq[0]);
#pragma unroll
        for (int g = 0; g < 4; ++g) { const float later = R + cs[g] + (hi == 0 ? pq[g] : 0.f);
#pragma unroll
            for (int i = 0; i < 4; ++i) s[4 * g + i] = ex2(ls[4 * g + i] + e[4 * g + i] + later); }
        R += total;
        const bf16x8 pf0 = pack8(s, 0), pf1 = pack8(s, 8);
        o0 = MFMA32(cv.v[0], pf0, o0); o0 = MFMA32(cv.v[1], pf1, o0); o1 = MFMA32(cv.v[2], pf0, o1); o1 = MFMA32(cv.v[3], pf1, o1);
        if (__all(R < -150.0f)) break;
    }
}

#define XB_TMO      128
#define XB_XCNT(j)  (256  + 64 * (j))
#define XB_XSUB(j)  (1280 + 64 * (j))
#define XB_XGEN(j)  (2304 + 64 * (j))
#define XB_TOP      3328
#define XB_TOPGEN   3392
#define XCD_BAR_WORDS 3456
#define XB_SPIN_CAP (1u << 18)
__device__ __forceinline__ unsigned xb_ld(unsigned* p)              { return __hip_atomic_load(p, __ATOMIC_RELAXED, __HIP_MEMORY_SCOPE_AGENT); }
__device__ __forceinline__ unsigned xb_add(unsigned* p, unsigned v) { return __hip_atomic_fetch_add(p, v, __ATOMIC_RELAXED, __HIP_MEMORY_SCOPE_AGENT); }
__device__ __forceinline__ unsigned xb_xcc_id() { return (unsigned)__builtin_amdgcn_s_getreg((3 << 11) | 20) & 0xFu; }
#define XB_SPIN(cond, bar) do { unsigned _sp = 0; while (cond) { __builtin_amdgcn_s_sleep(1); \
    if ((++_sp & 255u) == 0u) { if (xb_ld(&(bar)[XB_TMO])) break; if (_sp > XB_SPIN_CAP) { atomicAdd(&(bar)[XB_TMO], 1u); break; } } } } while (0)
__device__ __forceinline__ void xcd_barrier_complete(unsigned* bar, unsigned x, unsigned& nloc, unsigned& nx) {
    const unsigned G = gridDim.x * gridDim.y * gridDim.z;
    unsigned sum, cnt, mine, sp = 0u;
    for (;;) {
        sum = 0u; cnt = 0u; mine = 0u;
#pragma unroll
        for (unsigned j = 0; j < 16; ++j) { const unsigned c = xb_ld(&bar[XB_XCNT(j)]); sum += c; cnt += (c > 0u) ? 1u : 0u; mine = (j == x) ? c : mine; }
        if (sum == G) break;
        __builtin_amdgcn_s_sleep(1);
        if ((++sp & 255u) == 0u) { if (xb_ld(&bar[XB_TMO])) break; if (sp > XB_SPIN_CAP) { atomicAdd(&bar[XB_TMO], 1u); break; } }
    }
    nloc = mine > 0u ? mine : 1u; nx = cnt > 0u ? cnt : 1u;
}
__device__ __forceinline__ void xcd_barrier(unsigned* bar, volatile LAS unsigned* st) {
    asm volatile("s_waitcnt vmcnt(0)" ::: "memory");
    __syncthreads();
    if (threadIdx.x == 0) {
        const unsigned x = xb_xcc_id();
        __builtin_amdgcn_s_waitcnt(0);
        unsigned nloc = st[0], nx = st[1];
        if (nloc == 0u) { xcd_barrier_complete(bar, x, nloc, nx); st[0] = nloc; st[1] = nx; }
        const unsigned old = xb_add(&bar[XB_XSUB(x)], 1u);
        const unsigned gen = old / nloc;
        if (old + 1u == (gen + 1u) * nloc) {
            __builtin_amdgcn_fence(__ATOMIC_RELEASE, "agent");
            asm volatile("s_waitcnt vmcnt(0)" ::: "memory");
            const unsigned og = xb_add(&bar[XB_TOP], 1u);
            const unsigned tg = og / nx;
            if (og + 1u == (tg + 1u) * nx) xb_add(&bar[XB_TOPGEN], 1u);
            else XB_SPIN(xb_ld(&bar[XB_TOPGEN]) == tg, bar);
            __builtin_amdgcn_fence(__ATOMIC_ACQUIRE, "agent");
            xb_add(&bar[XB_XGEN(x)], 1u);
            asm volatile("s_waitcnt vmcnt(0)" ::: "memory");
        } else {
            XB_SPIN(xb_ld(&bar[XB_XGEN(x)]) == gen, bar);
            __builtin_amdgcn_fence(__ATOMIC_ACQUIRE, "agent");
            asm volatile("s_waitcnt vmcnt(0)" ::: "memory");
        }
    }
    __syncthreads();
}
constexpr int MISC_OFF = 131072 + 320;

struct Params {
    const float* x; const float* mix_g; const float* w_in; const float* b_forget; const float* lq1; const float* lk1; const float* lq2; const float* lk2;
    const float* diff_g; const float* w_branch; const float* w_out; const float* mlp_g; const float* w_up; const float* w_down; const float* final_g;
    float* out; unsigned char* ws;
};

#ifndef REP_P1
#define REP_P1 1
#endif
#ifndef REP_P2
#define REP_P2 1
#endif
#ifndef REP_P3
#define REP_P3 1
#endif
#ifndef REP_P5
#define REP_P5 1
#endif
#ifndef REP_SYNC
#define REP_SYNC 1
#endif
#ifndef REP_CONV
#define REP_CONV 1
#endif
#define GSYNC() do { for (int rs_ = 0; rs_ < REP_SYNC; ++rs_) { KParamsPtr pb_ = OPQ_PP(); xcd_barrier((unsigned*)(pb_->ws + WS_CTL) + CW_BAR, (volatile LAS unsigned*)(lds + MISC_OFF)); } } while (0)
#define OPQ_TID() ({ int t_ = threadIdx.x; asm volatile("" : "+v"(t_)); t_; })
typedef const __attribute__((address_space(4))) Params* KParamsPtr;
#define OPQ_PP() ({ KParamsPtr p_ = (KParamsPtr)__builtin_amdgcn_kernarg_segment_ptr(); asm volatile("" : "+s"(p_)); p_; })
#define PHASE_VARS() const int tid = OPQ_TID(); const int lane = tid & 63, wave = __builtin_amdgcn_readfirstlane(tid >> 6); const int G = gridDim.x, bx = blockIdx.x; \
    const int gw = bx * NWAVES + wave, NGW = G * NWAVES; KParamsPtr PP = OPQ_PP(); unsigned char* ws = PP->ws; LAS float* scr = (LAS float*)(lds + wave * 16384); (void)lane; (void)gw; (void)NGW; (void)ws; (void)scr; (void)G; (void)bx; (void)PP

__global__ void __launch_bounds__(NWAVES * 64, 2) fwd_mega(Params P) {
    extern __shared__ __attribute__((aligned(16))) unsigned char lds_raw[];
    LAS unsigned char* lds = (LAS unsigned char*)lds_raw;
    cg::grid_group grid = cg::this_grid();
    { const int t0 = OPQ_TID(); if (t0 < 64) ((LAS unsigned*)(lds + 131072))[t0 + 64] = 0u; __syncthreads();
      if (t0 == 0) { KParamsPtr p0 = OPQ_PP(); (void)xb_add((unsigned*)(p0->ws + WS_CTL) + CW_BAR + XB_XCNT(xb_xcc_id()), 1u); } }

    {
        PHASE_VARS();
        float* X = PP->out; bf16_t* XB = (bf16_t*)(ws + WS_XB); float* SSQ = (float*)(ws + WS_SSQ);
        for (int row = gw; row < TOK; row += NGW) {
            const f32x4* xr = (const f32x4*)(PP->x + (size_t)row * DM) + lane; f32x4* xo = (f32x4*)(X + (size_t)row * DM) + lane;
            unsigned long long* o8 = (unsigned long long*)(XB + (size_t)row * DM) + lane;
            float s = 0.f;
#pragma unroll
            for (int j = 0; j < 4; ++j) { const f32x4 v = xr[64 * j]; xo[64 * j] = v; s += (v[0] * v[0] + v[1] * v[1]) + (v[2] * v[2] + v[3] * v[3]);
                o8[64 * j] = (unsigned long long)cvtpk(v[0], v[1]) | ((unsigned long long)cvtpk(v[2], v[3]) << 32); }
            s = wave_sum(s);
            if (lane < 16) SSQ[(size_t)row * 16 + lane] = (lane == 0) ? s : 0.f;
        }
    }

    for (int layer = 0; layer < DEPTH; ++layer) {
        for (int rep = 0; rep < REP_CONV; ++rep) {
            PHASE_VARS();
            bf16_t* WIN = (bf16_t*)(ws + WS_WIN); bf16_t* WB = (bf16_t*)(ws + WS_WB); bf16_t* WOUT = (bf16_t*)(ws + WS_WOUT);
            const float* w_in = PP->w_in + (size_t)layer * DM * DIN; const float* mg = PP->mix_g + (size_t)layer * DM;
            const float* wb = PP->w_branch + (size_t)layer * 4 * 256 * DM; const float* wo = PP->w_out + (size_t)layer * DM * DM;
            constexpr int I_IN = (DM / 64) * (NPROJ / 32), I_B = (256 / 64) * (DM / 32), I_O = (DM / 64) * (DM / 32);
            for (int it = gw; it < I_IN + 4 * I_B + I_O; it += NGW) {
                int r = it;
                if (r < I_IN) { transpose_item<1>(w_in, DM, NPROJ, DIN, mg, WIN, scr, r, lane); continue; } r -= I_IN;
                if (r < 4 * I_B) { const int n = r / I_B; branch_item(wb + (size_t)n * 256 * DM, n, WB, scr, r % I_B, lane); continue; } r -= 4 * I_B;
                transpose_item<0>(wo, DM, DM, DM, nullptr, WOUT, scr, r, lane);
            }
        }
        if (layer == 0) grid.sync(); else GSYNC();

        for (int half = 0; half < 2; ++half) {
#ifndef NO_P1
            for (int rep = 0; rep < REP_P1; ++rep) {
                PHASE_VARS();
                const int rb = half * HT;
                pg8::Gemm g{(const bf16_t*)(ws + WS_XB) + (size_t)rb * DM, (const bf16_t*)(ws + WS_WIN), DM, DM, DM, 0, 0};
                pg8::StaticOrder S; S.init(HT, NPROJ, G, bx);
                pg8::EpiProj E{(const float*)(ws + WS_SSQ), rb, (bf16_t*)(ws + WS_QK), (bf16_t*)(ws + WS_VT), (float*)(ws + WS_FL), (bf16_t*)(ws + WS_GATE)};
                pg8::gemm_phase<pg8::EpiProj, pg8::StaticOrder, true>(lds, g, S, E);
            }
#endif
            GSYNC();
#ifndef NO_P2
            for (int rep = 0; rep < REP_P2; ++rep) {
                PHASE_VARS();
                unsigned* ctr = (unsigned*)(ws + WS_CTL) + 64 + 512 * (layer * 2 + half + 4 * rep);
                const int r32 = lane & 31, hi = lane >> 5;
                const int xq = bx & 7;
                ctr += 64 * xq;
                for (;;) {
                    int li = 0; if (lane == 0) li = (int)atomicAdd(ctr, 1u); li = __builtin_amdgcn_readfirstlane(li);
                    if (li >= 1088) break;
                    int idx;
                    if (li < 576) { const int hl = li / 96, row = li - hl * 96; idx = row * 48 + (xq + 8 * hl); }
                    else if (li < 704) { const int i = li - 576; idx = 4608 + ((63 - (i & 63)) << 4) + (xq + 8 * (i >> 6)); }
                    else { const int i = li - 704; idx = 5632 + (xq + 8 * (i >> 6)) * 64 + (i & 63); }
                    KParamsPtr PU = OPQ_PP(); unsigned char* wsu = PU->ws;
                    bf16_t* YS = (bf16_t*)(wsu + WS_YS); bf16_t* DILO = (bf16_t*)(wsu + WS_DILO); float* LSE = (float*)(wsu + WS_LSE); const float* FL = (const float*)(wsu + WS_FL);
                    const bf16_t* QK = (const bf16_t*)(wsu + WS_QK); const bf16_t* VT = (const bf16_t*)(wsu + WS_VT);
                    if (idx < 4608) {
                        const int j = idx / 48, e = idx - j * 48, type3 = e >> 4, bh = e & 15, b = bh >> 2, h = bh & 3;
                        int qb, chunk; if (j < 64) { qb = 63 - (j >> 1); chunk = j & 1; } else { qb = 95 - j; chunk = 0; }
                        int kb_lo = 0, kb_hi = qb;
                        if (qb >= 32) { const int ks = (qb + 1) >> 1; if (chunk == 0) kb_hi = ks - 1; else kb_lo = ks; }
                        const size_t rowb = (size_t)b * SEQ; const int t = qb * 32 + r32;
                        bf16_t* SCRB = (bf16_t*)(wsu + WS_MERGED) + (size_t)(half * HT) * DM;
                        float* LSE2 = (float*)(wsu + WS_LSE2);
                        f32x16 o0, o1; float m, l; bf16_t* dst; int slot;
                        if (type3 == 2) {
                            LAS float* cl = scr;
                            const float bf = PP->b_forget[layer * 4 + h];
                            float run = 0.f;
                            if (lane <= kb_hi) {
                                const float* fp = FL + (rowb + 32 * lane) * 4 + h;
#pragma unroll 8
                                for (int i = 0; i < 32; ++i) { const float y = fp[4 * i] + bf; const float lf = fminf(y, 0.f) - __logf(1.0f + __expf(-fabsf(y))); run += lf; cl[33 * lane + i] = run; }
                            }
                            float incl = run;
#pragma unroll
                            for (int o = 1; o < 64; o <<= 1) { const float tt = __uint_as_float((unsigned)__builtin_amdgcn_ds_bpermute((lane - o) << 2, (int)__float_as_uint(incl))); if (lane >= o) incl += tt; }
                            const float excl = incl - run;
                            if (lane <= kb_hi) {
#pragma unroll 8
                                for (int i = 0; i < 32; ++i) cl[33 * lane + i] = -(cl[33 * lane + i] + excl) * LOG2E;
                            }
                            asm volatile("s_waitcnt lgkmcnt(0)" ::: "memory");
                            sm_unit<0>(QK + rowb * LDQK + 8 * 256 + h * 64, QK + rowb * LDQK + 9 * 256 + h * 64, VT + ((size_t)(b * 24 + 16 + h) * 64) * SEQ, qb, kb_hi, kb_lo, 0.f, cl, o0, o1, m, l, lane);
                            asm volatile("s_waitcnt lgkmcnt(0)" ::: "memory");
                            slot = chunk; dst = chunk ? SCRB + (rowb + t) * 256 + h * 64 : YS + (rowb + t) * DM + 512 + h * 64;
                        } else {
                            const float slope = exp2f(-8.0f * (float)(5 + h) / 16.0f);
                            sm_unit<2>(QK + rowb * LDQK + 10 * 256 + h * 64 + type3 * 32, QK + rowb * LDQK + 11 * 256 + h * 64 + type3 * 32, VT + ((size_t)(b * 24 + 20 + h) * 64) * SEQ, qb, kb_hi, kb_lo, slope * LOG2E, nullptr, o0, o1, m, l, lane);
                            slot = 2 + 2 * type3 + chunk;
                            dst = (type3 == 0 && chunk == 0) ? YS + (rowb + t) * DM + 768 + h * 64 : SCRB + (size_t)(2 * type3 + chunk) * HT * 256 + (rowb + t) * 256 + h * 64;
                        }
                        const float inv = 1.0f / l;
#pragma unroll
                        for (int i = 0; i < 16; ++i) { o0[i] *= inv; o1[i] *= inv; }
                        store_o(dst, o0, o1, hi);
                        if (hi == 0) LSE2[(rowb + t) * 24 + h * 6 + slot] = m + lg2(l);
                    } else if (idx < 5632) {
                        const int i1 = idx - 4608, qb = 63 - (i1 >> 4), bh = i1 & 15, b = bh >> 2, h = bh & 3;
                        const size_t rowb = (size_t)b * SEQ; const int t = qb * 32 + r32;
                        f32x16 o0, o1;
                        sb_unit(QK + rowb * LDQK + 0 * 256 + h * 64, QK + rowb * LDQK + 1 * 256 + h * 64, VT + ((size_t)(b * 24 + h) * 64) * SEQ, qb, o0, o1, lane);
                        store_o(YS + (rowb + t) * DM + 0 * 256 + h * 64, o0, o1, hi);
                    } else {
                        const int i2 = idx - 5632, j = i2 & 63, gh = (i2 >> 6) % 12, b = i2 / 768, gI = gh >> 2, h = gh & 3;
                        const int rsh = 2 * gI, r = 1 << rsh, sl = SEQ >> rsh, nubsh = 6 - rsh, rho = j >> nubsh, ub = j & ((1 << nubsh) - 1);
                        const int sidx = (gI == 0) ? h : (gI == 1 ? 8 + h : 12 + h);
                        const float slope = exp2f(-8.0f * (float)(sidx + 1) / 16.0f);
                        const size_t rowb = (size_t)b * SEQ + (size_t)rho * sl;
                        f32x16 o0, o1; float m, l;
                        const int kb_lo = (ub - 4 > 0) ? ub - 4 : 0;
                        sm_unit<1>(QK + rowb * LDQK + (2 + gI) * 256 + h * 64, QK + rowb * LDQK + (5 + gI) * 256 + h * 64,
                                   VT + ((size_t)(b * 24 + 4 + 4 * gI + h) * 64) * SEQ + (size_t)rho * sl, ub, ub, kb_lo, slope * (float)r * LOG2E, nullptr, o0, o1, m, l, lane);
                        const float inv = 1.0f / l;
#pragma unroll
                        for (int i = 0; i < 16; ++i) { o0[i] *= inv; o1[i] *= inv; }
                        const int u = ub * 32 + r32; const size_t tok = (size_t)b * SEQ + (size_t)u * r + rho;
                        store_o(DILO + tok * 768 + gI * 256 + h * 64, o0, o1, hi);
                        if (hi == 0) LSE[tok * 12 + gI * 4 + h] = (m + lg2(l)) * LN2;
                    }
                }
            }
#endif
            GSYNC();
            {
                PHASE_VARS();
                const float lam_init = (layer == 0) ? 0.2f : 0.35550906759093115f;
                float lam;
                { const float a = (lane < 32) ? PP->lq1[layer * 32 + lane] * PP->lk1[layer * 32 + lane] : 0.f, b = (lane < 32) ? PP->lq2[layer * 32 + lane] * PP->lk2[layer * 32 + lane] : 0.f;
                  lam = __expf(wave_sum(a)) - __expf(wave_sum(b)) + lam_init; }
                bf16_t* YS = (bf16_t*)(ws + WS_YS); const bf16_t* DILO = (const bf16_t*)(ws + WS_DILO); const float* LSE = (const float*)(ws + WS_LSE);
                const bf16_t* SCRB = (const bf16_t*)(ws + WS_MERGED) + (size_t)(half * HT) * DM; const float* LSE2 = (const float*)(ws + WS_LSE2);
                const int h = lane >> 4, dq = (lane & 15) * 4;
                const f32x4 dgv = *(const f32x4*)(PP->diff_g + layer * 64 + dq);
                for (int row = gw; row < HT; row += NGW) {
                    const bool split = ((row & (SEQ - 1)) >> 5) >= 32;
                    {
                        const float l0 = LSE[(size_t)row * 12 + h], l1 = LSE[(size_t)row * 12 + 4 + h], l2 = LSE[(size_t)row * 12 + 8 + h];
                        const float mx = fmaxf(l0, fmaxf(l1, l2)); const float e0 = __expf(l0 - mx), e1 = __expf(l1 - mx), e2 = __expf(l2 - mx); const float inv = 1.0f / (e0 + e1 + e2);
                        const u32x2 a = *(const u32x2*)(DILO + (size_t)row * 768 + 4 * lane), b = *(const u32x2*)(DILO + (size_t)row * 768 + 256 + 4 * lane), c = *(const u32x2*)(DILO + (size_t)row * 768 + 512 + 4 * lane);
                        const float w0 = e0 * inv, w1 = e1 * inv, w2 = e2 * inv;
                        u32x2 o; o.x = cvtpk(w0 * bflo(a.x) + w1 * bflo(b.x) + w2 * bflo(c.x), w0 * bfhi(a.x) + w1 * bfhi(b.x) + w2 * bfhi(c.x));
                        o.y = cvtpk(w0 * bflo(a.y) + w1 * bflo(b.y) + w2 * bflo(c.y), w0 * bfhi(a.y) + w1 * bfhi(b.y) + w2 * bfhi(c.y));
                        *(u32x2*)(YS + (size_t)row * DM + 256 + 4 * lane) = o;
                    }
                    const float* ls = LSE2 + (size_t)row * 24 + h * 6;
                    const u32x2 f0 = *(const u32x2*)(YS + (size_t)row * DM + 512 + 4 * lane), a0 = *(const u32x2*)(YS + (size_t)row * DM + 768 + 4 * lane);
                    const u32x2 b0 = *(const u32x2*)(SCRB + (size_t)2 * HT * 256 + (size_t)row * 256 + 4 * lane);
                    float fv[4] = {bflo(f0.x), bfhi(f0.x), bflo(f0.y), bfhi(f0.y)}, av[4] = {bflo(a0.x), bfhi(a0.x), bflo(a0.y), bfhi(a0.y)}, bv[4] = {bflo(b0.x), bfhi(b0.x), bflo(b0.y), bfhi(b0.y)};
                    if (split) {
                        const u32x2 f1 = *(const u32x2*)(SCRB + (size_t)row * 256 + 4 * lane), a1 = *(const u32x2*)(SCRB + (size_t)1 * HT * 256 + (size_t)row * 256 + 4 * lane), b1 = *(const u32x2*)(SCRB + (size_t)3 * HT * 256 + (size_t)row * 256 + 4 * lane);
                        const float lf0 = ls[0], lf1 = ls[1], la0 = ls[2], la1 = ls[3], lb0 = ls[4], lb1 = ls[5];
                        { const float mx = fmaxf(lf0, lf1), e0 = ex2(lf0 - mx), e1 = ex2(lf1 - mx), inv = 1.0f / (e0 + e1), w0 = e0 * inv, w1 = e1 * inv;
                          fv[0] = w0 * fv[0] + w1 * bflo(f1.x); fv[1] = w0 * fv[1] + w1 * bfhi(f1.x); fv[2] = w0 * fv[2] + w1 * bflo(f1.y); fv[3] = w0 * fv[3] + w1 * bfhi(f1.y); }
                        { const float mx = fmaxf(la0, la1), e0 = ex2(la0 - mx), e1 = ex2(la1 - mx), inv = 1.0f / (e0 + e1), w0 = e0 * inv, w1 = e1 * inv;
                          av[0] = w0 * av[0] + w1 * bflo(a1.x); av[1] = w0 * av[1] + w1 * bfhi(a1.x); av[2] = w0 * av[2] + w1 * bflo(a1.y); av[3] = w0 * av[3] + w1 * bfhi(a1.y); }
                        { const float mx = fmaxf(lb0, lb1), e0 = ex2(lb0 - mx), e1 = ex2(lb1 - mx), inv = 1.0f / (e0 + e1), w0 = e0 * inv, w1 = e1 * inv;
                          bv[0] = w0 * bv[0] + w1 * bflo(b1.x); bv[1] = w0 * bv[1] + w1 * bfhi(b1.x); bv[2] = w0 * bv[2] + w1 * bflo(b1.y); bv[3] = w0 * bv[3] + w1 * bfhi(b1.y); }
                        u32x2 fo; fo.x = cvtpk(fv[0], fv[1]); fo.y = cvtpk(fv[2], fv[3]);
                        *(u32x2*)(YS + (size_t)row * DM + 512 + 4 * lane) = fo;
                    }
                    float dv[4]; float ss = 0.f;
#pragma unroll
                    for (int i = 0; i < 4; ++i) { dv[i] = av[i] - lam * bv[i]; ss += dv[i] * dv[i]; }
                    ss += swz_xor<1>(ss); ss += swz_xor<2>(ss); ss += swz_xor<4>(ss); ss += swz_xor<8>(ss);
                    const float rn = __builtin_amdgcn_rsqf(ss * (1.0f / 64.0f) + RMS_EPS) * (1.0f - lam_init);
                    u32x2 dout; dout.x = cvtpk(dv[0] * rn * dgv[0], dv[1] * rn * dgv[1]); dout.y = cvtpk(dv[2] * rn * dgv[2], dv[3] * rn * dgv[3]);
                    *(u32x2*)(YS + (size_t)row * DM + 768 + 4 * lane) = dout;
                }
            }
            GSYNC();
#ifndef NO_P3
            for (int rep = 0; rep < REP_P3; ++rep) {
                PHASE_VARS();
                pg8::Gemm g{(const bf16_t*)(ws + WS_YS), (const bf16_t*)(ws + WS_WB), DM, 512, 512, 512 * 2, (long)8 * 256 * 512 * 2};
                pg8::BranchOrder S{bx, G};
                pg8::EpiBranch E{(const bf16_t*)(ws + WS_GATE), (bf16_t*)(ws + WS_MERGED), half * HT};
                pg8::gemm_phase<pg8::EpiBranch, pg8::BranchOrder, false>(lds, g, S, E);
            }
#endif
            GSYNC();
        }
#ifndef NO_P4
        for (int rep = 0; rep < REP_CONV; ++rep) {
            PHASE_VARS();
            bf16_t* WUP = (bf16_t*)(ws + WS_WUP); bf16_t* WDN = (bf16_t*)(ws + WS_WDN);
            const float* wu = PP->w_up + (size_t)layer * DM * DFF; const float* wd = PP->w_down + (size_t)layer * DFF * DM; const float* mg = PP->mlp_g + (size_t)layer * DM;
            constexpr int I_U = (DM / 64) * (DFF / 32), I_D = (DFF / 64) * (DM / 32);
            for (int it = gw; it < I_U + I_D; it += NGW) {
                if (it < I_U) transpose_item<0>(wu, DM, DFF, DFF, mg, WUP, scr, it, lane);
                else transpose_item<0>(wd, DFF, DM, DM, nullptr, WDN, scr, it - I_U, lane);
            }
            __syncthreads();
        }
        {
            PHASE_VARS();
            pg8::Gemm g{(const bf16_t*)(ws + WS_MERGED), (const bf16_t*)(ws + WS_WOUT), DM, DM, DM, 0, 0};
            pg8::StaticOrder S; S.init(TOK, DM, G, bx);
            pg8::EpiResid E{PP->out, (bf16_t*)(ws + WS_XB), (float*)(ws + WS_SSQ)};
            pg8::gemm_phase<pg8::EpiResid, pg8::StaticOrder, false>(lds, g, S, E);
        }
#endif
        GSYNC();
#ifndef NO_P5
        for (int rep = 0; rep < REP_P5; ++rep) {
            PHASE_VARS();
            pg8::Gemm g{(const bf16_t*)(ws + WS_XB), (const bf16_t*)(ws + WS_WUP), DM, DM, DM, 0, 0};
            pg8::StaticOrder S; S.init(TOK, DFF, G, bx);
            pg8::EpiUp E{(const float*)(ws + WS_SSQ), (bf16_t*)(ws + WS_HMLP)};
            pg8::gemm_phase<pg8::EpiUp, pg8::StaticOrder, true>(lds, g, S, E);
        }
#endif
        GSYNC();
#ifndef NO_P6
        {
            PHASE_VARS();
            pg8::Gemm g{(const bf16_t*)(ws + WS_HMLP), (const bf16_t*)(ws + WS_WDN), DFF, DFF, DFF, 0, 0};
            pg8::StaticOrder S; S.init(TOK, DM, G, bx);
            pg8::EpiResid E{PP->out, (bf16_t*)(ws + WS_XB), (float*)(ws + WS_SSQ)};
            pg8::gemm_phase<pg8::EpiResid, pg8::StaticOrder, false>(lds, g, S, E);
        }
#endif
        GSYNC();
    }
    {
        PHASE_VARS();
        float* X = PP->out;
        for (int row = gw; row < TOK; row += NGW) {
            f32x4* xo = (f32x4*)(X + (size_t)row * DM) + lane; const f32x4* gp = (const f32x4*)PP->final_g + lane;
            f32x4 v[4]; float s = 0.f;
#pragma unroll
            for (int j = 0; j < 4; ++j) { v[j] = xo[64 * j]; s += (v[j][0] * v[j][0] + v[j][1] * v[j][1]) + (v[j][2] * v[j][2] + v[j][3] * v[j][3]); }
            const float rstd = __builtin_amdgcn_rsqf(wave_sum(s) * (1.0f / DM) + RMS_EPS);
#pragma unroll
            for (int j = 0; j < 4; ++j) xo[64 * j] = v[j] * rstd * gp[64 * j];
        }
    }
}

extern "C" void kernel_launch(void* const* d_in, const int* in_sizes, int n_in, void* d_out, int out_size, void* d_ws, size_t ws_size, hipStream_t stream) {
    static int grid = 0;
    if (grid == 0) {
        if (n_in != 15 || in_sizes[0] != TOK * DM || out_size != TOK * DM || ws_size < WS_END) { fprintf(stderr, "kernel_launch: unexpected shapes / workspace (n_in %d, ws %zu)\n", n_in, ws_size); grid = -1; return; }
        int dev = 0, cus = 0, per_cu = 0;
        hipGetDevice(&dev); hipDeviceGetAttribute(&cus, hipDeviceAttributeMultiprocessorCount, dev);
        hipFuncSetAttribute((const void*)fwd_mega, hipFuncAttributeMaxDynamicSharedMemorySize, LDS_BYTES);
        hipOccupancyMaxActiveBlocksPerMultiprocessor(&per_cu, (const void*)fwd_mega, NWAVES * 64, LDS_BYTES);
        (void)hipGetLastError();
        if (per_cu < 1) per_cu = 1;
        grid = cus;
        if (grid > 256) grid = 256;
        if (grid % 8 != 0) { fprintf(stderr, "kernel_launch: the per-XCD work queues need a grid that is a multiple of 8 (got %d)\n", grid); grid = -1; return; }
    }
    if (grid < 0) return;
    hipMemsetAsync((char*)d_ws + WS_CTL, 0, CTL_BYTES, stream);
    Params p{};
    p.x = (const float*)d_in[0]; p.mix_g = (const float*)d_in[1]; p.w_in = (const float*)d_in[2]; p.b_forget = (const float*)d_in[3];
    p.lq1 = (const float*)d_in[4]; p.lk1 = (const float*)d_in[5]; p.lq2 = (const float*)d_in[6]; p.lk2 = (const float*)d_in[7];
    p.diff_g = (const float*)d_in[8]; p.w_branch = (const float*)d_in[9]; p.w_out = (const float*)d_in[10]; p.mlp_g = (const float*)d_in[11];
    p.w_up = (const float*)d_in[12]; p.w_down = (const float*)d_in[13]; p.final_g = (const float*)d_in[14];
    p.out = (float*)d_out; p.ws = (unsigned char*)d_ws;
    void* args[] = {&p};
    hipError_t e = hipLaunchCooperativeKernel((const void*)fwd_mega, dim3(grid), dim3(NWAVES * 64), args, LDS_BYTES, stream);
    if (e != hipSuccess) fprintf(stderr, "cooperative launch failed: %s (grid %d)\n", hipGetErrorString(e), grid);
}
```

```cpp
#include <hip/hip_runtime.h>
#include <hip/hip_cooperative_groups.h>
#include <cstdio>
#include <cstdint>
namespace cg = cooperative_groups;

#define LAS __attribute__((address_space(3)))
typedef unsigned short bf16_t;
typedef short bf16x8 __attribute__((ext_vector_type(8)));
typedef float f32x4 __attribute__((ext_vector_type(4)));
typedef float f32x16 __attribute__((ext_vector_type(16)));
typedef unsigned u32x4 __attribute__((ext_vector_type(4)));
typedef unsigned u32x2 __attribute__((ext_vector_type(2)));
typedef float f32x2_t __attribute__((ext_vector_type(2)));
typedef __bf16 bf16x2_t __attribute__((ext_vector_type(2)));

constexpr int DM = 1024, BATCH = 8, SEQ = 2048, DEPTH = 2, TOK = BATCH * SEQ, DFF = 4096, DIN = 8708;
constexpr int HT = TOK / 2;
constexpr int NPROJ = 35 * 256;
constexpr int LDQK = 12 * 256;
constexpr float LOG2E = 1.4426950408889634f, LN2 = 0.6931471805599453f;
constexpr float RMS_EPS = 1e-6f;

constexpr size_t MiB = 1u << 20;
constexpr size_t WS_CTL = 0, CTL_BYTES = 65536;
constexpr int CW_BAR = 4096;
constexpr size_t WS_SSQ = 1 * MiB;
constexpr size_t WS_WIN = 2 * MiB;
constexpr size_t WS_WUP = WS_WIN, WS_WDN = WS_WIN + 8 * MiB;
constexpr size_t WS_WB = 20 * MiB;
constexpr size_t WS_WOUT = 24 * MiB;
constexpr size_t WS_XB = 26 * MiB;
constexpr size_t WS_MERGED = 58 * MiB;
constexpr size_t WS_YS = 90 * MiB;
constexpr size_t WS_DILO = 106 * MiB;
constexpr size_t WS_LSE = 118 * MiB;
constexpr size_t WS_LSE2 = 118 * MiB + 512 * 1024;
constexpr size_t WS_FL = 119 * MiB + 512 * 1024;
constexpr size_t WS_QK = 120 * MiB;
constexpr size_t WS_VT = 168 * MiB;
constexpr size_t WS_GATE = 192 * MiB;
constexpr size_t WS_HMLP = 120 * MiB;
constexpr size_t WS_END = 256 * MiB;

constexpr int LDS_BYTES = 147456;
constexpr int NWAVES = 8;

__device__ __forceinline__ unsigned cvtpk(float lo, float hi) { f32x2_t v = {lo, hi}; bf16x2_t b = __builtin_convertvector(v, bf16x2_t); return __builtin_bit_cast(unsigned, b); }
__device__ __forceinline__ float bflo(unsigned w) { return __uint_as_float(w << 16); }
__device__ __forceinline__ float bfhi(unsigned w) { return __uint_as_float(w & 0xffff0000u); }
__device__ __forceinline__ float ex2(float x) { return __builtin_amdgcn_exp2f(x); }
__device__ __forceinline__ float lg2(float x) { return __builtin_amdgcn_logf(x); }
__device__ __forceinline__ float x32_sum(float v) { auto r = __builtin_amdgcn_permlane32_swap(__float_as_uint(v), __float_as_uint(v), false, false); return __uint_as_float(r[0]) + __uint_as_float(r[1]); }
__device__ __forceinline__ float x32_max(float v) { auto r = __builtin_amdgcn_permlane32_swap(__float_as_uint(v), __float_as_uint(v), false, false); return fmaxf(__uint_as_float(r[0]), __uint_as_float(r[1])); }
__device__ __forceinline__ float x32_partner(float v, int hi) { auto r = __builtin_amdgcn_permlane32_swap(__float_as_uint(v), __float_as_uint(v), false, false); return hi ? __uint_as_float(r[0]) : __uint_as_float(r[1]); }
template <int X> __device__ __forceinline__ float swz_xor(float v) { return __uint_as_float((unsigned)__builtin_amdgcn_ds_swizzle((int)__float_as_uint(v), (X << 10) | 0x1f)); }
__device__ __forceinline__ float x16_sum(float v) { return v + swz_xor<16>(v); }
__device__ __forceinline__ float wave_sum(float v) { v += swz_xor<1>(v); v += swz_xor<2>(v); v += swz_xor<4>(v); v += swz_xor<8>(v); v += swz_xor<16>(v); return x32_sum(v); }

namespace pg8 {
constexpr int BM = 256, BK = 64, HALF = 128, HTB = HALF * BK * 2, STAGE_BYTES = 8 * HTB, NXCD = 8, WGM = 8;
__host__ __device__ __forceinline__ int lds_byte(int r, int c) { const int st = (r >> 4) * 2 + (c >> 5), rr = r & 15, cc = c & 31, ob = rr * 64 + cc * 2; return st * 1024 + (ob ^ (((ob >> 9) & 1) << 5)); }
__host__ __device__ __forceinline__ void stage_rc(int b, int& R, int& C) { const int st = b / 1024, sb = b % 1024, swz = sb ^ (((sb >> 9) & 1) << 5); R = (st >> 1) * 16 + swz / 64; C = (st & 1) * 32 + (swz % 64) / 2; }
__host__ __device__ __forceinline__ int perm32(int rho) { const int n = rho >> 4, i = rho & 15; return 8 * (i >> 2) + 4 * n + (i & 3); }

struct Unit { int pm, pn, aux; };
struct Gemm { const bf16_t* A; const bf16_t* Bt; int lda, ldb, K; long a_aux, b_aux; };

struct StaticOrder {
    int nM, nN, nwg, G, c;
    __device__ void init(int M, int N, int G_, int c_) { nM = M / BM; nN = N / BM; nwg = nM * nN; G = G_; c = c_; }
    __device__ bool next(int i, Unit& u) const {
        const long L = (long)i * G + c; if (L >= nwg) return false;
        int wgid = (int)L; { const int q = nwg / NXCD, r = nwg % NXCD, xcd = wgid % NXCD, off = wgid / NXCD; wgid = (xcd < r ? xcd * (q + 1) : r * (q + 1) + (xcd - r) * q) + off; }
        const int nig = WGM * nN, gid = wgid / nig, fm = gid * WGM, gsz = (nM - fm) < WGM ? (nM - fm) : WGM;
        u.pm = fm + ((wgid % nig) % gsz); u.pn = (wgid % nig) / gsz; u.aux = 0; return true;
    }
};
struct BranchOrder {
    int c, G;
    __device__ bool next(int i, Unit& u) const { const int t = c + (i >> 1) * G; if (t >= 256) return false; u.pm = t >> 3; u.pn = t & 7; u.aux = i & 1; return true; }
};

template <class Epi, class Sched, bool ALIGN_EPI>
__device__ __forceinline__ void gemm_phase(LAS unsigned char* lds, const Gemm g, const Sched& S, const Epi& E) {
    int tid_ = threadIdx.x; asm volatile("" : "+v"(tid_));
    const int tid = tid_, wid = __builtin_amdgcn_readfirstlane(tid >> 6), lane = tid & 63, wr = wid >> 2, wc = wid & 3, fr = lane & 15, fq = lane >> 4;
    int nt_ = g.K / BK; asm volatile("" : "+s"(nt_)); const int nt = nt_;
    unsigned voffA[2], voffB[2];
#pragma unroll
    for (int i = 0; i < 2; ++i) { int R, C; stage_rc(tid * 16 + i * 8192, R, C); const int Rb = Epi::PERM ? ((R & ~31) + perm32(R & 31)) : R;
        voffA[i] = (unsigned)(R * g.lda + C) * 2u; voffB[i] = (unsigned)(Rb * g.ldb + C) * 2u; }
    const size_t kstep = (size_t)(BK * 2);
    const size_t hstepA = (size_t)HALF * g.lda * 2, hstepB = (size_t)HALF * g.ldb * 2;
    const size_t tstepA = 2 * hstepA, tstepB = 2 * hstepB;
    const unsigned ldsw = (unsigned)wid * 1024u;
    const int aoff = lds_byte(wr * 64 + fr, fq * 8), boff = lds_byte(wc * 32 + fr, fq * 8);
#define PG8_SA(b, h) (((b) * 2 + (h)) * HTB)
#define PG8_SB(b, h) ((4 + (b) * 2 + (h)) * HTB)
#define PG8_STAGE(bufoff, gbase, voff) do { _Pragma("unroll") for (int _i = 0; _i < 2; ++_i) \
        __builtin_amdgcn_global_load_lds((const unsigned*)((const char*)(gbase) + (voff)[_i]), (LAS unsigned*)(lds + (bufoff) + ldsw + _i * 8192), 16, 0, 0); } while (0)
#define PG8_LDA(dst, b, h) do { _Pragma("unroll") for (int m = 0; m < 4; ++m) _Pragma("unroll") for (int k = 0; k < 2; ++k) dst[m][k] = *(const LAS bf16x8*)(lds + PG8_SA(b, h) + aoff + m * 2048 + k * 1024); } while (0)
#define PG8_LDB(dst, b, h) do { _Pragma("unroll") for (int n = 0; n < 2; ++n) _Pragma("unroll") for (int k = 0; k < 2; ++k) dst[n][k] = *(const LAS bf16x8*)(lds + PG8_SB(b, h) + boff + n * 2048 + k * 1024); } while (0)
#define PG8_MMA(ai, bj, At, Bt) do { __builtin_amdgcn_s_setprio(1); _Pragma("unroll") for (int m = 0; m < 4; ++m) _Pragma("unroll") for (int n = 0; n < 2; ++n) _Pragma("unroll") for (int k = 0; k < 2; ++k) \
        acc[ai][bj][m][n] = __builtin_amdgcn_mfma_f32_16x16x32_bf16(Bt[n][k], At[m][k], acc[ai][bj][m][n], 0, 0, 0); __builtin_amdgcn_s_setprio(0); } while (0)
#define PG8_WAIT_V(n) asm volatile("s_waitcnt vmcnt(" #n ")" ::: "memory")
#define PG8_WAIT_L(n) asm volatile("s_waitcnt lgkmcnt(" #n ")" ::: "memory")
#define PG8_BAR __builtin_amdgcn_s_barrier()
#define PG8_SCHED __builtin_amdgcn_sched_barrier(0)
#define PG8_UA(u) ((const char*)g.A + (size_t)(u).pm * tstepA + (size_t)(u).aux * (size_t)g.a_aux)
#define PG8_UB(u) ((const char*)g.Bt + (size_t)(u).pn * tstepB + (size_t)(u).aux * (size_t)g.b_aux)
    Unit cur, nxt; int ui = 0;
    if (!S.next(0, cur)) return;
    f32x4 acc[2][2][4][2];
#pragma unroll
    for (int a = 0; a < 2; ++a)
#pragma unroll
        for (int b = 0; b < 2; ++b)
#pragma unroll
            for (int m = 0; m < 4; ++m)
#pragma unroll
                for (int n = 0; n < 2; ++n) acc[a][b][m][n] = (f32x4){0.f, 0.f, 0.f, 0.f};
    bf16x8 At[4][2], B0[2][2], B1[2][2];
    const char* cA = PG8_UA(cur); const char* cB = PG8_UB(cur);
    PG8_STAGE(PG8_SB(0, 0), cB, voffB); PG8_STAGE(PG8_SB(0, 1), cB + hstepB, voffB); PG8_STAGE(PG8_SA(0, 0), cA, voffA); PG8_STAGE(PG8_SA(0, 1), cA + hstepA, voffA);
    if (wr == 1) PG8_BAR;
    PG8_WAIT_V(2); PG8_BAR;
    PG8_STAGE(PG8_SB(1, 0), cB + kstep, voffB); PG8_STAGE(PG8_SA(1, 0), cA + kstep, voffA); PG8_STAGE(PG8_SB(1, 1), cB + hstepB + kstep, voffB);
    PG8_WAIT_V(6); PG8_BAR;
    for (;;) {
        const bool has_next = S.next(ui + 1, nxt);
        const char* nA = has_next ? PG8_UA(nxt) : cA; const char* nB = has_next ? PG8_UB(nxt) : cB;
        for (int t = 0; t < nt; t += 2) {
            const bool last = (t == nt - 2);
            const char* a1 = cA + (size_t)(t + 1) * kstep;
            const char* a2 = last ? nA : cA + (size_t)(t + 2) * kstep; const char* b2 = last ? nB : cB + (size_t)(t + 2) * kstep;
            const char* a3 = a2 + kstep; const char* b3 = b2 + kstep;
            PG8_LDB(B0, 0, 0); PG8_LDB(B1, 0, 1); PG8_SCHED; PG8_LDA(At, 0, 0); PG8_STAGE(PG8_SA(1, 1), a1 + hstepA, voffA);
            PG8_WAIT_V(8); PG8_WAIT_L(0); PG8_BAR; PG8_MMA(0, 0, At, B0); PG8_MMA(0, 1, At, B1); PG8_BAR; PG8_SCHED;
            PG8_LDA(At, 0, 1); PG8_STAGE(PG8_SB(0, 0), b2, voffB); PG8_STAGE(PG8_SB(0, 1), b2 + hstepB, voffB); PG8_STAGE(PG8_SA(0, 0), a2, voffA);
            PG8_WAIT_V(8); PG8_WAIT_L(0); PG8_BAR; PG8_MMA(1, 0, At, B0); PG8_MMA(1, 1, At, B1); PG8_BAR; PG8_SCHED;
            PG8_LDB(B0, 1, 0); PG8_LDB(B1, 1, 1); PG8_SCHED; PG8_LDA(At, 1, 0); PG8_STAGE(PG8_SA(0, 1), a2 + hstepA, voffA);
            PG8_WAIT_V(8); PG8_WAIT_L(0); PG8_BAR; PG8_MMA(0, 0, At, B0); PG8_MMA(0, 1, At, B1); PG8_BAR; PG8_SCHED;
            PG8_LDA(At, 1, 1); PG8_STAGE(PG8_SB(1, 0), b3, voffB); PG8_STAGE(PG8_SB(1, 1), b3 + hstepB, voffB); PG8_STAGE(PG8_SA(1, 0), a3, voffA);
            PG8_WAIT_V(8); PG8_WAIT_L(0); PG8_BAR; PG8_MMA(1, 0, At, B0); PG8_MMA(1, 1, At, B1); PG8_BAR; PG8_SCHED;
        }
        if constexpr (ALIGN_EPI) { if (wr == 0) PG8_BAR; }
        { Unit eu = cur; asm volatile("" : "+s"(eu.pm), "+s"(eu.pn), "+s"(eu.aux)); E(acc, eu, wr, wc, fr, fq); }
        if (!has_next) break;
#pragma unroll
        for (int a = 0; a < 2; ++a)
#pragma unroll
            for (int b = 0; b < 2; ++b)
#pragma unroll
                for (int m = 0; m < 4; ++m)
#pragma unroll
                    for (int n = 0; n < 2; ++n) acc[a][b][m][n] = (f32x4){0.f, 0.f, 0.f, 0.f};
        cur = nxt; cA = nA; cB = nB; ++ui;
        if constexpr (ALIGN_EPI) { if (wr == 1) PG8_BAR; }
    }
    PG8_WAIT_V(0);
    if constexpr (!ALIGN_EPI) { if (wr == 0) PG8_BAR; }
    PG8_BAR;
#undef PG8_SA
#undef PG8_SB
#undef PG8_STAGE
#undef PG8_LDA
#undef PG8_LDB
#undef PG8_MMA
#undef PG8_WAIT_V
#undef PG8_WAIT_L
#undef PG8_BAR
#undef PG8_SCHED
#undef PG8_UA
#undef PG8_UB
}

__device__ __forceinline__ float row_rstd(const float* ssq, int row, int fq) {
    const f32x4 a = *(const f32x4*)(ssq + (size_t)row * 16 + 4 * fq);
    float s = (a[0] + a[1]) + (a[2] + a[3]);
    s = x16_sum(s); s = x32_sum(s);
    return __builtin_amdgcn_rsqf(s * (1.0f / DM) + RMS_EPS);
}
__device__ __forceinline__ int pos16(int o) { return 8 * ((o >> 2) & 1) + 4 * (o >> 3) + (o & 3); }

struct EpiProj {
    static constexpr bool PERM = true;
    const float* ssq; int row_base; bf16_t* QK; bf16_t* VT; float* FL; bf16_t* GATE;
    __device__ __forceinline__ void operator()(const f32x4 (&acc)[2][2][4][2], const Unit& u, int wr, int wc, int fr, int fq) const {
        const int pn = u.pn;
        const int lrow0 = u.pm * BM + wr * 64 + fr;
        float rs[2][4];
#pragma unroll
        for (int ai = 0; ai < 2; ++ai)
#pragma unroll
            for (int m = 0; m < 4; ++m) rs[ai][m] = row_rstd(ssq, row_base + lrow0 + ai * HALF + m * 16, fq);
        const int cin = wc * 32 + 8 * fq;
        if (pn >= 19) {
#pragma unroll
            for (int ai = 0; ai < 2; ++ai)
#pragma unroll
                for (int m = 0; m < 4; ++m) { const int lrow = lrow0 + ai * HALF + m * 16; const float s = rs[ai][m];
#pragma unroll
                    for (int bj = 0; bj < 2; ++bj) { const f32x4 v0 = acc[ai][bj][m][0] * s, v1 = acc[ai][bj][m][1] * s;
                        u32x4 w; w.x = cvtpk(v0[0], v0[1]); w.y = cvtpk(v0[2], v0[3]); w.z = cvtpk(v1[0], v1[1]); w.w = cvtpk(v1[2], v1[3]);
                        *(u32x4*)(GATE + (size_t)lrow * 4096 + (pn - 19) * 256 + bj * HALF + cin) = w; } }
        } else if (pn == 18) {
            if (wc == 0 && fq == 0) {
#pragma unroll
                for (int ai = 0; ai < 2; ++ai)
#pragma unroll
                    for (int m = 0; m < 4; ++m) { const int lrow = lrow0 + ai * HALF + m * 16; *(f32x4*)(FL + (size_t)lrow * 4) = acc[ai][0][m][0] * rs[ai][m]; }
            }
        } else if (pn == 2 || (pn >= 9 && pn <= 11) || pn == 14 || pn == 17) {
            int vhb, rsh;
            if (pn == 2) { vhb = 0; rsh = 0; } else if (pn == 14) { vhb = 16; rsh = 0; } else if (pn == 17) { vhb = 20; rsh = 0; } else { const int gI = pn - 9; vhb = 4 + 4 * gI; rsh = 2 * gI; }
            const int slsh = 11 - rsh, rmask = (1 << rsh) - 1;
#pragma unroll
            for (int ai = 0; ai < 2; ++ai)
#pragma unroll
                for (int m = 0; m < 4; ++m) { const int lrow = lrow0 + ai * HALF + m * 16; const float s = rs[ai][m];
                    const int bl = lrow >> 11, t = lrow & (SEQ - 1); int p = ((t & rmask) << slsh) + (t >> rsh); p = (p & ~15) | pos16(p & 15);
                    bf16_t* base = VT + (size_t)bl * 24 * 64 * SEQ + p;
#pragma unroll
                    for (int bj = 0; bj < 2; ++bj) { const int c0 = bj * HALF + cin; bf16_t* bp = base + (size_t)(vhb * 64 + c0) * SEQ;
                        const f32x4 v0 = acc[ai][bj][m][0] * s, v1 = acc[ai][bj][m][1] * s;
                        const unsigned w0 = cvtpk(v0[0], v0[1]), w1 = cvtpk(v0[2], v0[3]), w2 = cvtpk(v1[0], v1[1]), w3 = cvtpk(v1[2], v1[3]);
                        bp[0 * SEQ] = (bf16_t)(w0 & 0xffff); bp[1 * SEQ] = (bf16_t)(w0 >> 16); bp[2 * SEQ] = (bf16_t)(w1 & 0xffff); bp[3 * SEQ] = (bf16_t)(w1 >> 16);
                        bp[4 * SEQ] = (bf16_t)(w2 & 0xffff); bp[5 * SEQ] = (bf16_t)(w2 >> 16); bp[6 * SEQ] = (bf16_t)(w3 & 0xffff); bp[7 * SEQ] = (bf16_t)(w3 >> 16); } }
        } else {
            int slot, rsh = 0;
            if (pn <= 1) slot = pn; else if (pn <= 8) { slot = pn - 1; const int gI = (pn - 3) % 3; rsh = 2 * gI; } else if (pn <= 13) slot = pn - 4; else slot = pn - 5;
            const int slsh = 11 - rsh, rmask = (1 << rsh) - 1;
#pragma unroll
            for (int ai = 0; ai < 2; ++ai)
#pragma unroll
                for (int m = 0; m < 4; ++m) { const int lrow = lrow0 + ai * HALF + m * 16; const float s = rs[ai][m];
                    const int bl = lrow >> 11, t = lrow & (SEQ - 1); const int prow = bl * SEQ + ((t & rmask) << slsh) + (t >> rsh);
#pragma unroll
                    for (int bj = 0; bj < 2; ++bj) { const f32x4 v0 = acc[ai][bj][m][0] * s, v1 = acc[ai][bj][m][1] * s;
                        u32x4 w; w.x = cvtpk(v0[0], v0[1]); w.y = cvtpk(v0[2], v0[3]); w.z = cvtpk(v1[0], v1[1]); w.w = cvtpk(v1[2], v1[3]);
                        *(u32x4*)(QK + (size_t)prow * LDQK + slot * 256 + bj * HALF + cin) = w; } }
        }
    }
};

struct EpiBranch {
    static constexpr bool PERM = true;
    const bf16_t* GATE; bf16_t* MERGED; int row_base;
    __device__ __forceinline__ static float sg(float g) { return __builtin_amdgcn_rcpf(1.0f + ex2(-g * LOG2E)); }
    __device__ __forceinline__ static u32x4 mix(const u32x4 ga, const u32x4 gb, const u32x4 ow, const f32x4 a0, const f32x4 a1, const f32x4 b0, const f32x4 b1) {
        const float o0 = sg(bflo(ga.x)) * a0[0] + sg(bflo(gb.x)) * b0[0] + bflo(ow.x), o1 = sg(bfhi(ga.x)) * a0[1] + sg(bfhi(gb.x)) * b0[1] + bfhi(ow.x);
        const float o2 = sg(bflo(ga.y)) * a0[2] + sg(bflo(gb.y)) * b0[2] + bflo(ow.y), o3 = sg(bfhi(ga.y)) * a0[3] + sg(bfhi(gb.y)) * b0[3] + bfhi(ow.y);
        const float o4 = sg(bflo(ga.z)) * a1[0] + sg(bflo(gb.z)) * b1[0] + bflo(ow.z), o5 = sg(bfhi(ga.z)) * a1[1] + sg(bfhi(gb.z)) * b1[1] + bfhi(ow.z);
        const float o6 = sg(bflo(ga.w)) * a1[2] + sg(bflo(gb.w)) * b1[2] + bflo(ow.w), o7 = sg(bfhi(ga.w)) * a1[3] + sg(bfhi(gb.w)) * b1[3] + bfhi(ow.w);
        u32x4 w; w.x = cvtpk(o0, o1); w.y = cvtpk(o2, o3); w.z = cvtpk(o4, o5); w.w = cvtpk(o6, o7); return w;
    }
    __device__ __forceinline__ void operator()(const f32x4 (&acc)[2][2][4][2], const Unit& u, int wr, int wc, int fr, int fq) const {
        const int p = u.aux; const int lrow0 = u.pm * BM + wr * 64 + fr; const int d0 = u.pn * 128 + wc * 32 + 8 * fq;
        const bf16_t* gbase = GATE + (size_t)lrow0 * 4096 + (2 * p) * 1024 + d0; bf16_t* mbase = MERGED + (size_t)(row_base + lrow0) * DM + d0;
        const u32x4 zero = {0u, 0u, 0u, 0u};
#pragma unroll
        for (int ai = 0; ai < 2; ++ai)
#pragma unroll
            for (int mp = 0; mp < 2; ++mp) {
                u32x4 ga[2], gb[2], ow[2];
#pragma unroll
                for (int mm = 0; mm < 2; ++mm) { const size_t ro = (size_t)(ai * HALF + (2 * mp + mm) * 16);
                    ga[mm] = *(const u32x4*)(gbase + ro * 4096); gb[mm] = *(const u32x4*)(gbase + ro * 4096 + 1024);
                    ow[mm] = zero; if (p > 0) ow[mm] = *(const u32x4*)(mbase + ro * DM); }
#pragma unroll
                for (int mm = 0; mm < 2; ++mm) { const int m = 2 * mp + mm; const size_t ro = (size_t)(ai * HALF + m * 16);
                    *(u32x4*)(mbase + ro * DM) = mix(ga[mm], gb[mm], ow[mm], acc[ai][0][m][0], acc[ai][0][m][1], acc[ai][1][m][0], acc[ai][1][m][1]); }
                asm volatile("" ::: "memory");
            }
    }
};

struct EpiResid {
    static constexpr bool PERM = true;
    float* X; bf16_t* XB; float* ssq;
    __device__ __forceinline__ void operator()(const f32x4 (&acc)[2][2][4][2], const Unit& u, int wr, int wc, int fr, int fq) const {
        const int row0 = u.pm * BM + wr * 64 + fr; const int col0 = u.pn * BM + wc * 32 + 8 * fq;
#pragma unroll
        for (int ai = 0; ai < 2; ++ai)
#pragma unroll
            for (int m = 0; m < 4; ++m) { const int row = row0 + ai * HALF + m * 16; float sq = 0.f;
#pragma unroll
                for (int bj = 0; bj < 2; ++bj) { const int col = col0 + bj * HALF; f32x4* xp = (f32x4*)(X + (size_t)row * DM + col);
                    const f32x4 x0 = xp[0] + acc[ai][bj][m][0], x1 = xp[1] + acc[ai][bj][m][1];
                    xp[0] = x0; xp[1] = x1;
                    u32x4 w; w.x = cvtpk(x0[0], x0[1]); w.y = cvtpk(x0[2], x0[3]); w.z = cvtpk(x1[0], x1[1]); w.w = cvtpk(x1[2], x1[3]);
                    *(u32x4*)(XB + (size_t)row * DM + col) = w;
                    sq += (x0[0] * x0[0] + x0[1] * x0[1]) + (x0[2] * x0[2] + x0[3] * x0[3]) + (x1[0] * x1[0] + x1[1] * x1[1]) + (x1[2] * x1[2] + x1[3] * x1[3]); }
                sq = x16_sum(sq); sq = x32_sum(sq);
                if (fq == 0) ssq[(size_t)row * 16 + u.pn * 4 + wc] = sq; if (m & 1) asm volatile("" ::: "memory"); }
    }
};

struct EpiUp {
    static constexpr bool PERM = true;
    const float* ssq; bf16_t* H;
    __device__ __forceinline__ void operator()(const f32x4 (&acc)[2][2][4][2], const Unit& u, int wr, int wc, int fr, int fq) const {
        const int row0 = u.pm * BM + wr * 64 + fr; const int col0 = u.pn * BM + wc * 32 + 8 * fq;
        float rs[2][4];
#pragma unroll
        for (int ai = 0; ai < 2; ++ai)
#pragma unroll
            for (int m = 0; m < 4; ++m) rs[ai][m] = row_rstd(ssq, row0 + ai * HALF + m * 16, fq);
#pragma unroll
        for (int ai = 0; ai < 2; ++ai)
#pragma unroll
            for (int m = 0; m < 4; ++m) { const int row = row0 + ai * HALF + m * 16; const float s = rs[ai][m];
#pragma unroll
                for (int bj = 0; bj < 2; ++bj) { f32x4 v0 = acc[ai][bj][m][0] * s, v1 = acc[ai][bj][m][1] * s;
#pragma unroll
                    for (int i = 0; i < 4; ++i) { const float a = fmaxf(v0[i], 0.f), b = fmaxf(v1[i], 0.f); v0[i] = a * a; v1[i] = b * b; }
                    u32x4 w; w.x = cvtpk(v0[0], v0[1]); w.y = cvtpk(v0[2], v0[3]); w.z = cvtpk(v1[0], v1[1]); w.w = cvtpk(v1[2], v1[3]);
                    *(u32x4*)(H + (size_t)row * DFF + col0 + bj * HALF) = w; } }
    }
};
}

__device__ __forceinline__ int win_src(int n) {
    if (n < 3840) return n;
    if (n < 4608) return n + 4;
    if (n < 4864) return (n - 4608 < 4) ? 3840 + (n - 4608) : -1;
    return n - 4864 + 4612;
}
template <int CMAP>
__device__ __forceinline__ void transpose_item(const float* W, int K, int N, int Nsrc, const float* gain, bf16_t* WT, LAS float* scr, int item, int lane) {
    const int nblk = N / 32, kb = item / nblk, nb = item % nblk, k0 = 64 * kb, n0 = 32 * nb;
    const int n = n0 + (lane & 31); const int src = CMAP ? win_src(n) : n;
    const bool live = (src >= 0); const float* wp = W + (size_t)(k0 + (lane >> 5)) * Nsrc + (live ? src : 0); const float* gp = gain ? gain + k0 + (lane >> 5) : nullptr;
    float wv[32];
#pragma unroll
    for (int i = 0; i < 32; ++i) wv[i] = wp[(size_t)(2 * i) * Nsrc];
#pragma unroll
    for (int i = 0; i < 32; ++i) { float v = live ? wv[i] : 0.f; if (gp) v *= gp[2 * i]; scr[(2 * i + (lane >> 5)) * 33 + (lane & 31)] = v; }
    asm volatile("s_waitcnt lgkmcnt(0)" ::: "memory");
    const int c = lane & 7;
#pragma unroll
    for (int j = 0; j < 4; ++j) { const int nn = (lane >> 3) + 8 * j; const LAS float* s = scr + (8 * c) * 33 + nn;
        u32x4 o; o.x = cvtpk(s[0 * 33], s[1 * 33]); o.y = cvtpk(s[2 * 33], s[3 * 33]); o.z = cvtpk(s[4 * 33], s[5 * 33]); o.w = cvtpk(s[6 * 33], s[7 * 33]);
        *(u32x4*)(WT + (size_t)(n0 + nn) * K + k0 + 8 * c) = o; }
    asm volatile("s_waitcnt lgkmcnt(0)" ::: "memory");
}

__device__ __forceinline__ void branch_item(const float* Wn, int n, bf16_t* WBP, LAS float* scr, int item, int lane) {
    const int kb = item >> 5, nb = item & 31, k0 = 64 * kb, n0 = 32 * nb;
    const float* wp = Wn + (size_t)(k0 + (lane >> 5)) * DM + n0 + (lane & 31);
    float wv[32];
#pragma unroll
    for (int i = 0; i < 32; ++i) wv[i] = wp[(size_t)(2 * i) * DM];
#pragma unroll
    for (int i = 0; i < 32; ++i) scr[(2 * i + (lane >> 5)) * 33 + (lane & 31)] = wv[i];
    asm volatile("s_waitcnt lgkmcnt(0)" ::: "memory");
    const int c = lane & 7, bj = n & 1, pair = n >> 1;
    const u32x4 zero = {0u, 0u, 0u, 0u};
#pragma unroll
    for (int j = 0; j < 4; ++j) { const int nn = (lane >> 3) + 8 * j; const LAS float* sp = scr + (8 * c) * 33 + nn; const int d = n0 + nn;
        u32x4 o; o.x = cvtpk(sp[0 * 33], sp[1 * 33]); o.y = cvtpk(sp[2 * 33], sp[3 * 33]); o.z = cvtpk(sp[4 * 33], sp[5 * 33]); o.w = cvtpk(sp[6 * 33], sp[7 * 33]);
        bf16_t* row = WBP + ((size_t)((pair * 8 + (d >> 7)) * 256 + bj * 128 + (d & 127))) * 512 + k0 + 8 * c;
        *(u32x4*)(row + 256 * bj) = o; *(u32x4*)(row + 256 * (1 - bj)) = zero; }
    asm volatile("s_waitcnt lgkmcnt(0)" ::: "memory");
}

#define MFMA32(a, b, c) __builtin_amdgcn_mfma_f32_32x32x16_bf16((a), (b), (c), 0, 0, 0)
__device__ __forceinline__ bf16x8 ld16(const bf16_t* p) { return *(const bf16x8*)p; }
__device__ __forceinline__ bf16x8 pack8(const f32x16& s, int b) { u32x4 w; w.x = cvtpk(s[b], s[b + 1]); w.y = cvtpk(s[b + 2], s[b + 3]); w.z = cvtpk(s[b + 4], s[b + 5]); w.w = cvtpk(s[b + 6], s[b + 7]); return __builtin_bit_cast(bf16x8, w); }
__device__ __forceinline__ int crow(int r, int hi) { return (r & 3) + 8 * (r >> 2) + 4 * hi; }
__device__ __forceinline__ void store_o(bf16_t* orow, const f32x16& o0, const f32x16& o1, int hi) {
#pragma unroll
    for (int g = 0; g < 4; ++g) {
        u32x2 a; a.x = cvtpk(o0[4 * g], o0[4 * g + 1]); a.y = cvtpk(o0[4 * g + 2], o0[4 * g + 3]); *(u32x2*)(orow + 8 * g + 4 * hi) = a;
        u32x2 b; b.x = cvtpk(o1[4 * g], o1[4 * g + 1]); b.y = cvtpk(o1[4 * g + 2], o1[4 * g + 3]); *(u32x2*)(orow + 32 + 8 * g + 4 * hi) = b; }
}

struct KFrag { bf16x8 k[4]; };
struct VFrag { bf16x8 v[4]; };
__device__ __forceinline__ void k_load(KFrag& f, const bf16_t* Ks, int kb, int r32, int hi) {
    const bf16_t* kp = Ks + (size_t)(kb * 32 + r32) * LDQK + hi * 8;
#pragma unroll
    for (int ds = 0; ds < 4; ++ds) f.k[ds] = ld16(kp + ds * 16);
}
__device__ __forceinline__ void v_load(VFrag& f, const bf16_t* VTs, int kb, int r32, int hi) {
    const bf16_t* vp = VTs + (size_t)r32 * SEQ + kb * 32 + hi * 8;
    f.v[0] = ld16(vp); f.v[1] = ld16(vp + 16); f.v[2] = ld16(vp + 32 * SEQ); f.v[3] = ld16(vp + 32 * SEQ + 16);
}
__device__ __forceinline__ void q_load(bf16x8 (&qf)[4], const bf16_t* Qs, int qb, int r32, int hi) {
    const bf16_t* qp = Qs + (size_t)(qb * 32 + r32) * LDQK + hi * 8;
#pragma unroll
    for (int ds = 0; ds < 4; ++ds) qf[ds] = ld16(qp + ds * 16);
}

template <int MODE, bool MASK, int NDS>
__device__ __forceinline__ void sm_step(const bf16x8 (&ck)[NDS], const bf16x8 (&qf)[NDS], const VFrag& cv, float slope2, const LAS float* cl, int kb, int d0,
                                        float& m, float& l, f32x16& o0, f32x16& o1, int hi) {
    constexpr float SC2 = ((MODE == 2) ? 0.17677669529663687f : 0.125f) * LOG2E;
    f32x16 s;
#pragma unroll
    for (int i = 0; i < 16; ++i) s[i] = 0.f;
#pragma unroll
    for (int ds = 0; ds < NDS; ++ds) s = MFMA32(ck[ds], qf[ds], s);
#define KC(r) (((r) & 3) + 8 * ((r) >> 2))
    int dh = d0 - 4 * hi; asm volatile("" : "+v"(dh));
    float sl = slope2; asm volatile("" : "+v"(sl));
    const LAS float* clk = cl + 33 * kb + 4 * hi; if (MODE == 0) asm volatile("" : "+v"(clk));
    const float base = (MODE == 0) ? 0.f : -sl * (float)dh;
#pragma unroll
    for (int r = 0; r < 16; ++r) {
        float v = (MODE == 0) ? fmaf(s[r], SC2, clk[KC(r)]) : fmaf(s[r], SC2, sl * (float)KC(r));
        if (MASK) { const int dist = dh - KC(r); const bool valid = (MODE == 1) ? ((unsigned)dist <= 128u) : (dist >= 0); v = valid ? v : -INFINITY; }
        s[r] = v;
    }
#undef KC
    float mt = fmaxf(fmaxf(s[0], s[1]), fmaxf(s[2], s[3]));
#pragma unroll
    for (int r = 4; r < 16; r += 4) mt = fmaxf(mt, fmaxf(fmaxf(s[r], s[r + 1]), fmaxf(s[r + 2], s[r + 3])));
    mt = x32_max(mt + base);
    const float mn = fmaxf(m, mt), alpha = ex2(m - mn), c = mn - base;
    float ps = 0.f;
#pragma unroll
    for (int r = 0; r < 16; ++r) { const float p = ex2(s[r] - c); s[r] = p; ps += p; }
    l = l * alpha + ps; m = mn;
#pragma unroll
    for (int i = 0; i < 16; ++i) { o0[i] *= alpha; o1[i] *= alpha; }
    const bf16x8 pf0 = pack8(s, 0), pf1 = pack8(s, 8);
    o0 = MFMA32(cv.v[0], pf0, o0); o0 = MFMA32(cv.v[1], pf1, o0); o1 = MFMA32(cv.v[2], pf0, o1); o1 = MFMA32(cv.v[3], pf1, o1);
}
template <int MODE>
__device__ __forceinline__ void sm_unit(const bf16_t* Qs, const bf16_t* Ks, const bf16_t* VTs, int qb, int kb_hi, int kb_lo, float slope2, const LAS float* cl,
                                        f32x16& o0, f32x16& o1, float& m_out, float& l_out, int lane) {
    const int r32 = lane & 31, hi = lane >> 5;
    constexpr int NDS = (MODE == 2) ? 2 : 4;
    bf16x8 qf[NDS];
    { const bf16_t* qp = Qs + (size_t)(qb * 32 + r32) * LDQK + hi * 8;
#pragma unroll
      for (int ds = 0; ds < NDS; ++ds) qf[ds] = ld16(qp + ds * 16); }
    bf16x8 nk[NDS];
    { const bf16_t* kp = Ks + (size_t)(kb_hi * 32 + r32) * LDQK + hi * 8;
#pragma unroll
      for (int ds = 0; ds < NDS; ++ds) nk[ds] = ld16(kp + ds * 16); }
    float m = -INFINITY, l = 0.f;
#pragma unroll
    for (int i = 0; i < 16; ++i) { o0[i] = 0.f; o1[i] = 0.f; }
    for (int kb = kb_hi; kb >= kb_lo; --kb) {
        bf16x8 ck[NDS];
#pragma unroll
        for (int ds = 0; ds < NDS; ++ds) ck[ds] = nk[ds];
        VFrag cv; v_load(cv, VTs, kb, r32, hi);
        if (kb > kb_lo) { const bf16_t* kp = Ks + (size_t)((kb - 1) * 32 + r32) * LDQK + hi * 8;
#pragma unroll
            for (int ds = 0; ds < NDS; ++ds) nk[ds] = ld16(kp + ds * 16); }
        const int d0 = (qb - kb) * 32 + r32;
        const bool edge = (MODE == 1) ? (kb == qb || kb + 4 <= qb) : (kb == qb);
        if (edge) sm_step<MODE, true, NDS>(ck, qf, cv, slope2, cl, kb, d0, m, l, o0, o1, hi);
        else      sm_step<MODE, false, NDS>(ck, qf, cv, slope2, cl, kb, d0, m, l, o0, o1, hi);
    }
    l = x32_sum(l);
    m_out = m; l_out = l;
}

template <int MODE>
__device__ __forceinline__ void sm_unit64(const bf16_t* Qs, const bf16_t* Ks, const bf16_t* VTs, int Q, int kb_hi, int kb_lo, float slope2, const LAS float* cl,
                                          f32x16 (&o)[2][2], float (&m)[2], float (&l)[2], int lane) {
    const int r32 = lane & 31, hi = lane >> 5;
    constexpr int NDS = (MODE == 2) ? 2 : 4;
    bf16x8 qf[2][NDS];
#pragma unroll
    for (int i = 0; i < 2; ++i) { const bf16_t* qp = Qs + (size_t)((2 * Q + i) * 32 + r32) * LDQK + hi * 8;
#pragma unroll
        for (int ds = 0; ds < NDS; ++ds) qf[i][ds] = ld16(qp + ds * 16); }
    bf16x8 nk[NDS];
    { const bf16_t* kp = Ks + (size_t)(kb_hi * 32 + r32) * LDQK + hi * 8;
#pragma unroll
      for (int ds = 0; ds < NDS; ++ds) nk[ds] = ld16(kp + ds * 16); }
#pragma unroll
    for (int i = 0; i < 2; ++i) { m[i] = -INFINITY; l[i] = 0.f;
#pragma unroll
        for (int k = 0; k < 16; ++k) { o[i][0][k] = 0.f; o[i][1][k] = 0.f; } }
    for (int kb = kb_hi; kb >= kb_lo; --kb) {
        bf16x8 ck[NDS];
#pragma unroll
        for (int ds = 0; ds < NDS; ++ds) ck[ds] = nk[ds];
        VFrag cv; v_load(cv, VTs, kb, r32, hi);
        if (kb > kb_lo) { const bf16_t* kp = Ks + (size_t)((kb - 1) * 32 + r32) * LDQK + hi * 8;
#pragma unroll
            for (int ds = 0; ds < NDS; ++ds) nk[ds] = ld16(kp + ds * 16); }
#pragma unroll
        for (int i = 0; i < 2; ++i) {
            const int qbi = 2 * Q + i;
            if (kb <= qbi) {
                const int d0 = (qbi - kb) * 32 + r32;
                if (kb == qbi) sm_step<MODE, true, NDS>(ck, qf[i], cv, slope2, cl, kb, d0, m[i], l[i], o[i][0], o[i][1], hi);
                else           sm_step<MODE, false, NDS>(ck, qf[i], cv, slope2, cl, kb, d0, m[i], l[i], o[i][0], o[i][1], hi);
            }
        }
    }
    l[0] = x32_sum(l[0]); l[1] = x32_sum(l[1]);
}

__device__ __forceinline__ void sb_unit(const bf16_t* Qs, const bf16_t* Ks, const bf16_t* VTs, int qb, f32x16& o0, f32x16& o1, int lane) {
    const int r32 = lane & 31, hi = lane >> 5;
    constexpr float SC2 = 0.125f * LOG2E;
    bf16x8 qf[4]; q_load(qf, Qs, qb, r32, hi);
    KFrag nx; k_load(nx, Ks, qb, r32, hi);
    float R = 0.f;
#pragma unroll
    for (int i = 0; i < 16; ++i) { o0[i] = 0.f; o1[i] = 0.f; }
    for (int kb = qb; kb >= 0; --kb) {
        const KFrag cu = nx; VFrag cv; v_load(cv, VTs, kb, r32, hi);
        if (kb > 0) k_load(nx, Ks, kb - 1, r32, hi);
        f32x16 s;
#pragma unroll
        for (int i = 0; i < 16; ++i) s[i] = 0.f;
#pragma unroll
        for (int ds = 0; ds < 4; ++ds) s = MFMA32(cu.k[ds], qf[ds], s);
        float lk[16], ls[16];
        const int d0 = (qb - kb) * 32 + r32;
#pragma unroll
        for (int r = 0; r < 16; ++r) { const float z2 = s[r] * SC2; const float sp = fmaxf(z2, 0.f) + lg2(1.0f + ex2(-fabsf(z2))); const bool valid = crow(r, hi) < d0; lk[r] = valid ? -sp : 0.f; ls[r] = valid ? (z2 - sp) : -INFINITY; }
        float e[16], tq[4], pq[4];
#pragma unroll
        for (int g = 0; g < 4; ++g) { e[4 * g + 3] = 0.f; e[4 * g + 2] = lk[4 * g + 3]; e[4 * g + 1] = e[4 * g + 2] + lk[4 * g + 2]; e[4 * g] = e[4 * g + 1] + lk[4 * g + 1]; tq[g] = e[4 * g] + lk[4 * g]; }
#pragma unroll
        for (int g = 0; g < 4; ++g) pq[g] = x32_partner(tq[g], hi);
        float cs[4]; cs[3] = 0.f; cs[2] = tq[3] + pq[3]; cs[1] = cs[2] + (tq[2] + pq[2]); cs[0] = cs[1] + (tq[1] + pq[1]);
        const float total = cs[0] + (tq[0] + pq[0]);
#pragma unroll
        for (int g = 0; g < 4; ++g) { const float later = R + cs[g] + (hi == 0 ? pq[g] : 0.f);
#pragma unroll
            for (int i = 0; i < 4; ++i) s[4 * g + i] = ex2(ls[4 * g + i] + e[4 * g + i] + later); }
        R += total;
        const bf16x8 pf0 = pack8(s, 0), pf1 = pack8(s, 8);
        o0 = MFMA32(cv.v[0], pf0, o0); o0 = MFMA32(cv.v[1], pf1, o0); o1 = MFMA32(cv.v[2], pf0, o1); o1 = MFMA32(cv.v[3], pf1, o1);
        if (__all(R < -150.0f)) break;
    }
}

#define XB_TMO      128
#define XB_XCNT(j)  (256  + 64 * (j))
#define XB_XSUB(j)  (1280 + 64 * (j))
#define XB_XGEN(j)  (2304 + 64 * (j))
#define XB_TOP      3328
#define XB_TOPGEN   3392
#define XCD_BAR_WORDS 3456
#define XB_SPIN_CAP (1u << 18)
__device__ __forceinline__ unsigned xb_ld(unsigned* p)              { return __hip_atomic_load(p, __ATOMIC_RELAXED, __HIP_MEMORY_SCOPE_AGENT); }
__device__ __forceinline__ unsigned xb_add(unsigned* p, unsigned v) { return __hip_atomic_fetch_add(p, v, __ATOMIC_RELAXED, __HIP_MEMORY_SCOPE_AGENT); }
__device__ __forceinline__ unsigned xb_xcc_id() { return (unsigned)__builtin_amdgcn_s_getreg((3 << 11) | 20) & 0xFu; }
#define XB_SPIN(cond, bar) do { unsigned _sp = 0; while (cond) { __builtin_amdgcn_s_sleep(1); \
    if ((++_sp & 255u) == 0u) { if (xb_ld(&(bar)[XB_TMO])) break; if (_sp > XB_SPIN_CAP) { atomicAdd(&(bar)[XB_TMO], 1u); break; } } } } while (0)
__device__ __forceinline__ void xcd_barrier_complete(unsigned* bar, unsigned x, unsigned& nloc, unsigned& nx) {
    const unsigned G = gridDim.x * gridDim.y * gridDim.z;
    unsigned sum, cnt, mine, sp = 0u;
    for (;;) {
        sum = 0u; cnt = 0u; mine = 0u;
#pragma unroll
        for (unsigned j = 0; j < 16; ++j) { const unsigned c = xb_ld(&bar[XB_XCNT(j)]); sum += c; cnt += (c > 0u) ? 1u : 0u; mine = (j == x) ? c : mine; }
        if (sum == G) break;
        __builtin_amdgcn_s_sleep(1);
        if ((++sp & 255u) == 0u) { if (xb_ld(&bar[XB_TMO])) break; if (sp > XB_SPIN_CAP) { atomicAdd(&bar[XB_TMO], 1u); break; } }
    }
    nloc = mine > 0u ? mine : 1u; nx = cnt > 0u ? cnt : 1u;
}
__device__ __forceinline__ void xcd_barrier(unsigned* bar, volatile LAS unsigned* st) {
    asm volatile("s_waitcnt vmcnt(0)" ::: "memory");
    __syncthreads();
    if (threadIdx.x == 0) {
        const unsigned x = xb_xcc_id();
        __builtin_amdgcn_s_waitcnt(0);
        unsigned nloc = st[0], nx = st[1];
        if (nloc == 0u) { xcd_barrier_complete(bar, x, nloc, nx); st[0] = nloc; st[1] = nx; }
        const unsigned old = xb_add(&bar[XB_XSUB(x)], 1u);
        const unsigned gen = old / nloc;
        if (old + 1u == (gen + 1u) * nloc) {
            __builtin_amdgcn_fence(__ATOMIC_RELEASE, "agent");
            asm volatile("s_waitcnt vmcnt(0)" ::: "memory");
            const unsigned og = xb_add(&bar[XB_TOP], 1u);
            const unsigned tg = og / nx;
            if (og + 1u == (tg + 1u) * nx) xb_add(&bar[XB_TOPGEN], 1u);
            else XB_SPIN(xb_ld(&bar[XB_TOPGEN]) == tg, bar);
            __builtin_amdgcn_fence(__ATOMIC_ACQUIRE, "agent");
            xb_add(&bar[XB_XGEN(x)], 1u);
            asm volatile("s_waitcnt vmcnt(0)" ::: "memory");
        } else {
            XB_SPIN(xb_ld(&bar[XB_XGEN(x)]) == gen, bar);
            __builtin_amdgcn_fence(__ATOMIC_ACQUIRE, "agent");
            asm volatile("s_waitcnt vmcnt(0)" ::: "memory");
        }
    }
    __syncthreads();
}
constexpr int MISC_OFF = 131072 + 320;

struct Params {
    const float* x; const float* mix_g; const float* w_in; const float* b_forget; const float* lq1; const float* lk1; const float* lq2; const float* lk2;
    const float* diff_g; const float* w_branch; const float* w_out; const float* mlp_g; const float* w_up; const float* w_down; const float* final_g;
    float* out; unsigned char* ws;
};

#ifndef REP_P1
#define REP_P1 1
#endif
#ifndef REP_P2
#define REP_P2 1
#endif
#ifndef REP_P3
#define REP_P3 1
#endif
#ifndef REP_P5
#define REP_P5 1
#endif
#ifndef REP_SYNC
#define REP_SYNC 1
#endif
#ifndef REP_CONV
#define REP_CONV 1
#endif
#define GSYNC() do { for (int rs_ = 0; rs_ < REP_SYNC; ++rs_) { KParamsPtr pb_ = OPQ_PP(); xcd_barrier((unsigned*)(pb_->ws + WS_CTL) + CW_BAR, (volatile LAS unsigned*)(lds + MISC_OFF)); } } while (0)
#define OPQ_TID() ({ int t_ = threadIdx.x; asm volatile("" : "+v"(t_)); t_; })
typedef const __attribute__((address_space(4))) Params* KParamsPtr;
#define OPQ_PP() ({ KParamsPtr p_ = (KParamsPtr)__builtin_amdgcn_kernarg_segment_ptr(); asm volatile("" : "+s"(p_)); p_; })
#define PHASE_VARS() const int tid = OPQ_TID(); const int lane = tid & 63, wave = __builtin_amdgcn_readfirstlane(tid >> 6); const int G = gridDim.x, bx = blockIdx.x; \
    const int gw = bx * NWAVES + wave, NGW = G * NWAVES; KParamsPtr PP = OPQ_PP(); unsigned char* ws = PP->ws; LAS float* scr = (LAS float*)(lds + wave * 16384); (void)lane; (void)gw; (void)NGW; (void)ws; (void)scr; (void)G; (void)bx; (void)PP

__global__ void __launch_bounds__(NWAVES * 64, 2) fwd_mega(Params P) {
    extern __shared__ __attribute__((aligned(16))) unsigned char lds_raw[];
    LAS unsigned char* lds = (LAS unsigned char*)lds_raw;
    cg::grid_group grid = cg::this_grid();
    { const int t0 = OPQ_TID(); if (t0 < 64) ((LAS unsigned*)(lds + 131072))[t0 + 64] = 0u; __syncthreads();
      if (t0 == 0) { KParamsPtr p0 = OPQ_PP(); (void)xb_add((unsigned*)(p0->ws + WS_CTL) + CW_BAR + XB_XCNT(xb_xcc_id()), 1u); } }

    {
        PHASE_VARS();
        float* X = PP->out; bf16_t* XB = (bf16_t*)(ws + WS_XB); float* SSQ = (float*)(ws + WS_SSQ);
        for (int row = gw; row < TOK; row += NGW) {
            const f32x4* xr = (const f32x4*)(PP->x + (size_t)row * DM) + lane; f32x4* xo = (f32x4*)(X + (size_t)row * DM) + lane;
            unsigned long long* o8 = (unsigned long long*)(XB + (size_t)row * DM) + lane;
            float s = 0.f;
#pragma unroll
            for (int j = 0; j < 4; ++j) { const f32x4 v = xr[64 * j]; xo[64 * j] = v; s += (v[0] * v[0] + v[1] * v[1]) + (v[2] * v[2] + v[3] * v[3]);
                o8[64 * j] = (unsigned long long)cvtpk(v[0], v[1]) | ((unsigned long long)cvtpk(v[2], v[3]) << 32); }
            s = wave_sum(s);
            if (lane < 16) SSQ[(size_t)row * 16 + lane] = (lane == 0) ? s : 0.f;
        }
    }

    for (int layer = 0; layer < DEPTH; ++layer) {
        for (int rep = 0; rep < REP_CONV; ++rep) {
            PHASE_VARS();
            bf16_t* WIN = (bf16_t*)(ws + WS_WIN); bf16_t* WB = (bf16_t*)(ws + WS_WB); bf16_t* WOUT = (bf16_t*)(ws + WS_WOUT);
            const float* w_in = PP->w_in + (size_t)layer * DM * DIN; const float* mg = PP->mix_g + (size_t)layer * DM;
            const float* wb = PP->w_branch + (size_t)layer * 4 * 256 * DM; const float* wo = PP->w_out + (size_t)layer * DM * DM;
            constexpr int I_IN = (DM / 64) * (NPROJ / 32), I_B = (256 / 64) * (DM / 32), I_O = (DM / 64) * (DM / 32);
            for (int it = gw; it < I_IN + 4 * I_B + I_O; it += NGW) {
                int r = it;
                if (r < I_IN) { transpose_item<1>(w_in, DM, NPROJ, DIN, mg, WIN, scr, r, lane); continue; } r -= I_IN;
                if (r < 4 * I_B) { const int n = r / I_B; branch_item(wb + (size_t)n * 256 * DM, n, WB, scr, r % I_B, lane); continue; } r -= 4 * I_B;
                transpose_item<0>(wo, DM, DM, DM, nullptr, WOUT, scr, r, lane);
            }
        }
        if (layer == 0) grid.sync(); else GSYNC();

        for (int half = 0; half < 2; ++half) {
#ifndef NO_P1
            for (int rep = 0; rep < REP_P1; ++rep) {
                PHASE_VARS();
                const int rb = half * HT;
                pg8::Gemm g{(const bf16_t*)(ws + WS_XB) + (size_t)rb * DM, (const bf16_t*)(ws + WS_WIN), DM, DM, DM, 0, 0};
                pg8::StaticOrder S; S.init(HT, NPROJ, G, bx);
                pg8::EpiProj E{(const float*)(ws + WS_SSQ), rb, (bf16_t*)(ws + WS_QK), (bf16_t*)(ws + WS_VT), (float*)(ws + WS_FL), (bf16_t*)(ws + WS_GATE)};
                pg8::gemm_phase<pg8::EpiProj, pg8::StaticOrder, true>(lds, g, S, E);
            }
#endif
            GSYNC();
#ifndef NO_P2
            for (int rep = 0; rep < REP_P2; ++rep) {
                PHASE_VARS();
                unsigned* ctr = (unsigned*)(ws + WS_CTL) + 64 + 512 * (layer * 2 + half + 4 * rep);
                const int xq = bx & 7;
                ctr += 64 * xq;
                for (;;) {
                    int li = 0; if (lane == 0) li = (int)atomicAdd(ctr, 1u); li = __builtin_amdgcn_readfirstlane(li);
                    if (li >= 800) break;
                    int idx;
                    if (li < 288) { const int hl = li / 48, row = li - hl * 48; idx = row * 48 + (xq + 8 * hl); }
                    else if (li < 416) { const int i = li - 288; idx = 2304 + ((63 - (i & 63)) << 4) + (xq + 8 * (i >> 6)); }
                    else { const int i = li - 416; idx = 3328 + (xq + 8 * (i >> 6)) * 64 + (i & 63); }
                    int lane_u = lane; asm volatile("" : "+v"(lane_u));
                    const int lane = lane_u, r32 = lane & 31, hi = lane >> 5;
                    KParamsPtr PU = OPQ_PP(); unsigned char* wsu = PU->ws;
                    bf16_t* YS = (bf16_t*)(wsu + WS_YS); bf16_t* DILO = (bf16_t*)(wsu + WS_DILO); float* LSE = (float*)(wsu + WS_LSE); const float* FL = (const float*)(wsu + WS_FL);
                    const bf16_t* QK = (const bf16_t*)(wsu + WS_QK); const bf16_t* VT = (const bf16_t*)(wsu + WS_VT);
                    if (idx < 2304) {
                        const int j = idx / 48, e = idx - j * 48, type3 = e >> 4, bh = e & 15, b = bh >> 2, h = bh & 3;
                        int Q, chunk; if (j < 32) { Q = 31 - (j >> 1); chunk = j & 1; } else { Q = 47 - j; chunk = 0; }
                        int kb_lo = 0, kb_hi = 2 * Q + 1;
                        if (Q >= 16) { if (chunk == 0) kb_hi = Q; else kb_lo = Q + 1; }
                        const size_t rowb = (size_t)b * SEQ;
                        bf16_t* SCRB = (bf16_t*)(wsu + WS_MERGED) + (size_t)(half * HT) * DM;
                        float* LSE2 = (float*)(wsu + WS_LSE2);
                        f32x16 o[2][2]; float m[2], l[2]; int slot;
                        if (type3 == 2) {
                            LAS float* cl = scr;
                            const float bf = PP->b_forget[layer * 4 + h];
                            float run = 0.f;
                            if (lane <= kb_hi) {
                                const float* fp = FL + (rowb + 32 * lane) * 4 + h;
#pragma unroll 8
                                for (int i = 0; i < 32; ++i) { const float y = fp[4 * i] + bf; const float lf = fminf(y, 0.f) - __logf(1.0f + __expf(-fabsf(y))); run += lf; cl[33 * lane + i] = run; }
                            }
                            float incl = run;
#pragma unroll
                            for (int o_ = 1; o_ < 64; o_ <<= 1) { const float tt = __uint_as_float((unsigned)__builtin_amdgcn_ds_bpermute((lane - o_) << 2, (int)__float_as_uint(incl))); if (lane >= o_) incl += tt; }
                            const float excl = incl - run;
                            if (lane <= kb_hi) {
#pragma unroll 8
                                for (int i = 0; i < 32; ++i) cl[33 * lane + i] = -(cl[33 * lane + i] + excl) * LOG2E;
                            }
                            asm volatile("s_waitcnt lgkmcnt(0)" ::: "memory");
                            sm_unit64<0>(QK + rowb * LDQK + 8 * 256 + h * 64, QK + rowb * LDQK + 9 * 256 + h * 64, VT + ((size_t)(b * 24 + 16 + h) * 64) * SEQ, Q, kb_hi, kb_lo, 0.f, cl, o, m, l, lane);
                            asm volatile("s_waitcnt lgkmcnt(0)" ::: "memory");
                            slot = chunk;
                        } else {
                            const float slope = exp2f(-8.0f * (float)(5 + h) / 16.0f);
                            sm_unit64<2>(QK + rowb * LDQK + 10 * 256 + h * 64 + type3 * 32, QK + rowb * LDQK + 11 * 256 + h * 64 + type3 * 32, VT + ((size_t)(b * 24 + 20 + h) * 64) * SEQ, Q, kb_hi, kb_lo, slope * LOG2E, nullptr, o, m, l, lane);
                            slot = 2 + 2 * type3 + chunk;
                        }
#pragma unroll
                        for (int i = 0; i < 2; ++i) {
                            const int t = (2 * Q + i) * 32 + r32;
                            bf16_t* dst;
                            if (type3 == 2) dst = chunk ? SCRB + (rowb + t) * 256 + h * 64 : YS + (rowb + t) * DM + 512 + h * 64;
                            else dst = (type3 == 0 && chunk == 0) ? YS + (rowb + t) * DM + 768 + h * 64 : SCRB + (size_t)(2 * type3 + chunk) * HT * 256 + (rowb + t) * 256 + h * 64;
                            const float inv = 1.0f / l[i];
#pragma unroll
                            for (int k = 0; k < 16; ++k) { o[i][0][k] *= inv; o[i][1][k] *= inv; }
                            store_o(dst, o[i][0], o[i][1], hi);
                            if (hi == 0) LSE2[(rowb + t) * 24 + h * 6 + slot] = m[i] + lg2(l[i]);
                        }
                    } else if (idx < 3328) {
                        const int i1 = idx - 2304, qb = 63 - (i1 >> 4), bh = i1 & 15, b = bh >> 2, h = bh & 3;
                        const size_t rowb = (size_t)b * SEQ; const int t = qb * 32 + r32;
                        f32x16 o0, o1;
                        sb_unit(QK + rowb * LDQK + 0 * 256 + h * 64, QK + rowb * LDQK + 1 * 256 + h * 64, VT + ((size_t)(b * 24 + h) * 64) * SEQ, qb, o0, o1, lane);
                        store_o(YS + (rowb + t) * DM + 0 * 256 + h * 64, o0, o1, hi);
                    } else {
                        const int i2 = idx - 3328, j = i2 & 63, gh = (i2 >> 6) % 12, b = i2 / 768, gI = gh >> 2, h = gh & 3;
                        const int rsh = 2 * gI, r = 1 << rsh, sl = SEQ >> rsh, nubsh = 6 - rsh, rho = j >> nubsh, ub = j & ((1 << nubsh) - 1);
                        const int sidx = (gI == 0) ? h : (gI == 1 ? 8 + h : 12 + h);
                        const float slope = exp2f(-8.0f * (float)(sidx + 1) / 16.0f);
                        const size_t rowb = (size_t)b * SEQ + (size_t)rho * sl;
                        f32x16 o0, o1; float m, l;
                        const int kb_lo = (ub - 4 > 0) ? ub - 4 : 0;
                        sm_unit<1>(QK + rowb * LDQK + (2 + gI) * 256 + h * 64, QK + rowb * LDQK + (5 + gI) * 256 + h * 64,
                                   VT + ((size_t)(b * 24 + 4 + 4 * gI + h) * 64) * SEQ + (size_t)rho * sl, ub, ub, kb_lo, slope * (float)r * LOG2E, nullptr, o0, o1, m, l, lane);
                        const float inv = 1.0f / l;
#pragma unroll
                        for (int i = 0; i < 16; ++i) { o0[i] *= inv; o1[i] *= inv; }
                        const int u = ub * 32 + r32; const size_t tok = (size_t)b * SEQ + (size_t)u * r + rho;
                        store_o(DILO + tok * 768 + gI * 256 + h * 64, o0, o1, hi);
                        if (hi == 0) LSE[tok * 12 + gI * 4 + h] = (m + lg2(l)) * LN2;
                    }
                }
            }
#endif
            GSYNC();
            {
                PHASE_VARS();
                const float lam_init = (layer == 0) ? 0.2f : 0.35550906759093115f;
                float lam;
                { const float a = (lane < 32) ? PP->lq1[layer * 32 + lane] * PP->lk1[layer * 32 + lane] : 0.f, b = (lane < 32) ? PP->lq2[layer * 32 + lane] * PP->lk2[layer * 32 + lane] : 0.f;
                  lam = __expf(wave_sum(a)) - __expf(wave_sum(b)) + lam_init; }
                bf16_t* YS = (bf16_t*)(ws + WS_YS); const bf16_t* DILO = (const bf16_t*)(ws + WS_DILO); const float* LSE = (const float*)(ws + WS_LSE);
                const bf16_t* SCRB = (const bf16_t*)(ws + WS_MERGED) + (size_t)(half * HT) * DM; const float* LSE2 = (const float*)(ws + WS_LSE2);
                const int h = lane >> 4, dq = (lane & 15) * 4;
                const f32x4 dgv = *(const f32x4*)(PP->diff_g + layer * 64 + dq);
                for (int row = gw; row < HT; row += NGW) {
                    const bool split = ((row & (SEQ - 1)) >> 5) >= 32;
                    {
                        const float l0 = LSE[(size_t)row * 12 + h], l1 = LSE[(size_t)row * 12 + 4 + h], l2 = LSE[(size_t)row * 12 + 8 + h];
                        const float mx = fmaxf(l0, fmaxf(l1, l2)); const float e0 = __expf(l0 - mx), e1 = __expf(l1 - mx), e2 = __expf(l2 - mx); const float inv = 1.0f / (e0 + e1 + e2);
                        const u32x2 a = *(const u32x2*)(DILO + (size_t)row * 768 + 4 * lane), b = *(const u32x2*)(DILO + (size_t)row * 768 + 256 + 4 * lane), c = *(const u32x2*)(DILO + (size_t)row * 768 + 512 + 4 * lane);
                        const float w0 = e0 * inv, w1 = e1 * inv, w2 = e2 * inv;
                        u32x2 o; o.x = cvtpk(w0 * bflo(a.x) + w1 * bflo(b.x) + w2 * bflo(c.x), w0 * bfhi(a.x) + w1 * bfhi(b.x) + w2 * bfhi(c.x));
                        o.y = cvtpk(w0 * bflo(a.y) + w1 * bflo(b.y) + w2 * bflo(c.y), w0 * bfhi(a.y) + w1 * bfhi(b.y) + w2 * bfhi(c.y));
                        *(u32x2*)(YS + (size_t)row * DM + 256 + 4 * lane) = o;
                    }
                    const float* ls = LSE2 + (size_t)row * 24 + h * 6;
                    const u32x2 f0 = *(const u32x2*)(YS + (size_t)row * DM + 512 + 4 * lane), a0 = *(const u32x2*)(YS + (size_t)row * DM + 768 + 4 * lane);
                    const u32x2 b0 = *(const u32x2*)(SCRB + (size_t)2 * HT * 256 + (size_t)row * 256 + 4 * lane);
                    float fv[4] = {bflo(f0.x), bfhi(f0.x), bflo(f0.y), bfhi(f0.y)}, av[4] = {bflo(a0.x), bfhi(a0.x), bflo(a0.y), bfhi(a0.y)}, bv[4] = {bflo(b0.x), bfhi(b0.x), bflo(b0.y), bfhi(b0.y)};
                    if (split) {
                        const u32x2 f1 = *(const u32x2*)(SCRB + (size_t)row * 256 + 4 * lane), a1 = *(const u32x2*)(SCRB + (size_t)1 * HT * 256 + (size_t)row * 256 + 4 * lane), b1 = *(const u32x2*)(SCRB + (size_t)3 * HT * 256 + (size_t)row * 256 + 4 * lane);
                        const float lf0 = ls[0], lf1 = ls[1], la0 = ls[2], la1 = ls[3], lb0 = ls[4], lb1 = ls[5];
                        { const float mx = fmaxf(lf0, lf1), e0 = ex2(lf0 - mx), e1 = ex2(lf1 - mx), inv = 1.0f / (e0 + e1), w0 = e0 * inv, w1 = e1 * inv;
                          fv[0] = w0 * fv[0] + w1 * bflo(f1.x); fv[1] = w0 * fv[1] + w1 * bfhi(f1.x); fv[2] = w0 * fv[2] + w1 * bflo(f1.y); fv[3] = w0 * fv[3] + w1 * bfhi(f1.y); }
                        { const float mx = fmaxf(la0, la1), e0 = ex2(la0 - mx), e1 = ex2(la1 - mx), inv = 1.0f / (e0 + e1), w0 = e0 * inv, w1 = e1 * inv;
                          av[0] = w0 * av[0] + w1 * bflo(a1.x); av[1] = w0 * av[1] + w1 * bfhi(a1.x); av[2] = w0 * av[2] + w1 * bflo(a1.y); av[3] = w0 * av[3] + w1 * bfhi(a1.y); }
                        { const float mx = fmaxf(lb0, lb1), e0 = ex2(lb0 - mx), e1 = ex2(lb1 - mx), inv = 1.0f / (e0 + e1), w0 = e0 * inv, w1 = e1 * inv;
                          bv[0] = w0 * bv[0] + w1 * bflo(b1.x); bv[1] = w0 * bv[1] + w1 * bfhi(b1.x); bv[2] = w0 * bv[2] + w1 * bflo(b1.y); bv[3] = w0 * bv[3] + w1 * bfhi(b1.y); }
                        u32x2 fo; fo.x = cvtpk(fv[0], fv[1]); fo.y = cvtpk(fv[2], fv[3]);
                        *(u32x2*)(YS + (size_t)row * DM + 512 + 4 * lane) = fo;
                    }
                    float dv[4]; float ss = 0.f;
#pragma unroll
                    for (int i = 0; i < 4; ++i) { dv[i] = av[i] - lam * bv[i]; ss += dv[i] * dv[i]; }
                    ss += swz_xor<1>(ss); ss += swz_xor<2>(ss); ss += swz_xor<4>(ss); ss += swz_xor<8>(ss);
                    const float rn = __builtin_amdgcn_rsqf(ss * (1.0f / 64.0f) + RMS_EPS) * (1.0f - lam_init);
                    u32x2 dout; dout.x = cvtpk(dv[0] * rn * dgv[0], dv[1] * rn * dgv[1]); dout.y = cvtpk(dv[2] * rn * dgv[2], dv[3] * rn * dgv[3]);
                    *(u32x2*)(YS + (size_t)row * DM + 768 + 4 * lane) = dout;
                }
            }
            GSYNC();
#ifndef NO_P3
            for (int rep = 0; rep < REP_P3; ++rep) {
                PHASE_VARS();
                pg8::Gemm g{(const bf16_t*)(ws + WS_YS), (const bf16_t*)(ws + WS_WB), DM, 512, 512, 512 * 2, (long)8 * 256 * 512 * 2};
                pg8::BranchOrder S{bx, G};
                pg8::EpiBranch E{(const bf16_t*)(ws + WS_GATE), (bf16_t*)(ws + WS_MERGED), half * HT};
                pg8::gemm_phase<pg8::EpiBranch, pg8::BranchOrder, false>(lds, g, S, E);
            }
#endif
            GSYNC();
        }
#ifndef NO_P4
        for (int rep = 0; rep < REP_CONV; ++rep) {
            PHASE_VARS();
            bf16_t* WUP = (bf16_t*)(ws + WS_WUP); bf16_t* WDN = (bf16_t*)(ws + WS_WDN);
            const float* wu = PP->w_up + (size_t)layer * DM * DFF; const float* wd = PP->w_down + (size_t)layer * DFF * DM; const float* mg = PP->mlp_g + (size_t)layer * DM;
            constexpr int I_U = (DM / 64) * (DFF / 32), I_D = (DFF / 64) * (DM / 32);
            for (int it = gw; it < I_U + I_D; it += NGW) {
                if (it < I_U) transpose_item<0>(wu, DM, DFF, DFF, mg, WUP, scr, it, lane);
                else transpose_item<0>(wd, DFF, DM, DM, nullptr, WDN, scr, it - I_U, lane);
            }
            __syncthreads();
        }
        {
            PHASE_VARS();
            pg8::Gemm g{(const bf16_t*)(ws + WS_MERGED), (const bf16_t*)(ws + WS_WOUT), DM, DM, DM, 0, 0};
            pg8::StaticOrder S; S.init(TOK, DM, G, bx);
            pg8::EpiResid E{PP->out, (bf16_t*)(ws + WS_XB), (float*)(ws + WS_SSQ)};
            pg8::gemm_phase<pg8::EpiResid, pg8::StaticOrder, false>(lds, g, S, E);
        }
#endif
        GSYNC();
#ifndef NO_P5
        for (int rep = 0; rep < REP_P5; ++rep) {
            PHASE_VARS();
            pg8::Gemm g{(const bf16_t*)(ws + WS_XB), (const bf16_t*)(ws + WS_WUP), DM, DM, DM, 0, 0};
            pg8::StaticOrder S; S.init(TOK, DFF, G, bx);
            pg8::EpiUp E{(const float*)(ws + WS_SSQ), (bf16_t*)(ws + WS_HMLP)};
            pg8::gemm_phase<pg8::EpiUp, pg8::StaticOrder, true>(lds, g, S, E);
        }
#endif
        GSYNC();
#ifndef NO_P6
        {
            PHASE_VARS();
            pg8::Gemm g{(const bf16_t*)(ws + WS_HMLP), (const bf16_t*)(ws + WS_WDN), DFF, DFF, DFF, 0, 0};
            pg8::StaticOrder S; S.init(TOK, DM, G, bx);
            pg8::EpiResid E{PP->out, (bf16_t*)(ws + WS_XB), (float*)(ws + WS_SSQ)};
            pg8::gemm_phase<pg8::EpiResid, pg8::StaticOrder, false>(lds, g, S, E);
        }
#endif
        GSYNC();
    }
    {
        PHASE_VARS();
        float* X = PP->out;
        for (int row = gw; row < TOK; row += NGW) {
            f32x4* xo = (f32x4*)(X + (size_t)row * DM) + lane; const f32x4* gp = (const f32x4*)PP->final_g + lane;
            f32x4 v[4]; float s = 0.f;
#pragma unroll
            for (int j = 0; j < 4; ++j) { v[j] = xo[64 * j]; s += (v[j][0] * v[j][0] + v[j][1] * v[j][1]) + (v[j][2] * v[j][2] + v[j][3] * v[j][3]); }
            const float rstd = __builtin_amdgcn_rsqf(wave_sum(s) * (1.0f / DM) + RMS_EPS);
#pragma unroll
            for (int j = 0; j < 4; ++j) xo[64 * j] = v[j] * rstd * gp[64 * j];
        }
    }
}

extern "C" void kernel_launch(void* const* d_in, const int* in_sizes, int n_in, void* d_out, int out_size, void* d_ws, size_t ws_size, hipStream_t stream) {
    static int grid = 0;
    if (grid == 0) {
        if (n_in != 15 || in_sizes[0] != TOK * DM || out_size != TOK * DM || ws_size < WS_END) { fprintf(stderr, "kernel_launch: unexpected shapes / workspace (n_in %d, ws %zu)\n", n_in, ws_size); grid = -1; return; }
        int dev = 0, cus = 0, per_cu = 0;
        hipGetDevice(&dev); hipDeviceGetAttribute(&cus, hipDeviceAttributeMultiprocessorCount, dev);
        hipFuncSetAttribute((const void*)fwd_mega, hipFuncAttributeMaxDynamicSharedMemorySize, LDS_BYTES);
        hipOccupancyMaxActiveBlocksPerMultiprocessor(&per_cu, (const void*)fwd_mega, NWAVES * 64, LDS_BYTES);
        (void)hipGetLastError();
        if (per_cu < 1) per_cu = 1;
        grid = cus;
        if (grid > 256) grid = 256;
        if (grid % 8 != 0) { fprintf(stderr, "kernel_launch: the per-XCD work queues need a grid that is a multiple of 8 (got %d)\n", grid); grid = -1; return; }
    }
    if (grid < 0) return;
    hipMemsetAsync((char*)d_ws + WS_CTL, 0, CTL_BYTES, stream);
    Params p{};
    p.x = (const float*)d_in[0]; p.mix_g = (const float*)d_in[1]; p.w_in = (const float*)d_in[2]; p.b_forget = (const float*)d_in[3];
    p.lq1 = (const float*)d_in[4]; p.lk1 = (const float*)d_in[5]; p.lq2 = (const float*)d_in[6]; p.lk2 = (const float*)d_in[7];
    p.diff_g = (const float*)d_in[8]; p.w_branch = (const float*)d_in[9]; p.w_out = (const float*)d_in[10]; p.mlp_g = (const float*)d_in[11];
    p.w_up = (const float*)d_in[12]; p.w_down = (const float*)d_in[13]; p.final_g = (const float*)d_in[14];
    p.out = (float*)d_out; p.ws = (unsigned char*)d_ws;
    void* args[] = {&p};
    hipError_t e = hipLaunchCooperativeKernel((const void*)fwd_mega, dim3(grid), dim3(NWAVES * 64), args, LDS_BYTES, stream);
    if (e != hipSuccess) fprintf(stderr, "cooperative launch failed: %s (grid %d)\n", hipGetErrorString(e), grid);
}
```

```cpp
#include <hip/hip_runtime.h>
#include <hip/hip_cooperative_groups.h>
#include <cstdio>
#include <cstdint>
namespace cg = cooperative_groups;

#define LAS __attribute__((address_space(3)))
typedef unsigned short bf16_t;
typedef short bf16x8 __attribute__((ext_vector_type(8)));
typedef float f32x4 __attribute__((ext_vector_type(4)));
typedef float f32x16 __attribute__((ext_vector_type(16)));
typedef unsigned u32x4 __attribute__((ext_vector_type(4)));
typedef unsigned u32x2 __attribute__((ext_vector_type(2)));
typedef float f32x2_t __attribute__((ext_vector_type(2)));
typedef __bf16 bf16x2_t __attribute__((ext_vector_type(2)));

constexpr int DM = 1024, BATCH = 8, SEQ = 2048, DEPTH = 2, TOK = BATCH * SEQ, DFF = 4096, DIN = 8708;
constexpr int HT = TOK / 2;
constexpr int NPROJ = 35 * 256;
constexpr int LDQK = 6 * 256;
constexpr int HSEQ = SEQ * 64;
constexpr float LOG2E = 1.4426950408889634f, LN2 = 0.6931471805599453f;
constexpr float RMS_EPS = 1e-6f;

constexpr size_t MiB = 1u << 20;
constexpr size_t WS_CTL = 0, CTL_BYTES = 65536;
constexpr int CW_BAR = 4096;
constexpr size_t WS_SSQ = 1 * MiB;
constexpr size_t WS_WIN = 2 * MiB;
constexpr size_t WS_WUP = WS_WIN, WS_WDN = WS_WIN + 8 * MiB;
constexpr size_t WS_WB = 20 * MiB;
constexpr size_t WS_WOUT = 24 * MiB;
constexpr size_t WS_XB = 26 * MiB;
constexpr size_t WS_MERGED = 58 * MiB;
constexpr size_t WS_YS = 90 * MiB;
constexpr size_t WS_DILO = 106 * MiB;
constexpr size_t WS_LSE = 118 * MiB;
constexpr size_t WS_LSE2 = 118 * MiB + 512 * 1024;
constexpr size_t WS_FL = 119 * MiB + 512 * 1024;
constexpr size_t WS_QK = 120 * MiB;
constexpr size_t WS_KF = 144 * MiB;
constexpr size_t WS_VT = 168 * MiB;
constexpr size_t WS_GATE = 192 * MiB;
constexpr size_t WS_HMLP = 120 * MiB;
constexpr size_t WS_END = 256 * MiB;

constexpr int LDS_BYTES = 147456;
constexpr int NWAVES = 8;

__device__ __forceinline__ unsigned cvtpk(float lo, float hi) { f32x2_t v = {lo, hi}; bf16x2_t b = __builtin_convertvector(v, bf16x2_t); return __builtin_bit_cast(unsigned, b); }
__device__ __forceinline__ float bflo(unsigned w) { return __uint_as_float(w << 16); }
__device__ __forceinline__ float bfhi(unsigned w) { return __uint_as_float(w & 0xffff0000u); }
__device__ __forceinline__ float ex2(float x) { return __builtin_amdgcn_exp2f(x); }
__device__ __forceinline__ float lg2(float x) { return __builtin_amdgcn_logf(x); }
__device__ __forceinline__ float x32_sum(float v) { auto r = __builtin_amdgcn_permlane32_swap(__float_as_uint(v), __float_as_uint(v), false, false); return __uint_as_float(r[0]) + __uint_as_float(r[1]); }
__device__ __forceinline__ float x32_max(float v) { auto r = __builtin_amdgcn_permlane32_swap(__float_as_uint(v), __float_as_uint(v), false, false); return fmaxf(__uint_as_float(r[0]), __uint_as_float(r[1])); }
__device__ __forceinline__ float x32_partner(float v, int hi) { auto r = __builtin_amdgcn_permlane32_swap(__float_as_uint(v), __float_as_uint(v), false, false); return hi ? __uint_as_float(r[0]) : __uint_as_float(r[1]); }
template <int X> __device__ __forceinline__ float swz_xor(float v) { return __uint_as_float((unsigned)__builtin_amdgcn_ds_swizzle((int)__float_as_uint(v), (X << 10) | 0x1f)); }
__device__ __forceinline__ float x16_sum(float v) { return v + swz_xor<16>(v); }
__device__ __forceinline__ float wave_sum(float v) { v += swz_xor<1>(v); v += swz_xor<2>(v); v += swz_xor<4>(v); v += swz_xor<8>(v); v += swz_xor<16>(v); return x32_sum(v); }

namespace pg8 {
constexpr int BM = 256, BK = 64, HALF = 128, HTB = HALF * BK * 2, STAGE_BYTES = 8 * HTB, NXCD = 8, WGM = 8;
__host__ __device__ __forceinline__ int lds_byte(int r, int c) { const int st = (r >> 4) * 2 + (c >> 5), rr = r & 15, cc = c & 31, ob = rr * 64 + cc * 2; return st * 1024 + (ob ^ (((ob >> 9) & 1) << 5)); }
__host__ __device__ __forceinline__ void stage_rc(int b, int& R, int& C) { const int st = b / 1024, sb = b % 1024, swz = sb ^ (((sb >> 9) & 1) << 5); R = (st >> 1) * 16 + swz / 64; C = (st & 1) * 32 + (swz % 64) / 2; }
__host__ __device__ __forceinline__ int perm32(int rho) { const int n = rho >> 4, i = rho & 15; return 8 * (i >> 2) + 4 * n + (i & 3); }

struct Unit { int pm, pn, aux; };
struct Gemm { const bf16_t* A; const bf16_t* Bt; int lda, ldb, K; long a_aux, b_aux; };

struct StaticOrder {
    int nM, nN, nwg, G, c;
    __device__ void init(int M, int N, int G_, int c_) { nM = M / BM; nN = N / BM; nwg = nM * nN; G = G_; c = c_; }
    __device__ bool next(int i, Unit& u) const {
        const long L = (long)i * G + c; if (L >= nwg) return false;
        int wgid = (int)L; { const int q = nwg / NXCD, r = nwg % NXCD, xcd = wgid % NXCD, off = wgid / NXCD; wgid = (xcd < r ? xcd * (q + 1) : r * (q + 1) + (xcd - r) * q) + off; }
        const int nig = WGM * nN, gid = wgid / nig, fm = gid * WGM, gsz = (nM - fm) < WGM ? (nM - fm) : WGM;
        u.pm = fm + ((wgid % nig) % gsz); u.pn = (wgid % nig) / gsz; u.aux = 0; return true;
    }
};
struct BranchOrder {
    int c, G;
    __device__ bool next(int i, Unit& u) const { const int t = c + (i >> 1) * G; if (t >= 256) return false; u.pm = t >> 3; u.pn = t & 7; u.aux = i & 1; return true; }
};

template <class Epi, class Sched, bool ALIGN_EPI>
__device__ __forceinline__ void gemm_phase(LAS unsigned char* lds, const Gemm g, const Sched& S, const Epi& E) {
    int tid_ = threadIdx.x; asm volatile("" : "+v"(tid_));
    const int tid = tid_, wid = __builtin_amdgcn_readfirstlane(tid >> 6), lane = tid & 63, wr = wid >> 2, wc = wid & 3, fr = lane & 15, fq = lane >> 4;
    int nt_ = g.K / BK; asm volatile("" : "+s"(nt_)); const int nt = nt_;
    unsigned voffA[2], voffB[2];
#pragma unroll
    for (int i = 0; i < 2; ++i) { int R, C; stage_rc(tid * 16 + i * 8192, R, C); const int Rb = Epi::PERM ? ((R & ~31) + perm32(R & 31)) : R;
        voffA[i] = (unsigned)(R * g.lda + C) * 2u; voffB[i] = (unsigned)(Rb * g.ldb + C) * 2u; }
    const size_t kstep = (size_t)(BK * 2);
    const size_t hstepA = (size_t)HALF * g.lda * 2, hstepB = (size_t)HALF * g.ldb * 2;
    const size_t tstepA = 2 * hstepA, tstepB = 2 * hstepB;
    const unsigned ldsw = (unsigned)wid * 1024u;
    const int aoff = lds_byte(wr * 64 + fr, fq * 8), boff = lds_byte(wc * 32 + fr, fq * 8);
#define PG8_SA(b, h) (((b) * 2 + (h)) * HTB)
#define PG8_SB(b, h) ((4 + (b) * 2 + (h)) * HTB)
#define PG8_STAGE(bufoff, gbase, voff) do { _Pragma("unroll") for (int _i = 0; _i < 2; ++_i) \
        __builtin_amdgcn_global_load_lds((const unsigned*)((const char*)(gbase) + (voff)[_i]), (LAS unsigned*)(lds + (bufoff) + ldsw + _i * 8192), 16, 0, 0); } while (0)
#define PG8_LDA(dst, b, h) do { _Pragma("unroll") for (int m = 0; m < 4; ++m) _Pragma("unroll") for (int k = 0; k < 2; ++k) dst[m][k] = *(const LAS bf16x8*)(lds + PG8_SA(b, h) + aoff + m * 2048 + k * 1024); } while (0)
#define PG8_LDB(dst, b, h) do { _Pragma("unroll") for (int n = 0; n < 2; ++n) _Pragma("unroll") for (int k = 0; k < 2; ++k) dst[n][k] = *(const LAS bf16x8*)(lds + PG8_SB(b, h) + boff + n * 2048 + k * 1024); } while (0)
#define PG8_MMA(ai, bj, At, Bt) do { __builtin_amdgcn_s_setprio(1); _Pragma("unroll") for (int m = 0; m < 4; ++m) _Pragma("unroll") for (int n = 0; n < 2; ++n) _Pragma("unroll") for (int k = 0; k < 2; ++k) \
        acc[ai][bj][m][n] = __builtin_amdgcn_mfma_f32_16x16x32_bf16(Bt[n][k], At[m][k], acc[ai][bj][m][n], 0, 0, 0); __builtin_amdgcn_s_setprio(0); } while (0)
#define PG8_WAIT_V(n) asm volatile("s_waitcnt vmcnt(" #n ")" ::: "memory")
#define PG8_WAIT_L(n) asm volatile("s_waitcnt lgkmcnt(" #n ")" ::: "memory")
#define PG8_BAR __builtin_amdgcn_s_barrier()
#define PG8_SCHED __builtin_amdgcn_sched_barrier(0)
#define PG8_UA(u) ((const char*)g.A + (size_t)(u).pm * tstepA + (size_t)(u).aux * (size_t)g.a_aux)
#define PG8_UB(u) ((const char*)g.Bt + (size_t)(u).pn * tstepB + (size_t)(u).aux * (size_t)g.b_aux)
    Unit cur, nxt; int ui = 0;
    if (!S.next(0, cur)) return;
    f32x4 acc[2][2][4][2];
#pragma unroll
    for (int a = 0; a < 2; ++a)
#pragma unroll
        for (int b = 0; b < 2; ++b)
#pragma unroll
            for (int m = 0; m < 4; ++m)
#pragma unroll
                for (int n = 0; n < 2; ++n) acc[a][b][m][n] = (f32x4){0.f, 0.f, 0.f, 0.f};
    bf16x8 At[4][2], B0[2][2], B1[2][2];
    const char* cA = PG8_UA(cur); const char* cB = PG8_UB(cur);
    PG8_STAGE(PG8_SB(0, 0), cB, voffB); PG8_STAGE(PG8_SB(0, 1), cB + hstepB, voffB); PG8_STAGE(PG8_SA(0, 0), cA, voffA); PG8_STAGE(PG8_SA(0, 1), cA + hstepA, voffA);
    if (wr == 1) PG8_BAR;
    PG8_WAIT_V(2); PG8_BAR;
    PG8_STAGE(PG8_SB(1, 0), cB + kstep, voffB); PG8_STAGE(PG8_SA(1, 0), cA + kstep, voffA); PG8_STAGE(PG8_SB(1, 1), cB + hstepB + kstep, voffB);
    PG8_WAIT_V(6); PG8_BAR;
    for (;;) {
        const bool has_next = S.next(ui + 1, nxt);
        const char* nA = has_next ? PG8_UA(nxt) : cA; const char* nB = has_next ? PG8_UB(nxt) : cB;
        for (int t = 0; t < nt; t += 2) {
            const bool last = (t == nt - 2);
            const char* a1 = cA + (size_t)(t + 1) * kstep;
            const char* a2 = last ? nA : cA + (size_t)(t + 2) * kstep; const char* b2 = last ? nB : cB + (size_t)(t + 2) * kstep;
            const char* a3 = a2 + kstep; const char* b3 = b2 + kstep;
            PG8_LDB(B0, 0, 0); PG8_LDB(B1, 0, 1); PG8_SCHED; PG8_LDA(At, 0, 0); PG8_STAGE(PG8_SA(1, 1), a1 + hstepA, voffA);
            PG8_WAIT_V(8); PG8_WAIT_L(0); PG8_BAR; PG8_MMA(0, 0, At, B0); PG8_MMA(0, 1, At, B1); PG8_BAR; PG8_SCHED;
            PG8_LDA(At, 0, 1); PG8_STAGE(PG8_SB(0, 0), b2, voffB); PG8_STAGE(PG8_SB(0, 1), b2 + hstepB, voffB); PG8_STAGE(PG8_SA(0, 0), a2, voffA);
            PG8_WAIT_V(8); PG8_WAIT_L(0); PG8_BAR; PG8_MMA(1, 0, At, B0); PG8_MMA(1, 1, At, B1); PG8_BAR; PG8_SCHED;
            PG8_LDB(B0, 1, 0); PG8_LDB(B1, 1, 1); PG8_SCHED; PG8_LDA(At, 1, 0); PG8_STAGE(PG8_SA(0, 1), a2 + hstepA, voffA);
            PG8_WAIT_V(8); PG8_WAIT_L(0); PG8_BAR; PG8_MMA(0, 0, At, B0); PG8_MMA(0, 1, At, B1); PG8_BAR; PG8_SCHED;
            PG8_LDA(At, 1, 1); PG8_STAGE(PG8_SB(1, 0), b3, voffB); PG8_STAGE(PG8_SB(1, 1), b3 + hstepB, voffB); PG8_STAGE(PG8_SA(1, 0), a3, voffA);
            PG8_WAIT_V(8); PG8_WAIT_L(0); PG8_BAR; PG8_MMA(1, 0, At, B0); PG8_MMA(1, 1, At, B1); PG8_BAR; PG8_SCHED;
        }
        if constexpr (ALIGN_EPI) { if (wr == 0) PG8_BAR; }
        { Unit eu = cur; asm volatile("" : "+s"(eu.pm), "+s"(eu.pn), "+s"(eu.aux)); E(acc, eu, wr, wc, fr, fq); }
        if (!has_next) break;
#pragma unroll
        for (int a = 0; a < 2; ++a)
#pragma unroll
            for (int b = 0; b < 2; ++b)
#pragma unroll
                for (int m = 0; m < 4; ++m)
#pragma unroll
                    for (int n = 0; n < 2; ++n) acc[a][b][m][n] = (f32x4){0.f, 0.f, 0.f, 0.f};
        cur = nxt; cA = nA; cB = nB; ++ui;
        if constexpr (ALIGN_EPI) { if (wr == 1) PG8_BAR; }
    }
    PG8_WAIT_V(0);
    if constexpr (!ALIGN_EPI) { if (wr == 0) PG8_BAR; }
    PG8_BAR;
#undef PG8_SA
#undef PG8_SB
#undef PG8_STAGE
#undef PG8_LDA
#undef PG8_LDB
#undef PG8_MMA
#undef PG8_WAIT_V
#undef PG8_WAIT_L
#undef PG8_BAR
#undef PG8_SCHED
#undef PG8_UA
#undef PG8_UB
}

__device__ __forceinline__ float row_rstd(const float* ssq, int row, int fq) {
    const f32x4 a = *(const f32x4*)(ssq + (size_t)row * 16 + 4 * fq);
    float s = (a[0] + a[1]) + (a[2] + a[3]);
    s = x16_sum(s); s = x32_sum(s);
    return __builtin_amdgcn_rsqf(s * (1.0f / DM) + RMS_EPS);
}
__device__ __forceinline__ int pos16(int o) { return 8 * ((o >> 2) & 1) + 4 * (o >> 3) + (o & 3); }

struct EpiProj {
    static constexpr bool PERM = true;
    const float* ssq; int row_base; bf16_t* QK; bf16_t* KF; bf16_t* VT; float* FL; bf16_t* GATE;
    __device__ __forceinline__ void operator()(const f32x4 (&acc)[2][2][4][2], const Unit& u, int wr, int wc, int fr, int fq) const {
        const int pn = u.pn;
        const int lrow0 = u.pm * BM + wr * 64 + fr;
        float rs[2][4];
#pragma unroll
        for (int ai = 0; ai < 2; ++ai)
#pragma unroll
            for (int m = 0; m < 4; ++m) rs[ai][m] = row_rstd(ssq, row_base + lrow0 + ai * HALF + m * 16, fq);
        const int cin = wc * 32 + 8 * fq;
        if (pn >= 19) {
#pragma unroll
            for (int ai = 0; ai < 2; ++ai)
#pragma unroll
                for (int m = 0; m < 4; ++m) { const int lrow = lrow0 + ai * HALF + m * 16; const float s = rs[ai][m];
#pragma unroll
                    for (int bj = 0; bj < 2; ++bj) { const f32x4 v0 = acc[ai][bj][m][0] * s, v1 = acc[ai][bj][m][1] * s;
                        u32x4 w; w.x = cvtpk(v0[0], v0[1]); w.y = cvtpk(v0[2], v0[3]); w.z = cvtpk(v1[0], v1[1]); w.w = cvtpk(v1[2], v1[3]);
                        *(u32x4*)(GATE + (size_t)lrow * 4096 + (pn - 19) * 256 + bj * HALF + cin) = w; } }
        } else if (pn == 18) {
            if (wc == 0 && fq == 0) {
#pragma unroll
                for (int ai = 0; ai < 2; ++ai)
#pragma unroll
                    for (int m = 0; m < 4; ++m) { const int lrow = lrow0 + ai * HALF + m * 16; *(f32x4*)(FL + (size_t)lrow * 4) = acc[ai][0][m][0] * rs[ai][m]; }
            }
        } else if (pn == 2 || (pn >= 9 && pn <= 11) || pn == 14 || pn == 17) {
            int vhb, rsh;
            if (pn == 2) { vhb = 0; rsh = 0; } else if (pn == 14) { vhb = 16; rsh = 0; } else if (pn == 17) { vhb = 20; rsh = 0; } else { const int gI = pn - 9; vhb = 4 + 4 * gI; rsh = 2 * gI; }
            const int slsh = 11 - rsh, rmask = (1 << rsh) - 1;
#pragma unroll
            for (int ai = 0; ai < 2; ++ai)
#pragma unroll
                for (int m = 0; m < 4; ++m) { const int lrow = lrow0 + ai * HALF + m * 16; const float s = rs[ai][m];
                    const int bl = lrow >> 11, t = lrow & (SEQ - 1); int p = ((t & rmask) << slsh) + (t >> rsh); p = (p & ~15) | pos16(p & 15);
                    const int kb = p >> 5, q = p & 31;
                    bf16_t* base = VT + (size_t)(bl * 24 + vhb) * HSEQ + (size_t)kb * 2048 + (q >> 4) * 512 + ((q >> 3) & 1) * 256 + (q & 7);
#pragma unroll
                    for (int bj = 0; bj < 2; ++bj) { const int c0 = bj * HALF + cin;
                        bf16_t* bp = base + (size_t)(c0 >> 6) * HSEQ + ((c0 >> 5) & 1) * 1024 + (c0 & 31) * 8;
                        const f32x4 v0 = acc[ai][bj][m][0] * s, v1 = acc[ai][bj][m][1] * s;
                        const unsigned w0 = cvtpk(v0[0], v0[1]), w1 = cvtpk(v0[2], v0[3]), w2 = cvtpk(v1[0], v1[1]), w3 = cvtpk(v1[2], v1[3]);
                        bp[0 * 8] = (bf16_t)(w0 & 0xffff); bp[1 * 8] = (bf16_t)(w0 >> 16); bp[2 * 8] = (bf16_t)(w1 & 0xffff); bp[3 * 8] = (bf16_t)(w1 >> 16);
                        bp[4 * 8] = (bf16_t)(w2 & 0xffff); bp[5 * 8] = (bf16_t)(w2 >> 16); bp[6 * 8] = (bf16_t)(w3 & 0xffff); bp[7 * 8] = (bf16_t)(w3 >> 16); } }
        } else {
            const bool isK = (pn == 1) || (pn >= 6 && pn <= 8) || pn == 13 || pn == 16;
            int slot = 0, khb = 0, rsh = 0;
            if (pn <= 1) { slot = 0; khb = 0; } else if (pn <= 8) { const int gI = (pn - 3) % 3; rsh = 2 * gI; slot = 1 + gI; khb = 4 + 4 * gI; } else if (pn <= 13) { slot = 4; khb = 16; } else { slot = 5; khb = 20; }
            const int slsh = 11 - rsh, rmask = (1 << rsh) - 1;
#pragma unroll
            for (int ai = 0; ai < 2; ++ai)
#pragma unroll
                for (int m = 0; m < 4; ++m) { const int lrow = lrow0 + ai * HALF + m * 16; const float s = rs[ai][m];
                    const int bl = lrow >> 11, t = lrow & (SEQ - 1); const int p = ((t & rmask) << slsh) + (t >> rsh);
#pragma unroll
                    for (int bj = 0; bj < 2; ++bj) { const f32x4 v0 = acc[ai][bj][m][0] * s, v1 = acc[ai][bj][m][1] * s;
                        u32x4 w; w.x = cvtpk(v0[0], v0[1]); w.y = cvtpk(v0[2], v0[3]); w.z = cvtpk(v1[0], v1[1]); w.w = cvtpk(v1[2], v1[3]);
                        const int c0 = bj * HALF + cin;
                        if (isK) { const int dcol = c0 & 63;
                            *(u32x4*)(KF + (size_t)(bl * 24 + khb + (c0 >> 6)) * HSEQ + (size_t)(p >> 5) * 2048 + (dcol >> 4) * 512 + (((dcol >> 3) & 1) * 32 + (p & 31)) * 8) = w; }
                        else *(u32x4*)(QK + (size_t)(bl * SEQ + p) * LDQK + slot * 256 + c0) = w; } }
        }
    }
};

struct EpiBranch {
    static constexpr bool PERM = true;
    const bf16_t* GATE; bf16_t* MERGED; int row_base;
    __device__ __forceinline__ static float sg(float g) { return __builtin_amdgcn_rcpf(1.0f + ex2(-g * LOG2E)); }
    __device__ __forceinline__ static u32x4 mix(const u32x4 ga, const u32x4 gb, const u32x4 ow, const f32x4 a0, const f32x4 a1, const f32x4 b0, const f32x4 b1) {
        const float o0 = sg(bflo(ga.x)) * a0[0] + sg(bflo(gb.x)) * b0[0] + bflo(ow.x), o1 = sg(bfhi(ga.x)) * a0[1] + sg(bfhi(gb.x)) * b0[1] + bfhi(ow.x);
        const float o2 = sg(bflo(ga.y)) * a0[2] + sg(bflo(gb.y)) * b0[2] + bflo(ow.y), o3 = sg(bfhi(ga.y)) * a0[3] + sg(bfhi(gb.y)) * b0[3] + bfhi(ow.y);
        const float o4 = sg(bflo(ga.z)) * a1[0] + sg(bflo(gb.z)) * b1[0] + bflo(ow.z), o5 = sg(bfhi(ga.z)) * a1[1] + sg(bfhi(gb.z)) * b1[1] + bfhi(ow.z);
        const float o6 = sg(bflo(ga.w)) * a1[2] + sg(bflo(gb.w)) * b1[2] + bflo(ow.w), o7 = sg(bfhi(ga.w)) * a1[3] + sg(bfhi(gb.w)) * b1[3] + bfhi(ow.w);
        u32x4 w; w.x = cvtpk(o0, o1); w.y = cvtpk(o2, o3); w.z = cvtpk(o4, o5); w.w = cvtpk(o6, o7); return w;
    }
    __device__ __forceinline__ void operator()(const f32x4 (&acc)[2][2][4][2], const Unit& u, int wr, int wc, int fr, int fq) const {
        const int p = u.aux; const int lrow0 = u.pm * BM + wr * 64 + fr; const int d0 = u.pn * 128 + wc * 32 + 8 * fq;
        const bf16_t* gbase = GATE + (size_t)lrow0 * 4096 + (2 * p) * 1024 + d0; bf16_t* mbase = MERGED + (size_t)(row_base + lrow0) * DM + d0;
        const u32x4 zero = {0u, 0u, 0u, 0u};
#pragma unroll
        for (int ai = 0; ai < 2; ++ai)
#pragma unroll
            for (int mp = 0; mp < 2; ++mp) {
                u32x4 ga[2], gb[2], ow[2];
#pragma unroll
                for (int mm = 0; mm < 2; ++mm) { const size_t ro = (size_t)(ai * HALF + (2 * mp + mm) * 16);
                    ga[mm] = *(const u32x4*)(gbase + ro * 4096); gb[mm] = *(const u32x4*)(gbase + ro * 4096 + 1024);
                    ow[mm] = zero; if (p > 0) ow[mm] = *(const u32x4*)(mbase + ro * DM); }
#pragma unroll
                for (int mm = 0; mm < 2; ++mm) { const int m = 2 * mp + mm; const size_t ro = (size_t)(ai * HALF + m * 16);
                    *(u32x4*)(mbase + ro * DM) = mix(ga[mm], gb[mm], ow[mm], acc[ai][0][m][0], acc[ai][0][m][1], acc[ai][1][m][0], acc[ai][1][m][1]); }
                asm volatile("" ::: "memory");
            }
    }
};

struct EpiResid {
    static constexpr bool PERM = true;
    float* X; bf16_t* XB; float* ssq;
    __device__ __forceinline__ void operator()(const f32x4 (&acc)[2][2][4][2], const Unit& u, int wr, int wc, int fr, int fq) const {
        const int row0 = u.pm * BM + wr * 64 + fr; const int col0 = u.pn * BM + wc * 32 + 8 * fq;
#pragma unroll
        for (int ai = 0; ai < 2; ++ai)
#pragma unroll
            for (int m = 0; m < 4; ++m) { const int row = row0 + ai * HALF + m * 16; float sq = 0.f;
#pragma unroll
                for (int bj = 0; bj < 2; ++bj) { const int col = col0 + bj * HALF; f32x4* xp = (f32x4*)(X + (size_t)row * DM + col);
                    const f32x4 x0 = xp[0] + acc[ai][bj][m][0], x1 = xp[1] + acc[ai][bj][m][1];
                    xp[0] = x0; xp[1] = x1;
                    u32x4 w; w.x = cvtpk(x0[0], x0[1]); w.y = cvtpk(x0[2], x0[3]); w.z = cvtpk(x1[0], x1[1]); w.w = cvtpk(x1[2], x1[3]);
                    *(u32x4*)(XB + (size_t)row * DM + col) = w;
                    sq += (x0[0] * x0[0] + x0[1] * x0[1]) + (x0[2] * x0[2] + x0[3] * x0[3]) + (x1[0] * x1[0] + x1[1] * x1[1]) + (x1[2] * x1[2] + x1[3] * x1[3]); }
                sq = x16_sum(sq); sq = x32_sum(sq);
                if (fq == 0) ssq[(size_t)row * 16 + u.pn * 4 + wc] = sq; if (m & 1) asm volatile("" ::: "memory"); }
    }
};

struct EpiUp {
    static constexpr bool PERM = true;
    const float* ssq; bf16_t* H;
    __device__ __forceinline__ void operator()(const f32x4 (&acc)[2][2][4][2], const Unit& u, int wr, int wc, int fr, int fq) const {
        const int row0 = u.pm * BM + wr * 64 + fr; const int col0 = u.pn * BM + wc * 32 + 8 * fq;
        float rs[2][4];
#pragma unroll
        for (int ai = 0; ai < 2; ++ai)
#pragma unroll
            for (int m = 0; m < 4; ++m) rs[ai][m] = row_rstd(ssq, row0 + ai * HALF + m * 16, fq);
#pragma unroll
        for (int ai = 0; ai < 2; ++ai)
#pragma unroll
            for (int m = 0; m < 4; ++m) { const int row = row0 + ai * HALF + m * 16; const float s = rs[ai][m];
#pragma unroll
                for (int bj = 0; bj < 2; ++bj) { f32x4 v0 = acc[ai][bj][m][0] * s, v1 = acc[ai][bj][m][1] * s;
#pragma unroll
                    for (int i = 0; i < 4; ++i) { const float a = fmaxf(v0[i], 0.f), b = fmaxf(v1[i], 0.f); v0[i] = a * a; v1[i] = b * b; }
                    u32x4 w; w.x = cvtpk(v0[0], v0[1]); w.y = cvtpk(v0[2], v0[3]); w.z = cvtpk(v1[0], v1[1]); w.w = cvtpk(v1[2], v1[3]);
                    *(u32x4*)(H + (size_t)row * DFF + col0 + bj * HALF) = w; } }
    }
};
}

__device__ __forceinline__ int win_src(int n) {
    if (n < 3840) return n;
    if (n < 4608) return n + 4;
    if (n < 4864) return (n - 4608 < 4) ? 3840 + (n - 4608) : -1;
    return n - 4864 + 4612;
}
template <int CMAP>
__device__ __forceinline__ void transpose_item(const float* W, int K, int N, int Nsrc, const float* gain, bf16_t* WT, LAS float* scr, int item, int lane) {
    const int nblk = N / 32, kb = item / nblk, nb = item % nblk, k0 = 64 * kb, n0 = 32 * nb;
    const int n = n0 + (lane & 31); const int src = CMAP ? win_src(n) : n;
    const bool live = (src >= 0); const float* wp = W + (size_t)(k0 + (lane >> 5)) * Nsrc + (live ? src : 0); const float* gp = gain ? gain + k0 + (lane >> 5) : nullptr;
    float wv[32];
#pragma unroll
    for (int i = 0; i < 32; ++i) wv[i] = wp[(size_t)(2 * i) * Nsrc];
#pragma unroll
    for (int i = 0; i < 32; ++i) { float v = live ? wv[i] : 0.f; if (gp) v *= gp[2 * i]; scr[(2 * i + (lane >> 5)) * 33 + (lane & 31)] = v; }
    asm volatile("s_waitcnt lgkmcnt(0)" ::: "memory");
    const int c = lane & 7;
#pragma unroll
    for (int j = 0; j < 4; ++j) { const int nn = (lane >> 3) + 8 * j; const LAS float* s = scr + (8 * c) * 33 + nn;
        u32x4 o; o.x = cvtpk(s[0 * 33], s[1 * 33]); o.y = cvtpk(s[2 * 33], s[3 * 33]); o.z = cvtpk(s[4 * 33], s[5 * 33]); o.w = cvtpk(s[6 * 33], s[7 * 33]);
        *(u32x4*)(WT + (size_t)(n0 + nn) * K + k0 + 8 * c) = o; }
    asm volatile("s_waitcnt lgkmcnt(0)" ::: "memory");
}

__device__ __forceinline__ void branch_item(const float* Wn, int n, bf16_t* WBP, LAS float* scr, int item, int lane) {
    const int kb = item >> 5, nb = item & 31, k0 = 64 * kb, n0 = 32 * nb;
    const float* wp = Wn + (size_t)(k0 + (lane >> 5)) * DM + n0 + (lane & 31);
    float wv[32];
#pragma unroll
    for (int i = 0; i < 32; ++i) wv[i] = wp[(size_t)(2 * i) * DM];
#pragma unroll
    for (int i = 0; i < 32; ++i) scr[(2 * i + (lane >> 5)) * 33 + (lane & 31)] = wv[i];
    asm volatile("s_waitcnt lgkmcnt(0)" ::: "memory");
    const int c = lane & 7, bj = n & 1, pair = n >> 1;
    const u32x4 zero = {0u, 0u, 0u, 0u};
#pragma unroll
    for (int j = 0; j < 4; ++j) { const int nn = (lane >> 3) + 8 * j; const LAS float* sp = scr + (8 * c) * 33 + nn; const int d = n0 + nn;
        u32x4 o; o.x = cvtpk(sp[0 * 33], sp[1 * 33]); o.y = cvtpk(sp[2 * 33], sp[3 * 33]); o.z = cvtpk(sp[4 * 33], sp[5 * 33]); o.w = cvtpk(sp[6 * 33], sp[7 * 33]);
        bf16_t* row = WBP + ((size_t)((pair * 8 + (d >> 7)) * 256 + bj * 128 + (d & 127))) * 512 + k0 + 8 * c;
        *(u32x4*)(row + 256 * bj) = o; *(u32x4*)(row + 256 * (1 - bj)) = zero; }
    asm volatile("s_waitcnt lgkmcnt(0)" ::: "memory");
}

#define MFMA32(a, b, c) __builtin_amdgcn_mfma_f32_32x32x16_bf16((a), (b), (c), 0, 0, 0)
__device__ __forceinline__ bf16x8 ld16(const bf16_t* p) { return *(const bf16x8*)p; }
__device__ __forceinline__ bf16x8 pack8(const f32x16& s, int b) { u32x4 w; w.x = cvtpk(s[b], s[b + 1]); w.y = cvtpk(s[b + 2], s[b + 3]); w.z = cvtpk(s[b + 4], s[b + 5]); w.w = cvtpk(s[b + 6], s[b + 7]); return __builtin_bit_cast(bf16x8, w); }
__device__ __forceinline__ int crow(int r, int hi) { return (r & 3) + 8 * (r >> 2) + 4 * hi; }
__device__ __forceinline__ void store_o(bf16_t* orow, const f32x16& o0, const f32x16& o1, int hi) {
#pragma unroll
    for (int g = 0; g < 4; ++g) {
        u32x2 a; a.x = cvtpk(o0[4 * g], o0[4 * g + 1]); a.y = cvtpk(o0[4 * g + 2], o0[4 * g + 3]); *(u32x2*)(orow + 8 * g + 4 * hi) = a;
        u32x2 b; b.x = cvtpk(o1[4 * g], o1[4 * g + 1]); b.y = cvtpk(o1[4 * g + 2], o1[4 * g + 3]); *(u32x2*)(orow + 32 + 8 * g + 4 * hi) = b; }
}

struct KFrag { bf16x8 k[4]; };
struct VFrag { bf16x8 v[4]; };
__device__ __forceinline__ void k_load(KFrag& f, const bf16_t* Kh, int kb, int lane) {
    const bf16_t* kp = Kh + (size_t)kb * 2048 + lane * 8;
#pragma unroll
    for (int ds = 0; ds < 4; ++ds) f.k[ds] = ld16(kp + ds * 512);
}
__device__ __forceinline__ void v_load(VFrag& f, const bf16_t* Vh, int kb, int lane) {
    const bf16_t* vp = Vh + (size_t)kb * 2048 + lane * 8;
    f.v[0] = ld16(vp); f.v[1] = ld16(vp + 512); f.v[2] = ld16(vp + 1024); f.v[3] = ld16(vp + 1536);
}
__device__ __forceinline__ void q_load(bf16x8 (&qf)[4], const bf16_t* Qs, int qb, int r32, int hi) {
    const bf16_t* qp = Qs + (size_t)(qb * 32 + r32) * LDQK + hi * 8;
#pragma unroll
    for (int ds = 0; ds < 4; ++ds) qf[ds] = ld16(qp + ds * 16);
}

template <int MODE, bool MASK, int NDS>
__device__ __forceinline__ void sm_step(const bf16x8 (&ck)[NDS], const bf16x8 (&qf)[NDS], const VFrag& cv, float slope2, const LAS float* cl, int kb, int d0,
                                        float& m, float& l, f32x16& o0, f32x16& o1, int hi) {
    constexpr float SC2 = ((MODE == 2) ? 0.17677669529663687f : 0.125f) * LOG2E;
    f32x16 s;
#pragma unroll
    for (int i = 0; i < 16; ++i) s[i] = 0.f;
#pragma unroll
    for (int ds = 0; ds < NDS; ++ds) s = MFMA32(ck[ds], qf[ds], s);
#define KC(r) (((r) & 3) + 8 * ((r) >> 2))
    int dh = d0 - 4 * hi; asm volatile("" : "+v"(dh));
    float sl = slope2; asm volatile("" : "+v"(sl));
    const LAS float* clk = cl + 33 * kb + 4 * hi; if (MODE == 0) asm volatile("" : "+v"(clk));
    const float base = (MODE == 0) ? 0.f : -sl * (float)dh;
#pragma unroll
    for (int r = 0; r < 16; ++r) {
        float v = (MODE == 0) ? fmaf(s[r], SC2, clk[KC(r)]) : fmaf(s[r], SC2, sl * (float)KC(r));
        if (MASK) { const int dist = dh - KC(r); const bool valid = (MODE == 1) ? ((unsigned)dist <= 128u) : (dist >= 0); v = valid ? v : -INFINITY; }
        s[r] = v;
    }
#undef KC
    float mt = fmaxf(fmaxf(s[0], s[1]), fmaxf(s[2], s[3]));
#pragma unroll
    for (int r = 4; r < 16; r += 4) mt = fmaxf(mt, fmaxf(fmaxf(s[r], s[r + 1]), fmaxf(s[r + 2], s[r + 3])));
    mt = x32_max(mt + base);
    const float mn = fmaxf(m, mt), alpha = ex2(m - mn), c = mn - base;
    float ps = 0.f;
#pragma unroll
    for (int r = 0; r < 16; ++r) { const float p = ex2(s[r] - c); s[r] = p; ps += p; }
    l = l * alpha + ps; m = mn;
#pragma unroll
    for (int i = 0; i < 16; ++i) { o0[i] *= alpha; o1[i] *= alpha; }
    const bf16x8 pf0 = pack8(s, 0), pf1 = pack8(s, 8);
    o0 = MFMA32(cv.v[0], pf0, o0); o0 = MFMA32(cv.v[1], pf1, o0); o1 = MFMA32(cv.v[2], pf0, o1); o1 = MFMA32(cv.v[3], pf1, o1);
}
template <int MODE>
__device__ __forceinline__ void sm_unit(const bf16_t* Qs, const bf16_t* Ks, const bf16_t* VTs, int qb, int kb_hi, int kb_lo, float slope2, const LAS float* cl,
                                        f32x16& o0, f32x16& o1, float& m_out, float& l_out, int lane) {
    const int r32 = lane & 31, hi = lane >> 5;
    constexpr int NDS = (MODE == 2) ? 2 : 4;
    bf16x8 qf[NDS];
    { const bf16_t* qp = Qs + (size_t)(qb * 32 + r32) * LDQK + hi * 8;
#pragma unroll
      for (int ds = 0; ds < NDS; ++ds) qf[ds] = ld16(qp + ds * 16); }
    bf16x8 nk[NDS];
    { const bf16_t* kp = Ks + (size_t)kb_hi * 2048 + lane * 8;
#pragma unroll
      for (int ds = 0; ds < NDS; ++ds) nk[ds] = ld16(kp + ds * 512); }
    float m = -INFINITY, l = 0.f;
#pragma unroll
    for (int i = 0; i < 16; ++i) { o0[i] = 0.f; o1[i] = 0.f; }
    for (int kb = kb_hi; kb >= kb_lo; --kb) {
        bf16x8 ck[NDS];
#pragma unroll
        for (int ds = 0; ds < NDS; ++ds) ck[ds] = nk[ds];
        VFrag cv; v_load(cv, VTs, kb, lane);
        if (kb > kb_lo) { const bf16_t* kp = Ks + (size_t)(kb - 1) * 2048 + lane * 8;
#pragma unroll
            for (int ds = 0; ds < NDS; ++ds) nk[ds] = ld16(kp + ds * 512); }
        const int d0 = (qb - kb) * 32 + r32;
        const bool edge = (MODE == 1) ? (kb == qb || kb + 4 <= qb) : (kb == qb);
        if (edge) sm_step<MODE, true, NDS>(ck, qf, cv, slope2, cl, kb, d0, m, l, o0, o1, hi);
        else      sm_step<MODE, false, NDS>(ck, qf, cv, slope2, cl, kb, d0, m, l, o0, o1, hi);
    }
    l = x32_sum(l);
    m_out = m; l_out = l;
}

template <int MODE>
__device__ __forceinline__ void sm_unit64(const bf16_t* Qs, const bf16_t* Ks, const bf16_t* VTs, int Q, int kb_hi, int kb_lo, float slope2, const LAS float* cl,
                                          f32x16 (&o)[2][2], float (&m)[2], float (&l)[2], int lane) {
    const int r32 = lane & 31, hi = lane >> 5;
    constexpr int NDS = (MODE == 2) ? 2 : 4;
    bf16x8 qf[2][NDS];
#pragma unroll
    for (int i = 0; i < 2; ++i) { const bf16_t* qp = Qs + (size_t)((2 * Q + i) * 32 + r32) * LDQK + hi * 8;
#pragma unroll
        for (int ds = 0; ds < NDS; ++ds) qf[i][ds] = ld16(qp + ds * 16); }
    bf16x8 nk[NDS];
    { const bf16_t* kp = Ks + (size_t)kb_hi * 2048 + lane * 8;
#pragma unroll
      for (int ds = 0; ds < NDS; ++ds) nk[ds] = ld16(kp + ds * 512); }
#pragma unroll
    for (int i = 0; i < 2; ++i) { m[i] = -INFINITY; l[i] = 0.f;
#pragma unroll
        for (int k = 0; k < 16; ++k) { o[i][0][k] = 0.f; o[i][1][k] = 0.f; } }
    for (int kb = kb_hi; kb >= kb_lo; --kb) {
        bf16x8 ck[NDS];
#pragma unroll
        for (int ds = 0; ds < NDS; ++ds) ck[ds] = nk[ds];
        VFrag cv; v_load(cv, VTs, kb, lane);
        if (kb > kb_lo) { const bf16_t* kp = Ks + (size_t)(kb - 1) * 2048 + lane * 8;
#pragma unroll
            for (int ds = 0; ds < NDS; ++ds) nk[ds] = ld16(kp + ds * 512); }
        if (kb < 2 * Q) {
            const int d00 = (2 * Q - kb) * 32 + r32;
            sm_step<MODE, false, NDS>(ck, qf[0], cv, slope2, cl, kb, d00, m[0], l[0], o[0][0], o[0][1], hi);
            sm_step<MODE, false, NDS>(ck, qf[1], cv, slope2, cl, kb, d00 + 32, m[1], l[1], o[1][0], o[1][1], hi);
        } else {
#pragma unroll
            for (int i = 0; i < 2; ++i) {
                const int qbi = 2 * Q + i;
                if (kb <= qbi) {
                    const int d0 = (qbi - kb) * 32 + r32;
                    if (kb == qbi) sm_step<MODE, true, NDS>(ck, qf[i], cv, slope2, cl, kb, d0, m[i], l[i], o[i][0], o[i][1], hi);
                    else           sm_step<MODE, false, NDS>(ck, qf[i], cv, slope2, cl, kb, d0, m[i], l[i], o[i][0], o[i][1], hi);
                }
            }
        }
    }
    l[0] = x32_sum(l[0]); l[1] = x32_sum(l[1]);
}

__device__ __forceinline__ void sb_unit(const bf16_t* Qs, const bf16_t* Ks, const bf16_t* VTs, int qb, f32x16& o0, f32x16& o1, int lane) {
    const int r32 = lane & 31, hi = lane >> 5;
    constexpr float SC2 = 0.125f * LOG2E;
    bf16x8 qf[4]; q_load(qf, Qs, qb, r32, hi);
    KFrag nx; k_load(nx, Ks, qb, lane);
    float R = 0.f;
#pragma unroll
    for (int i = 0; i < 16; ++i) { o0[i] = 0.f; o1[i] = 0.f; }
    for (int kb = qb; kb >= 0; --kb) {
        const KFrag cu = nx; VFrag cv; v_load(cv, VTs, kb, lane);
        if (kb > 0) k_load(nx, Ks, kb - 1, lane);
        f32x16 s;
#pragma unroll
        for (int i = 0; i < 16; ++i) s[i] = 0.f;
#pragma unroll
        for (int ds = 0; ds < 4; ++ds) s = MFMA32(cu.k[ds], qf[ds], s);
        float lk[16], ls[16];
        const int d0 = (qb - kb) * 32 + r32;
#pragma unroll
        for (int r = 0; r < 16; ++r) { const float z2 = s[r] * SC2; const float sp = fmaxf(z2, 0.f) + lg2(1.0f + ex2(-fabsf(z2))); const bool valid = crow(r, hi) < d0; lk[r] = valid ? -sp : 0.f; ls[r] = valid ? (z2 - sp) : -INFINITY; }
        float e[16], tq[4], pq[4];
#pragma unroll
        for (int g = 0; g < 4; ++g) { e[4 * g + 3] = 0.f; e[4 * g + 2] = lk[4 * g + 3]; e[4 * g + 1] = e[4 * g + 2] + lk[4 * g + 2]; e[4 * g] = e[4 * g + 1] + lk[4 * g + 1]; tq[g] = e[4 * g] + lk[4 * g]; }
#pragma unroll
        for (int g = 0; g < 4; ++g) pq[g] = x32_partner(tq[g], hi);
        float cs[4]; cs[3] = 0.f; cs[2] = tq[3] + pq[3]; cs[1] = cs[2] + (tq[2] + pq[2]); cs[0] = cs[1] + (tq[1] + pq[1]);
        const float total = cs[0] + (tq[0] + pq[0]);
#pragma unroll
        for (int g = 0; g < 4; ++g) { const float later = R + cs[g] + (hi == 0 ? pq[g] : 0.f);
#pragma unroll
            for (int i = 0; i < 4; ++i) s[4 * g + i] = ex2(ls[4 * g + i] + e[4 * g + i] + later); }
        R += total;
        const bf16x8 pf0 = pack8(s, 0), pf1 = pack8(s, 8);
        o0 = MFMA32(cv.v[0], pf0, o0); o0 = MFMA32(cv.v[1], pf1, o0); o1 = MFMA32(cv.v[2], pf0, o1); o1 = MFMA32(cv.v[3], pf1, o1);
        if (__all(R < -150.0f)) break;
    }
}

#define XB_TMO      128
#define XB_XCNT(j)  (256  + 64 * (j))
#define XB_XSUB(j)  (1280 + 64 * (j))
#define XB_XGEN(j)  (2304 + 64 * (j))
#define XB_TOP      3328
#define XB_TOPGEN   3392
#define XCD_BAR_WORDS 3456
#define XB_SPIN_CAP (1u << 18)
__device__ __forceinline__ unsigned xb_ld(unsigned* p)              { return __hip_atomic_load(p, __ATOMIC_RELAXED, __HIP_MEMORY_SCOPE_AGENT); }
__device__ __forceinline__ unsigned xb_add(unsigned* p, unsigned v) { return __hip_atomic_fetch_add(p, v, __ATOMIC_RELAXED, __HIP_MEMORY_SCOPE_AGENT); }
__device__ __forceinline__ unsigned xb_xcc_id() { return (unsigned)__builtin_amdgcn_s_getreg((3 << 11) | 20) & 0xFu; }
#define XB_SPIN(cond, bar) do { unsigned _sp = 0; while (cond) { __builtin_amdgcn_s_sleep(1); \
    if ((++_sp & 255u) == 0u) { if (xb_ld(&(bar)[XB_TMO])) break; if (_sp > XB_SPIN_CAP) { atomicAdd(&(bar)[XB_TMO], 1u); break; } } } } while (0)
__device__ __forceinline__ void xcd_barrier_complete(unsigned* bar, unsigned x, unsigned& nloc, unsigned& nx) {
    const unsigned G = gridDim.x * gridDim.y * gridDim.z;
    unsigned sum, cnt, mine, sp = 0u;
    for (;;) {
        sum = 0u; cnt = 0u; mine = 0u;
#pragma unroll
        for (unsigned j = 0; j < 16; ++j) { const unsigned c = xb_ld(&bar[XB_XCNT(j)]); sum += c; cnt += (c > 0u) ? 1u : 0u; mine = (j == x) ? c : mine; }
        if (sum == G) break;
        __builtin_amdgcn_s_sleep(1);
        if ((++sp & 255u) == 0u) { if (xb_ld(&bar[XB_TMO])) break; if (sp > XB_SPIN_CAP) { atomicAdd(&bar[XB_TMO], 1u); break; } }
    }
    nloc = mine > 0u ? mine : 1u; nx = cnt > 0u ? cnt : 1u;
}
__device__ __forceinline__ void xcd_barrier(unsigned* bar, volatile LAS unsigned* st) {
    asm volatile("s_waitcnt vmcnt(0)" ::: "memory");
    __syncthreads();
    if (threadIdx.x == 0) {
        const unsigned x = xb_xcc_id();
        __builtin_amdgcn_s_waitcnt(0);
        unsigned nloc = st[0], nx = st[1];
        if (nloc == 0u) { xcd_barrier_complete(bar, x, nloc, nx); st[0] = nloc; st[1] = nx; }
        const unsigned old = xb_add(&bar[XB_XSUB(x)], 1u);
        const unsigned gen = old / nloc;
        if (old + 1u == (gen + 1u) * nloc) {
            __builtin_amdgcn_fence(__ATOMIC_RELEASE, "agent");
            asm volatile("s_waitcnt vmcnt(0)" ::: "memory");
            const unsigned og = xb_add(&bar[XB_TOP], 1u);
            const unsigned tg = og / nx;
            if (og + 1u == (tg + 1u) * nx) xb_add(&bar[XB_TOPGEN], 1u);
            else XB_SPIN(xb_ld(&bar[XB_TOPGEN]) == tg, bar);
            __builtin_amdgcn_fence(__ATOMIC_ACQUIRE, "agent");
            xb_add(&bar[XB_XGEN(x)], 1u);
            asm volatile("s_waitcnt vmcnt(0)" ::: "memory");
        } else {
            XB_SPIN(xb_ld(&bar[XB_XGEN(x)]) == gen, bar);
            __builtin_amdgcn_fence(__ATOMIC_ACQUIRE, "agent");
            asm volatile("s_waitcnt vmcnt(0)" ::: "memory");
        }
    }
    __syncthreads();
}
constexpr int MISC_OFF = 131072 + 320;

struct Params {
    const float* x; const float* mix_g; const float* w_in; const float* b_forget; const float* lq1; const float* lk1; const float* lq2; const float* lk2;
    const float* diff_g; const float* w_branch; const float* w_out; const float* mlp_g; const float* w_up; const float* w_down; const float* final_g;
    float* out; unsigned char* ws;
};

#ifndef REP_P1
#define REP_P1 1
#endif
#ifndef REP_P2
#define REP_P2 1
#endif
#ifndef REP_P3
#define REP_P3 1
#endif
#ifndef REP_P5
#define REP_P5 1
#endif
#ifndef REP_SYNC
#define REP_SYNC 1
#endif
#ifndef REP_CONV
#define REP_CONV 1
#endif
#define GSYNC() do { for (int rs_ = 0; rs_ < REP_SYNC; ++rs_) { KParamsPtr pb_ = OPQ_PP(); xcd_barrier((unsigned*)(pb_->ws + WS_CTL) + CW_BAR, (volatile LAS unsigned*)(lds + MISC_OFF)); } } while (0)
#define OPQ_TID() ({ int t_ = threadIdx.x; asm volatile("" : "+v"(t_)); t_; })
typedef const __attribute__((address_space(4))) Params* KParamsPtr;
#define OPQ_PP() ({ KParamsPtr p_ = (KParamsPtr)__builtin_amdgcn_kernarg_segment_ptr(); asm volatile("" : "+s"(p_)); p_; })
#define PHASE_VARS() const int tid = OPQ_TID(); const int lane = tid & 63, wave = __builtin_amdgcn_readfirstlane(tid >> 6); const int G = gridDim.x, bx = blockIdx.x; \
    const int gw = bx * NWAVES + wave, NGW = G * NWAVES; KParamsPtr PP = OPQ_PP(); unsigned char* ws = PP->ws; LAS float* scr = (LAS float*)(lds + wave * 16384); (void)lane; (void)gw; (void)NGW; (void)ws; (void)scr; (void)G; (void)bx; (void)PP

__global__ void __launch_bounds__(NWAVES * 64, 2) fwd_mega(Params P) {
    extern __shared__ __attribute__((aligned(16))) unsigned char lds_raw[];
    LAS unsigned char* lds = (LAS unsigned char*)lds_raw;
    cg::grid_group grid = cg::this_grid();
    { const int t0 = OPQ_TID(); if (t0 < 64) ((LAS unsigned*)(lds + 131072))[t0 + 64] = 0u; __syncthreads();
      if (t0 == 0) { KParamsPtr p0 = OPQ_PP(); (void)xb_add((unsigned*)(p0->ws + WS_CTL) + CW_BAR + XB_XCNT(xb_xcc_id()), 1u); } }

    {
        PHASE_VARS();
        float* X = PP->out; bf16_t* XB = (bf16_t*)(ws + WS_XB); float* SSQ = (float*)(ws + WS_SSQ);
        for (int row = gw; row < TOK; row += NGW) {
            const f32x4* xr = (const f32x4*)(PP->x + (size_t)row * DM) + lane; f32x4* xo = (f32x4*)(X + (size_t)row * DM) + lane;
            unsigned long long* o8 = (unsigned long long*)(XB + (size_t)row * DM) + lane;
            float s = 0.f;
#pragma unroll
            for (int j = 0; j < 4; ++j) { const f32x4 v = xr[64 * j]; xo[64 * j] = v; s += (v[0] * v[0] + v[1] * v[1]) + (v[2] * v[2] + v[3] * v[3]);
                o8[64 * j] = (unsigned long long)cvtpk(v[0], v[1]) | ((unsigned long long)cvtpk(v[2], v[3]) << 32); }
            s = wave_sum(s);
            if (lane < 16) SSQ[(size_t)row * 16 + lane] = (lane == 0) ? s : 0.f;
        }
    }

    for (int layer = 0; layer < DEPTH; ++layer) {
        for (int rep = 0; rep < REP_CONV; ++rep) {
            PHASE_VARS();
            bf16_t* WIN = (bf16_t*)(ws + WS_WIN); bf16_t* WB = (bf16_t*)(ws + WS_WB); bf16_t* WOUT = (bf16_t*)(ws + WS_WOUT);
            const float* w_in = PP->w_in + (size_t)layer * DM * DIN; const float* mg = PP->mix_g + (size_t)layer * DM;
            const float* wb = PP->w_branch + (size_t)layer * 4 * 256 * DM; const float* wo = PP->w_out + (size_t)layer * DM * DM;
            constexpr int I_IN = (DM / 64) * (NPROJ / 32), I_B = (256 / 64) * (DM / 32), I_O = (DM / 64) * (DM / 32);
            for (int it = gw; it < I_IN + 4 * I_B + I_O; it += NGW) {
                int r = it;
                if (r < I_IN) { transpose_item<1>(w_in, DM, NPROJ, DIN, mg, WIN, scr, r, lane); continue; } r -= I_IN;
                if (r < 4 * I_B) { const int n = r / I_B; branch_item(wb + (size_t)n * 256 * DM, n, WB, scr, r % I_B, lane); continue; } r -= 4 * I_B;
                transpose_item<0>(wo, DM, DM, DM, nullptr, WOUT, scr, r, lane);
            }
        }
        if (layer == 0) grid.sync(); else GSYNC();

        for (int half = 0; half < 2; ++half) {
#ifndef NO_P1
            for (int rep = 0; rep < REP_P1; ++rep) {
                PHASE_VARS();
                const int rb = half * HT;
                pg8::Gemm g{(const bf16_t*)(ws + WS_XB) + (size_t)rb * DM, (const bf16_t*)(ws + WS_WIN), DM, DM, DM, 0, 0};
                pg8::StaticOrder S; S.init(HT, NPROJ, G, bx);
                pg8::EpiProj E{(const float*)(ws + WS_SSQ), rb, (bf16_t*)(ws + WS_QK), (bf16_t*)(ws + WS_KF), (bf16_t*)(ws + WS_VT), (float*)(ws + WS_FL), (bf16_t*)(ws + WS_GATE)};
                pg8::gemm_phase<pg8::EpiProj, pg8::StaticOrder, true>(lds, g, S, E);
            }
#endif
            GSYNC();
#ifndef NO_P2
            for (int rep = 0; rep < REP_P2; ++rep) {
                PHASE_VARS();
                unsigned* ctr = (unsigned*)(ws + WS_CTL) + 64 + 512 * (layer * 2 + half + 4 * rep);
                const int xq = bx & 7;
                ctr += 64 * xq;
                for (;;) {
                    int li = 0; if (lane == 0) li = (int)atomicAdd(ctr, 1u); li = __builtin_amdgcn_readfirstlane(li);
                    if (li >= 800) break;
                    int idx;
                    if (li < 288) { const int hl = li / 48, row = li - hl * 48; idx = row * 48 + (xq + 8 * hl); }
                    else if (li < 416) { const int i = li - 288; idx = 2304 + ((63 - (i & 63)) << 4) + (xq + 8 * (i >> 6)); }
                    else { const int i = li - 416; idx = 3328 + (xq + 8 * (i >> 6)) * 64 + (i & 63); }
                    int lane_u = lane; asm volatile("" : "+v"(lane_u));
                    const int lane = lane_u, r32 = lane & 31, hi = lane >> 5;
                    KParamsPtr PU = OPQ_PP(); unsigned char* wsu = PU->ws;
                    bf16_t* YS = (bf16_t*)(wsu + WS_YS); bf16_t* DILO = (bf16_t*)(wsu + WS_DILO); float* LSE = (float*)(wsu + WS_LSE); const float* FL = (const float*)(wsu + WS_FL);
                    const bf16_t* QK = (const bf16_t*)(wsu + WS_QK); const bf16_t* KF = (const bf16_t*)(wsu + WS_KF); const bf16_t* VT = (const bf16_t*)(wsu + WS_VT);
                    if (idx < 2304) {
                        const int j = idx / 48, e = idx - j * 48, type3 = e >> 4, bh = e & 15, b = bh >> 2, h = bh & 3;
                        int Q, chunk; if (j < 32) { Q = 31 - (j >> 1); chunk = j & 1; } else { Q = 47 - j; chunk = 0; }
                        int kb_lo = 0, kb_hi = 2 * Q + 1;
                        if (Q >= 16) { if (chunk == 0) kb_hi = Q; else kb_lo = Q + 1; }
                        const size_t rowb = (size_t)b * SEQ;
                        bf16_t* SCRB = (bf16_t*)(wsu + WS_MERGED) + (size_t)(half * HT) * DM;
                        float* LSE2 = (float*)(wsu + WS_LSE2);
                        f32x16 o[2][2]; float m[2], l[2]; int slot;
                        if (type3 == 2) {
                            LAS float* cl = scr;
                            const float bf = PP->b_forget[layer * 4 + h];
                            float run = 0.f;
                            if (lane <= kb_hi) {
                                const float* fp = FL + (rowb + 32 * lane) * 4 + h;
#pragma unroll 8
                                for (int i = 0; i < 32; ++i) { const float y = fp[4 * i] + bf; const float lf = fminf(y, 0.f) - __logf(1.0f + __expf(-fabsf(y))); run += lf; cl[33 * lane + i] = run; }
                            }
                            float incl = run;
#pragma unroll
                            for (int o_ = 1; o_ < 64; o_ <<= 1) { const float tt = __uint_as_float((unsigned)__builtin_amdgcn_ds_bpermute((lane - o_) << 2, (int)__float_as_uint(incl))); if (lane >= o_) incl += tt; }
                            const float excl = incl - run;
                            if (lane <= kb_hi) {
#pragma unroll 8
                                for (int i = 0; i < 32; ++i) cl[33 * lane + i] = -(cl[33 * lane + i] + excl) * LOG2E;
                            }
                            asm volatile("s_waitcnt lgkmcnt(0)" ::: "memory");
                            sm_unit64<0>(QK + rowb * LDQK + 4 * 256 + h * 64, KF + (size_t)(b * 24 + 16 + h) * HSEQ, VT + (size_t)(b * 24 + 16 + h) * HSEQ, Q, kb_hi, kb_lo, 0.f, cl, o, m, l, lane);
                            asm volatile("s_waitcnt lgkmcnt(0)" ::: "memory");
                            slot = chunk;
                        } else {
                            const float slope = exp2f(-8.0f * (float)(5 + h) / 16.0f);
                            sm_unit64<2>(QK + rowb * LDQK + 5 * 256 + h * 64 + type3 * 32, KF + (size_t)(b * 24 + 20 + h) * HSEQ + type3 * 1024, VT + (size_t)(b * 24 + 20 + h) * HSEQ, Q, kb_hi, kb_lo, slope * LOG2E, nullptr, o, m, l, lane);
                            slot = 2 + 2 * type3 + chunk;
                        }
#pragma unroll
                        for (int i = 0; i < 2; ++i) {
                            const int t = (2 * Q + i) * 32 + r32;
                            bf16_t* dst;
                            if (type3 == 2) dst = chunk ? SCRB + (rowb + t) * 256 + h * 64 : YS + (rowb + t) * DM + 512 + h * 64;
                            else dst = (type3 == 0 && chunk == 0) ? YS + (rowb + t) * DM + 768 + h * 64 : SCRB + (size_t)(2 * type3 + chunk) * HT * 256 + (rowb + t) * 256 + h * 64;
                            const float inv = 1.0f / l[i];
#pragma unroll
                            for (int k = 0; k < 16; ++k) { o[i][0][k] *= inv; o[i][1][k] *= inv; }
                            store_o(dst, o[i][0], o[i][1], hi);
                            if (hi == 0) LSE2[(rowb + t) * 24 + h * 6 + slot] = m[i] + lg2(l[i]);
                        }
                    } else if (idx < 3328) {
                        const int i1 = idx - 2304, qb = 63 - (i1 >> 4), bh = i1 & 15, b = bh >> 2, h = bh & 3;
                        const size_t rowb = (size_t)b * SEQ; const int t = qb * 32 + r32;
                        f32x16 o0, o1;
                        sb_unit(QK + rowb * LDQK + 0 * 256 + h * 64, KF + (size_t)(b * 24 + h) * HSEQ, VT + (size_t)(b * 24 + h) * HSEQ, qb, o0, o1, lane);
                        store_o(YS + (rowb + t) * DM + 0 * 256 + h * 64, o0, o1, hi);
                    } else {
                        const int i2 = idx - 3328, j = i2 & 63, gh = (i2 >> 6) % 12, b = i2 / 768, gI = gh >> 2, h = gh & 3;
                        const int rsh = 2 * gI, r = 1 << rsh, sl = SEQ >> rsh, nubsh = 6 - rsh, rho = j >> nubsh, ub = j & ((1 << nubsh) - 1);
                        const int sidx = (gI == 0) ? h : (gI == 1 ? 8 + h : 12 + h);
                        const float slope = exp2f(-8.0f * (float)(sidx + 1) / 16.0f);
                        const size_t rowb = (size_t)b * SEQ + (size_t)rho * sl;
                        f32x16 o0, o1; float m, l;
                        const int kb_lo = (ub - 4 > 0) ? ub - 4 : 0;
                        sm_unit<1>(QK + rowb * LDQK + (1 + gI) * 256 + h * 64, KF + (size_t)(b * 24 + 4 + 4 * gI + h) * HSEQ + (size_t)rho * sl * 64,
                                   VT + (size_t)(b * 24 + 4 + 4 * gI + h) * HSEQ + (size_t)rho * sl * 64, ub, ub, kb_lo, slope * (float)r * LOG2E, nullptr, o0, o1, m, l, lane);
                        const float inv = 1.0f / l;
#pragma unroll
                        for (int i = 0; i < 16; ++i) { o0[i] *= inv; o1[i] *= inv; }
                        const int u = ub * 32 + r32; const size_t tok = (size_t)b * SEQ + (size_t)u * r + rho;
                        store_o(DILO + tok * 768 + gI * 256 + h * 64, o0, o1, hi);
                        if (hi == 0) LSE[tok * 12 + gI * 4 + h] = (m + lg2(l)) * LN2;
                    }
                }
            }
#endif
            GSYNC();
            {
                PHASE_VARS();
                const float lam_init = (layer == 0) ? 0.2f : 0.35550906759093115f;
                float lam;
                { const float a = (lane < 32) ? PP->lq1[layer * 32 + lane] * PP->lk1[layer * 32 + lane] : 0.f, b = (lane < 32) ? PP->lq2[layer * 32 + lane] * PP->lk2[layer * 32 + lane] : 0.f;
                  lam = __expf(wave_sum(a)) - __expf(wave_sum(b)) + lam_init; }
                bf16_t* YS = (bf16_t*)(ws + WS_YS); const bf16_t* DILO = (const bf16_t*)(ws + WS_DILO); const float* LSE = (const float*)(ws + WS_LSE);
                const bf16_t* SCRB = (const bf16_t*)(ws + WS_MERGED) + (size_t)(half * HT) * DM; const float* LSE2 = (const float*)(ws + WS_LSE2);
                const int h = lane >> 4, dq = (lane & 15) * 4;
                const f32x4 dgv = *(const f32x4*)(PP->diff_g + layer * 64 + dq);
                for (int row = gw; row < HT; row += NGW) {
                    const bool split = ((row & (SEQ - 1)) >> 5) >= 32;
                    {
                        const float l0 = LSE[(size_t)row * 12 + h], l1 = LSE[(size_t)row * 12 + 4 + h], l2 = LSE[(size_t)row * 12 + 8 + h];
                        const float mx = fmaxf(l0, fmaxf(l1, l2)); const float e0 = __expf(l0 - mx), e1 = __expf(l1 - mx), e2 = __expf(l2 - mx); const float inv = 1.0f / (e0 + e1 + e2);
                        const u32x2 a = *(const u32x2*)(DILO + (size_t)row * 768 + 4 * lane), b = *(const u32x2*)(DILO + (size_t)row * 768 + 256 + 4 * lane), c = *(const u32x2*)(DILO + (size_t)row * 768 + 512 + 4 * lane);
                        const float w0 = e0 * inv, w1 = e1 * inv, w2 = e2 * inv;
                        u32x2 o; o.x = cvtpk(w0 * bflo(a.x) + w1 * bflo(b.x) + w2 * bflo(c.x), w0 * bfhi(a.x) + w1 * bfhi(b.x) + w2 * bfhi(c.x));
                        o.y = cvtpk(w0 * bflo(a.y) + w1 * bflo(b.y) + w2 * bflo(c.y), w0 * bfhi(a.y) + w1 * bfhi(b.y) + w2 * bfhi(c.y));
                        *(u32x2*)(YS + (size_t)row * DM + 256 + 4 * lane) = o;
                    }
                    const float* ls = LSE2 + (size_t)row * 24 + h * 6;
                    const u32x2 f0 = *(const u32x2*)(YS + (size_t)row * DM + 512 + 4 * lane), a0 = *(const u32x2*)(YS + (size_t)row * DM + 768 + 4 * lane);
                    const u32x2 b0 = *(const u32x2*)(SCRB + (size_t)2 * HT * 256 + (size_t)row * 256 + 4 * lane);
                    float fv[4] = {bflo(f0.x), bfhi(f0.x), bflo(f0.y), bfhi(f0.y)}, av[4] = {bflo(a0.x), bfhi(a0.x), bflo(a0.y), bfhi(a0.y)}, bv[4] = {bflo(b0.x), bfhi(b0.x), bflo(b0.y), bfhi(b0.y)};
                    if (split) {
                        const u32x2 f1 = *(const u32x2*)(SCRB + (size_t)row * 256 + 4 * lane), a1 = *(const u32x2*)(SCRB + (size_t)1 * HT * 256 + (size_t)row * 256 + 4 * lane), b1 = *(const u32x2*)(SCRB + (size_t)3 * HT * 256 + (size_t)row * 256 + 4 * lane);
                        const float lf0 = ls[0], lf1 = ls[1], la0 = ls[2], la1 = ls[3], lb0 = ls[4], lb1 = ls[5];
                        { const float mx = fmaxf(lf0, lf1), e0 = ex2(lf0 - mx), e1 = ex2(lf1 - mx), inv = 1.0f / (e0 + e1), w0 = e0 * inv, w1 = e1 * inv;
                          fv[0] = w0 * fv[0] + w1 * bflo(f1.x); fv[1] = w0 * fv[1] + w1 * bfhi(f1.x); fv[2] = w0 * fv[2] + w1 * bflo(f1.y); fv[3] = w0 * fv[3] + w1 * bfhi(f1.y); }
                        { const float mx = fmaxf(la0, la1), e0 = ex2(la0 - mx), e1 = ex2(la1 - mx), inv = 1.0f / (e0 + e1), w0 = e0 * inv, w1 = e1 * inv;
                          av[0] = w0 * av[0] + w1 * bflo(a1.x); av[1] = w0 * av[1] + w1 * bfhi(a1.x); av[2] = w0 * av[2] + w1 * bflo(a1.y); av[3] = w0 * av[3] + w1 * bfhi(a1.y); }
                        { const float mx = fmaxf(lb0, lb1), e0 = ex2(lb0 - mx), e1 = ex2(lb1 - mx), inv = 1.0f / (e0 + e1), w0 = e0 * inv, w1 = e1 * inv;
                          bv[0] = w0 * bv[0] + w1 * bflo(b1.x); bv[1] = w0 * bv[1] + w1 * bfhi(b1.x); bv[2] = w0 * bv[2] + w1 * bflo(b1.y); bv[3] = w0 * bv[3] + w1 * bfhi(b1.y); }
                        u32x2 fo; fo.x = cvtpk(fv[0], fv[1]); fo.y = cvtpk(fv[2], fv[3]);
                        *(u32x2*)(YS + (size_t)row * DM + 512 + 4 * lane) = fo;
                    }
                    float dv[4]; float ss = 0.f;
#pragma unroll
                    for (int i = 0; i < 4; ++i) { dv[i] = av[i] - lam * bv[i]; ss += dv[i] * dv[i]; }
                    ss += swz_xor<1>(ss); ss += swz_xor<2>(ss); ss += swz_xor<4>(ss); ss += swz_xor<8>(ss);
                    const float rn = __builtin_amdgcn_rsqf(ss * (1.0f / 64.0f) + RMS_EPS) * (1.0f - lam_init);
                    u32x2 dout; dout.x = cvtpk(dv[0] * rn * dgv[0], dv[1] * rn * dgv[1]); dout.y = cvtpk(dv[2] * rn * dgv[2], dv[3] * rn * dgv[3]);
                    *(u32x2*)(YS + (size_t)row * DM + 768 + 4 * lane) = dout;
                }
            }
            GSYNC();
#ifndef NO_P3
            for (int rep = 0; rep < REP_P3; ++rep) {
                PHASE_VARS();
                pg8::Gemm g{(const bf16_t*)(ws + WS_YS), (const bf16_t*)(ws + WS_WB), DM, 512, 512, 512 * 2, (long)8 * 256 * 512 * 2};
                pg8::BranchOrder S{bx, G};
                pg8::EpiBranch E{(const bf16_t*)(ws + WS_GATE), (bf16_t*)(ws + WS_MERGED), half * HT};
                pg8::gemm_phase<pg8::EpiBranch, pg8::BranchOrder, false>(lds, g, S, E);
            }
#endif
            GSYNC();
        }
#ifndef NO_P4
        for (int rep = 0; rep < REP_CONV; ++rep) {
            PHASE_VARS();
            bf16_t* WUP = (bf16_t*)(ws + WS_WUP); bf16_t* WDN = (bf16_t*)(ws + WS_WDN);
            const float* wu = PP->w_up + (size_t)layer * DM * DFF; const float* wd = PP->w_down + (size_t)layer * DFF * DM; const float* mg = PP->mlp_g + (size_t)layer * DM;
            constexpr int I_U = (DM / 64) * (DFF / 32), I_D = (DFF / 64) * (DM / 32);
            for (int it = gw; it < I_U + I_D; it += NGW) {
                if (it < I_U) transpose_item<0>(wu, DM, DFF, DFF, mg, WUP, scr, it, lane);
                else transpose_item<0>(wd, DFF, DM, DM, nullptr, WDN, scr, it - I_U, lane);
            }
            __syncthreads();
        }
        {
            PHASE_VARS();
            pg8::Gemm g{(const bf16_t*)(ws + WS_MERGED), (const bf16_t*)(ws + WS_WOUT), DM, DM, DM, 0, 0};
            pg8::StaticOrder S; S.init(TOK, DM, G, bx);
            pg8::EpiResid E{PP->out, (bf16_t*)(ws + WS_XB), (float*)(ws + WS_SSQ)};
            pg8::gemm_phase<pg8::EpiResid, pg8::StaticOrder, false>(lds, g, S, E);
        }
#endif
        GSYNC();
#ifndef NO_P5
        for (int rep = 0; rep < REP_P5; ++rep) {
            PHASE_VARS();
            pg8::Gemm g{(const bf16_t*)(ws + WS_XB), (const bf16_t*)(ws + WS_WUP), DM, DM, DM, 0, 0};
            pg8::StaticOrder S; S.init(TOK, DFF, G, bx);
            pg8::EpiUp E{(const float*)(ws + WS_SSQ), (bf16_t*)(ws + WS_HMLP)};
            pg8::gemm_phase<pg8::EpiUp, pg8::StaticOrder, true>(lds, g, S, E);
        }
#endif
        GSYNC();
#ifndef NO_P6
        {
            PHASE_VARS();
            pg8::Gemm g{(const bf16_t*)(ws + WS_HMLP), (const bf16_t*)(ws + WS_WDN), DFF, DFF, DFF, 0, 0};
            pg8::StaticOrder S; S.init(TOK, DM, G, bx);
            pg8::EpiResid E{PP->out, (bf16_t*)(ws + WS_XB), (float*)(ws + WS_SSQ)};
            pg8::gemm_phase<pg8::EpiResid, pg8::StaticOrder, false>(lds, g, S, E);
        }
#endif
        GSYNC();
    }
    {
        PHASE_VARS();
        float* X = PP->out;
        for (int row = gw; row < TOK; row += NGW) {
            f32x4* xo = (f32x4*)(X + (size_t)row * DM) + lane; const f32x4* gp = (const f32x4*)PP->final_g + lane;
            f32x4 v[4]; float s = 0.f;
#pragma unroll
            for (int j = 0; j < 4; ++j) { v[j] = xo[64 * j]; s += (v[j][0] * v[j][0] + v[j][1] * v[j][1]) + (v[j][2] * v[j][2] + v[j][3] * v[j][3]); }
            const float rstd = __builtin_amdgcn_rsqf(wave_sum(s) * (1.0f / DM) + RMS_EPS);
#pragma unroll
            for (int j = 0; j < 4; ++j) xo[64 * j] = v[j] * rstd * gp[64 * j];
        }
    }
}

extern "C" void kernel_launch(void* const* d_in, const int* in_sizes, int n_in, void* d_out, int out_size, void* d_ws, size_t ws_size, hipStream_t stream) {
    static int grid = 0;
    if (grid == 0) {
        if (n_in != 15 || in_sizes[0] != TOK * DM || out_size != TOK * DM || ws_size < WS_END) { fprintf(stderr, "kernel_launch: unexpected shapes / workspace (n_in %d, ws %zu)\n", n_in, ws_size); grid = -1; return; }
        int dev = 0, cus = 0, per_cu = 0;
        hipGetDevice(&dev); hipDeviceGetAttribute(&cus, hipDeviceAttributeMultiprocessorCount, dev);
        hipFuncSetAttribute((const void*)fwd_mega, hipFuncAttributeMaxDynamicSharedMemorySize, LDS_BYTES);
        hipOccupancyMaxActiveBlocksPerMultiprocessor(&per_cu, (const void*)fwd_mega, NWAVES * 64, LDS_BYTES);
        (void)hipGetLastError();
        if (per_cu < 1) per_cu = 1;
        grid = cus;
        if (grid > 256) grid = 256;
        if (grid % 8 != 0) { fprintf(stderr, "kernel_launch: the per-XCD work queues need a grid that is a multiple of 8 (got %d)\n", grid); grid = -1; return; }
    }
    if (grid < 0) return;
    hipMemsetAsync((char*)d_ws + WS_CTL, 0, CTL_BYTES, stream);
    Params p{};
    p.x = (const float*)d_in[0]; p.mix_g = (const float*)d_in[1]; p.w_in = (const float*)d_in[2]; p.b_forget = (const float*)d_in[3];
    p.lq1 = (const float*)d_in[4]; p.lk1 = (const float*)d_in[5]; p.lq2 = (const float*)d_in[6]; p.lk2 = (const float*)d_in[7];
    p.diff_g = (const float*)d_in[8]; p.w_branch = (const float*)d_in[9]; p.w_out = (const float*)d_in[10]; p.mlp_g = (const float*)d_in[11];
    p.w_up = (const float*)d_in[12]; p.w_down = (const float*)d_in[13]; p.final_g = (const float*)d_in[14];
    p.out = (float*)d_out; p.ws = (unsigned char*)d_ws;
    void* args[] = {&p};
    hipError_t e = hipLaunchCooperativeKernel((const void*)fwd_mega, dim3(grid), dim3(NWAVES * 64), args, LDS_BYTES, stream);
    if (e != hipSuccess) fprintf(stderr, "cooperative launch failed: %s (grid %d)\n", hipGetErrorString(e), grid);
}
```

```cpp
#include <hip/hip_runtime.h>
#include <hip/hip_cooperative_groups.h>
#include <cstdio>
#include <cstdint>
namespace cg = cooperative_groups;

#define LAS __attribute__((address_space(3)))
typedef unsigned short bf16_t;
typedef short bf16x8 __attribute__((ext_vector_type(8)));
typedef float f32x4 __attribute__((ext_vector_type(4)));
typedef float f32x16 __attribute__((ext_vector_type(16)));
typedef unsigned u32x4 __attribute__((ext_vector_type(4)));
typedef unsigned u32x2 __attribute__((ext_vector_type(2)));
typedef float f32x2_t __attribute__((ext_vector_type(2)));
typedef __bf16 bf16x2_t __attribute__((ext_vector_type(2)));

constexpr int DM = 1024, BATCH = 8, SEQ = 2048, DEPTH = 2, TOK = BATCH * SEQ, DFF = 4096, DIN = 8708;
constexpr int HT = TOK / 2;
constexpr int NPROJ = 35 * 256;
constexpr int LDQK = 6 * 256;
constexpr int HSEQ = SEQ * 64;
constexpr float LOG2E = 1.4426950408889634f, LN2 = 0.6931471805599453f;
constexpr float RMS_EPS = 1e-6f;

constexpr size_t MiB = 1u << 20;
constexpr size_t WS_CTL = 0, CTL_BYTES = 65536;
constexpr int CW_BAR = 4096;
constexpr size_t WS_SSQ = 1 * MiB;
constexpr size_t WS_WIN = 2 * MiB;
constexpr size_t WS_WUP = WS_WIN, WS_WDN = WS_WIN + 8 * MiB;
constexpr size_t WS_WB = 20 * MiB;
constexpr size_t WS_WOUT = 24 * MiB;
constexpr size_t WS_XB = 26 * MiB;
constexpr size_t WS_MERGED = 58 * MiB;
constexpr size_t WS_YS = 90 * MiB;
constexpr size_t WS_DILO = 106 * MiB;
constexpr size_t WS_LSE = 118 * MiB;
constexpr size_t WS_LSE2 = 118 * MiB + 512 * 1024;
constexpr size_t WS_FL = 119 * MiB + 512 * 1024;
constexpr size_t WS_QK = 120 * MiB;
constexpr size_t WS_KF = 144 * MiB;
constexpr size_t WS_VT = 168 * MiB;
constexpr size_t WS_GATE = 192 * MiB;
constexpr size_t WS_HMLP = 120 * MiB;
constexpr size_t WS_END = 256 * MiB;

constexpr int LDS_BYTES = 147456;
constexpr int NWAVES = 8;

__device__ __forceinline__ unsigned cvtpk(float lo, float hi) { f32x2_t v = {lo, hi}; bf16x2_t b = __builtin_convertvector(v, bf16x2_t); return __builtin_bit_cast(unsigned, b); }
__device__ __forceinline__ float bflo(unsigned w) { return __uint_as_float(w << 16); }
__device__ __forceinline__ float bfhi(unsigned w) { return __uint_as_float(w & 0xffff0000u); }
__device__ __forceinline__ float ex2(float x) { return __builtin_amdgcn_exp2f(x); }
__device__ __forceinline__ float lg2(float x) { return __builtin_amdgcn_logf(x); }
__device__ __forceinline__ float x32_sum(float v) { auto r = __builtin_amdgcn_permlane32_swap(__float_as_uint(v), __float_as_uint(v), false, false); return __uint_as_float(r[0]) + __uint_as_float(r[1]); }
__device__ __forceinline__ float x32_max(float v) { auto r = __builtin_amdgcn_permlane32_swap(__float_as_uint(v), __float_as_uint(v), false, false); return fmaxf(__uint_as_float(r[0]), __uint_as_float(r[1])); }
__device__ __forceinline__ float x32_partner(float v, int hi) { auto r = __builtin_amdgcn_permlane32_swap(__float_as_uint(v), __float_as_uint(v), false, false); return hi ? __uint_as_float(r[0]) : __uint_as_float(r[1]); }
template <int X> __device__ __forceinline__ float swz_xor(float v) { return __uint_as_float((unsigned)__builtin_amdgcn_ds_swizzle((int)__float_as_uint(v), (X << 10) | 0x1f)); }
__device__ __forceinline__ float x16_sum(float v) { return v + swz_xor<16>(v); }
__device__ __forceinline__ float wave_sum(float v) { v += swz_xor<1>(v); v += swz_xor<2>(v); v += swz_xor<4>(v); v += swz_xor<8>(v); v += swz_xor<16>(v); return x32_sum(v); }

namespace pg8 {
constexpr int BM = 256, BK = 64, HALF = 128, HTB = HALF * BK * 2, STAGE_BYTES = 8 * HTB, NXCD = 8, WGM = 8;
__host__ __device__ __forceinline__ int lds_byte(int r, int c) { const int st = (r >> 4) * 2 + (c >> 5), rr = r & 15, cc = c & 31, ob = rr * 64 + cc * 2; return st * 1024 + (ob ^ (((ob >> 9) & 1) << 5)); }
__host__ __device__ __forceinline__ void stage_rc(int b, int& R, int& C) { const int st = b / 1024, sb = b % 1024, swz = sb ^ (((sb >> 9) & 1) << 5); R = (st >> 1) * 16 + swz / 64; C = (st & 1) * 32 + (swz % 64) / 2; }
__host__ __device__ __forceinline__ int perm32(int rho) { const int n = rho >> 4, i = rho & 15; return 8 * (i >> 2) + 4 * n + (i & 3); }

struct Unit { int pm, pn, aux; };
struct Gemm { const bf16_t* A; const bf16_t* Bt; int lda, ldb, K; long a_aux, b_aux; };

struct StaticOrder {
    int nM, nN, nwg, G, c;
    __device__ void init(int M, int N, int G_, int c_) { nM = M / BM; nN = N / BM; nwg = nM * nN; G = G_; c = c_; }
    __device__ bool next(int i, Unit& u) const {
        const long L = (long)i * G + c; if (L >= nwg) return false;
        int wgid = (int)L; { const int q = nwg / NXCD, r = nwg % NXCD, xcd = wgid % NXCD, off = wgid / NXCD; wgid = (xcd < r ? xcd * (q + 1) : r * (q + 1) + (xcd - r) * q) + off; }
        const int nig = WGM * nN, gid = wgid / nig, fm = gid * WGM, gsz = (nM - fm) < WGM ? (nM - fm) : WGM;
        u.pm = fm + ((wgid % nig) % gsz); u.pn = (wgid % nig) / gsz; u.aux = 0; return true;
    }
};
struct BranchOrder {
    int c, G;
    __device__ bool next(int i, Unit& u) const { const int t = c + (i >> 1) * G; if (t >= 256) return false; u.pm = t >> 3; u.pn = t & 7; u.aux = i & 1; return true; }
};

template <class Epi, class Sched, bool ALIGN_EPI>
__device__ __forceinline__ void gemm_phase(LAS unsigned char* lds, const Gemm g, const Sched& S, const Epi& E) {
    int tid_ = threadIdx.x; asm volatile("" : "+v"(tid_));
    const int tid = tid_, wid = __builtin_amdgcn_readfirstlane(tid >> 6), lane = tid & 63, wr = wid >> 2, wc = wid & 3, fr = lane & 15, fq = lane >> 4;
    int nt_ = g.K / BK; asm volatile("" : "+s"(nt_)); const int nt = nt_;
    unsigned voffA[2], voffB[2];
#pragma unroll
    for (int i = 0; i < 2; ++i) { int R, C; stage_rc(tid * 16 + i * 8192, R, C); const int Rb = Epi::PERM ? ((R & ~31) + perm32(R & 31)) : R;
        voffA[i] = (unsigned)(R * g.lda + C) * 2u; voffB[i] = (unsigned)(Rb * g.ldb + C) * 2u; }
    const size_t kstep = (size_t)(BK * 2);
    const size_t hstepA = (size_t)HALF * g.lda * 2, hstepB = (size_t)HALF * g.ldb * 2;
    const size_t tstepA = 2 * hstepA, tstepB = 2 * hstepB;
    const unsigned ldsw = (unsigned)wid * 1024u;
    const int aoff = lds_byte(wr * 64 + fr, fq * 8), boff = lds_byte(wc * 32 + fr, fq * 8);
#define PG8_SA(b, h) (((b) * 2 + (h)) * HTB)
#define PG8_SB(b, h) ((4 + (b) * 2 + (h)) * HTB)
#define PG8_STAGE(bufoff, gbase, voff) do { _Pragma("unroll") for (int _i = 0; _i < 2; ++_i) \
        __builtin_amdgcn_global_load_lds((const unsigned*)((const char*)(gbase) + (voff)[_i]), (LAS unsigned*)(lds + (bufoff) + ldsw + _i * 8192), 16, 0, 0); } while (0)
#define PG8_LDA(dst, b, h) do { _Pragma("unroll") for (int m = 0; m < 4; ++m) _Pragma("unroll") for (int k = 0; k < 2; ++k) dst[m][k] = *(const LAS bf16x8*)(lds + PG8_SA(b, h) + aoff + m * 2048 + k * 1024); } while (0)
#define PG8_LDB(dst, b, h) do { _Pragma("unroll") for (int n = 0; n < 2; ++n) _Pragma("unroll") for (int k = 0; k < 2; ++k) dst[n][k] = *(const LAS bf16x8*)(lds + PG8_SB(b, h) + boff + n * 2048 + k * 1024); } while (0)
#define PG8_MMA(ai, bj, At, Bt) do { __builtin_amdgcn_s_setprio(1); _Pragma("unroll") for (int m = 0; m < 4; ++m) _Pragma("unroll") for (int n = 0; n < 2; ++n) _Pragma("unroll") for (int k = 0; k < 2; ++k) \
        acc[ai][bj][m][n] = __builtin_amdgcn_mfma_f32_16x16x32_bf16(Bt[n][k], At[m][k], acc[ai][bj][m][n], 0, 0, 0); __builtin_amdgcn_s_setprio(0); } while (0)
#define PG8_WAIT_V(n) asm volatile("s_waitcnt vmcnt(" #n ")" ::: "memory")
#define PG8_WAIT_L(n) asm volatile("s_waitcnt lgkmcnt(" #n ")" ::: "memory")
#define PG8_BAR __builtin_amdgcn_s_barrier()
#define PG8_SCHED __builtin_amdgcn_sched_barrier(0)
#define PG8_UA(u) ((const char*)g.A + (size_t)(u).pm * tstepA + (size_t)(u).aux * (size_t)g.a_aux)
#define PG8_UB(u) ((const char*)g.Bt + (size_t)(u).pn * tstepB + (size_t)(u).aux * (size_t)g.b_aux)
    Unit cur, nxt; int ui = 0;
    if (!S.next(0, cur)) return;
    f32x4 acc[2][2][4][2];
#pragma unroll
    for (int a = 0; a < 2; ++a)
#pragma unroll
        for (int b = 0; b < 2; ++b)
#pragma unroll
            for (int m = 0; m < 4; ++m)
#pragma unroll
                for (int n = 0; n < 2; ++n) acc[a][b][m][n] = (f32x4){0.f, 0.f, 0.f, 0.f};
    bf16x8 At[4][2], B0[2][2], B1[2][2];
    const char* cA = PG8_UA(cur); const char* cB = PG8_UB(cur);
    PG8_STAGE(PG8_SB(0, 0), cB, voffB); PG8_STAGE(PG8_SB(0, 1), cB + hstepB, voffB); PG8_STAGE(PG8_SA(0, 0), cA, voffA); PG8_STAGE(PG8_SA(0, 1), cA + hstepA, voffA);
    if (wr == 1) PG8_BAR;
    PG8_WAIT_V(2); PG8_BAR;
    PG8_STAGE(PG8_SB(1, 0), cB + kstep, voffB); PG8_STAGE(PG8_SA(1, 0), cA + kstep, voffA); PG8_STAGE(PG8_SB(1, 1), cB + hstepB + kstep, voffB);
    PG8_WAIT_V(6); PG8_BAR;
    for (;;) {
        const bool has_next = S.next(ui + 1, nxt);
        const char* nA = has_next ? PG8_UA(nxt) : cA; const char* nB = has_next ? PG8_UB(nxt) : cB;
        for (int t = 0; t < nt; t += 2) {
            const bool last = (t == nt - 2);
            const char* a1 = cA + (size_t)(t + 1) * kstep;
            const char* a2 = last ? nA : cA + (size_t)(t + 2) * kstep; const char* b2 = last ? nB : cB + (size_t)(t + 2) * kstep;
            const char* a3 = a2 + kstep; const char* b3 = b2 + kstep;
            PG8_LDB(B0, 0, 0); PG8_LDB(B1, 0, 1); PG8_SCHED; PG8_LDA(At, 0, 0); PG8_STAGE(PG8_SA(1, 1), a1 + hstepA, voffA);
            PG8_WAIT_V(8); PG8_WAIT_L(0); PG8_BAR; PG8_MMA(0, 0, At, B0); PG8_MMA(0, 1, At, B1); PG8_BAR; PG8_SCHED;
            PG8_LDA(At, 0, 1); PG8_STAGE(PG8_SB(0, 0), b2, voffB); PG8_STAGE(PG8_SB(0, 1), b2 + hstepB, voffB); PG8_STAGE(PG8_SA(0, 0), a2, voffA);
            PG8_WAIT_V(8); PG8_WAIT_L(0); PG8_BAR; PG8_MMA(1, 0, At, B0); PG8_MMA(1, 1, At, B1); PG8_BAR; PG8_SCHED;
            PG8_LDB(B0, 1, 0); PG8_LDB(B1, 1, 1); PG8_SCHED; PG8_LDA(At, 1, 0); PG8_STAGE(PG8_SA(0, 1), a2 + hstepA, voffA);
            PG8_WAIT_V(8); PG8_WAIT_L(0); PG8_BAR; PG8_MMA(0, 0, At, B0); PG8_MMA(0, 1, At, B1); PG8_BAR; PG8_SCHED;
            PG8_LDA(At, 1, 1); PG8_STAGE(PG8_SB(1, 0), b3, voffB); PG8_STAGE(PG8_SB(1, 1), b3 + hstepB, voffB); PG8_STAGE(PG8_SA(1, 0), a3, voffA);
            PG8_WAIT_V(8); PG8_WAIT_L(0); PG8_BAR; PG8_MMA(1, 0, At, B0); PG8_MMA(1, 1, At, B1); PG8_BAR; PG8_SCHED;
        }
        if constexpr (ALIGN_EPI) { if (wr == 0) PG8_BAR; }
        { Unit eu = cur; asm volatile("" : "+s"(eu.pm), "+s"(eu.pn), "+s"(eu.aux)); E(acc, eu, wr, wc, fr, fq); }
        if (!has_next) break;
#pragma unroll
        for (int a = 0; a < 2; ++a)
#pragma unroll
            for (int b = 0; b < 2; ++b)
#pragma unroll
                for (int m = 0; m < 4; ++m)
#pragma unroll
                    for (int n = 0; n < 2; ++n) acc[a][b][m][n] = (f32x4){0.f, 0.f, 0.f, 0.f};
        cur = nxt; cA = nA; cB = nB; ++ui;
        if constexpr (ALIGN_EPI) { if (wr == 1) PG8_BAR; }
    }
    PG8_WAIT_V(0);
    if constexpr (!ALIGN_EPI) { if (wr == 0) PG8_BAR; }
    PG8_BAR;
#undef PG8_SA
#undef PG8_SB
#undef PG8_STAGE
#undef PG8_LDA
#undef PG8_LDB
#undef PG8_MMA
#undef PG8_WAIT_V
#undef PG8_WAIT_L
#undef PG8_BAR
#undef PG8_SCHED
#undef PG8_UA
#undef PG8_UB
}

__device__ __forceinline__ float row_rstd(const float* ssq, int row, int fq) {
    const f32x4 a = *(const f32x4*)(ssq + (size_t)row * 16 + 4 * fq);
    float s = (a[0] + a[1]) + (a[2] + a[3]);
    s = x16_sum(s); s = x32_sum(s);
    return __builtin_amdgcn_rsqf(s * (1.0f / DM) + RMS_EPS);
}
__device__ __forceinline__ int pos16(int o) { return 8 * ((o >> 2) & 1) + 4 * (o >> 3) + (o & 3); }

struct EpiProj {
    static constexpr bool PERM = true;
    const float* ssq; int row_base; bf16_t* QK; bf16_t* KF; bf16_t* VT; float* FL; bf16_t* GATE;
    __device__ __forceinline__ void operator()(const f32x4 (&acc)[2][2][4][2], const Unit& u, int wr, int wc, int fr, int fq) const {
        const int pn = u.pn;
        const int lrow0 = u.pm * BM + wr * 64 + fr;
        float rs[2][4];
#pragma unroll
        for (int ai = 0; ai < 2; ++ai)
#pragma unroll
            for (int m = 0; m < 4; ++m) rs[ai][m] = row_rstd(ssq, row_base + lrow0 + ai * HALF + m * 16, fq);
        const int cin = wc * 32 + 8 * fq;
        if (pn >= 19) {
#pragma unroll
            for (int ai = 0; ai < 2; ++ai)
#pragma unroll
                for (int m = 0; m < 4; ++m) { const int lrow = lrow0 + ai * HALF + m * 16; const float s = rs[ai][m];
#pragma unroll
                    for (int bj = 0; bj < 2; ++bj) { const f32x4 v0 = acc[ai][bj][m][0] * s, v1 = acc[ai][bj][m][1] * s;
                        u32x4 w; w.x = cvtpk(v0[0], v0[1]); w.y = cvtpk(v0[2], v0[3]); w.z = cvtpk(v1[0], v1[1]); w.w = cvtpk(v1[2], v1[3]);
                        *(u32x4*)(GATE + (size_t)lrow * 4096 + (pn - 19) * 256 + bj * HALF + cin) = w; } }
        } else if (pn == 18) {
            if (wc == 0 && fq == 0) {
#pragma unroll
                for (int ai = 0; ai < 2; ++ai)
#pragma unroll
                    for (int m = 0; m < 4; ++m) { const int lrow = lrow0 + ai * HALF + m * 16; *(f32x4*)(FL + (size_t)lrow * 4) = acc[ai][0][m][0] * rs[ai][m]; }
            }
        } else if (pn == 2 || (pn >= 9 && pn <= 11) || pn == 14 || pn == 17) {
            int vhb, rsh;
            if (pn == 2) { vhb = 0; rsh = 0; } else if (pn == 14) { vhb = 16; rsh = 0; } else if (pn == 17) { vhb = 20; rsh = 0; } else { const int gI = pn - 9; vhb = 4 + 4 * gI; rsh = 2 * gI; }
            const int slsh = 11 - rsh, rmask = (1 << rsh) - 1;
#pragma unroll
            for (int ai = 0; ai < 2; ++ai)
#pragma unroll
                for (int m = 0; m < 4; ++m) { const int lrow = lrow0 + ai * HALF + m * 16; const float s = rs[ai][m];
                    const int bl = lrow >> 11, t = lrow & (SEQ - 1); int p = ((t & rmask) << slsh) + (t >> rsh); p = (p & ~15) | pos16(p & 15);
                    const int kb = p >> 5, q = p & 31;
                    bf16_t* base = VT + (size_t)(bl * 24 + vhb) * HSEQ + (size_t)kb * 2048 + (q >> 4) * 512 + ((q >> 3) & 1) * 256 + (q & 7);
#pragma unroll
                    for (int bj = 0; bj < 2; ++bj) { const int c0 = bj * HALF + cin;
                        bf16_t* bp = base + (size_t)(c0 >> 6) * HSEQ + ((c0 >> 5) & 1) * 1024 + (c0 & 31) * 8;
                        const f32x4 v0 = acc[ai][bj][m][0] * s, v1 = acc[ai][bj][m][1] * s;
                        const unsigned w0 = cvtpk(v0[0], v0[1]), w1 = cvtpk(v0[2], v0[3]), w2 = cvtpk(v1[0], v1[1]), w3 = cvtpk(v1[2], v1[3]);
                        bp[0 * 8] = (bf16_t)(w0 & 0xffff); bp[1 * 8] = (bf16_t)(w0 >> 16); bp[2 * 8] = (bf16_t)(w1 & 0xffff); bp[3 * 8] = (bf16_t)(w1 >> 16);
                        bp[4 * 8] = (bf16_t)(w2 & 0xffff); bp[5 * 8] = (bf16_t)(w2 >> 16); bp[6 * 8] = (bf16_t)(w3 & 0xffff); bp[7 * 8] = (bf16_t)(w3 >> 16); } }
        } else {
            const bool isK = (pn == 1) || (pn >= 6 && pn <= 8) || pn == 13 || pn == 16;
            int slot = 0, khb = 0, rsh = 0;
            if (pn <= 1) { slot = 0; khb = 0; } else if (pn <= 8) { const int gI = (pn - 3) % 3; rsh = 2 * gI; slot = 1 + gI; khb = 4 + 4 * gI; } else if (pn <= 13) { slot = 4; khb = 16; } else { slot = 5; khb = 20; }
            const int slsh = 11 - rsh, rmask = (1 << rsh) - 1;
#pragma unroll
            for (int ai = 0; ai < 2; ++ai)
#pragma unroll
                for (int m = 0; m < 4; ++m) { const int lrow = lrow0 + ai * HALF + m * 16; const float s = rs[ai][m];
                    const int bl = lrow >> 11, t = lrow & (SEQ - 1); const int p = ((t & rmask) << slsh) + (t >> rsh);
#pragma unroll
                    for (int bj = 0; bj < 2; ++bj) { const f32x4 v0 = acc[ai][bj][m][0] * s, v1 = acc[ai][bj][m][1] * s;
                        u32x4 w; w.x = cvtpk(v0[0], v0[1]); w.y = cvtpk(v0[2], v0[3]); w.z = cvtpk(v1[0], v1[1]); w.w = cvtpk(v1[2], v1[3]);
                        const int c0 = bj * HALF + cin;
                        if (isK) { const int dcol = c0 & 63;
                            *(u32x4*)(KF + (size_t)(bl * 24 + khb + (c0 >> 6)) * HSEQ + (size_t)(p >> 5) * 2048 + (dcol >> 4) * 512 + (((dcol >> 3) & 1) * 32 + (p & 31)) * 8) = w; }
                        else *(u32x4*)(QK + (size_t)(bl * SEQ + p) * LDQK + slot * 256 + c0) = w; } }
        }
    }
};

struct EpiBranch {
    static constexpr bool PERM = true;
    const bf16_t* GATE; bf16_t* MERGED; int row_base;
    __device__ __forceinline__ static float sg(float g) { return __builtin_amdgcn_rcpf(1.0f + ex2(-g * LOG2E)); }
    __device__ __forceinline__ static u32x4 mix(const u32x4 ga, const u32x4 gb, const u32x4 ow, const f32x4 a0, const f32x4 a1, const f32x4 b0, const f32x4 b1) {
        const float o0 = sg(bflo(ga.x)) * a0[0] + sg(bflo(gb.x)) * b0[0] + bflo(ow.x), o1 = sg(bfhi(ga.x)) * a0[1] + sg(bfhi(gb.x)) * b0[1] + bfhi(ow.x);
        const float o2 = sg(bflo(ga.y)) * a0[2] + sg(bflo(gb.y)) * b0[2] + bflo(ow.y), o3 = sg(bfhi(ga.y)) * a0[3] + sg(bfhi(gb.y)) * b0[3] + bfhi(ow.y);
        const float o4 = sg(bflo(ga.z)) * a1[0] + sg(bflo(gb.z)) * b1[0] + bflo(ow.z), o5 = sg(bfhi(ga.z)) * a1[1] + sg(bfhi(gb.z)) * b1[1] + bfhi(ow.z);
        const float o6 = sg(bflo(ga.w)) * a1[2] + sg(bflo(gb.w)) * b1[2] + bflo(ow.w), o7 = sg(bfhi(ga.w)) * a1[3] + sg(bfhi(gb.w)) * b1[3] + bfhi(ow.w);
        u32x4 w; w.x = cvtpk(o0, o1); w.y = cvtpk(o2, o3); w.z = cvtpk(o4, o5); w.w = cvtpk(o6, o7); return w;
    }
    __device__ __forceinline__ void operator()(const f32x4 (&acc)[2][2][4][2], const Unit& u, int wr, int wc, int fr, int fq) const {
        const int p = u.aux; const int lrow0 = u.pm * BM + wr * 64 + fr; const int d0 = u.pn * 128 + wc * 32 + 8 * fq;
        const bf16_t* gbase = GATE + (size_t)lrow0 * 4096 + (2 * p) * 1024 + d0; bf16_t* mbase = MERGED + (size_t)(row_base + lrow0) * DM + d0;
        const u32x4 zero = {0u, 0u, 0u, 0u};
#pragma unroll
        for (int ai = 0; ai < 2; ++ai)
#pragma unroll
            for (int mp = 0; mp < 2; ++mp) {
                u32x4 ga[2], gb[2], ow[2];
#pragma unroll
                for (int mm = 0; mm < 2; ++mm) { const size_t ro = (size_t)(ai * HALF + (2 * mp + mm) * 16);
                    ga[mm] = *(const u32x4*)(gbase + ro * 4096); gb[mm] = *(const u32x4*)(gbase + ro * 4096 + 1024);
                    ow[mm] = zero; if (p > 0) ow[mm] = *(const u32x4*)(mbase + ro * DM); }
#pragma unroll
                for (int mm = 0; mm < 2; ++mm) { const int m = 2 * mp + mm; const size_t ro = (size_t)(ai * HALF + m * 16);
                    *(u32x4*)(mbase + ro * DM) = mix(ga[mm], gb[mm], ow[mm], acc[ai][0][m][0], acc[ai][0][m][1], acc[ai][1][m][0], acc[ai][1][m][1]); }
                asm volatile("" ::: "memory");
            }
    }
};

struct EpiResid {
    static constexpr bool PERM = true;
    const float* Xin; float* X; bf16_t* XB; float* ssq;
    __device__ __forceinline__ void operator()(const f32x4 (&acc)[2][2][4][2], const Unit& u, int wr, int wc, int fr, int fq) const {
        const int row0 = u.pm * BM + wr * 64 + fr; const int col0 = u.pn * BM + wc * 32 + 8 * fq;
#pragma unroll
        for (int ai = 0; ai < 2; ++ai)
#pragma unroll
            for (int m = 0; m < 4; ++m) { const int row = row0 + ai * HALF + m * 16; float sq = 0.f;
#pragma unroll
                for (int bj = 0; bj < 2; ++bj) { const int col = col0 + bj * HALF; f32x4* xp = (f32x4*)(X + (size_t)row * DM + col); const f32x4* xi = (const f32x4*)(Xin + (size_t)row * DM + col);
                    const f32x4 x0 = xi[0] + acc[ai][bj][m][0], x1 = xi[1] + acc[ai][bj][m][1];
                    xp[0] = x0; xp[1] = x1;
                    u32x4 w; w.x = cvtpk(x0[0], x0[1]); w.y = cvtpk(x0[2], x0[3]); w.z = cvtpk(x1[0], x1[1]); w.w = cvtpk(x1[2], x1[3]);
                    *(u32x4*)(XB + (size_t)row * DM + col) = w;
                    sq += (x0[0] * x0[0] + x0[1] * x0[1]) + (x0[2] * x0[2] + x0[3] * x0[3]) + (x1[0] * x1[0] + x1[1] * x1[1]) + (x1[2] * x1[2] + x1[3] * x1[3]); }
                sq = x16_sum(sq); sq = x32_sum(sq);
                if (fq == 0) ssq[(size_t)row * 16 + u.pn * 4 + wc] = sq; if (m & 1) asm volatile("" ::: "memory"); }
    }
};

struct EpiUp {
    static constexpr bool PERM = true;
    const float* ssq; bf16_t* H;
    __device__ __forceinline__ void operator()(const f32x4 (&acc)[2][2][4][2], const Unit& u, int wr, int wc, int fr, int fq) const {
        const int row0 = u.pm * BM + wr * 64 + fr; const int col0 = u.pn * BM + wc * 32 + 8 * fq;
        float rs[2][4];
#pragma unroll
        for (int ai = 0; ai < 2; ++ai)
#pragma unroll
            for (int m = 0; m < 4; ++m) rs[ai][m] = row_rstd(ssq, row0 + ai * HALF + m * 16, fq);
#pragma unroll
        for (int ai = 0; ai < 2; ++ai)
#pragma unroll
            for (int m = 0; m < 4; ++m) { const int row = row0 + ai * HALF + m * 16; const float s = rs[ai][m];
#pragma unroll
                for (int bj = 0; bj < 2; ++bj) { f32x4 v0 = acc[ai][bj][m][0] * s, v1 = acc[ai][bj][m][1] * s;
#pragma unroll
                    for (int i = 0; i < 4; ++i) { const float a = fmaxf(v0[i], 0.f), b = fmaxf(v1[i], 0.f); v0[i] = a * a; v1[i] = b * b; }
                    u32x4 w; w.x = cvtpk(v0[0], v0[1]); w.y = cvtpk(v0[2], v0[3]); w.z = cvtpk(v1[0], v1[1]); w.w = cvtpk(v1[2], v1[3]);
                    *(u32x4*)(H + (size_t)row * DFF + col0 + bj * HALF) = w; } }
    }
};
}

__device__ __forceinline__ int win_src(int n) {
    if (n < 3840) return n;
    if (n < 4608) return n + 4;
    if (n < 4864) return (n - 4608 < 4) ? 3840 + (n - 4608) : -1;
    return n - 4864 + 4612;
}
template <int CMAP>
__device__ __forceinline__ void transpose_item(const float* W, int K, int N, int Nsrc, const float* gain, bf16_t* WT, LAS float* scr, int item, int lane) {
    const int nblk = N / 32, kb = item / nblk, nb = item % nblk, k0 = 64 * kb, n0 = 32 * nb;
    const int n = n0 + (lane & 31); const int src = CMAP ? win_src(n) : n;
    const bool live = (src >= 0); const float* wp = W + (size_t)(k0 + (lane >> 5)) * Nsrc + (live ? src : 0); const float* gp = gain ? gain + k0 + (lane >> 5) : nullptr;
    float wv[32];
#pragma unroll
    for (int i = 0; i < 32; ++i) wv[i] = wp[(size_t)(2 * i) * Nsrc];
#pragma unroll
    for (int i = 0; i < 32; ++i) { float v = live ? wv[i] : 0.f; if (gp) v *= gp[2 * i]; scr[(2 * i + (lane >> 5)) * 33 + (lane & 31)] = v; }
    asm volatile("s_waitcnt lgkmcnt(0)" ::: "memory");
    const int c = lane & 7;
#pragma unroll
    for (int j = 0; j < 4; ++j) { const int nn = (lane >> 3) + 8 * j; const LAS float* s = scr + (8 * c) * 33 + nn;
        u32x4 o; o.x = cvtpk(s[0 * 33], s[1 * 33]); o.y = cvtpk(s[2 * 33], s[3 * 33]); o.z = cvtpk(s[4 * 33], s[5 * 33]); o.w = cvtpk(s[6 * 33], s[7 * 33]);
        *(u32x4*)(WT + (size_t)(n0 + nn) * K + k0 + 8 * c) = o; }
    asm volatile("s_waitcnt lgkmcnt(0)" ::: "memory");
}

__device__ __forceinline__ void branch_item(const float* Wn, int n, bf16_t* WBP, LAS float* scr, int item, int lane) {
    const int kb = item >> 5, nb = item & 31, k0 = 64 * kb, n0 = 32 * nb;
    const float* wp = Wn + (size_t)(k0 + (lane >> 5)) * DM + n0 + (lane & 31);
    float wv[32];
#pragma unroll
    for (int i = 0; i < 32; ++i) wv[i] = wp[(size_t)(2 * i) * DM];
#pragma unroll
    for (int i = 0; i < 32; ++i) scr[(2 * i + (lane >> 5)) * 33 + (lane & 31)] = wv[i];
    asm volatile("s_waitcnt lgkmcnt(0)" ::: "memory");
    const int c = lane & 7, bj = n & 1, pair = n >> 1;
    const u32x4 zero = {0u, 0u, 0u, 0u};
#pragma unroll
    for (int j = 0; j < 4; ++j) { const int nn = (lane >> 3) + 8 * j; const LAS float* sp = scr + (8 * c) * 33 + nn; const int d = n0 + nn;
        u32x4 o; o.x = cvtpk(sp[0 * 33], sp[1 * 33]); o.y = cvtpk(sp[2 * 33], sp[3 * 33]); o.z = cvtpk(sp[4 * 33], sp[5 * 33]); o.w = cvtpk(sp[6 * 33], sp[7 * 33]);
        bf16_t* row = WBP + ((size_t)((pair * 8 + (d >> 7)) * 256 + bj * 128 + (d & 127))) * 512 + k0 + 8 * c;
        *(u32x4*)(row + 256 * bj) = o; *(u32x4*)(row + 256 * (1 - bj)) = zero; }
    asm volatile("s_waitcnt lgkmcnt(0)" ::: "memory");
}

#define MFMA32(a, b, c) __builtin_amdgcn_mfma_f32_32x32x16_bf16((a), (b), (c), 0, 0, 0)
__device__ __forceinline__ bf16x8 ld16(const bf16_t* p) { return *(const bf16x8*)p; }
__device__ __forceinline__ bf16x8 pack8(const f32x16& s, int b) { u32x4 w; w.x = cvtpk(s[b], s[b + 1]); w.y = cvtpk(s[b + 2], s[b + 3]); w.z = cvtpk(s[b + 4], s[b + 5]); w.w = cvtpk(s[b + 6], s[b + 7]); return __builtin_bit_cast(bf16x8, w); }
__device__ __forceinline__ int crow(int r, int hi) { return (r & 3) + 8 * (r >> 2) + 4 * hi; }
__device__ __forceinline__ void store_o(bf16_t* orow, const f32x16& o0, const f32x16& o1, int hi) {
#pragma unroll
    for (int g = 0; g < 4; ++g) {
        u32x2 a; a.x = cvtpk(o0[4 * g], o0[4 * g + 1]); a.y = cvtpk(o0[4 * g + 2], o0[4 * g + 3]); *(u32x2*)(orow + 8 * g + 4 * hi) = a;
        u32x2 b; b.x = cvtpk(o1[4 * g], o1[4 * g + 1]); b.y = cvtpk(o1[4 * g + 2], o1[4 * g + 3]); *(u32x2*)(orow + 32 + 8 * g + 4 * hi) = b; }
}

struct KFrag { bf16x8 k[4]; };
struct VFrag { bf16x8 v[4]; };
__device__ __forceinline__ void k_load(KFrag& f, const bf16_t* Kh, int kb, int lane) {
    const bf16_t* kp = Kh + (size_t)kb * 2048 + lane * 8;
#pragma unroll
    for (int ds = 0; ds < 4; ++ds) f.k[ds] = ld16(kp + ds * 512);
}
__device__ __forceinline__ void v_load(VFrag& f, const bf16_t* Vh, int kb, int lane) {
    const bf16_t* vp = Vh + (size_t)kb * 2048 + lane * 8;
    f.v[0] = ld16(vp); f.v[1] = ld16(vp + 512); f.v[2] = ld16(vp + 1024); f.v[3] = ld16(vp + 1536);
}
__device__ __forceinline__ void q_load(bf16x8 (&qf)[4], const bf16_t* Qs, int qb, int r32, int hi) {
    const bf16_t* qp = Qs + (size_t)(qb * 32 + r32) * LDQK + hi * 8;
#pragma unroll
    for (int ds = 0; ds < 4; ++ds) qf[ds] = ld16(qp + ds * 16);
}

template <int MODE, bool MASK, int NDS>
__device__ __forceinline__ void sm_step(const bf16x8 (&ck)[NDS], const bf16x8 (&qf)[NDS], const VFrag& cv, float slope2, const LAS float* cl, int kb, int d0,
                                        float& m, float& l, f32x16& o0, f32x16& o1, int hi) {
    constexpr float SC2 = ((MODE == 2) ? 0.17677669529663687f : 0.125f) * LOG2E;
    f32x16 s;
#pragma unroll
    for (int i = 0; i < 16; ++i) s[i] = 0.f;
#pragma unroll
    for (int ds = 0; ds < NDS; ++ds) s = MFMA32(ck[ds], qf[ds], s);
#define KC(r) (((r) & 3) + 8 * ((r) >> 2))
    int dh = d0 - 4 * hi; asm volatile("" : "+v"(dh));
    float sl = slope2; asm volatile("" : "+v"(sl));
    const LAS float* clk = cl + 33 * kb + 4 * hi; if (MODE == 0) asm volatile("" : "+v"(clk));
    const float base = (MODE == 0) ? 0.f : -sl * (float)dh;
#pragma unroll
    for (int r = 0; r < 16; ++r) {
        float v = (MODE == 0) ? fmaf(s[r], SC2, clk[KC(r)]) : fmaf(s[r], SC2, sl * (float)KC(r));
        if (MASK) { const int dist = dh - KC(r); const bool valid = (MODE == 1) ? ((unsigned)dist <= 128u) : (dist >= 0); v = valid ? v : -INFINITY; }
        s[r] = v;
    }
#undef KC
    float mt = fmaxf(fmaxf(s[0], s[1]), fmaxf(s[2], s[3]));
#pragma unroll
    for (int r = 4; r < 16; r += 4) mt = fmaxf(mt, fmaxf(fmaxf(s[r], s[r + 1]), fmaxf(s[r + 2], s[r + 3])));
    mt = x32_max(mt + base);
    const float mn = fmaxf(m, mt), alpha = ex2(m - mn), c = mn - base;
    float ps = 0.f;
#pragma unroll
    for (int r = 0; r < 16; ++r) { const float p = ex2(s[r] - c); s[r] = p; ps += p; }
    l = l * alpha + ps; m = mn;
#pragma unroll
    for (int i = 0; i < 16; ++i) { o0[i] *= alpha; o1[i] *= alpha; }
    const bf16x8 pf0 = pack8(s, 0), pf1 = pack8(s, 8);
    o0 = MFMA32(cv.v[0], pf0, o0); o0 = MFMA32(cv.v[1], pf1, o0); o1 = MFMA32(cv.v[2], pf0, o1); o1 = MFMA32(cv.v[3], pf1, o1);
}
template <int MODE>
__device__ __forceinline__ void sm_unit(const bf16_t* Qs, const bf16_t* Ks, const bf16_t* VTs, int qb, int kb_hi, int kb_lo, float slope2, const LAS float* cl,
                                        f32x16& o0, f32x16& o1, float& m_out, float& l_out, int lane) {
    const int r32 = lane & 31, hi = lane >> 5;
    constexpr int NDS = (MODE == 2) ? 2 : 4;
    bf16x8 qf[NDS];
    { const bf16_t* qp = Qs + (size_t)(qb * 32 + r32) * LDQK + hi * 8;
#pragma unroll
      for (int ds = 0; ds < NDS; ++ds) qf[ds] = ld16(qp + ds * 16); }
    bf16x8 nk[NDS];
    { const bf16_t* kp = Ks + (size_t)kb_hi * 2048 + lane * 8;
#pragma unroll
      for (int ds = 0; ds < NDS; ++ds) nk[ds] = ld16(kp + ds * 512); }
    float m = -INFINITY, l = 0.f;
#pragma unroll
    for (int i = 0; i < 16; ++i) { o0[i] = 0.f; o1[i] = 0.f; }
    for (int kb = kb_hi; kb >= kb_lo; --kb) {
        bf16x8 ck[NDS];
#pragma unroll
        for (int ds = 0; ds < NDS; ++ds) ck[ds] = nk[ds];
        VFrag cv; v_load(cv, VTs, kb, lane);
        if (kb > kb_lo) { const bf16_t* kp = Ks + (size_t)(kb - 1) * 2048 + lane * 8;
#pragma unroll
            for (int ds = 0; ds < NDS; ++ds) nk[ds] = ld16(kp + ds * 512); }
        const int d0 = (qb - kb) * 32 + r32;
        const bool edge = (MODE == 1) ? (kb == qb || kb + 4 <= qb) : (kb == qb);
        if (edge) sm_step<MODE, true, NDS>(ck, qf, cv, slope2, cl, kb, d0, m, l, o0, o1, hi);
        else      sm_step<MODE, false, NDS>(ck, qf, cv, slope2, cl, kb, d0, m, l, o0, o1, hi);
    }
    l = x32_sum(l);
    m_out = m; l_out = l;
}

template <int MODE>
__device__ __forceinline__ void sm_unit64(const bf16_t* Qs, const bf16_t* Ks, const bf16_t* VTs, int Q, int kb_hi, int kb_lo, float slope2, const LAS float* cl,
                                          f32x16 (&o)[2][2], float (&m)[2], float (&l)[2], int lane) {
    const int r32 = lane & 31, hi = lane >> 5;
    constexpr int NDS = (MODE == 2) ? 2 : 4;
    bf16x8 qf[2][NDS];
#pragma unroll
    for (int i = 0; i < 2; ++i) { const bf16_t* qp = Qs + (size_t)((2 * Q + i) * 32 + r32) * LDQK + hi * 8;
#pragma unroll
        for (int ds = 0; ds < NDS; ++ds) qf[i][ds] = ld16(qp + ds * 16); }
    bf16x8 nk[NDS];
    { const bf16_t* kp = Ks + (size_t)kb_hi * 2048 + lane * 8;
#pragma unroll
      for (int ds = 0; ds < NDS; ++ds) nk[ds] = ld16(kp + ds * 512); }
#pragma unroll
    for (int i = 0; i < 2; ++i) { m[i] = -INFINITY; l[i] = 0.f;
#pragma unroll
        for (int k = 0; k < 16; ++k) { o[i][0][k] = 0.f; o[i][1][k] = 0.f; } }
    for (int kb = kb_hi; kb >= kb_lo; --kb) {
        bf16x8 ck[NDS];
#pragma unroll
        for (int ds = 0; ds < NDS; ++ds) ck[ds] = nk[ds];
        VFrag cv; v_load(cv, VTs, kb, lane);
        if (kb > kb_lo) { const bf16_t* kp = Ks + (size_t)(kb - 1) * 2048 + lane * 8;
#pragma unroll
            for (int ds = 0; ds < NDS; ++ds) nk[ds] = ld16(kp + ds * 512); }
        if (kb < 2 * Q) {
            const int d00 = (2 * Q - kb) * 32 + r32;
            sm_step<MODE, false, NDS>(ck, qf[0], cv, slope2, cl, kb, d00, m[0], l[0], o[0][0], o[0][1], hi);
            sm_step<MODE, false, NDS>(ck, qf[1], cv, slope2, cl, kb, d00 + 32, m[1], l[1], o[1][0], o[1][1], hi);
        } else {
#pragma unroll
            for (int i = 0; i < 2; ++i) {
                const int qbi = 2 * Q + i;
                if (kb <= qbi) {
                    const int d0 = (qbi - kb) * 32 + r32;
                    if (kb == qbi) sm_step<MODE, true, NDS>(ck, qf[i], cv, slope2, cl, kb, d0, m[i], l[i], o[i][0], o[i][1], hi);
                    else           sm_step<MODE, false, NDS>(ck, qf[i], cv, slope2, cl, kb, d0, m[i], l[i], o[i][0], o[i][1], hi);
                }
            }
        }
    }
    l[0] = x32_sum(l[0]); l[1] = x32_sum(l[1]);
}

__device__ __forceinline__ void sb_unit(const bf16_t* Qs, const bf16_t* Ks, const bf16_t* VTs, int qb, f32x16& o0, f32x16& o1, int lane) {
    const int r32 = lane & 31, hi = lane >> 5;
    constexpr float SC2 = 0.125f * LOG2E;
    bf16x8 qf[4]; q_load(qf, Qs, qb, r32, hi);
    KFrag nx; k_load(nx, Ks, qb, lane);
    float R = 0.f;
#pragma unroll
    for (int i = 0; i < 16; ++i) { o0[i] = 0.f; o1[i] = 0.f; }
    for (int kb = qb; kb >= 0; --kb) {
        const KFrag cu = nx; VFrag cv; v_load(cv, VTs, kb, lane);
        if (kb > 0) k_load(nx, Ks, kb - 1, lane);
        f32x16 s;
#pragma unroll
        for (int i = 0; i < 16; ++i) s[i] = 0.f;
#pragma unroll
        for (int ds = 0; ds < 4; ++ds) s = MFMA32(cu.k[ds], qf[ds], s);
        float lk[16], ls[16];
        const int d0 = (qb - kb) * 32 + r32;
#pragma unroll
        for (int r = 0; r < 16; ++r) { const float z2 = s[r] * SC2; const float sp = fmaxf(z2, 0.f) + lg2(1.0f + ex2(-fabsf(z2))); const bool valid = crow(r, hi) < d0; lk[r] = valid ? -sp : 0.f; ls[r] = valid ? (z2 - sp) : -INFINITY; }
        float e[16], tq[4], pq[4];
#pragma unroll
        for (int g = 0; g < 4; ++g) { e[4 * g + 3] = 0.f; e[4 * g + 2] = lk[4 * g + 3]; e[4 * g + 1] = e[4 * g + 2] + lk[4 * g + 2]; e[4 * g] = e[4 * g + 1] + lk[4 * g + 1]; tq[g] = e[4 * g] + lk[4 * g]; }
#pragma unroll
        for (int g = 0; g < 4; ++g) pq[g] = x32_partner(tq[g], hi);
        float cs[4]; cs[3] = 0.f; cs[2] = tq[3] + pq[3]; cs[1] = cs[2] + (tq[2] + pq[2]); cs[0] = cs[1] + (tq[1] + pq[1]);
        const float total = cs[0] + (tq[0] + pq[0]);
#pragma unroll
        for (int g = 0; g < 4; ++g) { const float later = R + cs[g] + (hi == 0 ? pq[g] : 0.f);
#pragma unroll
            for (int i = 0; i < 4; ++i) s[4 * g + i] = ex2(ls[4 * g + i] + e[4 * g + i] + later); }
        R += total;
        const bf16x8 pf0 = pack8(s, 0), pf1 = pack8(s, 8);
        o0 = MFMA32(cv.v[0], pf0, o0); o0 = MFMA32(cv.v[1], pf1, o0); o1 = MFMA32(cv.v[2], pf0, o1); o1 = MFMA32(cv.v[3], pf1, o1);
        if (__all(R < -150.0f)) break;
    }
}

#define XB_TMO      128
#define XB_XCNT(j)  (256  + 64 * (j))
#define XB_XSUB(j)  (1280 + 64 * (j))
#define XB_XGEN(j)  (2304 + 64 * (j))
#define XB_TOP      3328
#define XB_TOPGEN   3392
#define XCD_BAR_WORDS 3456
#define XB_SPIN_CAP (1u << 18)
__device__ __forceinline__ unsigned xb_ld(unsigned* p)              { return __hip_atomic_load(p, __ATOMIC_RELAXED, __HIP_MEMORY_SCOPE_AGENT); }
__device__ __forceinline__ unsigned xb_add(unsigned* p, unsigned v) { return __hip_atomic_fetch_add(p, v, __ATOMIC_RELAXED, __HIP_MEMORY_SCOPE_AGENT); }
__device__ __forceinline__ unsigned xb_xcc_id() { return (unsigned)__builtin_amdgcn_s_getreg((3 << 11) | 20) & 0xFu; }
#define XB_SPIN(cond, bar) do { unsigned _sp = 0; while (cond) { __builtin_amdgcn_s_sleep(1); \
    if ((++_sp & 255u) == 0u) { if (xb_ld(&(bar)[XB_TMO])) break; if (_sp > XB_SPIN_CAP) { atomicAdd(&(bar)[XB_TMO], 1u); break; } } } } while (0)
__device__ __forceinline__ void xcd_barrier_complete(unsigned* bar, unsigned x, unsigned& nloc, unsigned& nx) {
    const unsigned G = gridDim.x * gridDim.y * gridDim.z;
    unsigned sum, cnt, mine, sp = 0u;
    for (;;) {
        sum = 0u; cnt = 0u; mine = 0u;
#pragma unroll
        for (unsigned j = 0; j < 16; ++j) { const unsigned c = xb_ld(&bar[XB_XCNT(j)]); sum += c; cnt += (c > 0u) ? 1u : 0u; mine = (j == x) ? c : mine; }
        if (sum == G) break;
        __builtin_amdgcn_s_sleep(1);
        if ((++sp & 255u) == 0u) { if (xb_ld(&bar[XB_TMO])) break; if (sp > XB_SPIN_CAP) { atomicAdd(&bar[XB_TMO], 1u); break; } }
    }
    nloc = mine > 0u ? mine : 1u; nx = cnt > 0u ? cnt : 1u;
}
__device__ __forceinline__ void xcd_barrier(unsigned* bar, volatile LAS unsigned* st) {
    asm volatile("s_waitcnt vmcnt(0)" ::: "memory");
    __syncthreads();
    if (threadIdx.x == 0) {
        const unsigned x = xb_xcc_id();
        __builtin_amdgcn_s_waitcnt(0);
        unsigned nloc = st[0], nx = st[1];
        if (nloc == 0u) { xcd_barrier_complete(bar, x, nloc, nx); st[0] = nloc; st[1] = nx; }
        const unsigned old = xb_add(&bar[XB_XSUB(x)], 1u);
        const unsigned gen = old / nloc;
        if (old + 1u == (gen + 1u) * nloc) {
            __builtin_amdgcn_fence(__ATOMIC_RELEASE, "agent");
            asm volatile("s_waitcnt vmcnt(0)" ::: "memory");
            const unsigned og = xb_add(&bar[XB_TOP], 1u);
            const unsigned tg = og / nx;
            if (og + 1u == (tg + 1u) * nx) xb_add(&bar[XB_TOPGEN], 1u);
            else XB_SPIN(xb_ld(&bar[XB_TOPGEN]) == tg, bar);
            __builtin_amdgcn_fence(__ATOMIC_ACQUIRE, "agent");
            xb_add(&bar[XB_XGEN(x)], 1u);
            asm volatile("s_waitcnt vmcnt(0)" ::: "memory");
        } else {
            XB_SPIN(xb_ld(&bar[XB_XGEN(x)]) == gen, bar);
            __builtin_amdgcn_fence(__ATOMIC_ACQUIRE, "agent");
            asm volatile("s_waitcnt vmcnt(0)" ::: "memory");
        }
    }
    __syncthreads();
}
constexpr int MISC_OFF = 131072 + 320;

struct Params {
    const float* x; const float* mix_g; const float* w_in; const float* b_forget; const float* lq1; const float* lk1; const float* lq2; const float* lk2;
    const float* diff_g; const float* w_branch; const float* w_out; const float* mlp_g; const float* w_up; const float* w_down; const float* final_g;
    float* out; unsigned char* ws;
};

#ifndef REP_P1
#define REP_P1 1
#endif
#ifndef REP_P2
#define REP_P2 1
#endif
#ifndef REP_P3
#define REP_P3 1
#endif
#ifndef REP_P5
#define REP_P5 1
#endif
#ifndef REP_SYNC
#define REP_SYNC 1
#endif
#ifndef REP_CONV
#define REP_CONV 1
#endif
#define GSYNC() do { for (int rs_ = 0; rs_ < REP_SYNC; ++rs_) { KParamsPtr pb_ = OPQ_PP(); xcd_barrier((unsigned*)(pb_->ws + WS_CTL) + CW_BAR, (volatile LAS unsigned*)(lds + MISC_OFF)); } } while (0)
#define OPQ_TID() ({ int t_ = threadIdx.x; asm volatile("" : "+v"(t_)); t_; })
typedef const __attribute__((address_space(4))) Params* KParamsPtr;
#define OPQ_PP() ({ KParamsPtr p_ = (KParamsPtr)__builtin_amdgcn_kernarg_segment_ptr(); asm volatile("" : "+s"(p_)); p_; })
#define PHASE_VARS() const int tid = OPQ_TID(); const int lane = tid & 63, wave = __builtin_amdgcn_readfirstlane(tid >> 6); const int G = gridDim.x, bx = blockIdx.x; \
    const int gw = bx * NWAVES + wave, NGW = G * NWAVES; KParamsPtr PP = OPQ_PP(); unsigned char* ws = PP->ws; LAS float* scr = (LAS float*)(lds + wave * 16384); (void)lane; (void)gw; (void)NGW; (void)ws; (void)scr; (void)G; (void)bx; (void)PP

__global__ void __launch_bounds__(NWAVES * 64, 2) fwd_mega(Params P) {
    extern __shared__ __attribute__((aligned(16))) unsigned char lds_raw[];
    LAS unsigned char* lds = (LAS unsigned char*)lds_raw;
    cg::grid_group grid = cg::this_grid();
    { const int t0 = OPQ_TID(); if (t0 < 64) ((LAS unsigned*)(lds + 131072))[t0 + 64] = 0u; __syncthreads();
      if (t0 == 0) { KParamsPtr p0 = OPQ_PP(); (void)xb_add((unsigned*)(p0->ws + WS_CTL) + CW_BAR + XB_XCNT(xb_xcc_id()), 1u); } }

    {
        PHASE_VARS();
        bf16_t* XB = (bf16_t*)(ws + WS_XB); float* SSQ = (float*)(ws + WS_SSQ);
        for (int row = gw; row < TOK; row += NGW) {
            const f32x4* xr = (const f32x4*)(PP->x + (size_t)row * DM) + lane;
            unsigned long long* o8 = (unsigned long long*)(XB + (size_t)row * DM) + lane;
            float s = 0.f;
#pragma unroll
            for (int j = 0; j < 4; ++j) { const f32x4 v = xr[64 * j]; s += (v[0] * v[0] + v[1] * v[1]) + (v[2] * v[2] + v[3] * v[3]);
                o8[64 * j] = (unsigned long long)cvtpk(v[0], v[1]) | ((unsigned long long)cvtpk(v[2], v[3]) << 32); }
            s = wave_sum(s);
            if (lane < 16) SSQ[(size_t)row * 16 + lane] = (lane == 0) ? s : 0.f;
        }
    }

    for (int layer = 0; layer < DEPTH; ++layer) {
        for (int rep = 0; rep < REP_CONV; ++rep) {
            PHASE_VARS();
            bf16_t* WIN = (bf16_t*)(ws + WS_WIN); bf16_t* WB = (bf16_t*)(ws + WS_WB); bf16_t* WOUT = (bf16_t*)(ws + WS_WOUT);
            const float* w_in = PP->w_in + (size_t)layer * DM * DIN; const float* mg = PP->mix_g + (size_t)layer * DM;
            const float* wb = PP->w_branch + (size_t)layer * 4 * 256 * DM; const float* wo = PP->w_out + (size_t)layer * DM * DM;
            constexpr int I_IN = (DM / 64) * (NPROJ / 32), I_B = (256 / 64) * (DM / 32), I_O = (DM / 64) * (DM / 32);
            for (int it = gw; it < I_IN + 4 * I_B + I_O; it += NGW) {
                int r = it;
                if (r < I_IN) { transpose_item<1>(w_in, DM, NPROJ, DIN, mg, WIN, scr, r, lane); continue; } r -= I_IN;
                if (r < 4 * I_B) { const int n = r / I_B; branch_item(wb + (size_t)n * 256 * DM, n, WB, scr, r % I_B, lane); continue; } r -= 4 * I_B;
                transpose_item<0>(wo, DM, DM, DM, nullptr, WOUT, scr, r, lane);
            }
        }
        if (layer == 0) grid.sync(); else GSYNC();

        for (int half = 0; half < 2; ++half) {
#ifndef NO_P1
            for (int rep = 0; rep < REP_P1; ++rep) {
                PHASE_VARS();
                const int rb = half * HT;
                pg8::Gemm g{(const bf16_t*)(ws + WS_XB) + (size_t)rb * DM, (const bf16_t*)(ws + WS_WIN), DM, DM, DM, 0, 0};
                pg8::StaticOrder S; S.init(HT, NPROJ, G, bx);
                pg8::EpiProj E{(const float*)(ws + WS_SSQ), rb, (bf16_t*)(ws + WS_QK), (bf16_t*)(ws + WS_KF), (bf16_t*)(ws + WS_VT), (float*)(ws + WS_FL), (bf16_t*)(ws + WS_GATE)};
                pg8::gemm_phase<pg8::EpiProj, pg8::StaticOrder, true>(lds, g, S, E);
            }
#endif
            GSYNC();
#ifndef NO_P2
            for (int rep = 0; rep < REP_P2; ++rep) {
                PHASE_VARS();
                unsigned* ctr = (unsigned*)(ws + WS_CTL) + 64 + 512 * (layer * 2 + half + 4 * rep);
                const int xq = bx & 7;
                ctr += 64 * xq;
                for (;;) {
                    int li = 0; if (lane == 0) li = (int)atomicAdd(ctr, 1u); li = __builtin_amdgcn_readfirstlane(li);
                    if (li >= 800) break;
                    int idx;
                    if (li < 288) { const int hl = li / 48, row = li - hl * 48; idx = row * 48 + (xq + 8 * hl); }
                    else if (li < 416) { const int i = li - 288; idx = 2304 + ((63 - (i & 63)) << 4) + (xq + 8 * (i >> 6)); }
                    else { const int i = li - 416; idx = 3328 + (xq + 8 * (i >> 6)) * 64 + (i & 63); }
                    int lane_u = lane; asm volatile("" : "+v"(lane_u));
                    const int lane = lane_u, r32 = lane & 31, hi = lane >> 5;
                    KParamsPtr PU = OPQ_PP(); unsigned char* wsu = PU->ws;
                    bf16_t* YS = (bf16_t*)(wsu + WS_YS); bf16_t* DILO = (bf16_t*)(wsu + WS_DILO); float* LSE = (float*)(wsu + WS_LSE); const float* FL = (const float*)(wsu + WS_FL);
                    const bf16_t* QK = (const bf16_t*)(wsu + WS_QK); const bf16_t* KF = (const bf16_t*)(wsu + WS_KF); const bf16_t* VT = (const bf16_t*)(wsu + WS_VT);
                    if (idx < 2304) {
                        const int j = idx / 48, e = idx - j * 48, type3 = e >> 4, bh = e & 15, b = bh >> 2, h = bh & 3;
                        int Q, chunk; if (j < 32) { Q = 31 - (j >> 1); chunk = j & 1; } else { Q = 47 - j; chunk = 0; }
                        int kb_lo = 0, kb_hi = 2 * Q + 1;
                        if (Q >= 16) { if (chunk == 0) kb_hi = Q; else kb_lo = Q + 1; }
                        const size_t rowb = (size_t)b * SEQ;
                        bf16_t* SCRB = (bf16_t*)(wsu + WS_MERGED) + (size_t)(half * HT) * DM;
                        float* LSE2 = (float*)(wsu + WS_LSE2);
                        f32x16 o[2][2]; float m[2], l[2]; int slot;
                        if (type3 == 2) {
                            LAS float* cl = scr;
                            const float bf = PP->b_forget[layer * 4 + h];
                            float run = 0.f;
                            if (lane <= kb_hi) {
                                const float* fp = FL + (rowb + 32 * lane) * 4 + h;
#pragma unroll 8
                                for (int i = 0; i < 32; ++i) { const float y = fp[4 * i] + bf; const float lf = fminf(y, 0.f) - __logf(1.0f + __expf(-fabsf(y))); run += lf; cl[33 * lane + i] = run; }
                            }
                            float incl = run;
#pragma unroll
                            for (int o_ = 1; o_ < 64; o_ <<= 1) { const float tt = __uint_as_float((unsigned)__builtin_amdgcn_ds_bpermute((lane - o_) << 2, (int)__float_as_uint(incl))); if (lane >= o_) incl += tt; }
                            const float excl = incl - run;
                            if (lane <= kb_hi) {
#pragma unroll 8
                                for (int i = 0; i < 32; ++i) cl[33 * lane + i] = -(cl[33 * lane + i] + excl) * LOG2E;
                            }
                            asm volatile("s_waitcnt lgkmcnt(0)" ::: "memory");
                            sm_unit64<0>(QK + rowb * LDQK + 4 * 256 + h * 64, KF + (size_t)(b * 24 + 16 + h) * HSEQ, VT + (size_t)(b * 24 + 16 + h) * HSEQ, Q, kb_hi, kb_lo, 0.f, cl, o, m, l, lane);
                            asm volatile("s_waitcnt lgkmcnt(0)" ::: "memory");
                            slot = chunk;
                        } else {
                            const float slope = exp2f(-8.0f * (float)(5 + h) / 16.0f);
                            sm_unit64<2>(QK + rowb * LDQK + 5 * 256 + h * 64 + type3 * 32, KF + (size_t)(b * 24 + 20 + h) * HSEQ + type3 * 1024, VT + (size_t)(b * 24 + 20 + h) * HSEQ, Q, kb_hi, kb_lo, slope * LOG2E, nullptr, o, m, l, lane);
                            slot = 2 + 2 * type3 + chunk;
                        }
#pragma unroll
                        for (int i = 0; i < 2; ++i) {
                            const int t = (2 * Q + i) * 32 + r32;
                            bf16_t* dst;
                            if (type3 == 2) dst = chunk ? SCRB + (rowb + t) * 256 + h * 64 : YS + (rowb + t) * DM + 512 + h * 64;
                            else dst = (type3 == 0 && chunk == 0) ? YS + (rowb + t) * DM + 768 + h * 64 : SCRB + (size_t)(2 * type3 + chunk) * HT * 256 + (rowb + t) * 256 + h * 64;
                            const float inv = 1.0f / l[i];
#pragma unroll
                            for (int k = 0; k < 16; ++k) { o[i][0][k] *= inv; o[i][1][k] *= inv; }
                            store_o(dst, o[i][0], o[i][1], hi);
                            if (hi == 0) LSE2[(rowb + t) * 24 + h * 6 + slot] = m[i] + lg2(l[i]);
                        }
                    } else if (idx < 3328) {
                        const int i1 = idx - 2304, qb = 63 - (i1 >> 4), bh = i1 & 15, b = bh >> 2, h = bh & 3;
                        const size_t rowb = (size_t)b * SEQ; const int t = qb * 32 + r32;
                        f32x16 o0, o1;
                        sb_unit(QK + rowb * LDQK + 0 * 256 + h * 64, KF + (size_t)(b * 24 + h) * HSEQ, VT + (size_t)(b * 24 + h) * HSEQ, qb, o0, o1, lane);
                        store_o(YS + (rowb + t) * DM + 0 * 256 + h * 64, o0, o1, hi);
                    } else {
                        const int i2 = idx - 3328, j = i2 & 63, gh = (i2 >> 6) % 12, b = i2 / 768, gI = gh >> 2, h = gh & 3;
                        const int rsh = 2 * gI, r = 1 << rsh, sl = SEQ >> rsh, nubsh = 6 - rsh, rho = j >> nubsh, ub = j & ((1 << nubsh) - 1);
                        const int sidx = (gI == 0) ? h : (gI == 1 ? 8 + h : 12 + h);
                        const float slope = exp2f(-8.0f * (float)(sidx + 1) / 16.0f);
                        const size_t rowb = (size_t)b * SEQ + (size_t)rho * sl;
                        f32x16 o0, o1; float m, l;
                        const int kb_lo = (ub - 4 > 0) ? ub - 4 : 0;
                        sm_unit<1>(QK + rowb * LDQK + (1 + gI) * 256 + h * 64, KF + (size_t)(b * 24 + 4 + 4 * gI + h) * HSEQ + (size_t)rho * sl * 64,
                                   VT + (size_t)(b * 24 + 4 + 4 * gI + h) * HSEQ + (size_t)rho * sl * 64, ub, ub, kb_lo, slope * (float)r * LOG2E, nullptr, o0, o1, m, l, lane);
                        const float inv = 1.0f / l;
#pragma unroll
                        for (int i = 0; i < 16; ++i) { o0[i] *= inv; o1[i] *= inv; }
                        const int u = ub * 32 + r32; const size_t tok = (size_t)b * SEQ + (size_t)u * r + rho;
                        store_o(DILO + tok * 768 + gI * 256 + h * 64, o0, o1, hi);
                        if (hi == 0) LSE[tok * 12 + gI * 4 + h] = (m + lg2(l)) * LN2;
                    }
                }
            }
#endif
            GSYNC();
            {
                PHASE_VARS();
                const float lam_init = (layer == 0) ? 0.2f : 0.35550906759093115f;
                float lam;
                { const float a = (lane < 32) ? PP->lq1[layer * 32 + lane] * PP->lk1[layer * 32 + lane] : 0.f, b = (lane < 32) ? PP->lq2[layer * 32 + lane] * PP->lk2[layer * 32 + lane] : 0.f;
                  lam = __expf(wave_sum(a)) - __expf(wave_sum(b)) + lam_init; }
                bf16_t* YS = (bf16_t*)(ws + WS_YS); const bf16_t* DILO = (const bf16_t*)(ws + WS_DILO); const float* LSE = (const float*)(ws + WS_LSE);
                const bf16_t* SCRB = (const bf16_t*)(ws + WS_MERGED) + (size_t)(half * HT) * DM; const float* LSE2 = (const float*)(ws + WS_LSE2);
                const int h = lane >> 4, dq = (lane & 15) * 4;
                const f32x4 dgv = *(const f32x4*)(PP->diff_g + layer * 64 + dq);
                for (int row = gw; row < HT; row += NGW) {
                    const bool split = ((row & (SEQ - 1)) >> 5) >= 32;
                    {
                        const float l0 = LSE[(size_t)row * 12 + h], l1 = LSE[(size_t)row * 12 + 4 + h], l2 = LSE[(size_t)row * 12 + 8 + h];
                        const float mx = fmaxf(l0, fmaxf(l1, l2)); const float e0 = __expf(l0 - mx), e1 = __expf(l1 - mx), e2 = __expf(l2 - mx); const float inv = 1.0f / (e0 + e1 + e2);
                        const u32x2 a = *(const u32x2*)(DILO + (size_t)row * 768 + 4 * lane), b = *(const u32x2*)(DILO + (size_t)row * 768 + 256 + 4 * lane), c = *(const u32x2*)(DILO + (size_t)row * 768 + 512 + 4 * lane);
                        const float w0 = e0 * inv, w1 = e1 * inv, w2 = e2 * inv;
                        u32x2 o; o.x = cvtpk(w0 * bflo(a.x) + w1 * bflo(b.x) + w2 * bflo(c.x), w0 * bfhi(a.x) + w1 * bfhi(b.x) + w2 * bfhi(c.x));
                        o.y = cvtpk(w0 * bflo(a.y) + w1 * bflo(b.y) + w2 * bflo(c.y), w0 * bfhi(a.y) + w1 * bfhi(b.y) + w2 * bfhi(c.y));
                        *(u32x2*)(YS + (size_t)row * DM + 256 + 4 * lane) = o;
                    }
                    const float* ls = LSE2 + (size_t)row * 24 + h * 6;
                    const u32x2 f0 = *(const u32x2*)(YS + (size_t)row * DM + 512 + 4 * lane), a0 = *(const u32x2*)(YS + (size_t)row * DM + 768 + 4 * lane);
                    const u32x2 b0 = *(const u32x2*)(SCRB + (size_t)2 * HT * 256 + (size_t)row * 256 + 4 * lane);
                    float fv[4] = {bflo(f0.x), bfhi(f0.x), bflo(f0.y), bfhi(f0.y)}, av[4] = {bflo(a0.x), bfhi(a0.x), bflo(a0.y), bfhi(a0.y)}, bv[4] = {bflo(b0.x), bfhi(b0.x), bflo(b0.y), bfhi(b0.y)};
                    if (split) {
                        const u32x2 f1 = *(const u32x2*)(SCRB + (size_t)row * 256 + 4 * lane), a1 = *(const u32x2*)(SCRB + (size_t)1 * HT * 256 + (size_t)row * 256 + 4 * lane), b1 = *(const u32x2*)(SCRB + (size_t)3 * HT * 256 + (size_t)row * 256 + 4 * lane);
                        const float lf0 = ls[0], lf1 = ls[1], la0 = ls[2], la1 = ls[3], lb0 = ls[4], lb1 = ls[5];
                        { const float mx = fmaxf(lf0, lf1), e0 = ex2(lf0 - mx), e1 = ex2(lf1 - mx), inv = 1.0f / (e0 + e1), w0 = e0 * inv, w1 = e1 * inv;
                          fv[0] = w0 * fv[0] + w1 * bflo(f1.x); fv[1] = w0 * fv[1] + w1 * bfhi(f1.x); fv[2] = w0 * fv[2] + w1 * bflo(f1.y); fv[3] = w0 * fv[3] + w1 * bfhi(f1.y); }
                        { const float mx = fmaxf(la0, la1), e0 = ex2(la0 - mx), e1 = ex2(la1 - mx), inv = 1.0f / (e0 + e1), w0 = e0 * inv, w1 = e1 * inv;
                          av[0] = w0 * av[0] + w1 * bflo(a1.x); av[1] = w0 * av[1] + w1 * bfhi(a1.x); av[2] = w0 * av[2] + w1 * bflo(a1.y); av[3] = w0 * av[3] + w1 * bfhi(a1.y); }
                        { const float mx = fmaxf(lb0, lb1), e0 = ex2(lb0 - mx), e1 = ex2(lb1 - mx), inv = 1.0f / (e0 + e1), w0 = e0 * inv, w1 = e1 * inv;
                          bv[0] = w0 * bv[0] + w1 * bflo(b1.x); bv[1] = w0 * bv[1] + w1 * bfhi(b1.x); bv[2] = w0 * bv[2] + w1 * bflo(b1.y); bv[3] = w0 * bv[3] + w1 * bfhi(b1.y); }
                        u32x2 fo; fo.x = cvtpk(fv[0], fv[1]); fo.y = cvtpk(fv[2], fv[3]);
                        *(u32x2*)(YS + (size_t)row * DM + 512 + 4 * lane) = fo;
                    }
                    float dv[4]; float ss = 0.f;
#pragma unroll
                    for (int i = 0; i < 4; ++i) { dv[i] = av[i] - lam * bv[i]; ss += dv[i] * dv[i]; }
                    ss += swz_xor<1>(ss); ss += swz_xor<2>(ss); ss += swz_xor<4>(ss); ss += swz_xor<8>(ss);
                    const float rn = __builtin_amdgcn_rsqf(ss * (1.0f / 64.0f) + RMS_EPS) * (1.0f - lam_init);
                    u32x2 dout; dout.x = cvtpk(dv[0] * rn * dgv[0], dv[1] * rn * dgv[1]); dout.y = cvtpk(dv[2] * rn * dgv[2], dv[3] * rn * dgv[3]);
                    *(u32x2*)(YS + (size_t)row * DM + 768 + 4 * lane) = dout;
                }
            }
            GSYNC();
#ifndef NO_P3
            for (int rep = 0; rep < REP_P3; ++rep) {
                PHASE_VARS();
                pg8::Gemm g{(const bf16_t*)(ws + WS_YS), (const bf16_t*)(ws + WS_WB), DM, 512, 512, 512 * 2, (long)8 * 256 * 512 * 2};
                pg8::BranchOrder S{bx, G};
                pg8::EpiBranch E{(const bf16_t*)(ws + WS_GATE), (bf16_t*)(ws + WS_MERGED), half * HT};
                pg8::gemm_phase<pg8::EpiBranch, pg8::BranchOrder, true>(lds, g, S, E);
            }
#endif
            GSYNC();
        }
#ifndef NO_P4
        for (int rep = 0; rep < REP_CONV; ++rep) {
            PHASE_VARS();
            bf16_t* WUP = (bf16_t*)(ws + WS_WUP); bf16_t* WDN = (bf16_t*)(ws + WS_WDN);
            const float* wu = PP->w_up + (size_t)layer * DM * DFF; const float* wd = PP->w_down + (size_t)layer * DFF * DM; const float* mg = PP->mlp_g + (size_t)layer * DM;
            constexpr int I_U = (DM / 64) * (DFF / 32), I_D = (DFF / 64) * (DM / 32);
            for (int it = gw; it < I_U + I_D; it += NGW) {
                if (it < I_U) transpose_item<0>(wu, DM, DFF, DFF, mg, WUP, scr, it, lane);
                else transpose_item<0>(wd, DFF, DM, DM, nullptr, WDN, scr, it - I_U, lane);
            }
            __syncthreads();
        }
        {
            PHASE_VARS();
            pg8::Gemm g{(const bf16_t*)(ws + WS_MERGED), (const bf16_t*)(ws + WS_WOUT), DM, DM, DM, 0, 0};
            pg8::StaticOrder S; S.init(TOK, DM, G, bx);
            pg8::EpiResid E{(layer == 0) ? PP->x : (const float*)PP->out, PP->out, (bf16_t*)(ws + WS_XB), (float*)(ws + WS_SSQ)};
            pg8::gemm_phase<pg8::EpiResid, pg8::StaticOrder, false>(lds, g, S, E);
        }
#endif
        GSYNC();
#ifndef NO_P5
        for (int rep = 0; rep < REP_P5; ++rep) {
            PHASE_VARS();
            pg8::Gemm g{(const bf16_t*)(ws + WS_XB), (const bf16_t*)(ws + WS_WUP), DM, DM, DM, 0, 0};
            pg8::StaticOrder S; S.init(TOK, DFF, G, bx);
            pg8::EpiUp E{(const float*)(ws + WS_SSQ), (bf16_t*)(ws + WS_HMLP)};
            pg8::gemm_phase<pg8::EpiUp, pg8::StaticOrder, true>(lds, g, S, E);
        }
#endif
        GSYNC();
#ifndef NO_P6
        {
            PHASE_VARS();
            pg8::Gemm g{(const bf16_t*)(ws + WS_HMLP), (const bf16_t*)(ws + WS_WDN), DFF, DFF, DFF, 0, 0};
            pg8::StaticOrder S; S.init(TOK, DM, G, bx);
            pg8::EpiResid E{(const float*)PP->out, PP->out, (bf16_t*)(ws + WS_XB), (float*)(ws + WS_SSQ)};
            pg8::gemm_phase<pg8::EpiResid, pg8::StaticOrder, false>(lds, g, S, E);
        }
#endif
        GSYNC();
    }
    {
        PHASE_VARS();
        float* X = PP->out;
        for (int row = gw; row < TOK; row += NGW) {
            f32x4* xo = (f32x4*)(X + (size_t)row * DM) + lane; const f32x4* gp = (const f32x4*)PP->final_g + lane;
            f32x4 v[4]; float s = 0.f;
#pragma unroll
            for (int j = 0; j < 4; ++j) { v[j] = xo[64 * j]; s += (v[j][0] * v[j][0] + v[j][1] * v[j][1]) + (v[j][2] * v[j][2] + v[j][3] * v[j][3]); }
            const float rstd = __builtin_amdgcn_rsqf(wave_sum(s) * (1.0f / DM) + RMS_EPS);
#pragma unroll
            for (int j = 0; j < 4; ++j) xo[64 * j] = v[j] * rstd * gp[64 * j];
        }
    }
}

extern "C" void kernel_launch(void* const* d_in, const int* in_sizes, int n_in, void* d_out, int out_size, void* d_ws, size_t ws_size, hipStream_t stream) {
    static int grid = 0;
    if (grid == 0) {
        if (n_in != 15 || in_sizes[0] != TOK * DM || out_size != TOK * DM || ws_size < WS_END) { fprintf(stderr, "kernel_launch: unexpected shapes / workspace (n_in %d, ws %zu)\n", n_in, ws_size); grid = -1; return; }
        int dev = 0, cus = 0, per_cu = 0;
        hipGetDevice(&dev); hipDeviceGetAttribute(&cus, hipDeviceAttributeMultiprocessorCount, dev);
        hipFuncSetAttribute((const void*)fwd_mega, hipFuncAttributeMaxDynamicSharedMemorySize, LDS_BYTES);
        hipOccupancyMaxActiveBlocksPerMultiprocessor(&per_cu, (const void*)fwd_mega, NWAVES * 64, LDS_BYTES);
        (void)hipGetLastError();
        if (per_cu < 1) per_cu = 1;
        grid = cus;
        if (grid > 256) grid = 256;
        if (grid % 8 != 0) { fprintf(stderr, "kernel_launch: the per-XCD work queues need a grid that is a multiple of 8 (got %d)\n", grid); grid = -1; return; }
    }
    if (grid < 0) return;
    hipMemsetAsync((char*)d_ws + WS_CTL, 0, CTL_BYTES, stream);
    Params p{};
    p.x = (const float*)d_in[0]; p.mix_g = (const float*)d_in[1]; p.w_in = (const float*)d_in[2]; p.b_forget = (const float*)d_in[3];
    p.lq1 = (const float*)d_in[4]; p.lk1 = (const float*)d_in[5]; p.lq2 = (const float*)d_in[6]; p.lk2 = (const float*)d_in[7];
    p.diff_g = (const float*)d_in[8]; p.w_branch = (const float*)d_in[9]; p.w_out = (const float*)d_in[10]; p.mlp_g = (const float*)d_in[11];
    p.w_up = (const float*)d_in[12]; p.w_down = (const float*)d_in[13]; p.final_g = (const float*)d_in[14];
    p.out = (float*)d_out; p.ws = (unsigned char*)d_ws;
    void* args[] = {&p};
    hipError_t e = hipLaunchCooperativeKernel((const void*)fwd_mega, dim3(grid), dim3(NWAVES * 64), args, LDS_BYTES, stream);
    if (e != hipSuccess) fprintf(stderr, "cooperative launch failed: %s (grid %d)\n", hipGetErrorString(e), grid);
}
```

```cpp
#include <hip/hip_runtime.h>
#include <hip/hip_cooperative_groups.h>
#include <cstdio>
#include <cstdint>
namespace cg = cooperative_groups;

#define LAS __attribute__((address_space(3)))
typedef unsigned short bf16_t;
typedef short bf16x8 __attribute__((ext_vector_type(8)));
typedef float f32x4 __attribute__((ext_vector_type(4)));
typedef float f32x16 __attribute__((ext_vector_type(16)));
typedef unsigned u32x4 __attribute__((ext_vector_type(4)));
typedef unsigned u32x2 __attribute__((ext_vector_type(2)));
typedef float f32x2_t __attribute__((ext_vector_type(2)));
typedef __bf16 bf16x2_t __attribute__((ext_vector_type(2)));

constexpr int DM = 1024, BATCH = 8, SEQ = 2048, DEPTH = 2, TOK = BATCH * SEQ, DFF = 4096, DIN = 8708;
constexpr int HT = TOK / 2;
constexpr int NPROJ = 35 * 256;
constexpr int LDQK = 6 * 256;
constexpr int HSEQ = SEQ * 64;
constexpr float LOG2E = 1.4426950408889634f, LN2 = 0.6931471805599453f;
constexpr float RMS_EPS = 1e-6f;

constexpr size_t MiB = 1u << 20;
constexpr size_t WS_CTL = 0, CTL_BYTES = 65536;
constexpr int CW_BAR = 4096, CW_PANEL = 8192;
constexpr size_t WS_SSQ = 1 * MiB;
constexpr size_t WS_WIN = 2 * MiB;
constexpr size_t WS_WUP = WS_WIN, WS_WDN = WS_WIN + 8 * MiB;
constexpr size_t WS_WB = 20 * MiB;
constexpr size_t WS_WOUT = 24 * MiB;
constexpr size_t WS_XB = 26 * MiB;
constexpr size_t WS_MERGED = 58 * MiB;
constexpr size_t WS_YS = 90 * MiB;
constexpr size_t WS_DILO = 106 * MiB;
constexpr size_t WS_LSE = 118 * MiB;
constexpr size_t WS_LSE2 = 118 * MiB + 512 * 1024;
constexpr size_t WS_FL = 119 * MiB + 512 * 1024;
constexpr size_t WS_QK = 120 * MiB;
constexpr size_t WS_KF = 144 * MiB;
constexpr size_t WS_VT = 168 * MiB;
constexpr size_t WS_GATE = 192 * MiB;
constexpr size_t WS_HMLP = 120 * MiB;
constexpr size_t WS_END = 256 * MiB;

constexpr int LDS_BYTES = 147456;
constexpr int NWAVES = 8;

__device__ __forceinline__ unsigned cvtpk(float lo, float hi) { f32x2_t v = {lo, hi}; bf16x2_t b = __builtin_convertvector(v, bf16x2_t); return __builtin_bit_cast(unsigned, b); }
__device__ __forceinline__ float bflo(unsigned w) { return __uint_as_float(w << 16); }
__device__ __forceinline__ float bfhi(unsigned w) { return __uint_as_float(w & 0xffff0000u); }
__device__ __forceinline__ float ex2(float x) { return __builtin_amdgcn_exp2f(x); }
__device__ __forceinline__ float lg2(float x) { return __builtin_amdgcn_logf(x); }
__device__ __forceinline__ float x32_sum(float v) { auto r = __builtin_amdgcn_permlane32_swap(__float_as_uint(v), __float_as_uint(v), false, false); return __uint_as_float(r[0]) + __uint_as_float(r[1]); }
__device__ __forceinline__ float x32_max(float v) { auto r = __builtin_amdgcn_permlane32_swap(__float_as_uint(v), __float_as_uint(v), false, false); return fmaxf(__uint_as_float(r[0]), __uint_as_float(r[1])); }
__device__ __forceinline__ float x32_partner(float v, int hi) { auto r = __builtin_amdgcn_permlane32_swap(__float_as_uint(v), __float_as_uint(v), false, false); return hi ? __uint_as_float(r[0]) : __uint_as_float(r[1]); }
template <int X> __device__ __forceinline__ float swz_xor(float v) { return __uint_as_float((unsigned)__builtin_amdgcn_ds_swizzle((int)__float_as_uint(v), (X << 10) | 0x1f)); }
__device__ __forceinline__ float x16_sum(float v) { return v + swz_xor<16>(v); }
__device__ __forceinline__ float wave_sum(float v) { v += swz_xor<1>(v); v += swz_xor<2>(v); v += swz_xor<4>(v); v += swz_xor<8>(v); v += swz_xor<16>(v); return x32_sum(v); }

namespace pg8 {
constexpr int BM = 256, BK = 64, HALF = 128, HTB = HALF * BK * 2, STAGE_BYTES = 8 * HTB, NXCD = 8, WGM = 8;
__host__ __device__ __forceinline__ int lds_byte(int r, int c) { const int st = (r >> 4) * 2 + (c >> 5), rr = r & 15, cc = c & 31, ob = rr * 64 + cc * 2; return st * 1024 + (ob ^ (((ob >> 9) & 1) << 5)); }
__host__ __device__ __forceinline__ void stage_rc(int b, int& R, int& C) { const int st = b / 1024, sb = b % 1024, swz = sb ^ (((sb >> 9) & 1) << 5); R = (st >> 1) * 16 + swz / 64; C = (st & 1) * 32 + (swz % 64) / 2; }
__host__ __device__ __forceinline__ int perm32(int rho) { const int n = rho >> 4, i = rho & 15; return 8 * (i >> 2) + 4 * n + (i & 3); }

struct Unit { int pm, pn, aux; };
struct Gemm { const bf16_t* A; const bf16_t* Bt; int lda, ldb, K; long a_aux, b_aux; };

struct StaticOrder {
    int nM, nN, nwg, G, c;
    __device__ void init(int M, int N, int G_, int c_) { nM = M / BM; nN = N / BM; nwg = nM * nN; G = G_; c = c_; }
    __device__ bool next(int i, Unit& u) const {
        const long L = (long)i * G + c; if (L >= nwg) return false;
        int wgid = (int)L; { const int q = nwg / NXCD, r = nwg % NXCD, xcd = wgid % NXCD, off = wgid / NXCD; wgid = (xcd < r ? xcd * (q + 1) : r * (q + 1) + (xcd - r) * q) + off; }
        const int nig = WGM * nN, gid = wgid / nig, fm = gid * WGM, gsz = (nM - fm) < WGM ? (nM - fm) : WGM;
        u.pm = fm + ((wgid % nig) % gsz); u.pn = (wgid % nig) / gsz; u.aux = 0; return true;
    }
};
struct BranchOrder {
    int c, G;
    __device__ bool next(int i, Unit& u) const { const int t = c + (i >> 1) * G; if (t >= 256) return false; u.pm = t >> 3; u.pn = t & 7; u.aux = i & 1; return true; }
};

template <class Epi, class Sched, bool ALIGN_EPI>
__device__ __forceinline__ void gemm_phase(LAS unsigned char* lds, const Gemm g, const Sched& S, const Epi& E) {
    int tid_ = threadIdx.x; asm volatile("" : "+v"(tid_));
    const int tid = tid_, wid = __builtin_amdgcn_readfirstlane(tid >> 6), lane = tid & 63, wr = wid >> 2, wc = wid & 3, fr = lane & 15, fq = lane >> 4;
    int nt_ = g.K / BK; asm volatile("" : "+s"(nt_)); const int nt = nt_;
    unsigned voffA[2], voffB[2];
#pragma unroll
    for (int i = 0; i < 2; ++i) { int R, C; stage_rc(tid * 16 + i * 8192, R, C); const int Rb = Epi::PERM ? ((R & ~31) + perm32(R & 31)) : R;
        voffA[i] = (unsigned)(R * g.lda + C) * 2u; voffB[i] = (unsigned)(Rb * g.ldb + C) * 2u; }
    const size_t kstep = (size_t)(BK * 2);
    const size_t hstepA = (size_t)HALF * g.lda * 2, hstepB = (size_t)HALF * g.ldb * 2;
    const size_t tstepA = 2 * hstepA, tstepB = 2 * hstepB;
    const unsigned ldsw = (unsigned)wid * 1024u;
    const int aoff = lds_byte(wr * 64 + fr, fq * 8), boff = lds_byte(wc * 32 + fr, fq * 8);
#define PG8_SA(b, h) (((b) * 2 + (h)) * HTB)
#define PG8_SB(b, h) ((4 + (b) * 2 + (h)) * HTB)
#define PG8_STAGE(bufoff, gbase, voff) do { _Pragma("unroll") for (int _i = 0; _i < 2; ++_i) \
        __builtin_amdgcn_global_load_lds((const unsigned*)((const char*)(gbase) + (voff)[_i]), (LAS unsigned*)(lds + (bufoff) + ldsw + _i * 8192), 16, 0, 0); } while (0)
#define PG8_LDA(dst, b, h) do { _Pragma("unroll") for (int m = 0; m < 4; ++m) _Pragma("unroll") for (int k = 0; k < 2; ++k) dst[m][k] = *(const LAS bf16x8*)(lds + PG8_SA(b, h) + aoff + m * 2048 + k * 1024); } while (0)
#define PG8_LDB(dst, b, h) do { _Pragma("unroll") for (int n = 0; n < 2; ++n) _Pragma("unroll") for (int k = 0; k < 2; ++k) dst[n][k] = *(const LAS bf16x8*)(lds + PG8_SB(b, h) + boff + n * 2048 + k * 1024); } while (0)
#define PG8_MMA(ai, bj, At, Bt) do { __builtin_amdgcn_s_setprio(1); _Pragma("unroll") for (int m = 0; m < 4; ++m) _Pragma("unroll") for (int n = 0; n < 2; ++n) _Pragma("unroll") for (int k = 0; k < 2; ++k) \
        acc[ai][bj][m][n] = __builtin_amdgcn_mfma_f32_16x16x32_bf16(Bt[n][k], At[m][k], acc[ai][bj][m][n], 0, 0, 0); __builtin_amdgcn_s_setprio(0); } while (0)
#define PG8_WAIT_V(n) asm volatile("s_waitcnt vmcnt(" #n ")" ::: "memory")
#define PG8_WAIT_L(n) asm volatile("s_waitcnt lgkmcnt(" #n ")" ::: "memory")
#define PG8_BAR __builtin_amdgcn_s_barrier()
#define PG8_SCHED __builtin_amdgcn_sched_barrier(0)
#define PG8_UA(u) ((const char*)g.A + (size_t)(u).pm * tstepA + (size_t)(u).aux * (size_t)g.a_aux)
#define PG8_UB(u) ((const char*)g.Bt + (size_t)(u).pn * tstepB + (size_t)(u).aux * (size_t)g.b_aux)
    Unit cur, nxt; int ui = 0;
    if (!S.next(0, cur)) return;
    f32x4 acc[2][2][4][2];
#pragma unroll
    for (int a = 0; a < 2; ++a)
#pragma unroll
        for (int b = 0; b < 2; ++b)
#pragma unroll
            for (int m = 0; m < 4; ++m)
#pragma unroll
                for (int n = 0; n < 2; ++n) acc[a][b][m][n] = (f32x4){0.f, 0.f, 0.f, 0.f};
    bf16x8 At[4][2], B0[2][2], B1[2][2];
    const char* cA = PG8_UA(cur); const char* cB = PG8_UB(cur);
    PG8_STAGE(PG8_SB(0, 0), cB, voffB); PG8_STAGE(PG8_SB(0, 1), cB + hstepB, voffB); PG8_STAGE(PG8_SA(0, 0), cA, voffA); PG8_STAGE(PG8_SA(0, 1), cA + hstepA, voffA);
    if (wr == 1) PG8_BAR;
    PG8_WAIT_V(2); PG8_BAR;
    PG8_STAGE(PG8_SB(1, 0), cB + kstep, voffB); PG8_STAGE(PG8_SA(1, 0), cA + kstep, voffA); PG8_STAGE(PG8_SB(1, 1), cB + hstepB + kstep, voffB);
    PG8_WAIT_V(6); PG8_BAR;
    for (;;) {
        const bool has_next = S.next(ui + 1, nxt);
        const char* nA = has_next ? PG8_UA(nxt) : cA; const char* nB = has_next ? PG8_UB(nxt) : cB;
        for (int t = 0; t < nt; t += 2) {
            const bool last = (t == nt - 2);
            const char* a1 = cA + (size_t)(t + 1) * kstep;
            const char* a2 = last ? nA : cA + (size_t)(t + 2) * kstep; const char* b2 = last ? nB : cB + (size_t)(t + 2) * kstep;
            const char* a3 = a2 + kstep; const char* b3 = b2 + kstep;
            PG8_LDB(B0, 0, 0); PG8_LDB(B1, 0, 1); PG8_SCHED; PG8_LDA(At, 0, 0); PG8_STAGE(PG8_SA(1, 1), a1 + hstepA, voffA);
            PG8_WAIT_V(8); PG8_WAIT_L(0); PG8_BAR; PG8_MMA(0, 0, At, B0); PG8_MMA(0, 1, At, B1); PG8_BAR; PG8_SCHED;
            PG8_LDA(At, 0, 1); PG8_STAGE(PG8_SB(0, 0), b2, voffB); PG8_STAGE(PG8_SB(0, 1), b2 + hstepB, voffB); PG8_STAGE(PG8_SA(0, 0), a2, voffA);
            PG8_WAIT_V(8); PG8_WAIT_L(0); PG8_BAR; PG8_MMA(1, 0, At, B0); PG8_MMA(1, 1, At, B1); PG8_BAR; PG8_SCHED;
            PG8_LDB(B0, 1, 0); PG8_LDB(B1, 1, 1); PG8_SCHED; PG8_LDA(At, 1, 0); PG8_STAGE(PG8_SA(0, 1), a2 + hstepA, voffA);
            PG8_WAIT_V(8); PG8_WAIT_L(0); PG8_BAR; PG8_MMA(0, 0, At, B0); PG8_MMA(0, 1, At, B1); PG8_BAR; PG8_SCHED;
            PG8_LDA(At, 1, 1); PG8_STAGE(PG8_SB(1, 0), b3, voffB); PG8_STAGE(PG8_SB(1, 1), b3 + hstepB, voffB); PG8_STAGE(PG8_SA(1, 0), a3, voffA);
            PG8_WAIT_V(8); PG8_WAIT_L(0); PG8_BAR; PG8_MMA(1, 0, At, B0); PG8_MMA(1, 1, At, B1); PG8_BAR; PG8_SCHED;
        }
        if constexpr (ALIGN_EPI) { if (wr == 0) PG8_BAR; }
        { Unit eu = cur; asm volatile("" : "+s"(eu.pm), "+s"(eu.pn), "+s"(eu.aux)); E(acc, eu, wr, wc, fr, fq); }
        if (!has_next) break;
#pragma unroll
        for (int a = 0; a < 2; ++a)
#pragma unroll
            for (int b = 0; b < 2; ++b)
#pragma unroll
                for (int m = 0; m < 4; ++m)
#pragma unroll
                    for (int n = 0; n < 2; ++n) acc[a][b][m][n] = (f32x4){0.f, 0.f, 0.f, 0.f};
        cur = nxt; cA = nA; cB = nB; ++ui;
        if constexpr (ALIGN_EPI) { if (wr == 1) PG8_BAR; }
    }
    PG8_WAIT_V(0);
    if constexpr (!ALIGN_EPI) { if (wr == 0) PG8_BAR; }
    PG8_BAR;
#undef PG8_SA
#undef PG8_SB
#undef PG8_STAGE
#undef PG8_LDA
#undef PG8_LDB
#undef PG8_MMA
#undef PG8_WAIT_V
#undef PG8_WAIT_L
#undef PG8_BAR
#undef PG8_SCHED
#undef PG8_UA
#undef PG8_UB
}

__device__ __forceinline__ float row_rstd(const float* ssq, int row, int fq) {
    const f32x4 a = *(const f32x4*)(ssq + (size_t)row * 16 + 4 * fq);
    float s = (a[0] + a[1]) + (a[2] + a[3]);
    s = x16_sum(s); s = x32_sum(s);
    return __builtin_amdgcn_rsqf(s * (1.0f / DM) + RMS_EPS);
}
__device__ __forceinline__ int pos16(int o) { return 8 * ((o >> 2) & 1) + 4 * (o >> 3) + (o & 3); }

struct EpiProj {
    static constexpr bool PERM = true;
    const float* ssq; int row_base; bf16_t* QK; bf16_t* KF; bf16_t* VT; float* FL; bf16_t* GATE;
    __device__ __forceinline__ void operator()(const f32x4 (&acc)[2][2][4][2], const Unit& u, int wr, int wc, int fr, int fq) const {
        const int pn = u.pn;
        const int lrow0 = u.pm * BM + wr * 64 + fr;
        float rs[2][4];
#pragma unroll
        for (int ai = 0; ai < 2; ++ai)
#pragma unroll
            for (int m = 0; m < 4; ++m) rs[ai][m] = row_rstd(ssq, row_base + lrow0 + ai * HALF + m * 16, fq);
        const int cin = wc * 32 + 8 * fq;
        if (pn >= 19) {
#pragma unroll
            for (int ai = 0; ai < 2; ++ai)
#pragma unroll
                for (int m = 0; m < 4; ++m) { const int lrow = lrow0 + ai * HALF + m * 16; const float s = rs[ai][m];
#pragma unroll
                    for (int bj = 0; bj < 2; ++bj) { const f32x4 v0 = acc[ai][bj][m][0] * s, v1 = acc[ai][bj][m][1] * s;
                        u32x4 w; w.x = cvtpk(v0[0], v0[1]); w.y = cvtpk(v0[2], v0[3]); w.z = cvtpk(v1[0], v1[1]); w.w = cvtpk(v1[2], v1[3]);
                        *(u32x4*)(GATE + (size_t)lrow * 4096 + (pn - 19) * 256 + bj * HALF + cin) = w; } }
        } else if (pn == 18) {
            if (wc == 0 && fq == 0) {
#pragma unroll
                for (int ai = 0; ai < 2; ++ai)
#pragma unroll
                    for (int m = 0; m < 4; ++m) { const int lrow = lrow0 + ai * HALF + m * 16; *(f32x4*)(FL + (size_t)lrow * 4) = acc[ai][0][m][0] * rs[ai][m]; }
            }
        } else if (pn == 2 || (pn >= 9 && pn <= 11) || pn == 14 || pn == 17) {
            int vhb, rsh;
            if (pn == 2) { vhb = 0; rsh = 0; } else if (pn == 14) { vhb = 16; rsh = 0; } else if (pn == 17) { vhb = 20; rsh = 0; } else { const int gI = pn - 9; vhb = 4 + 4 * gI; rsh = 2 * gI; }
            const int slsh = 11 - rsh, rmask = (1 << rsh) - 1;
#pragma unroll
            for (int ai = 0; ai < 2; ++ai)
#pragma unroll
                for (int m = 0; m < 4; ++m) { const int lrow = lrow0 + ai * HALF + m * 16; const float s = rs[ai][m];
                    const int bl = lrow >> 11, t = lrow & (SEQ - 1); int p = ((t & rmask) << slsh) + (t >> rsh); p = (p & ~15) | pos16(p & 15);
                    const int kb = p >> 5, q = p & 31;
                    bf16_t* base = VT + (size_t)(bl * 24 + vhb) * HSEQ + (size_t)kb * 2048 + (q >> 4) * 512 + ((q >> 3) & 1) * 256 + (q & 7);
#pragma unroll
                    for (int bj = 0; bj < 2; ++bj) { const int c0 = bj * HALF + cin;
                        bf16_t* bp = base + (size_t)(c0 >> 6) * HSEQ + ((c0 >> 5) & 1) * 1024 + (c0 & 31) * 8;
                        const f32x4 v0 = acc[ai][bj][m][0] * s, v1 = acc[ai][bj][m][1] * s;
                        const unsigned w0 = cvtpk(v0[0], v0[1]), w1 = cvtpk(v0[2], v0[3]), w2 = cvtpk(v1[0], v1[1]), w3 = cvtpk(v1[2], v1[3]);
                        bp[0 * 8] = (bf16_t)(w0 & 0xffff); bp[1 * 8] = (bf16_t)(w0 >> 16); bp[2 * 8] = (bf16_t)(w1 & 0xffff); bp[3 * 8] = (bf16_t)(w1 >> 16);
                        bp[4 * 8] = (bf16_t)(w2 & 0xffff); bp[5 * 8] = (bf16_t)(w2 >> 16); bp[6 * 8] = (bf16_t)(w3 & 0xffff); bp[7 * 8] = (bf16_t)(w3 >> 16); } }
        } else {
            const bool isK = (pn == 1) || (pn >= 6 && pn <= 8) || pn == 13 || pn == 16;
            int slot = 0, khb = 0, rsh = 0;
            if (pn <= 1) { slot = 0; khb = 0; } else if (pn <= 8) { const int gI = (pn - 3) % 3; rsh = 2 * gI; slot = 1 + gI; khb = 4 + 4 * gI; } else if (pn <= 13) { slot = 4; khb = 16; } else { slot = 5; khb = 20; }
            const int slsh = 11 - rsh, rmask = (1 << rsh) - 1;
#pragma unroll
            for (int ai = 0; ai < 2; ++ai)
#pragma unroll
                for (int m = 0; m < 4; ++m) { const int lrow = lrow0 + ai * HALF + m * 16; const float s = rs[ai][m];
                    const int bl = lrow >> 11, t = lrow & (SEQ - 1); const int p = ((t & rmask) << slsh) + (t >> rsh);
#pragma unroll
                    for (int bj = 0; bj < 2; ++bj) { const f32x4 v0 = acc[ai][bj][m][0] * s, v1 = acc[ai][bj][m][1] * s;
                        u32x4 w; w.x = cvtpk(v0[0], v0[1]); w.y = cvtpk(v0[2], v0[3]); w.z = cvtpk(v1[0], v1[1]); w.w = cvtpk(v1[2], v1[3]);
                        const int c0 = bj * HALF + cin;
                        if (isK) { const int dcol = c0 & 63;
                            *(u32x4*)(KF + (size_t)(bl * 24 + khb + (c0 >> 6)) * HSEQ + (size_t)(p >> 5) * 2048 + (dcol >> 4) * 512 + (((dcol >> 3) & 1) * 32 + (p & 31)) * 8) = w; }
                        else *(u32x4*)(QK + (size_t)(bl * SEQ + p) * LDQK + slot * 256 + c0) = w; } }
        }
    }
};

struct EpiBranch {
    static constexpr bool PERM = true;
    const bf16_t* GATE; bf16_t* MERGED; int row_base;
    __device__ __forceinline__ static float sg(float g) { return __builtin_amdgcn_rcpf(1.0f + ex2(-g * LOG2E)); }
    __device__ __forceinline__ static u32x4 mix(const u32x4 ga, const u32x4 gb, const u32x4 ow, const f32x4 a0, const f32x4 a1, const f32x4 b0, const f32x4 b1) {
        const float o0 = sg(bflo(ga.x)) * a0[0] + sg(bflo(gb.x)) * b0[0] + bflo(ow.x), o1 = sg(bfhi(ga.x)) * a0[1] + sg(bfhi(gb.x)) * b0[1] + bfhi(ow.x);
        const float o2 = sg(bflo(ga.y)) * a0[2] + sg(bflo(gb.y)) * b0[2] + bflo(ow.y), o3 = sg(bfhi(ga.y)) * a0[3] + sg(bfhi(gb.y)) * b0[3] + bfhi(ow.y);
        const float o4 = sg(bflo(ga.z)) * a1[0] + sg(bflo(gb.z)) * b1[0] + bflo(ow.z), o5 = sg(bfhi(ga.z)) * a1[1] + sg(bfhi(gb.z)) * b1[1] + bfhi(ow.z);
        const float o6 = sg(bflo(ga.w)) * a1[2] + sg(bflo(gb.w)) * b1[2] + bflo(ow.w), o7 = sg(bfhi(ga.w)) * a1[3] + sg(bfhi(gb.w)) * b1[3] + bfhi(ow.w);
        u32x4 w; w.x = cvtpk(o0, o1); w.y = cvtpk(o2, o3); w.z = cvtpk(o4, o5); w.w = cvtpk(o6, o7); return w;
    }
    __device__ __forceinline__ void operator()(const f32x4 (&acc)[2][2][4][2], const Unit& u, int wr, int wc, int fr, int fq) const {
        const int p = u.aux; const int lrow0 = u.pm * BM + wr * 64 + fr; const int d0 = u.pn * 128 + wc * 32 + 8 * fq;
        const bf16_t* gbase = GATE + (size_t)lrow0 * 4096 + (2 * p) * 1024 + d0; bf16_t* mbase = MERGED + (size_t)(row_base + lrow0) * DM + d0;
        const u32x4 zero = {0u, 0u, 0u, 0u};
#pragma unroll
        for (int ai = 0; ai < 2; ++ai)
#pragma unroll
            for (int mp = 0; mp < 2; ++mp) {
                u32x4 ga[2], gb[2], ow[2];
#pragma unroll
                for (int mm = 0; mm < 2; ++mm) { const size_t ro = (size_t)(ai * HALF + (2 * mp + mm) * 16);
                    ga[mm] = *(const u32x4*)(gbase + ro * 4096); gb[mm] = *(const u32x4*)(gbase + ro * 4096 + 1024);
                    ow[mm] = zero; if (p > 0) ow[mm] = *(const u32x4*)(mbase + ro * DM); }
#pragma unroll
                for (int mm = 0; mm < 2; ++mm) { const int m = 2 * mp + mm; const size_t ro = (size_t)(ai * HALF + m * 16);
                    *(u32x4*)(mbase + ro * DM) = mix(ga[mm], gb[mm], ow[mm], acc[ai][0][m][0], acc[ai][0][m][1], acc[ai][1][m][0], acc[ai][1][m][1]); }
                asm volatile("" ::: "memory");
            }
    }
};

struct EpiResid {
    static constexpr bool PERM = true;
    const float* Xin; float* X; bf16_t* XB; float* ssq;
    __device__ __forceinline__ void operator()(const f32x4 (&acc)[2][2][4][2], const Unit& u, int wr, int wc, int fr, int fq) const {
        const int row0 = u.pm * BM + wr * 64 + fr; const int col0 = u.pn * BM + wc * 32 + 8 * fq;
#pragma unroll
        for (int ai = 0; ai < 2; ++ai)
#pragma unroll
            for (int m = 0; m < 4; ++m) { const int row = row0 + ai * HALF + m * 16; float sq = 0.f;
#pragma unroll
                for (int bj = 0; bj < 2; ++bj) { const int col = col0 + bj * HALF; f32x4* xp = (f32x4*)(X + (size_t)row * DM + col); const f32x4* xi = (const f32x4*)(Xin + (size_t)row * DM + col);
                    const f32x4 x0 = xi[0] + acc[ai][bj][m][0], x1 = xi[1] + acc[ai][bj][m][1];
                    xp[0] = x0; xp[1] = x1;
                    u32x4 w; w.x = cvtpk(x0[0], x0[1]); w.y = cvtpk(x0[2], x0[3]); w.z = cvtpk(x1[0], x1[1]); w.w = cvtpk(x1[2], x1[3]);
                    *(u32x4*)(XB + (size_t)row * DM + col) = w;
                    sq += (x0[0] * x0[0] + x0[1] * x0[1]) + (x0[2] * x0[2] + x0[3] * x0[3]) + (x1[0] * x1[0] + x1[1] * x1[1]) + (x1[2] * x1[2] + x1[3] * x1[3]); }
                sq = x16_sum(sq); sq = x32_sum(sq);
                if (fq == 0) ssq[(size_t)row * 16 + u.pn * 4 + wc] = sq; if (m & 1) asm volatile("" ::: "memory"); }
    }
};

struct EpiFinal {
    static constexpr bool PERM = true;
    const float* X; float* out; float* ssq; const float* gfin; unsigned* cnt;
    __device__ __forceinline__ void operator()(f32x4 (&acc)[2][2][4][2], const Unit& u, int wr, int wc, int fr, int fq) const {
        const int row0 = u.pm * BM + wr * 64 + fr; const int col0 = u.pn * BM + wc * 32 + 8 * fq;
#pragma unroll
        for (int ai = 0; ai < 2; ++ai)
#pragma unroll
            for (int m = 0; m < 4; ++m) { const int row = row0 + ai * HALF + m * 16; float sq = 0.f;
#pragma unroll
                for (int bj = 0; bj < 2; ++bj) { const f32x4* xi = (const f32x4*)(X + (size_t)row * DM + col0 + bj * HALF);
                    const f32x4 x0 = xi[0] + acc[ai][bj][m][0], x1 = xi[1] + acc[ai][bj][m][1];
                    acc[ai][bj][m][0] = x0; acc[ai][bj][m][1] = x1;
                    sq += (x0[0] * x0[0] + x0[1] * x0[1]) + (x0[2] * x0[2] + x0[3] * x0[3]) + (x1[0] * x1[0] + x1[1] * x1[1]) + (x1[2] * x1[2] + x1[3] * x1[3]); }
                sq = x16_sum(sq); sq = x32_sum(sq);
                if (fq == 0) __hip_atomic_store(ssq + (size_t)row * 16 + u.pn * 4 + wc, sq, __ATOMIC_RELAXED, __HIP_MEMORY_SCOPE_AGENT);
                if (m & 1) asm volatile("" ::: "memory"); }
        asm volatile("s_waitcnt vmcnt(0)" ::: "memory");
        unsigned* c = cnt + 64 * u.pm;
        if ((fr | fq) == 0) {
            __hip_atomic_fetch_add(c, 1u, __ATOMIC_RELAXED, __HIP_MEMORY_SCOPE_AGENT);
            unsigned sp = 0;
            while (__hip_atomic_load(c, __ATOMIC_RELAXED, __HIP_MEMORY_SCOPE_AGENT) < 32u) { __builtin_amdgcn_s_sleep(2); if (++sp > (1u << 22)) break; }
        }
        __builtin_amdgcn_fence(__ATOMIC_ACQUIRE, "agent");
        asm volatile("s_waitcnt vmcnt(0)" ::: "memory");
        float rs[2][4];
#pragma unroll
        for (int ai = 0; ai < 2; ++ai)
#pragma unroll
            for (int m = 0; m < 4; ++m) rs[ai][m] = row_rstd(ssq, row0 + ai * HALF + m * 16, fq);
#pragma unroll
        for (int bj = 0; bj < 2; ++bj) { const f32x4 g0 = *(const f32x4*)(gfin + col0 + bj * HALF), g1 = *(const f32x4*)(gfin + col0 + bj * HALF + 4);
#pragma unroll
            for (int ai = 0; ai < 2; ++ai)
#pragma unroll
                for (int m = 0; m < 4; ++m) { const int row = row0 + ai * HALF + m * 16; f32x4* op = (f32x4*)(out + (size_t)row * DM + col0 + bj * HALF);
                    op[0] = acc[ai][bj][m][0] * rs[ai][m] * g0; op[1] = acc[ai][bj][m][1] * rs[ai][m] * g1; } }
    }
};

struct EpiUp {
    static constexpr bool PERM = true;
    const float* ssq; bf16_t* H;
    __device__ __forceinline__ void operator()(const f32x4 (&acc)[2][2][4][2], const Unit& u, int wr, int wc, int fr, int fq) const {
        const int row0 = u.pm * BM + wr * 64 + fr; const int col0 = u.pn * BM + wc * 32 + 8 * fq;
        float rs[2][4];
#pragma unroll
        for (int ai = 0; ai < 2; ++ai)
#pragma unroll
            for (int m = 0; m < 4; ++m) rs[ai][m] = row_rstd(ssq, row0 + ai * HALF + m * 16, fq);
#pragma unroll
        for (int ai = 0; ai < 2; ++ai)
#pragma unroll
            for (int m = 0; m < 4; ++m) { const int row = row0 + ai * HALF + m * 16; const float s = rs[ai][m];
#pragma unroll
                for (int bj = 0; bj < 2; ++bj) { f32x4 v0 = acc[ai][bj][m][0] * s, v1 = acc[ai][bj][m][1] * s;
#pragma unroll
                    for (int i = 0; i < 4; ++i) { const float a = fmaxf(v0[i], 0.f), b = fmaxf(v1[i], 0.f); v0[i] = a * a; v1[i] = b * b; }
                    u32x4 w; w.x = cvtpk(v0[0], v0[1]); w.y = cvtpk(v0[2], v0[3]); w.z = cvtpk(v1[0], v1[1]); w.w = cvtpk(v1[2], v1[3]);
                    *(u32x4*)(H + (size_t)row * DFF + col0 + bj * HALF) = w; } }
    }
};
}

__device__ __forceinline__ int win_src(int n) {
    if (n < 3840) return n;
    if (n < 4608) return n + 4;
    if (n < 4864) return (n - 4608 < 4) ? 3840 + (n - 4608) : -1;
    return n - 4864 + 4612;
}
template <int CMAP>
__device__ __forceinline__ void transpose_item(const float* W, int K, int N, int Nsrc, const float* gain, bf16_t* WT, LAS float* scr, int item, int lane) {
    const int nblk = N / 32, kb = item / nblk, nb = item % nblk, k0 = 64 * kb, n0 = 32 * nb;
    const int n = n0 + (lane & 31); const int src = CMAP ? win_src(n) : n;
    const bool live = (src >= 0); const float* wp = W + (size_t)(k0 + (lane >> 5)) * Nsrc + (live ? src : 0); const float* gp = gain ? gain + k0 + (lane >> 5) : nullptr;
    float wv[32];
#pragma unroll
    for (int i = 0; i < 32; ++i) wv[i] = wp[(size_t)(2 * i) * Nsrc];
#pragma unroll
    for (int i = 0; i < 32; ++i) { float v = live ? wv[i] : 0.f; if (gp) v *= gp[2 * i]; scr[(2 * i + (lane >> 5)) * 33 + (lane & 31)] = v; }
    asm volatile("s_waitcnt lgkmcnt(0)" ::: "memory");
    const int c = lane & 7;
#pragma unroll
    for (int j = 0; j < 4; ++j) { const int nn = (lane >> 3) + 8 * j; const LAS float* s = scr + (8 * c) * 33 + nn;
        u32x4 o; o.x = cvtpk(s[0 * 33], s[1 * 33]); o.y = cvtpk(s[2 * 33], s[3 * 33]); o.z = cvtpk(s[4 * 33], s[5 * 33]); o.w = cvtpk(s[6 * 33], s[7 * 33]);
        *(u32x4*)(WT + (size_t)(n0 + nn) * K + k0 + 8 * c) = o; }
    asm volatile("s_waitcnt lgkmcnt(0)" ::: "memory");
}

__device__ __forceinline__ void branch_item(const float* Wn, int n, bf16_t* WBP, LAS float* scr, int item, int lane) {
    const int kb = item >> 5, nb = item & 31, k0 = 64 * kb, n0 = 32 * nb;
    const float* wp = Wn + (size_t)(k0 + (lane >> 5)) * DM + n0 + (lane & 31);
    float wv[32];
#pragma unroll
    for (int i = 0; i < 32; ++i) wv[i] = wp[(size_t)(2 * i) * DM];
#pragma unroll
    for (int i = 0; i < 32; ++i) scr[(2 * i + (lane >> 5)) * 33 + (lane & 31)] = wv[i];
    asm volatile("s_waitcnt lgkmcnt(0)" ::: "memory");
    const int c = lane & 7, bj = n & 1, pair = n >> 1;
    const u32x4 zero = {0u, 0u, 0u, 0u};
#pragma unroll
    for (int j = 0; j < 4; ++j) { const int nn = (lane >> 3) + 8 * j; const LAS float* sp = scr + (8 * c) * 33 + nn; const int d = n0 + nn;
        u32x4 o; o.x = cvtpk(sp[0 * 33], sp[1 * 33]); o.y = cvtpk(sp[2 * 33], sp[3 * 33]); o.z = cvtpk(sp[4 * 33], sp[5 * 33]); o.w = cvtpk(sp[6 * 33], sp[7 * 33]);
        bf16_t* row = WBP + ((size_t)((pair * 8 + (d >> 7)) * 256 + bj * 128 + (d & 127))) * 512 + k0 + 8 * c;
        *(u32x4*)(row + 256 * bj) = o; *(u32x4*)(row + 256 * (1 - bj)) = zero; }
    asm volatile("s_waitcnt lgkmcnt(0)" ::: "memory");
}

#define MFMA32(a, b, c) __builtin_amdgcn_mfma_f32_32x32x16_bf16((a), (b), (c), 0, 0, 0)
__device__ __forceinline__ bf16x8 ld16(const bf16_t* p) { return *(const bf16x8*)p; }
__device__ __forceinline__ bf16x8 pack8(const f32x16& s, int b) { u32x4 w; w.x = cvtpk(s[b], s[b + 1]); w.y = cvtpk(s[b + 2], s[b + 3]); w.z = cvtpk(s[b + 4], s[b + 5]); w.w = cvtpk(s[b + 6], s[b + 7]); return __builtin_bit_cast(bf16x8, w); }
__device__ __forceinline__ int crow(int r, int hi) { return (r & 3) + 8 * (r >> 2) + 4 * hi; }
__device__ __forceinline__ void store_o(bf16_t* orow, const f32x16& o0, const f32x16& o1, int hi) {
#pragma unroll
    for (int g = 0; g < 4; ++g) {
        u32x2 a; a.x = cvtpk(o0[4 * g], o0[4 * g + 1]); a.y = cvtpk(o0[4 * g + 2], o0[4 * g + 3]); *(u32x2*)(orow + 8 * g + 4 * hi) = a;
        u32x2 b; b.x = cvtpk(o1[4 * g], o1[4 * g + 1]); b.y = cvtpk(o1[4 * g + 2], o1[4 * g + 3]); *(u32x2*)(orow + 32 + 8 * g + 4 * hi) = b; }
}

struct KFrag { bf16x8 k[4]; };
struct VFrag { bf16x8 v[4]; };
__device__ __forceinline__ void k_load(KFrag& f, const bf16_t* Kh, int kb, int lane) {
    const bf16_t* kp = Kh + (size_t)kb * 2048 + lane * 8;
#pragma unroll
    for (int ds = 0; ds < 4; ++ds) f.k[ds] = ld16(kp + ds * 512);
}
__device__ __forceinline__ void v_load(VFrag& f, const bf16_t* Vh, int kb, int lane) {
    const bf16_t* vp = Vh + (size_t)kb * 2048 + lane * 8;
    f.v[0] = ld16(vp); f.v[1] = ld16(vp + 512); f.v[2] = ld16(vp + 1024); f.v[3] = ld16(vp + 1536);
}
__device__ __forceinline__ void q_load(bf16x8 (&qf)[4], const bf16_t* Qs, int qb, int r32, int hi) {
    const bf16_t* qp = Qs + (size_t)(qb * 32 + r32) * LDQK + hi * 8;
#pragma unroll
    for (int ds = 0; ds < 4; ++ds) qf[ds] = ld16(qp + ds * 16);
}

template <int MODE, bool MASK, int NDS>
__device__ __forceinline__ void sm_step(const bf16x8 (&ck)[NDS], const bf16x8 (&qf)[NDS], const VFrag& cv, float slope2, const LAS float* cl, int kb, int d0,
                                        float& m, float& l, f32x16& o0, f32x16& o1, int hi) {
    constexpr float SC2 = ((MODE == 2) ? 0.17677669529663687f : 0.125f) * LOG2E;
    f32x16 s;
#pragma unroll
    for (int i = 0; i < 16; ++i) s[i] = 0.f;
#pragma unroll
    for (int ds = 0; ds < NDS; ++ds) s = MFMA32(ck[ds], qf[ds], s);
#define KC(r) (((r) & 3) + 8 * ((r) >> 2))
    int dh = d0 - 4 * hi; asm volatile("" : "+v"(dh));
    float sl = slope2; asm volatile("" : "+v"(sl));
    const LAS float* clk = cl + 33 * kb + 4 * hi; if (MODE == 0) asm volatile("" : "+v"(clk));
    const float base = (MODE == 0) ? 0.f : -sl * (float)dh;
#pragma unroll
    for (int r = 0; r < 16; ++r) {
        float v = (MODE == 0) ? fmaf(s[r], SC2, clk[KC(r)]) : fmaf(s[r], SC2, sl * (float)KC(r));
        if (MASK) { const int dist = dh - KC(r); const bool valid = (MODE == 1) ? ((unsigned)dist <= 128u) : (dist >= 0); v = valid ? v : -INFINITY; }
        s[r] = v;
    }
#undef KC
    float mt = fmaxf(fmaxf(s[0], s[1]), fmaxf(s[2], s[3]));
#pragma unroll
    for (int r = 4; r < 16; r += 4) mt = fmaxf(mt, fmaxf(fmaxf(s[r], s[r + 1]), fmaxf(s[r + 2], s[r + 3])));
    mt = x32_max(mt + base);
    const float mn = fmaxf(m, mt), alpha = ex2(m - mn), c = mn - base;
    float ps = 0.f;
#pragma unroll
    for (int r = 0; r < 16; ++r) { const float p = ex2(s[r] - c); s[r] = p; ps += p; }
    l = l * alpha + ps; m = mn;
#pragma unroll
    for (int i = 0; i < 16; ++i) { o0[i] *= alpha; o1[i] *= alpha; }
    const bf16x8 pf0 = pack8(s, 0), pf1 = pack8(s, 8);
    o0 = MFMA32(cv.v[0], pf0, o0); o0 = MFMA32(cv.v[1], pf1, o0); o1 = MFMA32(cv.v[2], pf0, o1); o1 = MFMA32(cv.v[3], pf1, o1);
}
template <int MODE>
__device__ __forceinline__ void sm_unit(const bf16_t* Qs, const bf16_t* Ks, const bf16_t* VTs, int qb, int kb_hi, int kb_lo, float slope2, const LAS float* cl,
                                        f32x16& o0, f32x16& o1, float& m_out, float& l_out, int lane) {
    const int r32 = lane & 31, hi = lane >> 5;
    constexpr int NDS = (MODE == 2) ? 2 : 4;
    bf16x8 qf[NDS];
    { const bf16_t* qp = Qs + (size_t)(qb * 32 + r32) * LDQK + hi * 8;
#pragma unroll
      for (int ds = 0; ds < NDS; ++ds) qf[ds] = ld16(qp + ds * 16); }
    bf16x8 nk[NDS];
    { const bf16_t* kp = Ks + (size_t)kb_hi * 2048 + lane * 8;
#pragma unroll
      for (int ds = 0; ds < NDS; ++ds) nk[ds] = ld16(kp + ds * 512); }
    float m = -INFINITY, l = 0.f;
#pragma unroll
    for (int i = 0; i < 16; ++i) { o0[i] = 0.f; o1[i] = 0.f; }
    for (int kb = kb_hi; kb >= kb_lo; --kb) {
        bf16x8 ck[NDS];
#pragma unroll
        for (int ds = 0; ds < NDS; ++ds) ck[ds] = nk[ds];
        VFrag cv; v_load(cv, VTs, kb, lane);
        if (kb > kb_lo) { const bf16_t* kp = Ks + (size_t)(kb - 1) * 2048 + lane * 8;
#pragma unroll
            for (int ds = 0; ds < NDS; ++ds) nk[ds] = ld16(kp + ds * 512); }
        const int d0 = (qb - kb) * 32 + r32;
        const bool edge = (MODE == 1) ? (kb == qb || kb + 4 <= qb) : (kb == qb);
        if (edge) sm_step<MODE, true, NDS>(ck, qf, cv, slope2, cl, kb, d0, m, l, o0, o1, hi);
        else      sm_step<MODE, false, NDS>(ck, qf, cv, slope2, cl, kb, d0, m, l, o0, o1, hi);
    }
    l = x32_sum(l);
    m_out = m; l_out = l;
}

template <int MODE>
__device__ __forceinline__ void sm_unit64(const bf16_t* Qs, const bf16_t* Ks, const bf16_t* VTs, int Q, int kb_hi, int kb_lo, float slope2, const LAS float* cl,
                                          f32x16 (&o)[2][2], float (&m)[2], float (&l)[2], int lane) {
    const int r32 = lane & 31, hi = lane >> 5;
    constexpr int NDS = (MODE == 2) ? 2 : 4;
    bf16x8 qf[2][NDS];
#pragma unroll
    for (int i = 0; i < 2; ++i) { const bf16_t* qp = Qs + (size_t)((2 * Q + i) * 32 + r32) * LDQK + hi * 8;
#pragma unroll
        for (int ds = 0; ds < NDS; ++ds) qf[i][ds] = ld16(qp + ds * 16); }
    bf16x8 nk[NDS];
    { const bf16_t* kp = Ks + (size_t)kb_hi * 2048 + lane * 8;
#pragma unroll
      for (int ds = 0; ds < NDS; ++ds) nk[ds] = ld16(kp + ds * 512); }
#pragma unroll
    for (int i = 0; i < 2; ++i) { m[i] = -INFINITY; l[i] = 0.f;
#pragma unroll
        for (int k = 0; k < 16; ++k) { o[i][0][k] = 0.f; o[i][1][k] = 0.f; } }
    for (int kb = kb_hi; kb >= kb_lo; --kb) {
        bf16x8 ck[NDS];
#pragma unroll
        for (int ds = 0; ds < NDS; ++ds) ck[ds] = nk[ds];
        VFrag cv; v_load(cv, VTs, kb, lane);
        if (kb > kb_lo) { const bf16_t* kp = Ks + (size_t)(kb - 1) * 2048 + lane * 8;
#pragma unroll
            for (int ds = 0; ds < NDS; ++ds) nk[ds] = ld16(kp + ds * 512); }
        if (kb < 2 * Q) {
            const int d00 = (2 * Q - kb) * 32 + r32;
            sm_step<MODE, false, NDS>(ck, qf[0], cv, slope2, cl, kb, d00, m[0], l[0], o[0][0], o[0][1], hi);
            sm_step<MODE, false, NDS>(ck, qf[1], cv, slope2, cl, kb, d00 + 32, m[1], l[1], o[1][0], o[1][1], hi);
        } else {
#pragma unroll
            for (int i = 0; i < 2; ++i) {
                const int qbi = 2 * Q + i;
                if (kb <= qbi) {
                    const int d0 = (qbi - kb) * 32 + r32;
                    if (kb == qbi) sm_step<MODE, true, NDS>(ck, qf[i], cv, slope2, cl, kb, d0, m[i], l[i], o[i][0], o[i][1], hi);
                    else           sm_step<MODE, false, NDS>(ck, qf[i], cv, slope2, cl, kb, d0, m[i], l[i], o[i][0], o[i][1], hi);
                }
            }
        }
    }
    l[0] = x32_sum(l[0]); l[1] = x32_sum(l[1]);
}

__device__ __forceinline__ void sb_unit(const bf16_t* Qs, const bf16_t* Ks, const bf16_t* VTs, int qb, f32x16& o0, f32x16& o1, int lane) {
    const int r32 = lane & 31, hi = lane >> 5;
    constexpr float SC2 = 0.125f * LOG2E;
    bf16x8 qf[4]; q_load(qf, Qs, qb, r32, hi);
    KFrag nx; k_load(nx, Ks, qb, lane);
    float R = 0.f;
#pragma unroll
    for (int i = 0; i < 16; ++i) { o0[i] = 0.f; o1[i] = 0.f; }
    for (int kb = qb; kb >= 0; --kb) {
        const KFrag cu = nx; VFrag cv; v_load(cv, VTs, kb, lane);
        if (kb > 0) k_load(nx, Ks, kb - 1, lane);
        f32x16 s;
#pragma unroll
        for (int i = 0; i < 16; ++i) s[i] = 0.f;
#pragma unroll
        for (int ds = 0; ds < 4; ++ds) s = MFMA32(cu.k[ds], qf[ds], s);
        float lk[16], ls[16];
        const int d0 = (qb - kb) * 32 + r32;
#pragma unroll
        for (int r = 0; r < 16; ++r) { const float z2 = s[r] * SC2; const float sp = fmaxf(z2, 0.f) + lg2(1.0f + ex2(-fabsf(z2))); const bool valid = crow(r, hi) < d0; lk[r] = valid ? -sp : 0.f; ls[r] = valid ? (z2 - sp) : -INFINITY; }
        float e[16], tq[4], pq[4];
#pragma unroll
        for (int g = 0; g < 4; ++g) { e[4 * g + 3] = 0.f; e[4 * g + 2] = lk[4 * g + 3]; e[4 * g + 1] = e[4 * g + 2] + lk[4 * g + 2]; e[4 * g] = e[4 * g + 1] + lk[4 * g + 1]; tq[g] = e[4 * g] + lk[4 * g]; }
#pragma unroll
        for (int g = 0; g < 4; ++g) pq[g] = x32_partner(tq[g], hi);
        float cs[4]; cs[3] = 0.f; cs[2] = tq[3] + pq[3]; cs[1] = cs[2] + (tq[2] + pq[2]); cs[0] = cs[1] + (tq[1] + pq[1]);
        const float total = cs[0] + (tq[0] + pq[0]);
#pragma unroll
        for (int g = 0; g < 4; ++g) { const float later = R + cs[g] + (hi == 0 ? pq[g] : 0.f);
#pragma unroll
            for (int i = 0; i < 4; ++i) s[4 * g + i] = ex2(ls[4 * g + i] + e[4 * g + i] + later); }
        R += total;
        const bf16x8 pf0 = pack8(s, 0), pf1 = pack8(s, 8);
        o0 = MFMA32(cv.v[0], pf0, o0); o0 = MFMA32(cv.v[1], pf1, o0); o1 = MFMA32(cv.v[2], pf0, o1); o1 = MFMA32(cv.v[3], pf1, o1);
        if (__all(R < -150.0f)) break;
    }
}

#define XB_TMO      128
#define XB_XCNT(j)  (256  + 64 * (j))
#define XB_XSUB(j)  (1280 + 64 * (j))
#define XB_XGEN(j)  (2304 + 64 * (j))
#define XB_TOP      3328
#define XB_TOPGEN   3392
#define XCD_BAR_WORDS 3456
#define XB_SPIN_CAP (1u << 18)
__device__ __forceinline__ unsigned xb_ld(unsigned* p)              { return __hip_atomic_load(p, __ATOMIC_RELAXED, __HIP_MEMORY_SCOPE_AGENT); }
__device__ __forceinline__ unsigned xb_add(unsigned* p, unsigned v) { return __hip_atomic_fetch_add(p, v, __ATOMIC_RELAXED, __HIP_MEMORY_SCOPE_AGENT); }
__device__ __forceinline__ unsigned xb_xcc_id() { return (unsigned)__builtin_amdgcn_s_getreg((3 << 11) | 20) & 0xFu; }
#define XB_SPIN(cond, bar) do { unsigned _sp = 0; while (cond) { __builtin_amdgcn_s_sleep(1); \
    if ((++_sp & 255u) == 0u) { if (xb_ld(&(bar)[XB_TMO])) break; if (_sp > XB_SPIN_CAP) { atomicAdd(&(bar)[XB_TMO], 1u); break; } } } } while (0)
__device__ __forceinline__ void xcd_barrier_complete(unsigned* bar, unsigned x, unsigned& nloc, unsigned& nx) {
    const unsigned G = gridDim.x * gridDim.y * gridDim.z;
    unsigned sum, cnt, mine, sp = 0u;
    for (;;) {
        sum = 0u; cnt = 0u; mine = 0u;
#pragma unroll
        for (unsigned j = 0; j < 16; ++j) { const unsigned c = xb_ld(&bar[XB_XCNT(j)]); sum += c; cnt += (c > 0u) ? 1u : 0u; mine = (j == x) ? c : mine; }
        if (sum == G) break;
        __builtin_amdgcn_s_sleep(1);
        if ((++sp & 255u) == 0u) { if (xb_ld(&bar[XB_TMO])) break; if (sp > XB_SPIN_CAP) { atomicAdd(&bar[XB_TMO], 1u); break; } }
    }
    nloc = mine > 0u ? mine : 1u; nx = cnt > 0u ? cnt : 1u;
}
__device__ __forceinline__ void xcd_barrier(unsigned* bar, volatile LAS unsigned* st) {
    asm volatile("s_waitcnt vmcnt(0)" ::: "memory");
    __syncthreads();
    if (threadIdx.x == 0) {
        const unsigned x = xb_xcc_id();
        __builtin_amdgcn_s_waitcnt(0);
        unsigned nloc = st[0], nx = st[1];
        if (nloc == 0u) { xcd_barrier_complete(bar, x, nloc, nx); st[0] = nloc; st[1] = nx; }
        const unsigned old = xb_add(&bar[XB_XSUB(x)], 1u);
        const unsigned gen = old / nloc;
        if (old + 1u == (gen + 1u) * nloc) {
            __builtin_amdgcn_fence(__ATOMIC_RELEASE, "agent");
            asm volatile("s_waitcnt vmcnt(0)" ::: "memory");
            const unsigned og = xb_add(&bar[XB_TOP], 1u);
            const unsigned tg = og / nx;
            if (og + 1u == (tg + 1u) * nx) xb_add(&bar[XB_TOPGEN], 1u);
            else XB_SPIN(xb_ld(&bar[XB_TOPGEN]) == tg, bar);
            __builtin_amdgcn_fence(__ATOMIC_ACQUIRE, "agent");
            xb_add(&bar[XB_XGEN(x)], 1u);
            asm volatile("s_waitcnt vmcnt(0)" ::: "memory");
        } else {
            XB_SPIN(xb_ld(&bar[XB_XGEN(x)]) == gen, bar);
            __builtin_amdgcn_fence(__ATOMIC_ACQUIRE, "agent");
            asm volatile("s_waitcnt vmcnt(0)" ::: "memory");
        }
    }
    __syncthreads();
}
constexpr int MISC_OFF = 131072 + 320;

struct Params {
    const float* x; const float* mix_g; const float* w_in; const float* b_forget; const float* lq1; const float* lk1; const float* lq2; const float* lk2;
    const float* diff_g; const float* w_branch; const float* w_out; const float* mlp_g; const float* w_up; const float* w_down; const float* final_g;
    float* out; unsigned char* ws;
};

#ifndef REP_P1
#define REP_P1 1
#endif
#ifndef REP_P2
#define REP_P2 1
#endif
#ifndef REP_P3
#define REP_P3 1
#endif
#ifndef REP_P5
#define REP_P5 1
#endif
#ifndef REP_SYNC
#define REP_SYNC 1
#endif
#ifndef REP_CONV
#define REP_CONV 1
#endif
#define GSYNC() do { for (int rs_ = 0; rs_ < REP_SYNC; ++rs_) { KParamsPtr pb_ = OPQ_PP(); xcd_barrier((unsigned*)(pb_->ws + WS_CTL) + CW_BAR, (volatile LAS unsigned*)(lds + MISC_OFF)); } } while (0)
#define OPQ_TID() ({ int t_ = threadIdx.x; asm volatile("" : "+v"(t_)); t_; })
typedef const __attribute__((address_space(4))) Params* KParamsPtr;
#define OPQ_PP() ({ KParamsPtr p_ = (KParamsPtr)__builtin_amdgcn_kernarg_segment_ptr(); asm volatile("" : "+s"(p_)); p_; })
#define PHASE_VARS() const int tid = OPQ_TID(); const int lane = tid & 63, wave = __builtin_amdgcn_readfirstlane(tid >> 6); const int G = gridDim.x, bx = blockIdx.x; \
    const int gw = bx * NWAVES + wave, NGW = G * NWAVES; KParamsPtr PP = OPQ_PP(); unsigned char* ws = PP->ws; LAS float* scr = (LAS float*)(lds + wave * 16384); (void)lane; (void)gw; (void)NGW; (void)ws; (void)scr; (void)G; (void)bx; (void)PP

__global__ void __launch_bounds__(NWAVES * 64, 2) fwd_mega(Params P) {
    extern __shared__ __attribute__((aligned(16))) unsigned char lds_raw[];
    LAS unsigned char* lds = (LAS unsigned char*)lds_raw;
    cg::grid_group grid = cg::this_grid();
    { const int t0 = OPQ_TID(); if (t0 < 64) ((LAS unsigned*)(lds + 131072))[t0 + 64] = 0u; __syncthreads();
      if (t0 == 0) { KParamsPtr p0 = OPQ_PP(); (void)xb_add((unsigned*)(p0->ws + WS_CTL) + CW_BAR + XB_XCNT(xb_xcc_id()), 1u); } }

    {
        PHASE_VARS();
        bf16_t* XB = (bf16_t*)(ws + WS_XB); float* SSQ = (float*)(ws + WS_SSQ);
        for (int row = gw; row < TOK; row += NGW) {
            const f32x4* xr = (const f32x4*)(PP->x + (size_t)row * DM) + lane;
            unsigned long long* o8 = (unsigned long long*)(XB + (size_t)row * DM) + lane;
            float s = 0.f;
#pragma unroll
            for (int j = 0; j < 4; ++j) { const f32x4 v = xr[64 * j]; s += (v[0] * v[0] + v[1] * v[1]) + (v[2] * v[2] + v[3] * v[3]);
                o8[64 * j] = (unsigned long long)cvtpk(v[0], v[1]) | ((unsigned long long)cvtpk(v[2], v[3]) << 32); }
            s = wave_sum(s);
            if (lane < 16) SSQ[(size_t)row * 16 + lane] = (lane == 0) ? s : 0.f;
        }
    }

    for (int layer = 0; layer < DEPTH; ++layer) {
        for (int rep = 0; rep < REP_CONV; ++rep) {
            PHASE_VARS();
            bf16_t* WIN = (bf16_t*)(ws + WS_WIN); bf16_t* WB = (bf16_t*)(ws + WS_WB); bf16_t* WOUT = (bf16_t*)(ws + WS_WOUT);
            const float* w_in = PP->w_in + (size_t)layer * DM * DIN; const float* mg = PP->mix_g + (size_t)layer * DM;
            const float* wb = PP->w_branch + (size_t)layer * 4 * 256 * DM; const float* wo = PP->w_out + (size_t)layer * DM * DM;
            constexpr int I_IN = (DM / 64) * (NPROJ / 32), I_B = (256 / 64) * (DM / 32), I_O = (DM / 64) * (DM / 32);
            for (int it = gw; it < I_IN + 4 * I_B + I_O; it += NGW) {
                int r = it;
                if (r < I_IN) { transpose_item<1>(w_in, DM, NPROJ, DIN, mg, WIN, scr, r, lane); continue; } r -= I_IN;
                if (r < 4 * I_B) { const int n = r / I_B; branch_item(wb + (size_t)n * 256 * DM, n, WB, scr, r % I_B, lane); continue; } r -= 4 * I_B;
                transpose_item<0>(wo, DM, DM, DM, nullptr, WOUT, scr, r, lane);
            }
        }
        if (layer == 0) grid.sync(); else GSYNC();

        for (int half = 0; half < 2; ++half) {
#ifndef NO_P1
            for (int rep = 0; rep < REP_P1; ++rep) {
                PHASE_VARS();
                const int rb = half * HT;
                pg8::Gemm g{(const bf16_t*)(ws + WS_XB) + (size_t)rb * DM, (const bf16_t*)(ws + WS_WIN), DM, DM, DM, 0, 0};
                pg8::StaticOrder S; S.init(HT, NPROJ, G, bx);
                pg8::EpiProj E{(const float*)(ws + WS_SSQ), rb, (bf16_t*)(ws + WS_QK), (bf16_t*)(ws + WS_KF), (bf16_t*)(ws + WS_VT), (float*)(ws + WS_FL), (bf16_t*)(ws + WS_GATE)};
                pg8::gemm_phase<pg8::EpiProj, pg8::StaticOrder, true>(lds, g, S, E);
            }
#endif
            GSYNC();
#ifndef NO_P2
            for (int rep = 0; rep < REP_P2; ++rep) {
                PHASE_VARS();
                unsigned* ctr = (unsigned*)(ws + WS_CTL) + 64 + 512 * (layer * 2 + half + 4 * rep);
                const int xq = bx & 7;
                ctr += 64 * xq;
                for (;;) {
                    int li = 0; if (lane == 0) li = (int)atomicAdd(ctr, 1u); li = __builtin_amdgcn_readfirstlane(li);
                    if (li >= 800) break;
                    int idx;
                    if (li < 288) { const int hl = li / 48, row = li - hl * 48; idx = row * 48 + (xq + 8 * hl); }
                    else if (li < 416) { const int i = li - 288; idx = 2304 + ((63 - (i & 63)) << 4) + (xq + 8 * (i >> 6)); }
                    else { const int i = li - 416; idx = 3328 + (xq + 8 * (i >> 6)) * 64 + (i & 63); }
                    int lane_u = lane; asm volatile("" : "+v"(lane_u));
                    const int lane = lane_u, r32 = lane & 31, hi = lane >> 5;
                    KParamsPtr PU = OPQ_PP(); unsigned char* wsu = PU->ws;
                    bf16_t* YS = (bf16_t*)(wsu + WS_YS); bf16_t* DILO = (bf16_t*)(wsu + WS_DILO); float* LSE = (float*)(wsu + WS_LSE); const float* FL = (const float*)(wsu + WS_FL);
                    const bf16_t* QK = (const bf16_t*)(wsu + WS_QK); const bf16_t* KF = (const bf16_t*)(wsu + WS_KF); const bf16_t* VT = (const bf16_t*)(wsu + WS_VT);
                    if (idx < 2304) {
                        const int j = idx / 48, e = idx - j * 48, type3 = e >> 4, bh = e & 15, b = bh >> 2, h = bh & 3;
                        int Q, chunk; if (j < 32) { Q = 31 - (j >> 1); chunk = j & 1; } else { Q = 47 - j; chunk = 0; }
                        int kb_lo = 0, kb_hi = 2 * Q + 1;
                        if (Q >= 16) { if (chunk == 0) kb_hi = Q; else kb_lo = Q + 1; }
                        const size_t rowb = (size_t)b * SEQ;
                        bf16_t* SCRB = (bf16_t*)(wsu + WS_MERGED) + (size_t)(half * HT) * DM;
                        float* LSE2 = (float*)(wsu + WS_LSE2);
                        f32x16 o[2][2]; float m[2], l[2]; int slot;
                        if (type3 == 2) {
                            LAS float* cl = scr;
                            const float bf = PP->b_forget[layer * 4 + h];
                            float run = 0.f;
                            if (lane <= kb_hi) {
                                const float* fp = FL + (rowb + 32 * lane) * 4 + h;
#pragma unroll 8
                                for (int i = 0; i < 32; ++i) { const float y = fp[4 * i] + bf; const float lf = fminf(y, 0.f) - __logf(1.0f + __expf(-fabsf(y))); run += lf; cl[33 * lane + i] = run; }
                            }
                            float incl = run;
#pragma unroll
                            for (int o_ = 1; o_ < 64; o_ <<= 1) { const float tt = __uint_as_float((unsigned)__builtin_amdgcn_ds_bpermute((lane - o_) << 2, (int)__float_as_uint(incl))); if (lane >= o_) incl += tt; }
                            const float excl = incl - run;
                            if (lane <= kb_hi) {
#pragma unroll 8
                                for (int i = 0; i < 32; ++i) cl[33 * lane + i] = -(cl[33 * lane + i] + excl) * LOG2E;
                            }
                            asm volatile("s_waitcnt lgkmcnt(0)" ::: "memory");
                            sm_unit64<0>(QK + rowb * LDQK + 4 * 256 + h * 64, KF + (size_t)(b * 24 + 16 + h) * HSEQ, VT + (size_t)(b * 24 + 16 + h) * HSEQ, Q, kb_hi, kb_lo, 0.f, cl, o, m, l, lane);
                            asm volatile("s_waitcnt lgkmcnt(0)" ::: "memory");
                            slot = chunk;
                        } else {
                            const float slope = exp2f(-8.0f * (float)(5 + h) / 16.0f);
                            sm_unit64<2>(QK + rowb * LDQK + 5 * 256 + h * 64 + type3 * 32, KF + (size_t)(b * 24 + 20 + h) * HSEQ + type3 * 1024, VT + (size_t)(b * 24 + 20 + h) * HSEQ, Q, kb_hi, kb_lo, slope * LOG2E, nullptr, o, m, l, lane);
                            slot = 2 + 2 * type3 + chunk;
                        }
#pragma unroll
                        for (int i = 0; i < 2; ++i) {
                            const int t = (2 * Q + i) * 32 + r32;
                            bf16_t* dst;
                            if (type3 == 2) dst = chunk ? SCRB + (rowb + t) * 256 + h * 64 : YS + (rowb + t) * DM + 512 + h * 64;
                            else dst = (type3 == 0 && chunk == 0) ? YS + (rowb + t) * DM + 768 + h * 64 : SCRB + (size_t)(2 * type3 + chunk) * HT * 256 + (rowb + t) * 256 + h * 64;
                            const float inv = 1.0f / l[i];
#pragma unroll
                            for (int k = 0; k < 16; ++k) { o[i][0][k] *= inv; o[i][1][k] *= inv; }
                            store_o(dst, o[i][0], o[i][1], hi);
                            if (hi == 0) LSE2[(rowb + t) * 24 + h * 6 + slot] = m[i] + lg2(l[i]);
                        }
                    } else if (idx < 3328) {
                        const int i1 = idx - 2304, qb = 63 - (i1 >> 4), bh = i1 & 15, b = bh >> 2, h = bh & 3;
                        const size_t rowb = (size_t)b * SEQ; const int t = qb * 32 + r32;
                        f32x16 o0, o1;
                        sb_unit(QK + rowb * LDQK + 0 * 256 + h * 64, KF + (size_t)(b * 24 + h) * HSEQ, VT + (size_t)(b * 24 + h) * HSEQ, qb, o0, o1, lane);
                        store_o(YS + (rowb + t) * DM + 0 * 256 + h * 64, o0, o1, hi);
                    } else {
                        const int i2 = idx - 3328, j = i2 & 63, gh = (i2 >> 6) % 12, b = i2 / 768, gI = gh >> 2, h = gh & 3;
                        const int rsh = 2 * gI, r = 1 << rsh, sl = SEQ >> rsh, nubsh = 6 - rsh, rho = j >> nubsh, ub = j & ((1 << nubsh) - 1);
                        const int sidx = (gI == 0) ? h : (gI == 1 ? 8 + h : 12 + h);
                        const float slope = exp2f(-8.0f * (float)(sidx + 1) / 16.0f);
                        const size_t rowb = (size_t)b * SEQ + (size_t)rho * sl;
                        f32x16 o0, o1; float m, l;
                        const int kb_lo = (ub - 4 > 0) ? ub - 4 : 0;
                        sm_unit<1>(QK + rowb * LDQK + (1 + gI) * 256 + h * 64, KF + (size_t)(b * 24 + 4 + 4 * gI + h) * HSEQ + (size_t)rho * sl * 64,
                                   VT + (size_t)(b * 24 + 4 + 4 * gI + h) * HSEQ + (size_t)rho * sl * 64, ub, ub, kb_lo, slope * (float)r * LOG2E, nullptr, o0, o1, m, l, lane);
                        const float inv = 1.0f / l;
#pragma unroll
                        for (int i = 0; i < 16; ++i) { o0[i] *= inv; o1[i] *= inv; }
                        const int u = ub * 32 + r32; const size_t tok = (size_t)b * SEQ + (size_t)u * r + rho;
                        store_o(DILO + tok * 768 + gI * 256 + h * 64, o0, o1, hi);
                        if (hi == 0) LSE[tok * 12 + gI * 4 + h] = (m + lg2(l)) * LN2;
                    }
                }
            }
#endif
            GSYNC();
            {
                PHASE_VARS();
                const float lam_init = (layer == 0) ? 0.2f : 0.35550906759093115f;
                float lam;
                { const float a = (lane < 32) ? PP->lq1[layer * 32 + lane] * PP->lk1[layer * 32 + lane] : 0.f, b = (lane < 32) ? PP->lq2[layer * 32 + lane] * PP->lk2[layer * 32 + lane] : 0.f;
                  lam = __expf(wave_sum(a)) - __expf(wave_sum(b)) + lam_init; }
                bf16_t* YS = (bf16_t*)(ws + WS_YS); const bf16_t* DILO = (const bf16_t*)(ws + WS_DILO); const float* LSE = (const float*)(ws + WS_LSE);
                const bf16_t* SCRB = (const bf16_t*)(ws + WS_MERGED) + (size_t)(half * HT) * DM; const float* LSE2 = (const float*)(ws + WS_LSE2);
                const int h = lane >> 4, dq = (lane & 15) * 4;
                const f32x4 dgv = *(const f32x4*)(PP->diff_g + layer * 64 + dq);
                for (int row = gw; row < HT; row += NGW) {
                    const bool split = ((row & (SEQ - 1)) >> 5) >= 32;
                    {
                        const float l0 = LSE[(size_t)row * 12 + h], l1 = LSE[(size_t)row * 12 + 4 + h], l2 = LSE[(size_t)row * 12 + 8 + h];
                        const float mx = fmaxf(l0, fmaxf(l1, l2)); const float e0 = __expf(l0 - mx), e1 = __expf(l1 - mx), e2 = __expf(l2 - mx); const float inv = 1.0f / (e0 + e1 + e2);
                        const u32x2 a = *(const u32x2*)(DILO + (size_t)row * 768 + 4 * lane), b = *(const u32x2*)(DILO + (size_t)row * 768 + 256 + 4 * lane), c = *(const u32x2*)(DILO + (size_t)row * 768 + 512 + 4 * lane);
                        const float w0 = e0 * inv, w1 = e1 * inv, w2 = e2 * inv;
                        u32x2 o; o.x = cvtpk(w0 * bflo(a.x) + w1 * bflo(b.x) + w2 * bflo(c.x), w0 * bfhi(a.x) + w1 * bfhi(b.x) + w2 * bfhi(c.x));
                        o.y = cvtpk(w0 * bflo(a.y) + w1 * bflo(b.y) + w2 * bflo(c.y), w0 * bfhi(a.y) + w1 * bfhi(b.y) + w2 * bfhi(c.y));
                        *(u32x2*)(YS + (size_t)row * DM + 256 + 4 * lane) = o;
                    }
                    const float* ls = LSE2 + (size_t)row * 24 + h * 6;
                    const u32x2 f0 = *(const u32x2*)(YS + (size_t)row * DM + 512 + 4 * lane), a0 = *(const u32x2*)(YS + (size_t)row * DM + 768 + 4 * lane);
                    const u32x2 b0 = *(const u32x2*)(SCRB + (size_t)2 * HT * 256 + (size_t)row * 256 + 4 * lane);
                    float fv[4] = {bflo(f0.x), bfhi(f0.x), bflo(f0.y), bfhi(f0.y)}, av[4] = {bflo(a0.x), bfhi(a0.x), bflo(a0.y), bfhi(a0.y)}, bv[4] = {bflo(b0.x), bfhi(b0.x), bflo(b0.y), bfhi(b0.y)};
                    if (split) {
                        const u32x2 f1 = *(const u32x2*)(SCRB + (size_t)row * 256 + 4 * lane), a1 = *(const u32x2*)(SCRB + (size_t)1 * HT * 256 + (size_t)row * 256 + 4 * lane), b1 = *(const u32x2*)(SCRB + (size_t)3 * HT * 256 + (size_t)row * 256 + 4 * lane);
                        const float lf0 = ls[0], lf1 = ls[1], la0 = ls[2], la1 = ls[3], lb0 = ls[4], lb1 = ls[5];
                        { const float mx = fmaxf(lf0, lf1), e0 = ex2(lf0 - mx), e1 = ex2(lf1 - mx), inv = 1.0f / (e0 + e1), w0 = e0 * inv, w1 = e1 * inv;
                          fv[0] = w0 * fv[0] + w1 * bflo(f1.x); fv[1] = w0 * fv[1] + w1 * bfhi(f1.x); fv[2] = w0 * fv[2] + w1 * bflo(f1.y); fv[3] = w0 * fv[3] + w1 * bfhi(f1.y); }
                        { const float mx = fmaxf(la0, la1), e0 = ex2(la0 - mx), e1 = ex2(la1 - mx), inv = 1.0f / (e0 + e1), w0 = e0 * inv, w1 = e1 * inv;
                          av[0] = w0 * av[0] + w1 * bflo(a1.x); av[1] = w0 * av[1] + w1 * bfhi(a1.x); av[2] = w0 * av[2] + w1 * bflo(a1.y); av[3] = w0 * av[3] + w1 * bfhi(a1.y); }
                        { const float mx = fmaxf(lb0, lb1), e0 = ex2(lb0 - mx), e1 = ex2(lb1 - mx), inv = 1.0f / (e0 + e1), w0 = e0 * inv, w1 = e1 * inv;
                          bv[0] = w0 * bv[0] + w1 * bflo(b1.x); bv[1] = w0 * bv[1] + w1 * bfhi(b1.x); bv[2] = w0 * bv[2] + w1 * bflo(b1.y); bv[3] = w0 * bv[3] + w1 * bfhi(b1.y); }
                        u32x2 fo; fo.x = cvtpk(fv[0], fv[1]); fo.y = cvtpk(fv[2], fv[3]);
                        *(u32x2*)(YS + (size_t)row * DM + 512 + 4 * lane) = fo;
                    }
                    float dv[4]; float ss = 0.f;
#pragma unroll
                    for (int i = 0; i < 4; ++i) { dv[i] = av[i] - lam * bv[i]; ss += dv[i] * dv[i]; }
                    ss += swz_xor<1>(ss); ss += swz_xor<2>(ss); ss += swz_xor<4>(ss); ss += swz_xor<8>(ss);
                    const float rn = __builtin_amdgcn_rsqf(ss * (1.0f / 64.0f) + RMS_EPS) * (1.0f - lam_init);
                    u32x2 dout; dout.x = cvtpk(dv[0] * rn * dgv[0], dv[1] * rn * dgv[1]); dout.y = cvtpk(dv[2] * rn * dgv[2], dv[3] * rn * dgv[3]);
                    *(u32x2*)(YS + (size_t)row * DM + 768 + 4 * lane) = dout;
                }
            }
            GSYNC();
#ifndef NO_P3
            for (int rep = 0; rep < REP_P3; ++rep) {
                PHASE_VARS();
                pg8::Gemm g{(const bf16_t*)(ws + WS_YS), (const bf16_t*)(ws + WS_WB), DM, 512, 512, 512 * 2, (long)8 * 256 * 512 * 2};
                pg8::BranchOrder S{bx, G};
                pg8::EpiBranch E{(const bf16_t*)(ws + WS_GATE), (bf16_t*)(ws + WS_MERGED), half * HT};
                pg8::gemm_phase<pg8::EpiBranch, pg8::BranchOrder, true>(lds, g, S, E);
            }
#endif
            GSYNC();
        }
#ifndef NO_P4
        for (int rep = 0; rep < REP_CONV; ++rep) {
            PHASE_VARS();
            bf16_t* WUP = (bf16_t*)(ws + WS_WUP); bf16_t* WDN = (bf16_t*)(ws + WS_WDN);
            const float* wu = PP->w_up + (size_t)layer * DM * DFF; const float* wd = PP->w_down + (size_t)layer * DFF * DM; const float* mg = PP->mlp_g + (size_t)layer * DM;
            constexpr int I_U = (DM / 64) * (DFF / 32), I_D = (DFF / 64) * (DM / 32);
            for (int it = gw; it < I_U + I_D; it += NGW) {
                if (it < I_U) transpose_item<0>(wu, DM, DFF, DFF, mg, WUP, scr, it, lane);
                else transpose_item<0>(wd, DFF, DM, DM, nullptr, WDN, scr, it - I_U, lane);
            }
            __syncthreads();
        }
        {
            PHASE_VARS();
            pg8::Gemm g{(const bf16_t*)(ws + WS_MERGED), (const bf16_t*)(ws + WS_WOUT), DM, DM, DM, 0, 0};
            pg8::StaticOrder S; S.init(TOK, DM, G, bx);
            pg8::EpiResid E{(layer == 0) ? PP->x : (const float*)PP->out, PP->out, (bf16_t*)(ws + WS_XB), (float*)(ws + WS_SSQ)};
            pg8::gemm_phase<pg8::EpiResid, pg8::StaticOrder, false>(lds, g, S, E);
        }
#endif
        GSYNC();
#ifndef NO_P5
        for (int rep = 0; rep < REP_P5; ++rep) {
            PHASE_VARS();
            pg8::Gemm g{(const bf16_t*)(ws + WS_XB), (const bf16_t*)(ws + WS_WUP), DM, DM, DM, 0, 0};
            pg8::StaticOrder S; S.init(TOK, DFF, G, bx);
            pg8::EpiUp E{(const float*)(ws + WS_SSQ), (bf16_t*)(ws + WS_HMLP)};
            pg8::gemm_phase<pg8::EpiUp, pg8::StaticOrder, true>(lds, g, S, E);
        }
#endif
        GSYNC();
#ifndef NO_P6
        {
            PHASE_VARS();
            pg8::Gemm g{(const bf16_t*)(ws + WS_HMLP), (const bf16_t*)(ws + WS_WDN), DFF, DFF, DFF, 0, 0};
            pg8::StaticOrder S; S.init(TOK, DM, G, bx);
            if (layer == DEPTH - 1 && G == 256) {
                pg8::EpiFinal E{(const float*)PP->out, PP->out, (float*)(ws + WS_SSQ), PP->final_g, (unsigned*)(ws + WS_CTL) + CW_PANEL};
                pg8::gemm_phase<pg8::EpiFinal, pg8::StaticOrder, true>(lds, g, S, E);
            } else {
                pg8::EpiResid E{(const float*)PP->out, PP->out, (bf16_t*)(ws + WS_XB), (float*)(ws + WS_SSQ)};
                pg8::gemm_phase<pg8::EpiResid, pg8::StaticOrder, false>(lds, g, S, E);
            }
        }
#endif
        if (layer < DEPTH - 1 || gridDim.x != 256) GSYNC();
    }
    if (gridDim.x != 256)
    {
        PHASE_VARS();
        float* X = PP->out;
        for (int row = gw; row < TOK; row += NGW) {
            f32x4* xo = (f32x4*)(X + (size_t)row * DM) + lane; const f32x4* gp = (const f32x4*)PP->final_g + lane;
            f32x4 v[4]; float s = 0.f;
#pragma unroll
            for (int j = 0; j < 4; ++j) { v[j] = xo[64 * j]; s += (v[j][0] * v[j][0] + v[j][1] * v[j][1]) + (v[j][2] * v[j][2] + v[j][3] * v[j][3]); }
            const float rstd = __builtin_amdgcn_rsqf(wave_sum(s) * (1.0f / DM) + RMS_EPS);
#pragma unroll
            for (int j = 0; j < 4; ++j) xo[64 * j] = v[j] * rstd * gp[64 * j];
        }
    }
}

extern "C" void kernel_launch(void* const* d_in, const int* in_sizes, int n_in, void* d_out, int out_size, void* d_ws, size_t ws_size, hipStream_t stream) {
    static int grid = 0;
    if (grid == 0) {
        if (n_in != 15 || in_sizes[0] != TOK * DM || out_size != TOK * DM || ws_size < WS_END) { fprintf(stderr, "kernel_launch: unexpected shapes / workspace (n_in %d, ws %zu)\n", n_in, ws_size); grid = -1; return; }
        int dev = 0, cus = 0, per_cu = 0;
        hipGetDevice(&dev); hipDeviceGetAttribute(&cus, hipDeviceAttributeMultiprocessorCount, dev);
        hipFuncSetAttribute((const void*)fwd_mega, hipFuncAttributeMaxDynamicSharedMemorySize, LDS_BYTES);
        hipOccupancyMaxActiveBlocksPerMultiprocessor(&per_cu, (const void*)fwd_mega, NWAVES * 64, LDS_BYTES);
        (void)hipGetLastError();
        if (per_cu < 1) per_cu = 1;
        grid = cus;
        if (grid > 256) grid = 256;
        if (grid % 8 != 0) { fprintf(stderr, "kernel_launch: the per-XCD work queues need a grid that is a multiple of 8 (got %d)\n", grid); grid = -1; return; }
    }
    if (grid < 0) return;
    hipMemsetAsync((char*)d_ws + WS_CTL, 0, CTL_BYTES, stream);
    Params p{};
    p.x = (const float*)d_in[0]; p.mix_g = (const float*)d_in[1]; p.w_in = (const float*)d_in[2]; p.b_forget = (const float*)d_in[3];
    p.lq1 = (const float*)d_in[4]; p.lk1 = (const float*)d_in[5]; p.lq2 = (const float*)d_in[6]; p.lk2 = (const float*)d_in[7];
    p.diff_g = (const float*)d_in[8]; p.w_branch = (const float*)d_in[9]; p.w_out = (const float*)d_in[10]; p.mlp_g = (const float*)d_in[11];
    p.w_up = (const float*)d_in[12]; p.w_down = (const float*)d_in[13]; p.final_g = (const float*)d_in[14];
    p.out = (float*)d_out; p.ws = (unsigned char*)d_ws;
    void* args[] = {&p};
    hipError_t e = hipLaunchCooperativeKernel((const void*)fwd_mega, dim3(grid), dim3(NWAVES * 64), args, LDS_BYTES, stream);
    if (e != hipSuccess) fprintf(stderr, "cooperative launch failed: %s (grid %d)\n", hipGetErrorString(e), grid);
}
```

```cpp
#include <hip/hip_runtime.h>
#include <hip/hip_cooperative_groups.h>
#include <cstdio>
#include <cstdint>
namespace cg = cooperative_groups;

#define LAS __attribute__((address_space(3)))
typedef unsigned short bf16_t;
typedef short bf16x8 __attribute__((ext_vector_type(8)));
typedef float f32x4 __attribute__((ext_vector_type(4)));
typedef float f32x16 __attribute__((ext_vector_type(16)));
typedef unsigned u32x4 __attribute__((ext_vector_type(4)));
typedef unsigned u32x2 __attribute__((ext_vector_type(2)));
typedef float f32x2_t __attribute__((ext_vector_type(2)));
typedef __bf16 bf16x2_t __attribute__((ext_vector_type(2)));

constexpr int DM = 1024, BATCH = 8, SEQ = 2048, DEPTH = 2, TOK = BATCH * SEQ, DFF = 4096, DIN = 8708;
constexpr int HT = TOK / 2;
constexpr int NPROJ = 35 * 256;
constexpr int LDQK = 6 * 256;
constexpr int HSEQ = SEQ * 64;
constexpr float LOG2E = 1.4426950408889634f, LN2 = 0.6931471805599453f;
constexpr float RMS_EPS = 1e-6f;

constexpr size_t MiB = 1u << 20;
constexpr size_t WS_CTL = 0, CTL_BYTES = 65536;
constexpr int CW_BAR = 4096, CW_PANEL = 8192;
constexpr size_t WS_SSQ = 1 * MiB;
constexpr size_t WS_WIN = 2 * MiB;
constexpr size_t WS_WUP = WS_WIN, WS_WDN = WS_WIN + 8 * MiB;
constexpr size_t WS_WB = 20 * MiB;
constexpr size_t WS_WOUT = 24 * MiB;
constexpr size_t WS_XB = 26 * MiB;
constexpr size_t WS_MERGED = 58 * MiB;
constexpr size_t WS_YS = 90 * MiB;
constexpr size_t WS_DILO = 106 * MiB;
constexpr size_t WS_LSE = 118 * MiB;
constexpr size_t WS_LSE2 = 118 * MiB + 512 * 1024;
constexpr size_t WS_FL = 119 * MiB + 512 * 1024;
constexpr size_t WS_QK = 120 * MiB;
constexpr size_t WS_KF = 144 * MiB;
constexpr size_t WS_VT = 168 * MiB;
constexpr size_t WS_GATE = 192 * MiB;
constexpr size_t WS_HMLP = 120 * MiB;
constexpr size_t WS_END = 256 * MiB;

constexpr int LDS_BYTES = 147456;
constexpr int NWAVES = 8;

__device__ __forceinline__ unsigned cvtpk(float lo, float hi) { f32x2_t v = {lo, hi}; bf16x2_t b = __builtin_convertvector(v, bf16x2_t); return __builtin_bit_cast(unsigned, b); }
__device__ __forceinline__ float bflo(unsigned w) { return __uint_as_float(w << 16); }
__device__ __forceinline__ float bfhi(unsigned w) { return __uint_as_float(w & 0xffff0000u); }
__device__ __forceinline__ float ex2(float x) { return __builtin_amdgcn_exp2f(x); }
__device__ __forceinline__ float lg2(float x) { return __builtin_amdgcn_logf(x); }
__device__ __forceinline__ float x32_sum(float v) { auto r = __builtin_amdgcn_permlane32_swap(__float_as_uint(v), __float_as_uint(v), false, false); return __uint_as_float(r[0]) + __uint_as_float(r[1]); }
__device__ __forceinline__ float x32_max(float v) { auto r = __builtin_amdgcn_permlane32_swap(__float_as_uint(v), __float_as_uint(v), false, false); return fmaxf(__uint_as_float(r[0]), __uint_as_float(r[1])); }
__device__ __forceinline__ float x32_partner(float v, int hi) { auto r = __builtin_amdgcn_permlane32_swap(__float_as_uint(v), __float_as_uint(v), false, false); return hi ? __uint_as_float(r[0]) : __uint_as_float(r[1]); }
template <int X> __device__ __forceinline__ float swz_xor(float v) { return __uint_as_float((unsigned)__builtin_amdgcn_ds_swizzle((int)__float_as_uint(v), (X << 10) | 0x1f)); }
__device__ __forceinline__ float x16_sum(float v) { return v + swz_xor<16>(v); }
__device__ __forceinline__ float wave_sum(float v) { v += swz_xor<1>(v); v += swz_xor<2>(v); v += swz_xor<4>(v); v += swz_xor<8>(v); v += swz_xor<16>(v); return x32_sum(v); }

namespace pg8 {
constexpr int BM = 256, BK = 64, HALF = 128, HTB = HALF * BK * 2, STAGE_BYTES = 8 * HTB, NXCD = 8, WGM = 8;
__host__ __device__ __forceinline__ int lds_byte(int r, int c) { const int st = (r >> 4) * 2 + (c >> 5), rr = r & 15, cc = c & 31, ob = rr * 64 + cc * 2; return st * 1024 + (ob ^ (((ob >> 9) & 1) << 5)); }
__host__ __device__ __forceinline__ void stage_rc(int b, int& R, int& C) { const int st = b / 1024, sb = b % 1024, swz = sb ^ (((sb >> 9) & 1) << 5); R = (st >> 1) * 16 + swz / 64; C = (st & 1) * 32 + (swz % 64) / 2; }
__host__ __device__ __forceinline__ int perm32(int rho) { const int n = rho >> 4, i = rho & 15; return 8 * (i >> 2) + 4 * n + (i & 3); }

struct Unit { int pm, pn, aux; };
struct Gemm { const bf16_t* A; const bf16_t* Bt; int lda, ldb, K; long a_aux, b_aux; };

struct StaticOrder {
    int nM, nN, nwg, G, c;
    __device__ void init(int M, int N, int G_, int c_) { nM = M / BM; nN = N / BM; nwg = nM * nN; G = G_; c = c_; }
    __device__ bool next(int i, Unit& u) const {
        const long L = (long)i * G + c; if (L >= nwg) return false;
        int wgid = (int)L; { const int q = nwg / NXCD, r = nwg % NXCD, xcd = wgid % NXCD, off = wgid / NXCD; wgid = (xcd < r ? xcd * (q + 1) : r * (q + 1) + (xcd - r) * q) + off; }
        const int nig = WGM * nN, gid = wgid / nig, fm = gid * WGM, gsz = (nM - fm) < WGM ? (nM - fm) : WGM;
        u.pm = fm + ((wgid % nig) % gsz); u.pn = (wgid % nig) / gsz; u.aux = 0; return true;
    }
};
struct BranchOrder {
    int c, G;
    __device__ bool next(int i, Unit& u) const { const int t = c + (i >> 1) * G; if (t >= 256) return false; u.pm = t >> 3; u.pn = t & 7; u.aux = i & 1; return true; }
};

template <class Epi, class Sched, bool ALIGN_EPI>
__device__ __forceinline__ void gemm_phase(LAS unsigned char* lds, const Gemm g, const Sched& S, const Epi& E) {
    int tid_ = threadIdx.x; asm volatile("" : "+v"(tid_));
    const int tid = tid_, wid = __builtin_amdgcn_readfirstlane(tid >> 6), lane = tid & 63, wr = wid >> 2, wc = wid & 3, fr = lane & 15, fq = lane >> 4;
    int nt_ = g.K / BK; asm volatile("" : "+s"(nt_)); const int nt = nt_;
    unsigned voffA[2], voffB[2];
#pragma unroll
    for (int i = 0; i < 2; ++i) { int R, C; stage_rc(tid * 16 + i * 8192, R, C); const int Rb = Epi::PERM ? ((R & ~31) + perm32(R & 31)) : R;
        voffA[i] = (unsigned)(R * g.lda + C) * 2u; voffB[i] = (unsigned)(Rb * g.ldb + C) * 2u; }
    const size_t kstep = (size_t)(BK * 2);
    const size_t hstepA = (size_t)HALF * g.lda * 2, hstepB = (size_t)HALF * g.ldb * 2;
    const size_t tstepA = 2 * hstepA, tstepB = 2 * hstepB;
    const unsigned ldsw = (unsigned)wid * 1024u;
    const int aoff = lds_byte(wr * 64 + fr, fq * 8), boff = lds_byte(wc * 32 + fr, fq * 8);
#define PG8_SA(b, h) (((b) * 2 + (h)) * HTB)
#define PG8_SB(b, h) ((4 + (b) * 2 + (h)) * HTB)
#define PG8_STAGE(bufoff, gbase, voff) do { _Pragma("unroll") for (int _i = 0; _i < 2; ++_i) \
        __builtin_amdgcn_global_load_lds((const unsigned*)((const char*)(gbase) + (voff)[_i]), (LAS unsigned*)(lds + (bufoff) + ldsw + _i * 8192), 16, 0, 0); } while (0)
#define PG8_LDA(dst, b, h) do { _Pragma("unroll") for (int m = 0; m < 4; ++m) _Pragma("unroll") for (int k = 0; k < 2; ++k) dst[m][k] = *(const LAS bf16x8*)(lds + PG8_SA(b, h) + aoff + m * 2048 + k * 1024); } while (0)
#define PG8_LDB(dst, b, h) do { _Pragma("unroll") for (int n = 0; n < 2; ++n) _Pragma("unroll") for (int k = 0; k < 2; ++k) dst[n][k] = *(const LAS bf16x8*)(lds + PG8_SB(b, h) + boff + n * 2048 + k * 1024); } while (0)
#define PG8_MMA(ai, bj, At, Bt) do { __builtin_amdgcn_s_setprio(1); _Pragma("unroll") for (int m = 0; m < 4; ++m) _Pragma("unroll") for (int n = 0; n < 2; ++n) _Pragma("unroll") for (int k = 0; k < 2; ++k) \
        acc[ai][bj][m][n] = __builtin_amdgcn_mfma_f32_16x16x32_bf16(Bt[n][k], At[m][k], acc[ai][bj][m][n], 0, 0, 0); __builtin_amdgcn_s_setprio(0); } while (0)
#define PG8_WAIT_V(n) asm volatile("s_waitcnt vmcnt(" #n ")" ::: "memory")
#define PG8_WAIT_L(n) asm volatile("s_waitcnt lgkmcnt(" #n ")" ::: "memory")
#define PG8_BAR __builtin_amdgcn_s_barrier()
#define PG8_SCHED __builtin_amdgcn_sched_barrier(0)
#define PG8_UA(u) ((const char*)g.A + (size_t)(u).pm * tstepA + (size_t)(u).aux * (size_t)g.a_aux)
#define PG8_UB(u) ((const char*)g.Bt + (size_t)(u).pn * tstepB + (size_t)(u).aux * (size_t)g.b_aux)
    Unit cur, nxt; int ui = 0;
    if (!S.next(0, cur)) return;
    f32x4 acc[2][2][4][2];
#pragma unroll
    for (int a = 0; a < 2; ++a)
#pragma unroll
        for (int b = 0; b < 2; ++b)
#pragma unroll
            for (int m = 0; m < 4; ++m)
#pragma unroll
                for (int n = 0; n < 2; ++n) acc[a][b][m][n] = (f32x4){0.f, 0.f, 0.f, 0.f};
    bf16x8 At[4][2], B0[2][2], B1[2][2];
    const char* cA = PG8_UA(cur); const char* cB = PG8_UB(cur);
    PG8_STAGE(PG8_SB(0, 0), cB, voffB); PG8_STAGE(PG8_SB(0, 1), cB + hstepB, voffB); PG8_STAGE(PG8_SA(0, 0), cA, voffA); PG8_STAGE(PG8_SA(0, 1), cA + hstepA, voffA);
    if (wr == 1) PG8_BAR;
    PG8_WAIT_V(2); PG8_BAR;
    PG8_STAGE(PG8_SB(1, 0), cB + kstep, voffB); PG8_STAGE(PG8_SA(1, 0), cA + kstep, voffA); PG8_STAGE(PG8_SB(1, 1), cB + hstepB + kstep, voffB);
    PG8_WAIT_V(6); PG8_BAR;
    for (;;) {
        const bool has_next = S.next(ui + 1, nxt);
        const char* nA = has_next ? PG8_UA(nxt) : cA; const char* nB = has_next ? PG8_UB(nxt) : cB;
        for (int t = 0; t < nt; t += 2) {
            const bool last = (t == nt - 2);
            const char* a1 = cA + (size_t)(t + 1) * kstep;
            const char* a2 = last ? nA : cA + (size_t)(t + 2) * kstep; const char* b2 = last ? nB : cB + (size_t)(t + 2) * kstep;
            const char* a3 = a2 + kstep; const char* b3 = b2 + kstep;
            PG8_LDB(B0, 0, 0); PG8_LDB(B1, 0, 1); PG8_SCHED; PG8_LDA(At, 0, 0); PG8_STAGE(PG8_SA(1, 1), a1 + hstepA, voffA);
            PG8_WAIT_V(8); PG8_WAIT_L(0); PG8_BAR; PG8_MMA(0, 0, At, B0); PG8_MMA(0, 1, At, B1); PG8_BAR; PG8_SCHED;
            PG8_LDA(At, 0, 1); PG8_STAGE(PG8_SB(0, 0), b2, voffB); PG8_STAGE(PG8_SB(0, 1), b2 + hstepB, voffB); PG8_STAGE(PG8_SA(0, 0), a2, voffA);
            PG8_WAIT_V(8); PG8_WAIT_L(0); PG8_BAR; PG8_MMA(1, 0, At, B0); PG8_MMA(1, 1, At, B1); PG8_BAR; PG8_SCHED;
            PG8_LDB(B0, 1, 0); PG8_LDB(B1, 1, 1); PG8_SCHED; PG8_LDA(At, 1, 0); PG8_STAGE(PG8_SA(0, 1), a2 + hstepA, voffA);
            PG8_WAIT_V(8); PG8_WAIT_L(0); PG8_BAR; PG8_MMA(0, 0, At, B0); PG8_MMA(0, 1, At, B1); PG8_BAR; PG8_SCHED;
            PG8_LDA(At, 1, 1); PG8_STAGE(PG8_SB(1, 0), b3, voffB); PG8_STAGE(PG8_SB(1, 1), b3 + hstepB, voffB); PG8_STAGE(PG8_SA(1, 0), a3, voffA);
            PG8_WAIT_V(8); PG8_WAIT_L(0); PG8_BAR; PG8_MMA(1, 0, At, B0); PG8_MMA(1, 1, At, B1); PG8_BAR; PG8_SCHED;
        }
        if constexpr (ALIGN_EPI) { if (wr == 0) PG8_BAR; }
        { Unit eu = cur; asm volatile("" : "+s"(eu.pm), "+s"(eu.pn), "+s"(eu.aux)); E(acc, eu, wr, wc, fr, fq); }
        if (!has_next) break;
#pragma unroll
        for (int a = 0; a < 2; ++a)
#pragma unroll
            for (int b = 0; b < 2; ++b)
#pragma unroll
                for (int m = 0; m < 4; ++m)
#pragma unroll
                    for (int n = 0; n < 2; ++n) acc[a][b][m][n] = (f32x4){0.f, 0.f, 0.f, 0.f};
        cur = nxt; cA = nA; cB = nB; ++ui;
        if constexpr (ALIGN_EPI) { if (wr == 1) PG8_BAR; }
    }
    PG8_WAIT_V(0);
    if constexpr (!ALIGN_EPI) { if (wr == 0) PG8_BAR; }
    PG8_BAR;
#undef PG8_SA
#undef PG8_SB
#undef PG8_STAGE
#undef PG8_LDA
#undef PG8_LDB
#undef PG8_MMA
#undef PG8_WAIT_V
#undef PG8_WAIT_L
#undef PG8_BAR
#undef PG8_SCHED
#undef PG8_UA
#undef PG8_UB
}

__device__ __forceinline__ float row_rstd(const float* ssq, int row, int fq) {
    const f32x4 a = *(const f32x4*)(ssq + (size_t)row * 16 + 4 * fq);
    float s = (a[0] + a[1]) + (a[2] + a[3]);
    s = x16_sum(s); s = x32_sum(s);
    return __builtin_amdgcn_rsqf(s * (1.0f / DM) + RMS_EPS);
}
__device__ __forceinline__ int pos16(int o) { return 8 * ((o >> 2) & 1) + 4 * (o >> 3) + (o & 3); }

struct EpiProj {
    static constexpr bool PERM = true;
    const float* ssq; int row_base; bf16_t* QK; bf16_t* KF; bf16_t* VT; float* FL; bf16_t* GATE;
    __device__ __forceinline__ void operator()(const f32x4 (&acc)[2][2][4][2], const Unit& u, int wr, int wc, int fr, int fq) const {
        const int pn = u.pn;
        const int lrow0 = u.pm * BM + wr * 64 + fr;
        float rs[2][4];
#pragma unroll
        for (int ai = 0; ai < 2; ++ai)
#pragma unroll
            for (int m = 0; m < 4; ++m) rs[ai][m] = row_rstd(ssq, row_base + lrow0 + ai * HALF + m * 16, fq);
        const int cin = wc * 32 + 8 * fq;
        if (pn >= 19) {
#pragma unroll
            for (int ai = 0; ai < 2; ++ai)
#pragma unroll
                for (int m = 0; m < 4; ++m) { const int lrow = lrow0 + ai * HALF + m * 16; const float s = rs[ai][m];
#pragma unroll
                    for (int bj = 0; bj < 2; ++bj) { const f32x4 v0 = acc[ai][bj][m][0] * s, v1 = acc[ai][bj][m][1] * s;
                        u32x4 w; w.x = cvtpk(v0[0], v0[1]); w.y = cvtpk(v0[2], v0[3]); w.z = cvtpk(v1[0], v1[1]); w.w = cvtpk(v1[2], v1[3]);
                        *(u32x4*)(GATE + (size_t)lrow * 4096 + (pn - 19) * 256 + bj * HALF + cin) = w; } }
        } else if (pn == 18) {
            if (wc == 0 && fq == 0) {
#pragma unroll
                for (int ai = 0; ai < 2; ++ai)
#pragma unroll
                    for (int m = 0; m < 4; ++m) { const int lrow = lrow0 + ai * HALF + m * 16; *(f32x4*)(FL + (size_t)lrow * 4) = acc[ai][0][m][0] * rs[ai][m]; }
            }
        } else if (pn == 2 || (pn >= 9 && pn <= 11) || pn == 14 || pn == 17) {
            int vhb, rsh;
            if (pn == 2) { vhb = 0; rsh = 0; } else if (pn == 14) { vhb = 16; rsh = 0; } else if (pn == 17) { vhb = 20; rsh = 0; } else { const int gI = pn - 9; vhb = 4 + 4 * gI; rsh = 2 * gI; }
            const int slsh = 11 - rsh, rmask = (1 << rsh) - 1;
#pragma unroll
            for (int ai = 0; ai < 2; ++ai)
#pragma unroll
                for (int m = 0; m < 4; ++m) { const int lrow = lrow0 + ai * HALF + m * 16; const float s = rs[ai][m];
                    const int bl = lrow >> 11, t = lrow & (SEQ - 1); int p = ((t & rmask) << slsh) + (t >> rsh); p = (p & ~15) | pos16(p & 15);
                    const int kb = p >> 5, q = p & 31;
                    bf16_t* base = VT + (size_t)(bl * 24 + vhb) * HSEQ + (size_t)kb * 2048 + (q >> 4) * 512 + ((q >> 3) & 1) * 256 + (q & 7);
#pragma unroll
                    for (int bj = 0; bj < 2; ++bj) { const int c0 = bj * HALF + cin;
                        bf16_t* bp = base + (size_t)(c0 >> 6) * HSEQ + ((c0 >> 5) & 1) * 1024 + (c0 & 31) * 8;
                        const f32x4 v0 = acc[ai][bj][m][0] * s, v1 = acc[ai][bj][m][1] * s;
                        const unsigned w0 = cvtpk(v0[0], v0[1]), w1 = cvtpk(v0[2], v0[3]), w2 = cvtpk(v1[0], v1[1]), w3 = cvtpk(v1[2], v1[3]);
                        bp[0 * 8] = (bf16_t)(w0 & 0xffff); bp[1 * 8] = (bf16_t)(w0 >> 16); bp[2 * 8] = (bf16_t)(w1 & 0xffff); bp[3 * 8] = (bf16_t)(w1 >> 16);
                        bp[4 * 8] = (bf16_t)(w2 & 0xffff); bp[5 * 8] = (bf16_t)(w2 >> 16); bp[6 * 8] = (bf16_t)(w3 & 0xffff); bp[7 * 8] = (bf16_t)(w3 >> 16); } }
        } else {
            const bool isK = (pn == 1) || (pn >= 6 && pn <= 8) || pn == 13 || pn == 16;
            int slot = 0, khb = 0, rsh = 0;
            if (pn <= 1) { slot = 0; khb = 0; } else if (pn <= 8) { const int gI = (pn - 3) % 3; rsh = 2 * gI; slot = 1 + gI; khb = 4 + 4 * gI; } else if (pn <= 13) { slot = 4; khb = 16; } else { slot = 5; khb = 20; }
            const int slsh = 11 - rsh, rmask = (1 << rsh) - 1;
#pragma unroll
            for (int ai = 0; ai < 2; ++ai)
#pragma unroll
                for (int m = 0; m < 4; ++m) { const int lrow = lrow0 + ai * HALF + m * 16; const float s = rs[ai][m];
                    const int bl = lrow >> 11, t = lrow & (SEQ - 1); const int p = ((t & rmask) << slsh) + (t >> rsh);
#pragma unroll
                    for (int bj = 0; bj < 2; ++bj) { const f32x4 v0 = acc[ai][bj][m][0] * s, v1 = acc[ai][bj][m][1] * s;
                        u32x4 w; w.x = cvtpk(v0[0], v0[1]); w.y = cvtpk(v0[2], v0[3]); w.z = cvtpk(v1[0], v1[1]); w.w = cvtpk(v1[2], v1[3]);
                        const int c0 = bj * HALF + cin;
                        if (isK) { const int dcol = c0 & 63;
                            *(u32x4*)(KF + (size_t)(bl * 24 + khb + (c0 >> 6)) * HSEQ + (size_t)(p >> 5) * 2048 + (dcol >> 4) * 512 + (((dcol >> 3) & 1) * 32 + (p & 31)) * 8) = w; }
                        else *(u32x4*)(QK + (size_t)(bl * SEQ + p) * LDQK + slot * 256 + c0) = w; } }
        }
    }
};

struct EpiBranch {
    static constexpr bool PERM = true;
    const bf16_t* GATE; bf16_t* MERGED; int row_base;
    __device__ __forceinline__ static float sg(float g) { return __builtin_amdgcn_rcpf(1.0f + ex2(-g * LOG2E)); }
    __device__ __forceinline__ static u32x4 mix(const u32x4 ga, const u32x4 gb, const u32x4 ow, const f32x4 a0, const f32x4 a1, const f32x4 b0, const f32x4 b1) {
        const float o0 = sg(bflo(ga.x)) * a0[0] + sg(bflo(gb.x)) * b0[0] + bflo(ow.x), o1 = sg(bfhi(ga.x)) * a0[1] + sg(bfhi(gb.x)) * b0[1] + bfhi(ow.x);
        const float o2 = sg(bflo(ga.y)) * a0[2] + sg(bflo(gb.y)) * b0[2] + bflo(ow.y), o3 = sg(bfhi(ga.y)) * a0[3] + sg(bfhi(gb.y)) * b0[3] + bfhi(ow.y);
        const float o4 = sg(bflo(ga.z)) * a1[0] + sg(bflo(gb.z)) * b1[0] + bflo(ow.z), o5 = sg(bfhi(ga.z)) * a1[1] + sg(bfhi(gb.z)) * b1[1] + bfhi(ow.z);
        const float o6 = sg(bflo(ga.w)) * a1[2] + sg(bflo(gb.w)) * b1[2] + bflo(ow.w), o7 = sg(bfhi(ga.w)) * a1[3] + sg(bfhi(gb.w)) * b1[3] + bfhi(ow.w);
        u32x4 w; w.x = cvtpk(o0, o1); w.y = cvtpk(o2, o3); w.z = cvtpk(o4, o5); w.w = cvtpk(o6, o7); return w;
    }
    __device__ __forceinline__ void operator()(const f32x4 (&acc)[2][2][4][2], const Unit& u, int wr, int wc, int fr, int fq) const {
        const int p = u.aux; const int lrow0 = u.pm * BM + wr * 64 + fr; const int d0 = u.pn * 128 + wc * 32 + 8 * fq;
        const bf16_t* gbase = GATE + (size_t)lrow0 * 4096 + (2 * p) * 1024 + d0; bf16_t* mbase = MERGED + (size_t)(row_base + lrow0) * DM + d0;
        const u32x4 zero = {0u, 0u, 0u, 0u};
#pragma unroll
        for (int ai = 0; ai < 2; ++ai)
#pragma unroll
            for (int mp = 0; mp < 2; ++mp) {
                u32x4 ga[2], gb[2], ow[2];
#pragma unroll
                for (int mm = 0; mm < 2; ++mm) { const size_t ro = (size_t)(ai * HALF + (2 * mp + mm) * 16);
                    ga[mm] = *(const u32x4*)(gbase + ro * 4096); gb[mm] = *(const u32x4*)(gbase + ro * 4096 + 1024);
                    ow[mm] = zero; if (p > 0) ow[mm] = *(const u32x4*)(mbase + ro * DM); }
#pragma unroll
                for (int mm = 0; mm < 2; ++mm) { const int m = 2 * mp + mm; const size_t ro = (size_t)(ai * HALF + m * 16);
                    *(u32x4*)(mbase + ro * DM) = mix(ga[mm], gb[mm], ow[mm], acc[ai][0][m][0], acc[ai][0][m][1], acc[ai][1][m][0], acc[ai][1][m][1]); }
                asm volatile("" ::: "memory");
            }
    }
};

struct EpiResid {
    static constexpr bool PERM = true;
    const float* Xin; float* X; bf16_t* XB; float* ssq;
    __device__ __forceinline__ void operator()(const f32x4 (&acc)[2][2][4][2], const Unit& u, int wr, int wc, int fr, int fq) const {
        const int row0 = u.pm * BM + wr * 64 + fr; const int col0 = u.pn * BM + wc * 32 + 8 * fq;
#pragma unroll
        for (int ai = 0; ai < 2; ++ai)
#pragma unroll
            for (int m = 0; m < 4; ++m) { const int row = row0 + ai * HALF + m * 16; float sq = 0.f;
#pragma unroll
                for (int bj = 0; bj < 2; ++bj) { const int col = col0 + bj * HALF; f32x4* xp = (f32x4*)(X + (size_t)row * DM + col); const f32x4* xi = (const f32x4*)(Xin + (size_t)row * DM + col);
                    const f32x4 x0 = xi[0] + acc[ai][bj][m][0], x1 = xi[1] + acc[ai][bj][m][1];
                    xp[0] = x0; xp[1] = x1;
                    u32x4 w; w.x = cvtpk(x0[0], x0[1]); w.y = cvtpk(x0[2], x0[3]); w.z = cvtpk(x1[0], x1[1]); w.w = cvtpk(x1[2], x1[3]);
                    *(u32x4*)(XB + (size_t)row * DM + col) = w;
                    sq += (x0[0] * x0[0] + x0[1] * x0[1]) + (x0[2] * x0[2] + x0[3] * x0[3]) + (x1[0] * x1[0] + x1[1] * x1[1]) + (x1[2] * x1[2] + x1[3] * x1[3]); }
                sq = x16_sum(sq); sq = x32_sum(sq);
                if (fq == 0) ssq[(size_t)row * 16 + u.pn * 4 + wc] = sq; if (m & 1) asm volatile("" ::: "memory"); }
    }
};

struct EpiFinal {
    static constexpr bool PERM = true;
    const float* X; float* out; float* ssq; const float* gfin; unsigned* cnt;
    __device__ __forceinline__ void operator()(f32x4 (&acc)[2][2][4][2], const Unit& u, int wr, int wc, int fr, int fq) const {
        const int row0 = u.pm * BM + wr * 64 + fr; const int col0 = u.pn * BM + wc * 32 + 8 * fq;
#pragma unroll
        for (int ai = 0; ai < 2; ++ai)
#pragma unroll
            for (int m = 0; m < 4; ++m) { const int row = row0 + ai * HALF + m * 16; float sq = 0.f;
#pragma unroll
                for (int bj = 0; bj < 2; ++bj) { const f32x4* xi = (const f32x4*)(X + (size_t)row * DM + col0 + bj * HALF);
                    const f32x4 x0 = xi[0] + acc[ai][bj][m][0], x1 = xi[1] + acc[ai][bj][m][1];
                    acc[ai][bj][m][0] = x0; acc[ai][bj][m][1] = x1;
                    sq += (x0[0] * x0[0] + x0[1] * x0[1]) + (x0[2] * x0[2] + x0[3] * x0[3]) + (x1[0] * x1[0] + x1[1] * x1[1]) + (x1[2] * x1[2] + x1[3] * x1[3]); }
                sq = x16_sum(sq); sq = x32_sum(sq);
                if (fq == 0) __hip_atomic_store(ssq + (size_t)row * 16 + u.pn * 4 + wc, sq, __ATOMIC_RELAXED, __HIP_MEMORY_SCOPE_AGENT);
                if (m & 1) asm volatile("" ::: "memory"); }
        asm volatile("s_waitcnt vmcnt(0)" ::: "memory");
        unsigned* c = cnt + 64 * u.pm;
        if ((fr | fq) == 0) {
            __hip_atomic_fetch_add(c, 1u, __ATOMIC_RELAXED, __HIP_MEMORY_SCOPE_AGENT);
            unsigned sp = 0;
            while (__hip_atomic_load(c, __ATOMIC_RELAXED, __HIP_MEMORY_SCOPE_AGENT) < 32u) { __builtin_amdgcn_s_sleep(2); if (++sp > (1u << 22)) break; }
        }
        __builtin_amdgcn_fence(__ATOMIC_ACQUIRE, "agent");
        asm volatile("s_waitcnt vmcnt(0)" ::: "memory");
        float rs[2][4];
#pragma unroll
        for (int ai = 0; ai < 2; ++ai)
#pragma unroll
            for (int m = 0; m < 4; ++m) rs[ai][m] = row_rstd(ssq, row0 + ai * HALF + m * 16, fq);
#pragma unroll
        for (int bj = 0; bj < 2; ++bj) { const f32x4 g0 = *(const f32x4*)(gfin + col0 + bj * HALF), g1 = *(const f32x4*)(gfin + col0 + bj * HALF + 4);
#pragma unroll
            for (int ai = 0; ai < 2; ++ai)
#pragma unroll
                for (int m = 0; m < 4; ++m) { const int row = row0 + ai * HALF + m * 16; f32x4* op = (f32x4*)(out + (size_t)row * DM + col0 + bj * HALF);
                    op[0] = acc[ai][bj][m][0] * rs[ai][m] * g0; op[1] = acc[ai][bj][m][1] * rs[ai][m] * g1; } }
    }
};

struct EpiUp {
    static constexpr bool PERM = true;
    const float* ssq; bf16_t* H;
    __device__ __forceinline__ void operator()(const f32x4 (&acc)[2][2][4][2], const Unit& u, int wr, int wc, int fr, int fq) const {
        const int row0 = u.pm * BM + wr * 64 + fr; const int col0 = u.pn * BM + wc * 32 + 8 * fq;
        float rs[2][4];
#pragma unroll
        for (int ai = 0; ai < 2; ++ai)
#pragma unroll
            for (int m = 0; m < 4; ++m) rs[ai][m] = row_rstd(ssq, row0 + ai * HALF + m * 16, fq);
#pragma unroll
        for (int ai = 0; ai < 2; ++ai)
#pragma unroll
            for (int m = 0; m < 4; ++m) { const int row = row0 + ai * HALF + m * 16; const float s = rs[ai][m];
#pragma unroll
                for (int bj = 0; bj < 2; ++bj) { f32x4 v0 = acc[ai][bj][m][0] * s, v1 = acc[ai][bj][m][1] * s;
#pragma unroll
                    for (int i = 0; i < 4; ++i) { const float a = fmaxf(v0[i], 0.f), b = fmaxf(v1[i], 0.f); v0[i] = a * a; v1[i] = b * b; }
                    u32x4 w; w.x = cvtpk(v0[0], v0[1]); w.y = cvtpk(v0[2], v0[3]); w.z = cvtpk(v1[0], v1[1]); w.w = cvtpk(v1[2], v1[3]);
                    *(u32x4*)(H + (size_t)row * DFF + col0 + bj * HALF) = w; } }
    }
};
}

__device__ __forceinline__ int win_src(int n) {
    if (n < 3840) return n;
    if (n < 4608) return n + 4;
    if (n < 4864) return (n - 4608 < 4) ? 3840 + (n - 4608) : -1;
    return n - 4864 + 4612;
}
template <int CMAP>
__device__ __forceinline__ void transpose_item(const float* W, int K, int N, int Nsrc, const float* gain, bf16_t* WT, LAS float* scr, int item, int lane) {
    const int nblk = N / 32, kb = item / nblk, nb = item % nblk, k0 = 64 * kb, n0 = 32 * nb;
    const int n = n0 + (lane & 31); const int src = CMAP ? win_src(n) : n;
    const bool live = (src >= 0); const float* wp = W + (size_t)(k0 + (lane >> 5)) * Nsrc + (live ? src : 0); const float* gp = gain ? gain + k0 + (lane >> 5) : nullptr;
    float wv[32];
#pragma unroll
    for (int i = 0; i < 32; ++i) wv[i] = wp[(size_t)(2 * i) * Nsrc];
#pragma unroll
    for (int i = 0; i < 32; ++i) { float v = live ? wv[i] : 0.f; if (gp) v *= gp[2 * i]; scr[(2 * i + (lane >> 5)) * 33 + (lane & 31)] = v; }
    asm volatile("s_waitcnt lgkmcnt(0)" ::: "memory");
    const int c = lane & 7;
#pragma unroll
    for (int j = 0; j < 4; ++j) { const int nn = (lane >> 3) + 8 * j; const LAS float* s = scr + (8 * c) * 33 + nn;
        u32x4 o; o.x = cvtpk(s[0 * 33], s[1 * 33]); o.y = cvtpk(s[2 * 33], s[3 * 33]); o.z = cvtpk(s[4 * 33], s[5 * 33]); o.w = cvtpk(s[6 * 33], s[7 * 33]);
        *(u32x4*)(WT + (size_t)(n0 + nn) * K + k0 + 8 * c) = o; }
    asm volatile("s_waitcnt lgkmcnt(0)" ::: "memory");
}

__device__ __forceinline__ void branch_item(const float* Wn, int n, bf16_t* WBP, LAS float* scr, int item, int lane) {
    const int kb = item >> 5, nb = item & 31, k0 = 64 * kb, n0 = 32 * nb;
    const float* wp = Wn + (size_t)(k0 + (lane >> 5)) * DM + n0 + (lane & 31);
    float wv[32];
#pragma unroll
    for (int i = 0; i < 32; ++i) wv[i] = wp[(size_t)(2 * i) * DM];
#pragma unroll
    for (int i = 0; i < 32; ++i) scr[(2 * i + (lane >> 5)) * 33 + (lane & 31)] = wv[i];
    asm volatile("s_waitcnt lgkmcnt(0)" ::: "memory");
    const int c = lane & 7, bj = n & 1, pair = n >> 1;
    const u32x4 zero = {0u, 0u, 0u, 0u};
#pragma unroll
    for (int j = 0; j < 4; ++j) { const int nn = (lane >> 3) + 8 * j; const LAS float* sp = scr + (8 * c) * 33 + nn; const int d = n0 + nn;
        u32x4 o; o.x = cvtpk(sp[0 * 33], sp[1 * 33]); o.y = cvtpk(sp[2 * 33], sp[3 * 33]); o.z = cvtpk(sp[4 * 33], sp[5 * 33]); o.w = cvtpk(sp[6 * 33], sp[7 * 33]);
        bf16_t* row = WBP + ((size_t)((pair * 8 + (d >> 7)) * 256 + bj * 128 + (d & 127))) * 512 + k0 + 8 * c;
        *(u32x4*)(row + 256 * bj) = o; *(u32x4*)(row + 256 * (1 - bj)) = zero; }
    asm volatile("s_waitcnt lgkmcnt(0)" ::: "memory");
}

#define MFMA32(a, b, c) __builtin_amdgcn_mfma_f32_32x32x16_bf16((a), (b), (c), 0, 0, 0)
__device__ __forceinline__ bf16x8 ld16(const bf16_t* p) { return *(const bf16x8*)p; }
__device__ __forceinline__ bf16x8 pack8(const f32x16& s, int b) { u32x4 w; w.x = cvtpk(s[b], s[b + 1]); w.y = cvtpk(s[b + 2], s[b + 3]); w.z = cvtpk(s[b + 4], s[b + 5]); w.w = cvtpk(s[b + 6], s[b + 7]); return __builtin_bit_cast(bf16x8, w); }
__device__ __forceinline__ int crow(int r, int hi) { return (r & 3) + 8 * (r >> 2) + 4 * hi; }
__device__ __forceinline__ void store_o(bf16_t* orow, const f32x16& o0, const f32x16& o1, int hi) {
#pragma unroll
    for (int g = 0; g < 4; ++g) {
        u32x2 a; a.x = cvtpk(o0[4 * g], o0[4 * g + 1]); a.y = cvtpk(o0[4 * g + 2], o0[4 * g + 3]); *(u32x2*)(orow + 8 * g + 4 * hi) = a;
        u32x2 b; b.x = cvtpk(o1[4 * g], o1[4 * g + 1]); b.y = cvtpk(o1[4 * g + 2], o1[4 * g + 3]); *(u32x2*)(orow + 32 + 8 * g + 4 * hi) = b; }
}

struct KFrag { bf16x8 k[4]; };
struct VFrag { bf16x8 v[4]; };
__device__ __forceinline__ void k_load(KFrag& f, const bf16_t* Kh, int kb, int lane) {
    const bf16_t* kp = Kh + (size_t)kb * 2048 + lane * 8;
#pragma unroll
    for (int ds = 0; ds < 4; ++ds) f.k[ds] = ld16(kp + ds * 512);
}
__device__ __forceinline__ void v_load(VFrag& f, const bf16_t* Vh, int kb, int lane) {
    const bf16_t* vp = Vh + (size_t)kb * 2048 + lane * 8;
    f.v[0] = ld16(vp); f.v[1] = ld16(vp + 512); f.v[2] = ld16(vp + 1024); f.v[3] = ld16(vp + 1536);
}
__device__ __forceinline__ void q_load(bf16x8 (&qf)[4], const bf16_t* Qs, int qb, int r32, int hi) {
    const bf16_t* qp = Qs + (size_t)(qb * 32 + r32) * LDQK + hi * 8;
#pragma unroll
    for (int ds = 0; ds < 4; ++ds) qf[ds] = ld16(qp + ds * 16);
}

template <int MODE, bool MASK, int NDS>
__device__ __forceinline__ void sm_step(const bf16x8 (&ck)[NDS], const bf16x8 (&qf)[NDS], const VFrag& cv, float slope2, const LAS float* cl, int kb, int d0,
                                        float& m, float& l, f32x16& o0, f32x16& o1, int hi) {
    constexpr float SC2 = ((MODE == 2) ? 0.17677669529663687f : 0.125f) * LOG2E;
    f32x16 s;
#pragma unroll
    for (int i = 0; i < 16; ++i) s[i] = 0.f;
#pragma unroll
    for (int ds = 0; ds < NDS; ++ds) s = MFMA32(ck[ds], qf[ds], s);
#define KC(r) (((r) & 3) + 8 * ((r) >> 2))
    int dh = d0 - 4 * hi; asm volatile("" : "+v"(dh));
    float sl = slope2; asm volatile("" : "+v"(sl));
    const LAS float* clk = cl + 33 * kb + 4 * hi; if (MODE == 0) asm volatile("" : "+v"(clk));
    const float base = (MODE == 0) ? 0.f : -sl * (float)dh;
#pragma unroll
    for (int r = 0; r < 16; ++r) {
        float v = (MODE == 0) ? fmaf(s[r], SC2, clk[KC(r)]) : fmaf(s[r], SC2, sl * (float)KC(r));
        if (MASK) { const int dist = dh - KC(r); const bool valid = (MODE == 1) ? ((unsigned)dist <= 128u) : (dist >= 0); v = valid ? v : -INFINITY; }
        s[r] = v;
    }
#undef KC
    float mt = fmaxf(fmaxf(s[0], s[1]), fmaxf(s[2], s[3]));
#pragma unroll
    for (int r = 4; r < 16; r += 4) mt = fmaxf(mt, fmaxf(fmaxf(s[r], s[r + 1]), fmaxf(s[r + 2], s[r + 3])));
    mt = x32_max(mt + base);
    const float mn = fmaxf(m, mt), alpha = ex2(m - mn), c = mn - base;
    float ps = 0.f;
#pragma unroll
    for (int r = 0; r < 16; ++r) { const float p = ex2(s[r] - c); s[r] = p; ps += p; }
    l = l * alpha + ps; m = mn;
#pragma unroll
    for (int i = 0; i < 16; ++i) { o0[i] *= alpha; o1[i] *= alpha; }
    const bf16x8 pf0 = pack8(s, 0), pf1 = pack8(s, 8);
    o0 = MFMA32(cv.v[0], pf0, o0); o0 = MFMA32(cv.v[1], pf1, o0); o1 = MFMA32(cv.v[2], pf0, o1); o1 = MFMA32(cv.v[3], pf1, o1);
}
template <int MODE>
__device__ __forceinline__ void sm_unit(const bf16_t* Qs, const bf16_t* Ks, const bf16_t* VTs, int qb, int kb_hi, int kb_lo, float slope2, const LAS float* cl,
                                        f32x16& o0, f32x16& o1, float& m_out, float& l_out, int lane) {
    const int r32 = lane & 31, hi = lane >> 5;
    constexpr int NDS = (MODE == 2) ? 2 : 4;
    bf16x8 qf[NDS];
    { const bf16_t* qp = Qs + (size_t)(qb * 32 + r32) * LDQK + hi * 8;
#pragma unroll
      for (int ds = 0; ds < NDS; ++ds) qf[ds] = ld16(qp + ds * 16); }
    bf16x8 nk[NDS];
    { const bf16_t* kp = Ks + (size_t)kb_hi * 2048 + lane * 8;
#pragma unroll
      for (int ds = 0; ds < NDS; ++ds) nk[ds] = ld16(kp + ds * 512); }
    float m = -INFINITY, l = 0.f;
#pragma unroll
    for (int i = 0; i < 16; ++i) { o0[i] = 0.f; o1[i] = 0.f; }
    for (int kb = kb_hi; kb >= kb_lo; --kb) {
        bf16x8 ck[NDS];
#pragma unroll
        for (int ds = 0; ds < NDS; ++ds) ck[ds] = nk[ds];
        VFrag cv; v_load(cv, VTs, kb, lane);
        if (kb > kb_lo) { const bf16_t* kp = Ks + (size_t)(kb - 1) * 2048 + lane * 8;
#pragma unroll
            for (int ds = 0; ds < NDS; ++ds) nk[ds] = ld16(kp + ds * 512); }
        const int d0 = (qb - kb) * 32 + r32;
        const bool edge = (MODE == 1) ? (kb == qb || kb + 4 <= qb) : (kb == qb);
        if (edge) sm_step<MODE, true, NDS>(ck, qf, cv, slope2, cl, kb, d0, m, l, o0, o1, hi);
        else      sm_step<MODE, false, NDS>(ck, qf, cv, slope2, cl, kb, d0, m, l, o0, o1, hi);
    }
    l = x32_sum(l);
    m_out = m; l_out = l;
}

template <int MODE>
__device__ __forceinline__ void sm_unit64(const bf16_t* Qs, const bf16_t* Ks, const bf16_t* VTs, int Q, int kb_hi, int kb_lo, float slope2, const LAS float* cl,
                                          f32x16 (&o)[2][2], float (&m)[2], float (&l)[2], int lane) {
    const int r32 = lane & 31, hi = lane >> 5;
    constexpr int NDS = (MODE == 2) ? 2 : 4;
    bf16x8 qf[2][NDS];
#pragma unroll
    for (int i = 0; i < 2; ++i) { const bf16_t* qp = Qs + (size_t)((2 * Q + i) * 32 + r32) * LDQK + hi * 8;
#pragma unroll
        for (int ds = 0; ds < NDS; ++ds) qf[i][ds] = ld16(qp + ds * 16); }
    bf16x8 nk[NDS];
    { const bf16_t* kp = Ks + (size_t)kb_hi * 2048 + lane * 8;
#pragma unroll
      for (int ds = 0; ds < NDS; ++ds) nk[ds] = ld16(kp + ds * 512); }
#pragma unroll
    for (int i = 0; i < 2; ++i) { m[i] = -INFINITY; l[i] = 0.f;
#pragma unroll
        for (int k = 0; k < 16; ++k) { o[i][0][k] = 0.f; o[i][1][k] = 0.f; } }
    for (int kb = kb_hi; kb >= kb_lo; --kb) {
        bf16x8 ck[NDS];
#pragma unroll
        for (int ds = 0; ds < NDS; ++ds) ck[ds] = nk[ds];
        VFrag cv; v_load(cv, VTs, kb, lane);
        if (kb > kb_lo) { const bf16_t* kp = Ks + (size_t)(kb - 1) * 2048 + lane * 8;
#pragma unroll
            for (int ds = 0; ds < NDS; ++ds) nk[ds] = ld16(kp + ds * 512); }
        if (kb < 2 * Q) {
            const int d00 = (2 * Q - kb) * 32 + r32;
            sm_step<MODE, false, NDS>(ck, qf[0], cv, slope2, cl, kb, d00, m[0], l[0], o[0][0], o[0][1], hi);
            sm_step<MODE, false, NDS>(ck, qf[1], cv, slope2, cl, kb, d00 + 32, m[1], l[1], o[1][0], o[1][1], hi);
        } else {
#pragma unroll
            for (int i = 0; i < 2; ++i) {
                const int qbi = 2 * Q + i;
                if (kb <= qbi) {
                    const int d0 = (qbi - kb) * 32 + r32;
                    if (kb == qbi) sm_step<MODE, true, NDS>(ck, qf[i], cv, slope2, cl, kb, d0, m[i], l[i], o[i][0], o[i][1], hi);
                    else           sm_step<MODE, false, NDS>(ck, qf[i], cv, slope2, cl, kb, d0, m[i], l[i], o[i][0], o[i][1], hi);
                }
            }
        }
    }
    l[0] = x32_sum(l[0]); l[1] = x32_sum(l[1]);
}

__device__ __forceinline__ void sb_unit(const bf16_t* Qs, const bf16_t* Ks, const bf16_t* VTs, int qb, f32x16& o0, f32x16& o1, int lane) {
    const int r32 = lane & 31, hi = lane >> 5;
    constexpr float SC2 = 0.125f * LOG2E;
    bf16x8 qf[4]; q_load(qf, Qs, qb, r32, hi);
    KFrag nx; k_load(nx, Ks, qb, lane);
    float R = 0.f;
#pragma unroll
    for (int i = 0; i < 16; ++i) { o0[i] = 0.f; o1[i] = 0.f; }
    for (int kb = qb; kb >= 0; --kb) {
        const KFrag cu = nx; VFrag cv; v_load(cv, VTs, kb, lane);
        if (kb > 0) k_load(nx, Ks, kb - 1, lane);
        f32x16 s;
#pragma unroll
        for (int i = 0; i < 16; ++i) s[i] = 0.f;
#pragma unroll
        for (int ds = 0; ds < 4; ++ds) s = MFMA32(cu.k[ds], qf[ds], s);
        float lk[16], ls[16];
        const int d0 = (qb - kb) * 32 + r32;
#pragma unroll
        for (int r = 0; r < 16; ++r) { const float z2 = s[r] * SC2; const float sp = fmaxf(z2, 0.f) + lg2(1.0f + ex2(-fabsf(z2))); const bool valid = crow(r, hi) < d0; lk[r] = valid ? -sp : 0.f; ls[r] = valid ? (z2 - sp) : -INFINITY; }
        float e[16], tq[4], pq[4];
#pragma unroll
        for (int g = 0; g < 4; ++g) { e[4 * g + 3] = 0.f; e[4 * g + 2] = lk[4 * g + 3]; e[4 * g + 1] = e[4 * g + 2] + lk[4 * g + 2]; e[4 * g] = e[4 * g + 1] + lk[4 * g + 1]; tq[g] = e[4 * g] + lk[4 * g]; }
#pragma unroll
        for (int g = 0; g < 4; ++g) pq[g] = x32_partner(tq[g], hi);
        float cs[4]; cs[3] = 0.f; cs[2] = tq[3] + pq[3]; cs[1] = cs[2] + (tq[2] + pq[2]); cs[0] = cs[1] + (tq[1] + pq[1]);
        const float total = cs[0] + (tq[0] + pq[0]);
#pragma unroll
        for (int g = 0; g < 4; ++g) { const float later = R + cs[g] + (hi == 0 ? pq[g] : 0.f);
#pragma unroll
            for (int i = 0; i < 4; ++i) s[4 * g + i] = ex2(ls[4 * g + i] + e[4 * g + i] + later); }
        R += total;
        const bf16x8 pf0 = pack8(s, 0), pf1 = pack8(s, 8);
        o0 = MFMA32(cv.v[0], pf0, o0); o0 = MFMA32(cv.v[1], pf1, o0); o1 = MFMA32(cv.v[2], pf0, o1); o1 = MFMA32(cv.v[3], pf1, o1);
        if (__all(R < -150.0f)) break;
    }
}

#define XB_TMO      128
#define XB_XCNT(j)  (256  + 64 * (j))
#define XB_XSUB(j)  (1280 + 64 * (j))
#define XB_XGEN(j)  (2304 + 64 * (j))
#define XB_TOP      3328
#define XB_TOPGEN   3392
#define XCD_BAR_WORDS 3456
#define XB_SPIN_CAP (1u << 18)
__device__ __forceinline__ unsigned xb_ld(unsigned* p)              { return __hip_atomic_load(p, __ATOMIC_RELAXED, __HIP_MEMORY_SCOPE_AGENT); }
__device__ __forceinline__ unsigned xb_add(unsigned* p, unsigned v) { return __hip_atomic_fetch_add(p, v, __ATOMIC_RELAXED, __HIP_MEMORY_SCOPE_AGENT); }
__device__ __forceinline__ unsigned xb_xcc_id() { return (unsigned)__builtin_amdgcn_s_getreg((3 << 11) | 20) & 0xFu; }
#define XB_SPIN(cond, bar) do { unsigned _sp = 0; while (cond) { __builtin_amdgcn_s_sleep(1); \
    if ((++_sp & 255u) == 0u) { if (xb_ld(&(bar)[XB_TMO])) break; if (_sp > XB_SPIN_CAP) { atomicAdd(&(bar)[XB_TMO], 1u); break; } } } } while (0)
__device__ __forceinline__ void xcd_barrier_complete(unsigned* bar, unsigned x, unsigned& nloc, unsigned& nx) {
    const unsigned G = gridDim.x * gridDim.y * gridDim.z;
    unsigned sum, cnt, mine, sp = 0u;
    for (;;) {
        sum = 0u; cnt = 0u; mine = 0u;
#pragma unroll
        for (unsigned j = 0; j < 16; ++j) { const unsigned c = xb_ld(&bar[XB_XCNT(j)]); sum += c; cnt += (c > 0u) ? 1u : 0u; mine = (j == x) ? c : mine; }
        if (sum == G) break;
        __builtin_amdgcn_s_sleep(1);
        if ((++sp & 255u) == 0u) { if (xb_ld(&bar[XB_TMO])) break; if (sp > XB_SPIN_CAP) { atomicAdd(&bar[XB_TMO], 1u); break; } }
    }
    nloc = mine > 0u ? mine : 1u; nx = cnt > 0u ? cnt : 1u;
}
__device__ __forceinline__ void xcd_barrier(unsigned* bar, volatile LAS unsigned* st) {
    asm volatile("s_waitcnt vmcnt(0)" ::: "memory");
    __syncthreads();
    if (threadIdx.x == 0) {
        const unsigned x = xb_xcc_id();
        __builtin_amdgcn_s_waitcnt(0);
        unsigned nloc = st[0], nx = st[1];
        if (nloc == 0u) { xcd_barrier_complete(bar, x, nloc, nx); st[0] = nloc; st[1] = nx; }
        const unsigned old = xb_add(&bar[XB_XSUB(x)], 1u);
        const unsigned gen = old / nloc;
        if (old + 1u == (gen + 1u) * nloc) {
            __builtin_amdgcn_fence(__ATOMIC_RELEASE, "agent");
            asm volatile("s_waitcnt vmcnt(0)" ::: "memory");
            const unsigned og = xb_add(&bar[XB_TOP], 1u);
            const unsigned tg = og / nx;
            if (og + 1u == (tg + 1u) * nx) xb_add(&bar[XB_TOPGEN], 1u);
            else XB_SPIN(xb_ld(&bar[XB_TOPGEN]) == tg, bar);
            __builtin_amdgcn_fence(__ATOMIC_ACQUIRE, "agent");
            xb_add(&bar[XB_XGEN(x)], 1u);
            asm volatile("s_waitcnt vmcnt(0)" ::: "memory");
        } else {
            XB_SPIN(xb_ld(&bar[XB_XGEN(x)]) == gen, bar);
            __builtin_amdgcn_fence(__ATOMIC_ACQUIRE, "agent");
            asm volatile("s_waitcnt vmcnt(0)" ::: "memory");
        }
    }
    __syncthreads();
}
constexpr int MISC_OFF = 131072 + 320;

struct Params {
    const float* x; const float* mix_g; const float* w_in; const float* b_forget; const float* lq1; const float* lk1; const float* lq2; const float* lk2;
    const float* diff_g; const float* w_branch; const float* w_out; const float* mlp_g; const float* w_up; const float* w_down; const float* final_g;
    float* out; unsigned char* ws;
};

#ifndef REP_P1
#define REP_P1 1
#endif
#ifndef REP_P2
#define REP_P2 1
#endif
#ifndef REP_P3
#define REP_P3 1
#endif
#ifndef REP_P5
#define REP_P5 1
#endif
#ifndef REP_SYNC
#define REP_SYNC 1
#endif
#ifndef REP_CONV
#define REP_CONV 1
#endif
#define GSYNC() do { for (int rs_ = 0; rs_ < REP_SYNC; ++rs_) { KParamsPtr pb_ = OPQ_PP(); xcd_barrier((unsigned*)(pb_->ws + WS_CTL) + CW_BAR, (volatile LAS unsigned*)(lds + MISC_OFF)); } } while (0)
#define OPQ_TID() ({ int t_ = threadIdx.x; asm volatile("" : "+v"(t_)); t_; })
typedef const __attribute__((address_space(4))) Params* KParamsPtr;
#define OPQ_PP() ({ KParamsPtr p_ = (KParamsPtr)__builtin_amdgcn_kernarg_segment_ptr(); asm volatile("" : "+s"(p_)); p_; })
#define PHASE_VARS() const int tid = OPQ_TID(); const int lane = tid & 63, wave = __builtin_amdgcn_readfirstlane(tid >> 6); const int G = gridDim.x, bx = blockIdx.x; \
    const int gw = bx * NWAVES + wave, NGW = G * NWAVES; KParamsPtr PP = OPQ_PP(); unsigned char* ws = PP->ws; LAS float* scr = (LAS float*)(lds + wave * 16384); (void)lane; (void)gw; (void)NGW; (void)ws; (void)scr; (void)G; (void)bx; (void)PP

__global__ void __launch_bounds__(NWAVES * 64, 2) fwd_mega(Params P) {
    extern __shared__ __attribute__((aligned(16))) unsigned char lds_raw[];
    LAS unsigned char* lds = (LAS unsigned char*)lds_raw;
    cg::grid_group grid = cg::this_grid();
    { KParamsPtr pz = OPQ_PP(); if (pz->ws == nullptr) grid.sync(); }
    { const int t0 = OPQ_TID(); if (t0 < 64) ((LAS unsigned*)(lds + 131072))[t0 + 64] = 0u; __syncthreads();
      if (t0 == 0) { KParamsPtr p0 = OPQ_PP(); (void)xb_add((unsigned*)(p0->ws + WS_CTL) + CW_BAR + XB_XCNT(xb_xcc_id()), 1u); } }

    {
        PHASE_VARS();
        bf16_t* XB = (bf16_t*)(ws + WS_XB); float* SSQ = (float*)(ws + WS_SSQ);
        for (int row = gw; row < TOK; row += NGW) {
            const f32x4* xr = (const f32x4*)(PP->x + (size_t)row * DM) + lane;
            unsigned long long* o8 = (unsigned long long*)(XB + (size_t)row * DM) + lane;
            float s = 0.f;
#pragma unroll
            for (int j = 0; j < 4; ++j) { const f32x4 v = xr[64 * j]; s += (v[0] * v[0] + v[1] * v[1]) + (v[2] * v[2] + v[3] * v[3]);
                o8[64 * j] = (unsigned long long)cvtpk(v[0], v[1]) | ((unsigned long long)cvtpk(v[2], v[3]) << 32); }
            s = wave_sum(s);
            if (lane < 16) SSQ[(size_t)row * 16 + lane] = (lane == 0) ? s : 0.f;
        }
    }

    for (int layer = 0; layer < DEPTH; ++layer) {
        for (int rep = 0; rep < REP_CONV; ++rep) {
            PHASE_VARS();
            bf16_t* WIN = (bf16_t*)(ws + WS_WIN); bf16_t* WB = (bf16_t*)(ws + WS_WB); bf16_t* WOUT = (bf16_t*)(ws + WS_WOUT);
            const float* w_in = PP->w_in + (size_t)layer * DM * DIN; const float* mg = PP->mix_g + (size_t)layer * DM;
            const float* wb = PP->w_branch + (size_t)layer * 4 * 256 * DM; const float* wo = PP->w_out + (size_t)layer * DM * DM;
            constexpr int I_IN = (DM / 64) * (NPROJ / 32), I_B = (256 / 64) * (DM / 32), I_O = (DM / 64) * (DM / 32);
            for (int it = gw; it < I_IN + 4 * I_B + I_O; it += NGW) {
                int r = it;
                if (r < I_IN) { transpose_item<1>(w_in, DM, NPROJ, DIN, mg, WIN, scr, r, lane); continue; } r -= I_IN;
                if (r < 4 * I_B) { const int n = r / I_B; branch_item(wb + (size_t)n * 256 * DM, n, WB, scr, r % I_B, lane); continue; } r -= 4 * I_B;
                transpose_item<0>(wo, DM, DM, DM, nullptr, WOUT, scr, r, lane);
            }
        }
        GSYNC();

        for (int half = 0; half < 2; ++half) {
#ifndef NO_P1
            for (int rep = 0; rep < REP_P1; ++rep) {
                PHASE_VARS();
                const int rb = half * HT;
                pg8::Gemm g{(const bf16_t*)(ws + WS_XB) + (size_t)rb * DM, (const bf16_t*)(ws + WS_WIN), DM, DM, DM, 0, 0};
                pg8::StaticOrder S; S.init(HT, NPROJ, G, bx);
                pg8::EpiProj E{(const float*)(ws + WS_SSQ), rb, (bf16_t*)(ws + WS_QK), (bf16_t*)(ws + WS_KF), (bf16_t*)(ws + WS_VT), (float*)(ws + WS_FL), (bf16_t*)(ws + WS_GATE)};
                pg8::gemm_phase<pg8::EpiProj, pg8::StaticOrder, true>(lds, g, S, E);
            }
#endif
            GSYNC();
#ifndef NO_P2
            for (int rep = 0; rep < REP_P2; ++rep) {
                PHASE_VARS();
                unsigned* ctr = (unsigned*)(ws + WS_CTL) + 64 + 512 * (layer * 2 + half + 4 * rep);
                const int xq = bx & 7;
                ctr += 64 * xq;
                for (;;) {
                    int li = 0; if (lane == 0) li = (int)atomicAdd(ctr, 1u); li = __builtin_amdgcn_readfirstlane(li);
                    if (li >= 800) break;
                    int idx;
                    if (li < 288) { const int hl = li / 48, row = li - hl * 48; idx = row * 48 + (xq + 8 * hl); }
                    else if (li < 416) { const int i = li - 288; idx = 2304 + ((63 - (i & 63)) << 4) + (xq + 8 * (i >> 6)); }
                    else { const int i = li - 416; idx = 3328 + (xq + 8 * (i >> 6)) * 64 + (i & 63); }
                    int lane_u = lane; asm volatile("" : "+v"(lane_u));
                    const int lane = lane_u, r32 = lane & 31, hi = lane >> 5;
                    KParamsPtr PU = OPQ_PP(); unsigned char* wsu = PU->ws;
                    bf16_t* YS = (bf16_t*)(wsu + WS_YS); bf16_t* DILO = (bf16_t*)(wsu + WS_DILO); float* LSE = (float*)(wsu + WS_LSE); const float* FL = (const float*)(wsu + WS_FL);
                    const bf16_t* QK = (const bf16_t*)(wsu + WS_QK); const bf16_t* KF = (const bf16_t*)(wsu + WS_KF); const bf16_t* VT = (const bf16_t*)(wsu + WS_VT);
                    if (idx < 2304) {
                        const int j = idx / 48, e = idx - j * 48, type3 = e >> 4, bh = e & 15, b = bh >> 2, h = bh & 3;
                        int Q, chunk; if (j < 32) { Q = 31 - (j >> 1); chunk = j & 1; } else { Q = 47 - j; chunk = 0; }
                        int kb_lo = 0, kb_hi = 2 * Q + 1;
                        if (Q >= 16) { if (chunk == 0) kb_hi = Q; else kb_lo = Q + 1; }
                        const size_t rowb = (size_t)b * SEQ;
                        bf16_t* SCRB = (bf16_t*)(wsu + WS_MERGED) + (size_t)(half * HT) * DM;
                        float* LSE2 = (float*)(wsu + WS_LSE2);
                        f32x16 o[2][2]; float m[2], l[2]; int slot;
                        if (type3 == 2) {
                            LAS float* cl = scr;
                            const float bf = PP->b_forget[layer * 4 + h];
                            float run = 0.f;
                            if (lane <= kb_hi) {
                                const float* fp = FL + (rowb + 32 * lane) * 4 + h;
#pragma unroll 8
                                for (int i = 0; i < 32; ++i) { const float y = fp[4 * i] + bf; const float lf = fminf(y, 0.f) - __logf(1.0f + __expf(-fabsf(y))); run += lf; cl[33 * lane + i] = run; }
                            }
                            float incl = run;
#pragma unroll
                            for (int o_ = 1; o_ < 64; o_ <<= 1) { const float tt = __uint_as_float((unsigned)__builtin_amdgcn_ds_bpermute((lane - o_) << 2, (int)__float_as_uint(incl))); if (lane >= o_) incl += tt; }
                            const float excl = incl - run;
                            if (lane <= kb_hi) {
#pragma unroll 8
                                for (int i = 0; i < 32; ++i) cl[33 * lane + i] = -(cl[33 * lane + i] + excl) * LOG2E;
                            }
                            asm volatile("s_waitcnt lgkmcnt(0)" ::: "memory");
                            sm_unit64<0>(QK + rowb * LDQK + 4 * 256 + h * 64, KF + (size_t)(b * 24 + 16 + h) * HSEQ, VT + (size_t)(b * 24 + 16 + h) * HSEQ, Q, kb_hi, kb_lo, 0.f, cl, o, m, l, lane);
                            asm volatile("s_waitcnt lgkmcnt(0)" ::: "memory");
                            slot = chunk;
                        } else {
                            const float slope = exp2f(-8.0f * (float)(5 + h) / 16.0f);
                            sm_unit64<2>(QK + rowb * LDQK + 5 * 256 + h * 64 + type3 * 32, KF + (size_t)(b * 24 + 20 + h) * HSEQ + type3 * 1024, VT + (size_t)(b * 24 + 20 + h) * HSEQ, Q, kb_hi, kb_lo, slope * LOG2E, nullptr, o, m, l, lane);
                            slot = 2 + 2 * type3 + chunk;
                        }
#pragma unroll
                        for (int i = 0; i < 2; ++i) {
                            const int t = (2 * Q + i) * 32 + r32;
                            bf16_t* dst;
                            if (type3 == 2) dst = chunk ? SCRB + (rowb + t) * 256 + h * 64 : YS + (rowb + t) * DM + 512 + h * 64;
                            else dst = (type3 == 0 && chunk == 0) ? YS + (rowb + t) * DM + 768 + h * 64 : SCRB + (size_t)(2 * type3 + chunk) * HT * 256 + (rowb + t) * 256 + h * 64;
                            const float inv = 1.0f / l[i];
#pragma unroll
                            for (int k = 0; k < 16; ++k) { o[i][0][k] *= inv; o[i][1][k] *= inv; }
                            store_o(dst, o[i][0], o[i][1], hi);
                            if (hi == 0) LSE2[(rowb + t) * 24 + h * 6 + slot] = m[i] + lg2(l[i]);
                        }
                    } else if (idx < 3328) {
                        const int i1 = idx - 2304, qb = 63 - (i1 >> 4), bh = i1 & 15, b = bh >> 2, h = bh & 3;
                        const size_t rowb = (size_t)b * SEQ; const int t = qb * 32 + r32;
                        f32x16 o0, o1;
                        sb_unit(QK + rowb * LDQK + 0 * 256 + h * 64, KF + (size_t)(b * 24 + h) * HSEQ, VT + (size_t)(b * 24 + h) * HSEQ, qb, o0, o1, lane);
                        store_o(YS + (rowb + t) * DM + 0 * 256 + h * 64, o0, o1, hi);
                    } else {
                        const int i2 = idx - 3328, j = i2 & 63, gh = (i2 >> 6) % 12, b = i2 / 768, gI = gh >> 2, h = gh & 3;
                        const int rsh = 2 * gI, r = 1 << rsh, sl = SEQ >> rsh, nubsh = 6 - rsh, rho = j >> nubsh, ub = j & ((1 << nubsh) - 1);
                        const int sidx = (gI == 0) ? h : (gI == 1 ? 8 + h : 12 + h);
                        const float slope = exp2f(-8.0f * (float)(sidx + 1) / 16.0f);
                        const size_t rowb = (size_t)b * SEQ + (size_t)rho * sl;
                        f32x16 o0, o1; float m, l;
                        const int kb_lo = (ub - 4 > 0) ? ub - 4 : 0;
                        sm_unit<1>(QK + rowb * LDQK + (1 + gI) * 256 + h * 64, KF + (size_t)(b * 24 + 4 + 4 * gI + h) * HSEQ + (size_t)rho * sl * 64,
                                   VT + (size_t)(b * 24 + 4 + 4 * gI + h) * HSEQ + (size_t)rho * sl * 64, ub, ub, kb_lo, slope * (float)r * LOG2E, nullptr, o0, o1, m, l, lane);
                        const float inv = 1.0f / l;
#pragma unroll
                        for (int i = 0; i < 16; ++i) { o0[i] *= inv; o1[i] *= inv; }
                        const int u = ub * 32 + r32; const size_t tok = (size_t)b * SEQ + (size_t)u * r + rho;
                        store_o(DILO + tok * 768 + gI * 256 + h * 64, o0, o1, hi);
                        if (hi == 0) LSE[tok * 12 + gI * 4 + h] = (m + lg2(l)) * LN2;
                    }
                }
            }
#endif
            GSYNC();
            {
                PHASE_VARS();
                const float lam_init = (layer == 0) ? 0.2f : 0.35550906759093115f;
                float lam;
                { const float a = (lane < 32) ? PP->lq1[layer * 32 + lane] * PP->lk1[layer * 32 + lane] : 0.f, b = (lane < 32) ? PP->lq2[layer * 32 + lane] * PP->lk2[layer * 32 + lane] : 0.f;
                  lam = __expf(wave_sum(a)) - __expf(wave_sum(b)) + lam_init; }
                bf16_t* YS = (bf16_t*)(ws + WS_YS); const bf16_t* DILO = (const bf16_t*)(ws + WS_DILO); const float* LSE = (const float*)(ws + WS_LSE);
                const bf16_t* SCRB = (const bf16_t*)(ws + WS_MERGED) + (size_t)(half * HT) * DM; const float* LSE2 = (const float*)(ws + WS_LSE2);
                const int h = lane >> 4, dq = (lane & 15) * 4;
                const f32x4 dgv = *(const f32x4*)(PP->diff_g + layer * 64 + dq);
                for (int row = gw; row < HT; row += NGW) {
                    const bool split = ((row & (SEQ - 1)) >> 5) >= 32;
                    {
                        const float l0 = LSE[(size_t)row * 12 + h], l1 = LSE[(size_t)row * 12 + 4 + h], l2 = LSE[(size_t)row * 12 + 8 + h];
                        const float mx = fmaxf(l0, fmaxf(l1, l2)); const float e0 = __expf(l0 - mx), e1 = __expf(l1 - mx), e2 = __expf(l2 - mx); const float inv = 1.0f / (e0 + e1 + e2);
                        const u32x2 a = *(const u32x2*)(DILO + (size_t)row * 768 + 4 * lane), b = *(const u32x2*)(DILO + (size_t)row * 768 + 256 + 4 * lane), c = *(const u32x2*)(DILO + (size_t)row * 768 + 512 + 4 * lane);
                        const float w0 = e0 * inv, w1 = e1 * inv, w2 = e2 * inv;
                        u32x2 o; o.x = cvtpk(w0 * bflo(a.x) + w1 * bflo(b.x) + w2 * bflo(c.x), w0 * bfhi(a.x) + w1 * bfhi(b.x) + w2 * bfhi(c.x));
                        o.y = cvtpk(w0 * bflo(a.y) + w1 * bflo(b.y) + w2 * bflo(c.y), w0 * bfhi(a.y) + w1 * bfhi(b.y) + w2 * bfhi(c.y));
                        *(u32x2*)(YS + (size_t)row * DM + 256 + 4 * lane) = o;
                    }
                    const float* ls = LSE2 + (size_t)row * 24 + h * 6;
                    const u32x2 f0 = *(const u32x2*)(YS + (size_t)row * DM + 512 + 4 * lane), a0 = *(const u32x2*)(YS + (size_t)row * DM + 768 + 4 * lane);
                    const u32x2 b0 = *(const u32x2*)(SCRB + (size_t)2 * HT * 256 + (size_t)row * 256 + 4 * lane);
                    float fv[4] = {bflo(f0.x), bfhi(f0.x), bflo(f0.y), bfhi(f0.y)}, av[4] = {bflo(a0.x), bfhi(a0.x), bflo(a0.y), bfhi(a0.y)}, bv[4] = {bflo(b0.x), bfhi(b0.x), bflo(b0.y), bfhi(b0.y)};
                    if (split) {
                        const u32x2 f1 = *(const u32x2*)(SCRB + (size_t)row * 256 + 4 * lane), a1 = *(const u32x2*)(SCRB + (size_t)1 * HT * 256 + (size_t)row * 256 + 4 * lane), b1 = *(const u32x2*)(SCRB + (size_t)3 * HT * 256 + (size_t)row * 256 + 4 * lane);
                        const float lf0 = ls[0], lf1 = ls[1], la0 = ls[2], la1 = ls[3], lb0 = ls[4], lb1 = ls[5];
                        { const float mx = fmaxf(lf0, lf1), e0 = ex2(lf0 - mx), e1 = ex2(lf1 - mx), inv = 1.0f / (e0 + e1), w0 = e0 * inv, w1 = e1 * inv;
                          fv[0] = w0 * fv[0] + w1 * bflo(f1.x); fv[1] = w0 * fv[1] + w1 * bfhi(f1.x); fv[2] = w0 * fv[2] + w1 * bflo(f1.y); fv[3] = w0 * fv[3] + w1 * bfhi(f1.y); }
                        { const float mx = fmaxf(la0, la1), e0 = ex2(la0 - mx), e1 = ex2(la1 - mx), inv = 1.0f / (e0 + e1), w0 = e0 * inv, w1 = e1 * inv;
                          av[0] = w0 * av[0] + w1 * bflo(a1.x); av[1] = w0 * av[1] + w1 * bfhi(a1.x); av[2] = w0 * av[2] + w1 * bflo(a1.y); av[3] = w0 * av[3] + w1 * bfhi(a1.y); }
                        { const float mx = fmaxf(lb0, lb1), e0 = ex2(lb0 - mx), e1 = ex2(lb1 - mx), inv = 1.0f / (e0 + e1), w0 = e0 * inv, w1 = e1 * inv;
                          bv[0] = w0 * bv[0] + w1 * bflo(b1.x); bv[1] = w0 * bv[1] + w1 * bfhi(b1.x); bv[2] = w0 * bv[2] + w1 * bflo(b1.y); bv[3] = w0 * bv[3] + w1 * bfhi(b1.y); }
                        u32x2 fo; fo.x = cvtpk(fv[0], fv[1]); fo.y = cvtpk(fv[2], fv[3]);
                        *(u32x2*)(YS + (size_t)row * DM + 512 + 4 * lane) = fo;
                    }
                    float dv[4]; float ss = 0.f;
#pragma unroll
                    for (int i = 0; i < 4; ++i) { dv[i] = av[i] - lam * bv[i]; ss += dv[i] * dv[i]; }
                    ss += swz_xor<1>(ss); ss += swz_xor<2>(ss); ss += swz_xor<4>(ss); ss += swz_xor<8>(ss);
                    const float rn = __builtin_amdgcn_rsqf(ss * (1.0f / 64.0f) + RMS_EPS) * (1.0f - lam_init);
                    u32x2 dout; dout.x = cvtpk(dv[0] * rn * dgv[0], dv[1] * rn * dgv[1]); dout.y = cvtpk(dv[2] * rn * dgv[2], dv[3] * rn * dgv[3]);
                    *(u32x2*)(YS + (size_t)row * DM + 768 + 4 * lane) = dout;
                }
            }
            GSYNC();
#ifndef NO_P3
            for (int rep = 0; rep < REP_P3; ++rep) {
                PHASE_VARS();
                pg8::Gemm g{(const bf16_t*)(ws + WS_YS), (const bf16_t*)(ws + WS_WB), DM, 512, 512, 512 * 2, (long)8 * 256 * 512 * 2};
                pg8::BranchOrder S{bx, G};
                pg8::EpiBranch E{(const bf16_t*)(ws + WS_GATE), (bf16_t*)(ws + WS_MERGED), half * HT};
                pg8::gemm_phase<pg8::EpiBranch, pg8::BranchOrder, true>(lds, g, S, E);
            }
#endif
            GSYNC();
        }
#ifndef NO_P4
        for (int rep = 0; rep < REP_CONV; ++rep) {
            PHASE_VARS();
            bf16_t* WUP = (bf16_t*)(ws + WS_WUP); bf16_t* WDN = (bf16_t*)(ws + WS_WDN);
            const float* wu = PP->w_up + (size_t)layer * DM * DFF; const float* wd = PP->w_down + (size_t)layer * DFF * DM; const float* mg = PP->mlp_g + (size_t)layer * DM;
            constexpr int I_U = (DM / 64) * (DFF / 32), I_D = (DFF / 64) * (DM / 32);
            for (int it = gw; it < I_U + I_D; it += NGW) {
                if (it < I_U) transpose_item<0>(wu, DM, DFF, DFF, mg, WUP, scr, it, lane);
                else transpose_item<0>(wd, DFF, DM, DM, nullptr, WDN, scr, it - I_U, lane);
            }
            __syncthreads();
        }
        {
            PHASE_VARS();
            pg8::Gemm g{(const bf16_t*)(ws + WS_MERGED), (const bf16_t*)(ws + WS_WOUT), DM, DM, DM, 0, 0};
            pg8::StaticOrder S; S.init(TOK, DM, G, bx);
            pg8::EpiResid E{(layer == 0) ? PP->x : (const float*)PP->out, PP->out, (bf16_t*)(ws + WS_XB), (float*)(ws + WS_SSQ)};
            pg8::gemm_phase<pg8::EpiResid, pg8::StaticOrder, false>(lds, g, S, E);
        }
#endif
        GSYNC();
#ifndef NO_P5
        for (int rep = 0; rep < REP_P5; ++rep) {
            PHASE_VARS();
            pg8::Gemm g{(const bf16_t*)(ws + WS_XB), (const bf16_t*)(ws + WS_WUP), DM, DM, DM, 0, 0};
            pg8::StaticOrder S; S.init(TOK, DFF, G, bx);
            pg8::EpiUp E{(const float*)(ws + WS_SSQ), (bf16_t*)(ws + WS_HMLP)};
            pg8::gemm_phase<pg8::EpiUp, pg8::StaticOrder, true>(lds, g, S, E);
        }
#endif
        GSYNC();
#ifndef NO_P6
        {
            PHASE_VARS();
            pg8::Gemm g{(const bf16_t*)(ws + WS_HMLP), (const bf16_t*)(ws + WS_WDN), DFF, DFF, DFF, 0, 0};
            pg8::StaticOrder S; S.init(TOK, DM, G, bx);
            if (layer == DEPTH - 1 && G == 256) {
                pg8::EpiFinal E{(const float*)PP->out, PP->out, (float*)(ws + WS_SSQ), PP->final_g, (unsigned*)(ws + WS_CTL) + CW_PANEL};
                pg8::gemm_phase<pg8::EpiFinal, pg8::StaticOrder, true>(lds, g, S, E);
            } else {
                pg8::EpiResid E{(const float*)PP->out, PP->out, (bf16_t*)(ws + WS_XB), (float*)(ws + WS_SSQ)};
                pg8::gemm_phase<pg8::EpiResid, pg8::StaticOrder, false>(lds, g, S, E);
            }
        }
#endif
        if (layer < DEPTH - 1 || gridDim.x != 256) GSYNC();
    }
    if (gridDim.x != 256)
    {
        PHASE_VARS();
        float* X = PP->out;
        for (int row = gw; row < TOK; row += NGW) {
            f32x4* xo = (f32x4*)(X + (size_t)row * DM) + lane; const f32x4* gp = (const f32x4*)PP->final_g + lane;
            f32x4 v[4]; float s = 0.f;
#pragma unroll
            for (int j = 0; j < 4; ++j) { v[j] = xo[64 * j]; s += (v[j][0] * v[j][0] + v[j][1] * v[j][1]) + (v[j][2] * v[j][2] + v[j][3] * v[j][3]); }
            const float rstd = __builtin_amdgcn_rsqf(wave_sum(s) * (1.0f / DM) + RMS_EPS);
#pragma unroll
            for (int j = 0; j < 4; ++j) xo[64 * j] = v[j] * rstd * gp[64 * j];
        }
    }
}

extern "C" void kernel_launch(void* const* d_in, const int* in_sizes, int n_in, void* d_out, int out_size, void* d_ws, size_t ws_size, hipStream_t stream) {
    static int grid = 0;
    if (grid == 0) {
        if (n_in != 15 || in_sizes[0] != TOK * DM || out_size != TOK * DM || ws_size < WS_END) { fprintf(stderr, "kernel_launch: unexpected shapes / workspace (n_in %d, ws %zu)\n", n_in, ws_size); grid = -1; return; }
        int dev = 0, cus = 0, per_cu = 0;
        hipGetDevice(&dev); hipDeviceGetAttribute(&cus, hipDeviceAttributeMultiprocessorCount, dev);
        hipFuncSetAttribute((const void*)fwd_mega, hipFuncAttributeMaxDynamicSharedMemorySize, LDS_BYTES);
        hipOccupancyMaxActiveBlocksPerMultiprocessor(&per_cu, (const void*)fwd_mega, NWAVES * 64, LDS_BYTES);
        (void)hipGetLastError();
        if (per_cu < 1) per_cu = 1;
        grid = cus;
        if (grid > 256) grid = 256;
        if (grid % 8 != 0) { fprintf(stderr, "kernel_launch: the per-XCD work queues need a grid that is a multiple of 8 (got %d)\n", grid); grid = -1; return; }
    }
    if (grid < 0) return;
    hipMemsetAsync((char*)d_ws + WS_CTL, 0, CTL_BYTES, stream);
    Params p{};
    p.x = (const float*)d_in[0]; p.mix_g = (const float*)d_in[1]; p.w_in = (const float*)d_in[2]; p.b_forget = (const float*)d_in[3];
    p.lq1 = (const float*)d_in[4]; p.lk1 = (const float*)d_in[5]; p.lq2 = (const float*)d_in[6]; p.lk2 = (const float*)d_in[7];
    p.diff_g = (const float*)d_in[8]; p.w_branch = (const float*)d_in[9]; p.w_out = (const float*)d_in[10]; p.mlp_g = (const float*)d_in[11];
    p.w_up = (const float*)d_in[12]; p.w_down = (const float*)d_in[13]; p.final_g = (const float*)d_in[14];
    p.out = (float*)d_out; p.ws = (unsigned char*)d_ws;
    void* args[] = {&p};
    hipError_t e = hipLaunchCooperativeKernel((const void*)fwd_mega, dim3(grid), dim3(NWAVES * 64), args, LDS_BYTES, stream);
    if (e != hipSuccess) fprintf(stderr, "cooperative launch failed: %s (grid %d)\n", hipGetErrorString(e), grid);
}
```

```cpp
#include <hip/hip_runtime.h>
#include <hip/hip_cooperative_groups.h>
#include <cstdio>
#include <cstdint>
namespace cg = cooperative_groups;

#define LAS __attribute__((address_space(3)))
typedef unsigned short bf16_t;
typedef short bf16x8 __attribute__((ext_vector_type(8)));
typedef float f32x4 __attribute__((ext_vector_type(4)));
typedef float f32x16 __attribute__((ext_vector_type(16)));
typedef unsigned u32x4 __attribute__((ext_vector_type(4)));
typedef unsigned u32x2 __attribute__((ext_vector_type(2)));
typedef float f32x2_t __attribute__((ext_vector_type(2)));
typedef __bf16 bf16x2_t __attribute__((ext_vector_type(2)));

constexpr int DM = 1024, BATCH = 8, SEQ = 2048, DEPTH = 2, TOK = BATCH * SEQ, DFF = 4096, DIN = 8708;
constexpr int HT = TOK / 2;
constexpr int NPROJ = 35 * 256;
constexpr int LDQK = 6 * 256;
constexpr int HSEQ = SEQ * 64;
constexpr float LOG2E = 1.4426950408889634f, LN2 = 0.6931471805599453f;
constexpr float RMS_EPS = 1e-6f;

constexpr size_t MiB = 1u << 20;
constexpr size_t WS_CTL = 0, CTL_BYTES = 65536;
constexpr int CW_BAR = 4096, CW_PANEL = 8192;
constexpr size_t WS_SSQ = 1 * MiB;
constexpr size_t WS_WIN = 2 * MiB;
constexpr size_t WS_WUP = WS_WIN, WS_WDN = WS_WIN + 8 * MiB;
constexpr size_t WS_WB = 20 * MiB;
constexpr size_t WS_WOUT = 24 * MiB;
constexpr size_t WS_XB = 26 * MiB;
constexpr size_t WS_MERGED = 58 * MiB;
constexpr size_t WS_YS = 90 * MiB;
constexpr size_t WS_DILO = 106 * MiB;
constexpr size_t WS_LSE = 118 * MiB;
constexpr size_t WS_LSE2 = 118 * MiB + 512 * 1024;
constexpr size_t WS_FL = 119 * MiB + 512 * 1024;
constexpr size_t WS_QK = 120 * MiB;
constexpr size_t WS_KF = 144 * MiB;
constexpr size_t WS_VT = 168 * MiB;
constexpr size_t WS_GATE = 192 * MiB;
constexpr size_t WS_HMLP = 120 * MiB;
constexpr size_t WS_END = 256 * MiB;

constexpr int LDS_BYTES = 147456;
constexpr int NWAVES = 8;

__device__ __forceinline__ unsigned cvtpk(float lo, float hi) { f32x2_t v = {lo, hi}; bf16x2_t b = __builtin_convertvector(v, bf16x2_t); return __builtin_bit_cast(unsigned, b); }
__device__ __forceinline__ float bflo(unsigned w) { return __uint_as_float(w << 16); }
__device__ __forceinline__ float bfhi(unsigned w) { return __uint_as_float(w & 0xffff0000u); }
__device__ __forceinline__ float ex2(float x) { return __builtin_amdgcn_exp2f(x); }
__device__ __forceinline__ float lg2(float x) { return __builtin_amdgcn_logf(x); }
__device__ __forceinline__ float x32_sum(float v) { auto r = __builtin_amdgcn_permlane32_swap(__float_as_uint(v), __float_as_uint(v), false, false); return __uint_as_float(r[0]) + __uint_as_float(r[1]); }
__device__ __forceinline__ float x32_max(float v) { auto r = __builtin_amdgcn_permlane32_swap(__float_as_uint(v), __float_as_uint(v), false, false); return fmaxf(__uint_as_float(r[0]), __uint_as_float(r[1])); }
__device__ __forceinline__ float x32_partner(float v, int hi) { auto r = __builtin_amdgcn_permlane32_swap(__float_as_uint(v), __float_as_uint(v), false, false); return hi ? __uint_as_float(r[0]) : __uint_as_float(r[1]); }
template <int X> __device__ __forceinline__ float swz_xor(float v) { return __uint_as_float((unsigned)__builtin_amdgcn_ds_swizzle((int)__float_as_uint(v), (X << 10) | 0x1f)); }
__device__ __forceinline__ float x16_sum(float v) { return v + swz_xor<16>(v); }
__device__ __forceinline__ float wave_sum(float v) { v += swz_xor<1>(v); v += swz_xor<2>(v); v += swz_xor<4>(v); v += swz_xor<8>(v); v += swz_xor<16>(v); return x32_sum(v); }

namespace pg8 {
constexpr int BM = 256, BK = 64, HALF = 128, HTB = HALF * BK * 2, STAGE_BYTES = 8 * HTB, NXCD = 8, WGM = 8;
__host__ __device__ __forceinline__ int lds_byte(int r, int c) { const int st = (r >> 4) * 2 + (c >> 5), rr = r & 15, cc = c & 31, ob = rr * 64 + cc * 2; return st * 1024 + (ob ^ (((ob >> 9) & 1) << 5)); }
__host__ __device__ __forceinline__ void stage_rc(int b, int& R, int& C) { const int st = b / 1024, sb = b % 1024, swz = sb ^ (((sb >> 9) & 1) << 5); R = (st >> 1) * 16 + swz / 64; C = (st & 1) * 32 + (swz % 64) / 2; }
__host__ __device__ __forceinline__ int perm32(int rho) { const int n = rho >> 4, i = rho & 15; return 8 * (i >> 2) + 4 * n + (i & 3); }

struct Unit { int pm, pn, aux; };
struct Gemm { const bf16_t* A; const bf16_t* Bt; int lda, ldb, K; long a_aux, b_aux; };

struct StaticOrder {
    int nM, nN, nwg, G, c;
    __device__ void init(int M, int N, int G_, int c_) { nM = M / BM; nN = N / BM; nwg = nM * nN; G = G_; c = c_; }
    __device__ bool next(int i, Unit& u) const {
        const long L = (long)i * G + c; if (L >= nwg) return false;
        int wgid = (int)L; { const int q = nwg / NXCD, r = nwg % NXCD, xcd = wgid % NXCD, off = wgid / NXCD; wgid = (xcd < r ? xcd * (q + 1) : r * (q + 1) + (xcd - r) * q) + off; }
        const int nig = WGM * nN, gid = wgid / nig, fm = gid * WGM, gsz = (nM - fm) < WGM ? (nM - fm) : WGM;
        u.pm = fm + ((wgid % nig) % gsz); u.pn = (wgid % nig) / gsz; u.aux = 0; return true;
    }
};
struct BranchOrder {
    int c, G;
    __device__ bool next(int i, Unit& u) const { const int t = c + (i >> 1) * G; if (t >= 256) return false; u.pm = t >> 3; u.pn = t & 7; u.aux = i & 1; return true; }
};

template <class Epi, class Sched, bool ALIGN_EPI>
__device__ __forceinline__ void gemm_phase(LAS unsigned char* lds, const Gemm g, const Sched& S, const Epi& E) {
    int tid_ = threadIdx.x; asm volatile("" : "+v"(tid_));
    const int tid = tid_, wid = __builtin_amdgcn_readfirstlane(tid >> 6), lane = tid & 63, wr = wid >> 2, wc = wid & 3, fr = lane & 15, fq = lane >> 4;
    int nt_ = g.K / BK; asm volatile("" : "+s"(nt_)); const int nt = nt_;
    unsigned voffA[2], voffB[2];
#pragma unroll
    for (int i = 0; i < 2; ++i) { int R, C; stage_rc(tid * 16 + i * 8192, R, C); const int Rb = Epi::PERM ? ((R & ~31) + perm32(R & 31)) : R;
        voffA[i] = (unsigned)(R * g.lda + C) * 2u; voffB[i] = (unsigned)(Rb * g.ldb + C) * 2u; }
    const size_t kstep = (size_t)(BK * 2);
    const size_t hstepA = (size_t)HALF * g.lda * 2, hstepB = (size_t)HALF * g.ldb * 2;
    const size_t tstepA = 2 * hstepA, tstepB = 2 * hstepB;
    const unsigned ldsw = (unsigned)wid * 1024u;
    const int aoff = lds_byte(wr * 64 + fr, fq * 8), boff = lds_byte(wc * 32 + fr, fq * 8);
#define PG8_SA(b, h) (((b) * 2 + (h)) * HTB)
#define PG8_SB(b, h) ((4 + (b) * 2 + (h)) * HTB)
#define PG8_STAGE(bufoff, gbase, voff) do { _Pragma("unroll") for (int _i = 0; _i < 2; ++_i) \
        __builtin_amdgcn_global_load_lds((const unsigned*)((const char*)(gbase) + (voff)[_i]), (LAS unsigned*)(lds + (bufoff) + ldsw + _i * 8192), 16, 0, 0); } while (0)
#define PG8_LDA(dst, b, h) do { _Pragma("unroll") for (int m = 0; m < 4; ++m) _Pragma("unroll") for (int k = 0; k < 2; ++k) dst[m][k] = *(const LAS bf16x8*)(lds + PG8_SA(b, h) + aoff + m * 2048 + k * 1024); } while (0)
#define PG8_LDB(dst, b, h) do { _Pragma("unroll") for (int n = 0; n < 2; ++n) _Pragma("unroll") for (int k = 0; k < 2; ++k) dst[n][k] = *(const LAS bf16x8*)(lds + PG8_SB(b, h) + boff + n * 2048 + k * 1024); } while (0)
#define PG8_MMA(ai, bj, At, Bt) do { __builtin_amdgcn_s_setprio(1); _Pragma("unroll") for (int m = 0; m < 4; ++m) _Pragma("unroll") for (int n = 0; n < 2; ++n) _Pragma("unroll") for (int k = 0; k < 2; ++k) \
        acc[ai][bj][m][n] = __builtin_amdgcn_mfma_f32_16x16x32_bf16(Bt[n][k], At[m][k], acc[ai][bj][m][n], 0, 0, 0); __builtin_amdgcn_s_setprio(0); } while (0)
#define PG8_WAIT_V(n) asm volatile("s_waitcnt vmcnt(" #n ")" ::: "memory")
#define PG8_WAIT_L(n) asm volatile("s_waitcnt lgkmcnt(" #n ")" ::: "memory")
#define PG8_BAR __builtin_amdgcn_s_barrier()
#define PG8_SCHED __builtin_amdgcn_sched_barrier(0)
#define PG8_UA(u) ((const char*)g.A + (size_t)(u).pm * tstepA + (size_t)(u).aux * (size_t)g.a_aux)
#define PG8_UB(u) ((const char*)g.Bt + (size_t)(u).pn * tstepB + (size_t)(u).aux * (size_t)g.b_aux)
    Unit cur, nxt; int ui = 0;
    if (!S.next(0, cur)) return;
    f32x4 acc[2][2][4][2];
#pragma unroll
    for (int a = 0; a < 2; ++a)
#pragma unroll
        for (int b = 0; b < 2; ++b)
#pragma unroll
            for (int m = 0; m < 4; ++m)
#pragma unroll
                for (int n = 0; n < 2; ++n) acc[a][b][m][n] = (f32x4){0.f, 0.f, 0.f, 0.f};
    bf16x8 At[4][2], B0[2][2], B1[2][2];
    const char* cA = PG8_UA(cur); const char* cB = PG8_UB(cur);
    PG8_STAGE(PG8_SB(0, 0), cB, voffB); PG8_STAGE(PG8_SB(0, 1), cB + hstepB, voffB); PG8_STAGE(PG8_SA(0, 0), cA, voffA); PG8_STAGE(PG8_SA(0, 1), cA + hstepA, voffA);
    if (wr == 1) PG8_BAR;
    PG8_WAIT_V(2); PG8_BAR;
    PG8_STAGE(PG8_SB(1, 0), cB + kstep, voffB); PG8_STAGE(PG8_SA(1, 0), cA + kstep, voffA); PG8_STAGE(PG8_SB(1, 1), cB + hstepB + kstep, voffB);
    PG8_WAIT_V(6); PG8_BAR;
    for (;;) {
        const bool has_next = S.next(ui + 1, nxt);
        const char* nA = has_next ? PG8_UA(nxt) : cA; const char* nB = has_next ? PG8_UB(nxt) : cB;
        for (int t = 0; t < nt; t += 2) {
            const bool last = (t == nt - 2);
            const char* a1 = cA + (size_t)(t + 1) * kstep;
            const char* a2 = last ? nA : cA + (size_t)(t + 2) * kstep; const char* b2 = last ? nB : cB + (size_t)(t + 2) * kstep;
            const char* a3 = a2 + kstep; const char* b3 = b2 + kstep;
            PG8_LDB(B0, 0, 0); PG8_LDB(B1, 0, 1); PG8_SCHED; PG8_LDA(At, 0, 0); PG8_STAGE(PG8_SA(1, 1), a1 + hstepA, voffA);
            PG8_WAIT_V(8); PG8_WAIT_L(0); PG8_BAR; PG8_MMA(0, 0, At, B0); PG8_MMA(0, 1, At, B1); PG8_BAR; PG8_SCHED;
            PG8_LDA(At, 0, 1); PG8_STAGE(PG8_SB(0, 0), b2, voffB); PG8_STAGE(PG8_SB(0, 1), b2 + hstepB, voffB); PG8_STAGE(PG8_SA(0, 0), a2, voffA);
            PG8_WAIT_V(8); PG8_WAIT_L(0); PG8_BAR; PG8_MMA(1, 0, At, B0); PG8_MMA(1, 1, At, B1); PG8_BAR; PG8_SCHED;
            PG8_LDB(B0, 1, 0); PG8_LDB(B1, 1, 1); PG8_SCHED; PG8_LDA(At, 1, 0); PG8_STAGE(PG8_SA(0, 1), a2 + hstepA, voffA);
            PG8_WAIT_V(8); PG8_WAIT_L(0); PG8_BAR; PG8_MMA(0, 0, At, B0); PG8_MMA(0, 1, At, B1); PG8_BAR; PG8_SCHED;
            PG8_LDA(At, 1, 1); PG8_STAGE(PG8_SB(1, 0), b3, voffB); PG8_STAGE(PG8_SB(1, 1), b3 + hstepB, voffB); PG8_STAGE(PG8_SA(1, 0), a3, voffA);
            PG8_WAIT_V(8); PG8_WAIT_L(0); PG8_BAR; PG8_MMA(1, 0, At, B0); PG8_MMA(1, 1, At, B1); PG8_BAR; PG8_SCHED;
        }
        if constexpr (ALIGN_EPI) { if (wr == 0) PG8_BAR; }
        { Unit eu = cur; asm volatile("" : "+s"(eu.pm), "+s"(eu.pn), "+s"(eu.aux)); E(acc, eu, wr, wc, fr, fq); }
        if (!has_next) break;
#pragma unroll
        for (int a = 0; a < 2; ++a)
#pragma unroll
            for (int b = 0; b < 2; ++b)
#pragma unroll
                for (int m = 0; m < 4; ++m)
#pragma unroll
                    for (int n = 0; n < 2; ++n) acc[a][b][m][n] = (f32x4){0.f, 0.f, 0.f, 0.f};
        cur = nxt; cA = nA; cB = nB; ++ui;
        if constexpr (ALIGN_EPI) { if (wr == 1) PG8_BAR; }
    }
    PG8_WAIT_V(0);
    if constexpr (!ALIGN_EPI) { if (wr == 0) PG8_BAR; }
    PG8_BAR;
#undef PG8_SA
#undef PG8_SB
#undef PG8_STAGE
#undef PG8_LDA
#undef PG8_LDB
#undef PG8_MMA
#undef PG8_WAIT_V
#undef PG8_WAIT_L
#undef PG8_BAR
#undef PG8_SCHED
#undef PG8_UA
#undef PG8_UB
}

__device__ __forceinline__ float row_rstd(const float* ssq, int row, int fq) {
    const f32x4 a = *(const f32x4*)(ssq + (size_t)row * 16 + 4 * fq);
    float s = (a[0] + a[1]) + (a[2] + a[3]);
    s = x16_sum(s); s = x32_sum(s);
    return __builtin_amdgcn_rsqf(s * (1.0f / DM) + RMS_EPS);
}
__device__ __forceinline__ int pos16(int o) { return 8 * ((o >> 2) & 1) + 4 * (o >> 3) + (o & 3); }

struct EpiProj {
    static constexpr bool PERM = true;
    const float* ssq; int row_base; bf16_t* QK; bf16_t* KF; bf16_t* VT; float* FL; bf16_t* GATE;
    __device__ __forceinline__ void operator()(const f32x4 (&acc)[2][2][4][2], const Unit& u, int wr, int wc, int fr, int fq) const {
        const int pn = u.pn;
        const int lrow0 = u.pm * BM + wr * 64 + fr;
        float rs[2][4];
#pragma unroll
        for (int ai = 0; ai < 2; ++ai)
#pragma unroll
            for (int m = 0; m < 4; ++m) rs[ai][m] = row_rstd(ssq, row_base + lrow0 + ai * HALF + m * 16, fq);
        const int cin = wc * 32 + 8 * fq;
        if (pn >= 19) {
#pragma unroll
            for (int ai = 0; ai < 2; ++ai)
#pragma unroll
                for (int m = 0; m < 4; ++m) { const int lrow = lrow0 + ai * HALF + m * 16; const float s = rs[ai][m];
#pragma unroll
                    for (int bj = 0; bj < 2; ++bj) { const f32x4 v0 = acc[ai][bj][m][0] * s, v1 = acc[ai][bj][m][1] * s;
                        u32x4 w; w.x = cvtpk(v0[0], v0[1]); w.y = cvtpk(v0[2], v0[3]); w.z = cvtpk(v1[0], v1[1]); w.w = cvtpk(v1[2], v1[3]);
                        *(u32x4*)(GATE + (size_t)lrow * 4096 + (pn - 19) * 256 + bj * HALF + cin) = w; } }
        } else if (pn == 18) {
            if (wc == 0 && fq == 0) {
#pragma unroll
                for (int ai = 0; ai < 2; ++ai)
#pragma unroll
                    for (int m = 0; m < 4; ++m) { const int lrow = lrow0 + ai * HALF + m * 16; *(f32x4*)(FL + (size_t)lrow * 4) = acc[ai][0][m][0] * rs[ai][m]; }
            }
        } else if (pn == 2 || (pn >= 9 && pn <= 11) || pn == 14 || pn == 17) {
            int vhb, rsh;
            if (pn == 2) { vhb = 0; rsh = 0; } else if (pn == 14) { vhb = 16; rsh = 0; } else if (pn == 17) { vhb = 20; rsh = 0; } else { const int gI = pn - 9; vhb = 4 + 4 * gI; rsh = 2 * gI; }
            const int slsh = 11 - rsh, rmask = (1 << rsh) - 1;
#pragma unroll
            for (int ai = 0; ai < 2; ++ai)
#pragma unroll
                for (int m = 0; m < 4; ++m) { const int lrow = lrow0 + ai * HALF + m * 16; const float s = rs[ai][m];
                    const int bl = lrow >> 11, t = lrow & (SEQ - 1); int p = ((t & rmask) << slsh) + (t >> rsh); p = (p & ~15) | pos16(p & 15);
                    const int kb = p >> 5, q = p & 31;
                    bf16_t* base = VT + (size_t)(bl * 24 + vhb) * HSEQ + (size_t)kb * 2048 + (q >> 4) * 512 + ((q >> 3) & 1) * 256 + (q & 7);
#pragma unroll
                    for (int bj = 0; bj < 2; ++bj) { const int c0 = bj * HALF + cin;
                        bf16_t* bp = base + (size_t)(c0 >> 6) * HSEQ + ((c0 >> 5) & 1) * 1024 + (c0 & 31) * 8;
                        const f32x4 v0 = acc[ai][bj][m][0] * s, v1 = acc[ai][bj][m][1] * s;
                        const unsigned w0 = cvtpk(v0[0], v0[1]), w1 = cvtpk(v0[2], v0[3]), w2 = cvtpk(v1[0], v1[1]), w3 = cvtpk(v1[2], v1[3]);
                        bp[0 * 8] = (bf16_t)(w0 & 0xffff); bp[1 * 8] = (bf16_t)(w0 >> 16); bp[2 * 8] = (bf16_t)(w1 & 0xffff); bp[3 * 8] = (bf16_t)(w1 >> 16);
                        bp[4 * 8] = (bf16_t)(w2 & 0xffff); bp[5 * 8] = (bf16_t)(w2 >> 16); bp[6 * 8] = (bf16_t)(w3 & 0xffff); bp[7 * 8] = (bf16_t)(w3 >> 16); } }
        } else {
            const bool isK = (pn == 1) || (pn >= 6 && pn <= 8) || pn == 13 || pn == 16;
            int slot = 0, khb = 0, rsh = 0;
            if (pn <= 1) { slot = 0; khb = 0; } else if (pn <= 8) { const int gI = (pn - 3) % 3; rsh = 2 * gI; slot = 1 + gI; khb = 4 + 4 * gI; } else if (pn <= 13) { slot = 4; khb = 16; } else { slot = 5; khb = 20; }
            const int slsh = 11 - rsh, rmask = (1 << rsh) - 1;
#pragma unroll
            for (int ai = 0; ai < 2; ++ai)
#pragma unroll
                for (int m = 0; m < 4; ++m) { const int lrow = lrow0 + ai * HALF + m * 16; const float s = rs[ai][m];
                    const int bl = lrow >> 11, t = lrow & (SEQ - 1); const int p = ((t & rmask) << slsh) + (t >> rsh);
#pragma unroll
                    for (int bj = 0; bj < 2; ++bj) { const f32x4 v0 = acc[ai][bj][m][0] * s, v1 = acc[ai][bj][m][1] * s;
                        u32x4 w; w.x = cvtpk(v0[0], v0[1]); w.y = cvtpk(v0[2], v0[3]); w.z = cvtpk(v1[0], v1[1]); w.w = cvtpk(v1[2], v1[3]);
                        const int c0 = bj * HALF + cin;
                        if (isK) { const int dcol = c0 & 63;
                            *(u32x4*)(KF + (size_t)(bl * 24 + khb + (c0 >> 6)) * HSEQ + (size_t)(p >> 5) * 2048 + (dcol >> 4) * 512 + (((dcol >> 3) & 1) * 32 + (p & 31)) * 8) = w; }
                        else *(u32x4*)(QK + (size_t)(bl * SEQ + p) * LDQK + slot * 256 + c0) = w; } }
        }
    }
};

struct EpiBranch {
    static constexpr bool PERM = true;
    const bf16_t* GATE; bf16_t* MERGED; int row_base;
    __device__ __forceinline__ static float sg(float g) { return __builtin_amdgcn_rcpf(1.0f + ex2(-g * LOG2E)); }
    __device__ __forceinline__ static u32x4 mix(const u32x4 ga, const u32x4 gb, const u32x4 ow, const f32x4 a0, const f32x4 a1, const f32x4 b0, const f32x4 b1) {
        const float o0 = sg(bflo(ga.x)) * a0[0] + sg(bflo(gb.x)) * b0[0] + bflo(ow.x), o1 = sg(bfhi(ga.x)) * a0[1] + sg(bfhi(gb.x)) * b0[1] + bfhi(ow.x);
        const float o2 = sg(bflo(ga.y)) * a0[2] + sg(bflo(gb.y)) * b0[2] + bflo(ow.y), o3 = sg(bfhi(ga.y)) * a0[3] + sg(bfhi(gb.y)) * b0[3] + bfhi(ow.y);
        const float o4 = sg(bflo(ga.z)) * a1[0] + sg(bflo(gb.z)) * b1[0] + bflo(ow.z), o5 = sg(bfhi(ga.z)) * a1[1] + sg(bfhi(gb.z)) * b1[1] + bfhi(ow.z);
        const float o6 = sg(bflo(ga.w)) * a1[2] + sg(bflo(gb.w)) * b1[2] + bflo(ow.w), o7 = sg(bfhi(ga.w)) * a1[3] + sg(bfhi(gb.w)) * b1[3] + bfhi(ow.w);
        u32x4 w; w.x = cvtpk(o0, o1); w.y = cvtpk(o2, o3); w.z = cvtpk(o4, o5); w.w = cvtpk(o6, o7); return w;
    }
    __device__ __forceinline__ void operator()(const f32x4 (&acc)[2][2][4][2], const Unit& u, int wr, int wc, int fr, int fq) const {
        const int p = u.aux; const int lrow0 = u.pm * BM + wr * 64 + fr; const int d0 = u.pn * 128 + wc * 32 + 8 * fq;
        const bf16_t* gbase = GATE + (size_t)lrow0 * 4096 + (2 * p) * 1024 + d0; bf16_t* mbase = MERGED + (size_t)(row_base + lrow0) * DM + d0;
        const u32x4 zero = {0u, 0u, 0u, 0u};
#pragma unroll
        for (int ai = 0; ai < 2; ++ai)
#pragma unroll
            for (int mp = 0; mp < 2; ++mp) {
                u32x4 ga[2], gb[2], ow[2];
#pragma unroll
                for (int mm = 0; mm < 2; ++mm) { const size_t ro = (size_t)(ai * HALF + (2 * mp + mm) * 16);
                    ga[mm] = *(const u32x4*)(gbase + ro * 4096); gb[mm] = *(const u32x4*)(gbase + ro * 4096 + 1024);
                    ow[mm] = zero; if (p > 0) ow[mm] = *(const u32x4*)(mbase + ro * DM); }
#pragma unroll
                for (int mm = 0; mm < 2; ++mm) { const int m = 2 * mp + mm; const size_t ro = (size_t)(ai * HALF + m * 16);
                    *(u32x4*)(mbase + ro * DM) = mix(ga[mm], gb[mm], ow[mm], acc[ai][0][m][0], acc[ai][0][m][1], acc[ai][1][m][0], acc[ai][1][m][1]); }
                asm volatile("" ::: "memory");
            }
    }
};

struct EpiResid {
    static constexpr bool PERM = true;
    const float* Xin; float* X; bf16_t* XB; float* ssq;
    __device__ __forceinline__ void operator()(const f32x4 (&acc)[2][2][4][2], const Unit& u, int wr, int wc, int fr, int fq) const {
        const int row0 = u.pm * BM + wr * 64 + fr; const int col0 = u.pn * BM + wc * 32 + 8 * fq;
#pragma unroll
        for (int ai = 0; ai < 2; ++ai)
#pragma unroll
            for (int m = 0; m < 4; ++m) { const int row = row0 + ai * HALF + m * 16; float sq = 0.f;
#pragma unroll
                for (int bj = 0; bj < 2; ++bj) { const int col = col0 + bj * HALF; f32x4* xp = (f32x4*)(X + (size_t)row * DM + col); const f32x4* xi = (const f32x4*)(Xin + (size_t)row * DM + col);
                    const f32x4 x0 = xi[0] + acc[ai][bj][m][0], x1 = xi[1] + acc[ai][bj][m][1];
                    xp[0] = x0; xp[1] = x1;
                    u32x4 w; w.x = cvtpk(x0[0], x0[1]); w.y = cvtpk(x0[2], x0[3]); w.z = cvtpk(x1[0], x1[1]); w.w = cvtpk(x1[2], x1[3]);
                    *(u32x4*)(XB + (size_t)row * DM + col) = w;
                    sq += (x0[0] * x0[0] + x0[1] * x0[1]) + (x0[2] * x0[2] + x0[3] * x0[3]) + (x1[0] * x1[0] + x1[1] * x1[1]) + (x1[2] * x1[2] + x1[3] * x1[3]); }
                sq = x16_sum(sq); sq = x32_sum(sq);
                if (fq == 0) ssq[(size_t)row * 16 + u.pn * 4 + wc] = sq; if (m & 1) asm volatile("" ::: "memory"); }
    }
};

struct EpiFinal {
    static constexpr bool PERM = true;
    const float* X; float* out; float* ssq; const float* gfin; unsigned* cnt;
    __device__ __forceinline__ void operator()(f32x4 (&acc)[2][2][4][2], const Unit& u, int wr, int wc, int fr, int fq) const {
        const int row0 = u.pm * BM + wr * 64 + fr; const int col0 = u.pn * BM + wc * 32 + 8 * fq;
#pragma unroll
        for (int ai = 0; ai < 2; ++ai)
#pragma unroll
            for (int m = 0; m < 4; ++m) { const int row = row0 + ai * HALF + m * 16; float sq = 0.f;
#pragma unroll
                for (int bj = 0; bj < 2; ++bj) { const f32x4* xi = (const f32x4*)(X + (size_t)row * DM + col0 + bj * HALF);
                    const f32x4 x0 = xi[0] + acc[ai][bj][m][0], x1 = xi[1] + acc[ai][bj][m][1];
                    acc[ai][bj][m][0] = x0; acc[ai][bj][m][1] = x1;
                    sq += (x0[0] * x0[0] + x0[1] * x0[1]) + (x0[2] * x0[2] + x0[3] * x0[3]) + (x1[0] * x1[0] + x1[1] * x1[1]) + (x1[2] * x1[2] + x1[3] * x1[3]); }
                sq = x16_sum(sq); sq = x32_sum(sq);
                if (fq == 0) __hip_atomic_store(ssq + (size_t)row * 16 + u.pn * 4 + wc, sq, __ATOMIC_RELAXED, __HIP_MEMORY_SCOPE_AGENT);
                if (m & 1) asm volatile("" ::: "memory"); }
        asm volatile("s_waitcnt vmcnt(0)" ::: "memory");
        unsigned* c = cnt + 64 * u.pm;
        if ((fr | fq) == 0) {
            __hip_atomic_fetch_add(c, 1u, __ATOMIC_RELAXED, __HIP_MEMORY_SCOPE_AGENT);
            unsigned sp = 0;
            while (__hip_atomic_load(c, __ATOMIC_RELAXED, __HIP_MEMORY_SCOPE_AGENT) < 32u) { __builtin_amdgcn_s_sleep(2); if (++sp > (1u << 22)) break; }
        }
        __builtin_amdgcn_fence(__ATOMIC_ACQUIRE, "agent");
        asm volatile("s_waitcnt vmcnt(0)" ::: "memory");
        float rs[2][4];
#pragma unroll
        for (int ai = 0; ai < 2; ++ai)
#pragma unroll
            for (int m = 0; m < 4; ++m) rs[ai][m] = row_rstd(ssq, row0 + ai * HALF + m * 16, fq);
#pragma unroll
        for (int bj = 0; bj < 2; ++bj) { const f32x4 g0 = *(const f32x4*)(gfin + col0 + bj * HALF), g1 = *(const f32x4*)(gfin + col0 + bj * HALF + 4);
#pragma unroll
            for (int ai = 0; ai < 2; ++ai)
#pragma unroll
                for (int m = 0; m < 4; ++m) { const int row = row0 + ai * HALF + m * 16; f32x4* op = (f32x4*)(out + (size_t)row * DM + col0 + bj * HALF);
                    op[0] = acc[ai][bj][m][0] * rs[ai][m] * g0; op[1] = acc[ai][bj][m][1] * rs[ai][m] * g1; } }
    }
};

struct EpiUp {
    static constexpr bool PERM = true;
    const float* ssq; bf16_t* H;
    __device__ __forceinline__ void operator()(const f32x4 (&acc)[2][2][4][2], const Unit& u, int wr, int wc, int fr, int fq) const {
        const int row0 = u.pm * BM + wr * 64 + fr; const int col0 = u.pn * BM + wc * 32 + 8 * fq;
        float rs[2][4];
#pragma unroll
        for (int ai = 0; ai < 2; ++ai)
#pragma unroll
            for (int m = 0; m < 4; ++m) rs[ai][m] = row_rstd(ssq, row0 + ai * HALF + m * 16, fq);
#pragma unroll
        for (int ai = 0; ai < 2; ++ai)
#pragma unroll
            for (int m = 0; m < 4; ++m) { const int row = row0 + ai * HALF + m * 16; const float s = rs[ai][m];
#pragma unroll
                for (int bj = 0; bj < 2; ++bj) { f32x4 v0 = acc[ai][bj][m][0] * s, v1 = acc[ai][bj][m][1] * s;
#pragma unroll
                    for (int i = 0; i < 4; ++i) { const float a = fmaxf(v0[i], 0.f), b = fmaxf(v1[i], 0.f); v0[i] = a * a; v1[i] = b * b; }
                    u32x4 w; w.x = cvtpk(v0[0], v0[1]); w.y = cvtpk(v0[2], v0[3]); w.z = cvtpk(v1[0], v1[1]); w.w = cvtpk(v1[2], v1[3]);
                    *(u32x4*)(H + (size_t)row * DFF + col0 + bj * HALF) = w; } }
    }
};
}

__device__ __forceinline__ int win_src(int n) {
    if (n < 3840) return n;
    if (n < 4608) return n + 4;
    if (n < 4864) return (n - 4608 < 4) ? 3840 + (n - 4608) : -1;
    return n - 4864 + 4612;
}
template <int CMAP>
__device__ __forceinline__ void transpose_item(const float* W, int K, int N, int Nsrc, const float* gain, bf16_t* WT, LAS float* scr, int item, int lane) {
    const int nblk = N / 32, kb = item / nblk, nb = item % nblk, k0 = 64 * kb, n0 = 32 * nb;
    const int n = n0 + (lane & 31); const int src = CMAP ? win_src(n) : n;
    const bool live = (src >= 0); const float* wp = W + (size_t)(k0 + (lane >> 5)) * Nsrc + (live ? src : 0); const float* gp = gain ? gain + k0 + (lane >> 5) : nullptr;
    float wv[32];
#pragma unroll
    for (int i = 0; i < 32; ++i) wv[i] = wp[(size_t)(2 * i) * Nsrc];
#pragma unroll
    for (int i = 0; i < 32; ++i) { float v = live ? wv[i] : 0.f; if (gp) v *= gp[2 * i]; scr[(2 * i + (lane >> 5)) * 33 + (lane & 31)] = v; }
    asm volatile("s_waitcnt lgkmcnt(0)" ::: "memory");
    const int c = lane & 7;
#pragma unroll
    for (int j = 0; j < 4; ++j) { const int nn = (lane >> 3) + 8 * j; const LAS float* s = scr + (8 * c) * 33 + nn;
        u32x4 o; o.x = cvtpk(s[0 * 33], s[1 * 33]); o.y = cvtpk(s[2 * 33], s[3 * 33]); o.z = cvtpk(s[4 * 33], s[5 * 33]); o.w = cvtpk(s[6 * 33], s[7 * 33]);
        *(u32x4*)(WT + (size_t)(n0 + nn) * K + k0 + 8 * c) = o; }
    asm volatile("s_waitcnt lgkmcnt(0)" ::: "memory");
}

__device__ __forceinline__ void branch_item(const float* Wn, int n, bf16_t* WBP, LAS float* scr, int item, int lane) {
    const int kb = item >> 5, nb = item & 31, k0 = 64 * kb, n0 = 32 * nb;
    const float* wp = Wn + (size_t)(k0 + (lane >> 5)) * DM + n0 + (lane & 31);
    float wv[32];
#pragma unroll
    for (int i = 0; i < 32; ++i) wv[i] = wp[(size_t)(2 * i) * DM];
#pragma unroll
    for (int i = 0; i < 32; ++i) scr[(2 * i + (lane >> 5)) * 33 + (lane & 31)] = wv[i];
    asm volatile("s_waitcnt lgkmcnt(0)" ::: "memory");
    const int c = lane & 7, bj = n & 1, pair = n >> 1;
    const u32x4 zero = {0u, 0u, 0u, 0u};
#pragma unroll
    for (int j = 0; j < 4; ++j) { const int nn = (lane >> 3) + 8 * j; const LAS float* sp = scr + (8 * c) * 33 + nn; const int d = n0 + nn;
        u32x4 o; o.x = cvtpk(sp[0 * 33], sp[1 * 33]); o.y = cvtpk(sp[2 * 33], sp[3 * 33]); o.z = cvtpk(sp[4 * 33], sp[5 * 33]); o.w = cvtpk(sp[6 * 33], sp[7 * 33]);
        bf16_t* row = WBP + ((size_t)((pair * 8 + (d >> 7)) * 256 + bj * 128 + (d & 127))) * 512 + k0 + 8 * c;
        *(u32x4*)(row + 256 * bj) = o; *(u32x4*)(row + 256 * (1 - bj)) = zero; }
    asm volatile("s_waitcnt lgkmcnt(0)" ::: "memory");
}

#define MFMA32(a, b, c) __builtin_amdgcn_mfma_f32_32x32x16_bf16((a), (b), (c), 0, 0, 0)
__device__ __forceinline__ bf16x8 ld16(const bf16_t* p) { return *(const bf16x8*)p; }
__device__ __forceinline__ bf16x8 pack8(const f32x16& s, int b) { u32x4 w; w.x = cvtpk(s[b], s[b + 1]); w.y = cvtpk(s[b + 2], s[b + 3]); w.z = cvtpk(s[b + 4], s[b + 5]); w.w = cvtpk(s[b + 6], s[b + 7]); return __builtin_bit_cast(bf16x8, w); }
__device__ __forceinline__ int crow(int r, int hi) { return (r & 3) + 8 * (r >> 2) + 4 * hi; }
__device__ __forceinline__ void store_o(bf16_t* orow, const f32x16& o0, const f32x16& o1, int hi) {
#pragma unroll
    for (int g = 0; g < 4; ++g) {
        u32x2 a; a.x = cvtpk(o0[4 * g], o0[4 * g + 1]); a.y = cvtpk(o0[4 * g + 2], o0[4 * g + 3]); *(u32x2*)(orow + 8 * g + 4 * hi) = a;
        u32x2 b; b.x = cvtpk(o1[4 * g], o1[4 * g + 1]); b.y = cvtpk(o1[4 * g + 2], o1[4 * g + 3]); *(u32x2*)(orow + 32 + 8 * g + 4 * hi) = b; }
}

struct KFrag { bf16x8 k[4]; };
struct VFrag { bf16x8 v[4]; };
__device__ __forceinline__ void k_load(KFrag& f, const bf16_t* Kh, int kb, int lane) {
    const bf16_t* kp = Kh + (size_t)kb * 2048 + lane * 8;
#pragma unroll
    for (int ds = 0; ds < 4; ++ds) f.k[ds] = ld16(kp + ds * 512);
}
__device__ __forceinline__ void v_load(VFrag& f, const bf16_t* Vh, int kb, int lane) {
    const bf16_t* vp = Vh + (size_t)kb * 2048 + lane * 8;
    f.v[0] = ld16(vp); f.v[1] = ld16(vp + 512); f.v[2] = ld16(vp + 1024); f.v[3] = ld16(vp + 1536);
}
__device__ __forceinline__ void q_load(bf16x8 (&qf)[4], const bf16_t* Qs, int qb, int r32, int hi) {
    const bf16_t* qp = Qs + (size_t)(qb * 32 + r32) * LDQK + hi * 8;
#pragma unroll
    for (int ds = 0; ds < 4; ++ds) qf[ds] = ld16(qp + ds * 16);
}

template <int MODE, bool MASK, int NDS>
__device__ __forceinline__ void sm_step(const bf16x8 (&ck)[NDS], const bf16x8 (&qf)[NDS], const VFrag& cv, float slope2, const LAS float* cl, int kb, int d0,
                                        float& m, float& l, f32x16& o0, f32x16& o1, int hi) {
    constexpr float SC2 = ((MODE == 2) ? 0.17677669529663687f : 0.125f) * LOG2E;
    f32x16 s;
#pragma unroll
    for (int i = 0; i < 16; ++i) s[i] = 0.f;
#pragma unroll
    for (int ds = 0; ds < NDS; ++ds) s = MFMA32(ck[ds], qf[ds], s);
#define KC(r) (((r) & 3) + 8 * ((r) >> 2))
    int dh = d0 - 4 * hi; asm volatile("" : "+v"(dh));
    float sl = slope2; asm volatile("" : "+v"(sl));
    const LAS float* clk = cl + 33 * kb + 4 * hi; if (MODE == 0) asm volatile("" : "+v"(clk));
    const float base = (MODE == 0) ? 0.f : -sl * (float)dh;
#pragma unroll
    for (int r = 0; r < 16; ++r) {
        float v = (MODE == 0) ? fmaf(s[r], SC2, clk[KC(r)]) : fmaf(s[r], SC2, sl * (float)KC(r));
        if (MASK) { const int dist = dh - KC(r); const bool valid = (MODE == 1) ? ((unsigned)dist <= 128u) : (dist >= 0); v = valid ? v : -INFINITY; }
        s[r] = v;
    }
#undef KC
    float mt = fmaxf(fmaxf(s[0], s[1]), fmaxf(s[2], s[3]));
#pragma unroll
    for (int r = 4; r < 16; r += 4) mt = fmaxf(mt, fmaxf(fmaxf(s[r], s[r + 1]), fmaxf(s[r + 2], s[r + 3])));
    mt = x32_max(mt + base);
    const float mn = fmaxf(m, mt), alpha = ex2(m - mn), c = mn - base;
    float ps = 0.f;
#pragma unroll
    for (int r = 0; r < 16; ++r) { const float p = ex2(s[r] - c); s[r] = p; ps += p; }
    l = l * alpha + ps; m = mn;
#pragma unroll
    for (int i = 0; i < 16; ++i) { o0[i] *= alpha; o1[i] *= alpha; }
    const bf16x8 pf0 = pack8(s, 0), pf1 = pack8(s, 8);
    o0 = MFMA32(cv.v[0], pf0, o0); o0 = MFMA32(cv.v[1], pf1, o0); o1 = MFMA32(cv.v[2], pf0, o1); o1 = MFMA32(cv.v[3], pf1, o1);
}
template <int MODE>
__device__ __forceinline__ void sm_unit(const bf16_t* Qs, const bf16_t* Ks, const bf16_t* VTs, int qb, int kb_hi, int kb_lo, float slope2, const LAS float* cl,
                                        f32x16& o0, f32x16& o1, float& m_out, float& l_out, int lane) {
    const int r32 = lane & 31, hi = lane >> 5;
    constexpr int NDS = (MODE == 2) ? 2 : 4;
    bf16x8 qf[NDS];
    { const bf16_t* qp = Qs + (size_t)(qb * 32 + r32) * LDQK + hi * 8;
#pragma unroll
      for (int ds = 0; ds < NDS; ++ds) qf[ds] = ld16(qp + ds * 16); }
    bf16x8 nk[NDS];
    { const bf16_t* kp = Ks + (size_t)kb_hi * 2048 + lane * 8;
#pragma unroll
      for (int ds = 0; ds < NDS; ++ds) nk[ds] = ld16(kp + ds * 512); }
    float m = -INFINITY, l = 0.f;
#pragma unroll
    for (int i = 0; i < 16; ++i) { o0[i] = 0.f; o1[i] = 0.f; }
    for (int kb = kb_hi; kb >= kb_lo; --kb) {
        bf16x8 ck[NDS];
#pragma unroll
        for (int ds = 0; ds < NDS; ++ds) ck[ds] = nk[ds];
        VFrag cv; v_load(cv, VTs, kb, lane);
        if (kb > kb_lo) { const bf16_t* kp = Ks + (size_t)(kb - 1) * 2048 + lane * 8;
#pragma unroll
            for (int ds = 0; ds < NDS; ++ds) nk[ds] = ld16(kp + ds * 512); }
        const int d0 = (qb - kb) * 32 + r32;
        const bool edge = (MODE == 1) ? (kb == qb || kb + 4 <= qb) : (kb == qb);
        if (edge) sm_step<MODE, true, NDS>(ck, qf, cv, slope2, cl, kb, d0, m, l, o0, o1, hi);
        else      sm_step<MODE, false, NDS>(ck, qf, cv, slope2, cl, kb, d0, m, l, o0, o1, hi);
    }
    l = x32_sum(l);
    m_out = m; l_out = l;
}

template <int MODE>
__device__ __forceinline__ void sm_unit64(const bf16_t* Qs, const bf16_t* Ks, const bf16_t* VTs, int Q, int kb_hi, int kb_lo, float slope2, const LAS float* cl,
                                          f32x16 (&o)[2][2], float (&m)[2], float (&l)[2], int lane) {
    const int r32 = lane & 31, hi = lane >> 5;
    constexpr int NDS = (MODE == 2) ? 2 : 4;
    bf16x8 qf[2][NDS];
#pragma unroll
    for (int i = 0; i < 2; ++i) { const bf16_t* qp = Qs + (size_t)((2 * Q + i) * 32 + r32) * LDQK + hi * 8;
#pragma unroll
        for (int ds = 0; ds < NDS; ++ds) qf[i][ds] = ld16(qp + ds * 16); }
    bf16x8 nk[NDS];
    { const bf16_t* kp = Ks + (size_t)kb_hi * 2048 + lane * 8;
#pragma unroll
      for (int ds = 0; ds < NDS; ++ds) nk[ds] = ld16(kp + ds * 512); }
#pragma unroll
    for (int i = 0; i < 2; ++i) { m[i] = -INFINITY; l[i] = 0.f;
#pragma unroll
        for (int k = 0; k < 16; ++k) { o[i][0][k] = 0.f; o[i][1][k] = 0.f; } }
    for (int kb = kb_hi; kb >= kb_lo; --kb) {
        bf16x8 ck[NDS];
#pragma unroll
        for (int ds = 0; ds < NDS; ++ds) ck[ds] = nk[ds];
        VFrag cv; v_load(cv, VTs, kb, lane);
        if (kb > kb_lo) { const bf16_t* kp = Ks + (size_t)(kb - 1) * 2048 + lane * 8;
#pragma unroll
            for (int ds = 0; ds < NDS; ++ds) nk[ds] = ld16(kp + ds * 512); }
        if (kb < 2 * Q) {
            const int d00 = (2 * Q - kb) * 32 + r32;
            sm_step<MODE, false, NDS>(ck, qf[0], cv, slope2, cl, kb, d00, m[0], l[0], o[0][0], o[0][1], hi);
            sm_step<MODE, false, NDS>(ck, qf[1], cv, slope2, cl, kb, d00 + 32, m[1], l[1], o[1][0], o[1][1], hi);
        } else {
#pragma unroll
            for (int i = 0; i < 2; ++i) {
                const int qbi = 2 * Q + i;
                if (kb <= qbi) {
                    const int d0 = (qbi - kb) * 32 + r32;
                    if (kb == qbi) sm_step<MODE, true, NDS>(ck, qf[i], cv, slope2, cl, kb, d0, m[i], l[i], o[i][0], o[i][1], hi);
                    else           sm_step<MODE, false, NDS>(ck, qf[i], cv, slope2, cl, kb, d0, m[i], l[i], o[i][0], o[i][1], hi);
                }
            }
        }
    }
    l[0] = x32_sum(l[0]); l[1] = x32_sum(l[1]);
}

__device__ __forceinline__ void sb_unit(const bf16_t* Qs, const bf16_t* Ks, const bf16_t* VTs, int qb, f32x16& o0, f32x16& o1, int lane) {
    const int r32 = lane & 31, hi = lane >> 5;
    constexpr float SC2 = 0.125f * LOG2E;
    bf16x8 qf[4]; q_load(qf, Qs, qb, r32, hi);
    KFrag nx; k_load(nx, Ks, qb, lane);
    float R = 0.f;
#pragma unroll
    for (int i = 0; i < 16; ++i) { o0[i] = 0.f; o1[i] = 0.f; }
    for (int kb = qb; kb >= 0; --kb) {
        const KFrag cu = nx; VFrag cv; v_load(cv, VTs, kb, lane);
        if (kb > 0) k_load(nx, Ks, kb - 1, lane);
        f32x16 s;
#pragma unroll
        for (int i = 0; i < 16; ++i) s[i] = 0.f;
#pragma unroll
        for (int ds = 0; ds < 4; ++ds) s = MFMA32(cu.k[ds], qf[ds], s);
        float lk[16], ls[16];
        const int d0 = (qb - kb) * 32 + r32;
#pragma unroll
        for (int r = 0; r < 16; ++r) { const float z2 = s[r] * SC2; const float sp = fmaxf(z2, 0.f) + lg2(1.0f + ex2(-fabsf(z2))); const bool valid = crow(r, hi) < d0; lk[r] = valid ? -sp : 0.f; ls[r] = valid ? (z2 - sp) : -INFINITY; }
        float e[16], tq[4], pq[4];
#pragma unroll
        for (int g = 0; g < 4; ++g) { e[4 * g + 3] = 0.f; e[4 * g + 2] = lk[4 * g + 3]; e[4 * g + 1] = e[4 * g + 2] + lk[4 * g + 2]; e[4 * g] = e[4 * g + 1] + lk[4 * g + 1]; tq[g] = e[4 * g] + lk[4 * g]; }
#pragma unroll
        for (int g = 0; g < 4; ++g) pq[g] = x32_partner(tq[g], hi);
        float cs[4]; cs[3] = 0.f; cs[2] = tq[3] + pq[3]; cs[1] = cs[2] + (tq[2] + pq[2]); cs[0] = cs[1] + (tq[1] + pq[1]);
        const float total = cs[0] + (tq[0] + pq[0]);
#pragma unroll
        for (int g = 0; g < 4; ++g) { const float later = R + cs[g] + (hi == 0 ? pq[g] : 0.f);
#pragma unroll
            for (int i = 0; i < 4; ++i) s[4 * g + i] = ex2(ls[4 * g + i] + e[4 * g + i] + later); }
        R += total;
        const bf16x8 pf0 = pack8(s, 0), pf1 = pack8(s, 8);
        o0 = MFMA32(cv.v[0], pf0, o0); o0 = MFMA32(cv.v[1], pf1, o0); o1 = MFMA32(cv.v[2], pf0, o1); o1 = MFMA32(cv.v[3], pf1, o1);
        if (__all(R < -150.0f)) break;
    }
}

#define XB_TMO      128
#define XB_XCNT(j)  (256  + 64 * (j))
#define XB_XSUB(j)  (1280 + 64 * (j))
#define XB_XGEN(j)  (2304 + 64 * (j))
#define XB_TOP      3328
#define XB_TOPGEN   3392
#define XCD_BAR_WORDS 3456
#define XB_SPIN_CAP (1u << 18)
__device__ __forceinline__ unsigned xb_ld(unsigned* p)              { return __hip_atomic_load(p, __ATOMIC_RELAXED, __HIP_MEMORY_SCOPE_AGENT); }
__device__ __forceinline__ unsigned xb_add(unsigned* p, unsigned v) { return __hip_atomic_fetch_add(p, v, __ATOMIC_RELAXED, __HIP_MEMORY_SCOPE_AGENT); }
__device__ __forceinline__ unsigned xb_xcc_id() { return (unsigned)__builtin_amdgcn_s_getreg((3 << 11) | 20) & 0xFu; }
#define XB_SPIN(cond, bar) do { unsigned _sp = 0; while (cond) { __builtin_amdgcn_s_sleep(1); \
    if ((++_sp & 255u) == 0u) { if (xb_ld(&(bar)[XB_TMO])) break; if (_sp > XB_SPIN_CAP) { atomicAdd(&(bar)[XB_TMO], 1u); break; } } } } while (0)
__device__ __forceinline__ void xcd_barrier_complete(unsigned* bar, unsigned x, unsigned& nloc, unsigned& nx) {
    const unsigned G = gridDim.x * gridDim.y * gridDim.z;
    unsigned sum, cnt, mine, sp = 0u;
    for (;;) {
        sum = 0u; cnt = 0u; mine = 0u;
#pragma unroll
        for (unsigned j = 0; j < 16; ++j) { const unsigned c = xb_ld(&bar[XB_XCNT(j)]); sum += c; cnt += (c > 0u) ? 1u : 0u; mine = (j == x) ? c : mine; }
        if (sum == G) break;
        __builtin_amdgcn_s_sleep(1);
        if ((++sp & 255u) == 0u) { if (xb_ld(&bar[XB_TMO])) break; if (sp > XB_SPIN_CAP) { atomicAdd(&bar[XB_TMO], 1u); break; } }
    }
    nloc = mine > 0u ? mine : 1u; nx = cnt > 0u ? cnt : 1u;
}
__device__ __forceinline__ void xcd_barrier(unsigned* bar, volatile LAS unsigned* st) {
    asm volatile("s_waitcnt vmcnt(0)" ::: "memory");
    __syncthreads();
    if (threadIdx.x == 0) {
        const unsigned x = xb_xcc_id();
        __builtin_amdgcn_s_waitcnt(0);
        unsigned nloc = st[0], nx = st[1];
        if (nloc == 0u) { xcd_barrier_complete(bar, x, nloc, nx); st[0] = nloc; st[1] = nx; }
        const unsigned old = xb_add(&bar[XB_XSUB(x)], 1u);
        const unsigned gen = old / nloc;
        if (old + 1u == (gen + 1u) * nloc) {
            __builtin_amdgcn_fence(__ATOMIC_RELEASE, "agent");
            asm volatile("s_waitcnt vmcnt(0)" ::: "memory");
            const unsigned og = xb_add(&bar[XB_TOP], 1u);
            const unsigned tg = og / nx;
            if (og + 1u == (tg + 1u) * nx) xb_add(&bar[XB_TOPGEN], 1u);
            else XB_SPIN(xb_ld(&bar[XB_TOPGEN]) == tg, bar);
            __builtin_amdgcn_fence(__ATOMIC_ACQUIRE, "agent");
            xb_add(&bar[XB_XGEN(x)], 1u);
            asm volatile("s_waitcnt vmcnt(0)" ::: "memory");
        } else {
            XB_SPIN(xb_ld(&bar[XB_XGEN(x)]) == gen, bar);
            __builtin_amdgcn_fence(__ATOMIC_ACQUIRE, "agent");
            asm volatile("s_waitcnt vmcnt(0)" ::: "memory");
        }
    }
    __syncthreads();
}
constexpr int MISC_OFF = 131072 + 320;

struct Params {
    const float* x; const float* mix_g; const float* w_in; const float* b_forget; const float* lq1; const float* lk1; const float* lq2; const float* lk2;
    const float* diff_g; const float* w_branch; const float* w_out; const float* mlp_g; const float* w_up; const float* w_down; const float* final_g;
    float* out; unsigned char* ws;
};

#ifndef REP_P1
#define REP_P1 1
#endif
#ifndef REP_P2
#define REP_P2 1
#endif
#ifndef REP_P3
#define REP_P3 1
#endif
#ifndef REP_P5
#define REP_P5 1
#endif
#ifndef REP_SYNC
#define REP_SYNC 1
#endif
#ifndef REP_CONV
#define REP_CONV 1
#endif
#define GSYNC() do { for (int rs_ = 0; rs_ < REP_SYNC; ++rs_) { KParamsPtr pb_ = OPQ_PP(); xcd_barrier((unsigned*)(pb_->ws + WS_CTL) + CW_BAR, (volatile LAS unsigned*)(lds + MISC_OFF)); } } while (0)
#define OPQ_TID() ({ int t_ = threadIdx.x; asm volatile("" : "+v"(t_)); t_; })
typedef const __attribute__((address_space(4))) Params* KParamsPtr;
#define OPQ_PP() ({ KParamsPtr p_ = (KParamsPtr)__builtin_amdgcn_kernarg_segment_ptr(); asm volatile("" : "+s"(p_)); p_; })
#define PHASE_VARS() const int tid = OPQ_TID(); const int lane = tid & 63, wave = __builtin_amdgcn_readfirstlane(tid >> 6); const int G = gridDim.x, bx = blockIdx.x; \
    const int gw = bx * NWAVES + wave, NGW = G * NWAVES; KParamsPtr PP = OPQ_PP(); unsigned char* ws = PP->ws; LAS float* scr = (LAS float*)(lds + wave * 16384); (void)lane; (void)gw; (void)NGW; (void)ws; (void)scr; (void)G; (void)bx; (void)PP

__global__ void __launch_bounds__(NWAVES * 64, 2) fwd_mega(Params P) {
    extern __shared__ __attribute__((aligned(16))) unsigned char lds_raw[];
    LAS unsigned char* lds = (LAS unsigned char*)lds_raw;
    cg::grid_group grid = cg::this_grid();
    { KParamsPtr pz = OPQ_PP(); if (pz->ws == nullptr) grid.sync(); }
    { const int t0 = OPQ_TID(); if (t0 < 64) ((LAS unsigned*)(lds + 131072))[t0 + 64] = 0u; __syncthreads();
      if (t0 == 0) { KParamsPtr p0 = OPQ_PP(); (void)xb_add((unsigned*)(p0->ws + WS_CTL) + CW_BAR + XB_XCNT(xb_xcc_id()), 1u); } }

    {
        PHASE_VARS();
        bf16_t* XB = (bf16_t*)(ws + WS_XB); float* SSQ = (float*)(ws + WS_SSQ);
        for (int row = gw; row < TOK; row += NGW) {
            const f32x4* xr = (const f32x4*)(PP->x + (size_t)row * DM) + lane;
            unsigned long long* o8 = (unsigned long long*)(XB + (size_t)row * DM) + lane;
            float s = 0.f;
#pragma unroll
            for (int j = 0; j < 4; ++j) { const f32x4 v = xr[64 * j]; s += (v[0] * v[0] + v[1] * v[1]) + (v[2] * v[2] + v[3] * v[3]);
                o8[64 * j] = (unsigned long long)cvtpk(v[0], v[1]) | ((unsigned long long)cvtpk(v[2], v[3]) << 32); }
            s = wave_sum(s);
            if (lane < 16) SSQ[(size_t)row * 16 + lane] = (lane == 0) ? s : 0.f;
        }
    }

    for (int layer = 0; layer < DEPTH; ++layer) {
        for (int rep = 0; rep < REP_CONV; ++rep) {
            PHASE_VARS();
            bf16_t* WIN = (bf16_t*)(ws + WS_WIN); bf16_t* WB = (bf16_t*)(ws + WS_WB); bf16_t* WOUT = (bf16_t*)(ws + WS_WOUT);
            const float* w_in = PP->w_in + (size_t)layer * DM * DIN; const float* mg = PP->mix_g + (size_t)layer * DM;
            const float* wb = PP->w_branch + (size_t)layer * 4 * 256 * DM; const float* wo = PP->w_out + (size_t)layer * DM * DM;
            constexpr int I_IN = (DM / 64) * (NPROJ / 32), I_B = (256 / 64) * (DM / 32), I_O = (DM / 64) * (DM / 32);
            for (int it = gw; it < I_IN + 4 * I_B + I_O; it += NGW) {
                int r = it;
                if (r < I_IN) { transpose_item<1>(w_in, DM, NPROJ, DIN, mg, WIN, scr, r, lane); continue; } r -= I_IN;
                if (r < 4 * I_B) { const int n = r / I_B; branch_item(wb + (size_t)n * 256 * DM, n, WB, scr, r % I_B, lane); continue; } r -= 4 * I_B;
                transpose_item<0>(wo, DM, DM, DM, nullptr, WOUT, scr, r, lane);
            }
        }
        GSYNC();

        for (int half = 0; half < 2; ++half) {
#ifndef NO_P1
            for (int rep = 0; rep < REP_P1; ++rep) {
                PHASE_VARS();
                const int rb = half * HT;
                pg8::Gemm g{(const bf16_t*)(ws + WS_XB) + (size_t)rb * DM, (const bf16_t*)(ws + WS_WIN), DM, DM, DM, 0, 0};
                pg8::StaticOrder S; S.init(HT, NPROJ, G, bx);
                pg8::EpiProj E{(const float*)(ws + WS_SSQ), rb, (bf16_t*)(ws + WS_QK), (bf16_t*)(ws + WS_KF), (bf16_t*)(ws + WS_VT), (float*)(ws + WS_FL), (bf16_t*)(ws + WS_GATE)};
                pg8::gemm_phase<pg8::EpiProj, pg8::StaticOrder, true>(lds, g, S, E);
            }
#endif
            GSYNC();
#ifndef NO_P2
            for (int rep = 0; rep < REP_P2; ++rep) {
                PHASE_VARS();
                unsigned* ctr = (unsigned*)(ws + WS_CTL) + 64 + 512 * (layer * 2 + half + 4 * rep);
                const int xq = bx & 7;
                ctr += 64 * xq;
                for (;;) {
                    int li = 0; if (lane == 0) li = (int)atomicAdd(ctr, 1u); li = __builtin_amdgcn_readfirstlane(li);
                    if (li >= 800) break;
                    int idx;
                    if (li < 288) { const int row = li / 6, hl = li - row * 6; idx = row * 48 + (xq + 8 * hl); }
                    else if (li < 416) { const int i = li - 288; idx = 2304 + ((63 - (i & 63)) << 4) + (xq + 8 * (i >> 6)); }
                    else { const int i = li - 416; idx = 3328 + (xq + 8 * (i >> 6)) * 64 + (i & 63); }
                    int lane_u = lane; asm volatile("" : "+v"(lane_u));
                    const int lane = lane_u, r32 = lane & 31, hi = lane >> 5;
                    KParamsPtr PU = OPQ_PP(); unsigned char* wsu = PU->ws;
                    bf16_t* YS = (bf16_t*)(wsu + WS_YS); bf16_t* DILO = (bf16_t*)(wsu + WS_DILO); float* LSE = (float*)(wsu + WS_LSE); const float* FL = (const float*)(wsu + WS_FL);
                    const bf16_t* QK = (const bf16_t*)(wsu + WS_QK); const bf16_t* KF = (const bf16_t*)(wsu + WS_KF); const bf16_t* VT = (const bf16_t*)(wsu + WS_VT);
                    if (idx < 2304) {
                        const int j = idx / 48, e = idx - j * 48, type3 = e >> 4, bh = e & 15, b = bh >> 2, h = bh & 3;
                        int Q, chunk; if (j < 32) { Q = 31 - (j >> 1); chunk = j & 1; } else { Q = 47 - j; chunk = 0; }
                        int kb_lo = 0, kb_hi = 2 * Q + 1;
                        if (Q >= 16) { if (chunk == 0) kb_hi = Q; else kb_lo = Q + 1; }
                        const size_t rowb = (size_t)b * SEQ;
                        bf16_t* SCRB = (bf16_t*)(wsu + WS_MERGED) + (size_t)(half * HT) * DM;
                        float* LSE2 = (float*)(wsu + WS_LSE2);
                        f32x16 o[2][2]; float m[2], l[2]; int slot;
                        if (type3 == 2) {
                            LAS float* cl = scr;
                            const float bf = PP->b_forget[layer * 4 + h];
                            float run = 0.f;
                            if (lane <= kb_hi) {
                                const float* fp = FL + (rowb + 32 * lane) * 4 + h;
#pragma unroll 8
                                for (int i = 0; i < 32; ++i) { const float y = fp[4 * i] + bf; const float lf = fminf(y, 0.f) - __logf(1.0f + __expf(-fabsf(y))); run += lf; cl[33 * lane + i] = run; }
                            }
                            float incl = run;
#pragma unroll
                            for (int o_ = 1; o_ < 64; o_ <<= 1) { const float tt = __uint_as_float((unsigned)__builtin_amdgcn_ds_bpermute((lane - o_) << 2, (int)__float_as_uint(incl))); if (lane >= o_) incl += tt; }
                            const float excl = incl - run;
                            if (lane <= kb_hi) {
#pragma unroll 8
                                for (int i = 0; i < 32; ++i) cl[33 * lane + i] = -(cl[33 * lane + i] + excl) * LOG2E;
                            }
                            asm volatile("s_waitcnt lgkmcnt(0)" ::: "memory");
                            sm_unit64<0>(QK + rowb * LDQK + 4 * 256 + h * 64, KF + (size_t)(b * 24 + 16 + h) * HSEQ, VT + (size_t)(b * 24 + 16 + h) * HSEQ, Q, kb_hi, kb_lo, 0.f, cl, o, m, l, lane);
                            asm volatile("s_waitcnt lgkmcnt(0)" ::: "memory");
                            slot = chunk;
                        } else {
                            const float slope = exp2f(-8.0f * (float)(5 + h) / 16.0f);
                            sm_unit64<2>(QK + rowb * LDQK + 5 * 256 + h * 64 + type3 * 32, KF + (size_t)(b * 24 + 20 + h) * HSEQ + type3 * 1024, VT + (size_t)(b * 24 + 20 + h) * HSEQ, Q, kb_hi, kb_lo, slope * LOG2E, nullptr, o, m, l, lane);
                            slot = 2 + 2 * type3 + chunk;
                        }
#pragma unroll
                        for (int i = 0; i < 2; ++i) {
                            const int t = (2 * Q + i) * 32 + r32;
                            bf16_t* dst;
                            if (type3 == 2) dst = chunk ? SCRB + (rowb + t) * 256 + h * 64 : YS + (rowb + t) * DM + 512 + h * 64;
                            else dst = (type3 == 0 && chunk == 0) ? YS + (rowb + t) * DM + 768 + h * 64 : SCRB + (size_t)(2 * type3 + chunk) * HT * 256 + (rowb + t) * 256 + h * 64;
                            const float inv = 1.0f / l[i];
#pragma unroll
                            for (int k = 0; k < 16; ++k) { o[i][0][k] *= inv; o[i][1][k] *= inv; }
                            store_o(dst, o[i][0], o[i][1], hi);
                            if (hi == 0) LSE2[(rowb + t) * 24 + h * 6 + slot] = m[i] + lg2(l[i]);
                        }
                    } else if (idx < 3328) {
                        const int i1 = idx - 2304, qb = 63 - (i1 >> 4), bh = i1 & 15, b = bh >> 2, h = bh & 3;
                        const size_t rowb = (size_t)b * SEQ; const int t = qb * 32 + r32;
                        f32x16 o0, o1;
                        sb_unit(QK + rowb * LDQK + 0 * 256 + h * 64, KF + (size_t)(b * 24 + h) * HSEQ, VT + (size_t)(b * 24 + h) * HSEQ, qb, o0, o1, lane);
                        store_o(YS + (rowb + t) * DM + 0 * 256 + h * 64, o0, o1, hi);
                    } else {
                        const int i2 = idx - 3328, j = i2 & 63, gh = (i2 >> 6) % 12, b = i2 / 768, gI = gh >> 2, h = gh & 3;
                        const int rsh = 2 * gI, r = 1 << rsh, sl = SEQ >> rsh, nubsh = 6 - rsh, rho = j >> nubsh, ub = j & ((1 << nubsh) - 1);
                        const int sidx = (gI == 0) ? h : (gI == 1 ? 8 + h : 12 + h);
                        const float slope = exp2f(-8.0f * (float)(sidx + 1) / 16.0f);
                        const size_t rowb = (size_t)b * SEQ + (size_t)rho * sl;
                        f32x16 o0, o1; float m, l;
                        const int kb_lo = (ub - 4 > 0) ? ub - 4 : 0;
                        sm_unit<1>(QK + rowb * LDQK + (1 + gI) * 256 + h * 64, KF + (size_t)(b * 24 + 4 + 4 * gI + h) * HSEQ + (size_t)rho * sl * 64,
                                   VT + (size_t)(b * 24 + 4 + 4 * gI + h) * HSEQ + (size_t)rho * sl * 64, ub, ub, kb_lo, slope * (float)r * LOG2E, nullptr, o0, o1, m, l, lane);
                        const float inv = 1.0f / l;
#pragma unroll
                        for (int i = 0; i < 16; ++i) { o0[i] *= inv; o1[i] *= inv; }
                        const int u = ub * 32 + r32; const size_t tok = (size_t)b * SEQ + (size_t)u * r + rho;
                        store_o(DILO + tok * 768 + gI * 256 + h * 64, o0, o1, hi);
                        if (hi == 0) LSE[tok * 12 + gI * 4 + h] = (m + lg2(l)) * LN2;
                    }
                }
            }
#endif
            GSYNC();
            {
                PHASE_VARS();
                const float lam_init = (layer == 0) ? 0.2f : 0.35550906759093115f;
                float lam;
                { const float a = (lane < 32) ? PP->lq1[layer * 32 + lane] * PP->lk1[layer * 32 + lane] : 0.f, b = (lane < 32) ? PP->lq2[layer * 32 + lane] * PP->lk2[layer * 32 + lane] : 0.f;
                  lam = __expf(wave_sum(a)) - __expf(wave_sum(b)) + lam_init; }
                bf16_t* YS = (bf16_t*)(ws + WS_YS); const bf16_t* DILO = (const bf16_t*)(ws + WS_DILO); const float* LSE = (const float*)(ws + WS_LSE);
                const bf16_t* SCRB = (const bf16_t*)(ws + WS_MERGED) + (size_t)(half * HT) * DM; const float* LSE2 = (const float*)(ws + WS_LSE2);
                const int h = lane >> 4, dq = (lane & 15) * 4;
                const f32x4 dgv = *(const f32x4*)(PP->diff_g + layer * 64 + dq);
                for (int row = gw; row < HT; row += NGW) {
                    const bool split = ((row & (SEQ - 1)) >> 5) >= 32;
                    {
                        const float l0 = LSE[(size_t)row * 12 + h], l1 = LSE[(size_t)row * 12 + 4 + h], l2 = LSE[(size_t)row * 12 + 8 + h];
                        const float mx = fmaxf(l0, fmaxf(l1, l2)); const float e0 = __expf(l0 - mx), e1 = __expf(l1 - mx), e2 = __expf(l2 - mx); const float inv = 1.0f / (e0 + e1 + e2);
                        const u32x2 a = *(const u32x2*)(DILO + (size_t)row * 768 + 4 * lane), b = *(const u32x2*)(DILO + (size_t)row * 768 + 256 + 4 * lane), c = *(const u32x2*)(DILO + (size_t)row * 768 + 512 + 4 * lane);
                        const float w0 = e0 * inv, w1 = e1 * inv, w2 = e2 * inv;
                        u32x2 o; o.x = cvtpk(w0 * bflo(a.x) + w1 * bflo(b.x) + w2 * bflo(c.x), w0 * bfhi(a.x) + w1 * bfhi(b.x) + w2 * bfhi(c.x));
                        o.y = cvtpk(w0 * bflo(a.y) + w1 * bflo(b.y) + w2 * bflo(c.y), w0 * bfhi(a.y) + w1 * bfhi(b.y) + w2 * bfhi(c.y));
                        *(u32x2*)(YS + (size_t)row * DM + 256 + 4 * lane) = o;
                    }
                    const float* ls = LSE2 + (size_t)row * 24 + h * 6;
                    const u32x2 f0 = *(const u32x2*)(YS + (size_t)row * DM + 512 + 4 * lane), a0 = *(const u32x2*)(YS + (size_t)row * DM + 768 + 4 * lane);
                    const u32x2 b0 = *(const u32x2*)(SCRB + (size_t)2 * HT * 256 + (size_t)row * 256 + 4 * lane);
                    float fv[4] = {bflo(f0.x), bfhi(f0.x), bflo(f0.y), bfhi(f0.y)}, av[4] = {bflo(a0.x), bfhi(a0.x), bflo(a0.y), bfhi(a0.y)}, bv[4] = {bflo(b0.x), bfhi(b0.x), bflo(b0.y), bfhi(b0.y)};
                    if (split) {
                        const u32x2 f1 = *(const u32x2*)(SCRB + (size_t)row * 256 + 4 * lane), a1 = *(const u32x2*)(SCRB + (size_t)1 * HT * 256 + (size_t)row * 256 + 4 * lane), b1 = *(const u32x2*)(SCRB + (size_t)3 * HT * 256 + (size_t)row * 256 + 4 * lane);
                        const float lf0 = ls[0], lf1 = ls[1], la0 = ls[2], la1 = ls[3], lb0 = ls[4], lb1 = ls[5];
                        { const float mx = fmaxf(lf0, lf1), e0 = ex2(lf0 - mx), e1 = ex2(lf1 - mx), inv = 1.0f / (e0 + e1), w0 = e0 * inv, w1 = e1 * inv;
                          fv[0] = w0 * fv[0] + w1 * bflo(f1.x); fv[1] = w0 * fv[1] + w1 * bfhi(f1.x); fv[2] = w0 * fv[2] + w1 * bflo(f1.y); fv[3] = w0 * fv[3] + w1 * bfhi(f1.y); }
                        { const float mx = fmaxf(la0, la1), e0 = ex2(la0 - mx), e1 = ex2(la1 - mx), inv = 1.0f / (e0 + e1), w0 = e0 * inv, w1 = e1 * inv;
                          av[0] = w0 * av[0] + w1 * bflo(a1.x); av[1] = w0 * av[1] + w1 * bfhi(a1.x); av[2] = w0 * av[2] + w1 * bflo(a1.y); av[3] = w0 * av[3] + w1 * bfhi(a1.y); }
                        { const float mx = fmaxf(lb0, lb1), e0 = ex2(lb0 - mx), e1 = ex2(lb1 - mx), inv = 1.0f / (e0 + e1), w0 = e0 * inv, w1 = e1 * inv;
                          bv[0] = w0 * bv[0] + w1 * bflo(b1.x); bv[1] = w0 * bv[1] + w1 * bfhi(b1.x); bv[2] = w0 * bv[2] + w1 * bflo(b1.y); bv[3] = w0 * bv[3] + w1 * bfhi(b1.y); }
                        u32x2 fo; fo.x = cvtpk(fv[0], fv[1]); fo.y = cvtpk(fv[2], fv[3]);
                        *(u32x2*)(YS + (size_t)row * DM + 512 + 4 * lane) = fo;
                    }
                    float dv[4]; float ss = 0.f;
#pragma unroll
                    for (int i = 0; i < 4; ++i) { dv[i] = av[i] - lam * bv[i]; ss += dv[i] * dv[i]; }
                    ss += swz_xor<1>(ss); ss += swz_xor<2>(ss); ss += swz_xor<4>(ss); ss += swz_xor<8>(ss);
                    const float rn = __builtin_amdgcn_rsqf(ss * (1.0f / 64.0f) + RMS_EPS) * (1.0f - lam_init);
                    u32x2 dout; dout.x = cvtpk(dv[0] * rn * dgv[0], dv[1] * rn * dgv[1]); dout.y = cvtpk(dv[2] * rn * dgv[2], dv[3] * rn * dgv[3]);
                    *(u32x2*)(YS + (size_t)row * DM + 768 + 4 * lane) = dout;
                }
            }
            GSYNC();
#ifndef NO_P3
            for (int rep = 0; rep < REP_P3; ++rep) {
                PHASE_VARS();
                pg8::Gemm g{(const bf16_t*)(ws + WS_YS), (const bf16_t*)(ws + WS_WB), DM, 512, 512, 512 * 2, (long)8 * 256 * 512 * 2};
                pg8::BranchOrder S{bx, G};
                pg8::EpiBranch E{(const bf16_t*)(ws + WS_GATE), (bf16_t*)(ws + WS_MERGED), half * HT};
                pg8::gemm_phase<pg8::EpiBranch, pg8::BranchOrder, true>(lds, g, S, E);
            }
#endif
            GSYNC();
        }
#ifndef NO_P4
        for (int rep = 0; rep < REP_CONV; ++rep) {
            PHASE_VARS();
            bf16_t* WUP = (bf16_t*)(ws + WS_WUP); bf16_t* WDN = (bf16_t*)(ws + WS_WDN);
            const float* wu = PP->w_up + (size_t)layer * DM * DFF; const float* wd = PP->w_down + (size_t)layer * DFF * DM; const float* mg = PP->mlp_g + (size_t)layer * DM;
            constexpr int I_U = (DM / 64) * (DFF / 32), I_D = (DFF / 64) * (DM / 32);
            for (int it = gw; it < I_U + I_D; it += NGW) {
                if (it < I_U) transpose_item<0>(wu, DM, DFF, DFF, mg, WUP, scr, it, lane);
                else transpose_item<0>(wd, DFF, DM, DM, nullptr, WDN, scr, it - I_U, lane);
            }
            __syncthreads();
        }
        {
            PHASE_VARS();
            pg8::Gemm g{(const bf16_t*)(ws + WS_MERGED), (const bf16_t*)(ws + WS_WOUT), DM, DM, DM, 0, 0};
            pg8::StaticOrder S; S.init(TOK, DM, G, bx);
            pg8::EpiResid E{(layer == 0) ? PP->x : (const float*)PP->out, PP->out, (bf16_t*)(ws + WS_XB), (float*)(ws + WS_SSQ)};
            pg8::gemm_phase<pg8::EpiResid, pg8::StaticOrder, false>(lds, g, S, E);
        }
#endif
        GSYNC();
#ifndef NO_P5
        for (int rep = 0; rep < REP_P5; ++rep) {
            PHASE_VARS();
            pg8::Gemm g{(const bf16_t*)(ws + WS_XB), (const bf16_t*)(ws + WS_WUP), DM, DM, DM, 0, 0};
            pg8::StaticOrder S; S.init(TOK, DFF, G, bx);
            pg8::EpiUp E{(const float*)(ws + WS_SSQ), (bf16_t*)(ws + WS_HMLP)};
            pg8::gemm_phase<pg8::EpiUp, pg8::StaticOrder, true>(lds, g, S, E);
        }
#endif
        GSYNC();
#ifndef NO_P6
        {
            PHASE_VARS();
            pg8::Gemm g{(const bf16_t*)(ws + WS_HMLP), (const bf16_t*)(ws + WS_WDN), DFF, DFF, DFF, 0, 0};
            pg8::StaticOrder S; S.init(TOK, DM, G, bx);
            if (layer == DEPTH - 1 && G == 256) {
                pg8::EpiFinal E{(const float*)PP->out, PP->out, (float*)(ws + WS_SSQ), PP->final_g, (unsigned*)(ws + WS_CTL) + CW_PANEL};
                pg8::gemm_phase<pg8::EpiFinal, pg8::StaticOrder, true>(lds, g, S, E);
            } else {
                pg8::EpiResid E{(const float*)PP->out, PP->out, (bf16_t*)(ws + WS_XB), (float*)(ws + WS_SSQ)};
                pg8::gemm_phase<pg8::EpiResid, pg8::StaticOrder, false>(lds, g, S, E);
            }
        }
#endif
        if (layer < DEPTH - 1 || gridDim.x != 256) GSYNC();
    }
    if (gridDim.x != 256)
    {
        PHASE_VARS();
        float* X = PP->out;
        for (int row = gw; row < TOK; row += NGW) {
            f32x4* xo = (f32x4*)(X + (size_t)row * DM) + lane; const f32x4* gp = (const f32x4*)PP->final_g + lane;
            f32x4 v[4]; float s = 0.f;
#pragma unroll
            for (int j = 0; j < 4; ++j) { v[j] = xo[64 * j]; s += (v[j][0] * v[j][0] + v[j][1] * v[j][1]) + (v[j][2] * v[j][2] + v[j][3] * v[j][3]); }
            const float rstd = __builtin_amdgcn_rsqf(wave_sum(s) * (1.0f / DM) + RMS_EPS);
#pragma unroll
            for (int j = 0; j < 4; ++j) xo[64 * j] = v[j] * rstd * gp[64 * j];
        }
    }
}

extern "C" void kernel_launch(void* const* d_in, const int* in_sizes, int n_in, void* d_out, int out_size, void* d_ws, size_t ws_size, hipStream_t stream) {
    static int grid = 0;
    if (grid == 0) {
        if (n_in != 15 || in_sizes[0] != TOK * DM || out_size != TOK * DM || ws_size < WS_END) { fprintf(stderr, "kernel_launch: unexpected shapes / workspace (n_in %d, ws %zu)\n", n_in, ws_size); grid = -1; return; }
        int dev = 0, cus = 0, per_cu = 0;
        hipGetDevice(&dev); hipDeviceGetAttribute(&cus, hipDeviceAttributeMultiprocessorCount, dev);
        hipFuncSetAttribute((const void*)fwd_mega, hipFuncAttributeMaxDynamicSharedMemorySize, LDS_BYTES);
        hipOccupancyMaxActiveBlocksPerMultiprocessor(&per_cu, (const void*)fwd_mega, NWAVES * 64, LDS_BYTES);
        (void)hipGetLastError();
        if (per_cu < 1) per_cu = 1;
        grid = cus;
        if (grid > 256) grid = 256;
        if (grid % 8 != 0) { fprintf(stderr, "kernel_launch: the per-XCD work queues need a grid that is a multiple of 8 (got %d)\n", grid); grid = -1; return; }
    }
    if (grid < 0) return;
    hipMemsetAsync((char*)d_ws + WS_CTL, 0, CTL_BYTES, stream);
    Params p{};
    p.x = (const float*)d_in[0]; p.mix_g = (const float*)d_in[1]; p.w_in = (const float*)d_in[2]; p.b_forget = (const float*)d_in[3];
    p.lq1 = (const float*)d_in[4]; p.lk1 = (const float*)d_in[5]; p.lq2 = (const float*)d_in[6]; p.lk2 = (const float*)d_in[7];
    p.diff_g = (const float*)d_in[8]; p.w_branch = (const float*)d_in[9]; p.w_out = (const float*)d_in[10]; p.mlp_g = (const float*)d_in[11];
    p.w_up = (const float*)d_in[12]; p.w_down = (const float*)d_in[13]; p.final_g = (const float*)d_in[14];
    p.out = (float*)d_out; p.ws = (unsigned char*)d_ws;
    void* args[] = {&p};
    hipError_t e = hipLaunchCooperativeKernel((const void*)fwd_mega, dim3(grid), dim3(NWAVES * 64), args, LDS_BYTES, stream);
    if (e != hipSuccess) fprintf(stderr, "cooperative launch failed: %s (grid %d)\n", hipGetErrorString(e), grid);
}
```

```cpp
#include <hip/hip_runtime.h>
#include <hip/hip_cooperative_groups.h>
#include <cstdio>
#include <cstdint>
namespace cg = cooperative_groups;

#define LAS __attribute__((address_space(3)))
typedef unsigned short bf16_t;
typedef short bf16x8 __attribute__((ext_vector_type(8)));
typedef float f32x4 __attribute__((ext_vector_type(4)));
typedef float f32x16 __attribute__((ext_vector_type(16)));
typedef unsigned u32x4 __attribute__((ext_vector_type(4)));
typedef unsigned u32x2 __attribute__((ext_vector_type(2)));
typedef float f32x2_t __attribute__((ext_vector_type(2)));
typedef __bf16 bf16x2_t __attribute__((ext_vector_type(2)));

constexpr int DM = 1024, BATCH = 8, SEQ = 2048, DEPTH = 2, TOK = BATCH * SEQ, DFF = 4096, DIN = 8708;
constexpr int HT = TOK / 2;
constexpr int NPROJ = 35 * 256;
constexpr int LDQK = 6 * 256;
constexpr int HSEQ = SEQ * 64;
constexpr float LOG2E = 1.4426950408889634f, LN2 = 0.6931471805599453f;
constexpr float RMS_EPS = 1e-6f;

constexpr size_t MiB = 1u << 20;
constexpr size_t WS_CTL = 0, CTL_BYTES = 65536;
constexpr int CW_BAR = 4096, CW_PANEL = 8192;
constexpr size_t WS_SSQ = 1 * MiB;
constexpr size_t WS_WIN = 2 * MiB;
constexpr size_t WS_WUP = WS_WIN, WS_WDN = WS_WIN + 8 * MiB;
constexpr size_t WS_WB = 20 * MiB;
constexpr size_t WS_WOUT = 24 * MiB;
constexpr size_t WS_XB = 26 * MiB;
constexpr size_t WS_MERGED = 58 * MiB;
constexpr size_t WS_YS = 90 * MiB;
constexpr size_t WS_DILO = 106 * MiB;
constexpr size_t WS_LSE = 118 * MiB;
constexpr size_t WS_LSE2 = 118 * MiB + 512 * 1024;
constexpr size_t WS_FL = 119 * MiB + 512 * 1024;
constexpr size_t WS_QK = 120 * MiB;
constexpr size_t WS_KF = 144 * MiB;
constexpr size_t WS_VT = 168 * MiB;
constexpr size_t WS_GATE = 192 * MiB;
constexpr size_t WS_HMLP = 120 * MiB;
constexpr size_t WS_END = 256 * MiB;

constexpr int LDS_BYTES = 147456;
constexpr int NWAVES = 8;
#ifndef WGM_P1
#define WGM_P1 4
#endif
#ifndef WGM_P5
#define WGM_P5 8
#endif

__device__ __forceinline__ unsigned cvtpk(float lo, float hi) { f32x2_t v = {lo, hi}; bf16x2_t b = __builtin_convertvector(v, bf16x2_t); return __builtin_bit_cast(unsigned, b); }
__device__ __forceinline__ float bflo(unsigned w) { return __uint_as_float(w << 16); }
__device__ __forceinline__ float bfhi(unsigned w) { return __uint_as_float(w & 0xffff0000u); }
__device__ __forceinline__ float ex2(float x) { return __builtin_amdgcn_exp2f(x); }
__device__ __forceinline__ float lg2(float x) { return __builtin_amdgcn_logf(x); }
__device__ __forceinline__ float x32_sum(float v) { auto r = __builtin_amdgcn_permlane32_swap(__float_as_uint(v), __float_as_uint(v), false, false); return __uint_as_float(r[0]) + __uint_as_float(r[1]); }
__device__ __forceinline__ float x32_max(float v) { auto r = __builtin_amdgcn_permlane32_swap(__float_as_uint(v), __float_as_uint(v), false, false); return fmaxf(__uint_as_float(r[0]), __uint_as_float(r[1])); }
__device__ __forceinline__ float x32_partner(float v, int hi) { auto r = __builtin_amdgcn_permlane32_swap(__float_as_uint(v), __float_as_uint(v), false, false); return hi ? __uint_as_float(r[0]) : __uint_as_float(r[1]); }
template <int X> __device__ __forceinline__ float swz_xor(float v) { return __uint_as_float((unsigned)__builtin_amdgcn_ds_swizzle((int)__float_as_uint(v), (X << 10) | 0x1f)); }
__device__ __forceinline__ float x16_sum(float v) { return v + swz_xor<16>(v); }
__device__ __forceinline__ float wave_sum(float v) { v += swz_xor<1>(v); v += swz_xor<2>(v); v += swz_xor<4>(v); v += swz_xor<8>(v); v += swz_xor<16>(v); return x32_sum(v); }

namespace pg8 {
constexpr int BM = 256, BK = 64, HALF = 128, HTB = HALF * BK * 2, STAGE_BYTES = 8 * HTB, NXCD = 8, WGM = 8;
__host__ __device__ __forceinline__ int lds_byte(int r, int c) { const int st = (r >> 4) * 2 + (c >> 5), rr = r & 15, cc = c & 31, ob = rr * 64 + cc * 2; return st * 1024 + (ob ^ (((ob >> 9) & 1) << 5)); }
__host__ __device__ __forceinline__ void stage_rc(int b, int& R, int& C) { const int st = b / 1024, sb = b % 1024, swz = sb ^ (((sb >> 9) & 1) << 5); R = (st >> 1) * 16 + swz / 64; C = (st & 1) * 32 + (swz % 64) / 2; }
__host__ __device__ __forceinline__ int perm32(int rho) { const int n = rho >> 4, i = rho & 15; return 8 * (i >> 2) + 4 * n + (i & 3); }

struct Unit { int pm, pn, aux; };
struct Gemm { const bf16_t* A; const bf16_t* Bt; int lda, ldb, K; long a_aux, b_aux; };

struct StaticOrder {
    int nM, nN, nwg, G, c, wgm;
    __device__ void init(int M, int N, int G_, int c_, int wgm_ = WGM) { nM = M / BM; nN = N / BM; nwg = nM * nN; G = G_; c = c_; wgm = wgm_; }
    __device__ bool next(int i, Unit& u) const {
        const long L = (long)i * G + c; if (L >= nwg) return false;
        int wgid = (int)L; { const int q = nwg / NXCD, r = nwg % NXCD, xcd = wgid % NXCD, off = wgid / NXCD; wgid = (xcd < r ? xcd * (q + 1) : r * (q + 1) + (xcd - r) * q) + off; }
        const int nig = wgm * nN, gid = wgid / nig, fm = gid * wgm, gsz = (nM - fm) < wgm ? (nM - fm) : wgm;
        u.pm = fm + ((wgid % nig) % gsz); u.pn = (wgid % nig) / gsz; u.aux = 0; return true;
    }
};
struct BranchOrder {
    int c, G;
    __device__ bool next(int i, Unit& u) const { const int t = c + (i >> 1) * G; if (t >= 256) return false; const int x = t & 7, j = t >> 3; u.pm = x + 8 * (j >> 3); u.pn = j & 7; u.aux = i & 1; return true; }
};

template <class Epi, class Sched, bool ALIGN_EPI>
__device__ __forceinline__ void gemm_phase(LAS unsigned char* lds, const Gemm g, const Sched& S, const Epi& E) {
    int tid_ = threadIdx.x; asm volatile("" : "+v"(tid_));
    const int tid = tid_, wid = __builtin_amdgcn_readfirstlane(tid >> 6), lane = tid & 63, wr = wid >> 2, wc = wid & 3, fr = lane & 15, fq = lane >> 4;
    int nt_ = g.K / BK; asm volatile("" : "+s"(nt_)); const int nt = nt_;
    unsigned voffA[2], voffB[2];
#pragma unroll
    for (int i = 0; i < 2; ++i) { int R, C; stage_rc(tid * 16 + i * 8192, R, C); const int Rb = Epi::PERM ? ((R & ~31) + perm32(R & 31)) : R;
        voffA[i] = (unsigned)(R * g.lda + C) * 2u; voffB[i] = (unsigned)(Rb * g.ldb + C) * 2u; }
    const size_t kstep = (size_t)(BK * 2);
    const size_t hstepA = (size_t)HALF * g.lda * 2, hstepB = (size_t)HALF * g.ldb * 2;
    const size_t tstepA = 2 * hstepA, tstepB = 2 * hstepB;
    const unsigned ldsw = (unsigned)wid * 1024u;
    const int aoff = lds_byte(wr * 64 + fr, fq * 8), boff = lds_byte(wc * 32 + fr, fq * 8);
#define PG8_SA(b, h) (((b) * 2 + (h)) * HTB)
#define PG8_SB(b, h) ((4 + (b) * 2 + (h)) * HTB)
#define PG8_STAGE(bufoff, gbase, voff) do { _Pragma("unroll") for (int _i = 0; _i < 2; ++_i) \
        __builtin_amdgcn_global_load_lds((const unsigned*)((const char*)(gbase) + (voff)[_i]), (LAS unsigned*)(lds + (bufoff) + ldsw + _i * 8192), 16, 0, 0); } while (0)
#define PG8_LDA(dst, b, h) do { _Pragma("unroll") for (int m = 0; m < 4; ++m) _Pragma("unroll") for (int k = 0; k < 2; ++k) dst[m][k] = *(const LAS bf16x8*)(lds + PG8_SA(b, h) + aoff + m * 2048 + k * 1024); } while (0)
#define PG8_LDB(dst, b, h) do { _Pragma("unroll") for (int n = 0; n < 2; ++n) _Pragma("unroll") for (int k = 0; k < 2; ++k) dst[n][k] = *(const LAS bf16x8*)(lds + PG8_SB(b, h) + boff + n * 2048 + k * 1024); } while (0)
#define PG8_MMA(ai, bj, At, Bt) do { __builtin_amdgcn_s_setprio(1); _Pragma("unroll") for (int m = 0; m < 4; ++m) _Pragma("unroll") for (int n = 0; n < 2; ++n) _Pragma("unroll") for (int k = 0; k < 2; ++k) \
        acc[ai][bj][m][n] = __builtin_amdgcn_mfma_f32_16x16x32_bf16(Bt[n][k], At[m][k], acc[ai][bj][m][n], 0, 0, 0); __builtin_amdgcn_s_setprio(0); } while (0)
#define PG8_WAIT_V(n) asm volatile("s_waitcnt vmcnt(" #n ")" ::: "memory")
#define PG8_WAIT_L(n) asm volatile("s_waitcnt lgkmcnt(" #n ")" ::: "memory")
#define PG8_BAR __builtin_amdgcn_s_barrier()
#define PG8_SCHED __builtin_amdgcn_sched_barrier(0)
#define PG8_UA(u) ((const char*)g.A + (size_t)(u).pm * tstepA + (size_t)(u).aux * (size_t)g.a_aux)
#define PG8_UB(u) ((const char*)g.Bt + (size_t)(u).pn * tstepB + (size_t)(u).aux * (size_t)g.b_aux)
    Unit cur, nxt; int ui = 0;
    if (!S.next(0, cur)) return;
    f32x4 acc[2][2][4][2];
#pragma unroll
    for (int a = 0; a < 2; ++a)
#pragma unroll
        for (int b = 0; b < 2; ++b)
#pragma unroll
            for (int m = 0; m < 4; ++m)
#pragma unroll
                for (int n = 0; n < 2; ++n) acc[a][b][m][n] = (f32x4){0.f, 0.f, 0.f, 0.f};
    bf16x8 At[4][2], B0[2][2], B1[2][2];
    const char* cA = PG8_UA(cur); const char* cB = PG8_UB(cur);
    PG8_STAGE(PG8_SB(0, 0), cB, voffB); PG8_STAGE(PG8_SB(0, 1), cB + hstepB, voffB); PG8_STAGE(PG8_SA(0, 0), cA, voffA); PG8_STAGE(PG8_SA(0, 1), cA + hstepA, voffA);
    if (wr == 1) PG8_BAR;
    PG8_WAIT_V(2); PG8_BAR;
    PG8_STAGE(PG8_SB(1, 0), cB + kstep, voffB); PG8_STAGE(PG8_SA(1, 0), cA + kstep, voffA); PG8_STAGE(PG8_SB(1, 1), cB + hstepB + kstep, voffB);
    PG8_WAIT_V(6); PG8_BAR;
    for (;;) {
        const bool has_next = S.next(ui + 1, nxt);
        const char* nA = has_next ? PG8_UA(nxt) : cA; const char* nB = has_next ? PG8_UB(nxt) : cB;
        for (int t = 0; t < nt; t += 2) {
            const bool last = (t == nt - 2);
            const char* a1 = cA + (size_t)(t + 1) * kstep;
            const char* a2 = last ? nA : cA + (size_t)(t + 2) * kstep; const char* b2 = last ? nB : cB + (size_t)(t + 2) * kstep;
            const char* a3 = a2 + kstep; const char* b3 = b2 + kstep;
            PG8_LDB(B0, 0, 0); PG8_LDB(B1, 0, 1); PG8_SCHED; PG8_LDA(At, 0, 0); PG8_STAGE(PG8_SA(1, 1), a1 + hstepA, voffA);
            PG8_WAIT_V(8); PG8_WAIT_L(0); PG8_BAR; PG8_MMA(0, 0, At, B0); PG8_MMA(0, 1, At, B1); PG8_BAR; PG8_SCHED;
            PG8_LDA(At, 0, 1); PG8_STAGE(PG8_SB(0, 0), b2, voffB); PG8_STAGE(PG8_SB(0, 1), b2 + hstepB, voffB); PG8_STAGE(PG8_SA(0, 0), a2, voffA);
            PG8_WAIT_V(8); PG8_WAIT_L(0); PG8_BAR; PG8_MMA(1, 0, At, B0); PG8_MMA(1, 1, At, B1); PG8_BAR; PG8_SCHED;
            PG8_LDB(B0, 1, 0); PG8_LDB(B1, 1, 1); PG8_SCHED; PG8_LDA(At, 1, 0); PG8_STAGE(PG8_SA(0, 1), a2 + hstepA, voffA);
            PG8_WAIT_V(8); PG8_WAIT_L(0); PG8_BAR; PG8_MMA(0, 0, At, B0); PG8_MMA(0, 1, At, B1); PG8_BAR; PG8_SCHED;
            PG8_LDA(At, 1, 1); PG8_STAGE(PG8_SB(1, 0), b3, voffB); PG8_STAGE(PG8_SB(1, 1), b3 + hstepB, voffB); PG8_STAGE(PG8_SA(1, 0), a3, voffA);
            PG8_WAIT_V(8); PG8_WAIT_L(0); PG8_BAR; PG8_MMA(1, 0, At, B0); PG8_MMA(1, 1, At, B1); PG8_BAR; PG8_SCHED;
        }
        if constexpr (ALIGN_EPI) { if (wr == 0) PG8_BAR; }
        { Unit eu = cur; asm volatile("" : "+s"(eu.pm), "+s"(eu.pn), "+s"(eu.aux)); E(acc, eu, wr, wc, fr, fq); }
        if (!has_next) break;
#pragma unroll
        for (int a = 0; a < 2; ++a)
#pragma unroll
            for (int b = 0; b < 2; ++b)
#pragma unroll
                for (int m = 0; m < 4; ++m)
#pragma unroll
                    for (int n = 0; n < 2; ++n) acc[a][b][m][n] = (f32x4){0.f, 0.f, 0.f, 0.f};
        cur = nxt; cA = nA; cB = nB; ++ui;
        if constexpr (ALIGN_EPI) { if (wr == 1) PG8_BAR; }
    }
    PG8_WAIT_V(0);
    if constexpr (!ALIGN_EPI) { if (wr == 0) PG8_BAR; }
    PG8_BAR;
#undef PG8_SA
#undef PG8_SB
#undef PG8_STAGE
#undef PG8_LDA
#undef PG8_LDB
#undef PG8_MMA
#undef PG8_WAIT_V
#undef PG8_WAIT_L
#undef PG8_BAR
#undef PG8_SCHED
#undef PG8_UA
#undef PG8_UB
}

__device__ __forceinline__ float row_rstd(const float* ssq, int row, int fq) {
    const f32x4 a = *(const f32x4*)(ssq + (size_t)row * 16 + 4 * fq);
    float s = (a[0] + a[1]) + (a[2] + a[3]);
    s = x16_sum(s); s = x32_sum(s);
    return __builtin_amdgcn_rsqf(s * (1.0f / DM) + RMS_EPS);
}
__device__ __forceinline__ int pos16(int o) { return 8 * ((o >> 2) & 1) + 4 * (o >> 3) + (o & 3); }

struct EpiProj {
    static constexpr bool PERM = true;
    const float* ssq; int row_base; bf16_t* QK; bf16_t* KF; bf16_t* VT; float* FL; bf16_t* GATE;
    __device__ __forceinline__ void operator()(const f32x4 (&acc)[2][2][4][2], const Unit& u, int wr, int wc, int fr, int fq) const {
        const int pn = u.pn;
        const int lrow0 = u.pm * BM + wr * 64 + fr;
        float rs[2][4];
#pragma unroll
        for (int ai = 0; ai < 2; ++ai)
#pragma unroll
            for (int m = 0; m < 4; ++m) rs[ai][m] = row_rstd(ssq, row_base + lrow0 + ai * HALF + m * 16, fq);
        const int cin = wc * 32 + 8 * fq;
        if (pn >= 19) {
#pragma unroll
            for (int ai = 0; ai < 2; ++ai)
#pragma unroll
                for (int m = 0; m < 4; ++m) { const int lrow = lrow0 + ai * HALF + m * 16; const float s = rs[ai][m];
#pragma unroll
                    for (int bj = 0; bj < 2; ++bj) { const f32x4 v0 = acc[ai][bj][m][0] * s, v1 = acc[ai][bj][m][1] * s;
                        u32x4 w; w.x = cvtpk(v0[0], v0[1]); w.y = cvtpk(v0[2], v0[3]); w.z = cvtpk(v1[0], v1[1]); w.w = cvtpk(v1[2], v1[3]);
                        *(u32x4*)(GATE + (size_t)lrow * 4096 + (pn - 19) * 256 + bj * HALF + cin) = w; } }
        } else if (pn == 18) {
            if (wc == 0 && fq == 0) {
#pragma unroll
                for (int ai = 0; ai < 2; ++ai)
#pragma unroll
                    for (int m = 0; m < 4; ++m) { const int lrow = lrow0 + ai * HALF + m * 16; *(f32x4*)(FL + (size_t)lrow * 4) = acc[ai][0][m][0] * rs[ai][m]; }
            }
        } else if (pn == 2 || (pn >= 9 && pn <= 11) || pn == 14 || pn == 17) {
            int vhb, rsh;
            if (pn == 2) { vhb = 0; rsh = 0; } else if (pn == 14) { vhb = 16; rsh = 0; } else if (pn == 17) { vhb = 20; rsh = 0; } else { const int gI = pn - 9; vhb = 4 + 4 * gI; rsh = 2 * gI; }
            const int slsh = 11 - rsh, rmask = (1 << rsh) - 1;
#pragma unroll
            for (int ai = 0; ai < 2; ++ai)
#pragma unroll
                for (int m = 0; m < 4; ++m) { const int lrow = lrow0 + ai * HALF + m * 16; const float s = rs[ai][m];
                    const int bl = lrow >> 11, t = lrow & (SEQ - 1); int p = ((t & rmask) << slsh) + (t >> rsh); p = (p & ~15) | pos16(p & 15);
                    const int kb = p >> 5, q = p & 31;
                    bf16_t* base = VT + (size_t)(bl * 24 + vhb) * HSEQ + (size_t)kb * 2048 + (q >> 4) * 512 + ((q >> 3) & 1) * 256 + (q & 7);
#pragma unroll
                    for (int bj = 0; bj < 2; ++bj) { const int c0 = bj * HALF + cin;
                        bf16_t* bp = base + (size_t)(c0 >> 6) * HSEQ + ((c0 >> 5) & 1) * 1024 + (c0 & 31) * 8;
                        const f32x4 v0 = acc[ai][bj][m][0] * s, v1 = acc[ai][bj][m][1] * s;
                        const unsigned w0 = cvtpk(v0[0], v0[1]), w1 = cvtpk(v0[2], v0[3]), w2 = cvtpk(v1[0], v1[1]), w3 = cvtpk(v1[2], v1[3]);
                        bp[0 * 8] = (bf16_t)(w0 & 0xffff); bp[1 * 8] = (bf16_t)(w0 >> 16); bp[2 * 8] = (bf16_t)(w1 & 0xffff); bp[3 * 8] = (bf16_t)(w1 >> 16);
                        bp[4 * 8] = (bf16_t)(w2 & 0xffff); bp[5 * 8] = (bf16_t)(w2 >> 16); bp[6 * 8] = (bf16_t)(w3 & 0xffff); bp[7 * 8] = (bf16_t)(w3 >> 16); } }
        } else {
            const bool isK = (pn == 1) || (pn >= 6 && pn <= 8) || pn == 13 || pn == 16;
            int slot = 0, khb = 0, rsh = 0;
            if (pn <= 1) { slot = 0; khb = 0; } else if (pn <= 8) { const int gI = (pn - 3) % 3; rsh = 2 * gI; slot = 1 + gI; khb = 4 + 4 * gI; } else if (pn <= 13) { slot = 4; khb = 16; } else { slot = 5; khb = 20; }
            const int slsh = 11 - rsh, rmask = (1 << rsh) - 1;
#pragma unroll
            for (int ai = 0; ai < 2; ++ai)
#pragma unroll
                for (int m = 0; m < 4; ++m) { const int lrow = lrow0 + ai * HALF + m * 16; const float s = rs[ai][m];
                    const int bl = lrow >> 11, t = lrow & (SEQ - 1); const int p = ((t & rmask) << slsh) + (t >> rsh);
#pragma unroll
                    for (int bj = 0; bj < 2; ++bj) { const f32x4 v0 = acc[ai][bj][m][0] * s, v1 = acc[ai][bj][m][1] * s;
                        u32x4 w; w.x = cvtpk(v0[0], v0[1]); w.y = cvtpk(v0[2], v0[3]); w.z = cvtpk(v1[0], v1[1]); w.w = cvtpk(v1[2], v1[3]);
                        const int c0 = bj * HALF + cin;
                        if (isK) { const int dcol = c0 & 63;
                            *(u32x4*)(KF + (size_t)(bl * 24 + khb + (c0 >> 6)) * HSEQ + (size_t)(p >> 5) * 2048 + (dcol >> 4) * 512 + (((dcol >> 3) & 1) * 32 + (p & 31)) * 8) = w; }
                        else *(u32x4*)(QK + (size_t)(bl * SEQ + p) * LDQK + slot * 256 + c0) = w; } }
        }
    }
};

struct EpiBranch {
    static constexpr bool PERM = true;
    const bf16_t* GATE; bf16_t* MERGED; int row_base;
    __device__ __forceinline__ static float sg(float g) { return __builtin_amdgcn_rcpf(1.0f + ex2(-g * LOG2E)); }
    __device__ __forceinline__ static u32x4 mix(const u32x4 ga, const u32x4 gb, const u32x4 ow, const f32x4 a0, const f32x4 a1, const f32x4 b0, const f32x4 b1) {
        const float o0 = sg(bflo(ga.x)) * a0[0] + sg(bflo(gb.x)) * b0[0] + bflo(ow.x), o1 = sg(bfhi(ga.x)) * a0[1] + sg(bfhi(gb.x)) * b0[1] + bfhi(ow.x);
        const float o2 = sg(bflo(ga.y)) * a0[2] + sg(bflo(gb.y)) * b0[2] + bflo(ow.y), o3 = sg(bfhi(ga.y)) * a0[3] + sg(bfhi(gb.y)) * b0[3] + bfhi(ow.y);
        const float o4 = sg(bflo(ga.z)) * a1[0] + sg(bflo(gb.z)) * b1[0] + bflo(ow.z), o5 = sg(bfhi(ga.z)) * a1[1] + sg(bfhi(gb.z)) * b1[1] + bfhi(ow.z);
        const float o6 = sg(bflo(ga.w)) * a1[2] + sg(bflo(gb.w)) * b1[2] + bflo(ow.w), o7 = sg(bfhi(ga.w)) * a1[3] + sg(bfhi(gb.w)) * b1[3] + bfhi(ow.w);
        u32x4 w; w.x = cvtpk(o0, o1); w.y = cvtpk(o2, o3); w.z = cvtpk(o4, o5); w.w = cvtpk(o6, o7); return w;
    }
    __device__ __forceinline__ void operator()(const f32x4 (&acc)[2][2][4][2], const Unit& u, int wr, int wc, int fr, int fq) const {
        const int p = u.aux; const int lrow0 = u.pm * BM + wr * 64 + fr; const int d0 = u.pn * 128 + wc * 32 + 8 * fq;
        const bf16_t* gbase = GATE + (size_t)lrow0 * 4096 + (2 * p) * 1024 + d0; bf16_t* mbase = MERGED + (size_t)(row_base + lrow0) * DM + d0;
        const u32x4 zero = {0u, 0u, 0u, 0u};
#pragma unroll
        for (int ai = 0; ai < 2; ++ai)
#pragma unroll
            for (int mp = 0; mp < 2; ++mp) {
                u32x4 ga[2], gb[2], ow[2];
#pragma unroll
                for (int mm = 0; mm < 2; ++mm) { const size_t ro = (size_t)(ai * HALF + (2 * mp + mm) * 16);
                    ga[mm] = *(const u32x4*)(gbase + ro * 4096); gb[mm] = *(const u32x4*)(gbase + ro * 4096 + 1024);
                    ow[mm] = zero; if (p > 0) ow[mm] = *(const u32x4*)(mbase + ro * DM); }
#pragma unroll
                for (int mm = 0; mm < 2; ++mm) { const int m = 2 * mp + mm; const size_t ro = (size_t)(ai * HALF + m * 16);
                    *(u32x4*)(mbase + ro * DM) = mix(ga[mm], gb[mm], ow[mm], acc[ai][0][m][0], acc[ai][0][m][1], acc[ai][1][m][0], acc[ai][1][m][1]); }
                asm volatile("" ::: "memory");
            }
    }
};

struct EpiResid {
    static constexpr bool PERM = true;
    const float* Xin; float* X; bf16_t* XB; float* ssq;
    __device__ __forceinline__ void operator()(const f32x4 (&acc)[2][2][4][2], const Unit& u, int wr, int wc, int fr, int fq) const {
        const int row0 = u.pm * BM + wr * 64 + fr; const int col0 = u.pn * BM + wc * 32 + 8 * fq;
#pragma unroll
        for (int ai = 0; ai < 2; ++ai)
#pragma unroll
            for (int m = 0; m < 4; ++m) { const int row = row0 + ai * HALF + m * 16; float sq = 0.f;
#pragma unroll
                for (int bj = 0; bj < 2; ++bj) { const int col = col0 + bj * HALF; f32x4* xp = (f32x4*)(X + (size_t)row * DM + col); const f32x4* xi = (const f32x4*)(Xin + (size_t)row * DM + col);
                    const f32x4 x0 = xi[0] + acc[ai][bj][m][0], x1 = xi[1] + acc[ai][bj][m][1];
                    xp[0] = x0; xp[1] = x1;
                    u32x4 w; w.x = cvtpk(x0[0], x0[1]); w.y = cvtpk(x0[2], x0[3]); w.z = cvtpk(x1[0], x1[1]); w.w = cvtpk(x1[2], x1[3]);
                    *(u32x4*)(XB + (size_t)row * DM + col) = w;
                    sq += (x0[0] * x0[0] + x0[1] * x0[1]) + (x0[2] * x0[2] + x0[3] * x0[3]) + (x1[0] * x1[0] + x1[1] * x1[1]) + (x1[2] * x1[2] + x1[3] * x1[3]); }
                sq = x16_sum(sq); sq = x32_sum(sq);
                if (fq == 0) ssq[(size_t)row * 16 + u.pn * 4 + wc] = sq; if (m & 1) asm volatile("" ::: "memory"); }
    }
};

struct EpiFinal {
    static constexpr bool PERM = true;
    const float* X; float* out; float* ssq; const float* gfin; unsigned* cnt;
    __device__ __forceinline__ void operator()(f32x4 (&acc)[2][2][4][2], const Unit& u, int wr, int wc, int fr, int fq) const {
        const int row0 = u.pm * BM + wr * 64 + fr; const int col0 = u.pn * BM + wc * 32 + 8 * fq;
#pragma unroll
        for (int ai = 0; ai < 2; ++ai)
#pragma unroll
            for (int m = 0; m < 4; ++m) { const int row = row0 + ai * HALF + m * 16; float sq = 0.f;
#pragma unroll
                for (int bj = 0; bj < 2; ++bj) { const f32x4* xi = (const f32x4*)(X + (size_t)row * DM + col0 + bj * HALF);
                    const f32x4 x0 = xi[0] + acc[ai][bj][m][0], x1 = xi[1] + acc[ai][bj][m][1];
                    acc[ai][bj][m][0] = x0; acc[ai][bj][m][1] = x1;
                    sq += (x0[0] * x0[0] + x0[1] * x0[1]) + (x0[2] * x0[2] + x0[3] * x0[3]) + (x1[0] * x1[0] + x1[1] * x1[1]) + (x1[2] * x1[2] + x1[3] * x1[3]); }
                sq = x16_sum(sq); sq = x32_sum(sq);
                if (fq == 0) __hip_atomic_store(ssq + (size_t)row * 16 + u.pn * 4 + wc, sq, __ATOMIC_RELAXED, __HIP_MEMORY_SCOPE_AGENT);
                if (m & 1) asm volatile("" ::: "memory"); }
        asm volatile("s_waitcnt vmcnt(0)" ::: "memory");
        unsigned* c = cnt + 64 * u.pm;
        if ((fr | fq) == 0) {
            __hip_atomic_fetch_add(c, 1u, __ATOMIC_RELAXED, __HIP_MEMORY_SCOPE_AGENT);
            unsigned sp = 0;
            while (__hip_atomic_load(c, __ATOMIC_RELAXED, __HIP_MEMORY_SCOPE_AGENT) < 32u) { __builtin_amdgcn_s_sleep(2); if (++sp > (1u << 22)) break; }
        }
        __builtin_amdgcn_fence(__ATOMIC_ACQUIRE, "agent");
        asm volatile("s_waitcnt vmcnt(0)" ::: "memory");
        float rs[2][4];
#pragma unroll
        for (int ai = 0; ai < 2; ++ai)
#pragma unroll
            for (int m = 0; m < 4; ++m) rs[ai][m] = row_rstd(ssq, row0 + ai * HALF + m * 16, fq);
#pragma unroll
        for (int bj = 0; bj < 2; ++bj) { const f32x4 g0 = *(const f32x4*)(gfin + col0 + bj * HALF), g1 = *(const f32x4*)(gfin + col0 + bj * HALF + 4);
#pragma unroll
            for (int ai = 0; ai < 2; ++ai)
#pragma unroll
                for (int m = 0; m < 4; ++m) { const int row = row0 + ai * HALF + m * 16; f32x4* op = (f32x4*)(out + (size_t)row * DM + col0 + bj * HALF);
                    op[0] = acc[ai][bj][m][0] * rs[ai][m] * g0; op[1] = acc[ai][bj][m][1] * rs[ai][m] * g1; } }
    }
};

struct EpiUp {
    static constexpr bool PERM = true;
    const float* ssq; bf16_t* H;
    __device__ __forceinline__ void operator()(const f32x4 (&acc)[2][2][4][2], const Unit& u, int wr, int wc, int fr, int fq) const {
        const int row0 = u.pm * BM + wr * 64 + fr; const int col0 = u.pn * BM + wc * 32 + 8 * fq;
        float rs[2][4];
#pragma unroll
        for (int ai = 0; ai < 2; ++ai)
#pragma unroll
            for (int m = 0; m < 4; ++m) rs[ai][m] = row_rstd(ssq, row0 + ai * HALF + m * 16, fq);
#pragma unroll
        for (int ai = 0; ai < 2; ++ai)
#pragma unroll
            for (int m = 0; m < 4; ++m) { const int row = row0 + ai * HALF + m * 16; const float s = rs[ai][m];
#pragma unroll
                for (int bj = 0; bj < 2; ++bj) { f32x4 v0 = acc[ai][bj][m][0] * s, v1 = acc[ai][bj][m][1] * s;
#pragma unroll
                    for (int i = 0; i < 4; ++i) { const float a = fmaxf(v0[i], 0.f), b = fmaxf(v1[i], 0.f); v0[i] = a * a; v1[i] = b * b; }
                    u32x4 w; w.x = cvtpk(v0[0], v0[1]); w.y = cvtpk(v0[2], v0[3]); w.z = cvtpk(v1[0], v1[1]); w.w = cvtpk(v1[2], v1[3]);
                    *(u32x4*)(H + (size_t)row * DFF + col0 + bj * HALF) = w; } }
    }
};
}

__device__ __forceinline__ int win_src(int n) {
    if (n < 3840) return n;
    if (n < 4608) return n + 4;
    if (n < 4864) return (n - 4608 < 4) ? 3840 + (n - 4608) : -1;
    return n - 4864 + 4612;
}
template <int CMAP>
__device__ __forceinline__ void transpose_item(const float* W, int K, int N, int Nsrc, const float* gain, bf16_t* WT, LAS float* scr, int item, int lane) {
    const int nblk = N / 32, kb = item / nblk, nb = item % nblk, k0 = 64 * kb, n0 = 32 * nb;
    const int n = n0 + (lane & 31); const int src = CMAP ? win_src(n) : n;
    const bool live = (src >= 0); const float* wp = W + (size_t)(k0 + (lane >> 5)) * Nsrc + (live ? src : 0); const float* gp = gain ? gain + k0 + (lane >> 5) : nullptr;
    float wv[32];
#pragma unroll
    for (int i = 0; i < 32; ++i) wv[i] = wp[(size_t)(2 * i) * Nsrc];
#pragma unroll
    for (int i = 0; i < 32; ++i) { float v = live ? wv[i] : 0.f; if (gp) v *= gp[2 * i]; scr[(2 * i + (lane >> 5)) * 33 + (lane & 31)] = v; }
    asm volatile("s_waitcnt lgkmcnt(0)" ::: "memory");
    const int c = lane & 7;
#pragma unroll
    for (int j = 0; j < 4; ++j) { const int nn = (lane >> 3) + 8 * j; const LAS float* s = scr + (8 * c) * 33 + nn;
        u32x4 o; o.x = cvtpk(s[0 * 33], s[1 * 33]); o.y = cvtpk(s[2 * 33], s[3 * 33]); o.z = cvtpk(s[4 * 33], s[5 * 33]); o.w = cvtpk(s[6 * 33], s[7 * 33]);
        *(u32x4*)(WT + (size_t)(n0 + nn) * K + k0 + 8 * c) = o; }
    asm volatile("s_waitcnt lgkmcnt(0)" ::: "memory");
}

__device__ __forceinline__ void branch_item(const float* Wn, int n, bf16_t* WBP, LAS float* scr, int item, int lane) {
    const int kb = item >> 5, nb = item & 31, k0 = 64 * kb, n0 = 32 * nb;
    const float* wp = Wn + (size_t)(k0 + (lane >> 5)) * DM + n0 + (lane & 31);
    float wv[32];
#pragma unroll
    for (int i = 0; i < 32; ++i) wv[i] = wp[(size_t)(2 * i) * DM];
#pragma unroll
    for (int i = 0; i < 32; ++i) scr[(2 * i + (lane >> 5)) * 33 + (lane & 31)] = wv[i];
    asm volatile("s_waitcnt lgkmcnt(0)" ::: "memory");
    const int c = lane & 7, bj = n & 1, pair = n >> 1;
    const u32x4 zero = {0u, 0u, 0u, 0u};
#pragma unroll
    for (int j = 0; j < 4; ++j) { const int nn = (lane >> 3) + 8 * j; const LAS float* sp = scr + (8 * c) * 33 + nn; const int d = n0 + nn;
        u32x4 o; o.x = cvtpk(sp[0 * 33], sp[1 * 33]); o.y = cvtpk(sp[2 * 33], sp[3 * 33]); o.z = cvtpk(sp[4 * 33], sp[5 * 33]); o.w = cvtpk(sp[6 * 33], sp[7 * 33]);
        bf16_t* row = WBP + ((size_t)((pair * 8 + (d >> 7)) * 256 + bj * 128 + (d & 127))) * 512 + k0 + 8 * c;
        *(u32x4*)(row + 256 * bj) = o; *(u32x4*)(row + 256 * (1 - bj)) = zero; }
    asm volatile("s_waitcnt lgkmcnt(0)" ::: "memory");
}

#define MFMA32(a, b, c) __builtin_amdgcn_mfma_f32_32x32x16_bf16((a), (b), (c), 0, 0, 0)
__device__ __forceinline__ bf16x8 ld16(const bf16_t* p) { return *(const bf16x8*)p; }
__device__ __forceinline__ bf16x8 pack8(const f32x16& s, int b) { u32x4 w; w.x = cvtpk(s[b], s[b + 1]); w.y = cvtpk(s[b + 2], s[b + 3]); w.z = cvtpk(s[b + 4], s[b + 5]); w.w = cvtpk(s[b + 6], s[b + 7]); return __builtin_bit_cast(bf16x8, w); }
__device__ __forceinline__ int crow(int r, int hi) { return (r & 3) + 8 * (r >> 2) + 4 * hi; }
__device__ __forceinline__ void store_o(bf16_t* orow, const f32x16& o0, const f32x16& o1, int hi) {
#pragma unroll
    for (int g = 0; g < 4; ++g) {
        u32x2 a; a.x = cvtpk(o0[4 * g], o0[4 * g + 1]); a.y = cvtpk(o0[4 * g + 2], o0[4 * g + 3]); *(u32x2*)(orow + 8 * g + 4 * hi) = a;
        u32x2 b; b.x = cvtpk(o1[4 * g], o1[4 * g + 1]); b.y = cvtpk(o1[4 * g + 2], o1[4 * g + 3]); *(u32x2*)(orow + 32 + 8 * g + 4 * hi) = b; }
}

struct KFrag { bf16x8 k[4]; };
struct VFrag { bf16x8 v[4]; };
__device__ __forceinline__ void k_load(KFrag& f, const bf16_t* Kh, int kb, int lane) {
    const bf16_t* kp = Kh + (size_t)kb * 2048 + lane * 8;
#pragma unroll
    for (int ds = 0; ds < 4; ++ds) f.k[ds] = ld16(kp + ds * 512);
}
__device__ __forceinline__ void v_load(VFrag& f, const bf16_t* Vh, int kb, int lane) {
    const bf16_t* vp = Vh + (size_t)kb * 2048 + lane * 8;
    f.v[0] = ld16(vp); f.v[1] = ld16(vp + 512); f.v[2] = ld16(vp + 1024); f.v[3] = ld16(vp + 1536);
}
__device__ __forceinline__ void q_load(bf16x8 (&qf)[4], const bf16_t* Qs, int qb, int r32, int hi) {
    const bf16_t* qp = Qs + (size_t)(qb * 32 + r32) * LDQK + hi * 8;
#pragma unroll
    for (int ds = 0; ds < 4; ++ds) qf[ds] = ld16(qp + ds * 16);
}

template <int MODE, bool MASK, int NDS>
__device__ __forceinline__ void sm_step(const bf16x8 (&ck)[NDS], const bf16x8 (&qf)[NDS], const VFrag& cv, float slope2, const LAS float* cl, int kb, int d0,
                                        float& m, float& l, f32x16& o0, f32x16& o1, int hi) {
    constexpr float SC2 = ((MODE == 2) ? 0.17677669529663687f : 0.125f) * LOG2E;
    f32x16 s;
#pragma unroll
    for (int i = 0; i < 16; ++i) s[i] = 0.f;
#pragma unroll
    for (int ds = 0; ds < NDS; ++ds) s = MFMA32(ck[ds], qf[ds], s);
#define KC(r) (((r) & 3) + 8 * ((r) >> 2))
    int dh = d0 - 4 * hi; asm volatile("" : "+v"(dh));
    float sl = slope2; asm volatile("" : "+v"(sl));
    const LAS float* clk = cl + 33 * kb + 4 * hi; if (MODE == 0) asm volatile("" : "+v"(clk));
    const float base = (MODE == 0) ? 0.f : -sl * (float)dh;
#pragma unroll
    for (int r = 0; r < 16; ++r) {
        float v = (MODE == 0) ? fmaf(s[r], SC2, clk[KC(r)]) : fmaf(s[r], SC2, sl * (float)KC(r));
        if (MASK) { const int dist = dh - KC(r); const bool valid = (MODE == 1) ? ((unsigned)dist <= 128u) : (dist >= 0); v = valid ? v : -INFINITY; }
        s[r] = v;
    }
#undef KC
    float mt = fmaxf(fmaxf(s[0], s[1]), fmaxf(s[2], s[3]));
#pragma unroll
    for (int r = 4; r < 16; r += 4) mt = fmaxf(mt, fmaxf(fmaxf(s[r], s[r + 1]), fmaxf(s[r + 2], s[r + 3])));
    mt = x32_max(mt + base);
    const float mn = fmaxf(m, mt), alpha = ex2(m - mn), c = mn - base;
    float ps = 0.f;
#pragma unroll
    for (int r = 0; r < 16; ++r) { const float p = ex2(s[r] - c); s[r] = p; ps += p; }
    l = l * alpha + ps; m = mn;
#pragma unroll
    for (int i = 0; i < 16; ++i) { o0[i] *= alpha; o1[i] *= alpha; }
    const bf16x8 pf0 = pack8(s, 0), pf1 = pack8(s, 8);
    o0 = MFMA32(cv.v[0], pf0, o0); o0 = MFMA32(cv.v[1], pf1, o0); o1 = MFMA32(cv.v[2], pf0, o1); o1 = MFMA32(cv.v[3], pf1, o1);
}
template <int MODE>
__device__ __forceinline__ void sm_unit(const bf16_t* Qs, const bf16_t* Ks, const bf16_t* VTs, int qb, int kb_hi, int kb_lo, float slope2, const LAS float* cl,
                                        f32x16& o0, f32x16& o1, float& m_out, float& l_out, int lane) {
    const int r32 = lane & 31, hi = lane >> 5;
    constexpr int NDS = (MODE == 2) ? 2 : 4;
    bf16x8 qf[NDS];
    { const bf16_t* qp = Qs + (size_t)(qb * 32 + r32) * LDQK + hi * 8;
#pragma unroll
      for (int ds = 0; ds < NDS; ++ds) qf[ds] = ld16(qp + ds * 16); }
    bf16x8 nk[NDS];
    { const bf16_t* kp = Ks + (size_t)kb_hi * 2048 + lane * 8;
#pragma unroll
      for (int ds = 0; ds < NDS; ++ds) nk[ds] = ld16(kp + ds * 512); }
    float m = -INFINITY, l = 0.f;
#pragma unroll
    for (int i = 0; i < 16; ++i) { o0[i] = 0.f; o1[i] = 0.f; }
    for (int kb = kb_hi; kb >= kb_lo; --kb) {
        bf16x8 ck[NDS];
#pragma unroll
        for (int ds = 0; ds < NDS; ++ds) ck[ds] = nk[ds];
        VFrag cv; v_load(cv, VTs, kb, lane);
        if (kb > kb_lo) { const bf16_t* kp = Ks + (size_t)(kb - 1) * 2048 + lane * 8;
#pragma unroll
            for (int ds = 0; ds < NDS; ++ds) nk[ds] = ld16(kp + ds * 512); }
        const int d0 = (qb - kb) * 32 + r32;
        const bool edge = (MODE == 1) ? (kb == qb || kb + 4 <= qb) : (kb == qb);
        if (edge) sm_step<MODE, true, NDS>(ck, qf, cv, slope2, cl, kb, d0, m, l, o0, o1, hi);
        else      sm_step<MODE, false, NDS>(ck, qf, cv, slope2, cl, kb, d0, m, l, o0, o1, hi);
    }
    l = x32_sum(l);
    m_out = m; l_out = l;
}

template <int MODE>
__device__ __forceinline__ void sm_unit64(const bf16_t* Qs, const bf16_t* Ks, const bf16_t* VTs, int Q, int kb_hi, int kb_lo, float slope2, const LAS float* cl,
                                          f32x16 (&o)[2][2], float (&m)[2], float (&l)[2], int lane) {
    const int r32 = lane & 31, hi = lane >> 5;
    constexpr int NDS = (MODE == 2) ? 2 : 4;
    bf16x8 qf[2][NDS];
#pragma unroll
    for (int i = 0; i < 2; ++i) { const bf16_t* qp = Qs + (size_t)((2 * Q + i) * 32 + r32) * LDQK + hi * 8;
#pragma unroll
        for (int ds = 0; ds < NDS; ++ds) qf[i][ds] = ld16(qp + ds * 16); }
    bf16x8 nk[NDS];
    { const bf16_t* kp = Ks + (size_t)kb_hi * 2048 + lane * 8;
#pragma unroll
      for (int ds = 0; ds < NDS; ++ds) nk[ds] = ld16(kp + ds * 512); }
#pragma unroll
    for (int i = 0; i < 2; ++i) { m[i] = -INFINITY; l[i] = 0.f;
#pragma unroll
        for (int k = 0; k < 16; ++k) { o[i][0][k] = 0.f; o[i][1][k] = 0.f; } }
    for (int kb = kb_hi; kb >= kb_lo; --kb) {
        bf16x8 ck[NDS];
#pragma unroll
        for (int ds = 0; ds < NDS; ++ds) ck[ds] = nk[ds];
        VFrag cv; v_load(cv, VTs, kb, lane);
        if (kb > kb_lo) { const bf16_t* kp = Ks + (size_t)(kb - 1) * 2048 + lane * 8;
#pragma unroll
            for (int ds = 0; ds < NDS; ++ds) nk[ds] = ld16(kp + ds * 512); }
        if (kb < 2 * Q) {
            const int d00 = (2 * Q - kb) * 32 + r32;
            sm_step<MODE, false, NDS>(ck, qf[0], cv, slope2, cl, kb, d00, m[0], l[0], o[0][0], o[0][1], hi);
            sm_step<MODE, false, NDS>(ck, qf[1], cv, slope2, cl, kb, d00 + 32, m[1], l[1], o[1][0], o[1][1], hi);
        } else {
#pragma unroll
            for (int i = 0; i < 2; ++i) {
                const int qbi = 2 * Q + i;
                if (kb <= qbi) {
                    const int d0 = (qbi - kb) * 32 + r32;
                    if (kb == qbi) sm_step<MODE, true, NDS>(ck, qf[i], cv, slope2, cl, kb, d0, m[i], l[i], o[i][0], o[i][1], hi);
                    else           sm_step<MODE, false, NDS>(ck, qf[i], cv, slope2, cl, kb, d0, m[i], l[i], o[i][0], o[i][1], hi);
                }
            }
        }
    }
    l[0] = x32_sum(l[0]); l[1] = x32_sum(l[1]);
}

__device__ __forceinline__ void sb_unit(const bf16_t* Qs, const bf16_t* Ks, const bf16_t* VTs, int qb, f32x16& o0, f32x16& o1, int lane) {
    const int r32 = lane & 31, hi = lane >> 5;
    constexpr float SC2 = 0.125f * LOG2E;
    bf16x8 qf[4]; q_load(qf, Qs, qb, r32, hi);
    KFrag nx; k_load(nx, Ks, qb, lane);
    float R = 0.f;
#pragma unroll
    for (int i = 0; i < 16; ++i) { o0[i] = 0.f; o1[i] = 0.f; }
    for (int kb = qb; kb >= 0; --kb) {
        const KFrag cu = nx; VFrag cv; v_load(cv, VTs, kb, lane);
        if (kb > 0) k_load(nx, Ks, kb - 1, lane);
        f32x16 s;
#pragma unroll
        for (int i = 0; i < 16; ++i) s[i] = 0.f;
#pragma unroll
        for (int ds = 0; ds < 4; ++ds) s = MFMA32(cu.k[ds], qf[ds], s);
        float lk[16], ls[16];
        const int d0 = (qb - kb) * 32 + r32;
#pragma unroll
        for (int r = 0; r < 16; ++r) { const float z2 = s[r] * SC2; const float sp = fmaxf(z2, 0.f) + lg2(1.0f + ex2(-fabsf(z2))); const bool valid = crow(r, hi) < d0; lk[r] = valid ? -sp : 0.f; ls[r] = valid ? (z2 - sp) : -INFINITY; }
        float e[16], tq[4], pq[4];
#pragma unroll
        for (int g = 0; g < 4; ++g) { e[4 * g + 3] = 0.f; e[4 * g + 2] = lk[4 * g + 3]; e[4 * g + 1] = e[4 * g + 2] + lk[4 * g + 2]; e[4 * g] = e[4 * g + 1] + lk[4 * g + 1]; tq[g] = e[4 * g] + lk[4 * g]; }
#pragma unroll
        for (int g = 0; g < 4; ++g) pq[g] = x32_partner(tq[g], hi);
        float cs[4]; cs[3] = 0.f; cs[2] = tq[3] + pq[3]; cs[1] = cs[2] + (tq[2] + pq[2]); cs[0] = cs[1] + (tq[1] + pq[1]);
        const float total = cs[0] + (tq[0] + pq[0]);
#pragma unroll
        for (int g = 0; g < 4; ++g) { const float later = R + cs[g] + (hi == 0 ? pq[g] : 0.f);
#pragma unroll
            for (int i = 0; i < 4; ++i) s[4 * g + i] = ex2(ls[4 * g + i] + e[4 * g + i] + later); }
        R += total;
        const bf16x8 pf0 = pack8(s, 0), pf1 = pack8(s, 8);
        o0 = MFMA32(cv.v[0], pf0, o0); o0 = MFMA32(cv.v[1], pf1, o0); o1 = MFMA32(cv.v[2], pf0, o1); o1 = MFMA32(cv.v[3], pf1, o1);
        if (__all(R < -150.0f)) break;
    }
}

#define XB_TMO      128
#define XB_XCNT(j)  (256  + 64 * (j))
#define XB_XSUB(j)  (1280 + 64 * (j))
#define XB_XGEN(j)  (2304 + 64 * (j))
#define XB_TOP      3328
#define XB_TOPGEN   3392
#define XCD_BAR_WORDS 3456
#define XB_SPIN_CAP (1u << 18)
__device__ __forceinline__ unsigned xb_ld(unsigned* p)              { return __hip_atomic_load(p, __ATOMIC_RELAXED, __HIP_MEMORY_SCOPE_AGENT); }
__device__ __forceinline__ unsigned xb_add(unsigned* p, unsigned v) { return __hip_atomic_fetch_add(p, v, __ATOMIC_RELAXED, __HIP_MEMORY_SCOPE_AGENT); }
__device__ __forceinline__ unsigned xb_xcc_id() { return (unsigned)__builtin_amdgcn_s_getreg((3 << 11) | 20) & 0xFu; }
#define XB_SPIN(cond, bar) do { unsigned _sp = 0; while (cond) { __builtin_amdgcn_s_sleep(1); \
    if ((++_sp & 255u) == 0u) { if (xb_ld(&(bar)[XB_TMO])) break; if (_sp > XB_SPIN_CAP) { atomicAdd(&(bar)[XB_TMO], 1u); break; } } } } while (0)
__device__ __forceinline__ void xcd_barrier_complete(unsigned* bar, unsigned x, unsigned& nloc, unsigned& nx) {
    const unsigned G = gridDim.x * gridDim.y * gridDim.z;
    unsigned sum, cnt, mine, sp = 0u;
    for (;;) {
        sum = 0u; cnt = 0u; mine = 0u;
#pragma unroll
        for (unsigned j = 0; j < 16; ++j) { const unsigned c = xb_ld(&bar[XB_XCNT(j)]); sum += c; cnt += (c > 0u) ? 1u : 0u; mine = (j == x) ? c : mine; }
        if (sum == G) break;
        __builtin_amdgcn_s_sleep(1);
        if ((++sp & 255u) == 0u) { if (xb_ld(&bar[XB_TMO])) break; if (sp > XB_SPIN_CAP) { atomicAdd(&bar[XB_TMO], 1u); break; } }
    }
    nloc = mine > 0u ? mine : 1u; nx = cnt > 0u ? cnt : 1u;
}
__device__ __forceinline__ void xcd_barrier(unsigned* bar, volatile LAS unsigned* st) {
    asm volatile("s_waitcnt vmcnt(0)" ::: "memory");
    __syncthreads();
    if (threadIdx.x == 0) {
        const unsigned x = xb_xcc_id();
        __builtin_amdgcn_s_waitcnt(0);
        unsigned nloc = st[0], nx = st[1];
        if (nloc == 0u) { xcd_barrier_complete(bar, x, nloc, nx); st[0] = nloc; st[1] = nx; }
        const unsigned old = xb_add(&bar[XB_XSUB(x)], 1u);
        const unsigned gen = old / nloc;
        if (old + 1u == (gen + 1u) * nloc) {
            __builtin_amdgcn_fence(__ATOMIC_RELEASE, "agent");
            asm volatile("s_waitcnt vmcnt(0)" ::: "memory");
            const unsigned og = xb_add(&bar[XB_TOP], 1u);
            const unsigned tg = og / nx;
            if (og + 1u == (tg + 1u) * nx) xb_add(&bar[XB_TOPGEN], 1u);
            else XB_SPIN(xb_ld(&bar[XB_TOPGEN]) == tg, bar);
            __builtin_amdgcn_fence(__ATOMIC_ACQUIRE, "agent");
            xb_add(&bar[XB_XGEN(x)], 1u);
            asm volatile("s_waitcnt vmcnt(0)" ::: "memory");
        } else {
            XB_SPIN(xb_ld(&bar[XB_XGEN(x)]) == gen, bar);
            __builtin_amdgcn_fence(__ATOMIC_ACQUIRE, "agent");
            asm volatile("s_waitcnt vmcnt(0)" ::: "memory");
        }
    }
    __syncthreads();
}
constexpr int MISC_OFF = 131072 + 320;

struct Params {
    const float* x; const float* mix_g; const float* w_in; const float* b_forget; const float* lq1; const float* lk1; const float* lq2; const float* lk2;
    const float* diff_g; const float* w_branch; const float* w_out; const float* mlp_g; const float* w_up; const float* w_down; const float* final_g;
    float* out; unsigned char* ws;
};

#ifndef REP_P1
#define REP_P1 1
#endif
#ifndef REP_P2
#define REP_P2 1
#endif
#ifndef REP_P3
#define REP_P3 1
#endif
#ifndef REP_P5
#define REP_P5 1
#endif
#ifndef REP_SYNC
#define REP_SYNC 1
#endif
#ifndef REP_CONV
#define REP_CONV 1
#endif
#define GSYNC() do { for (int rs_ = 0; rs_ < REP_SYNC; ++rs_) { KParamsPtr pb_ = OPQ_PP(); xcd_barrier((unsigned*)(pb_->ws + WS_CTL) + CW_BAR, (volatile LAS unsigned*)(lds + MISC_OFF)); } } while (0)
#define OPQ_TID() ({ int t_ = threadIdx.x; asm volatile("" : "+v"(t_)); t_; })
typedef const __attribute__((address_space(4))) Params* KParamsPtr;
#define OPQ_PP() ({ KParamsPtr p_ = (KParamsPtr)__builtin_amdgcn_kernarg_segment_ptr(); asm volatile("" : "+s"(p_)); p_; })
#define PHASE_VARS() const int tid = OPQ_TID(); const int lane = tid & 63, wave = __builtin_amdgcn_readfirstlane(tid >> 6); const int G = gridDim.x, bx = blockIdx.x; \
    const int gw = bx * NWAVES + wave, NGW = G * NWAVES; KParamsPtr PP = OPQ_PP(); unsigned char* ws = PP->ws; LAS float* scr = (LAS float*)(lds + wave * 16384); (void)lane; (void)gw; (void)NGW; (void)ws; (void)scr; (void)G; (void)bx; (void)PP

__global__ void __launch_bounds__(NWAVES * 64, 2) fwd_mega(Params P) {
    extern __shared__ __attribute__((aligned(16))) unsigned char lds_raw[];
    LAS unsigned char* lds = (LAS unsigned char*)lds_raw;
    cg::grid_group grid = cg::this_grid();
    { KParamsPtr pz = OPQ_PP(); if (pz->ws == nullptr) grid.sync(); }
    { const int t0 = OPQ_TID(); if (t0 < 64) ((LAS unsigned*)(lds + 131072))[t0 + 64] = 0u; __syncthreads();
      if (t0 == 0) { KParamsPtr p0 = OPQ_PP(); (void)xb_add((unsigned*)(p0->ws + WS_CTL) + CW_BAR + XB_XCNT(xb_xcc_id()), 1u); } }

    {
        PHASE_VARS();
        bf16_t* XB = (bf16_t*)(ws + WS_XB); float* SSQ = (float*)(ws + WS_SSQ);
        for (int row = gw; row < TOK; row += NGW) {
            const f32x4* xr = (const f32x4*)(PP->x + (size_t)row * DM) + lane;
            unsigned long long* o8 = (unsigned long long*)(XB + (size_t)row * DM) + lane;
            float s = 0.f;
#pragma unroll
            for (int j = 0; j < 4; ++j) { const f32x4 v = xr[64 * j]; s += (v[0] * v[0] + v[1] * v[1]) + (v[2] * v[2] + v[3] * v[3]);
                o8[64 * j] = (unsigned long long)cvtpk(v[0], v[1]) | ((unsigned long long)cvtpk(v[2], v[3]) << 32); }
            s = wave_sum(s);
            if (lane < 16) SSQ[(size_t)row * 16 + lane] = (lane == 0) ? s : 0.f;
        }
    }

    for (int layer = 0; layer < DEPTH; ++layer) {
        for (int rep = 0; rep < REP_CONV; ++rep) {
            PHASE_VARS();
            bf16_t* WIN = (bf16_t*)(ws + WS_WIN); bf16_t* WB = (bf16_t*)(ws + WS_WB); bf16_t* WOUT = (bf16_t*)(ws + WS_WOUT);
            const float* w_in = PP->w_in + (size_t)layer * DM * DIN; const float* mg = PP->mix_g + (size_t)layer * DM;
            const float* wb = PP->w_branch + (size_t)layer * 4 * 256 * DM; const float* wo = PP->w_out + (size_t)layer * DM * DM;
            constexpr int I_IN = (DM / 64) * (NPROJ / 32), I_B = (256 / 64) * (DM / 32), I_O = (DM / 64) * (DM / 32);
            for (int it = gw; it < I_IN + 4 * I_B + I_O; it += NGW) {
                int r = it;
                if (r < I_IN) { transpose_item<1>(w_in, DM, NPROJ, DIN, mg, WIN, scr, r, lane); continue; } r -= I_IN;
                if (r < 4 * I_B) { const int n = r / I_B; branch_item(wb + (size_t)n * 256 * DM, n, WB, scr, r % I_B, lane); continue; } r -= 4 * I_B;
                transpose_item<0>(wo, DM, DM, DM, nullptr, WOUT, scr, r, lane);
            }
        }
        GSYNC();

        for (int half = 0; half < 2; ++half) {
#ifndef NO_P1
            for (int rep = 0; rep < REP_P1; ++rep) {
                PHASE_VARS();
                const int rb = half * HT;
                pg8::Gemm g{(const bf16_t*)(ws + WS_XB) + (size_t)rb * DM, (const bf16_t*)(ws + WS_WIN), DM, DM, DM, 0, 0};
                pg8::StaticOrder S; S.init(HT, NPROJ, G, bx, WGM_P1);
                pg8::EpiProj E{(const float*)(ws + WS_SSQ), rb, (bf16_t*)(ws + WS_QK), (bf16_t*)(ws + WS_KF), (bf16_t*)(ws + WS_VT), (float*)(ws + WS_FL), (bf16_t*)(ws + WS_GATE)};
                pg8::gemm_phase<pg8::EpiProj, pg8::StaticOrder, true>(lds, g, S, E);
            }
#endif
            GSYNC();
#ifndef NO_P2
            for (int rep = 0; rep < REP_P2; ++rep) {
                PHASE_VARS();
                unsigned* ctr = (unsigned*)(ws + WS_CTL) + 64 + 512 * (layer * 2 + half + 4 * rep);
                const int xq = bx & 7;
                ctr += 64 * xq;
                for (;;) {
                    int li = 0; if (lane == 0) li = (int)atomicAdd(ctr, 1u); li = __builtin_amdgcn_readfirstlane(li);
                    if (li >= 800) break;
                    int idx;
                    if (li < 288) { const int row = li / 6, hl = li - row * 6; idx = row * 48 + (xq + 8 * hl); }
                    else if (li < 416) { const int i = li - 288; idx = 2304 + ((63 - (i & 63)) << 4) + (xq + 8 * (i >> 6)); }
                    else { const int i = li - 416; idx = 3328 + (xq + 8 * (i >> 6)) * 64 + (i & 63); }
                    int lane_u = lane; asm volatile("" : "+v"(lane_u));
                    const int lane = lane_u, r32 = lane & 31, hi = lane >> 5;
                    KParamsPtr PU = OPQ_PP(); unsigned char* wsu = PU->ws;
                    bf16_t* YS = (bf16_t*)(wsu + WS_YS); bf16_t* DILO = (bf16_t*)(wsu + WS_DILO); float* LSE = (float*)(wsu + WS_LSE); const float* FL = (const float*)(wsu + WS_FL);
                    const bf16_t* QK = (const bf16_t*)(wsu + WS_QK); const bf16_t* KF = (const bf16_t*)(wsu + WS_KF); const bf16_t* VT = (const bf16_t*)(wsu + WS_VT);
                    if (idx < 2304) {
                        const int j = idx / 48, e = idx - j * 48, type3 = e >> 4, bh = e & 15, b = bh >> 2, h = bh & 3;
                        int Q, chunk; if (j < 32) { Q = 31 - (j >> 1); chunk = j & 1; } else { Q = 47 - j; chunk = 0; }
                        int kb_lo = 0, kb_hi = 2 * Q + 1;
                        if (Q >= 16) { if (chunk == 0) kb_hi = Q; else kb_lo = Q + 1; }
                        const size_t rowb = (size_t)b * SEQ;
                        bf16_t* SCRB = (bf16_t*)(wsu + WS_MERGED) + (size_t)(half * HT) * DM;
                        float* LSE2 = (float*)(wsu + WS_LSE2);
                        f32x16 o[2][2]; float m[2], l[2]; int slot;
                        if (type3 == 2) {
                            LAS float* cl = scr;
                            const float bf = PP->b_forget[layer * 4 + h];
                            float run = 0.f;
                            if (lane <= kb_hi) {
                                const float* fp = FL + (rowb + 32 * lane) * 4 + h;
#pragma unroll 8
                                for (int i = 0; i < 32; ++i) { const float y = fp[4 * i] + bf; const float lf = fminf(y, 0.f) - __logf(1.0f + __expf(-fabsf(y))); run += lf; cl[33 * lane + i] = run; }
                            }
                            float incl = run;
#pragma unroll
                            for (int o_ = 1; o_ < 64; o_ <<= 1) { const float tt = __uint_as_float((unsigned)__builtin_amdgcn_ds_bpermute((lane - o_) << 2, (int)__float_as_uint(incl))); if (lane >= o_) incl += tt; }
                            const float excl = incl - run;
                            if (lane <= kb_hi) {
#pragma unroll 8
                                for (int i = 0; i < 32; ++i) cl[33 * lane + i] = -(cl[33 * lane + i] + excl) * LOG2E;
                            }
                            asm volatile("s_waitcnt lgkmcnt(0)" ::: "memory");
                            sm_unit64<0>(QK + rowb * LDQK + 4 * 256 + h * 64, KF + (size_t)(b * 24 + 16 + h) * HSEQ, VT + (size_t)(b * 24 + 16 + h) * HSEQ, Q, kb_hi, kb_lo, 0.f, cl, o, m, l, lane);
                            asm volatile("s_waitcnt lgkmcnt(0)" ::: "memory");
                            slot = chunk;
                        } else {
                            const float slope = exp2f(-8.0f * (float)(5 + h) / 16.0f);
                            sm_unit64<2>(QK + rowb * LDQK + 5 * 256 + h * 64 + type3 * 32, KF + (size_t)(b * 24 + 20 + h) * HSEQ + type3 * 1024, VT + (size_t)(b * 24 + 20 + h) * HSEQ, Q, kb_hi, kb_lo, slope * LOG2E, nullptr, o, m, l, lane);
                            slot = 2 + 2 * type3 + chunk;
                        }
#pragma unroll
                        for (int i = 0; i < 2; ++i) {
                            const int t = (2 * Q + i) * 32 + r32;
                            bf16_t* dst;
                            if (type3 == 2) dst = chunk ? SCRB + (rowb + t) * 256 + h * 64 : YS + (rowb + t) * DM + 512 + h * 64;
                            else dst = (type3 == 0 && chunk == 0) ? YS + (rowb + t) * DM + 768 + h * 64 : SCRB + (size_t)(2 * type3 + chunk) * HT * 256 + (rowb + t) * 256 + h * 64;
                            const float inv = 1.0f / l[i];
#pragma unroll
                            for (int k = 0; k < 16; ++k) { o[i][0][k] *= inv; o[i][1][k] *= inv; }
                            store_o(dst, o[i][0], o[i][1], hi);
                            if (hi == 0) LSE2[(rowb + t) * 24 + h * 6 + slot] = m[i] + lg2(l[i]);
                        }
                    } else if (idx < 3328) {
                        const int i1 = idx - 2304, qb = 63 - (i1 >> 4), bh = i1 & 15, b = bh >> 2, h = bh & 3;
                        const size_t rowb = (size_t)b * SEQ; const int t = qb * 32 + r32;
                        f32x16 o0, o1;
                        sb_unit(QK + rowb * LDQK + 0 * 256 + h * 64, KF + (size_t)(b * 24 + h) * HSEQ, VT + (size_t)(b * 24 + h) * HSEQ, qb, o0, o1, lane);
                        store_o(YS + (rowb + t) * DM + 0 * 256 + h * 64, o0, o1, hi);
                    } else {
                        const int i2 = idx - 3328, j = i2 & 63, gh = (i2 >> 6) % 12, b = i2 / 768, gI = gh >> 2, h = gh & 3;
                        const int rsh = 2 * gI, r = 1 << rsh, sl = SEQ >> rsh, nubsh = 6 - rsh, rho = j >> nubsh, ub = j & ((1 << nubsh) - 1);
                        const int sidx = (gI == 0) ? h : (gI == 1 ? 8 + h : 12 + h);
                        const float slope = exp2f(-8.0f * (float)(sidx + 1) / 16.0f);
                        const size_t rowb = (size_t)b * SEQ + (size_t)rho * sl;
                        f32x16 o0, o1; float m, l;
                        const int kb_lo = (ub - 4 > 0) ? ub - 4 : 0;
                        sm_unit<1>(QK + rowb * LDQK + (1 + gI) * 256 + h * 64, KF + (size_t)(b * 24 + 4 + 4 * gI + h) * HSEQ + (size_t)rho * sl * 64,
                                   VT + (size_t)(b * 24 + 4 + 4 * gI + h) * HSEQ + (size_t)rho * sl * 64, ub, ub, kb_lo, slope * (float)r * LOG2E, nullptr, o0, o1, m, l, lane);
                        const float inv = 1.0f / l;
#pragma unroll
                        for (int i = 0; i < 16; ++i) { o0[i] *= inv; o1[i] *= inv; }
                        const int u = ub * 32 + r32; const size_t tok = (size_t)b * SEQ + (size_t)u * r + rho;
                        store_o(DILO + tok * 768 + gI * 256 + h * 64, o0, o1, hi);
                        if (hi == 0) LSE[tok * 12 + gI * 4 + h] = (m + lg2(l)) * LN2;
                    }
                }
            }
#endif
            GSYNC();
            {
                PHASE_VARS();
                const float lam_init = (layer == 0) ? 0.2f : 0.35550906759093115f;
                float lam;
                { const float a = (lane < 32) ? PP->lq1[layer * 32 + lane] * PP->lk1[layer * 32 + lane] : 0.f, b = (lane < 32) ? PP->lq2[layer * 32 + lane] * PP->lk2[layer * 32 + lane] : 0.f;
                  lam = __expf(wave_sum(a)) - __expf(wave_sum(b)) + lam_init; }
                bf16_t* YS = (bf16_t*)(ws + WS_YS); const bf16_t* DILO = (const bf16_t*)(ws + WS_DILO); const float* LSE = (const float*)(ws + WS_LSE);
                const bf16_t* SCRB = (const bf16_t*)(ws + WS_MERGED) + (size_t)(half * HT) * DM; const float* LSE2 = (const float*)(ws + WS_LSE2);
                const int h = lane >> 4, dq = (lane & 15) * 4;
                const f32x4 dgv = *(const f32x4*)(PP->diff_g + layer * 64 + dq);
                for (int row = gw; row < HT; row += NGW) {
                    const bool split = ((row & (SEQ - 1)) >> 5) >= 32;
                    {
                        const float l0 = LSE[(size_t)row * 12 + h], l1 = LSE[(size_t)row * 12 + 4 + h], l2 = LSE[(size_t)row * 12 + 8 + h];
                        const float mx = fmaxf(l0, fmaxf(l1, l2)); const float e0 = __expf(l0 - mx), e1 = __expf(l1 - mx), e2 = __expf(l2 - mx); const float inv = 1.0f / (e0 + e1 + e2);
                        const u32x2 a = *(const u32x2*)(DILO + (size_t)row * 768 + 4 * lane), b = *(const u32x2*)(DILO + (size_t)row * 768 + 256 + 4 * lane), c = *(const u32x2*)(DILO + (size_t)row * 768 + 512 + 4 * lane);
                        const float w0 = e0 * inv, w1 = e1 * inv, w2 = e2 * inv;
                        u32x2 o; o.x = cvtpk(w0 * bflo(a.x) + w1 * bflo(b.x) + w2 * bflo(c.x), w0 * bfhi(a.x) + w1 * bfhi(b.x) + w2 * bfhi(c.x));
                        o.y = cvtpk(w0 * bflo(a.y) + w1 * bflo(b.y) + w2 * bflo(c.y), w0 * bfhi(a.y) + w1 * bfhi(b.y) + w2 * bfhi(c.y));
                        *(u32x2*)(YS + (size_t)row * DM + 256 + 4 * lane) = o;
                    }
                    const float* ls = LSE2 + (size_t)row * 24 + h * 6;
                    const u32x2 f0 = *(const u32x2*)(YS + (size_t)row * DM + 512 + 4 * lane), a0 = *(const u32x2*)(YS + (size_t)row * DM + 768 + 4 * lane);
                    const u32x2 b0 = *(const u32x2*)(SCRB + (size_t)2 * HT * 256 + (size_t)row * 256 + 4 * lane);
                    float fv[4] = {bflo(f0.x), bfhi(f0.x), bflo(f0.y), bfhi(f0.y)}, av[4] = {bflo(a0.x), bfhi(a0.x), bflo(a0.y), bfhi(a0.y)}, bv[4] = {bflo(b0.x), bfhi(b0.x), bflo(b0.y), bfhi(b0.y)};
                    if (split) {
                        const u32x2 f1 = *(const u32x2*)(SCRB + (size_t)row * 256 + 4 * lane), a1 = *(const u32x2*)(SCRB + (size_t)1 * HT * 256 + (size_t)row * 256 + 4 * lane), b1 = *(const u32x2*)(SCRB + (size_t)3 * HT * 256 + (size_t)row * 256 + 4 * lane);
                        const float lf0 = ls[0], lf1 = ls[1], la0 = ls[2], la1 = ls[3], lb0 = ls[4], lb1 = ls[5];
                        { const float mx = fmaxf(lf0, lf1), e0 = ex2(lf0 - mx), e1 = ex2(lf1 - mx), inv = 1.0f / (e0 + e1), w0 = e0 * inv, w1 = e1 * inv;
                          fv[0] = w0 * fv[0] + w1 * bflo(f1.x); fv[1] = w0 * fv[1] + w1 * bfhi(f1.x); fv[2] = w0 * fv[2] + w1 * bflo(f1.y); fv[3] = w0 * fv[3] + w1 * bfhi(f1.y); }
                        { const float mx = fmaxf(la0, la1), e0 = ex2(la0 - mx), e1 = ex2(la1 - mx), inv = 1.0f / (e0 + e1), w0 = e0 * inv, w1 = e1 * inv;
                          av[0] = w0 * av[0] + w1 * bflo(a1.x); av[1] = w0 * av[1] + w1 * bfhi(a1.x); av[2] = w0 * av[2] + w1 * bflo(a1.y); av[3] = w0 * av[3] + w1 * bfhi(a1.y); }
                        { const float mx = fmaxf(lb0, lb1), e0 = ex2(lb0 - mx), e1 = ex2(lb1 - mx), inv = 1.0f / (e0 + e1), w0 = e0 * inv, w1 = e1 * inv;
                          bv[0] = w0 * bv[0] + w1 * bflo(b1.x); bv[1] = w0 * bv[1] + w1 * bfhi(b1.x); bv[2] = w0 * bv[2] + w1 * bflo(b1.y); bv[3] = w0 * bv[3] + w1 * bfhi(b1.y); }
                        u32x2 fo; fo.x = cvtpk(fv[0], fv[1]); fo.y = cvtpk(fv[2], fv[3]);
                        *(u32x2*)(YS + (size_t)row * DM + 512 + 4 * lane) = fo;
                    }
                    float dv[4]; float ss = 0.f;
#pragma unroll
                    for (int i = 0; i < 4; ++i) { dv[i] = av[i] - lam * bv[i]; ss += dv[i] * dv[i]; }
                    ss += swz_xor<1>(ss); ss += swz_xor<2>(ss); ss += swz_xor<4>(ss); ss += swz_xor<8>(ss);
                    const float rn = __builtin_amdgcn_rsqf(ss * (1.0f / 64.0f) + RMS_EPS) * (1.0f - lam_init);
                    u32x2 dout; dout.x = cvtpk(dv[0] * rn * dgv[0], dv[1] * rn * dgv[1]); dout.y = cvtpk(dv[2] * rn * dgv[2], dv[3] * rn * dgv[3]);
                    *(u32x2*)(YS + (size_t)row * DM + 768 + 4 * lane) = dout;
                }
            }
            GSYNC();
#ifndef NO_P3
            for (int rep = 0; rep < REP_P3; ++rep) {
                PHASE_VARS();
                pg8::Gemm g{(const bf16_t*)(ws + WS_YS), (const bf16_t*)(ws + WS_WB), DM, 512, 512, 512 * 2, (long)8 * 256 * 512 * 2};
                pg8::BranchOrder S{bx, G};
                pg8::EpiBranch E{(const bf16_t*)(ws + WS_GATE), (bf16_t*)(ws + WS_MERGED), half * HT};
                pg8::gemm_phase<pg8::EpiBranch, pg8::BranchOrder, true>(lds, g, S, E);
            }
#endif
            GSYNC();
        }
#ifndef NO_P4
        for (int rep = 0; rep < REP_CONV; ++rep) {
            PHASE_VARS();
            bf16_t* WUP = (bf16_t*)(ws + WS_WUP); bf16_t* WDN = (bf16_t*)(ws + WS_WDN);
            const float* wu = PP->w_up + (size_t)layer * DM * DFF; const float* wd = PP->w_down + (size_t)layer * DFF * DM; const float* mg = PP->mlp_g + (size_t)layer * DM;
            constexpr int I_U = (DM / 64) * (DFF / 32), I_D = (DFF / 64) * (DM / 32);
            for (int it = gw; it < I_U + I_D; it += NGW) {
                if (it < I_U) transpose_item<0>(wu, DM, DFF, DFF, mg, WUP, scr, it, lane);
                else transpose_item<0>(wd, DFF, DM, DM, nullptr, WDN, scr, it - I_U, lane);
            }
            __syncthreads();
        }
        {
            PHASE_VARS();
            pg8::Gemm g{(const bf16_t*)(ws + WS_MERGED), (const bf16_t*)(ws + WS_WOUT), DM, DM, DM, 0, 0};
            pg8::StaticOrder S; S.init(TOK, DM, G, bx);
            pg8::EpiResid E{(layer == 0) ? PP->x : (const float*)PP->out, PP->out, (bf16_t*)(ws + WS_XB), (float*)(ws + WS_SSQ)};
            pg8::gemm_phase<pg8::EpiResid, pg8::StaticOrder, false>(lds, g, S, E);
        }
#endif
        GSYNC();
#ifndef NO_P5
        for (int rep = 0; rep < REP_P5; ++rep) {
            PHASE_VARS();
            pg8::Gemm g{(const bf16_t*)(ws + WS_XB), (const bf16_t*)(ws + WS_WUP), DM, DM, DM, 0, 0};
            pg8::StaticOrder S; S.init(TOK, DFF, G, bx, WGM_P5);
            pg8::EpiUp E{(const float*)(ws + WS_SSQ), (bf16_t*)(ws + WS_HMLP)};
            pg8::gemm_phase<pg8::EpiUp, pg8::StaticOrder, true>(lds, g, S, E);
        }
#endif
        GSYNC();
#ifndef NO_P6
        {
            PHASE_VARS();
            pg8::Gemm g{(const bf16_t*)(ws + WS_HMLP), (const bf16_t*)(ws + WS_WDN), DFF, DFF, DFF, 0, 0};
            pg8::StaticOrder S; S.init(TOK, DM, G, bx);
            if (layer == DEPTH - 1 && G == 256) {
                pg8::EpiFinal E{(const float*)PP->out, PP->out, (float*)(ws + WS_SSQ), PP->final_g, (unsigned*)(ws + WS_CTL) + CW_PANEL};
                pg8::gemm_phase<pg8::EpiFinal, pg8::StaticOrder, true>(lds, g, S, E);
            } else {
                pg8::EpiResid E{(const float*)PP->out, PP->out, (bf16_t*)(ws + WS_XB), (float*)(ws + WS_SSQ)};
                pg8::gemm_phase<pg8::EpiResid, pg8::StaticOrder, false>(lds, g, S, E);
            }
        }
#endif
        if (layer < DEPTH - 1 || gridDim.x != 256) GSYNC();
    }
    if (gridDim.x != 256)
    {
        PHASE_VARS();
        float* X = PP->out;
        for (int row = gw; row < TOK; row += NGW) {
            f32x4* xo = (f32x4*)(X + (size_t)row * DM) + lane; const f32x4* gp = (const f32x4*)PP->final_g + lane;
            f32x4 v[4]; float s = 0.f;
#pragma unroll
            for (int j = 0; j < 4; ++j) { v[j] = xo[64 * j]; s += (v[j][0] * v[j][0] + v[j][1] * v[j][1]) + (v[j][2] * v[j][2] + v[j][3] * v[j][3]); }
            const float rstd = __builtin_amdgcn_rsqf(wave_sum(s) * (1.0f / DM) + RMS_EPS);
#pragma unroll
            for (int j = 0; j < 4; ++j) xo[64 * j] = v[j] * rstd * gp[64 * j];
        }
    }
}

extern "C" void kernel_launch(void* const* d_in, const int* in_sizes, int n_in, void* d_out, int out_size, void* d_ws, size_t ws_size, hipStream_t stream) {
    static int grid = 0;
    if (grid == 0) {
        if (n_in != 15 || in_sizes[0] != TOK * DM || out_size != TOK * DM || ws_size < WS_END) { fprintf(stderr, "kernel_launch: unexpected shapes / workspace (n_in %d, ws %zu)\n", n_in, ws_size); grid = -1; return; }
        int dev = 0, cus = 0, per_cu = 0;
        hipGetDevice(&dev); hipDeviceGetAttribute(&cus, hipDeviceAttributeMultiprocessorCount, dev);
        hipFuncSetAttribute((const void*)fwd_mega, hipFuncAttributeMaxDynamicSharedMemorySize, LDS_BYTES);
        hipOccupancyMaxActiveBlocksPerMultiprocessor(&per_cu, (const void*)fwd_mega, NWAVES * 64, LDS_BYTES);
        (void)hipGetLastError();
        if (per_cu < 1) per_cu = 1;
        grid = cus;
        if (grid > 256) grid = 256;
        if (grid % 8 != 0) { fprintf(stderr, "kernel_launch: the per-XCD work queues need a grid that is a multiple of 8 (got %d)\n", grid); grid = -1; return; }
    }
    if (grid < 0) return;
    hipMemsetAsync((char*)d_ws + WS_CTL, 0, CTL_BYTES, stream);
    Params p{};
    p.x = (const float*)d_in[0]; p.mix_g = (const float*)d_in[1]; p.w_in = (const float*)d_in[2]; p.b_forget = (const float*)d_in[3];
    p.lq1 = (const float*)d_in[4]; p.lk1 = (const float*)d_in[5]; p.lq2 = (const float*)d_in[6]; p.lk2 = (const float*)d_in[7];
    p.diff_g = (const float*)d_in[8]; p.w_branch = (const float*)d_in[9]; p.w_out = (const float*)d_in[10]; p.mlp_g = (const float*)d_in[11];
    p.w_up = (const float*)d_in[12]; p.w_down = (const float*)d_in[13]; p.final_g = (const float*)d_in[14];
    p.out = (float*)d_out; p.ws = (unsigned char*)d_ws;
    void* args[] = {&p};
    hipError_t e = hipLaunchCooperativeKernel((const void*)fwd_mega, dim3(grid), dim3(NWAVES * 64), args, LDS_BYTES, stream);
    if (e != hipSuccess) fprintf(stderr, "cooperative launch failed: %s (grid %d)\n", hipGetErrorString(e), grid);
}
```

```cpp
#include <hip/hip_runtime.h>
#include <hip/hip_cooperative_groups.h>
#include <cstdio>
#include <cstdint>
namespace cg = cooperative_groups;

#define LAS __attribute__((address_space(3)))
typedef unsigned short bf16_t;
typedef short bf16x8 __attribute__((ext_vector_type(8)));
typedef float f32x4 __attribute__((ext_vector_type(4)));
typedef float f32x16 __attribute__((ext_vector_type(16)));
typedef unsigned u32x4 __attribute__((ext_vector_type(4)));
typedef unsigned u32x2 __attribute__((ext_vector_type(2)));
typedef float f32x2_t __attribute__((ext_vector_type(2)));
typedef __bf16 bf16x2_t __attribute__((ext_vector_type(2)));

constexpr int DM = 1024, BATCH = 8, SEQ = 2048, DEPTH = 2, TOK = BATCH * SEQ, DFF = 4096, DIN = 8708;
constexpr int HT = TOK / 2;
constexpr int NPROJ = 35 * 256;
constexpr int LDQK = 6 * 256;
constexpr int HSEQ = SEQ * 64;
constexpr float LOG2E = 1.4426950408889634f, LN2 = 0.6931471805599453f;
constexpr float RMS_EPS = 1e-6f;

constexpr size_t MiB = 1u << 20;
constexpr size_t WS_CTL = 0, CTL_BYTES = 65536;
constexpr int CW_BAR = 4096, CW_PANEL = 8192;
constexpr size_t WS_SSQ = 1 * MiB;
constexpr size_t WS_WIN = 2 * MiB;
constexpr size_t WS_WUP = WS_WIN, WS_WDN = WS_WIN + 8 * MiB;
constexpr size_t WS_WB = 20 * MiB;
constexpr size_t WS_WOUT = 24 * MiB;
constexpr size_t WS_XB = 26 * MiB;
constexpr size_t WS_MERGED = 58 * MiB;
constexpr size_t WS_YS = 90 * MiB;
constexpr size_t WS_DILO = 106 * MiB;
constexpr size_t WS_LSE = 118 * MiB;
constexpr size_t WS_LSE2 = 118 * MiB + 512 * 1024;
constexpr size_t WS_FL = 119 * MiB + 512 * 1024;
constexpr size_t WS_QK = 120 * MiB;
constexpr size_t WS_KF = 144 * MiB;
constexpr size_t WS_VT = 168 * MiB;
constexpr size_t WS_GATE = 192 * MiB;
constexpr size_t WS_HMLP = 120 * MiB;
constexpr size_t WS_END = 256 * MiB;

constexpr int LDS_BYTES = 147456;
constexpr int NWAVES = 8;
#ifndef WGM_P1
#define WGM_P1 4
#endif
#ifndef WGM_P5
#define WGM_P5 8
#endif

__device__ __forceinline__ unsigned cvtpk(float lo, float hi) { f32x2_t v = {lo, hi}; bf16x2_t b = __builtin_convertvector(v, bf16x2_t); return __builtin_bit_cast(unsigned, b); }
__device__ __forceinline__ float bflo(unsigned w) { return __uint_as_float(w << 16); }
__device__ __forceinline__ float bfhi(unsigned w) { return __uint_as_float(w & 0xffff0000u); }
__device__ __forceinline__ float ex2(float x) { return __builtin_amdgcn_exp2f(x); }
__device__ __forceinline__ float lg2(float x) { return __builtin_amdgcn_logf(x); }
__device__ __forceinline__ float x32_sum(float v) { auto r = __builtin_amdgcn_permlane32_swap(__float_as_uint(v), __float_as_uint(v), false, false); return __uint_as_float(r[0]) + __uint_as_float(r[1]); }
__device__ __forceinline__ float x32_max(float v) { auto r = __builtin_amdgcn_permlane32_swap(__float_as_uint(v), __float_as_uint(v), false, false); return fmaxf(__uint_as_float(r[0]), __uint_as_float(r[1])); }
__device__ __forceinline__ float x32_partner(float v, int hi) { auto r = __builtin_amdgcn_permlane32_swap(__float_as_uint(v), __float_as_uint(v), false, false); return hi ? __uint_as_float(r[0]) : __uint_as_float(r[1]); }
template <int X> __device__ __forceinline__ float swz_xor(float v) { return __uint_as_float((unsigned)__builtin_amdgcn_ds_swizzle((int)__float_as_uint(v), (X << 10) | 0x1f)); }
__device__ __forceinline__ float x16_sum(float v) { return v + swz_xor<16>(v); }
__device__ __forceinline__ float wave_sum(float v) { v += swz_xor<1>(v); v += swz_xor<2>(v); v += swz_xor<4>(v); v += swz_xor<8>(v); v += swz_xor<16>(v); return x32_sum(v); }

namespace pg8 {
constexpr int BM = 256, BK = 64, HALF = 128, HTB = HALF * BK * 2, STAGE_BYTES = 8 * HTB, NXCD = 8, WGM = 8;
__host__ __device__ __forceinline__ int lds_byte(int r, int c) { const int st = (r >> 4) * 2 + (c >> 5), rr = r & 15, cc = c & 31, ob = rr * 64 + cc * 2; return st * 1024 + (ob ^ (((ob >> 9) & 1) << 5)); }
__host__ __device__ __forceinline__ void stage_rc(int b, int& R, int& C) { const int st = b / 1024, sb = b % 1024, swz = sb ^ (((sb >> 9) & 1) << 5); R = (st >> 1) * 16 + swz / 64; C = (st & 1) * 32 + (swz % 64) / 2; }
__host__ __device__ __forceinline__ int perm32(int rho) { const int n = rho >> 4, i = rho & 15; return 8 * (i >> 2) + 4 * n + (i & 3); }

struct Unit { int pm, pn, aux; };
struct Gemm { const bf16_t* A; const bf16_t* Bt; int lda, ldb, K; long a_aux, b_aux; };

struct StaticOrder {
    int nM, nN, nwg, G, c, wgm;
    __device__ void init(int M, int N, int G_, int c_, int wgm_ = WGM) { nM = M / BM; nN = N / BM; nwg = nM * nN; G = G_; c = c_; wgm = wgm_; }
    __device__ bool next(int i, Unit& u) const {
        const long L = (long)i * G + c; if (L >= nwg) return false;
        int wgid = (int)L; { const int q = nwg / NXCD, r = nwg % NXCD, xcd = wgid % NXCD, off = wgid / NXCD; wgid = (xcd < r ? xcd * (q + 1) : r * (q + 1) + (xcd - r) * q) + off; }
        const int nig = wgm * nN, gid = wgid / nig, fm = gid * wgm, gsz = (nM - fm) < wgm ? (nM - fm) : wgm;
        u.pm = fm + ((wgid % nig) % gsz); u.pn = (wgid % nig) / gsz; u.aux = 0; return true;
    }
};
struct BranchOrder {
    int c, G;
    __device__ bool next(int i, Unit& u) const { const int t = c + (i >> 1) * G; if (t >= 256) return false; const int x = t & 7, j = t >> 3; u.pm = x + 8 * (j >> 3); u.pn = j & 7; u.aux = i & 1; return true; }
};

template <class Epi, class Sched, bool ALIGN_EPI, bool HALFB = false>
__device__ __forceinline__ void gemm_phase(LAS unsigned char* lds, const Gemm g, const Sched& S, const Epi& E) {
    int tid_ = threadIdx.x; asm volatile("" : "+v"(tid_));
    const int tid = tid_, wid = __builtin_amdgcn_readfirstlane(tid >> 6), lane = tid & 63, wr = wid >> 2, wc = wid & 3, fr = lane & 15, fq = lane >> 4;
    int nt_ = g.K / BK; asm volatile("" : "+s"(nt_)); const int nt = nt_;
    unsigned voffA[2], voffB[2];
#pragma unroll
    for (int i = 0; i < 2; ++i) { int R, C; stage_rc(tid * 16 + i * 8192, R, C); const int Rb = Epi::PERM ? ((R & ~31) + perm32(R & 31)) : R;
        voffA[i] = (unsigned)(R * g.lda + C) * 2u; voffB[i] = (unsigned)(Rb * g.ldb + C) * 2u; }
    const size_t kstep = (size_t)(BK * 2);
    const size_t hstepA = (size_t)HALF * g.lda * 2, hstepB = (size_t)HALF * g.ldb * 2;
    const size_t tstepA = 2 * hstepA, tstepB = 2 * hstepB;
    const unsigned ldsw = (unsigned)wid * 1024u;
    const int aoff = lds_byte(wr * 64 + fr, fq * 8), boff = lds_byte(wc * 32 + fr, fq * 8);
#define PG8_SA(b, h) (((b) * 2 + (h)) * HTB)
#define PG8_SB(b, h) ((4 + (b) * 2 + (h)) * HTB)
#define PG8_STAGE(bufoff, gbase, voff) do { _Pragma("unroll") for (int _i = 0; _i < 2; ++_i) \
        __builtin_amdgcn_global_load_lds((const unsigned*)((const char*)(gbase) + (voff)[_i]), (LAS unsigned*)(lds + (bufoff) + ldsw + _i * 8192), 16, 0, 0); } while (0)
#define PG8_LDA(dst, b, h) do { _Pragma("unroll") for (int m = 0; m < 4; ++m) _Pragma("unroll") for (int k = 0; k < 2; ++k) dst[m][k] = *(const LAS bf16x8*)(lds + PG8_SA(b, h) + aoff + m * 2048 + k * 1024); } while (0)
#define PG8_LDB(dst, b, h) do { _Pragma("unroll") for (int n = 0; n < 2; ++n) _Pragma("unroll") for (int k = 0; k < 2; ++k) dst[n][k] = *(const LAS bf16x8*)(lds + PG8_SB(b, h) + boff + n * 2048 + k * 1024); } while (0)
#define PG8_MMA(ai, bj, At, Bt) do { __builtin_amdgcn_s_setprio(1); _Pragma("unroll") for (int m = 0; m < 4; ++m) _Pragma("unroll") for (int n = 0; n < 2; ++n) _Pragma("unroll") for (int k = 0; k < 2; ++k) \
        acc[ai][bj][m][n] = __builtin_amdgcn_mfma_f32_16x16x32_bf16(Bt[n][k], At[m][k], acc[ai][bj][m][n], 0, 0, 0); __builtin_amdgcn_s_setprio(0); } while (0)
#define PG8_MMA2(ai) do { if constexpr (HALFB) { if (lo) { PG8_MMA(ai, 0, At, B0); } else { PG8_MMA(ai, 1, At, B1); } } else { PG8_MMA(ai, 0, At, B0); PG8_MMA(ai, 1, At, B1); } } while (0)
#define PG8_WAIT_V(n) asm volatile("s_waitcnt vmcnt(" #n ")" ::: "memory")
#define PG8_WAIT_L(n) asm volatile("s_waitcnt lgkmcnt(" #n ")" ::: "memory")
#define PG8_BAR __builtin_amdgcn_s_barrier()
#define PG8_SCHED __builtin_amdgcn_sched_barrier(0)
#define PG8_UA(u) ((const char*)g.A + (size_t)(u).pm * tstepA + (size_t)(u).aux * (size_t)g.a_aux)
#define PG8_UB(u) ((const char*)g.Bt + (size_t)(u).pn * tstepB + (size_t)(u).aux * (size_t)g.b_aux)
    Unit cur, nxt; int ui = 0;
    if (!S.next(0, cur)) return;
    f32x4 acc[2][2][4][2];
#pragma unroll
    for (int a = 0; a < 2; ++a)
#pragma unroll
        for (int b = 0; b < 2; ++b)
#pragma unroll
            for (int m = 0; m < 4; ++m)
#pragma unroll
                for (int n = 0; n < 2; ++n) acc[a][b][m][n] = (f32x4){0.f, 0.f, 0.f, 0.f};
    bf16x8 At[4][2], B0[2][2], B1[2][2];
    const char* cA = PG8_UA(cur); const char* cB = PG8_UB(cur);
    PG8_STAGE(PG8_SB(0, 0), cB, voffB); PG8_STAGE(PG8_SB(0, 1), cB + hstepB, voffB); PG8_STAGE(PG8_SA(0, 0), cA, voffA); PG8_STAGE(PG8_SA(0, 1), cA + hstepA, voffA);
    if (wr == 1) PG8_BAR;
    PG8_WAIT_V(2); PG8_BAR;
    PG8_STAGE(PG8_SB(1, 0), cB + kstep, voffB); PG8_STAGE(PG8_SA(1, 0), cA + kstep, voffA); PG8_STAGE(PG8_SB(1, 1), cB + hstepB + kstep, voffB);
    PG8_WAIT_V(6); PG8_BAR;
    for (;;) {
        const bool has_next = S.next(ui + 1, nxt);
        const char* nA = has_next ? PG8_UA(nxt) : cA; const char* nB = has_next ? PG8_UB(nxt) : cB;
        for (int t = 0; t < nt; t += 2) {
            const bool last = (t == nt - 2);
            const bool lo = (2 * t < nt);
            (void)lo;
            const char* a1 = cA + (size_t)(t + 1) * kstep;
            const char* a2 = last ? nA : cA + (size_t)(t + 2) * kstep; const char* b2 = last ? nB : cB + (size_t)(t + 2) * kstep;
            const char* a3 = a2 + kstep; const char* b3 = b2 + kstep;
            PG8_LDB(B0, 0, 0); PG8_LDB(B1, 0, 1); PG8_SCHED; PG8_LDA(At, 0, 0); PG8_STAGE(PG8_SA(1, 1), a1 + hstepA, voffA);
            PG8_WAIT_V(8); PG8_WAIT_L(0); PG8_BAR; PG8_MMA2(0); PG8_BAR; PG8_SCHED;
            PG8_LDA(At, 0, 1); PG8_STAGE(PG8_SB(0, 0), b2, voffB); PG8_STAGE(PG8_SB(0, 1), b2 + hstepB, voffB); PG8_STAGE(PG8_SA(0, 0), a2, voffA);
            PG8_WAIT_V(8); PG8_WAIT_L(0); PG8_BAR; PG8_MMA2(1); PG8_BAR; PG8_SCHED;
            PG8_LDB(B0, 1, 0); PG8_LDB(B1, 1, 1); PG8_SCHED; PG8_LDA(At, 1, 0); PG8_STAGE(PG8_SA(0, 1), a2 + hstepA, voffA);
            PG8_WAIT_V(8); PG8_WAIT_L(0); PG8_BAR; PG8_MMA2(0); PG8_BAR; PG8_SCHED;
            PG8_LDA(At, 1, 1); PG8_STAGE(PG8_SB(1, 0), b3, voffB); PG8_STAGE(PG8_SB(1, 1), b3 + hstepB, voffB); PG8_STAGE(PG8_SA(1, 0), a3, voffA);
            PG8_WAIT_V(8); PG8_WAIT_L(0); PG8_BAR; PG8_MMA2(1); PG8_BAR; PG8_SCHED;
        }
        if constexpr (ALIGN_EPI) { if (wr == 0) PG8_BAR; }
        { Unit eu = cur; asm volatile("" : "+s"(eu.pm), "+s"(eu.pn), "+s"(eu.aux)); E(acc, eu, wr, wc, fr, fq); }
        if (!has_next) break;
#pragma unroll
        for (int a = 0; a < 2; ++a)
#pragma unroll
            for (int b = 0; b < 2; ++b)
#pragma unroll
                for (int m = 0; m < 4; ++m)
#pragma unroll
                    for (int n = 0; n < 2; ++n) acc[a][b][m][n] = (f32x4){0.f, 0.f, 0.f, 0.f};
        cur = nxt; cA = nA; cB = nB; ++ui;
        if constexpr (ALIGN_EPI) { if (wr == 1) PG8_BAR; }
    }
    PG8_WAIT_V(0);
    if constexpr (!ALIGN_EPI) { if (wr == 0) PG8_BAR; }
    PG8_BAR;
#undef PG8_SA
#undef PG8_SB
#undef PG8_STAGE
#undef PG8_LDA
#undef PG8_LDB
#undef PG8_MMA
#undef PG8_MMA2
#undef PG8_WAIT_V
#undef PG8_WAIT_L
#undef PG8_BAR
#undef PG8_SCHED
#undef PG8_UA
#undef PG8_UB
}

__device__ __forceinline__ float row_rstd(const float* ssq, int row, int fq) {
    const f32x4 a = *(const f32x4*)(ssq + (size_t)row * 16 + 4 * fq);
    float s = (a[0] + a[1]) + (a[2] + a[3]);
    s = x16_sum(s); s = x32_sum(s);
    return __builtin_amdgcn_rsqf(s * (1.0f / DM) + RMS_EPS);
}
__device__ __forceinline__ int pos16(int o) { return 8 * ((o >> 2) & 1) + 4 * (o >> 3) + (o & 3); }

struct EpiProj {
    static constexpr bool PERM = true;
    const float* ssq; int row_base; bf16_t* QK; bf16_t* KF; bf16_t* VT; float* FL; bf16_t* GATE;
    __device__ __forceinline__ void operator()(const f32x4 (&acc)[2][2][4][2], const Unit& u, int wr, int wc, int fr, int fq) const {
        const int pn = u.pn;
        const int lrow0 = u.pm * BM + wr * 64 + fr;
        float rs[2][4];
#pragma unroll
        for (int ai = 0; ai < 2; ++ai)
#pragma unroll
            for (int m = 0; m < 4; ++m) rs[ai][m] = row_rstd(ssq, row_base + lrow0 + ai * HALF + m * 16, fq);
        const int cin = wc * 32 + 8 * fq;
        if (pn >= 19) {
#pragma unroll
            for (int ai = 0; ai < 2; ++ai)
#pragma unroll
                for (int m = 0; m < 4; ++m) { const int lrow = lrow0 + ai * HALF + m * 16; const float s = rs[ai][m];
#pragma unroll
                    for (int bj = 0; bj < 2; ++bj) { const f32x4 v0 = acc[ai][bj][m][0] * s, v1 = acc[ai][bj][m][1] * s;
                        u32x4 w; w.x = cvtpk(v0[0], v0[1]); w.y = cvtpk(v0[2], v0[3]); w.z = cvtpk(v1[0], v1[1]); w.w = cvtpk(v1[2], v1[3]);
                        *(u32x4*)(GATE + (size_t)lrow * 4096 + (pn - 19) * 256 + bj * HALF + cin) = w; } }
        } else if (pn == 18) {
            if (wc == 0 && fq == 0) {
#pragma unroll
                for (int ai = 0; ai < 2; ++ai)
#pragma unroll
                    for (int m = 0; m < 4; ++m) { const int lrow = lrow0 + ai * HALF + m * 16; *(f32x4*)(FL + (size_t)lrow * 4) = acc[ai][0][m][0] * rs[ai][m]; }
            }
        } else if (pn == 2 || (pn >= 9 && pn <= 11) || pn == 14 || pn == 17) {
            int vhb, rsh;
            if (pn == 2) { vhb = 0; rsh = 0; } else if (pn == 14) { vhb = 16; rsh = 0; } else if (pn == 17) { vhb = 20; rsh = 0; } else { const int gI = pn - 9; vhb = 4 + 4 * gI; rsh = 2 * gI; }
            const int slsh = 11 - rsh, rmask = (1 << rsh) - 1;
#pragma unroll
            for (int ai = 0; ai < 2; ++ai)
#pragma unroll
                for (int m = 0; m < 4; ++m) { const int lrow = lrow0 + ai * HALF + m * 16; const float s = rs[ai][m];
                    const int bl = lrow >> 11, t = lrow & (SEQ - 1); int p = ((t & rmask) << slsh) + (t >> rsh); p = (p & ~15) | pos16(p & 15);
                    const int kb = p >> 5, q = p & 31;
                    bf16_t* base = VT + (size_t)(bl * 24 + vhb) * HSEQ + (size_t)kb * 2048 + (q >> 4) * 512 + ((q >> 3) & 1) * 256 + (q & 7);
#pragma unroll
                    for (int bj = 0; bj < 2; ++bj) { const int c0 = bj * HALF + cin;
                        bf16_t* bp = base + (size_t)(c0 >> 6) * HSEQ + ((c0 >> 5) & 1) * 1024 + (c0 & 31) * 8;
                        const f32x4 v0 = acc[ai][bj][m][0] * s, v1 = acc[ai][bj][m][1] * s;
                        const unsigned w0 = cvtpk(v0[0], v0[1]), w1 = cvtpk(v0[2], v0[3]), w2 = cvtpk(v1[0], v1[1]), w3 = cvtpk(v1[2], v1[3]);
                        bp[0 * 8] = (bf16_t)(w0 & 0xffff); bp[1 * 8] = (bf16_t)(w0 >> 16); bp[2 * 8] = (bf16_t)(w1 & 0xffff); bp[3 * 8] = (bf16_t)(w1 >> 16);
                        bp[4 * 8] = (bf16_t)(w2 & 0xffff); bp[5 * 8] = (bf16_t)(w2 >> 16); bp[6 * 8] = (bf16_t)(w3 & 0xffff); bp[7 * 8] = (bf16_t)(w3 >> 16); } }
        } else {
            const bool isK = (pn == 1) || (pn >= 6 && pn <= 8) || pn == 13 || pn == 16;
            int slot = 0, khb = 0, rsh = 0;
            if (pn <= 1) { slot = 0; khb = 0; } else if (pn <= 8) { const int gI = (pn - 3) % 3; rsh = 2 * gI; slot = 1 + gI; khb = 4 + 4 * gI; } else if (pn <= 13) { slot = 4; khb = 16; } else { slot = 5; khb = 20; }
            const int slsh = 11 - rsh, rmask = (1 << rsh) - 1;
#pragma unroll
            for (int ai = 0; ai < 2; ++ai)
#pragma unroll
                for (int m = 0; m < 4; ++m) { const int lrow = lrow0 + ai * HALF + m * 16; const float s = rs[ai][m];
                    const int bl = lrow >> 11, t = lrow & (SEQ - 1); const int p = ((t & rmask) << slsh) + (t >> rsh);
#pragma unroll
                    for (int bj = 0; bj < 2; ++bj) { const f32x4 v0 = acc[ai][bj][m][0] * s, v1 = acc[ai][bj][m][1] * s;
                        u32x4 w; w.x = cvtpk(v0[0], v0[1]); w.y = cvtpk(v0[2], v0[3]); w.z = cvtpk(v1[0], v1[1]); w.w = cvtpk(v1[2], v1[3]);
                        const int c0 = bj * HALF + cin;
                        if (isK) { const int dcol = c0 & 63;
                            *(u32x4*)(KF + (size_t)(bl * 24 + khb + (c0 >> 6)) * HSEQ + (size_t)(p >> 5) * 2048 + (dcol >> 4) * 512 + (((dcol >> 3) & 1) * 32 + (p & 31)) * 8) = w; }
                        else *(u32x4*)(QK + (size_t)(bl * SEQ + p) * LDQK + slot * 256 + c0) = w; } }
        }
    }
};

struct EpiBranch {
    static constexpr bool PERM = true;
    const bf16_t* GATE; bf16_t* MERGED; int row_base;
    __device__ __forceinline__ static float sg(float g) { return __builtin_amdgcn_rcpf(1.0f + ex2(-g * LOG2E)); }
    __device__ __forceinline__ static u32x4 mix(const u32x4 ga, const u32x4 gb, const u32x4 ow, const f32x4 a0, const f32x4 a1, const f32x4 b0, const f32x4 b1) {
        const float o0 = sg(bflo(ga.x)) * a0[0] + sg(bflo(gb.x)) * b0[0] + bflo(ow.x), o1 = sg(bfhi(ga.x)) * a0[1] + sg(bfhi(gb.x)) * b0[1] + bfhi(ow.x);
        const float o2 = sg(bflo(ga.y)) * a0[2] + sg(bflo(gb.y)) * b0[2] + bflo(ow.y), o3 = sg(bfhi(ga.y)) * a0[3] + sg(bfhi(gb.y)) * b0[3] + bfhi(ow.y);
        const float o4 = sg(bflo(ga.z)) * a1[0] + sg(bflo(gb.z)) * b1[0] + bflo(ow.z), o5 = sg(bfhi(ga.z)) * a1[1] + sg(bfhi(gb.z)) * b1[1] + bfhi(ow.z);
        const float o6 = sg(bflo(ga.w)) * a1[2] + sg(bflo(gb.w)) * b1[2] + bflo(ow.w), o7 = sg(bfhi(ga.w)) * a1[3] + sg(bfhi(gb.w)) * b1[3] + bfhi(ow.w);
        u32x4 w; w.x = cvtpk(o0, o1); w.y = cvtpk(o2, o3); w.z = cvtpk(o4, o5); w.w = cvtpk(o6, o7); return w;
    }
    __device__ __forceinline__ void operator()(const f32x4 (&acc)[2][2][4][2], const Unit& u, int wr, int wc, int fr, int fq) const {
        const int p = u.aux; const int lrow0 = u.pm * BM + wr * 64 + fr; const int d0 = u.pn * 128 + wc * 32 + 8 * fq;
        const bf16_t* gbase = GATE + (size_t)lrow0 * 4096 + (2 * p) * 1024 + d0; bf16_t* mbase = MERGED + (size_t)(row_base + lrow0) * DM + d0;
        const u32x4 zero = {0u, 0u, 0u, 0u};
#pragma unroll
        for (int ai = 0; ai < 2; ++ai)
#pragma unroll
            for (int mp = 0; mp < 2; ++mp) {
                u32x4 ga[2], gb[2], ow[2];
#pragma unroll
                for (int mm = 0; mm < 2; ++mm) { const size_t ro = (size_t)(ai * HALF + (2 * mp + mm) * 16);
                    ga[mm] = *(const u32x4*)(gbase + ro * 4096); gb[mm] = *(const u32x4*)(gbase + ro * 4096 + 1024);
                    ow[mm] = zero; if (p > 0) ow[mm] = *(const u32x4*)(mbase + ro * DM); }
#pragma unroll
                for (int mm = 0; mm < 2; ++mm) { const int m = 2 * mp + mm; const size_t ro = (size_t)(ai * HALF + m * 16);
                    *(u32x4*)(mbase + ro * DM) = mix(ga[mm], gb[mm], ow[mm], acc[ai][0][m][0], acc[ai][0][m][1], acc[ai][1][m][0], acc[ai][1][m][1]); }
                asm volatile("" ::: "memory");
            }
    }
};

struct EpiResid {
    static constexpr bool PERM = true;
    const float* Xin; float* X; bf16_t* XB; float* ssq;
    __device__ __forceinline__ void operator()(const f32x4 (&acc)[2][2][4][2], const Unit& u, int wr, int wc, int fr, int fq) const {
        const int row0 = u.pm * BM + wr * 64 + fr; const int col0 = u.pn * BM + wc * 32 + 8 * fq;
#pragma unroll
        for (int ai = 0; ai < 2; ++ai)
#pragma unroll
            for (int m = 0; m < 4; ++m) { const int row = row0 + ai * HALF + m * 16; float sq = 0.f;
#pragma unroll
                for (int bj = 0; bj < 2; ++bj) { const int col = col0 + bj * HALF; f32x4* xp = (f32x4*)(X + (size_t)row * DM + col); const f32x4* xi = (const f32x4*)(Xin + (size_t)row * DM + col);
                    const f32x4 x0 = xi[0] + acc[ai][bj][m][0], x1 = xi[1] + acc[ai][bj][m][1];
                    xp[0] = x0; xp[1] = x1;
                    u32x4 w; w.x = cvtpk(x0[0], x0[1]); w.y = cvtpk(x0[2], x0[3]); w.z = cvtpk(x1[0], x1[1]); w.w = cvtpk(x1[2], x1[3]);
                    *(u32x4*)(XB + (size_t)row * DM + col) = w;
                    sq += (x0[0] * x0[0] + x0[1] * x0[1]) + (x0[2] * x0[2] + x0[3] * x0[3]) + (x1[0] * x1[0] + x1[1] * x1[1]) + (x1[2] * x1[2] + x1[3] * x1[3]); }
                sq = x16_sum(sq); sq = x32_sum(sq);
                if (fq == 0) ssq[(size_t)row * 16 + u.pn * 4 + wc] = sq; if (m & 1) asm volatile("" ::: "memory"); }
    }
};

struct EpiFinal {
    static constexpr bool PERM = true;
    const float* X; float* out; float* ssq; const float* gfin; unsigned* cnt;
    __device__ __forceinline__ void operator()(f32x4 (&acc)[2][2][4][2], const Unit& u, int wr, int wc, int fr, int fq) const {
        const int row0 = u.pm * BM + wr * 64 + fr; const int col0 = u.pn * BM + wc * 32 + 8 * fq;
#pragma unroll
        for (int ai = 0; ai < 2; ++ai)
#pragma unroll
            for (int m = 0; m < 4; ++m) { const int row = row0 + ai * HALF + m * 16; float sq = 0.f;
#pragma unroll
                for (int bj = 0; bj < 2; ++bj) { const f32x4* xi = (const f32x4*)(X + (size_t)row * DM + col0 + bj * HALF);
                    const f32x4 x0 = xi[0] + acc[ai][bj][m][0], x1 = xi[1] + acc[ai][bj][m][1];
                    acc[ai][bj][m][0] = x0; acc[ai][bj][m][1] = x1;
                    sq += (x0[0] * x0[0] + x0[1] * x0[1]) + (x0[2] * x0[2] + x0[3] * x0[3]) + (x1[0] * x1[0] + x1[1] * x1[1]) + (x1[2] * x1[2] + x1[3] * x1[3]); }
                sq = x16_sum(sq); sq = x32_sum(sq);
                if (fq == 0) __hip_atomic_store(ssq + (size_t)row * 16 + u.pn * 4 + wc, sq, __ATOMIC_RELAXED, __HIP_MEMORY_SCOPE_AGENT);
                if (m & 1) asm volatile("" ::: "memory"); }
        asm volatile("s_waitcnt vmcnt(0)" ::: "memory");
        unsigned* c = cnt + 64 * u.pm;
        if ((fr | fq) == 0) {
            __hip_atomic_fetch_add(c, 1u, __ATOMIC_RELAXED, __HIP_MEMORY_SCOPE_AGENT);
            unsigned sp = 0;
            while (__hip_atomic_load(c, __ATOMIC_RELAXED, __HIP_MEMORY_SCOPE_AGENT) < 32u) { __builtin_amdgcn_s_sleep(2); if (++sp > (1u << 22)) break; }
        }
        __builtin_amdgcn_fence(__ATOMIC_ACQUIRE, "agent");
        asm volatile("s_waitcnt vmcnt(0)" ::: "memory");
        float rs[2][4];
#pragma unroll
        for (int ai = 0; ai < 2; ++ai)
#pragma unroll
            for (int m = 0; m < 4; ++m) rs[ai][m] = row_rstd(ssq, row0 + ai * HALF + m * 16, fq);
#pragma unroll
        for (int bj = 0; bj < 2; ++bj) { const f32x4 g0 = *(const f32x4*)(gfin + col0 + bj * HALF), g1 = *(const f32x4*)(gfin + col0 + bj * HALF + 4);
#pragma unroll
            for (int ai = 0; ai < 2; ++ai)
#pragma unroll
                for (int m = 0; m < 4; ++m) { const int row = row0 + ai * HALF + m * 16; f32x4* op = (f32x4*)(out + (size_t)row * DM + col0 + bj * HALF);
                    op[0] = acc[ai][bj][m][0] * rs[ai][m] * g0; op[1] = acc[ai][bj][m][1] * rs[ai][m] * g1; } }
    }
};

struct EpiUp {
    static constexpr bool PERM = true;
    const float* ssq; bf16_t* H;
    __device__ __forceinline__ void operator()(const f32x4 (&acc)[2][2][4][2], const Unit& u, int wr, int wc, int fr, int fq) const {
        const int row0 = u.pm * BM + wr * 64 + fr; const int col0 = u.pn * BM + wc * 32 + 8 * fq;
        float rs[2][4];
#pragma unroll
        for (int ai = 0; ai < 2; ++ai)
#pragma unroll
            for (int m = 0; m < 4; ++m) rs[ai][m] = row_rstd(ssq, row0 + ai * HALF + m * 16, fq);
#pragma unroll
        for (int ai = 0; ai < 2; ++ai)
#pragma unroll
            for (int m = 0; m < 4; ++m) { const int row = row0 + ai * HALF + m * 16; const float s = rs[ai][m];
#pragma unroll
                for (int bj = 0; bj < 2; ++bj) { f32x4 v0 = acc[ai][bj][m][0] * s, v1 = acc[ai][bj][m][1] * s;
#pragma unroll
                    for (int i = 0; i < 4; ++i) { const float a = fmaxf(v0[i], 0.f), b = fmaxf(v1[i], 0.f); v0[i] = a * a; v1[i] = b * b; }
                    u32x4 w; w.x = cvtpk(v0[0], v0[1]); w.y = cvtpk(v0[2], v0[3]); w.z = cvtpk(v1[0], v1[1]); w.w = cvtpk(v1[2], v1[3]);
                    *(u32x4*)(H + (size_t)row * DFF + col0 + bj * HALF) = w; } }
    }
};
}

__device__ __forceinline__ int win_src(int n) {
    if (n < 3840) return n;
    if (n < 4608) return n + 4;
    if (n < 4864) return (n - 4608 < 4) ? 3840 + (n - 4608) : -1;
    return n - 4864 + 4612;
}
template <int CMAP>
__device__ __forceinline__ void transpose_item(const float* W, int K, int N, int Nsrc, const float* gain, bf16_t* WT, LAS float* scr, int item, int lane) {
    const int nblk = N / 32, kb = item / nblk, nb = item % nblk, k0 = 64 * kb, n0 = 32 * nb;
    const int n = n0 + (lane & 31); const int src = CMAP ? win_src(n) : n;
    const bool live = (src >= 0); const float* wp = W + (size_t)(k0 + (lane >> 5)) * Nsrc + (live ? src : 0); const float* gp = gain ? gain + k0 + (lane >> 5) : nullptr;
    float wv[32];
#pragma unroll
    for (int i = 0; i < 32; ++i) wv[i] = wp[(size_t)(2 * i) * Nsrc];
#pragma unroll
    for (int i = 0; i < 32; ++i) { float v = live ? wv[i] : 0.f; if (gp) v *= gp[2 * i]; scr[(2 * i + (lane >> 5)) * 33 + (lane & 31)] = v; }
    asm volatile("s_waitcnt lgkmcnt(0)" ::: "memory");
    const int c = lane & 7;
#pragma unroll
    for (int j = 0; j < 4; ++j) { const int nn = (lane >> 3) + 8 * j; const LAS float* s = scr + (8 * c) * 33 + nn;
        u32x4 o; o.x = cvtpk(s[0 * 33], s[1 * 33]); o.y = cvtpk(s[2 * 33], s[3 * 33]); o.z = cvtpk(s[4 * 33], s[5 * 33]); o.w = cvtpk(s[6 * 33], s[7 * 33]);
        *(u32x4*)(WT + (size_t)(n0 + nn) * K + k0 + 8 * c) = o; }
    asm volatile("s_waitcnt lgkmcnt(0)" ::: "memory");
}

__device__ __forceinline__ void branch_item(const float* Wn, int n, bf16_t* WBP, LAS float* scr, int item, int lane) {
    const int kb = item >> 5, nb = item & 31, k0 = 64 * kb, n0 = 32 * nb;
    const float* wp = Wn + (size_t)(k0 + (lane >> 5)) * DM + n0 + (lane & 31);
    float wv[32];
#pragma unroll
    for (int i = 0; i < 32; ++i) wv[i] = wp[(size_t)(2 * i) * DM];
#pragma unroll
    for (int i = 0; i < 32; ++i) scr[(2 * i + (lane >> 5)) * 33 + (lane & 31)] = wv[i];
    asm volatile("s_waitcnt lgkmcnt(0)" ::: "memory");
    const int c = lane & 7, bj = n & 1, pair = n >> 1;
    const u32x4 zero = {0u, 0u, 0u, 0u};
#pragma unroll
    for (int j = 0; j < 4; ++j) { const int nn = (lane >> 3) + 8 * j; const LAS float* sp = scr + (8 * c) * 33 + nn; const int d = n0 + nn;
        u32x4 o; o.x = cvtpk(sp[0 * 33], sp[1 * 33]); o.y = cvtpk(sp[2 * 33], sp[3 * 33]); o.z = cvtpk(sp[4 * 33], sp[5 * 33]); o.w = cvtpk(sp[6 * 33], sp[7 * 33]);
        bf16_t* row = WBP + ((size_t)((pair * 8 + (d >> 7)) * 256 + bj * 128 + (d & 127))) * 512 + k0 + 8 * c;
        *(u32x4*)(row + 256 * bj) = o; *(u32x4*)(row + 256 * (1 - bj)) = zero; }
    asm volatile("s_waitcnt lgkmcnt(0)" ::: "memory");
}

#define MFMA32(a, b, c) __builtin_amdgcn_mfma_f32_32x32x16_bf16((a), (b), (c), 0, 0, 0)
__device__ __forceinline__ bf16x8 ld16(const bf16_t* p) { return *(const bf16x8*)p; }
__device__ __forceinline__ bf16x8 pack8(const f32x16& s, int b) { u32x4 w; w.x = cvtpk(s[b], s[b + 1]); w.y = cvtpk(s[b + 2], s[b + 3]); w.z = cvtpk(s[b + 4], s[b + 5]); w.w = cvtpk(s[b + 6], s[b + 7]); return __builtin_bit_cast(bf16x8, w); }
__device__ __forceinline__ int crow(int r, int hi) { return (r & 3) + 8 * (r >> 2) + 4 * hi; }
__device__ __forceinline__ void store_o(bf16_t* orow, const f32x16& o0, const f32x16& o1, int hi) {
#pragma unroll
    for (int g = 0; g < 4; ++g) {
        u32x2 a; a.x = cvtpk(o0[4 * g], o0[4 * g + 1]); a.y = cvtpk(o0[4 * g + 2], o0[4 * g + 3]); *(u32x2*)(orow + 8 * g + 4 * hi) = a;
        u32x2 b; b.x = cvtpk(o1[4 * g], o1[4 * g + 1]); b.y = cvtpk(o1[4 * g + 2], o1[4 * g + 3]); *(u32x2*)(orow + 32 + 8 * g + 4 * hi) = b; }
}

struct KFrag { bf16x8 k[4]; };
struct VFrag { bf16x8 v[4]; };
__device__ __forceinline__ void k_load(KFrag& f, const bf16_t* Kh, int kb, int lane) {
    const bf16_t* kp = Kh + (size_t)kb * 2048 + lane * 8;
#pragma unroll
    for (int ds = 0; ds < 4; ++ds) f.k[ds] = ld16(kp + ds * 512);
}
__device__ __forceinline__ void v_load(VFrag& f, const bf16_t* Vh, int kb, int lane) {
    const bf16_t* vp = Vh + (size_t)kb * 2048 + lane * 8;
    f.v[0] = ld16(vp); f.v[1] = ld16(vp + 512); f.v[2] = ld16(vp + 1024); f.v[3] = ld16(vp + 1536);
}
__device__ __forceinline__ void q_load(bf16x8 (&qf)[4], const bf16_t* Qs, int qb, int r32, int hi) {
    const bf16_t* qp = Qs + (size_t)(qb * 32 + r32) * LDQK + hi * 8;
#pragma unroll
    for (int ds = 0; ds < 4; ++ds) qf[ds] = ld16(qp + ds * 16);
}

template <int MODE, bool MASK, int NDS>
__device__ __forceinline__ void sm_step(const bf16x8 (&ck)[NDS], const bf16x8 (&qf)[NDS], const VFrag& cv, float slope2, const LAS float* cl, int kb, int d0,
                                        float& m, float& l, f32x16& o0, f32x16& o1, int hi) {
    constexpr float SC2 = ((MODE == 2) ? 0.17677669529663687f : 0.125f) * LOG2E;
    f32x16 s;
#pragma unroll
    for (int i = 0; i < 16; ++i) s[i] = 0.f;
#pragma unroll
    for (int ds = 0; ds < NDS; ++ds) s = MFMA32(ck[ds], qf[ds], s);
#define KC(r) (((r) & 3) + 8 * ((r) >> 2))
    int dh = d0 - 4 * hi; asm volatile("" : "+v"(dh));
    float sl = slope2; asm volatile("" : "+v"(sl));
    const LAS float* clk = cl + 33 * kb + 4 * hi; if (MODE == 0) asm volatile("" : "+v"(clk));
    const float base = (MODE == 0) ? 0.f : -sl * (float)dh;
#pragma unroll
    for (int r = 0; r < 16; ++r) {
        float v = (MODE == 0) ? fmaf(s[r], SC2, clk[KC(r)]) : fmaf(s[r], SC2, sl * (float)KC(r));
        if (MASK) { const int dist = dh - KC(r); const bool valid = (MODE == 1) ? ((unsigned)dist <= 128u) : (dist >= 0); v = valid ? v : -INFINITY; }
        s[r] = v;
    }
#undef KC
    float mt = fmaxf(fmaxf(s[0], s[1]), fmaxf(s[2], s[3]));
#pragma unroll
    for (int r = 4; r < 16; r += 4) mt = fmaxf(mt, fmaxf(fmaxf(s[r], s[r + 1]), fmaxf(s[r + 2], s[r + 3])));
    mt = x32_max(mt + base);
    const float mn = fmaxf(m, mt), alpha = ex2(m - mn), c = mn - base;
    float ps = 0.f;
#pragma unroll
    for (int r = 0; r < 16; ++r) { const float p = ex2(s[r] - c); s[r] = p; ps += p; }
    l = l * alpha + ps; m = mn;
#pragma unroll
    for (int i = 0; i < 16; ++i) { o0[i] *= alpha; o1[i] *= alpha; }
    const bf16x8 pf0 = pack8(s, 0), pf1 = pack8(s, 8);
    o0 = MFMA32(cv.v[0], pf0, o0); o0 = MFMA32(cv.v[1], pf1, o0); o1 = MFMA32(cv.v[2], pf0, o1); o1 = MFMA32(cv.v[3], pf1, o1);
}
template <int MODE>
__device__ __forceinline__ void sm_unit(const bf16_t* Qs, const bf16_t* Ks, const bf16_t* VTs, int qb, int kb_hi, int kb_lo, float slope2, const LAS float* cl,
                                        f32x16& o0, f32x16& o1, float& m_out, float& l_out, int lane) {
    const int r32 = lane & 31, hi = lane >> 5;
    constexpr int NDS = (MODE == 2) ? 2 : 4;
    bf16x8 qf[NDS];
    { const bf16_t* qp = Qs + (size_t)(qb * 32 + r32) * LDQK + hi * 8;
#pragma unroll
      for (int ds = 0; ds < NDS; ++ds) qf[ds] = ld16(qp + ds * 16); }
    bf16x8 nk[NDS];
    { const bf16_t* kp = Ks + (size_t)kb_hi * 2048 + lane * 8;
#pragma unroll
      for (int ds = 0; ds < NDS; ++ds) nk[ds] = ld16(kp + ds * 512); }
    float m = -INFINITY, l = 0.f;
#pragma unroll
    for (int i = 0; i < 16; ++i) { o0[i] = 0.f; o1[i] = 0.f; }
    for (int kb = kb_hi; kb >= kb_lo; --kb) {
        bf16x8 ck[NDS];
#pragma unroll
        for (int ds = 0; ds < NDS; ++ds) ck[ds] = nk[ds];
        VFrag cv; v_load(cv, VTs, kb, lane);
        if (kb > kb_lo) { const bf16_t* kp = Ks + (size_t)(kb - 1) * 2048 + lane * 8;
#pragma unroll
            for (int ds = 0; ds < NDS; ++ds) nk[ds] = ld16(kp + ds * 512); }
        const int d0 = (qb - kb) * 32 + r32;
        const bool edge = (MODE == 1) ? (kb == qb || kb + 4 <= qb) : (kb == qb);
        if (edge) sm_step<MODE, true, NDS>(ck, qf, cv, slope2, cl, kb, d0, m, l, o0, o1, hi);
        else      sm_step<MODE, false, NDS>(ck, qf, cv, slope2, cl, kb, d0, m, l, o0, o1, hi);
    }
    l = x32_sum(l);
    m_out = m; l_out = l;
}

template <int MODE>
__device__ __forceinline__ void sm_unit64(const bf16_t* Qs, const bf16_t* Ks, const bf16_t* VTs, int Q, int kb_hi, int kb_lo, float slope2, const LAS float* cl,
                                          f32x16 (&o)[2][2], float (&m)[2], float (&l)[2], int lane) {
    const int r32 = lane & 31, hi = lane >> 5;
    constexpr int NDS = (MODE == 2) ? 2 : 4;
    bf16x8 qf[2][NDS];
#pragma unroll
    for (int i = 0; i < 2; ++i) { const bf16_t* qp = Qs + (size_t)((2 * Q + i) * 32 + r32) * LDQK + hi * 8;
#pragma unroll
        for (int ds = 0; ds < NDS; ++ds) qf[i][ds] = ld16(qp + ds * 16); }
    bf16x8 nk[NDS];
    { const bf16_t* kp = Ks + (size_t)kb_hi * 2048 + lane * 8;
#pragma unroll
      for (int ds = 0; ds < NDS; ++ds) nk[ds] = ld16(kp + ds * 512); }
#pragma unroll
    for (int i = 0; i < 2; ++i) { m[i] = -INFINITY; l[i] = 0.f;
#pragma unroll
        for (int k = 0; k < 16; ++k) { o[i][0][k] = 0.f; o[i][1][k] = 0.f; } }
    for (int kb = kb_hi; kb >= kb_lo; --kb) {
        bf16x8 ck[NDS];
#pragma unroll
        for (int ds = 0; ds < NDS; ++ds) ck[ds] = nk[ds];
        VFrag cv; v_load(cv, VTs, kb, lane);
        if (kb > kb_lo) { const bf16_t* kp = Ks + (size_t)(kb - 1) * 2048 + lane * 8;
#pragma unroll
            for (int ds = 0; ds < NDS; ++ds) nk[ds] = ld16(kp + ds * 512); }
        if (kb < 2 * Q) {
            const int d00 = (2 * Q - kb) * 32 + r32;
            sm_step<MODE, false, NDS>(ck, qf[0], cv, slope2, cl, kb, d00, m[0], l[0], o[0][0], o[0][1], hi);
            sm_step<MODE, false, NDS>(ck, qf[1], cv, slope2, cl, kb, d00 + 32, m[1], l[1], o[1][0], o[1][1], hi);
        } else {
#pragma unroll
            for (int i = 0; i < 2; ++i) {
                const int qbi = 2 * Q + i;
                if (kb <= qbi) {
                    const int d0 = (qbi - kb) * 32 + r32;
                    if (kb == qbi) sm_step<MODE, true, NDS>(ck, qf[i], cv, slope2, cl, kb, d0, m[i], l[i], o[i][0], o[i][1], hi);
                    else           sm_step<MODE, false, NDS>(ck, qf[i], cv, slope2, cl, kb, d0, m[i], l[i], o[i][0], o[i][1], hi);
                }
            }
        }
    }
    l[0] = x32_sum(l[0]); l[1] = x32_sum(l[1]);
}

__device__ __forceinline__ void sb_unit(const bf16_t* Qs, const bf16_t* Ks, const bf16_t* VTs, int qb, f32x16& o0, f32x16& o1, int lane) {
    const int r32 = lane & 31, hi = lane >> 5;
    constexpr float SC2 = 0.125f * LOG2E;
    bf16x8 qf[4]; q_load(qf, Qs, qb, r32, hi);
    KFrag nx; k_load(nx, Ks, qb, lane);
    float R = 0.f;
#pragma unroll
    for (int i = 0; i < 16; ++i) { o0[i] = 0.f; o1[i] = 0.f; }
    for (int kb = qb; kb >= 0; --kb) {
        const KFrag cu = nx; VFrag cv; v_load(cv, VTs, kb, lane);
        if (kb > 0) k_load(nx, Ks, kb - 1, lane);
        f32x16 s;
#pragma unroll
        for (int i = 0; i < 16; ++i) s[i] = 0.f;
#pragma unroll
        for (int ds = 0; ds < 4; ++ds) s = MFMA32(cu.k[ds], qf[ds], s);
        float lk[16], ls[16];
        const int d0 = (qb - kb) * 32 + r32;
#pragma unroll
        for (int r = 0; r < 16; ++r) { const float z2 = s[r] * SC2; const float sp = fmaxf(z2, 0.f) + lg2(1.0f + ex2(-fabsf(z2))); const bool valid = crow(r, hi) < d0; lk[r] = valid ? -sp : 0.f; ls[r] = valid ? (z2 - sp) : -INFINITY; }
        float e[16], tq[4], pq[4];
#pragma unroll
        for (int g = 0; g < 4; ++g) { e[4 * g + 3] = 0.f; e[4 * g + 2] = lk[4 * g + 3]; e[4 * g + 1] = e[4 * g + 2] + lk[4 * g + 2]; e[4 * g] = e[4 * g + 1] + lk[4 * g + 1]; tq[g] = e[4 * g] + lk[4 * g]; }
#pragma unroll
        for (int g = 0; g < 4; ++g) pq[g] = x32_partner(tq[g], hi);
        float cs[4]; cs[3] = 0.f; cs[2] = tq[3] + pq[3]; cs[1] = cs[2] + (tq[2] + pq[2]); cs[0] = cs[1] + (tq[1] + pq[1]);
        const float total = cs[0] + (tq[0] + pq[0]);
#pragma unroll
        for (int g = 0; g < 4; ++g) { const float later = R + cs[g] + (hi == 0 ? pq[g] : 0.f);
#pragma unroll
            for (int i = 0; i < 4; ++i) s[4 * g + i] = ex2(ls[4 * g + i] + e[4 * g + i] + later); }
        R += total;
        const bf16x8 pf0 = pack8(s, 0), pf1 = pack8(s, 8);
        o0 = MFMA32(cv.v[0], pf0, o0); o0 = MFMA32(cv.v[1], pf1, o0); o1 = MFMA32(cv.v[2], pf0, o1); o1 = MFMA32(cv.v[3], pf1, o1);
        if (__all(R < -150.0f)) break;
    }
}

#define XB_TMO      128
#define XB_XCNT(j)  (256  + 64 * (j))
#define XB_XSUB(j)  (1280 + 64 * (j))
#define XB_XGEN(j)  (2304 + 64 * (j))
#define XB_TOP      3328
#define XB_TOPGEN   3392
#define XCD_BAR_WORDS 3456
#define XB_SPIN_CAP (1u << 18)
__device__ __forceinline__ unsigned xb_ld(unsigned* p)              { return __hip_atomic_load(p, __ATOMIC_RELAXED, __HIP_MEMORY_SCOPE_AGENT); }
__device__ __forceinline__ unsigned xb_add(unsigned* p, unsigned v) { return __hip_atomic_fetch_add(p, v, __ATOMIC_RELAXED, __HIP_MEMORY_SCOPE_AGENT); }
__device__ __forceinline__ unsigned xb_xcc_id() { return (unsigned)__builtin_amdgcn_s_getreg((3 << 11) | 20) & 0xFu; }
#define XB_SPIN(cond, bar) do { unsigned _sp = 0; while (cond) { __builtin_amdgcn_s_sleep(1); \
    if ((++_sp & 255u) == 0u) { if (xb_ld(&(bar)[XB_TMO])) break; if (_sp > XB_SPIN_CAP) { atomicAdd(&(bar)[XB_TMO], 1u); break; } } } } while (0)
__device__ __forceinline__ void xcd_barrier_complete(unsigned* bar, unsigned x, unsigned& nloc, unsigned& nx) {
    const unsigned G = gridDim.x * gridDim.y * gridDim.z;
    unsigned sum, cnt, mine, sp = 0u;
    for (;;) {
        sum = 0u; cnt = 0u; mine = 0u;
#pragma unroll
        for (unsigned j = 0; j < 16; ++j) { const unsigned c = xb_ld(&bar[XB_XCNT(j)]); sum += c; cnt += (c > 0u) ? 1u : 0u; mine = (j == x) ? c : mine; }
        if (sum == G) break;
        __builtin_amdgcn_s_sleep(1);
        if ((++sp & 255u) == 0u) { if (xb_ld(&bar[XB_TMO])) break; if (sp > XB_SPIN_CAP) { atomicAdd(&bar[XB_TMO], 1u); break; } }
    }
    nloc = mine > 0u ? mine : 1u; nx = cnt > 0u ? cnt : 1u;
}
__device__ __forceinline__ void xcd_barrier(unsigned* bar, volatile LAS unsigned* st) {
    asm volatile("s_waitcnt vmcnt(0)" ::: "memory");
    __syncthreads();
    if (threadIdx.x == 0) {
        const unsigned x = xb_xcc_id();
        __builtin_amdgcn_s_waitcnt(0);
        unsigned nloc = st[0], nx = st[1];
        if (nloc == 0u) { xcd_barrier_complete(bar, x, nloc, nx); st[0] = nloc; st[1] = nx; }
        const unsigned old = xb_add(&bar[XB_XSUB(x)], 1u);
        const unsigned gen = old / nloc;
        if (old + 1u == (gen + 1u) * nloc) {
            __builtin_amdgcn_fence(__ATOMIC_RELEASE, "agent");
            asm volatile("s_waitcnt vmcnt(0)" ::: "memory");
            const unsigned og = xb_add(&bar[XB_TOP], 1u);
            const unsigned tg = og / nx;
            if (og + 1u == (tg + 1u) * nx) xb_add(&bar[XB_TOPGEN], 1u);
            else XB_SPIN(xb_ld(&bar[XB_TOPGEN]) == tg, bar);
            __builtin_amdgcn_fence(__ATOMIC_ACQUIRE, "agent");
            xb_add(&bar[XB_XGEN(x)], 1u);
            asm volatile("s_waitcnt vmcnt(0)" ::: "memory");
        } else {
            XB_SPIN(xb_ld(&bar[XB_XGEN(x)]) == gen, bar);
            __builtin_amdgcn_fence(__ATOMIC_ACQUIRE, "agent");
            asm volatile("s_waitcnt vmcnt(0)" ::: "memory");
        }
    }
    __syncthreads();
}
constexpr int MISC_OFF = 131072 + 320;

struct Params {
    const float* x; const float* mix_g; const float* w_in; const float* b_forget; const float* lq1; const float* lk1; const float* lq2; const float* lk2;
    const float* diff_g; const float* w_branch; const float* w_out; const float* mlp_g; const float* w_up; const float* w_down; const float* final_g;
    float* out; unsigned char* ws;
};

#ifndef REP_P1
#define REP_P1 1
#endif
#ifndef REP_P2
#define REP_P2 1
#endif
#ifndef REP_P3
#define REP_P3 1
#endif
#ifndef REP_P5
#define REP_P5 1
#endif
#ifndef REP_SYNC
#define REP_SYNC 1
#endif
#ifndef REP_CONV
#define REP_CONV 1
#endif
#define GSYNC() do { for (int rs_ = 0; rs_ < REP_SYNC; ++rs_) { KParamsPtr pb_ = OPQ_PP(); xcd_barrier((unsigned*)(pb_->ws + WS_CTL) + CW_BAR, (volatile LAS unsigned*)(lds + MISC_OFF)); } } while (0)
#define OPQ_TID() ({ int t_ = threadIdx.x; asm volatile("" : "+v"(t_)); t_; })
typedef const __attribute__((address_space(4))) Params* KParamsPtr;
#define OPQ_PP() ({ KParamsPtr p_ = (KParamsPtr)__builtin_amdgcn_kernarg_segment_ptr(); asm volatile("" : "+s"(p_)); p_; })
#define PHASE_VARS() const int tid = OPQ_TID(); const int lane = tid & 63, wave = __builtin_amdgcn_readfirstlane(tid >> 6); const int G = gridDim.x, bx = blockIdx.x; \
    const int gw = bx * NWAVES + wave, NGW = G * NWAVES; KParamsPtr PP = OPQ_PP(); unsigned char* ws = PP->ws; LAS float* scr = (LAS float*)(lds + wave * 16384); (void)lane; (void)gw; (void)NGW; (void)ws; (void)scr; (void)G; (void)bx; (void)PP

__global__ void __launch_bounds__(NWAVES * 64, 2) fwd_mega(Params P) {
    extern __shared__ __attribute__((aligned(16))) unsigned char lds_raw[];
    LAS unsigned char* lds = (LAS unsigned char*)lds_raw;
    cg::grid_group grid = cg::this_grid();
    { KParamsPtr pz = OPQ_PP(); if (pz->ws == nullptr) grid.sync(); }
    { const int t0 = OPQ_TID(); if (t0 < 64) ((LAS unsigned*)(lds + 131072))[t0 + 64] = 0u; __syncthreads();
      if (t0 == 0) { KParamsPtr p0 = OPQ_PP(); (void)xb_add((unsigned*)(p0->ws + WS_CTL) + CW_BAR + XB_XCNT(xb_xcc_id()), 1u); } }

    {
        PHASE_VARS();
        bf16_t* XB = (bf16_t*)(ws + WS_XB); float* SSQ = (float*)(ws + WS_SSQ);
        for (int row = gw; row < TOK; row += NGW) {
            const f32x4* xr = (const f32x4*)(PP->x + (size_t)row * DM) + lane;
            unsigned long long* o8 = (unsigned long long*)(XB + (size_t)row * DM) + lane;
            float s = 0.f;
#pragma unroll
            for (int j = 0; j < 4; ++j) { const f32x4 v = xr[64 * j]; s += (v[0] * v[0] + v[1] * v[1]) + (v[2] * v[2] + v[3] * v[3]);
                o8[64 * j] = (unsigned long long)cvtpk(v[0], v[1]) | ((unsigned long long)cvtpk(v[2], v[3]) << 32); }
            s = wave_sum(s);
            if (lane < 16) SSQ[(size_t)row * 16 + lane] = (lane == 0) ? s : 0.f;
        }
    }

    for (int layer = 0; layer < DEPTH; ++layer) {
        for (int rep = 0; rep < REP_CONV; ++rep) {
            PHASE_VARS();
            bf16_t* WIN = (bf16_t*)(ws + WS_WIN); bf16_t* WB = (bf16_t*)(ws + WS_WB); bf16_t* WOUT = (bf16_t*)(ws + WS_WOUT);
            const float* w_in = PP->w_in + (size_t)layer * DM * DIN; const float* mg = PP->mix_g + (size_t)layer * DM;
            const float* wb = PP->w_branch + (size_t)layer * 4 * 256 * DM; const float* wo = PP->w_out + (size_t)layer * DM * DM;
            constexpr int I_IN = (DM / 64) * (NPROJ / 32), I_B = (256 / 64) * (DM / 32), I_O = (DM / 64) * (DM / 32);
            for (int it = gw; it < I_IN + 4 * I_B + I_O; it += NGW) {
                int r = it;
                if (r < I_IN) { transpose_item<1>(w_in, DM, NPROJ, DIN, mg, WIN, scr, r, lane); continue; } r -= I_IN;
                if (r < 4 * I_B) { const int n = r / I_B; branch_item(wb + (size_t)n * 256 * DM, n, WB, scr, r % I_B, lane); continue; } r -= 4 * I_B;
                transpose_item<0>(wo, DM, DM, DM, nullptr, WOUT, scr, r, lane);
            }
        }
        GSYNC();

        for (int half = 0; half < 2; ++half) {
#ifndef NO_P1
            for (int rep = 0; rep < REP_P1; ++rep) {
                PHASE_VARS();
                const int rb = half * HT;
                pg8::Gemm g{(const bf16_t*)(ws + WS_XB) + (size_t)rb * DM, (const bf16_t*)(ws + WS_WIN), DM, DM, DM, 0, 0};
                pg8::StaticOrder S; S.init(HT, NPROJ, G, bx, WGM_P1);
                pg8::EpiProj E{(const float*)(ws + WS_SSQ), rb, (bf16_t*)(ws + WS_QK), (bf16_t*)(ws + WS_KF), (bf16_t*)(ws + WS_VT), (float*)(ws + WS_FL), (bf16_t*)(ws + WS_GATE)};
                pg8::gemm_phase<pg8::EpiProj, pg8::StaticOrder, true>(lds, g, S, E);
            }
#endif
            GSYNC();
#ifndef NO_P2
            for (int rep = 0; rep < REP_P2; ++rep) {
                PHASE_VARS();
                unsigned* ctr = (unsigned*)(ws + WS_CTL) + 64 + 512 * (layer * 2 + half + 4 * rep);
                const int xq = bx & 7;
                ctr += 64 * xq;
                for (;;) {
                    int li = 0; if (lane == 0) li = (int)atomicAdd(ctr, 1u); li = __builtin_amdgcn_readfirstlane(li);
                    if (li >= 800) break;
                    int idx;
                    if (li < 288) { const int row = li / 6, hl = li - row * 6; idx = row * 48 + (xq + 8 * hl); }
                    else if (li < 416) { const int i = li - 288; idx = 2304 + ((63 - (i & 63)) << 4) + (xq + 8 * (i >> 6)); }
                    else { const int i = li - 416; idx = 3328 + (xq + 8 * (i >> 6)) * 64 + (i & 63); }
                    int lane_u = lane; asm volatile("" : "+v"(lane_u));
                    const int lane = lane_u, r32 = lane & 31, hi = lane >> 5;
                    KParamsPtr PU = OPQ_PP(); unsigned char* wsu = PU->ws;
                    bf16_t* YS = (bf16_t*)(wsu + WS_YS); bf16_t* DILO = (bf16_t*)(wsu + WS_DILO); float* LSE = (float*)(wsu + WS_LSE); const float* FL = (const float*)(wsu + WS_FL);
                    const bf16_t* QK = (const bf16_t*)(wsu + WS_QK); const bf16_t* KF = (const bf16_t*)(wsu + WS_KF); const bf16_t* VT = (const bf16_t*)(wsu + WS_VT);
                    if (idx < 2304) {
                        const int j = idx / 48, e = idx - j * 48, type3 = e >> 4, bh = e & 15, b = bh >> 2, h = bh & 3;
                        int Q, chunk; if (j < 32) { Q = 31 - (j >> 1); chunk = j & 1; } else { Q = 47 - j; chunk = 0; }
                        int kb_lo = 0, kb_hi = 2 * Q + 1;
                        if (Q >= 16) { if (chunk == 0) kb_hi = Q; else kb_lo = Q + 1; }
                        const size_t rowb = (size_t)b * SEQ;
                        bf16_t* SCRB = (bf16_t*)(wsu + WS_MERGED) + (size_t)(half * HT) * DM;
                        float* LSE2 = (float*)(wsu + WS_LSE2);
                        f32x16 o[2][2]; float m[2], l[2]; int slot;
                        if (type3 == 2) {
                            LAS float* cl = scr;
                            const float bf = PP->b_forget[layer * 4 + h];
                            float run = 0.f;
                            if (lane <= kb_hi) {
                                const float* fp = FL + (rowb + 32 * lane) * 4 + h;
#pragma unroll 8
                                for (int i = 0; i < 32; ++i) { const float y = fp[4 * i] + bf; const float lf = fminf(y, 0.f) - __logf(1.0f + __expf(-fabsf(y))); run += lf; cl[33 * lane + i] = run; }
                            }
                            float incl = run;
#pragma unroll
                            for (int o_ = 1; o_ < 64; o_ <<= 1) { const float tt = __uint_as_float((unsigned)__builtin_amdgcn_ds_bpermute((lane - o_) << 2, (int)__float_as_uint(incl))); if (lane >= o_) incl += tt; }
                            const float excl = incl - run;
                            if (lane <= kb_hi) {
#pragma unroll 8
                                for (int i = 0; i < 32; ++i) cl[33 * lane + i] = -(cl[33 * lane + i] + excl) * LOG2E;
                            }
                            asm volatile("s_waitcnt lgkmcnt(0)" ::: "memory");
                            sm_unit64<0>(QK + rowb * LDQK + 4 * 256 + h * 64, KF + (size_t)(b * 24 + 16 + h) * HSEQ, VT + (size_t)(b * 24 + 16 + h) * HSEQ, Q, kb_hi, kb_lo, 0.f, cl, o, m, l, lane);
                            asm volatile("s_waitcnt lgkmcnt(0)" ::: "memory");
                            slot = chunk;
                        } else {
                            const float slope = exp2f(-8.0f * (float)(5 + h) / 16.0f);
                            sm_unit64<2>(QK + rowb * LDQK + 5 * 256 + h * 64 + type3 * 32, KF + (size_t)(b * 24 + 20 + h) * HSEQ + type3 * 1024, VT + (size_t)(b * 24 + 20 + h) * HSEQ, Q, kb_hi, kb_lo, slope * LOG2E, nullptr, o, m, l, lane);
                            slot = 2 + 2 * type3 + chunk;
                        }
#pragma unroll
                        for (int i = 0; i < 2; ++i) {
                            const int t = (2 * Q + i) * 32 + r32;
                            bf16_t* dst;
                            if (type3 == 2) dst = chunk ? SCRB + (rowb + t) * 256 + h * 64 : YS + (rowb + t) * DM + 512 + h * 64;
                            else dst = (type3 == 0 && chunk == 0) ? YS + (rowb + t) * DM + 768 + h * 64 : SCRB + (size_t)(2 * type3 + chunk) * HT * 256 + (rowb + t) * 256 + h * 64;
                            const float inv = 1.0f / l[i];
#pragma unroll
                            for (int k = 0; k < 16; ++k) { o[i][0][k] *= inv; o[i][1][k] *= inv; }
                            store_o(dst, o[i][0], o[i][1], hi);
                            if (hi == 0) LSE2[(rowb + t) * 24 + h * 6 + slot] = m[i] + lg2(l[i]);
                        }
                    } else if (idx < 3328) {
                        const int i1 = idx - 2304, qb = 63 - (i1 >> 4), bh = i1 & 15, b = bh >> 2, h = bh & 3;
                        const size_t rowb = (size_t)b * SEQ; const int t = qb * 32 + r32;
                        f32x16 o0, o1;
                        sb_unit(QK + rowb * LDQK + 0 * 256 + h * 64, KF + (size_t)(b * 24 + h) * HSEQ, VT + (size_t)(b * 24 + h) * HSEQ, qb, o0, o1, lane);
                        store_o(YS + (rowb + t) * DM + 0 * 256 + h * 64, o0, o1, hi);
                    } else {
                        const int i2 = idx - 3328, j = i2 & 63, gh = (i2 >> 6) % 12, b = i2 / 768, gI = gh >> 2, h = gh & 3;
                        const int rsh = 2 * gI, r = 1 << rsh, sl = SEQ >> rsh, nubsh = 6 - rsh, rho = j >> nubsh, ub = j & ((1 << nubsh) - 1);
                        const int sidx = (gI == 0) ? h : (gI == 1 ? 8 + h : 12 + h);
                        const float slope = exp2f(-8.0f * (float)(sidx + 1) / 16.0f);
                        const size_t rowb = (size_t)b * SEQ + (size_t)rho * sl;
                        f32x16 o0, o1; float m, l;
                        const int kb_lo = (ub - 4 > 0) ? ub - 4 : 0;
                        sm_unit<1>(QK + rowb * LDQK + (1 + gI) * 256 + h * 64, KF + (size_t)(b * 24 + 4 + 4 * gI + h) * HSEQ + (size_t)rho * sl * 64,
                                   VT + (size_t)(b * 24 + 4 + 4 * gI + h) * HSEQ + (size_t)rho * sl * 64, ub, ub, kb_lo, slope * (float)r * LOG2E, nullptr, o0, o1, m, l, lane);
                        const float inv = 1.0f / l;
#pragma unroll
                        for (int i = 0; i < 16; ++i) { o0[i] *= inv; o1[i] *= inv; }
                        const int u = ub * 32 + r32; const size_t tok = (size_t)b * SEQ + (size_t)u * r + rho;
                        store_o(DILO + tok * 768 + gI * 256 + h * 64, o0, o1, hi);
                        if (hi == 0) LSE[tok * 12 + gI * 4 + h] = (m + lg2(l)) * LN2;
                    }
                }
            }
#endif
            GSYNC();
            {
                PHASE_VARS();
                const float lam_init = (layer == 0) ? 0.2f : 0.35550906759093115f;
                float lam;
                { const float a = (lane < 32) ? PP->lq1[layer * 32 + lane] * PP->lk1[layer * 32 + lane] : 0.f, b = (lane < 32) ? PP->lq2[layer * 32 + lane] * PP->lk2[layer * 32 + lane] : 0.f;
                  lam = __expf(wave_sum(a)) - __expf(wave_sum(b)) + lam_init; }
                bf16_t* YS = (bf16_t*)(ws + WS_YS); const bf16_t* DILO = (const bf16_t*)(ws + WS_DILO); const float* LSE = (const float*)(ws + WS_LSE);
                const bf16_t* SCRB = (const bf16_t*)(ws + WS_MERGED) + (size_t)(half * HT) * DM; const float* LSE2 = (const float*)(ws + WS_LSE2);
                const int h = lane >> 4, dq = (lane & 15) * 4;
                const f32x4 dgv = *(const f32x4*)(PP->diff_g + layer * 64 + dq);
                for (int row = gw; row < HT; row += NGW) {
                    const bool split = ((row & (SEQ - 1)) >> 5) >= 32;
                    {
                        const float l0 = LSE[(size_t)row * 12 + h], l1 = LSE[(size_t)row * 12 + 4 + h], l2 = LSE[(size_t)row * 12 + 8 + h];
                        const float mx = fmaxf(l0, fmaxf(l1, l2)); const float e0 = __expf(l0 - mx), e1 = __expf(l1 - mx), e2 = __expf(l2 - mx); const float inv = 1.0f / (e0 + e1 + e2);
                        const u32x2 a = *(const u32x2*)(DILO + (size_t)row * 768 + 4 * lane), b = *(const u32x2*)(DILO + (size_t)row * 768 + 256 + 4 * lane), c = *(const u32x2*)(DILO + (size_t)row * 768 + 512 + 4 * lane);
                        const float w0 = e0 * inv, w1 = e1 * inv, w2 = e2 * inv;
                        u32x2 o; o.x = cvtpk(w0 * bflo(a.x) + w1 * bflo(b.x) + w2 * bflo(c.x), w0 * bfhi(a.x) + w1 * bfhi(b.x) + w2 * bfhi(c.x));
                        o.y = cvtpk(w0 * bflo(a.y) + w1 * bflo(b.y) + w2 * bflo(c.y), w0 * bfhi(a.y) + w1 * bfhi(b.y) + w2 * bfhi(c.y));
                        *(u32x2*)(YS + (size_t)row * DM + 256 + 4 * lane) = o;
                    }
                    const float* ls = LSE2 + (size_t)row * 24 + h * 6;
                    const u32x2 f0 = *(const u32x2*)(YS + (size_t)row * DM + 512 + 4 * lane), a0 = *(const u32x2*)(YS + (size_t)row * DM + 768 + 4 * lane);
                    const u32x2 b0 = *(const u32x2*)(SCRB + (size_t)2 * HT * 256 + (size_t)row * 256 + 4 * lane);
                    float fv[4] = {bflo(f0.x), bfhi(f0.x), bflo(f0.y), bfhi(f0.y)}, av[4] = {bflo(a0.x), bfhi(a0.x), bflo(a0.y), bfhi(a0.y)}, bv[4] = {bflo(b0.x), bfhi(b0.x), bflo(b0.y), bfhi(b0.y)};
                    if (split) {
                        const u32x2 f1 = *(const u32x2*)(SCRB + (size_t)row * 256 + 4 * lane), a1 = *(const u32x2*)(SCRB + (size_t)1 * HT * 256 + (size_t)row * 256 + 4 * lane), b1 = *(const u32x2*)(SCRB + (size_t)3 * HT * 256 + (size_t)row * 256 + 4 * lane);
                        const float lf0 = ls[0], lf1 = ls[1], la0 = ls[2], la1 = ls[3], lb0 = ls[4], lb1 = ls[5];
                        { const float mx = fmaxf(lf0, lf1), e0 = ex2(lf0 - mx), e1 = ex2(lf1 - mx), inv = 1.0f / (e0 + e1), w0 = e0 * inv, w1 = e1 * inv;
                          fv[0] = w0 * fv[0] + w1 * bflo(f1.x); fv[1] = w0 * fv[1] + w1 * bfhi(f1.x); fv[2] = w0 * fv[2] + w1 * bflo(f1.y); fv[3] = w0 * fv[3] + w1 * bfhi(f1.y); }
                        { const float mx = fmaxf(la0, la1), e0 = ex2(la0 - mx), e1 = ex2(la1 - mx), inv = 1.0f / (e0 + e1), w0 = e0 * inv, w1 = e1 * inv;
                          av[0] = w0 * av[0] + w1 * bflo(a1.x); av[1] = w0 * av[1] + w1 * bfhi(a1.x); av[2] = w0 * av[2] + w1 * bflo(a1.y); av[3] = w0 * av[3] + w1 * bfhi(a1.y); }
                        { const float mx = fmaxf(lb0, lb1), e0 = ex2(lb0 - mx), e1 = ex2(lb1 - mx), inv = 1.0f / (e0 + e1), w0 = e0 * inv, w1 = e1 * inv;
                          bv[0] = w0 * bv[0] + w1 * bflo(b1.x); bv[1] = w0 * bv[1] + w1 * bfhi(b1.x); bv[2] = w0 * bv[2] + w1 * bflo(b1.y); bv[3] = w0 * bv[3] + w1 * bfhi(b1.y); }
                        u32x2 fo; fo.x = cvtpk(fv[0], fv[1]); fo.y = cvtpk(fv[2], fv[3]);
                        *(u32x2*)(YS + (size_t)row * DM + 512 + 4 * lane) = fo;
                    }
                    float dv[4]; float ss = 0.f;
#pragma unroll
                    for (int i = 0; i < 4; ++i) { dv[i] = av[i] - lam * bv[i]; ss += dv[i] * dv[i]; }
                    ss += swz_xor<1>(ss); ss += swz_xor<2>(ss); ss += swz_xor<4>(ss); ss += swz_xor<8>(ss);
                    const float rn = __builtin_amdgcn_rsqf(ss * (1.0f / 64.0f) + RMS_EPS) * (1.0f - lam_init);
                    u32x2 dout; dout.x = cvtpk(dv[0] * rn * dgv[0], dv[1] * rn * dgv[1]); dout.y = cvtpk(dv[2] * rn * dgv[2], dv[3] * rn * dgv[3]);
                    *(u32x2*)(YS + (size_t)row * DM + 768 + 4 * lane) = dout;
                }
            }
            GSYNC();
#ifndef NO_P3
            for (int rep = 0; rep < REP_P3; ++rep) {
                PHASE_VARS();
                pg8::Gemm g{(const bf16_t*)(ws + WS_YS), (const bf16_t*)(ws + WS_WB), DM, 512, 512, 512 * 2, (long)8 * 256 * 512 * 2};
                pg8::BranchOrder S{bx, G};
                pg8::EpiBranch E{(const bf16_t*)(ws + WS_GATE), (bf16_t*)(ws + WS_MERGED), half * HT};
                pg8::gemm_phase<pg8::EpiBranch, pg8::BranchOrder, true, true>(lds, g, S, E);
            }
#endif
            GSYNC();
        }
#ifndef NO_P4
        for (int rep = 0; rep < REP_CONV; ++rep) {
            PHASE_VARS();
            bf16_t* WUP = (bf16_t*)(ws + WS_WUP); bf16_t* WDN = (bf16_t*)(ws + WS_WDN);
            const float* wu = PP->w_up + (size_t)layer * DM * DFF; const float* wd = PP->w_down + (size_t)layer * DFF * DM; const float* mg = PP->mlp_g + (size_t)layer * DM;
            constexpr int I_U = (DM / 64) * (DFF / 32), I_D = (DFF / 64) * (DM / 32);
            for (int it = gw; it < I_U + I_D; it += NGW) {
                if (it < I_U) transpose_item<0>(wu, DM, DFF, DFF, mg, WUP, scr, it, lane);
                else transpose_item<0>(wd, DFF, DM, DM, nullptr, WDN, scr, it - I_U, lane);
            }
            __syncthreads();
        }
        {
            PHASE_VARS();
            pg8::Gemm g{(const bf16_t*)(ws + WS_MERGED), (const bf16_t*)(ws + WS_WOUT), DM, DM, DM, 0, 0};
            pg8::StaticOrder S; S.init(TOK, DM, G, bx);
            pg8::EpiResid E{(layer == 0) ? PP->x : (const float*)PP->out, PP->out, (bf16_t*)(ws + WS_XB), (float*)(ws + WS_SSQ)};
            pg8::gemm_phase<pg8::EpiResid, pg8::StaticOrder, false>(lds, g, S, E);
        }
#endif
        GSYNC();
#ifndef NO_P5
        for (int rep = 0; rep < REP_P5; ++rep) {
            PHASE_VARS();
            pg8::Gemm g{(const bf16_t*)(ws + WS_XB), (const bf16_t*)(ws + WS_WUP), DM, DM, DM, 0, 0};
            pg8::StaticOrder S; S.init(TOK, DFF, G, bx, WGM_P5);
            pg8::EpiUp E{(const float*)(ws + WS_SSQ), (bf16_t*)(ws + WS_HMLP)};
            pg8::gemm_phase<pg8::EpiUp, pg8::StaticOrder, true>(lds, g, S, E);
        }
#endif
        GSYNC();
#ifndef NO_P6
        {
            PHASE_VARS();
            pg8::Gemm g{(const bf16_t*)(ws + WS_HMLP), (const bf16_t*)(ws + WS_WDN), DFF, DFF, DFF, 0, 0};
            pg8::StaticOrder S; S.init(TOK, DM, G, bx);
            if (layer == DEPTH - 1 && G == 256) {
                pg8::EpiFinal E{(const float*)PP->out, PP->out, (float*)(ws + WS_SSQ), PP->final_g, (unsigned*)(ws + WS_CTL) + CW_PANEL};
                pg8::gemm_phase<pg8::EpiFinal, pg8::StaticOrder, true>(lds, g, S, E);
            } else {
                pg8::EpiResid E{(const float*)PP->out, PP->out, (bf16_t*)(ws + WS_XB), (float*)(ws + WS_SSQ)};
                pg8::gemm_phase<pg8::EpiResid, pg8::StaticOrder, false>(lds, g, S, E);
            }
        }
#endif
        if (layer < DEPTH - 1 || gridDim.x != 256) GSYNC();
    }
    if (gridDim.x != 256)
    {
        PHASE_VARS();
        float* X = PP->out;
        for (int row = gw; row < TOK; row += NGW) {
            f32x4* xo = (f32x4*)(X + (size_t)row * DM) + lane; const f32x4* gp = (const f32x4*)PP->final_g + lane;
            f32x4 v[4]; float s = 0.f;
#pragma unroll
            for (int j = 0; j < 4; ++j) { v[j] = xo[64 * j]; s += (v[j][0] * v[j][0] + v[j][1] * v[j][1]) + (v[j][2] * v[j][2] + v[j][3] * v[j][3]); }
            const float rstd = __builtin_amdgcn_rsqf(wave_sum(s) * (1.0f / DM) + RMS_EPS);
#pragma unroll
            for (int j = 0; j < 4; ++j) xo[64 * j] = v[j] * rstd * gp[64 * j];
        }
    }
}

extern "C" void kernel_launch(void* const* d_in, const int* in_sizes, int n_in, void* d_out, int out_size, void* d_ws, size_t ws_size, hipStream_t stream) {
    static int grid = 0;
    if (grid == 0) {
        if (n_in != 15 || in_sizes[0] != TOK * DM || out_size != TOK * DM || ws_size < WS_END) { fprintf(stderr, "kernel_launch: unexpected shapes / workspace (n_in %d, ws %zu)\n", n_in, ws_size); grid = -1; return; }
        int dev = 0, cus = 0, per_cu = 0;
        hipGetDevice(&dev); hipDeviceGetAttribute(&cus, hipDeviceAttributeMultiprocessorCount, dev);
        hipFuncSetAttribute((const void*)fwd_mega, hipFuncAttributeMaxDynamicSharedMemorySize, LDS_BYTES);
        hipOccupancyMaxActiveBlocksPerMultiprocessor(&per_cu, (const void*)fwd_mega, NWAVES * 64, LDS_BYTES);
        (void)hipGetLastError();
        if (per_cu < 1) per_cu = 1;
        grid = cus;
        if (grid > 256) grid = 256;
        if (grid % 8 != 0) { fprintf(stderr, "kernel_launch: the per-XCD work queues need a grid that is a multiple of 8 (got %d)\n", grid); grid = -1; return; }
    }
    if (grid < 0) return;
    hipMemsetAsync((char*)d_ws + WS_CTL, 0, CTL_BYTES, stream);
    Params p{};
    p.x = (const float*)d_in[0]; p.mix_g = (const float*)d_in[1]; p.w_in = (const float*)d_in[2]; p.b_forget = (const float*)d_in[3];
    p.lq1 = (const float*)d_in[4]; p.lk1 = (const float*)d_in[5]; p.lq2 = (const float*)d_in[6]; p.lk2 = (const float*)d_in[7];
    p.diff_g = (const float*)d_in[8]; p.w_branch = (const float*)d_in[9]; p.w_out = (const float*)d_in[10]; p.mlp_g = (const float*)d_in[11];
    p.w_up = (const float*)d_in[12]; p.w_down = (const float*)d_in[13]; p.final_g = (const float*)d_in[14];
    p.out = (float*)d_out; p.ws = (unsigned char*)d_ws;
    void* args[] = {&p};
    hipError_t e = hipLaunchCooperativeKernel((const void*)fwd_mega, dim3(grid), dim3(NWAVES * 64), args, LDS_BYTES, stream);
    if (e != hipSuccess) fprintf(stderr, "cooperative launch failed: %s (grid %d)\n", hipGetErrorString(e), grid);
}
```

```cpp
#include <hip/hip_runtime.h>
#include <hip/hip_cooperative_groups.h>
#include <cstdio>
#include <cstdint>
namespace cg = cooperative_groups;

#define LAS __attribute__((address_space(3)))
typedef unsigned short bf16_t;
typedef short bf16x8 __attribute__((ext_vector_type(8)));
typedef float f32x4 __attribute__((ext_vector_type(4)));
typedef float f32x16 __attribute__((ext_vector_type(16)));
typedef unsigned u32x4 __attribute__((ext_vector_type(4)));
typedef unsigned u32x2 __attribute__((ext_vector_type(2)));
typedef float f32x2_t __attribute__((ext_vector_type(2)));
typedef __bf16 bf16x2_t __attribute__((ext_vector_type(2)));

constexpr int DM = 1024, BATCH = 8, SEQ = 2048, DEPTH = 2, TOK = BATCH * SEQ, DFF = 4096, DIN = 8708;
constexpr int HT = TOK / 2;
constexpr int NPROJ = 35 * 256;
constexpr int LDQK = 6 * 256;
constexpr int HSEQ = SEQ * 64;
constexpr float LOG2E = 1.4426950408889634f, LN2 = 0.6931471805599453f;
constexpr float RMS_EPS = 1e-6f;

constexpr size_t MiB = 1u << 20;
constexpr size_t WS_CTL = 0, CTL_BYTES = 65536;
constexpr int CW_BAR = 4096, CW_PANEL = 8192;
constexpr size_t WS_SSQ = 1 * MiB;
constexpr size_t WS_WIN = 2 * MiB;
constexpr size_t WS_WUP = WS_WIN, WS_WDN = WS_WIN + 8 * MiB;
constexpr size_t WS_WB = 20 * MiB;
constexpr size_t WS_WOUT = 24 * MiB;
constexpr size_t WS_XB = 26 * MiB;
constexpr size_t WS_MERGED = 58 * MiB;
constexpr size_t WS_YS = 90 * MiB;
constexpr size_t WS_DILO = 106 * MiB;
constexpr size_t WS_LSE = 118 * MiB;
constexpr size_t WS_LSE2 = 118 * MiB + 512 * 1024;
constexpr size_t WS_FL = 119 * MiB + 512 * 1024;
constexpr size_t WS_QK = 120 * MiB;
constexpr size_t WS_KF = 144 * MiB;
constexpr size_t WS_VT = 168 * MiB;
constexpr size_t WS_GATE = 192 * MiB;
constexpr size_t WS_HMLP = 120 * MiB;
constexpr size_t WS_END = 256 * MiB;

constexpr int LDS_BYTES = 147456;
constexpr int NWAVES = 8;
#ifndef WGM_P1
#define WGM_P1 4
#endif
#ifndef WGM_P5
#define WGM_P5 8
#endif

__device__ __forceinline__ unsigned cvtpk(float lo, float hi) { f32x2_t v = {lo, hi}; bf16x2_t b = __builtin_convertvector(v, bf16x2_t); return __builtin_bit_cast(unsigned, b); }
__device__ __forceinline__ float bflo(unsigned w) { return __uint_as_float(w << 16); }
__device__ __forceinline__ float bfhi(unsigned w) { return __uint_as_float(w & 0xffff0000u); }
__device__ __forceinline__ float ex2(float x) { return __builtin_amdgcn_exp2f(x); }
__device__ __forceinline__ float lg2(float x) { return __builtin_amdgcn_logf(x); }
__device__ __forceinline__ float x32_sum(float v) { auto r = __builtin_amdgcn_permlane32_swap(__float_as_uint(v), __float_as_uint(v), false, false); return __uint_as_float(r[0]) + __uint_as_float(r[1]); }
__device__ __forceinline__ float x32_max(float v) { auto r = __builtin_amdgcn_permlane32_swap(__float_as_uint(v), __float_as_uint(v), false, false); return fmaxf(__uint_as_float(r[0]), __uint_as_float(r[1])); }
__device__ __forceinline__ float x32_partner(float v, int hi) { auto r = __builtin_amdgcn_permlane32_swap(__float_as_uint(v), __float_as_uint(v), false, false); return hi ? __uint_as_float(r[0]) : __uint_as_float(r[1]); }
template <int X> __device__ __forceinline__ float swz_xor(float v) { return __uint_as_float((unsigned)__builtin_amdgcn_ds_swizzle((int)__float_as_uint(v), (X << 10) | 0x1f)); }
__device__ __forceinline__ float x16_sum(float v) { return v + swz_xor<16>(v); }
__device__ __forceinline__ float wave_sum(float v) { v += swz_xor<1>(v); v += swz_xor<2>(v); v += swz_xor<4>(v); v += swz_xor<8>(v); v += swz_xor<16>(v); return x32_sum(v); }

__device__ __forceinline__ int lane_id_hw() { return (int)__builtin_amdgcn_mbcnt_hi(~0u, __builtin_amdgcn_mbcnt_lo(~0u, 0u)); }
namespace pg8 {
constexpr int BM = 256, BK = 64, HALF = 128, HTB = HALF * BK * 2, STAGE_BYTES = 8 * HTB, NXCD = 8, WGM = 8;
__host__ __device__ __forceinline__ int lds_byte(int r, int c) { const int st = (r >> 4) * 2 + (c >> 5), rr = r & 15, cc = c & 31, ob = rr * 64 + cc * 2; return st * 1024 + (ob ^ (((ob >> 9) & 1) << 5)); }
__host__ __device__ __forceinline__ void stage_rc(int b, int& R, int& C) { const int st = b / 1024, sb = b % 1024, swz = sb ^ (((sb >> 9) & 1) << 5); R = (st >> 1) * 16 + swz / 64; C = (st & 1) * 32 + (swz % 64) / 2; }
__host__ __device__ __forceinline__ int perm32(int rho) { const int n = rho >> 4, i = rho & 15; return 8 * (i >> 2) + 4 * n + (i & 3); }

struct Unit { int pm, pn, aux; };
struct Gemm { const bf16_t* A; const bf16_t* Bt; int lda, ldb, K; long a_aux, b_aux; };

struct StaticOrder {
    int nM, nN, nwg, G, c, wgm;
    __device__ void init(int M, int N, int G_, int c_, int wgm_ = WGM) { nM = M / BM; nN = N / BM; nwg = nM * nN; G = G_; c = c_; wgm = wgm_; }
    __device__ bool next(int i, Unit& u) const {
        const long L = (long)i * G + c; if (L >= nwg) return false;
        int wgid = (int)L; { const int q = nwg / NXCD, r = nwg % NXCD, xcd = wgid % NXCD, off = wgid / NXCD; wgid = (xcd < r ? xcd * (q + 1) : r * (q + 1) + (xcd - r) * q) + off; }
        const int nig = wgm * nN, gid = wgid / nig, fm = gid * wgm, gsz = (nM - fm) < wgm ? (nM - fm) : wgm;
        u.pm = fm + ((wgid % nig) % gsz); u.pn = (wgid % nig) / gsz; u.aux = 0; return true;
    }
};
struct BranchOrder {
    int c, G;
    __device__ bool next(int i, Unit& u) const { const int t = c + (i >> 1) * G; if (t >= 256) return false; const int x = t & 7, j = t >> 3; u.pm = x + 8 * (j >> 3); u.pn = j & 7; u.aux = i & 1; return true; }
};

template <class Epi, class Sched, bool ALIGN_EPI, bool HALFB = false>
__device__ __forceinline__ void gemm_phase(LAS unsigned char* lds, const Gemm g, const Sched& S, const Epi& E, int wave_k) {
    int tid_ = wave_k * 64 + lane_id_hw(); asm volatile("" : "+v"(tid_));
    const int tid = tid_, wid = __builtin_amdgcn_readfirstlane(tid >> 6), lane = tid & 63, wr = wid >> 2, wc = wid & 3, fr = lane & 15, fq = lane >> 4;
    int nt_ = g.K / BK; asm volatile("" : "+s"(nt_)); const int nt = nt_;
    unsigned voffA[2], voffB[2];
#pragma unroll
    for (int i = 0; i < 2; ++i) { int R, C; stage_rc(tid * 16 + i * 8192, R, C); const int Rb = Epi::PERM ? ((R & ~31) + perm32(R & 31)) : R;
        voffA[i] = (unsigned)(R * g.lda + C) * 2u; voffB[i] = (unsigned)(Rb * g.ldb + C) * 2u; }
    const size_t kstep = (size_t)(BK * 2);
    const size_t hstepA = (size_t)HALF * g.lda * 2, hstepB = (size_t)HALF * g.ldb * 2;
    const size_t tstepA = 2 * hstepA, tstepB = 2 * hstepB;
    const unsigned ldsw = (unsigned)wid * 1024u;
    const int aoff = lds_byte(wr * 64 + fr, fq * 8), boff = lds_byte(wc * 32 + fr, fq * 8);
#define PG8_SA(b, h) (((b) * 2 + (h)) * HTB)
#define PG8_SB(b, h) ((4 + (b) * 2 + (h)) * HTB)
#define PG8_STAGE(bufoff, gbase, voff) do { _Pragma("unroll") for (int _i = 0; _i < 2; ++_i) \
        __builtin_amdgcn_global_load_lds((const unsigned*)((const char*)(gbase) + (voff)[_i]), (LAS unsigned*)(lds + (bufoff) + ldsw + _i * 8192), 16, 0, 0); } while (0)
#define PG8_LDA(dst, b, h) do { _Pragma("unroll") for (int m = 0; m < 4; ++m) _Pragma("unroll") for (int k = 0; k < 2; ++k) dst[m][k] = *(const LAS bf16x8*)(lds + PG8_SA(b, h) + aoff + m * 2048 + k * 1024); } while (0)
#define PG8_LDB(dst, b, h) do { _Pragma("unroll") for (int n = 0; n < 2; ++n) _Pragma("unroll") for (int k = 0; k < 2; ++k) dst[n][k] = *(const LAS bf16x8*)(lds + PG8_SB(b, h) + boff + n * 2048 + k * 1024); } while (0)
#define PG8_MMA(ai, bj, At, Bt) do { __builtin_amdgcn_s_setprio(1); _Pragma("unroll") for (int m = 0; m < 4; ++m) _Pragma("unroll") for (int n = 0; n < 2; ++n) _Pragma("unroll") for (int k = 0; k < 2; ++k) \
        acc[ai][bj][m][n] = __builtin_amdgcn_mfma_f32_16x16x32_bf16(Bt[n][k], At[m][k], acc[ai][bj][m][n], 0, 0, 0); __builtin_amdgcn_s_setprio(0); } while (0)
#define PG8_MMA2(ai) do { if constexpr (HALFB) { if (lo) { PG8_MMA(ai, 0, At, B0); } else { PG8_MMA(ai, 1, At, B1); } } else { PG8_MMA(ai, 0, At, B0); PG8_MMA(ai, 1, At, B1); } } while (0)
#define PG8_WAIT_V(n) asm volatile("s_waitcnt vmcnt(" #n ")" ::: "memory")
#define PG8_WAIT_L(n) asm volatile("s_waitcnt lgkmcnt(" #n ")" ::: "memory")
#define PG8_BAR __builtin_amdgcn_s_barrier()
#define PG8_SCHED __builtin_amdgcn_sched_barrier(0)
#define PG8_UA(u) ((const char*)g.A + (size_t)(u).pm * tstepA + (size_t)(u).aux * (size_t)g.a_aux)
#define PG8_UB(u) ((const char*)g.Bt + (size_t)(u).pn * tstepB + (size_t)(u).aux * (size_t)g.b_aux)
    Unit cur, nxt; int ui = 0;
    if (!S.next(0, cur)) return;
    f32x4 acc[2][2][4][2];
#pragma unroll
    for (int a = 0; a < 2; ++a)
#pragma unroll
        for (int b = 0; b < 2; ++b)
#pragma unroll
            for (int m = 0; m < 4; ++m)
#pragma unroll
                for (int n = 0; n < 2; ++n) acc[a][b][m][n] = (f32x4){0.f, 0.f, 0.f, 0.f};
    bf16x8 At[4][2], B0[2][2], B1[2][2];
    const char* cA = PG8_UA(cur); const char* cB = PG8_UB(cur);
    PG8_STAGE(PG8_SB(0, 0), cB, voffB); PG8_STAGE(PG8_SB(0, 1), cB + hstepB, voffB); PG8_STAGE(PG8_SA(0, 0), cA, voffA); PG8_STAGE(PG8_SA(0, 1), cA + hstepA, voffA);
    if (wr == 1) PG8_BAR;
    PG8_WAIT_V(2); PG8_BAR;
    PG8_STAGE(PG8_SB(1, 0), cB + kstep, voffB); PG8_STAGE(PG8_SA(1, 0), cA + kstep, voffA); PG8_STAGE(PG8_SB(1, 1), cB + hstepB + kstep, voffB);
    PG8_WAIT_V(6); PG8_BAR;
    for (;;) {
        const bool has_next = S.next(ui + 1, nxt);
        const char* nA = has_next ? PG8_UA(nxt) : cA; const char* nB = has_next ? PG8_UB(nxt) : cB;
        for (int t = 0; t < nt; t += 2) {
            const bool last = (t == nt - 2);
            const bool lo = (2 * t < nt);
            (void)lo;
            const char* a1 = cA + (size_t)(t + 1) * kstep;
            const char* a2 = last ? nA : cA + (size_t)(t + 2) * kstep; const char* b2 = last ? nB : cB + (size_t)(t + 2) * kstep;
            const char* a3 = a2 + kstep; const char* b3 = b2 + kstep;
            PG8_LDB(B0, 0, 0); PG8_LDB(B1, 0, 1); PG8_SCHED; PG8_LDA(At, 0, 0); PG8_STAGE(PG8_SA(1, 1), a1 + hstepA, voffA);
            PG8_WAIT_V(8); PG8_WAIT_L(0); PG8_BAR; PG8_MMA2(0); PG8_BAR; PG8_SCHED;
            PG8_LDA(At, 0, 1); PG8_STAGE(PG8_SB(0, 0), b2, voffB); PG8_STAGE(PG8_SB(0, 1), b2 + hstepB, voffB); PG8_STAGE(PG8_SA(0, 0), a2, voffA);
            PG8_WAIT_V(8); PG8_WAIT_L(0); PG8_BAR; PG8_MMA2(1); PG8_BAR; PG8_SCHED;
            PG8_LDB(B0, 1, 0); PG8_LDB(B1, 1, 1); PG8_SCHED; PG8_LDA(At, 1, 0); PG8_STAGE(PG8_SA(0, 1), a2 + hstepA, voffA);
            PG8_WAIT_V(8); PG8_WAIT_L(0); PG8_BAR; PG8_MMA2(0); PG8_BAR; PG8_SCHED;
            PG8_LDA(At, 1, 1); PG8_STAGE(PG8_SB(1, 0), b3, voffB); PG8_STAGE(PG8_SB(1, 1), b3 + hstepB, voffB); PG8_STAGE(PG8_SA(1, 0), a3, voffA);
            PG8_WAIT_V(8); PG8_WAIT_L(0); PG8_BAR; PG8_MMA2(1); PG8_BAR; PG8_SCHED;
        }
        if constexpr (ALIGN_EPI) { if (wr == 0) PG8_BAR; }
        { Unit eu = cur; asm volatile("" : "+s"(eu.pm), "+s"(eu.pn), "+s"(eu.aux)); E(acc, eu, wr, wc, fr, fq); }
        if (!has_next) break;
#pragma unroll
        for (int a = 0; a < 2; ++a)
#pragma unroll
            for (int b = 0; b < 2; ++b)
#pragma unroll
                for (int m = 0; m < 4; ++m)
#pragma unroll
                    for (int n = 0; n < 2; ++n) acc[a][b][m][n] = (f32x4){0.f, 0.f, 0.f, 0.f};
        cur = nxt; cA = nA; cB = nB; ++ui;
        if constexpr (ALIGN_EPI) { if (wr == 1) PG8_BAR; }
    }
    PG8_WAIT_V(0);
    if constexpr (!ALIGN_EPI) { if (wr == 0) PG8_BAR; }
    PG8_BAR;
#undef PG8_SA
#undef PG8_SB
#undef PG8_STAGE
#undef PG8_LDA
#undef PG8_LDB
#undef PG8_MMA
#undef PG8_MMA2
#undef PG8_WAIT_V
#undef PG8_WAIT_L
#undef PG8_BAR
#undef PG8_SCHED
#undef PG8_UA
#undef PG8_UB
}

__device__ __forceinline__ float row_rstd(const float* ssq, int row, int fq) {
    const f32x4 a = *(const f32x4*)(ssq + (size_t)row * 16 + 4 * fq);
    float s = (a[0] + a[1]) + (a[2] + a[3]);
    s = x16_sum(s); s = x32_sum(s);
    return __builtin_amdgcn_rsqf(s * (1.0f / DM) + RMS_EPS);
}
__device__ __forceinline__ int pos16(int o) { return 8 * ((o >> 2) & 1) + 4 * (o >> 3) + (o & 3); }

struct EpiProj {
    static constexpr bool PERM = true;
    const float* ssq; int row_base; bf16_t* QK; bf16_t* KF; bf16_t* VT; float* FL; bf16_t* GATE;
    __device__ __forceinline__ void operator()(const f32x4 (&acc)[2][2][4][2], const Unit& u, int wr, int wc, int fr, int fq) const {
        const int pn = u.pn;
        const int lrow0 = u.pm * BM + wr * 64 + fr;
        float rs[2][4];
#pragma unroll
        for (int ai = 0; ai < 2; ++ai)
#pragma unroll
            for (int m = 0; m < 4; ++m) rs[ai][m] = row_rstd(ssq, row_base + lrow0 + ai * HALF + m * 16, fq);
        const int cin = wc * 32 + 8 * fq;
        if (pn >= 19) {
#pragma unroll
            for (int ai = 0; ai < 2; ++ai)
#pragma unroll
                for (int m = 0; m < 4; ++m) { const int lrow = lrow0 + ai * HALF + m * 16; const float s = rs[ai][m];
#pragma unroll
                    for (int bj = 0; bj < 2; ++bj) { const f32x4 v0 = acc[ai][bj][m][0] * s, v1 = acc[ai][bj][m][1] * s;
                        u32x4 w; w.x = cvtpk(v0[0], v0[1]); w.y = cvtpk(v0[2], v0[3]); w.z = cvtpk(v1[0], v1[1]); w.w = cvtpk(v1[2], v1[3]);
                        *(u32x4*)(GATE + ((size_t)((u.pm * 32 + (pn - 19) * 2 + bj) * 2 + ai) * 4 + m) * 4096 + ((wr * 4 + wc) * 64 + fr + 16 * fq) * 8) = w; } }
        } else if (pn == 18) {
            if (wc == 0 && fq == 0) {
#pragma unroll
                for (int ai = 0; ai < 2; ++ai)
#pragma unroll
                    for (int m = 0; m < 4; ++m) { const int lrow = lrow0 + ai * HALF + m * 16; *(f32x4*)(FL + (size_t)lrow * 4) = acc[ai][0][m][0] * rs[ai][m]; }
            }
        } else if (pn == 2 || (pn >= 9 && pn <= 11) || pn == 14 || pn == 17) {
            int vhb, rsh;
            if (pn == 2) { vhb = 0; rsh = 0; } else if (pn == 14) { vhb = 16; rsh = 0; } else if (pn == 17) { vhb = 20; rsh = 0; } else { const int gI = pn - 9; vhb = 4 + 4 * gI; rsh = 2 * gI; }
            const int slsh = 11 - rsh, rmask = (1 << rsh) - 1;
#pragma unroll
            for (int ai = 0; ai < 2; ++ai)
#pragma unroll
                for (int m = 0; m < 4; ++m) { const int lrow = lrow0 + ai * HALF + m * 16; const float s = rs[ai][m];
                    const int bl = lrow >> 11, t = lrow & (SEQ - 1); int p = ((t & rmask) << slsh) + (t >> rsh); p = (p & ~15) | pos16(p & 15);
                    const int kb = p >> 5, q = p & 31;
                    bf16_t* base = VT + (size_t)(bl * 24 + vhb) * HSEQ + (size_t)kb * 2048 + (q >> 4) * 512 + ((q >> 3) & 1) * 256 + (q & 7);
#pragma unroll
                    for (int bj = 0; bj < 2; ++bj) { const int c0 = bj * HALF + cin;
                        bf16_t* bp = base + (size_t)(c0 >> 6) * HSEQ + ((c0 >> 5) & 1) * 1024 + (c0 & 31) * 8;
                        const f32x4 v0 = acc[ai][bj][m][0] * s, v1 = acc[ai][bj][m][1] * s;
                        const unsigned w0 = cvtpk(v0[0], v0[1]), w1 = cvtpk(v0[2], v0[3]), w2 = cvtpk(v1[0], v1[1]), w3 = cvtpk(v1[2], v1[3]);
                        bp[0 * 8] = (bf16_t)(w0 & 0xffff); bp[1 * 8] = (bf16_t)(w0 >> 16); bp[2 * 8] = (bf16_t)(w1 & 0xffff); bp[3 * 8] = (bf16_t)(w1 >> 16);
                        bp[4 * 8] = (bf16_t)(w2 & 0xffff); bp[5 * 8] = (bf16_t)(w2 >> 16); bp[6 * 8] = (bf16_t)(w3 & 0xffff); bp[7 * 8] = (bf16_t)(w3 >> 16); } }
        } else {
            const bool isK = (pn == 1) || (pn >= 6 && pn <= 8) || pn == 13 || pn == 16;
            int slot = 0, khb = 0, rsh = 0;
            if (pn <= 1) { slot = 0; khb = 0; } else if (pn <= 8) { const int gI = (pn - 3) % 3; rsh = 2 * gI; slot = 1 + gI; khb = 4 + 4 * gI; } else if (pn <= 13) { slot = 4; khb = 16; } else { slot = 5; khb = 20; }
            const int slsh = 11 - rsh, rmask = (1 << rsh) - 1;
#pragma unroll
            for (int ai = 0; ai < 2; ++ai)
#pragma unroll
                for (int m = 0; m < 4; ++m) { const int lrow = lrow0 + ai * HALF + m * 16; const float s = rs[ai][m];
                    const int bl = lrow >> 11, t = lrow & (SEQ - 1); const int p = ((t & rmask) << slsh) + (t >> rsh);
#pragma unroll
                    for (int bj = 0; bj < 2; ++bj) { const f32x4 v0 = acc[ai][bj][m][0] * s, v1 = acc[ai][bj][m][1] * s;
                        u32x4 w; w.x = cvtpk(v0[0], v0[1]); w.y = cvtpk(v0[2], v0[3]); w.z = cvtpk(v1[0], v1[1]); w.w = cvtpk(v1[2], v1[3]);
                        const int c0 = bj * HALF + cin;
                        if (isK) { const int dcol = c0 & 63;
                            *(u32x4*)(KF + (size_t)(bl * 24 + khb + (c0 >> 6)) * HSEQ + (size_t)(p >> 5) * 2048 + (dcol >> 4) * 512 + (((dcol >> 3) & 1) * 32 + (p & 31)) * 8) = w; }
                        else *(u32x4*)(QK + (size_t)(bl * SEQ + p) * LDQK + slot * 256 + c0) = w; } }
        }
    }
};

struct EpiBranch {
    static constexpr bool PERM = true;
    const bf16_t* GATE; bf16_t* MERGED; int row_base;
    __device__ __forceinline__ static float sg(float g) { return __builtin_amdgcn_rcpf(1.0f + ex2(-g * LOG2E)); }
    __device__ __forceinline__ static u32x4 mix(const u32x4 ga, const u32x4 gb, const u32x4 ow, const f32x4 a0, const f32x4 a1, const f32x4 b0, const f32x4 b1) {
        const float o0 = sg(bflo(ga.x)) * a0[0] + sg(bflo(gb.x)) * b0[0] + bflo(ow.x), o1 = sg(bfhi(ga.x)) * a0[1] + sg(bfhi(gb.x)) * b0[1] + bfhi(ow.x);
        const float o2 = sg(bflo(ga.y)) * a0[2] + sg(bflo(gb.y)) * b0[2] + bflo(ow.y), o3 = sg(bfhi(ga.y)) * a0[3] + sg(bfhi(gb.y)) * b0[3] + bfhi(ow.y);
        const float o4 = sg(bflo(ga.z)) * a1[0] + sg(bflo(gb.z)) * b1[0] + bflo(ow.z), o5 = sg(bfhi(ga.z)) * a1[1] + sg(bfhi(gb.z)) * b1[1] + bfhi(ow.z);
        const float o6 = sg(bflo(ga.w)) * a1[2] + sg(bflo(gb.w)) * b1[2] + bflo(ow.w), o7 = sg(bfhi(ga.w)) * a1[3] + sg(bfhi(gb.w)) * b1[3] + bfhi(ow.w);
        u32x4 w; w.x = cvtpk(o0, o1); w.y = cvtpk(o2, o3); w.z = cvtpk(o4, o5); w.w = cvtpk(o6, o7); return w;
    }
    __device__ __forceinline__ void operator()(const f32x4 (&acc)[2][2][4][2], const Unit& u, int wr, int wc, int fr, int fq) const {
        const int p = u.aux; const int lrow0 = u.pm * BM + wr * 64 + fr; const int d0 = u.pn * 128 + wc * 32 + 8 * fq;
        int fr_ = fr; asm volatile("" : "+v"(fr_));
        const bf16_t* gbase = GATE + (size_t)(u.pm * 32 + (2 * p) * 8 + u.pn) * 8 * 4096 + ((wr * 4 + wc) * 64 + fr_ + 16 * fq) * 8;
        bf16_t* mbase = MERGED + (size_t)(row_base + lrow0) * DM + d0;
        const u32x4 zero = {0u, 0u, 0u, 0u};
#pragma unroll
        for (int ai = 0; ai < 2; ++ai) {
#pragma unroll
            for (int m = 0; m < 4; ++m) {
                const size_t ro = (size_t)(ai * HALF + m * 16);
                const u32x4 ga = *(const u32x4*)(gbase + (size_t)(ai * 4 + m) * 4096), gb = *(const u32x4*)(gbase + (size_t)(ai * 4 + m) * 4096 + (size_t)8 * 8 * 4096);
                u32x4 ow = zero; if (p > 0) ow = *(const u32x4*)(mbase + ro * DM);
                *(u32x4*)(mbase + ro * DM) = mix(ga, gb, ow, acc[ai][0][m][0], acc[ai][0][m][1], acc[ai][1][m][0], acc[ai][1][m][1]);
                if (m & 1) asm volatile("" ::: "memory");
            }
        }
    }
};

struct EpiResid {
    static constexpr bool PERM = true;
    const float* Xin; float* X; bf16_t* XB; float* ssq;
    __device__ __forceinline__ void operator()(const f32x4 (&acc)[2][2][4][2], const Unit& u, int wr, int wc, int fr, int fq) const {
        const int row0 = u.pm * BM + wr * 64 + fr; const int col0 = u.pn * BM + wc * 32 + 8 * fq;
#pragma unroll
        for (int ai = 0; ai < 2; ++ai)
#pragma unroll
            for (int m = 0; m < 4; ++m) { const int row = row0 + ai * HALF + m * 16; float sq = 0.f;
#pragma unroll
                for (int bj = 0; bj < 2; ++bj) { const int col = col0 + bj * HALF; f32x4* xp = (f32x4*)(X + (size_t)row * DM + col); const f32x4* xi = (const f32x4*)(Xin + (size_t)row * DM + col);
                    const f32x4 x0 = xi[0] + acc[ai][bj][m][0], x1 = xi[1] + acc[ai][bj][m][1];
                    xp[0] = x0; xp[1] = x1;
                    u32x4 w; w.x = cvtpk(x0[0], x0[1]); w.y = cvtpk(x0[2], x0[3]); w.z = cvtpk(x1[0], x1[1]); w.w = cvtpk(x1[2], x1[3]);
                    *(u32x4*)(XB + (size_t)row * DM + col) = w;
                    sq += (x0[0] * x0[0] + x0[1] * x0[1]) + (x0[2] * x0[2] + x0[3] * x0[3]) + (x1[0] * x1[0] + x1[1] * x1[1]) + (x1[2] * x1[2] + x1[3] * x1[3]); }
                sq = x16_sum(sq); sq = x32_sum(sq);
                if (fq == 0) ssq[(size_t)row * 16 + u.pn * 4 + wc] = sq; if (m & 1) asm volatile("" ::: "memory"); }
    }
};

struct EpiFinal {
    static constexpr bool PERM = true;
    const float* X; float* out; float* ssq; const float* gfin; unsigned* cnt;
    __device__ __forceinline__ void operator()(f32x4 (&acc)[2][2][4][2], const Unit& u, int wr, int wc, int fr, int fq) const {
        const int row0 = u.pm * BM + wr * 64 + fr; const int col0 = u.pn * BM + wc * 32 + 8 * fq;
#pragma unroll
        for (int ai = 0; ai < 2; ++ai)
#pragma unroll
            for (int m = 0; m < 4; ++m) { const int row = row0 + ai * HALF + m * 16; float sq = 0.f;
#pragma unroll
                for (int bj = 0; bj < 2; ++bj) { const f32x4* xi = (const f32x4*)(X + (size_t)row * DM + col0 + bj * HALF);
                    const f32x4 x0 = xi[0] + acc[ai][bj][m][0], x1 = xi[1] + acc[ai][bj][m][1];
                    acc[ai][bj][m][0] = x0; acc[ai][bj][m][1] = x1;
                    sq += (x0[0] * x0[0] + x0[1] * x0[1]) + (x0[2] * x0[2] + x0[3] * x0[3]) + (x1[0] * x1[0] + x1[1] * x1[1]) + (x1[2] * x1[2] + x1[3] * x1[3]); }
                sq = x16_sum(sq); sq = x32_sum(sq);
                if (fq == 0) __hip_atomic_store(ssq + (size_t)row * 16 + u.pn * 4 + wc, sq, __ATOMIC_RELAXED, __HIP_MEMORY_SCOPE_AGENT);
                if (m & 1) asm volatile("" ::: "memory"); }
        asm volatile("s_waitcnt vmcnt(0)" ::: "memory");
        unsigned* c = cnt + 64 * u.pm;
        if ((fr | fq) == 0) {
            __hip_atomic_fetch_add(c, 1u, __ATOMIC_RELAXED, __HIP_MEMORY_SCOPE_AGENT);
            unsigned sp = 0;
            while (__hip_atomic_load(c, __ATOMIC_RELAXED, __HIP_MEMORY_SCOPE_AGENT) < 32u) { __builtin_amdgcn_s_sleep(2); if (++sp > (1u << 22)) break; }
        }
        __builtin_amdgcn_fence(__ATOMIC_ACQUIRE, "agent");
        asm volatile("s_waitcnt vmcnt(0)" ::: "memory");
        float rs[2][4];
#pragma unroll
        for (int ai = 0; ai < 2; ++ai)
#pragma unroll
            for (int m = 0; m < 4; ++m) rs[ai][m] = row_rstd(ssq, row0 + ai * HALF + m * 16, fq);
#pragma unroll
        for (int bj = 0; bj < 2; ++bj) { const f32x4 g0 = *(const f32x4*)(gfin + col0 + bj * HALF), g1 = *(const f32x4*)(gfin + col0 + bj * HALF + 4);
#pragma unroll
            for (int ai = 0; ai < 2; ++ai)
#pragma unroll
                for (int m = 0; m < 4; ++m) { const int row = row0 + ai * HALF + m * 16; f32x4* op = (f32x4*)(out + (size_t)row * DM + col0 + bj * HALF);
                    op[0] = acc[ai][bj][m][0] * rs[ai][m] * g0; op[1] = acc[ai][bj][m][1] * rs[ai][m] * g1; } }
    }
};

struct EpiUp {
    static constexpr bool PERM = true;
    const float* ssq; bf16_t* H;
    __device__ __forceinline__ void operator()(const f32x4 (&acc)[2][2][4][2], const Unit& u, int wr, int wc, int fr, int fq) const {
        const int row0 = u.pm * BM + wr * 64 + fr; const int col0 = u.pn * BM + wc * 32 + 8 * fq;
        float rs[2][4];
#pragma unroll
        for (int ai = 0; ai < 2; ++ai)
#pragma unroll
            for (int m = 0; m < 4; ++m) rs[ai][m] = row_rstd(ssq, row0 + ai * HALF + m * 16, fq);
#pragma unroll
        for (int ai = 0; ai < 2; ++ai)
#pragma unroll
            for (int m = 0; m < 4; ++m) { const int row = row0 + ai * HALF + m * 16; const float s = rs[ai][m];
#pragma unroll
                for (int bj = 0; bj < 2; ++bj) { f32x4 v0 = acc[ai][bj][m][0] * s, v1 = acc[ai][bj][m][1] * s;
#pragma unroll
                    for (int i = 0; i < 4; ++i) { const float a = fmaxf(v0[i], 0.f), b = fmaxf(v1[i], 0.f); v0[i] = a * a; v1[i] = b * b; }
                    u32x4 w; w.x = cvtpk(v0[0], v0[1]); w.y = cvtpk(v0[2], v0[3]); w.z = cvtpk(v1[0], v1[1]); w.w = cvtpk(v1[2], v1[3]);
                    *(u32x4*)(H + (size_t)row * DFF + col0 + bj * HALF) = w; } }
    }
};
}

__device__ __forceinline__ int win_src(int n) {
    if (n < 3840) return n;
    if (n < 4608) return n + 4;
    if (n < 4864) return (n - 4608 < 4) ? 3840 + (n - 4608) : -1;
    return n - 4864 + 4612;
}
template <int CMAP>
__device__ __forceinline__ void transpose_item(const float* W, int K, int N, int Nsrc, const float* gain, bf16_t* WT, LAS float* scr, int item, int lane) {
    const int nblk = N / 32, kb = item / nblk, nb = item % nblk, k0 = 64 * kb, n0 = 32 * nb;
    const int n = n0 + (lane & 31); const int src = CMAP ? win_src(n) : n;
    const bool live = (src >= 0); const float* wp = W + (size_t)(k0 + (lane >> 5)) * Nsrc + (live ? src : 0); const float* gp = gain ? gain + k0 + (lane >> 5) : nullptr;
    float wv[32];
#pragma unroll
    for (int i = 0; i < 32; ++i) wv[i] = wp[(size_t)(2 * i) * Nsrc];
#pragma unroll
    for (int i = 0; i < 32; ++i) { float v = live ? wv[i] : 0.f; if (gp) v *= gp[2 * i]; scr[(2 * i + (lane >> 5)) * 33 + (lane & 31)] = v; }
    asm volatile("s_waitcnt lgkmcnt(0)" ::: "memory");
    const int c = lane & 7;
#pragma unroll
    for (int j = 0; j < 4; ++j) { const int nn = (lane >> 3) + 8 * j; const LAS float* s = scr + (8 * c) * 33 + nn;
        u32x4 o; o.x = cvtpk(s[0 * 33], s[1 * 33]); o.y = cvtpk(s[2 * 33], s[3 * 33]); o.z = cvtpk(s[4 * 33], s[5 * 33]); o.w = cvtpk(s[6 * 33], s[7 * 33]);
        *(u32x4*)(WT + (size_t)(n0 + nn) * K + k0 + 8 * c) = o; }
    asm volatile("s_waitcnt lgkmcnt(0)" ::: "memory");
}

__device__ __forceinline__ void branch_item(const float* Wn, int n, bf16_t* WBP, LAS float* scr, int item, int lane) {
    const int kb = item >> 5, nb = item & 31, k0 = 64 * kb, n0 = 32 * nb;
    const float* wp = Wn + (size_t)(k0 + (lane >> 5)) * DM + n0 + (lane & 31);
    float wv[32];
#pragma unroll
    for (int i = 0; i < 32; ++i) wv[i] = wp[(size_t)(2 * i) * DM];
#pragma unroll
    for (int i = 0; i < 32; ++i) scr[(2 * i + (lane >> 5)) * 33 + (lane & 31)] = wv[i];
    asm volatile("s_waitcnt lgkmcnt(0)" ::: "memory");
    const int c = lane & 7, bj = n & 1, pair = n >> 1;
    const u32x4 zero = {0u, 0u, 0u, 0u};
#pragma unroll
    for (int j = 0; j < 4; ++j) { const int nn = (lane >> 3) + 8 * j; const LAS float* sp = scr + (8 * c) * 33 + nn; const int d = n0 + nn;
        u32x4 o; o.x = cvtpk(sp[0 * 33], sp[1 * 33]); o.y = cvtpk(sp[2 * 33], sp[3 * 33]); o.z = cvtpk(sp[4 * 33], sp[5 * 33]); o.w = cvtpk(sp[6 * 33], sp[7 * 33]);
        bf16_t* row = WBP + ((size_t)((pair * 8 + (d >> 7)) * 256 + bj * 128 + (d & 127))) * 512 + k0 + 8 * c;
        *(u32x4*)(row + 256 * bj) = o; *(u32x4*)(row + 256 * (1 - bj)) = zero; }
    asm volatile("s_waitcnt lgkmcnt(0)" ::: "memory");
}

#define MFMA32(a, b, c) __builtin_amdgcn_mfma_f32_32x32x16_bf16((a), (b), (c), 0, 0, 0)
__device__ __forceinline__ bf16x8 ld16(const bf16_t* p) { return *(const bf16x8*)p; }
__device__ __forceinline__ bf16x8 pack8(const f32x16& s, int b) { u32x4 w; w.x = cvtpk(s[b], s[b + 1]); w.y = cvtpk(s[b + 2], s[b + 3]); w.z = cvtpk(s[b + 4], s[b + 5]); w.w = cvtpk(s[b + 6], s[b + 7]); return __builtin_bit_cast(bf16x8, w); }
__device__ __forceinline__ int crow(int r, int hi) { return (r & 3) + 8 * (r >> 2) + 4 * hi; }
__device__ __forceinline__ void store_o(bf16_t* orow, const f32x16& o0, const f32x16& o1, int hi) {
#pragma unroll
    for (int g = 0; g < 4; ++g) {
        u32x2 a; a.x = cvtpk(o0[4 * g], o0[4 * g + 1]); a.y = cvtpk(o0[4 * g + 2], o0[4 * g + 3]); *(u32x2*)(orow + 8 * g + 4 * hi) = a;
        u32x2 b; b.x = cvtpk(o1[4 * g], o1[4 * g + 1]); b.y = cvtpk(o1[4 * g + 2], o1[4 * g + 3]); *(u32x2*)(orow + 32 + 8 * g + 4 * hi) = b; }
}

struct KFrag { bf16x8 k[4]; };
struct VFrag { bf16x8 v[4]; };
__device__ __forceinline__ void k_load(KFrag& f, const bf16_t* Kh, int kb, int lane) {
    const bf16_t* kp = Kh + (size_t)kb * 2048 + lane * 8;
#pragma unroll
    for (int ds = 0; ds < 4; ++ds) f.k[ds] = ld16(kp + ds * 512);
}
__device__ __forceinline__ void v_load(VFrag& f, const bf16_t* Vh, int kb, int lane) {
    const bf16_t* vp = Vh + (size_t)kb * 2048 + lane * 8;
    f.v[0] = ld16(vp); f.v[1] = ld16(vp + 512); f.v[2] = ld16(vp + 1024); f.v[3] = ld16(vp + 1536);
}
__device__ __forceinline__ void q_load(bf16x8 (&qf)[4], const bf16_t* Qs, int qb, int r32, int hi) {
    const bf16_t* qp = Qs + (size_t)(qb * 32 + r32) * LDQK + hi * 8;
#pragma unroll
    for (int ds = 0; ds < 4; ++ds) qf[ds] = ld16(qp + ds * 16);
}

template <int MODE, bool MASK, int NDS>
__device__ __forceinline__ void sm_step(const bf16x8 (&ck)[NDS], const bf16x8 (&qf)[NDS], const VFrag& cv, float slope2, const LAS float* cl, int kb, int d0,
                                        float& m, float& l, f32x16& o0, f32x16& o1, int hi) {
    constexpr float SC2 = ((MODE == 2) ? 0.17677669529663687f : 0.125f) * LOG2E;
    f32x16 s;
#pragma unroll
    for (int i = 0; i < 16; ++i) s[i] = 0.f;
#pragma unroll
    for (int ds = 0; ds < NDS; ++ds) s = MFMA32(ck[ds], qf[ds], s);
#define KC(r) (((r) & 3) + 8 * ((r) >> 2))
    int dh = d0 - 4 * hi; asm volatile("" : "+v"(dh));
    float sl = slope2; asm volatile("" : "+v"(sl));
    const LAS float* clk = cl + 33 * kb + 4 * hi; if (MODE == 0) asm volatile("" : "+v"(clk));
    const float base = (MODE == 0) ? 0.f : -sl * (float)dh;
#pragma unroll
    for (int r = 0; r < 16; ++r) {
        float v = (MODE == 0) ? fmaf(s[r], SC2, clk[KC(r)]) : fmaf(s[r], SC2, sl * (float)KC(r));
        if (MASK) { const int dist = dh - KC(r); const bool valid = (MODE == 1) ? ((unsigned)dist <= 128u) : (dist >= 0); v = valid ? v : -INFINITY; }
        s[r] = v;
    }
#undef KC
    float mt = fmaxf(fmaxf(s[0], s[1]), fmaxf(s[2], s[3]));
#pragma unroll
    for (int r = 4; r < 16; r += 4) mt = fmaxf(mt, fmaxf(fmaxf(s[r], s[r + 1]), fmaxf(s[r + 2], s[r + 3])));
    mt = x32_max(mt + base);
    const float mn = fmaxf(m, mt), alpha = ex2(m - mn), c = mn - base;
    float ps = 0.f;
#pragma unroll
    for (int r = 0; r < 16; ++r) { const float p = ex2(s[r] - c); s[r] = p; ps += p; }
    l = l * alpha + ps; m = mn;
#pragma unroll
    for (int i = 0; i < 16; ++i) { o0[i] *= alpha; o1[i] *= alpha; }
    const bf16x8 pf0 = pack8(s, 0), pf1 = pack8(s, 8);
    o0 = MFMA32(cv.v[0], pf0, o0); o0 = MFMA32(cv.v[1], pf1, o0); o1 = MFMA32(cv.v[2], pf0, o1); o1 = MFMA32(cv.v[3], pf1, o1);
}
template <int MODE>
__device__ __forceinline__ void sm_unit(const bf16_t* Qs, const bf16_t* Ks, const bf16_t* VTs, int qb, int kb_hi, int kb_lo, float slope2, const LAS float* cl,
                                        f32x16& o0, f32x16& o1, float& m_out, float& l_out, int lane) {
    const int r32 = lane & 31, hi = lane >> 5;
    constexpr int NDS = (MODE == 2) ? 2 : 4;
    bf16x8 qf[NDS];
    { const bf16_t* qp = Qs + (size_t)(qb * 32 + r32) * LDQK + hi * 8;
#pragma unroll
      for (int ds = 0; ds < NDS; ++ds) qf[ds] = ld16(qp + ds * 16); }
    bf16x8 nk[NDS];
    { const bf16_t* kp = Ks + (size_t)kb_hi * 2048 + lane * 8;
#pragma unroll
      for (int ds = 0; ds < NDS; ++ds) nk[ds] = ld16(kp + ds * 512); }
    float m = -INFINITY, l = 0.f;
#pragma unroll
    for (int i = 0; i < 16; ++i) { o0[i] = 0.f; o1[i] = 0.f; }
    for (int kb = kb_hi; kb >= kb_lo; --kb) {
        bf16x8 ck[NDS];
#pragma unroll
        for (int ds = 0; ds < NDS; ++ds) ck[ds] = nk[ds];
        VFrag cv; v_load(cv, VTs, kb, lane);
        if (kb > kb_lo) { const bf16_t* kp = Ks + (size_t)(kb - 1) * 2048 + lane * 8;
#pragma unroll
            for (int ds = 0; ds < NDS; ++ds) nk[ds] = ld16(kp + ds * 512); }
        const int d0 = (qb - kb) * 32 + r32;
        const bool edge = (MODE == 1) ? (kb == qb || kb + 4 <= qb) : (kb == qb);
        if (edge) sm_step<MODE, true, NDS>(ck, qf, cv, slope2, cl, kb, d0, m, l, o0, o1, hi);
        else      sm_step<MODE, false, NDS>(ck, qf, cv, slope2, cl, kb, d0, m, l, o0, o1, hi);
    }
    l = x32_sum(l);
    m_out = m; l_out = l;
}

template <int MODE>
__device__ __forceinline__ void sm_unit64(const bf16_t* Qs, const bf16_t* Ks, const bf16_t* VTs, int Q, int kb_hi, int kb_lo, float slope2, const LAS float* cl,
                                          f32x16 (&o)[2][2], float (&m)[2], float (&l)[2], int lane) {
    const int r32 = lane & 31, hi = lane >> 5;
    constexpr int NDS = (MODE == 2) ? 2 : 4;
    bf16x8 qf[2][NDS];
#pragma unroll
    for (int i = 0; i < 2; ++i) { const bf16_t* qp = Qs + (size_t)((2 * Q + i) * 32 + r32) * LDQK + hi * 8;
#pragma unroll
        for (int ds = 0; ds < NDS; ++ds) qf[i][ds] = ld16(qp + ds * 16); }
    bf16x8 nk[NDS];
    { const bf16_t* kp = Ks + (size_t)kb_hi * 2048 + lane * 8;
#pragma unroll
      for (int ds = 0; ds < NDS; ++ds) nk[ds] = ld16(kp + ds * 512); }
#pragma unroll
    for (int i = 0; i < 2; ++i) { m[i] = -INFINITY; l[i] = 0.f;
#pragma unroll
        for (int k = 0; k < 16; ++k) { o[i][0][k] = 0.f; o[i][1][k] = 0.f; } }
    for (int kb = kb_hi; kb >= kb_lo; --kb) {
        bf16x8 ck[NDS];
#pragma unroll
        for (int ds = 0; ds < NDS; ++ds) ck[ds] = nk[ds];
        VFrag cv; v_load(cv, VTs, kb, lane);
        if (kb > kb_lo) { const bf16_t* kp = Ks + (size_t)(kb - 1) * 2048 + lane * 8;
#pragma unroll
            for (int ds = 0; ds < NDS; ++ds) nk[ds] = ld16(kp + ds * 512); }
        if (kb < 2 * Q) {
            const int d00 = (2 * Q - kb) * 32 + r32;
            sm_step<MODE, false, NDS>(ck, qf[0], cv, slope2, cl, kb, d00, m[0], l[0], o[0][0], o[0][1], hi);
            sm_step<MODE, false, NDS>(ck, qf[1], cv, slope2, cl, kb, d00 + 32, m[1], l[1], o[1][0], o[1][1], hi);
        } else {
#pragma unroll
            for (int i = 0; i < 2; ++i) {
                const int qbi = 2 * Q + i;
                if (kb <= qbi) {
                    const int d0 = (qbi - kb) * 32 + r32;
                    if (kb == qbi) sm_step<MODE, true, NDS>(ck, qf[i], cv, slope2, cl, kb, d0, m[i], l[i], o[i][0], o[i][1], hi);
                    else           sm_step<MODE, false, NDS>(ck, qf[i], cv, slope2, cl, kb, d0, m[i], l[i], o[i][0], o[i][1], hi);
                }
            }
        }
    }
    l[0] = x32_sum(l[0]); l[1] = x32_sum(l[1]);
}

__device__ __forceinline__ void sb_unit(const bf16_t* Qs, const bf16_t* Ks, const bf16_t* VTs, int qb, f32x16& o0, f32x16& o1, int lane) {
    const int r32 = lane & 31, hi = lane >> 5;
    constexpr float SC2 = 0.125f * LOG2E;
    bf16x8 qf[4]; q_load(qf, Qs, qb, r32, hi);
    KFrag nx; k_load(nx, Ks, qb, lane);
    float R = 0.f;
#pragma unroll
    for (int i = 0; i < 16; ++i) { o0[i] = 0.f; o1[i] = 0.f; }
    for (int kb = qb; kb >= 0; --kb) {
        const KFrag cu = nx; VFrag cv; v_load(cv, VTs, kb, lane);
        if (kb > 0) k_load(nx, Ks, kb - 1, lane);
        f32x16 s;
#pragma unroll
        for (int i = 0; i < 16; ++i) s[i] = 0.f;
#pragma unroll
        for (int ds = 0; ds < 4; ++ds) s = MFMA32(cu.k[ds], qf[ds], s);
        float lk[16], ls[16];
        const int d0 = (qb - kb) * 32 + r32;
#pragma unroll
        for (int r = 0; r < 16; ++r) { const float z2 = s[r] * SC2; const float sp = fmaxf(z2, 0.f) + lg2(1.0f + ex2(-fabsf(z2))); const bool valid = crow(r, hi) < d0; lk[r] = valid ? -sp : 0.f; ls[r] = valid ? (z2 - sp) : -INFINITY; }
        float e[16], tq[4], pq[4];
#pragma unroll
        for (int g = 0; g < 4; ++g) { e[4 * g + 3] = 0.f; e[4 * g + 2] = lk[4 * g + 3]; e[4 * g + 1] = e[4 * g + 2] + lk[4 * g + 2]; e[4 * g] = e[4 * g + 1] + lk[4 * g + 1]; tq[g] = e[4 * g] + lk[4 * g]; }
#pragma unroll
        for (int g = 0; g < 4; ++g) pq[g] = x32_partner(tq[g], hi);
        float cs[4]; cs[3] = 0.f; cs[2] = tq[3] + pq[3]; cs[1] = cs[2] + (tq[2] + pq[2]); cs[0] = cs[1] + (tq[1] + pq[1]);
        const float total = cs[0] + (tq[0] + pq[0]);
#pragma unroll
        for (int g = 0; g < 4; ++g) { const float later = R + cs[g] + (hi == 0 ? pq[g] : 0.f);
#pragma unroll
            for (int i = 0; i < 4; ++i) s[4 * g + i] = ex2(ls[4 * g + i] + e[4 * g + i] + later); }
        R += total;
        const bf16x8 pf0 = pack8(s, 0), pf1 = pack8(s, 8);
        o0 = MFMA32(cv.v[0], pf0, o0); o0 = MFMA32(cv.v[1], pf1, o0); o1 = MFMA32(cv.v[2], pf0, o1); o1 = MFMA32(cv.v[3], pf1, o1);
        if (__all(R < -150.0f)) break;
    }
}

#define XB_TMO      128
#define XB_XCNT(j)  (256  + 64 * (j))
#define XB_XSUB(j)  (1280 + 64 * (j))
#define XB_XGEN(j)  (2304 + 64 * (j))
#define XB_TOP      3328
#define XB_TOPGEN   3392
#define XCD_BAR_WORDS 3456
#define XB_SPIN_CAP (1u << 18)
__device__ __forceinline__ unsigned xb_ld(unsigned* p)              { return __hip_atomic_load(p, __ATOMIC_RELAXED, __HIP_MEMORY_SCOPE_AGENT); }
__device__ __forceinline__ unsigned xb_add(unsigned* p, unsigned v) { return __hip_atomic_fetch_add(p, v, __ATOMIC_RELAXED, __HIP_MEMORY_SCOPE_AGENT); }
__device__ __forceinline__ unsigned xb_xcc_id() { return (unsigned)__builtin_amdgcn_s_getreg((3 << 11) | 20) & 0xFu; }
#define XB_SPIN(cond, bar) do { unsigned _sp = 0; while (cond) { __builtin_amdgcn_s_sleep(1); \
    if ((++_sp & 255u) == 0u) { if (xb_ld(&(bar)[XB_TMO])) break; if (_sp > XB_SPIN_CAP) { atomicAdd(&(bar)[XB_TMO], 1u); break; } } } } while (0)
__device__ __forceinline__ void xcd_barrier_complete(unsigned* bar, unsigned x, unsigned& nloc, unsigned& nx) {
    const unsigned G = gridDim.x * gridDim.y * gridDim.z;
    unsigned sum, cnt, mine, sp = 0u;
    for (;;) {
        sum = 0u; cnt = 0u; mine = 0u;
#pragma unroll
        for (unsigned j = 0; j < 16; ++j) { const unsigned c = xb_ld(&bar[XB_XCNT(j)]); sum += c; cnt += (c > 0u) ? 1u : 0u; mine = (j == x) ? c : mine; }
        if (sum == G) break;
        __builtin_amdgcn_s_sleep(1);
        if ((++sp & 255u) == 0u) { if (xb_ld(&bar[XB_TMO])) break; if (sp > XB_SPIN_CAP) { atomicAdd(&bar[XB_TMO], 1u); break; } }
    }
    nloc = mine > 0u ? mine : 1u; nx = cnt > 0u ? cnt : 1u;
}
__device__ __forceinline__ void xcd_barrier(unsigned* bar, volatile LAS unsigned* st, int wave_k) {
    asm volatile("s_waitcnt vmcnt(0)" ::: "memory");
    __syncthreads();
    if (wave_k == 0 && lane_id_hw() == 0) {
        const unsigned x = xb_xcc_id();
        __builtin_amdgcn_s_waitcnt(0);
        unsigned nloc = st[0], nx = st[1];
        if (nloc == 0u) { xcd_barrier_complete(bar, x, nloc, nx); st[0] = nloc; st[1] = nx; }
        const unsigned old = xb_add(&bar[XB_XSUB(x)], 1u);
        const unsigned gen = old / nloc;
        if (old + 1u == (gen + 1u) * nloc) {
            __builtin_amdgcn_fence(__ATOMIC_RELEASE, "agent");
            asm volatile("s_waitcnt vmcnt(0)" ::: "memory");
            const unsigned og = xb_add(&bar[XB_TOP], 1u);
            const unsigned tg = og / nx;
            if (og + 1u == (tg + 1u) * nx) xb_add(&bar[XB_TOPGEN], 1u);
            else XB_SPIN(xb_ld(&bar[XB_TOPGEN]) == tg, bar);
            __builtin_amdgcn_fence(__ATOMIC_ACQUIRE, "agent");
            xb_add(&bar[XB_XGEN(x)], 1u);
            asm volatile("s_waitcnt vmcnt(0)" ::: "memory");
        } else {
            XB_SPIN(xb_ld(&bar[XB_XGEN(x)]) == gen, bar);
            __builtin_amdgcn_fence(__ATOMIC_ACQUIRE, "agent");
            asm volatile("s_waitcnt vmcnt(0)" ::: "memory");
        }
    }
    __syncthreads();
}
constexpr int MISC_OFF = 131072 + 320;

struct Params {
    const float* x; const float* mix_g; const float* w_in; const float* b_forget; const float* lq1; const float* lk1; const float* lq2; const float* lk2;
    const float* diff_g; const float* w_branch; const float* w_out; const float* mlp_g; const float* w_up; const float* w_down; const float* final_g;
    float* out; unsigned char* ws;
};

#ifndef REP_P1
#define REP_P1 1
#endif
#ifndef REP_P2
#define REP_P2 1
#endif
#ifndef REP_P3
#define REP_P3 1
#endif
#ifndef REP_P5
#define REP_P5 1
#endif
#ifndef REP_SYNC
#define REP_SYNC 1
#endif
#ifndef REP_CONV
#define REP_CONV 1
#endif
#define GSYNC() do { for (int rs_ = 0; rs_ < REP_SYNC; ++rs_) { KParamsPtr pb_ = OPQ_PP(); xcd_barrier((unsigned*)(pb_->ws + WS_CTL) + CW_BAR, (volatile LAS unsigned*)(lds + MISC_OFF), wave_k); } } while (0)
#define OPQ_TID() ({ int t_ = wave_k * 64 + lane_id_hw(); asm volatile("" : "+v"(t_)); t_; })
typedef const __attribute__((address_space(4))) Params* KParamsPtr;
#define OPQ_PP() ({ KParamsPtr p_ = (KParamsPtr)__builtin_amdgcn_kernarg_segment_ptr(); asm volatile("" : "+s"(p_)); p_; })
#define PHASE_VARS() const int tid = OPQ_TID(); const int lane = tid & 63, wave = __builtin_amdgcn_readfirstlane(tid >> 6); const int G = gridDim.x, bx = blockIdx.x; \
    const int gw = bx * NWAVES + wave, NGW = G * NWAVES; KParamsPtr PP = OPQ_PP(); unsigned char* ws = PP->ws; LAS float* scr = (LAS float*)(lds + wave * 16384); (void)lane; (void)gw; (void)NGW; (void)ws; (void)scr; (void)G; (void)bx; (void)PP

__global__ void __launch_bounds__(NWAVES * 64, 2) fwd_mega(Params P) {
    extern __shared__ __attribute__((aligned(16))) unsigned char lds_raw[];
    LAS unsigned char* lds = (LAS unsigned char*)lds_raw;
    cg::grid_group grid = cg::this_grid();
    const int wave_k = __builtin_amdgcn_readfirstlane((int)(threadIdx.x >> 6));
    { KParamsPtr pz = OPQ_PP(); if (pz->ws == nullptr) grid.sync(); }
    { const int t0 = OPQ_TID(); if (t0 < 64) ((LAS unsigned*)(lds + 131072))[t0 + 64] = 0u; __syncthreads();
      if (t0 == 0) { KParamsPtr p0 = OPQ_PP(); (void)xb_add((unsigned*)(p0->ws + WS_CTL) + CW_BAR + XB_XCNT(xb_xcc_id()), 1u); } }

    {
        PHASE_VARS();
        bf16_t* XB = (bf16_t*)(ws + WS_XB); float* SSQ = (float*)(ws + WS_SSQ);
        for (int row = gw; row < TOK; row += NGW) {
            const f32x4* xr = (const f32x4*)(PP->x + (size_t)row * DM) + lane;
            unsigned long long* o8 = (unsigned long long*)(XB + (size_t)row * DM) + lane;
            float s = 0.f;
#pragma unroll
            for (int j = 0; j < 4; ++j) { const f32x4 v = xr[64 * j]; s += (v[0] * v[0] + v[1] * v[1]) + (v[2] * v[2] + v[3] * v[3]);
                o8[64 * j] = (unsigned long long)cvtpk(v[0], v[1]) | ((unsigned long long)cvtpk(v[2], v[3]) << 32); }
            s = wave_sum(s);
            if (lane < 16) SSQ[(size_t)row * 16 + lane] = (lane == 0) ? s : 0.f;
        }
    }

    for (int layer = 0; layer < DEPTH; ++layer) {
        for (int rep = 0; rep < REP_CONV; ++rep) {
            PHASE_VARS();
            bf16_t* WIN = (bf16_t*)(ws + WS_WIN); bf16_t* WB = (bf16_t*)(ws + WS_WB); bf16_t* WOUT = (bf16_t*)(ws + WS_WOUT);
            const float* w_in = PP->w_in + (size_t)layer * DM * DIN; const float* mg = PP->mix_g + (size_t)layer * DM;
            const float* wb = PP->w_branch + (size_t)layer * 4 * 256 * DM; const float* wo = PP->w_out + (size_t)layer * DM * DM;
            constexpr int I_IN = (DM / 64) * (NPROJ / 32), I_B = (256 / 64) * (DM / 32), I_O = (DM / 64) * (DM / 32);
            for (int it = gw; it < I_IN + 4 * I_B + I_O; it += NGW) {
                int r = it;
                if (r < I_IN) { transpose_item<1>(w_in, DM, NPROJ, DIN, mg, WIN, scr, r, lane); continue; } r -= I_IN;
                if (r < 4 * I_B) { const int n = r / I_B; branch_item(wb + (size_t)n * 256 * DM, n, WB, scr, r % I_B, lane); continue; } r -= 4 * I_B;
                transpose_item<0>(wo, DM, DM, DM, nullptr, WOUT, scr, r, lane);
            }
        }
        GSYNC();

        for (int half = 0; half < 2; ++half) {
#ifndef NO_P1
            for (int rep = 0; rep < REP_P1; ++rep) {
                PHASE_VARS();
                const int rb = half * HT;
                pg8::Gemm g{(const bf16_t*)(ws + WS_XB) + (size_t)rb * DM, (const bf16_t*)(ws + WS_WIN), DM, DM, DM, 0, 0};
                pg8::StaticOrder S; S.init(HT, NPROJ, G, bx, WGM_P1);
                pg8::EpiProj E{(const float*)(ws + WS_SSQ), rb, (bf16_t*)(ws + WS_QK), (bf16_t*)(ws + WS_KF), (bf16_t*)(ws + WS_VT), (float*)(ws + WS_FL), (bf16_t*)(ws + WS_GATE)};
                pg8::gemm_phase<pg8::EpiProj, pg8::StaticOrder, true>(lds, g, S, E, wave_k);
            }
#endif
            GSYNC();
#ifndef NO_P2
            for (int rep = 0; rep < REP_P2; ++rep) {
                PHASE_VARS();
                unsigned* ctr = (unsigned*)(ws + WS_CTL) + 64 + 512 * (layer * 2 + half + 4 * rep);
                const int xq = bx & 7;
                ctr += 64 * xq;
                for (;;) {
                    int li = 0; if (lane == 0) li = (int)atomicAdd(ctr, 1u); li = __builtin_amdgcn_readfirstlane(li);
                    if (li >= 800) break;
                    int idx;
                    if (li < 288) { const int row = li / 6, hl = li - row * 6; idx = row * 48 + (xq + 8 * hl); }
                    else if (li < 416) { const int i = li - 288; idx = 2304 + ((63 - (i & 63)) << 4) + (xq + 8 * (i >> 6)); }
                    else { const int i = li - 416; idx = 3328 + (xq + 8 * (i >> 6)) * 64 + (i & 63); }
                    int lane_u = lane; asm volatile("" : "+v"(lane_u));
                    const int lane = lane_u, r32 = lane & 31, hi = lane >> 5;
                    KParamsPtr PU = OPQ_PP(); unsigned char* wsu = PU->ws;
                    bf16_t* YS = (bf16_t*)(wsu + WS_YS); bf16_t* DILO = (bf16_t*)(wsu + WS_DILO); float* LSE = (float*)(wsu + WS_LSE); const float* FL = (const float*)(wsu + WS_FL);
                    const bf16_t* QK = (const bf16_t*)(wsu + WS_QK); const bf16_t* KF = (const bf16_t*)(wsu + WS_KF); const bf16_t* VT = (const bf16_t*)(wsu + WS_VT);
                    if (idx < 2304) {
                        const int j = idx / 48, e = idx - j * 48, type3 = e >> 4, bh = e & 15, b = bh >> 2, h = bh & 3;
                        int Q, chunk; if (j < 32) { Q = 31 - (j >> 1); chunk = j & 1; } else { Q = 47 - j; chunk = 0; }
                        int kb_lo = 0, kb_hi = 2 * Q + 1;
                        if (Q >= 16) { if (chunk == 0) kb_hi = Q; else kb_lo = Q + 1; }
                        const size_t rowb = (size_t)b * SEQ;
                        bf16_t* SCRB = (bf16_t*)(wsu + WS_MERGED) + (size_t)(half * HT) * DM;
                        float* LSE2 = (float*)(wsu + WS_LSE2);
                        f32x16 o[2][2]; float m[2], l[2]; int slot;
                        if (type3 == 2) {
                            LAS float* cl = scr;
                            const float bf = PP->b_forget[layer * 4 + h];
                            float run = 0.f;
                            if (lane <= kb_hi) {
                                const float* fp = FL + (rowb + 32 * lane) * 4 + h;
#pragma unroll 8
                                for (int i = 0; i < 32; ++i) { const float y = fp[4 * i] + bf; const float lf = fminf(y, 0.f) - __logf(1.0f + __expf(-fabsf(y))); run += lf; cl[33 * lane + i] = run; }
                            }
                            float incl = run;
#pragma unroll
                            for (int o_ = 1; o_ < 64; o_ <<= 1) { const float tt = __uint_as_float((unsigned)__builtin_amdgcn_ds_bpermute((lane - o_) << 2, (int)__float_as_uint(incl))); if (lane >= o_) incl += tt; }
                            const float excl = incl - run;
                            if (lane <= kb_hi) {
#pragma unroll 8
                                for (int i = 0; i < 32; ++i) cl[33 * lane + i] = -(cl[33 * lane + i] + excl) * LOG2E;
                            }
                            asm volatile("s_waitcnt lgkmcnt(0)" ::: "memory");
                            sm_unit64<0>(QK + rowb * LDQK + 4 * 256 + h * 64, KF + (size_t)(b * 24 + 16 + h) * HSEQ, VT + (size_t)(b * 24 + 16 + h) * HSEQ, Q, kb_hi, kb_lo, 0.f, cl, o, m, l, lane);
                            asm volatile("s_waitcnt lgkmcnt(0)" ::: "memory");
                            slot = chunk;
                        } else {
                            const float slope = exp2f(-8.0f * (float)(5 + h) / 16.0f);
                            sm_unit64<2>(QK + rowb * LDQK + 5 * 256 + h * 64 + type3 * 32, KF + (size_t)(b * 24 + 20 + h) * HSEQ + type3 * 1024, VT + (size_t)(b * 24 + 20 + h) * HSEQ, Q, kb_hi, kb_lo, slope * LOG2E, nullptr, o, m, l, lane);
                            slot = 2 + 2 * type3 + chunk;
                        }
#pragma unroll
                        for (int i = 0; i < 2; ++i) {
                            const int t = (2 * Q + i) * 32 + r32;
                            bf16_t* dst;
                            if (type3 == 2) dst = chunk ? SCRB + (rowb + t) * 256 + h * 64 : YS + (rowb + t) * DM + 512 + h * 64;
                            else dst = (type3 == 0 && chunk == 0) ? YS + (rowb + t) * DM + 768 + h * 64 : SCRB + (size_t)(2 * type3 + chunk) * HT * 256 + (rowb + t) * 256 + h * 64;
                            const float inv = 1.0f / l[i];
#pragma unroll
                            for (int k = 0; k < 16; ++k) { o[i][0][k] *= inv; o[i][1][k] *= inv; }
                            store_o(dst, o[i][0], o[i][1], hi);
                            if (hi == 0) LSE2[(rowb + t) * 24 + h * 6 + slot] = m[i] + lg2(l[i]);
                        }
                    } else if (idx < 3328) {
                        const int i1 = idx - 2304, qb = 63 - (i1 >> 4), bh = i1 & 15, b = bh >> 2, h = bh & 3;
                        const size_t rowb = (size_t)b * SEQ; const int t = qb * 32 + r32;
                        f32x16 o0, o1;
                        sb_unit(QK + rowb * LDQK + 0 * 256 + h * 64, KF + (size_t)(b * 24 + h) * HSEQ, VT + (size_t)(b * 24 + h) * HSEQ, qb, o0, o1, lane);
                        store_o(YS + (rowb + t) * DM + 0 * 256 + h * 64, o0, o1, hi);
                    } else {
                        const int i2 = idx - 3328, j = i2 & 63, gh = (i2 >> 6) % 12, b = i2 / 768, gI = gh >> 2, h = gh & 3;
                        const int rsh = 2 * gI, r = 1 << rsh, sl = SEQ >> rsh, nubsh = 6 - rsh, rho = j >> nubsh, ub = j & ((1 << nubsh) - 1);
                        const int sidx = (gI == 0) ? h : (gI == 1 ? 8 + h : 12 + h);
                        const float slope = exp2f(-8.0f * (float)(sidx + 1) / 16.0f);
                        const size_t rowb = (size_t)b * SEQ + (size_t)rho * sl;
                        f32x16 o0, o1; float m, l;
                        const int kb_lo = (ub - 4 > 0) ? ub - 4 : 0;
                        sm_unit<1>(QK + rowb * LDQK + (1 + gI) * 256 + h * 64, KF + (size_t)(b * 24 + 4 + 4 * gI + h) * HSEQ + (size_t)rho * sl * 64,
                                   VT + (size_t)(b * 24 + 4 + 4 * gI + h) * HSEQ + (size_t)rho * sl * 64, ub, ub, kb_lo, slope * (float)r * LOG2E, nullptr, o0, o1, m, l, lane);
                        const float inv = 1.0f / l;
#pragma unroll
                        for (int i = 0; i < 16; ++i) { o0[i] *= inv; o1[i] *= inv; }
                        const int u = ub * 32 + r32; const size_t tok = (size_t)b * SEQ + (size_t)u * r + rho;
                        store_o(DILO + tok * 768 + gI * 256 + h * 64, o0, o1, hi);
                        if (hi == 0) LSE[tok * 12 + gI * 4 + h] = (m + lg2(l)) * LN2;
                    }
                }
            }
#endif
            GSYNC();
            {
                PHASE_VARS();
                const float lam_init = (layer == 0) ? 0.2f : 0.35550906759093115f;
                float lam;
                { const float a = (lane < 32) ? PP->lq1[layer * 32 + lane] * PP->lk1[layer * 32 + lane] : 0.f, b = (lane < 32) ? PP->lq2[layer * 32 + lane] * PP->lk2[layer * 32 + lane] : 0.f;
                  lam = __expf(wave_sum(a)) - __expf(wave_sum(b)) + lam_init; }
                bf16_t* YS = (bf16_t*)(ws + WS_YS); const bf16_t* DILO = (const bf16_t*)(ws + WS_DILO); const float* LSE = (const float*)(ws + WS_LSE);
                const bf16_t* SCRB = (const bf16_t*)(ws + WS_MERGED) + (size_t)(half * HT) * DM; const float* LSE2 = (const float*)(ws + WS_LSE2);
                const int h = lane >> 4, dq = (lane & 15) * 4;
                const f32x4 dgv = *(const f32x4*)(PP->diff_g + layer * 64 + dq);
                for (int row = gw; row < HT; row += NGW) {
                    const bool split = ((row & (SEQ - 1)) >> 5) >= 32;
                    {
                        const float l0 = LSE[(size_t)row * 12 + h], l1 = LSE[(size_t)row * 12 + 4 + h], l2 = LSE[(size_t)row * 12 + 8 + h];
                        const float mx = fmaxf(l0, fmaxf(l1, l2)); const float e0 = __expf(l0 - mx), e1 = __expf(l1 - mx), e2 = __expf(l2 - mx); const float inv = 1.0f / (e0 + e1 + e2);
                        const u32x2 a = *(const u32x2*)(DILO + (size_t)row * 768 + 4 * lane), b = *(const u32x2*)(DILO + (size_t)row * 768 + 256 + 4 * lane), c = *(const u32x2*)(DILO + (size_t)row * 768 + 512 + 4 * lane);
                        const float w0 = e0 * inv, w1 = e1 * inv, w2 = e2 * inv;
                        u32x2 o; o.x = cvtpk(w0 * bflo(a.x) + w1 * bflo(b.x) + w2 * bflo(c.x), w0 * bfhi(a.x) + w1 * bfhi(b.x) + w2 * bfhi(c.x));
                        o.y = cvtpk(w0 * bflo(a.y) + w1 * bflo(b.y) + w2 * bflo(c.y), w0 * bfhi(a.y) + w1 * bfhi(b.y) + w2 * bfhi(c.y));
                        *(u32x2*)(YS + (size_t)row * DM + 256 + 4 * lane) = o;
                    }
                    const float* ls = LSE2 + (size_t)row * 24 + h * 6;
                    const u32x2 f0 = *(const u32x2*)(YS + (size_t)row * DM + 512 + 4 * lane), a0 = *(const u32x2*)(YS + (size_t)row * DM + 768 + 4 * lane);
                    const u32x2 b0 = *(const u32x2*)(SCRB + (size_t)2 * HT * 256 + (size_t)row * 256 + 4 * lane);
                    float fv[4] = {bflo(f0.x), bfhi(f0.x), bflo(f0.y), bfhi(f0.y)}, av[4] = {bflo(a0.x), bfhi(a0.x), bflo(a0.y), bfhi(a0.y)}, bv[4] = {bflo(b0.x), bfhi(b0.x), bflo(b0.y), bfhi(b0.y)};
                    if (split) {
                        const u32x2 f1 = *(const u32x2*)(SCRB + (size_t)row * 256 + 4 * lane), a1 = *(const u32x2*)(SCRB + (size_t)1 * HT * 256 + (size_t)row * 256 + 4 * lane), b1 = *(const u32x2*)(SCRB + (size_t)3 * HT * 256 + (size_t)row * 256 + 4 * lane);
                        const float lf0 = ls[0], lf1 = ls[1], la0 = ls[2], la1 = ls[3], lb0 = ls[4], lb1 = ls[5];
                        { const float mx = fmaxf(lf0, lf1), e0 = ex2(lf0 - mx), e1 = ex2(lf1 - mx), inv = 1.0f / (e0 + e1), w0 = e0 * inv, w1 = e1 * inv;
                          fv[0] = w0 * fv[0] + w1 * bflo(f1.x); fv[1] = w0 * fv[1] + w1 * bfhi(f1.x); fv[2] = w0 * fv[2] + w1 * bflo(f1.y); fv[3] = w0 * fv[3] + w1 * bfhi(f1.y); }
                        { const float mx = fmaxf(la0, la1), e0 = ex2(la0 - mx), e1 = ex2(la1 - mx), inv = 1.0f / (e0 + e1), w0 = e0 * inv, w1 = e1 * inv;
                          av[0] = w0 * av[0] + w1 * bflo(a1.x); av[1] = w0 * av[1] + w1 * bfhi(a1.x); av[2] = w0 * av[2] + w1 * bflo(a1.y); av[3] = w0 * av[3] + w1 * bfhi(a1.y); }
                        { const float mx = fmaxf(lb0, lb1), e0 = ex2(lb0 - mx), e1 = ex2(lb1 - mx), inv = 1.0f / (e0 + e1), w0 = e0 * inv, w1 = e1 * inv;
                          bv[0] = w0 * bv[0] + w1 * bflo(b1.x); bv[1] = w0 * bv[1] + w1 * bfhi(b1.x); bv[2] = w0 * bv[2] + w1 * bflo(b1.y); bv[3] = w0 * bv[3] + w1 * bfhi(b1.y); }
                        u32x2 fo; fo.x = cvtpk(fv[0], fv[1]); fo.y = cvtpk(fv[2], fv[3]);
                        *(u32x2*)(YS + (size_t)row * DM + 512 + 4 * lane) = fo;
                    }
                    float dv[4]; float ss = 0.f;
#pragma unroll
                    for (int i = 0; i < 4; ++i) { dv[i] = av[i] - lam * bv[i]; ss += dv[i] * dv[i]; }
                    ss += swz_xor<1>(ss); ss += swz_xor<2>(ss); ss += swz_xor<4>(ss); ss += swz_xor<8>(ss);
                    const float rn = __builtin_amdgcn_rsqf(ss * (1.0f / 64.0f) + RMS_EPS) * (1.0f - lam_init);
                    u32x2 dout; dout.x = cvtpk(dv[0] * rn * dgv[0], dv[1] * rn * dgv[1]); dout.y = cvtpk(dv[2] * rn * dgv[2], dv[3] * rn * dgv[3]);
                    *(u32x2*)(YS + (size_t)row * DM + 768 + 4 * lane) = dout;
                }
            }
            GSYNC();
#ifndef NO_P3
            for (int rep = 0; rep < REP_P3; ++rep) {
                PHASE_VARS();
                pg8::Gemm g{(const bf16_t*)(ws + WS_YS), (const bf16_t*)(ws + WS_WB), DM, 512, 512, 512 * 2, (long)8 * 256 * 512 * 2};
                pg8::BranchOrder S{bx, G};
                pg8::EpiBranch E{(const bf16_t*)(ws + WS_GATE), (bf16_t*)(ws + WS_MERGED), half * HT};
                pg8::gemm_phase<pg8::EpiBranch, pg8::BranchOrder, true, false>(lds, g, S, E, wave_k);
            }
#endif
            GSYNC();
        }
#ifndef NO_P4
        for (int rep = 0; rep < REP_CONV; ++rep) {
            PHASE_VARS();
            bf16_t* WUP = (bf16_t*)(ws + WS_WUP); bf16_t* WDN = (bf16_t*)(ws + WS_WDN);
            const float* wu = PP->w_up + (size_t)layer * DM * DFF; const float* wd = PP->w_down + (size_t)layer * DFF * DM; const float* mg = PP->mlp_g + (size_t)layer * DM;
            constexpr int I_U = (DM / 64) * (DFF / 32), I_D = (DFF / 64) * (DM / 32);
            for (int it = gw; it < I_U + I_D; it += NGW) {
                if (it < I_U) transpose_item<0>(wu, DM, DFF, DFF, mg, WUP, scr, it, lane);
                else transpose_item<0>(wd, DFF, DM, DM, nullptr, WDN, scr, it - I_U, lane);
            }
            __syncthreads();
        }
        {
            PHASE_VARS();
            pg8::Gemm g{(const bf16_t*)(ws + WS_MERGED), (const bf16_t*)(ws + WS_WOUT), DM, DM, DM, 0, 0};
            pg8::StaticOrder S; S.init(TOK, DM, G, bx);
            pg8::EpiResid E{(layer == 0) ? PP->x : (const float*)PP->out, PP->out, (bf16_t*)(ws + WS_XB), (float*)(ws + WS_SSQ)};
            pg8::gemm_phase<pg8::EpiResid, pg8::StaticOrder, false>(lds, g, S, E, wave_k);
        }
#endif
        GSYNC();
#ifndef NO_P5
        for (int rep = 0; rep < REP_P5; ++rep) {
            PHASE_VARS();
            pg8::Gemm g{(const bf16_t*)(ws + WS_XB), (const bf16_t*)(ws + WS_WUP), DM, DM, DM, 0, 0};
            pg8::StaticOrder S; S.init(TOK, DFF, G, bx, WGM_P5);
            pg8::EpiUp E{(const float*)(ws + WS_SSQ), (bf16_t*)(ws + WS_HMLP)};
            pg8::gemm_phase<pg8::EpiUp, pg8::StaticOrder, true>(lds, g, S, E, wave_k);
        }
#endif
        GSYNC();
#ifndef NO_P6
        {
            PHASE_VARS();
            pg8::Gemm g{(const bf16_t*)(ws + WS_HMLP), (const bf16_t*)(ws + WS_WDN), DFF, DFF, DFF, 0, 0};
            pg8::StaticOrder S; S.init(TOK, DM, G, bx);
            if (layer == DEPTH - 1 && G == 256) {
                pg8::EpiFinal E{(const float*)PP->out, PP->out, (float*)(ws + WS_SSQ), PP->final_g, (unsigned*)(ws + WS_CTL) + CW_PANEL};
                pg8::gemm_phase<pg8::EpiFinal, pg8::StaticOrder, true>(lds, g, S, E, wave_k);
            } else {
                pg8::EpiResid E{(const float*)PP->out, PP->out, (bf16_t*)(ws + WS_XB), (float*)(ws + WS_SSQ)};
                pg8::gemm_phase<pg8::EpiResid, pg8::StaticOrder, false>(lds, g, S, E, wave_k);
            }
        }
#endif
        if (layer < DEPTH - 1 || gridDim.x != 256) GSYNC();
    }
    if (gridDim.x != 256)
    {
        PHASE_VARS();
        float* X = PP->out;
        for (int row = gw; row < TOK; row += NGW) {
            f32x4* xo = (f32x4*)(X + (size_t)row * DM) + lane; const f32x4* gp = (const f32x4*)PP->final_g + lane;
            f32x4 v[4]; float s = 0.f;
#pragma unroll
            for (int j = 0; j < 4; ++j) { v[j] = xo[64 * j]; s += (v[j][0] * v[j][0] + v[j][1] * v[j][1]) + (v[j][2] * v[j][2] + v[j][3] * v[j][3]); }
            const float rstd = __builtin_amdgcn_rsqf(wave_sum(s) * (1.0f / DM) + RMS_EPS);
#pragma unroll
            for (int j = 0; j < 4; ++j) xo[64 * j] = v[j] * rstd * gp[64 * j];
        }
    }
}

extern "C" void kernel_launch(void* const* d_in, const int* in_sizes, int n_in, void* d_out, int out_size, void* d_ws, size_t ws_size, hipStream_t stream) {
    static int grid = 0;
    if (grid == 0) {
        if (n_in != 15 || in_sizes[0] != TOK * DM || out_size != TOK * DM || ws_size < WS_END) { fprintf(stderr, "kernel_launch: unexpected shapes / workspace (n_in %d, ws %zu)\n", n_in, ws_size); grid = -1; return; }
        int dev = 0, cus = 0, per_cu = 0;
        hipGetDevice(&dev); hipDeviceGetAttribute(&cus, hipDeviceAttributeMultiprocessorCount, dev);
        hipFuncSetAttribute((const void*)fwd_mega, hipFuncAttributeMaxDynamicSharedMemorySize, LDS_BYTES);
        hipOccupancyMaxActiveBlocksPerMultiprocessor(&per_cu, (const void*)fwd_mega, NWAVES * 64, LDS_BYTES);
        (void)hipGetLastError();
        if (per_cu < 1) per_cu = 1;
        grid = cus;
        if (grid > 256) grid = 256;
        if (grid % 8 != 0) { fprintf(stderr, "kernel_launch: the per-XCD work queues need a grid that is a multiple of 8 (got %d)\n", grid); grid = -1; return; }
    }
    if (grid < 0) return;
    hipMemsetAsync((char*)d_ws + WS_CTL, 0, CTL_BYTES, stream);
    Params p{};
    p.x = (const float*)d_in[0]; p.mix_g = (const float*)d_in[1]; p.w_in = (const float*)d_in[2]; p.b_forget = (const float*)d_in[3];
    p.lq1 = (const float*)d_in[4]; p.lk1 = (const float*)d_in[5]; p.lq2 = (const float*)d_in[6]; p.lk2 = (const float*)d_in[7];
    p.diff_g = (const float*)d_in[8]; p.w_branch = (const float*)d_in[9]; p.w_out = (const float*)d_in[10]; p.mlp_g = (const float*)d_in[11];
    p.w_up = (const float*)d_in[12]; p.w_down = (const float*)d_in[13]; p.final_g = (const float*)d_in[14];
    p.out = (float*)d_out; p.ws = (unsigned char*)d_ws;
    void* args[] = {&p};
    hipError_t e = hipLaunchCooperativeKernel((const void*)fwd_mega, dim3(grid), dim3(NWAVES * 64), args, LDS_BYTES, stream);
    if (e != hipSuccess) fprintf(stderr, "cooperative launch failed: %s (grid %d)\n", hipGetErrorString(e), grid);
}
```

```cpp
#include <hip/hip_runtime.h>
#include <hip/hip_cooperative_groups.h>
#include <cstdio>
#include <cstdint>
namespace cg = cooperative_groups;

#define LAS __attribute__((address_space(3)))
typedef unsigned short bf16_t;
typedef short bf16x8 __attribute__((ext_vector_type(8)));
typedef float f32x4 __attribute__((ext_vector_type(4)));
typedef float f32x16 __attribute__((ext_vector_type(16)));
typedef unsigned u32x4 __attribute__((ext_vector_type(4)));
typedef unsigned u32x2 __attribute__((ext_vector_type(2)));
typedef float f32x2_t __attribute__((ext_vector_type(2)));
typedef __bf16 bf16x2_t __attribute__((ext_vector_type(2)));

constexpr int DM = 1024, BATCH = 8, SEQ = 2048, DEPTH = 2, TOK = BATCH * SEQ, DFF = 4096, DIN = 8708;
constexpr int HT = TOK / 2;
constexpr int NPROJ = 35 * 256;
constexpr int LDQK = 6 * 256;
constexpr int HSEQ = SEQ * 64;
constexpr float LOG2E = 1.4426950408889634f, LN2 = 0.6931471805599453f;
constexpr float RMS_EPS = 1e-6f;

constexpr size_t MiB = 1u << 20;
constexpr size_t WS_CTL = 0, CTL_BYTES = 65536;
constexpr int CW_BAR = 4096, CW_PANEL = 8192;
constexpr size_t WS_SSQ = 1 * MiB;
constexpr size_t WS_WIN = 2 * MiB;
constexpr size_t WS_WUP = WS_WIN, WS_WDN = WS_WIN + 8 * MiB;
constexpr size_t WS_WB = 20 * MiB;
constexpr size_t WS_WOUT = 24 * MiB;
constexpr size_t WS_XB = 26 * MiB;
constexpr size_t WS_MERGED = 58 * MiB;
constexpr size_t WS_YS = 90 * MiB;
constexpr size_t WS_DILO = 106 * MiB;
constexpr size_t WS_LSE = 118 * MiB;
constexpr size_t WS_LSE2 = 118 * MiB + 512 * 1024;
constexpr size_t WS_FL = 119 * MiB + 512 * 1024;
constexpr size_t WS_QK = 120 * MiB;
constexpr size_t WS_KF = 144 * MiB;
constexpr size_t WS_VT = 168 * MiB;
constexpr size_t WS_GATE = 192 * MiB;
constexpr size_t WS_HMLP = 120 * MiB;
constexpr size_t WS_END = 256 * MiB;

constexpr int LDS_BYTES = 147456;
constexpr int NWAVES = 8;
#ifndef WGM_P1
#define WGM_P1 4
#endif
#ifndef WGM_P5
#define WGM_P5 8
#endif

__device__ __forceinline__ unsigned cvtpk(float lo, float hi) { f32x2_t v = {lo, hi}; bf16x2_t b = __builtin_convertvector(v, bf16x2_t); return __builtin_bit_cast(unsigned, b); }
__device__ __forceinline__ float bflo(unsigned w) { return __uint_as_float(w << 16); }
__device__ __forceinline__ float bfhi(unsigned w) { return __uint_as_float(w & 0xffff0000u); }
__device__ __forceinline__ float ex2(float x) { return __builtin_amdgcn_exp2f(x); }
__device__ __forceinline__ float lg2(float x) { return __builtin_amdgcn_logf(x); }
__device__ __forceinline__ float x32_sum(float v) { auto r = __builtin_amdgcn_permlane32_swap(__float_as_uint(v), __float_as_uint(v), false, false); return __uint_as_float(r[0]) + __uint_as_float(r[1]); }
__device__ __forceinline__ float x32_max(float v) { auto r = __builtin_amdgcn_permlane32_swap(__float_as_uint(v), __float_as_uint(v), false, false); return fmaxf(__uint_as_float(r[0]), __uint_as_float(r[1])); }
__device__ __forceinline__ float x32_partner(float v, int hi) { auto r = __builtin_amdgcn_permlane32_swap(__float_as_uint(v), __float_as_uint(v), false, false); return hi ? __uint_as_float(r[0]) : __uint_as_float(r[1]); }
template <int X> __device__ __forceinline__ float swz_xor(float v) { return __uint_as_float((unsigned)__builtin_amdgcn_ds_swizzle((int)__float_as_uint(v), (X << 10) | 0x1f)); }
__device__ __forceinline__ float x16_sum(float v) { return v + swz_xor<16>(v); }
__device__ __forceinline__ float wave_sum(float v) { v += swz_xor<1>(v); v += swz_xor<2>(v); v += swz_xor<4>(v); v += swz_xor<8>(v); v += swz_xor<16>(v); return x32_sum(v); }

__device__ __forceinline__ int lane_id_hw() { return (int)__builtin_amdgcn_mbcnt_hi(~0u, __builtin_amdgcn_mbcnt_lo(~0u, 0u)); }
namespace pg8 {
constexpr int BM = 256, BK = 64, HALF = 128, HTB = HALF * BK * 2, STAGE_BYTES = 8 * HTB, NXCD = 8, WGM = 8;
__host__ __device__ __forceinline__ int lds_byte(int r, int c) { const int st = (r >> 4) * 2 + (c >> 5), rr = r & 15, cc = c & 31, ob = rr * 64 + cc * 2; return st * 1024 + (ob ^ (((ob >> 9) & 1) << 5)); }
__host__ __device__ __forceinline__ void stage_rc(int b, int& R, int& C) { const int st = b / 1024, sb = b % 1024, swz = sb ^ (((sb >> 9) & 1) << 5); R = (st >> 1) * 16 + swz / 64; C = (st & 1) * 32 + (swz % 64) / 2; }
__host__ __device__ __forceinline__ int perm32(int rho) { const int n = rho >> 4, i = rho & 15; return 8 * (i >> 2) + 4 * n + (i & 3); }

struct Unit { int pm, pn, aux; };
struct Gemm { const bf16_t* A; const bf16_t* Bt; int lda, ldb, K; long a_aux, b_aux; };

struct StaticOrder {
    int nM, nN, nwg, G, c, wgm;
    __device__ void init(int M, int N, int G_, int c_, int wgm_ = WGM) { nM = M / BM; nN = N / BM; nwg = nM * nN; G = G_; c = c_; wgm = wgm_; }
    __device__ bool next(int i, Unit& u) const {
        const long L = (long)i * G + c; if (L >= nwg) return false;
        int wgid = (int)L; { const int q = nwg / NXCD, r = nwg % NXCD, xcd = wgid % NXCD, off = wgid / NXCD; wgid = (xcd < r ? xcd * (q + 1) : r * (q + 1) + (xcd - r) * q) + off; }
        const int nig = wgm * nN, gid = wgid / nig, fm = gid * wgm, gsz = (nM - fm) < wgm ? (nM - fm) : wgm;
        u.pm = fm + ((wgid % nig) % gsz); u.pn = (wgid % nig) / gsz; u.aux = 0; return true;
    }
};
struct BranchOrder {
    int c, G;
    __device__ bool next(int i, Unit& u) const { const int t = c + (i >> 1) * G; if (t >= 256) return false; const int x = t & 7, j = t >> 3; u.pm = x + 8 * (j >> 3); u.pn = j & 7; u.aux = i & 1; return true; }
};

template <class Epi, class Sched, bool ALIGN_EPI, bool HALFB = false>
__device__ __forceinline__ void gemm_phase(LAS unsigned char* lds, const Gemm g, const Sched& S, const Epi& E, int wave_k) {
    int tid_ = wave_k * 64 + lane_id_hw(); asm volatile("" : "+v"(tid_));
    const int tid = tid_, wid = __builtin_amdgcn_readfirstlane(tid >> 6), lane = tid & 63, wr = wid >> 2, wc = wid & 3, fr = lane & 15, fq = lane >> 4;
    int nt_ = g.K / BK; asm volatile("" : "+s"(nt_)); const int nt = nt_;
    unsigned voffA[2], voffB[2];
#pragma unroll
    for (int i = 0; i < 2; ++i) { int R, C; stage_rc(tid * 16 + i * 8192, R, C); const int Rb = Epi::PERM ? ((R & ~31) + perm32(R & 31)) : R;
        voffA[i] = (unsigned)(R * g.lda + C) * 2u; voffB[i] = (unsigned)(Rb * g.ldb + C) * 2u; }
    const size_t kstep = (size_t)(BK * 2);
    const size_t hstepA = (size_t)HALF * g.lda * 2, hstepB = (size_t)HALF * g.ldb * 2;
    const size_t tstepA = 2 * hstepA, tstepB = 2 * hstepB;
    const unsigned ldsw = (unsigned)wid * 1024u;
    const int aoff = lds_byte(wr * 64 + fr, fq * 8), boff = lds_byte(wc * 32 + fr, fq * 8);
#define PG8_SA(b, h) (((b) * 2 + (h)) * HTB)
#define PG8_SB(b, h) ((4 + (b) * 2 + (h)) * HTB)
#define PG8_STAGE(bufoff, gbase, voff) do { _Pragma("unroll") for (int _i = 0; _i < 2; ++_i) \
        __builtin_amdgcn_global_load_lds((const unsigned*)((const char*)(gbase) + (voff)[_i]), (LAS unsigned*)(lds + (bufoff) + ldsw + _i * 8192), 16, 0, 0); } while (0)
#define PG8_LDA(dst, b, h) do { _Pragma("unroll") for (int m = 0; m < 4; ++m) _Pragma("unroll") for (int k = 0; k < 2; ++k) dst[m][k] = *(const LAS bf16x8*)(lds + PG8_SA(b, h) + aoff + m * 2048 + k * 1024); } while (0)
#define PG8_LDB(dst, b, h) do { _Pragma("unroll") for (int n = 0; n < 2; ++n) _Pragma("unroll") for (int k = 0; k < 2; ++k) dst[n][k] = *(const LAS bf16x8*)(lds + PG8_SB(b, h) + boff + n * 2048 + k * 1024); } while (0)
#define PG8_MMA(ai, bj, At, Bt) do { __builtin_amdgcn_s_setprio(1); _Pragma("unroll") for (int m = 0; m < 4; ++m) _Pragma("unroll") for (int n = 0; n < 2; ++n) _Pragma("unroll") for (int k = 0; k < 2; ++k) \
        acc[ai][bj][m][n] = __builtin_amdgcn_mfma_f32_16x16x32_bf16(Bt[n][k], At[m][k], acc[ai][bj][m][n], 0, 0, 0); __builtin_amdgcn_s_setprio(0); } while (0)
#define PG8_MMA2(ai) do { if constexpr (HALFB) { if (lo) { PG8_MMA(ai, 0, At, B0); } else { PG8_MMA(ai, 1, At, B1); } } else { PG8_MMA(ai, 0, At, B0); PG8_MMA(ai, 1, At, B1); } } while (0)
#define PG8_WAIT_V(n) asm volatile("s_waitcnt vmcnt(" #n ")" ::: "memory")
#define PG8_WAIT_L(n) asm volatile("s_waitcnt lgkmcnt(" #n ")" ::: "memory")
#define PG8_BAR __builtin_amdgcn_s_barrier()
#define PG8_SCHED __builtin_amdgcn_sched_barrier(0)
#define PG8_UA(u) ((const char*)g.A + (size_t)(u).pm * tstepA + (size_t)(u).aux * (size_t)g.a_aux)
#define PG8_UB(u) ((const char*)g.Bt + (size_t)(u).pn * tstepB + (size_t)(u).aux * (size_t)g.b_aux)
    Unit cur, nxt; int ui = 0;
    if (!S.next(0, cur)) return;
    f32x4 acc[2][2][4][2];
#pragma unroll
    for (int a = 0; a < 2; ++a)
#pragma unroll
        for (int b = 0; b < 2; ++b)
#pragma unroll
            for (int m = 0; m < 4; ++m)
#pragma unroll
                for (int n = 0; n < 2; ++n) acc[a][b][m][n] = (f32x4){0.f, 0.f, 0.f, 0.f};
    bf16x8 At[4][2], B0[2][2], B1[2][2];
    const char* cA = PG8_UA(cur); const char* cB = PG8_UB(cur);
    PG8_STAGE(PG8_SB(0, 0), cB, voffB); PG8_STAGE(PG8_SB(0, 1), cB + hstepB, voffB); PG8_STAGE(PG8_SA(0, 0), cA, voffA); PG8_STAGE(PG8_SA(0, 1), cA + hstepA, voffA);
    if (wr == 1) PG8_BAR;
    PG8_WAIT_V(2); PG8_BAR;
    PG8_STAGE(PG8_SB(1, 0), cB + kstep, voffB); PG8_STAGE(PG8_SA(1, 0), cA + kstep, voffA); PG8_STAGE(PG8_SB(1, 1), cB + hstepB + kstep, voffB);
    PG8_WAIT_V(6); PG8_BAR;
    for (;;) {
        const bool has_next = S.next(ui + 1, nxt);
        const char* nA = has_next ? PG8_UA(nxt) : cA; const char* nB = has_next ? PG8_UB(nxt) : cB;
        for (int t = 0; t < nt; t += 2) {
            const bool last = (t == nt - 2);
            const bool lo = (2 * t < nt);
            (void)lo;
            const char* a1 = cA + (size_t)(t + 1) * kstep;
            const char* a2 = last ? nA : cA + (size_t)(t + 2) * kstep; const char* b2 = last ? nB : cB + (size_t)(t + 2) * kstep;
            const char* a3 = a2 + kstep; const char* b3 = b2 + kstep;
            PG8_LDB(B0, 0, 0); PG8_LDB(B1, 0, 1); PG8_SCHED; PG8_LDA(At, 0, 0); PG8_STAGE(PG8_SA(1, 1), a1 + hstepA, voffA);
            PG8_WAIT_V(8); PG8_WAIT_L(0); PG8_BAR; PG8_MMA2(0); PG8_BAR; PG8_SCHED;
            PG8_LDA(At, 0, 1); PG8_STAGE(PG8_SB(0, 0), b2, voffB); PG8_STAGE(PG8_SB(0, 1), b2 + hstepB, voffB); PG8_STAGE(PG8_SA(0, 0), a2, voffA);
            PG8_WAIT_V(8); PG8_WAIT_L(0); PG8_BAR; PG8_MMA2(1); PG8_BAR; PG8_SCHED;
            PG8_LDB(B0, 1, 0); PG8_LDB(B1, 1, 1); PG8_SCHED; PG8_LDA(At, 1, 0); PG8_STAGE(PG8_SA(0, 1), a2 + hstepA, voffA);
            PG8_WAIT_V(8); PG8_WAIT_L(0); PG8_BAR; PG8_MMA2(0); PG8_BAR; PG8_SCHED;
            PG8_LDA(At, 1, 1); PG8_STAGE(PG8_SB(1, 0), b3, voffB); PG8_STAGE(PG8_SB(1, 1), b3 + hstepB, voffB); PG8_STAGE(PG8_SA(1, 0), a3, voffA);
            PG8_WAIT_V(8); PG8_WAIT_L(0); PG8_BAR; PG8_MMA2(1); PG8_BAR; PG8_SCHED;
        }
        if constexpr (ALIGN_EPI) { if (wr == 0) PG8_BAR; }
        { Unit eu = cur; asm volatile("" : "+s"(eu.pm), "+s"(eu.pn), "+s"(eu.aux)); E(acc, eu, wr, wc, fr, fq); }
        if (!has_next) break;
#pragma unroll
        for (int a = 0; a < 2; ++a)
#pragma unroll
            for (int b = 0; b < 2; ++b)
#pragma unroll
                for (int m = 0; m < 4; ++m)
#pragma unroll
                    for (int n = 0; n < 2; ++n) acc[a][b][m][n] = (f32x4){0.f, 0.f, 0.f, 0.f};
        cur = nxt; cA = nA; cB = nB; ++ui;
        if constexpr (ALIGN_EPI) { if (wr == 1) PG8_BAR; }
    }
    PG8_WAIT_V(0);
    if constexpr (!ALIGN_EPI) { if (wr == 0) PG8_BAR; }
    PG8_BAR;
#undef PG8_SA
#undef PG8_SB
#undef PG8_STAGE
#undef PG8_LDA
#undef PG8_LDB
#undef PG8_MMA
#undef PG8_MMA2
#undef PG8_WAIT_V
#undef PG8_WAIT_L
#undef PG8_BAR
#undef PG8_SCHED
#undef PG8_UA
#undef PG8_UB
}

__device__ __forceinline__ float row_rstd(const float* ssq, int row, int fq) {
    const f32x4 a = *(const f32x4*)(ssq + (size_t)row * 16 + 4 * fq);
    float s = (a[0] + a[1]) + (a[2] + a[3]);
    s = x16_sum(s); s = x32_sum(s);
    return __builtin_amdgcn_rsqf(s * (1.0f / DM) + RMS_EPS);
}
__device__ __forceinline__ int pos16(int o) { return 8 * ((o >> 2) & 1) + 4 * (o >> 3) + (o & 3); }

struct EpiProj {
    static constexpr bool PERM = true;
    const float* ssq; int row_base; bf16_t* QK; bf16_t* KF; bf16_t* VT; float* FL; bf16_t* GATE;
    __device__ __forceinline__ void operator()(const f32x4 (&acc)[2][2][4][2], const Unit& u, int wr, int wc, int fr, int fq) const {
        const int pn = u.pn;
        const int lrow0 = u.pm * BM + wr * 64 + fr;
        float rs[2][4];
#pragma unroll
        for (int ai = 0; ai < 2; ++ai)
#pragma unroll
            for (int m = 0; m < 4; ++m) rs[ai][m] = row_rstd(ssq, row_base + lrow0 + ai * HALF + m * 16, fq);
        const int cin = wc * 32 + 8 * fq;
        if (pn >= 19) {
#pragma unroll
            for (int ai = 0; ai < 2; ++ai)
#pragma unroll
                for (int m = 0; m < 4; ++m) { const int lrow = lrow0 + ai * HALF + m * 16; const float s = rs[ai][m];
#pragma unroll
                    for (int bj = 0; bj < 2; ++bj) { const f32x4 v0 = acc[ai][bj][m][0] * s, v1 = acc[ai][bj][m][1] * s;
                        u32x4 w; w.x = cvtpk(v0[0], v0[1]); w.y = cvtpk(v0[2], v0[3]); w.z = cvtpk(v1[0], v1[1]); w.w = cvtpk(v1[2], v1[3]);
                        *(u32x4*)(GATE + ((size_t)((u.pm * 32 + (pn - 19) * 2 + bj) * 2 + ai) * 4 + m) * 4096 + ((wr * 4 + wc) * 64 + fr + 16 * fq) * 8) = w; } }
        } else if (pn == 18) {
            if (wc == 0 && fq == 0) {
#pragma unroll
                for (int ai = 0; ai < 2; ++ai)
#pragma unroll
                    for (int m = 0; m < 4; ++m) { const int lrow = lrow0 + ai * HALF + m * 16; *(f32x4*)(FL + (size_t)lrow * 4) = acc[ai][0][m][0] * rs[ai][m]; }
            }
        } else if (pn == 2 || (pn >= 9 && pn <= 11) || pn == 14 || pn == 17) {
            int vhb, rsh;
            if (pn == 2) { vhb = 0; rsh = 0; } else if (pn == 14) { vhb = 16; rsh = 0; } else if (pn == 17) { vhb = 20; rsh = 0; } else { const int gI = pn - 9; vhb = 4 + 4 * gI; rsh = 2 * gI; }
            const int slsh = 11 - rsh, rmask = (1 << rsh) - 1;
#pragma unroll
            for (int ai = 0; ai < 2; ++ai)
#pragma unroll
                for (int m = 0; m < 4; ++m) { const int lrow = lrow0 + ai * HALF + m * 16; const float s = rs[ai][m];
                    const int bl = lrow >> 11, t = lrow & (SEQ - 1); int p = ((t & rmask) << slsh) + (t >> rsh); p = (p & ~15) | pos16(p & 15);
                    const int kb = p >> 5, q = p & 31;
                    bf16_t* base = VT + (size_t)(bl * 24 + vhb) * HSEQ + (size_t)kb * 2048 + (q >> 4) * 512 + ((q >> 3) & 1) * 256 + (q & 7);
#pragma unroll
                    for (int bj = 0; bj < 2; ++bj) { const int c0 = bj * HALF + cin;
                        bf16_t* bp = base + (size_t)(c0 >> 6) * HSEQ + ((c0 >> 5) & 1) * 1024 + (c0 & 31) * 8;
                        const f32x4 v0 = acc[ai][bj][m][0] * s, v1 = acc[ai][bj][m][1] * s;
                        const unsigned w0 = cvtpk(v0[0], v0[1]), w1 = cvtpk(v0[2], v0[3]), w2 = cvtpk(v1[0], v1[1]), w3 = cvtpk(v1[2], v1[3]);
                        bp[0 * 8] = (bf16_t)(w0 & 0xffff); bp[1 * 8] = (bf16_t)(w0 >> 16); bp[2 * 8] = (bf16_t)(w1 & 0xffff); bp[3 * 8] = (bf16_t)(w1 >> 16);
                        bp[4 * 8] = (bf16_t)(w2 & 0xffff); bp[5 * 8] = (bf16_t)(w2 >> 16); bp[6 * 8] = (bf16_t)(w3 & 0xffff); bp[7 * 8] = (bf16_t)(w3 >> 16); } }
        } else {
            const bool isK = (pn == 1) || (pn >= 6 && pn <= 8) || pn == 13 || pn == 16;
            int slot = 0, khb = 0, rsh = 0;
            if (pn <= 1) { slot = 0; khb = 0; } else if (pn <= 8) { const int gI = (pn - 3) % 3; rsh = 2 * gI; slot = 1 + gI; khb = 4 + 4 * gI; } else if (pn <= 13) { slot = 4; khb = 16; } else { slot = 5; khb = 20; }
            const int slsh = 11 - rsh, rmask = (1 << rsh) - 1;
#pragma unroll
            for (int ai = 0; ai < 2; ++ai)
#pragma unroll
                for (int m = 0; m < 4; ++m) { const int lrow = lrow0 + ai * HALF + m * 16; const float s = rs[ai][m];
                    const int bl = lrow >> 11, t = lrow & (SEQ - 1); const int p = ((t & rmask) << slsh) + (t >> rsh);
#pragma unroll
                    for (int bj = 0; bj < 2; ++bj) { const f32x4 v0 = acc[ai][bj][m][0] * s, v1 = acc[ai][bj][m][1] * s;
                        u32x4 w; w.x = cvtpk(v0[0], v0[1]); w.y = cvtpk(v0[2], v0[3]); w.z = cvtpk(v1[0], v1[1]); w.w = cvtpk(v1[2], v1[3]);
                        const int c0 = bj * HALF + cin;
                        if (isK) { const int dcol = c0 & 63;
                            *(u32x4*)(KF + (size_t)(bl * 24 + khb + (c0 >> 6)) * HSEQ + (size_t)(p >> 5) * 2048 + (dcol >> 4) * 512 + (((dcol >> 3) & 1) * 32 + (p & 31)) * 8) = w; }
                        else *(u32x4*)(QK + (size_t)(bl * SEQ + p) * LDQK + slot * 256 + c0) = w; } }
        }
    }
};

struct EpiBranch {
    static constexpr bool PERM = true;
    const bf16_t* GATE; bf16_t* MERGED; int row_base; bf16_t* TMP;
    __device__ __forceinline__ static float sg(float g) { return __builtin_amdgcn_rcpf(1.0f + ex2(-g * LOG2E)); }
    __device__ __forceinline__ static u32x4 mix(const u32x4 ga, const u32x4 gb, const u32x4 ow, const f32x4 a0, const f32x4 a1, const f32x4 b0, const f32x4 b1) {
        const float o0 = sg(bflo(ga.x)) * a0[0] + sg(bflo(gb.x)) * b0[0] + bflo(ow.x), o1 = sg(bfhi(ga.x)) * a0[1] + sg(bfhi(gb.x)) * b0[1] + bfhi(ow.x);
        const float o2 = sg(bflo(ga.y)) * a0[2] + sg(bflo(gb.y)) * b0[2] + bflo(ow.y), o3 = sg(bfhi(ga.y)) * a0[3] + sg(bfhi(gb.y)) * b0[3] + bfhi(ow.y);
        const float o4 = sg(bflo(ga.z)) * a1[0] + sg(bflo(gb.z)) * b1[0] + bflo(ow.z), o5 = sg(bfhi(ga.z)) * a1[1] + sg(bfhi(gb.z)) * b1[1] + bfhi(ow.z);
        const float o6 = sg(bflo(ga.w)) * a1[2] + sg(bflo(gb.w)) * b1[2] + bflo(ow.w), o7 = sg(bfhi(ga.w)) * a1[3] + sg(bfhi(gb.w)) * b1[3] + bfhi(ow.w);
        u32x4 w; w.x = cvtpk(o0, o1); w.y = cvtpk(o2, o3); w.z = cvtpk(o4, o5); w.w = cvtpk(o6, o7); return w;
    }
    __device__ __forceinline__ void operator()(const f32x4 (&acc)[2][2][4][2], const Unit& u, int wr, int wc, int fr, int fq) const {
        const int p = u.aux; const int lrow0 = u.pm * BM + wr * 64 + fr; const int d0 = u.pn * 128 + wc * 32 + 8 * fq;
        int fr_ = fr; asm volatile("" : "+v"(fr_));
        const bf16_t* gbase = GATE + (size_t)(u.pm * 32 + (2 * p) * 8 + u.pn) * 8 * 4096 + ((wr * 4 + wc) * 64 + fr_ + 16 * fq) * 8;
        bf16_t* mbase = MERGED + (size_t)(row_base + lrow0) * DM + d0;
        bf16_t* tbase = TMP + (size_t)(u.pm * 8 + u.pn) * 8 * 4096 + ((wr * 4 + wc) * 64 + fr_ + 16 * fq) * 8;
        const u32x4 zero = {0u, 0u, 0u, 0u};
#pragma unroll
        for (int ai = 0; ai < 2; ++ai) {
#pragma unroll
            for (int m = 0; m < 4; ++m) {
                const size_t ro = (size_t)(ai * HALF + m * 16);
                const u32x4 ga = *(const u32x4*)(gbase + (size_t)(ai * 4 + m) * 4096), gb = *(const u32x4*)(gbase + (size_t)(ai * 4 + m) * 4096 + (size_t)8 * 8 * 4096);
                u32x4 ow = zero; if (p > 0) ow = *(const u32x4*)(tbase + (size_t)(ai * 4 + m) * 4096);
                const u32x4 r = mix(ga, gb, ow, acc[ai][0][m][0], acc[ai][0][m][1], acc[ai][1][m][0], acc[ai][1][m][1]);
                if (p > 0) *(u32x4*)(mbase + ro * DM) = r; else *(u32x4*)(tbase + (size_t)(ai * 4 + m) * 4096) = r;
                if (m & 1) asm volatile("" ::: "memory");
            }
        }
    }
};

struct EpiResid {
    static constexpr bool PERM = true;
    const float* Xin; float* X; bf16_t* XB; float* ssq;
    __device__ __forceinline__ void operator()(const f32x4 (&acc)[2][2][4][2], const Unit& u, int wr, int wc, int fr, int fq) const {
        const int row0 = u.pm * BM + wr * 64 + fr; const int col0 = u.pn * BM + wc * 32 + 8 * fq;
#pragma unroll
        for (int ai = 0; ai < 2; ++ai)
#pragma unroll
            for (int m = 0; m < 4; ++m) { const int row = row0 + ai * HALF + m * 16; float sq = 0.f;
#pragma unroll
                for (int bj = 0; bj < 2; ++bj) { const int col = col0 + bj * HALF; f32x4* xp = (f32x4*)(X + (size_t)row * DM + col); const f32x4* xi = (const f32x4*)(Xin + (size_t)row * DM + col);
                    const f32x4 x0 = xi[0] + acc[ai][bj][m][0], x1 = xi[1] + acc[ai][bj][m][1];
                    xp[0] = x0; xp[1] = x1;
                    u32x4 w; w.x = cvtpk(x0[0], x0[1]); w.y = cvtpk(x0[2], x0[3]); w.z = cvtpk(x1[0], x1[1]); w.w = cvtpk(x1[2], x1[3]);
                    *(u32x4*)(XB + (size_t)row * DM + col) = w;
                    sq += (x0[0] * x0[0] + x0[1] * x0[1]) + (x0[2] * x0[2] + x0[3] * x0[3]) + (x1[0] * x1[0] + x1[1] * x1[1]) + (x1[2] * x1[2] + x1[3] * x1[3]); }
                sq = x16_sum(sq); sq = x32_sum(sq);
                if (fq == 0) ssq[(size_t)row * 16 + u.pn * 4 + wc] = sq; if (m & 1) asm volatile("" ::: "memory"); }
    }
};

struct EpiFinal {
    static constexpr bool PERM = true;
    const float* X; float* out; float* ssq; const float* gfin; unsigned* cnt;
    __device__ __forceinline__ void operator()(f32x4 (&acc)[2][2][4][2], const Unit& u, int wr, int wc, int fr, int fq) const {
        const int row0 = u.pm * BM + wr * 64 + fr; const int col0 = u.pn * BM + wc * 32 + 8 * fq;
#pragma unroll
        for (int ai = 0; ai < 2; ++ai)
#pragma unroll
            for (int m = 0; m < 4; ++m) { const int row = row0 + ai * HALF + m * 16; float sq = 0.f;
#pragma unroll
                for (int bj = 0; bj < 2; ++bj) { const f32x4* xi = (const f32x4*)(X + (size_t)row * DM + col0 + bj * HALF);
                    const f32x4 x0 = xi[0] + acc[ai][bj][m][0], x1 = xi[1] + acc[ai][bj][m][1];
                    acc[ai][bj][m][0] = x0; acc[ai][bj][m][1] = x1;
                    sq += (x0[0] * x0[0] + x0[1] * x0[1]) + (x0[2] * x0[2] + x0[3] * x0[3]) + (x1[0] * x1[0] + x1[1] * x1[1]) + (x1[2] * x1[2] + x1[3] * x1[3]); }
                sq = x16_sum(sq); sq = x32_sum(sq);
                if (fq == 0) __hip_atomic_store(ssq + (size_t)row * 16 + u.pn * 4 + wc, sq, __ATOMIC_RELAXED, __HIP_MEMORY_SCOPE_AGENT);
                if (m & 1) asm volatile("" ::: "memory"); }
        asm volatile("s_waitcnt vmcnt(0)" ::: "memory");
        unsigned* c = cnt + 64 * u.pm;
        if ((fr | fq) == 0) {
            __hip_atomic_fetch_add(c, 1u, __ATOMIC_RELAXED, __HIP_MEMORY_SCOPE_AGENT);
            unsigned sp = 0;
            while (__hip_atomic_load(c, __ATOMIC_RELAXED, __HIP_MEMORY_SCOPE_AGENT) < 32u) { __builtin_amdgcn_s_sleep(2); if (++sp > (1u << 22)) break; }
        }
        __builtin_amdgcn_fence(__ATOMIC_ACQUIRE, "agent");
        asm volatile("s_waitcnt vmcnt(0)" ::: "memory");
        float rs[2][4];
#pragma unroll
        for (int ai = 0; ai < 2; ++ai)
#pragma unroll
            for (int m = 0; m < 4; ++m) rs[ai][m] = row_rstd(ssq, row0 + ai * HALF + m * 16, fq);
#pragma unroll
        for (int bj = 0; bj < 2; ++bj) { const f32x4 g0 = *(const f32x4*)(gfin + col0 + bj * HALF), g1 = *(const f32x4*)(gfin + col0 + bj * HALF + 4);
#pragma unroll
            for (int ai = 0; ai < 2; ++ai)
#pragma unroll
                for (int m = 0; m < 4; ++m) { const int row = row0 + ai * HALF + m * 16; f32x4* op = (f32x4*)(out + (size_t)row * DM + col0 + bj * HALF);
                    op[0] = acc[ai][bj][m][0] * rs[ai][m] * g0; op[1] = acc[ai][bj][m][1] * rs[ai][m] * g1; } }
    }
};

struct EpiUp {
    static constexpr bool PERM = true;
    const float* ssq; bf16_t* H;
    __device__ __forceinline__ void operator()(const f32x4 (&acc)[2][2][4][2], const Unit& u, int wr, int wc, int fr, int fq) const {
        const int row0 = u.pm * BM + wr * 64 + fr; const int col0 = u.pn * BM + wc * 32 + 8 * fq;
        float rs[2][4];
#pragma unroll
        for (int ai = 0; ai < 2; ++ai)
#pragma unroll
            for (int m = 0; m < 4; ++m) rs[ai][m] = row_rstd(ssq, row0 + ai * HALF + m * 16, fq);
#pragma unroll
        for (int ai = 0; ai < 2; ++ai)
#pragma unroll
            for (int m = 0; m < 4; ++m) { const int row = row0 + ai * HALF + m * 16; const float s = rs[ai][m];
#pragma unroll
                for (int bj = 0; bj < 2; ++bj) { f32x4 v0 = acc[ai][bj][m][0] * s, v1 = acc[ai][bj][m][1] * s;
#pragma unroll
                    for (int i = 0; i < 4; ++i) { const float a = fmaxf(v0[i], 0.f), b = fmaxf(v1[i], 0.f); v0[i] = a * a; v1[i] = b * b; }
                    u32x4 w; w.x = cvtpk(v0[0], v0[1]); w.y = cvtpk(v0[2], v0[3]); w.z = cvtpk(v1[0], v1[1]); w.w = cvtpk(v1[2], v1[3]);
                    *(u32x4*)(H + (size_t)row * DFF + col0 + bj * HALF) = w; } }
    }
};
}

__device__ __forceinline__ int win_src(int n) {
    if (n < 3840) return n;
    if (n < 4608) return n + 4;
    if (n < 4864) return (n - 4608 < 4) ? 3840 + (n - 4608) : -1;
    return n - 4864 + 4612;
}
template <int CMAP>
__device__ __forceinline__ void transpose_item(const float* W, int K, int N, int Nsrc, const float* gain, bf16_t* WT, LAS float* scr, int item, int lane) {
    const int nblk = N / 32, kb = item / nblk, nb = item % nblk, k0 = 64 * kb, n0 = 32 * nb;
    const int n = n0 + (lane & 31); const int src = CMAP ? win_src(n) : n;
    const bool live = (src >= 0); const float* wp = W + (size_t)(k0 + (lane >> 5)) * Nsrc + (live ? src : 0); const float* gp = gain ? gain + k0 + (lane >> 5) : nullptr;
    float wv[32];
#pragma unroll
    for (int i = 0; i < 32; ++i) wv[i] = wp[(size_t)(2 * i) * Nsrc];
#pragma unroll
    for (int i = 0; i < 32; ++i) { float v = live ? wv[i] : 0.f; if (gp) v *= gp[2 * i]; scr[(2 * i + (lane >> 5)) * 33 + (lane & 31)] = v; }
    asm volatile("s_waitcnt lgkmcnt(0)" ::: "memory");
    const int c = lane & 7;
#pragma unroll
    for (int j = 0; j < 4; ++j) { const int nn = (lane >> 3) + 8 * j; const LAS float* s = scr + (8 * c) * 33 + nn;
        u32x4 o; o.x = cvtpk(s[0 * 33], s[1 * 33]); o.y = cvtpk(s[2 * 33], s[3 * 33]); o.z = cvtpk(s[4 * 33], s[5 * 33]); o.w = cvtpk(s[6 * 33], s[7 * 33]);
        *(u32x4*)(WT + (size_t)(n0 + nn) * K + k0 + 8 * c) = o; }
    asm volatile("s_waitcnt lgkmcnt(0)" ::: "memory");
}

__device__ __forceinline__ void branch_item(const float* Wn, int n, bf16_t* WBP, LAS float* scr, int item, int lane) {
    const int kb = item >> 5, nb = item & 31, k0 = 64 * kb, n0 = 32 * nb;
    const float* wp = Wn + (size_t)(k0 + (lane >> 5)) * DM + n0 + (lane & 31);
    float wv[32];
#pragma unroll
    for (int i = 0; i < 32; ++i) wv[i] = wp[(size_t)(2 * i) * DM];
#pragma unroll
    for (int i = 0; i < 32; ++i) scr[(2 * i + (lane >> 5)) * 33 + (lane & 31)] = wv[i];
    asm volatile("s_waitcnt lgkmcnt(0)" ::: "memory");
    const int c = lane & 7, bj = n & 1, pair = n >> 1;
    const u32x4 zero = {0u, 0u, 0u, 0u};
#pragma unroll
    for (int j = 0; j < 4; ++j) { const int nn = (lane >> 3) + 8 * j; const LAS float* sp = scr + (8 * c) * 33 + nn; const int d = n0 + nn;
        u32x4 o; o.x = cvtpk(sp[0 * 33], sp[1 * 33]); o.y = cvtpk(sp[2 * 33], sp[3 * 33]); o.z = cvtpk(sp[4 * 33], sp[5 * 33]); o.w = cvtpk(sp[6 * 33], sp[7 * 33]);
        bf16_t* row = WBP + ((size_t)((pair * 8 + (d >> 7)) * 256 + bj * 128 + (d & 127))) * 512 + k0 + 8 * c;
        *(u32x4*)(row + 256 * bj) = o; *(u32x4*)(row + 256 * (1 - bj)) = zero; }
    asm volatile("s_waitcnt lgkmcnt(0)" ::: "memory");
}

#define MFMA32(a, b, c) __builtin_amdgcn_mfma_f32_32x32x16_bf16((a), (b), (c), 0, 0, 0)
__device__ __forceinline__ bf16x8 ld16(const bf16_t* p) { return *(const bf16x8*)p; }
__device__ __forceinline__ bf16x8 pack8(const f32x16& s, int b) { u32x4 w; w.x = cvtpk(s[b], s[b + 1]); w.y = cvtpk(s[b + 2], s[b + 3]); w.z = cvtpk(s[b + 4], s[b + 5]); w.w = cvtpk(s[b + 6], s[b + 7]); return __builtin_bit_cast(bf16x8, w); }
__device__ __forceinline__ int crow(int r, int hi) { return (r & 3) + 8 * (r >> 2) + 4 * hi; }
__device__ __forceinline__ void store_o(bf16_t* orow, const f32x16& o0, const f32x16& o1, int hi) {
#pragma unroll
    for (int g = 0; g < 4; ++g) {
        u32x2 a; a.x = cvtpk(o0[4 * g], o0[4 * g + 1]); a.y = cvtpk(o0[4 * g + 2], o0[4 * g + 3]); *(u32x2*)(orow + 8 * g + 4 * hi) = a;
        u32x2 b; b.x = cvtpk(o1[4 * g], o1[4 * g + 1]); b.y = cvtpk(o1[4 * g + 2], o1[4 * g + 3]); *(u32x2*)(orow + 32 + 8 * g + 4 * hi) = b; }
}

struct KFrag { bf16x8 k[4]; };
struct VFrag { bf16x8 v[4]; };
__device__ __forceinline__ void k_load(KFrag& f, const bf16_t* Kh, int kb, int lane) {
    const bf16_t* kp = Kh + (size_t)kb * 2048 + lane * 8;
#pragma unroll
    for (int ds = 0; ds < 4; ++ds) f.k[ds] = ld16(kp + ds * 512);
}
__device__ __forceinline__ void v_load(VFrag& f, const bf16_t* Vh, int kb, int lane) {
    const bf16_t* vp = Vh + (size_t)kb * 2048 + lane * 8;
    f.v[0] = ld16(vp); f.v[1] = ld16(vp + 512); f.v[2] = ld16(vp + 1024); f.v[3] = ld16(vp + 1536);
}
__device__ __forceinline__ void q_load(bf16x8 (&qf)[4], const bf16_t* Qs, int qb, int r32, int hi) {
    const bf16_t* qp = Qs + (size_t)(qb * 32 + r32) * LDQK + hi * 8;
#pragma unroll
    for (int ds = 0; ds < 4; ++ds) qf[ds] = ld16(qp + ds * 16);
}

template <int MODE, bool MASK, int NDS>
__device__ __forceinline__ void sm_step(const bf16x8 (&ck)[NDS], const bf16x8 (&qf)[NDS], const VFrag& cv, float slope2, const LAS float* cl, int kb, int d0,
                                        float& m, float& l, f32x16& o0, f32x16& o1, int hi) {
    constexpr float SC2 = ((MODE == 2) ? 0.17677669529663687f : 0.125f) * LOG2E;
    f32x16 s;
#pragma unroll
    for (int i = 0; i < 16; ++i) s[i] = 0.f;
#pragma unroll
    for (int ds = 0; ds < NDS; ++ds) s = MFMA32(ck[ds], qf[ds], s);
#define KC(r) (((r) & 3) + 8 * ((r) >> 2))
    int dh = d0 - 4 * hi; asm volatile("" : "+v"(dh));
    float sl = slope2; asm volatile("" : "+v"(sl));
    const LAS float* clk = cl + 33 * kb + 4 * hi; if (MODE == 0) asm volatile("" : "+v"(clk));
    const float base = (MODE == 0) ? 0.f : -sl * (float)dh;
#pragma unroll
    for (int r = 0; r < 16; ++r) {
        float v = (MODE == 0) ? fmaf(s[r], SC2, clk[KC(r)]) : fmaf(s[r], SC2, sl * (float)KC(r));
        if (MASK) { const int dist = dh - KC(r); const bool valid = (MODE == 1) ? ((unsigned)dist <= 128u) : (dist >= 0); v = valid ? v : -INFINITY; }
        s[r] = v;
    }
#undef KC
    float mt = fmaxf(fmaxf(s[0], s[1]), fmaxf(s[2], s[3]));
#pragma unroll
    for (int r = 4; r < 16; r += 4) mt = fmaxf(mt, fmaxf(fmaxf(s[r], s[r + 1]), fmaxf(s[r + 2], s[r + 3])));
    mt = x32_max(mt + base);
    const float mn = fmaxf(m, mt), alpha = ex2(m - mn), c = mn - base;
    float ps = 0.f;
#pragma unroll
    for (int r = 0; r < 16; ++r) { const float p = ex2(s[r] - c); s[r] = p; ps += p; }
    l = l * alpha + ps; m = mn;
#pragma unroll
    for (int i = 0; i < 16; ++i) { o0[i] *= alpha; o1[i] *= alpha; }
    const bf16x8 pf0 = pack8(s, 0), pf1 = pack8(s, 8);
    o0 = MFMA32(cv.v[0], pf0, o0); o0 = MFMA32(cv.v[1], pf1, o0); o1 = MFMA32(cv.v[2], pf0, o1); o1 = MFMA32(cv.v[3], pf1, o1);
}
template <int MODE>
__device__ __forceinline__ void sm_unit(const bf16_t* Qs, const bf16_t* Ks, const bf16_t* VTs, int qb, int kb_hi, int kb_lo, float slope2, const LAS float* cl,
                                        f32x16& o0, f32x16& o1, float& m_out, float& l_out, int lane) {
    const int r32 = lane & 31, hi = lane >> 5;
    constexpr int NDS = (MODE == 2) ? 2 : 4;
    bf16x8 qf[NDS];
    { const bf16_t* qp = Qs + (size_t)(qb * 32 + r32) * LDQK + hi * 8;
#pragma unroll
      for (int ds = 0; ds < NDS; ++ds) qf[ds] = ld16(qp + ds * 16); }
    bf16x8 nk[NDS];
    { const bf16_t* kp = Ks + (size_t)kb_hi * 2048 + lane * 8;
#pragma unroll
      for (int ds = 0; ds < NDS; ++ds) nk[ds] = ld16(kp + ds * 512); }
    float m = -INFINITY, l = 0.f;
#pragma unroll
    for (int i = 0; i < 16; ++i) { o0[i] = 0.f; o1[i] = 0.f; }
    for (int kb = kb_hi; kb >= kb_lo; --kb) {
        bf16x8 ck[NDS];
#pragma unroll
        for (int ds = 0; ds < NDS; ++ds) ck[ds] = nk[ds];
        VFrag cv; v_load(cv, VTs, kb, lane);
        if (kb > kb_lo) { const bf16_t* kp = Ks + (size_t)(kb - 1) * 2048 + lane * 8;
#pragma unroll
            for (int ds = 0; ds < NDS; ++ds) nk[ds] = ld16(kp + ds * 512); }
        const int d0 = (qb - kb) * 32 + r32;
        const bool edge = (MODE == 1) ? (kb == qb || kb + 4 <= qb) : (kb == qb);
        if (edge) sm_step<MODE, true, NDS>(ck, qf, cv, slope2, cl, kb, d0, m, l, o0, o1, hi);
        else      sm_step<MODE, false, NDS>(ck, qf, cv, slope2, cl, kb, d0, m, l, o0, o1, hi);
    }
    l = x32_sum(l);
    m_out = m; l_out = l;
}

template <int MODE>
__device__ __forceinline__ void sm_unit64(const bf16_t* Qs, const bf16_t* Ks, const bf16_t* VTs, int Q, int kb_hi, int kb_lo, float slope2, const LAS float* cl,
                                          f32x16 (&o)[2][2], float (&m)[2], float (&l)[2], int lane) {
    const int r32 = lane & 31, hi = lane >> 5;
    constexpr int NDS = (MODE == 2) ? 2 : 4;
    bf16x8 qf[2][NDS];
#pragma unroll
    for (int i = 0; i < 2; ++i) { const bf16_t* qp = Qs + (size_t)((2 * Q + i) * 32 + r32) * LDQK + hi * 8;
#pragma unroll
        for (int ds = 0; ds < NDS; ++ds) qf[i][ds] = ld16(qp + ds * 16); }
    bf16x8 nk[NDS];
    { const bf16_t* kp = Ks + (size_t)kb_hi * 2048 + lane * 8;
#pragma unroll
      for (int ds = 0; ds < NDS; ++ds) nk[ds] = ld16(kp + ds * 512); }
#pragma unroll
    for (int i = 0; i < 2; ++i) { m[i] = -INFINITY; l[i] = 0.f;
#pragma unroll
        for (int k = 0; k < 16; ++k) { o[i][0][k] = 0.f; o[i][1][k] = 0.f; } }
    for (int kb = kb_hi; kb >= kb_lo; --kb) {
        bf16x8 ck[NDS];
#pragma unroll
        for (int ds = 0; ds < NDS; ++ds) ck[ds] = nk[ds];
        VFrag cv; v_load(cv, VTs, kb, lane);
        if (kb > kb_lo) { const bf16_t* kp = Ks + (size_t)(kb - 1) * 2048 + lane * 8;
#pragma unroll
            for (int ds = 0; ds < NDS; ++ds) nk[ds] = ld16(kp + ds * 512); }
        if (kb < 2 * Q) {
            const int d00 = (2 * Q - kb) * 32 + r32;
            sm_step<MODE, false, NDS>(ck, qf[0], cv, slope2, cl, kb, d00, m[0], l[0], o[0][0], o[0][1], hi);
            sm_step<MODE, false, NDS>(ck, qf[1], cv, slope2, cl, kb, d00 + 32, m[1], l[1], o[1][0], o[1][1], hi);
        } else {
#pragma unroll
            for (int i = 0; i < 2; ++i) {
                const int qbi = 2 * Q + i;
                if (kb <= qbi) {
                    const int d0 = (qbi - kb) * 32 + r32;
                    if (kb == qbi) sm_step<MODE, true, NDS>(ck, qf[i], cv, slope2, cl, kb, d0, m[i], l[i], o[i][0], o[i][1], hi);
                    else           sm_step<MODE, false, NDS>(ck, qf[i], cv, slope2, cl, kb, d0, m[i], l[i], o[i][0], o[i][1], hi);
                }
            }
        }
    }
    l[0] = x32_sum(l[0]); l[1] = x32_sum(l[1]);
}

__device__ __forceinline__ void sb_unit(const bf16_t* Qs, const bf16_t* Ks, const bf16_t* VTs, int qb, f32x16& o0, f32x16& o1, int lane) {
    const int r32 = lane & 31, hi = lane >> 5;
    constexpr float SC2 = 0.125f * LOG2E;
    bf16x8 qf[4]; q_load(qf, Qs, qb, r32, hi);
    KFrag nx; k_load(nx, Ks, qb, lane);
    float R = 0.f;
#pragma unroll
    for (int i = 0; i < 16; ++i) { o0[i] = 0.f; o1[i] = 0.f; }
    for (int kb = qb; kb >= 0; --kb) {
        const KFrag cu = nx; VFrag cv; v_load(cv, VTs, kb, lane);
        if (kb > 0) k_load(nx, Ks, kb - 1, lane);
        f32x16 s;
#pragma unroll
        for (int i = 0; i < 16; ++i) s[i] = 0.f;
#pragma unroll
        for (int ds = 0; ds < 4; ++ds) s = MFMA32(cu.k[ds], qf[ds], s);
        float lk[16], ls[16];
        const int d0 = (qb - kb) * 32 + r32;
#pragma unroll
        for (int r = 0; r < 16; ++r) { const float z2 = s[r] * SC2; const float sp = fmaxf(z2, 0.f) + lg2(1.0f + ex2(-fabsf(z2))); const bool valid = crow(r, hi) < d0; lk[r] = valid ? -sp : 0.f; ls[r] = valid ? (z2 - sp) : -INFINITY; }
        float e[16], tq[4], pq[4];
#pragma unroll
        for (int g = 0; g < 4; ++g) { e[4 * g + 3] = 0.f; e[4 * g + 2] = lk[4 * g + 3]; e[4 * g + 1] = e[4 * g + 2] + lk[4 * g + 2]; e[4 * g] = e[4 * g + 1] + lk[4 * g + 1]; tq[g] = e[4 * g] + lk[4 * g]; }
#pragma unroll
        for (int g = 0; g < 4; ++g) pq[g] = x32_partner(tq[g], hi);
        float cs[4]; cs[3] = 0.f; cs[2] = tq[3] + pq[3]; cs[1] = cs[2] + (tq[2] + pq[2]); cs[0] = cs[1] + (tq[1] + pq[1]);
        const float total = cs[0] + (tq[0] + pq[0]);
#pragma unroll
        for (int g = 0; g < 4; ++g) { const float later = R + cs[g] + (hi == 0 ? pq[g] : 0.f);
#pragma unroll
            for (int i = 0; i < 4; ++i) s[4 * g + i] = ex2(ls[4 * g + i] + e[4 * g + i] + later); }
        R += total;
        const bf16x8 pf0 = pack8(s, 0), pf1 = pack8(s, 8);
        o0 = MFMA32(cv.v[0], pf0, o0); o0 = MFMA32(cv.v[1], pf1, o0); o1 = MFMA32(cv.v[2], pf0, o1); o1 = MFMA32(cv.v[3], pf1, o1);
        if (__all(R < -150.0f)) break;
    }
}

#define XB_TMO      128
#define XB_XCNT(j)  (256  + 64 * (j))
#define XB_XSUB(j)  (1280 + 64 * (j))
#define XB_XGEN(j)  (2304 + 64 * (j))
#define XB_TOP      3328
#define XB_TOPGEN   3392
#define XCD_BAR_WORDS 3456
#define XB_SPIN_CAP (1u << 18)
__device__ __forceinline__ unsigned xb_ld(unsigned* p)              { return __hip_atomic_load(p, __ATOMIC_RELAXED, __HIP_MEMORY_SCOPE_AGENT); }
__device__ __forceinline__ unsigned xb_add(unsigned* p, unsigned v) { return __hip_atomic_fetch_add(p, v, __ATOMIC_RELAXED, __HIP_MEMORY_SCOPE_AGENT); }
__device__ __forceinline__ unsigned xb_xcc_id() { return (unsigned)__builtin_amdgcn_s_getreg((3 << 11) | 20) & 0xFu; }
#define XB_SPIN(cond, bar) do { unsigned _sp = 0; while (cond) { __builtin_amdgcn_s_sleep(1); \
    if ((++_sp & 255u) == 0u) { if (xb_ld(&(bar)[XB_TMO])) break; if (_sp > XB_SPIN_CAP) { atomicAdd(&(bar)[XB_TMO], 1u); break; } } } } while (0)
__device__ __forceinline__ void xcd_barrier_complete(unsigned* bar, unsigned x, unsigned& nloc, unsigned& nx) {
    const unsigned G = gridDim.x * gridDim.y * gridDim.z;
    unsigned sum, cnt, mine, sp = 0u;
    for (;;) {
        sum = 0u; cnt = 0u; mine = 0u;
#pragma unroll
        for (unsigned j = 0; j < 16; ++j) { const unsigned c = xb_ld(&bar[XB_XCNT(j)]); sum += c; cnt += (c > 0u) ? 1u : 0u; mine = (j == x) ? c : mine; }
        if (sum == G) break;
        __builtin_amdgcn_s_sleep(1);
        if ((++sp & 255u) == 0u) { if (xb_ld(&bar[XB_TMO])) break; if (sp > XB_SPIN_CAP) { atomicAdd(&bar[XB_TMO], 1u); break; } }
    }
    nloc = mine > 0u ? mine : 1u; nx = cnt > 0u ? cnt : 1u;
}
__device__ __forceinline__ void xcd_barrier(unsigned* bar, volatile LAS unsigned* st, int wave_k) {
    asm volatile("s_waitcnt vmcnt(0)" ::: "memory");
    __syncthreads();
    if (wave_k == 0 && lane_id_hw() == 0) {
        const unsigned x = xb_xcc_id();
        __builtin_amdgcn_s_waitcnt(0);
        unsigned nloc = st[0], nx = st[1];
        if (nloc == 0u) { xcd_barrier_complete(bar, x, nloc, nx); st[0] = nloc; st[1] = nx; }
        const unsigned old = xb_add(&bar[XB_XSUB(x)], 1u);
        const unsigned gen = old / nloc;
        if (old + 1u == (gen + 1u) * nloc) {
            __builtin_amdgcn_fence(__ATOMIC_RELEASE, "agent");
            asm volatile("s_waitcnt vmcnt(0)" ::: "memory");
            const unsigned og = xb_add(&bar[XB_TOP], 1u);
            const unsigned tg = og / nx;
            if (og + 1u == (tg + 1u) * nx) xb_add(&bar[XB_TOPGEN], 1u);
            else XB_SPIN(xb_ld(&bar[XB_TOPGEN]) == tg, bar);
            __builtin_amdgcn_fence(__ATOMIC_ACQUIRE, "agent");
            xb_add(&bar[XB_XGEN(x)], 1u);
            asm volatile("s_waitcnt vmcnt(0)" ::: "memory");
        } else {
            XB_SPIN(xb_ld(&bar[XB_XGEN(x)]) == gen, bar);
            __builtin_amdgcn_fence(__ATOMIC_ACQUIRE, "agent");
            asm volatile("s_waitcnt vmcnt(0)" ::: "memory");
        }
    }
    __syncthreads();
}
constexpr int MISC_OFF = 131072 + 320;

struct Params {
    const float* x; const float* mix_g; const float* w_in; const float* b_forget; const float* lq1; const float* lk1; const float* lq2; const float* lk2;
    const float* diff_g; const float* w_branch; const float* w_out; const float* mlp_g; const float* w_up; const float* w_down; const float* final_g;
    float* out; unsigned char* ws;
};

#ifndef REP_P1
#define REP_P1 1
#endif
#ifndef REP_P2
#define REP_P2 1
#endif
#ifndef REP_P3
#define REP_P3 1
#endif
#ifndef REP_P5
#define REP_P5 1
#endif
#ifndef REP_SYNC
#define REP_SYNC 1
#endif
#ifndef REP_CONV
#define REP_CONV 1
#endif
#define GSYNC() do { for (int rs_ = 0; rs_ < REP_SYNC; ++rs_) { KParamsPtr pb_ = OPQ_PP(); xcd_barrier((unsigned*)(pb_->ws + WS_CTL) + CW_BAR, (volatile LAS unsigned*)(lds + MISC_OFF), wave_k); } } while (0)
#define OPQ_TID() ({ int t_ = wave_k * 64 + lane_id_hw(); asm volatile("" : "+v"(t_)); t_; })
typedef const __attribute__((address_space(4))) Params* KParamsPtr;
#define OPQ_PP() ({ KParamsPtr p_ = (KParamsPtr)__builtin_amdgcn_kernarg_segment_ptr(); asm volatile("" : "+s"(p_)); p_; })
#define PHASE_VARS() const int tid = OPQ_TID(); const int lane = tid & 63, wave = __builtin_amdgcn_readfirstlane(tid >> 6); const int G = gridDim.x, bx = blockIdx.x; \
    const int gw = bx * NWAVES + wave, NGW = G * NWAVES; KParamsPtr PP = OPQ_PP(); unsigned char* ws = PP->ws; LAS float* scr = (LAS float*)(lds + wave * 16384); (void)lane; (void)gw; (void)NGW; (void)ws; (void)scr; (void)G; (void)bx; (void)PP

__global__ void __launch_bounds__(NWAVES * 64, 2) fwd_mega(Params P) {
    extern __shared__ __attribute__((aligned(16))) unsigned char lds_raw[];
    LAS unsigned char* lds = (LAS unsigned char*)lds_raw;
    cg::grid_group grid = cg::this_grid();
    const int wave_k = __builtin_amdgcn_readfirstlane((int)(threadIdx.x >> 6));
    { KParamsPtr pz = OPQ_PP(); if (pz->ws == nullptr) grid.sync(); }
    { const int t0 = OPQ_TID(); if (t0 < 64) ((LAS unsigned*)(lds + 131072))[t0 + 64] = 0u; __syncthreads();
      if (t0 == 0) { KParamsPtr p0 = OPQ_PP(); (void)xb_add((unsigned*)(p0->ws + WS_CTL) + CW_BAR + XB_XCNT(xb_xcc_id()), 1u); } }

    {
        PHASE_VARS();
        bf16_t* XB = (bf16_t*)(ws + WS_XB); float* SSQ = (float*)(ws + WS_SSQ);
        for (int row = gw; row < TOK; row += NGW) {
            const f32x4* xr = (const f32x4*)(PP->x + (size_t)row * DM) + lane;
            unsigned long long* o8 = (unsigned long long*)(XB + (size_t)row * DM) + lane;
            float s = 0.f;
#pragma unroll
            for (int j = 0; j < 4; ++j) { const f32x4 v = xr[64 * j]; s += (v[0] * v[0] + v[1] * v[1]) + (v[2] * v[2] + v[3] * v[3]);
                o8[64 * j] = (unsigned long long)cvtpk(v[0], v[1]) | ((unsigned long long)cvtpk(v[2], v[3]) << 32); }
            s = wave_sum(s);
            if (lane < 16) SSQ[(size_t)row * 16 + lane] = (lane == 0) ? s : 0.f;
        }
    }

    for (int layer = 0; layer < DEPTH; ++layer) {
        for (int rep = 0; rep < REP_CONV; ++rep) {
            PHASE_VARS();
            bf16_t* WIN = (bf16_t*)(ws + WS_WIN); bf16_t* WB = (bf16_t*)(ws + WS_WB); bf16_t* WOUT = (bf16_t*)(ws + WS_WOUT);
            const float* w_in = PP->w_in + (size_t)layer * DM * DIN; const float* mg = PP->mix_g + (size_t)layer * DM;
            const float* wb = PP->w_branch + (size_t)layer * 4 * 256 * DM; const float* wo = PP->w_out + (size_t)layer * DM * DM;
            constexpr int I_IN = (DM / 64) * (NPROJ / 32), I_B = (256 / 64) * (DM / 32), I_O = (DM / 64) * (DM / 32);
            for (int it = gw; it < I_IN + 4 * I_B + I_O; it += NGW) {
                int r = it;
                if (r < I_IN) { transpose_item<1>(w_in, DM, NPROJ, DIN, mg, WIN, scr, r, lane); continue; } r -= I_IN;
                if (r < 4 * I_B) { const int n = r / I_B; branch_item(wb + (size_t)n * 256 * DM, n, WB, scr, r % I_B, lane); continue; } r -= 4 * I_B;
                transpose_item<0>(wo, DM, DM, DM, nullptr, WOUT, scr, r, lane);
            }
        }
        GSYNC();

        for (int half = 0; half < 2; ++half) {
#ifndef NO_P1
            for (int rep = 0; rep < REP_P1; ++rep) {
                PHASE_VARS();
                const int rb = half * HT;
                pg8::Gemm g{(const bf16_t*)(ws + WS_XB) + (size_t)rb * DM, (const bf16_t*)(ws + WS_WIN), DM, DM, DM, 0, 0};
                pg8::StaticOrder S; S.init(HT, NPROJ, G, bx, WGM_P1);
                pg8::EpiProj E{(const float*)(ws + WS_SSQ), rb, (bf16_t*)(ws + WS_QK), (bf16_t*)(ws + WS_KF), (bf16_t*)(ws + WS_VT), (float*)(ws + WS_FL), (bf16_t*)(ws + WS_GATE)};
                pg8::gemm_phase<pg8::EpiProj, pg8::StaticOrder, true>(lds, g, S, E, wave_k);
            }
#endif
            GSYNC();
#ifndef NO_P2
            for (int rep = 0; rep < REP_P2; ++rep) {
                PHASE_VARS();
                unsigned* ctr = (unsigned*)(ws + WS_CTL) + 64 + 512 * (layer * 2 + half + 4 * rep);
                const int xq = bx & 7;
                ctr += 64 * xq;
                for (;;) {
                    int li = 0; if (lane == 0) li = (int)atomicAdd(ctr, 1u); li = __builtin_amdgcn_readfirstlane(li);
                    if (li >= 800) break;
                    int idx;
                    if (li < 288) { const int row = li / 6, hl = li - row * 6; idx = row * 48 + (xq + 8 * hl); }
                    else if (li < 416) { const int i = li - 288; idx = 2304 + ((63 - (i & 63)) << 4) + (xq + 8 * (i >> 6)); }
                    else { const int i = li - 416; idx = 3328 + (xq + 8 * (i >> 6)) * 64 + (i & 63); }
                    int lane_u = lane; asm volatile("" : "+v"(lane_u));
                    const int lane = lane_u, r32 = lane & 31, hi = lane >> 5;
                    KParamsPtr PU = OPQ_PP(); unsigned char* wsu = PU->ws;
                    bf16_t* YS = (bf16_t*)(wsu + WS_YS); bf16_t* DILO = (bf16_t*)(wsu + WS_DILO); float* LSE = (float*)(wsu + WS_LSE); const float* FL = (const float*)(wsu + WS_FL);
                    const bf16_t* QK = (const bf16_t*)(wsu + WS_QK); const bf16_t* KF = (const bf16_t*)(wsu + WS_KF); const bf16_t* VT = (const bf16_t*)(wsu + WS_VT);
                    if (idx < 2304) {
                        const int j = idx / 48, e = idx - j * 48, type3 = e >> 4, bh = e & 15, b = bh >> 2, h = bh & 3;
                        int Q, chunk; if (j < 32) { Q = 31 - (j >> 1); chunk = j & 1; } else { Q = 47 - j; chunk = 0; }
                        int kb_lo = 0, kb_hi = 2 * Q + 1;
                        if (Q >= 16) { if (chunk == 0) kb_hi = Q; else kb_lo = Q + 1; }
                        const size_t rowb = (size_t)b * SEQ;
                        bf16_t* SCRB = (bf16_t*)(wsu + WS_MERGED) + (size_t)(half * HT) * DM;
                        float* LSE2 = (float*)(wsu + WS_LSE2);
                        f32x16 o[2][2]; float m[2], l[2]; int slot;
                        if (type3 == 2) {
                            LAS float* cl = scr;
                            const float bf = PP->b_forget[layer * 4 + h];
                            float run = 0.f;
                            if (lane <= kb_hi) {
                                const float* fp = FL + (rowb + 32 * lane) * 4 + h;
#pragma unroll 8
                                for (int i = 0; i < 32; ++i) { const float y = fp[4 * i] + bf; const float lf = fminf(y, 0.f) - __logf(1.0f + __expf(-fabsf(y))); run += lf; cl[33 * lane + i] = run; }
                            }
                            float incl = run;
#pragma unroll
                            for (int o_ = 1; o_ < 64; o_ <<= 1) { const float tt = __uint_as_float((unsigned)__builtin_amdgcn_ds_bpermute((lane - o_) << 2, (int)__float_as_uint(incl))); if (lane >= o_) incl += tt; }
                            const float excl = incl - run;
                            if (lane <= kb_hi) {
#pragma unroll 8
                                for (int i = 0; i < 32; ++i) cl[33 * lane + i] = -(cl[33 * lane + i] + excl) * LOG2E;
                            }
                            asm volatile("s_waitcnt lgkmcnt(0)" ::: "memory");
                            sm_unit64<0>(QK + rowb * LDQK + 4 * 256 + h * 64, KF + (size_t)(b * 24 + 16 + h) * HSEQ, VT + (size_t)(b * 24 + 16 + h) * HSEQ, Q, kb_hi, kb_lo, 0.f, cl, o, m, l, lane);
                            asm volatile("s_waitcnt lgkmcnt(0)" ::: "memory");
                            slot = chunk;
                        } else {
                            const float slope = exp2f(-8.0f * (float)(5 + h) / 16.0f);
                            sm_unit64<2>(QK + rowb * LDQK + 5 * 256 + h * 64 + type3 * 32, KF + (size_t)(b * 24 + 20 + h) * HSEQ + type3 * 1024, VT + (size_t)(b * 24 + 20 + h) * HSEQ, Q, kb_hi, kb_lo, slope * LOG2E, nullptr, o, m, l, lane);
                            slot = 2 + 2 * type3 + chunk;
                        }
#pragma unroll
                        for (int i = 0; i < 2; ++i) {
                            const int t = (2 * Q + i) * 32 + r32;
                            bf16_t* dst;
                            if (type3 == 2) dst = chunk ? SCRB + (rowb + t) * 256 + h * 64 : YS + (rowb + t) * DM + 512 + h * 64;
                            else dst = (type3 == 0 && chunk == 0) ? YS + (rowb + t) * DM + 768 + h * 64 : SCRB + (size_t)(2 * type3 + chunk) * HT * 256 + (rowb + t) * 256 + h * 64;
                            const float inv = 1.0f / l[i];
#pragma unroll
                            for (int k = 0; k < 16; ++k) { o[i][0][k] *= inv; o[i][1][k] *= inv; }
                            store_o(dst, o[i][0], o[i][1], hi);
                            if (hi == 0) LSE2[(rowb + t) * 24 + h * 6 + slot] = m[i] + lg2(l[i]);
                        }
                    } else if (idx < 3328) {
                        const int i1 = idx - 2304, qb = 63 - (i1 >> 4), bh = i1 & 15, b = bh >> 2, h = bh & 3;
                        const size_t rowb = (size_t)b * SEQ; const int t = qb * 32 + r32;
                        f32x16 o0, o1;
                        sb_unit(QK + rowb * LDQK + 0 * 256 + h * 64, KF + (size_t)(b * 24 + h) * HSEQ, VT + (size_t)(b * 24 + h) * HSEQ, qb, o0, o1, lane);
                        store_o(YS + (rowb + t) * DM + 0 * 256 + h * 64, o0, o1, hi);
                    } else {
                        const int i2 = idx - 3328, j = i2 & 63, gh = (i2 >> 6) % 12, b = i2 / 768, gI = gh >> 2, h = gh & 3;
                        const int rsh = 2 * gI, r = 1 << rsh, sl = SEQ >> rsh, nubsh = 6 - rsh, rho = j >> nubsh, ub = j & ((1 << nubsh) - 1);
                        const int sidx = (gI == 0) ? h : (gI == 1 ? 8 + h : 12 + h);
                        const float slope = exp2f(-8.0f * (float)(sidx + 1) / 16.0f);
                        const size_t rowb = (size_t)b * SEQ + (size_t)rho * sl;
                        f32x16 o0, o1; float m, l;
                        const int kb_lo = (ub - 4 > 0) ? ub - 4 : 0;
                        sm_unit<1>(QK + rowb * LDQK + (1 + gI) * 256 + h * 64, KF + (size_t)(b * 24 + 4 + 4 * gI + h) * HSEQ + (size_t)rho * sl * 64,
                                   VT + (size_t)(b * 24 + 4 + 4 * gI + h) * HSEQ + (size_t)rho * sl * 64, ub, ub, kb_lo, slope * (float)r * LOG2E, nullptr, o0, o1, m, l, lane);
                        const float inv = 1.0f / l;
#pragma unroll
                        for (int i = 0; i < 16; ++i) { o0[i] *= inv; o1[i] *= inv; }
                        const int u = ub * 32 + r32; const size_t tok = (size_t)b * SEQ + (size_t)u * r + rho;
                        store_o(DILO + tok * 768 + gI * 256 + h * 64, o0, o1, hi);
                        if (hi == 0) LSE[tok * 12 + gI * 4 + h] = (m + lg2(l)) * LN2;
                    }
                }
            }
#endif
            GSYNC();
            {
                PHASE_VARS();
                const float lam_init = (layer == 0) ? 0.2f : 0.35550906759093115f;
                float lam;
                { const float a = (lane < 32) ? PP->lq1[layer * 32 + lane] * PP->lk1[layer * 32 + lane] : 0.f, b = (lane < 32) ? PP->lq2[layer * 32 + lane] * PP->lk2[layer * 32 + lane] : 0.f;
                  lam = __expf(wave_sum(a)) - __expf(wave_sum(b)) + lam_init; }
                bf16_t* YS = (bf16_t*)(ws + WS_YS); const bf16_t* DILO = (const bf16_t*)(ws + WS_DILO); const float* LSE = (const float*)(ws + WS_LSE);
                const bf16_t* SCRB = (const bf16_t*)(ws + WS_MERGED) + (size_t)(half * HT) * DM; const float* LSE2 = (const float*)(ws + WS_LSE2);
                const int h = lane >> 4, dq = (lane & 15) * 4;
                const f32x4 dgv = *(const f32x4*)(PP->diff_g + layer * 64 + dq);
                for (int row = gw; row < HT; row += NGW) {
                    const bool split = ((row & (SEQ - 1)) >> 5) >= 32;
                    {
                        const float l0 = LSE[(size_t)row * 12 + h], l1 = LSE[(size_t)row * 12 + 4 + h], l2 = LSE[(size_t)row * 12 + 8 + h];
                        const float mx = fmaxf(l0, fmaxf(l1, l2)); const float e0 = __expf(l0 - mx), e1 = __expf(l1 - mx), e2 = __expf(l2 - mx); const float inv = 1.0f / (e0 + e1 + e2);
                        const u32x2 a = *(const u32x2*)(DILO + (size_t)row * 768 + 4 * lane), b = *(const u32x2*)(DILO + (size_t)row * 768 + 256 + 4 * lane), c = *(const u32x2*)(DILO + (size_t)row * 768 + 512 + 4 * lane);
                        const float w0 = e0 * inv, w1 = e1 * inv, w2 = e2 * inv;
                        u32x2 o; o.x = cvtpk(w0 * bflo(a.x) + w1 * bflo(b.x) + w2 * bflo(c.x), w0 * bfhi(a.x) + w1 * bfhi(b.x) + w2 * bfhi(c.x));
                        o.y = cvtpk(w0 * bflo(a.y) + w1 * bflo(b.y) + w2 * bflo(c.y), w0 * bfhi(a.y) + w1 * bfhi(b.y) + w2 * bfhi(c.y));
                        *(u32x2*)(YS + (size_t)row * DM + 256 + 4 * lane) = o;
                    }
                    const float* ls = LSE2 + (size_t)row * 24 + h * 6;
                    const u32x2 f0 = *(const u32x2*)(YS + (size_t)row * DM + 512 + 4 * lane), a0 = *(const u32x2*)(YS + (size_t)row * DM + 768 + 4 * lane);
                    const u32x2 b0 = *(const u32x2*)(SCRB + (size_t)2 * HT * 256 + (size_t)row * 256 + 4 * lane);
                    float fv[4] = {bflo(f0.x), bfhi(f0.x), bflo(f0.y), bfhi(f0.y)}, av[4] = {bflo(a0.x), bfhi(a0.x), bflo(a0.y), bfhi(a0.y)}, bv[4] = {bflo(b0.x), bfhi(b0.x), bflo(b0.y), bfhi(b0.y)};
                    if (split) {
                        const u32x2 f1 = *(const u32x2*)(SCRB + (size_t)row * 256 + 4 * lane), a1 = *(const u32x2*)(SCRB + (size_t)1 * HT * 256 + (size_t)row * 256 + 4 * lane), b1 = *(const u32x2*)(SCRB + (size_t)3 * HT * 256 + (size_t)row * 256 + 4 * lane);
                        const float lf0 = ls[0], lf1 = ls[1], la0 = ls[2], la1 = ls[3], lb0 = ls[4], lb1 = ls[5];
                        { const float mx = fmaxf(lf0, lf1), e0 = ex2(lf0 - mx), e1 = ex2(lf1 - mx), inv = 1.0f / (e0 + e1), w0 = e0 * inv, w1 = e1 * inv;
                          fv[0] = w0 * fv[0] + w1 * bflo(f1.x); fv[1] = w0 * fv[1] + w1 * bfhi(f1.x); fv[2] = w0 * fv[2] + w1 * bflo(f1.y); fv[3] = w0 * fv[3] + w1 * bfhi(f1.y); }
                        { const float mx = fmaxf(la0, la1), e0 = ex2(la0 - mx), e1 = ex2(la1 - mx), inv = 1.0f / (e0 + e1), w0 = e0 * inv, w1 = e1 * inv;
                          av[0] = w0 * av[0] + w1 * bflo(a1.x); av[1] = w0 * av[1] + w1 * bfhi(a1.x); av[2] = w0 * av[2] + w1 * bflo(a1.y); av[3] = w0 * av[3] + w1 * bfhi(a1.y); }
                        { const float mx = fmaxf(lb0, lb1), e0 = ex2(lb0 - mx), e1 = ex2(lb1 - mx), inv = 1.0f / (e0 + e1), w0 = e0 * inv, w1 = e1 * inv;
                          bv[0] = w0 * bv[0] + w1 * bflo(b1.x); bv[1] = w0 * bv[1] + w1 * bfhi(b1.x); bv[2] = w0 * bv[2] + w1 * bflo(b1.y); bv[3] = w0 * bv[3] + w1 * bfhi(b1.y); }
                        u32x2 fo; fo.x = cvtpk(fv[0], fv[1]); fo.y = cvtpk(fv[2], fv[3]);
                        *(u32x2*)(YS + (size_t)row * DM + 512 + 4 * lane) = fo;
                    }
                    float dv[4]; float ss = 0.f;
#pragma unroll
                    for (int i = 0; i < 4; ++i) { dv[i] = av[i] - lam * bv[i]; ss += dv[i] * dv[i]; }
                    ss += swz_xor<1>(ss); ss += swz_xor<2>(ss); ss += swz_xor<4>(ss); ss += swz_xor<8>(ss);
                    const float rn = __builtin_amdgcn_rsqf(ss * (1.0f / 64.0f) + RMS_EPS) * (1.0f - lam_init);
                    u32x2 dout; dout.x = cvtpk(dv[0] * rn * dgv[0], dv[1] * rn * dgv[1]); dout.y = cvtpk(dv[2] * rn * dgv[2], dv[3] * rn * dgv[3]);
                    *(u32x2*)(YS + (size_t)row * DM + 768 + 4 * lane) = dout;
                }
            }
            GSYNC();
#ifndef NO_P3
            for (int rep = 0; rep < REP_P3; ++rep) {
                PHASE_VARS();
                pg8::Gemm g{(const bf16_t*)(ws + WS_YS), (const bf16_t*)(ws + WS_WB), DM, 512, 512, 512 * 2, (long)8 * 256 * 512 * 2};
                pg8::BranchOrder S{bx, G};
                pg8::EpiBranch E{(const bf16_t*)(ws + WS_GATE), (bf16_t*)(ws + WS_MERGED), half * HT, (bf16_t*)(ws + WS_QK)};
                pg8::gemm_phase<pg8::EpiBranch, pg8::BranchOrder, true, false>(lds, g, S, E, wave_k);
            }
#endif
            GSYNC();
        }
#ifndef NO_P4
        for (int rep = 0; rep < REP_CONV; ++rep) {
            PHASE_VARS();
            bf16_t* WUP = (bf16_t*)(ws + WS_WUP); bf16_t* WDN = (bf16_t*)(ws + WS_WDN);
            const float* wu = PP->w_up + (size_t)layer * DM * DFF; const float* wd = PP->w_down + (size_t)layer * DFF * DM; const float* mg = PP->mlp_g + (size_t)layer * DM;
            constexpr int I_U = (DM / 64) * (DFF / 32), I_D = (DFF / 64) * (DM / 32);
            for (int it = gw; it < I_U + I_D; it += NGW) {
                if (it < I_U) transpose_item<0>(wu, DM, DFF, DFF, mg, WUP, scr, it, lane);
                else transpose_item<0>(wd, DFF, DM, DM, nullptr, WDN, scr, it - I_U, lane);
            }
            __syncthreads();
        }
        {
            PHASE_VARS();
            pg8::Gemm g{(const bf16_t*)(ws + WS_MERGED), (const bf16_t*)(ws + WS_WOUT), DM, DM, DM, 0, 0};
            pg8::StaticOrder S; S.init(TOK, DM, G, bx);
            pg8::EpiResid E{(layer == 0) ? PP->x : (const float*)PP->out, PP->out, (bf16_t*)(ws + WS_XB), (float*)(ws + WS_SSQ)};
            pg8::gemm_phase<pg8::EpiResid, pg8::StaticOrder, false>(lds, g, S, E, wave_k);
        }
#endif
        GSYNC();
#ifndef NO_P5
        for (int rep = 0; rep < REP_P5; ++rep) {
            PHASE_VARS();
            pg8::Gemm g{(const bf16_t*)(ws + WS_XB), (const bf16_t*)(ws + WS_WUP), DM, DM, DM, 0, 0};
            pg8::StaticOrder S; S.init(TOK, DFF, G, bx, WGM_P5);
            pg8::EpiUp E{(const float*)(ws + WS_SSQ), (bf16_t*)(ws + WS_HMLP)};
            pg8::gemm_phase<pg8::EpiUp, pg8::StaticOrder, true>(lds, g, S, E, wave_k);
        }
#endif
        GSYNC();
#ifndef NO_P6
        {
            PHASE_VARS();
            pg8::Gemm g{(const bf16_t*)(ws + WS_HMLP), (const bf16_t*)(ws + WS_WDN), DFF, DFF, DFF, 0, 0};
            pg8::StaticOrder S; S.init(TOK, DM, G, bx);
            if (layer == DEPTH - 1 && G == 256) {
                pg8::EpiFinal E{(const float*)PP->out, PP->out, (float*)(ws + WS_SSQ), PP->final_g, (unsigned*)(ws + WS_CTL) + CW_PANEL};
                pg8::gemm_phase<pg8::EpiFinal, pg8::StaticOrder, true>(lds, g, S, E, wave_k);
            } else {
                pg8::EpiResid E{(const float*)PP->out, PP->out, (bf16_t*)(ws + WS_XB), (float*)(ws + WS_SSQ)};
                pg8::gemm_phase<pg8::EpiResid, pg8::StaticOrder, false>(lds, g, S, E, wave_k);
            }
        }
#endif
        if (layer < DEPTH - 1 || gridDim.x != 256) GSYNC();
    }
    if (gridDim.x != 256)
    {
        PHASE_VARS();
        float* X = PP->out;
        for (int row = gw; row < TOK; row += NGW) {
            f32x4* xo = (f32x4*)(X + (size_t)row * DM) + lane; const f32x4* gp = (const f32x4*)PP->final_g + lane;
            f32x4 v[4]; float s = 0.f;
#pragma unroll
            for (int j = 0; j < 4; ++j) { v[j] = xo[64 * j]; s += (v[j][0] * v[j][0] + v[j][1] * v[j][1]) + (v[j][2] * v[j][2] + v[j][3] * v[j][3]); }
            const float rstd = __builtin_amdgcn_rsqf(wave_sum(s) * (1.0f / DM) + RMS_EPS);
#pragma unroll
            for (int j = 0; j < 4; ++j) xo[64 * j] = v[j] * rstd * gp[64 * j];
        }
    }
}

extern "C" void kernel_launch(void* const* d_in, const int* in_sizes, int n_in, void* d_out, int out_size, void* d_ws, size_t ws_size, hipStream_t stream) {
    static int grid = 0;
    if (grid == 0) {
        if (n_in != 15 || in_sizes[0] != TOK * DM || out_size != TOK * DM || ws_size < WS_END) { fprintf(stderr, "kernel_launch: unexpected shapes / workspace (n_in %d, ws %zu)\n", n_in, ws_size); grid = -1; return; }
        int dev = 0, cus = 0, per_cu = 0;
        hipGetDevice(&dev); hipDeviceGetAttribute(&cus, hipDeviceAttributeMultiprocessorCount, dev);
        hipFuncSetAttribute((const void*)fwd_mega, hipFuncAttributeMaxDynamicSharedMemorySize, LDS_BYTES);
        hipOccupancyMaxActiveBlocksPerMultiprocessor(&per_cu, (const void*)fwd_mega, NWAVES * 64, LDS_BYTES);
        (void)hipGetLastError();
        if (per_cu < 1) per_cu = 1;
        grid = cus;
        if (grid > 256) grid = 256;
        if (grid % 8 != 0) { fprintf(stderr, "kernel_launch: the per-XCD work queues need a grid that is a multiple of 8 (got %d)\n", grid); grid = -1; return; }
    }
    if (grid < 0) return;
    hipMemsetAsync((char*)d_ws + WS_CTL, 0, CTL_BYTES, stream);
    Params p{};
    p.x = (const float*)d_in[0]; p.mix_g = (const float*)d_in[1]; p.w_in = (const float*)d_in[2]; p.b_forget = (const float*)d_in[3];
    p.lq1 = (const float*)d_in[4]; p.lk1 = (const float*)d_in[5]; p.lq2 = (const float*)d_in[6]; p.lk2 = (const float*)d_in[7];
    p.diff_g = (const float*)d_in[8]; p.w_branch = (const float*)d_in[9]; p.w_out = (const float*)d_in[10]; p.mlp_g = (const float*)d_in[11];
    p.w_up = (const float*)d_in[12]; p.w_down = (const float*)d_in[13]; p.final_g = (const float*)d_in[14];
    p.out = (float*)d_out; p.ws = (unsigned char*)d_ws;
    void* args[] = {&p};
    hipError_t e = hipLaunchCooperativeKernel((const void*)fwd_mega, dim3(grid), dim3(NWAVES * 64), args, LDS_BYTES, stream);
    if (e != hipSuccess) fprintf(stderr, "cooperative launch failed: %s (grid %d)\n", hipGetErrorString(e), grid);
}
```
